# Optimizing an MI355X kernel written in HIP

```python
import math
import jax, jax.numpy as jnp
from jax import lax
import numpy as np

D_MODEL = 1024
BATCH = 8
SEQ = 8192
DEPTH = 2

N_META = 16
M_HEADS = 4
M_DK = 128
M_DV = 128
M_WIDTH = M_HEADS * M_DV
CONV_W = 4
CHUNK = 64
A_HEADS = 4
A_DK = 64
A_DV = 2 * A_DK
A_WIDTH = A_HEADS * A_DV
Q_BLOCK = 128
D_FF = 2816
ALPHA = (2 * DEPTH) ** 0.25
BETA = (8 * DEPTH) ** -0.25
LN_EPS = 1e-5
NEG = -1e30
PROJ_SPLITS = (M_HEADS * M_DK, M_HEADS * M_DK, M_WIDTH, M_WIDTH, 2 * M_HEADS,
               A_HEADS * 2 * A_DK, A_HEADS * 2 * A_DK, A_WIDTH, 2 * D_MODEL)
D_PROJ = sum(PROJ_SPLITS)

kernel_name = "hybrid_mlstm_diffattn_macaron_deepnorm"


def layer_norm(x, g, b):
    xf = x.astype(jnp.float32)
    mu = jnp.mean(xf, -1, keepdims=True)
    var = jnp.mean(jnp.square(xf - mu), -1, keepdims=True)
    return ((xf - mu) * lax.rsqrt(var + LN_EPS) * g + b).astype(x.dtype)


def swiglu(x, w_gate, w_up, w_down):
    return (jax.nn.silu(x @ w_gate) * (x @ w_up)) @ w_down


def causal_dwconv(u, w, b):
    L = u.shape[1]
    up = jnp.pad(u, ((0, 0), (CONV_W - 1, 0), (0, 0)))
    return b + sum(up[:, j:j + L] * w[j] for j in range(CONV_W))


def alibi_slopes():
    return jnp.array([2.0 ** (-8.0 * (h + 1) / A_HEADS) for h in range(A_HEADS)], jnp.float32)


def mlstm_chunk(carry, inp):
    C, n, m = carry
    q, k, v, log_i, log_f = inp
    T = q.shape[2]
    b = jnp.cumsum(log_f, axis=-1)
    a = b + m[..., None]
    D = b[..., :, None] - b[..., None, :] + log_i[..., None, :]
    causal = jnp.tril(jnp.ones((T, T), dtype=bool))
    D = jnp.where(causal, D, NEG)
    m_t = jnp.maximum(a, jnp.max(D, -1))
    w_state = jnp.exp(a - m_t)
    S = jnp.einsum('bhtk,bhsk->bhts', q, k) * jnp.exp(D - m_t[..., None])
    num = jnp.einsum('bhts,bhsv->bhtv', S, v) + w_state[..., None] * jnp.einsum('bhtk,bhkv->bhtv', q, C)
    den = jnp.sum(S, -1) + w_state * jnp.einsum('bhtk,bhk->bht', q, n)
    h = num / jnp.maximum(jnp.abs(den), jnp.exp(-m_t))[..., None]
    g_end = b[..., -1]
    a_end = g_end + m
    d_end = g_end[..., None] - b + log_i
    m_new = jnp.maximum(a_end, jnp.max(d_end, -1))
    ws = jnp.exp(d_end - m_new[..., None])
    decay = jnp.exp(a_end - m_new)
    C_new = decay[..., None, None] * C + jnp.einsum('bhs,bhsk,bhsv->bhkv', ws, k, v)
    n_new = decay[..., None] * n + jnp.einsum('bhs,bhsk->bhk', ws, k)
    return (C_new, n_new, m_new), h


def mlstm_chunkwise(q, k, v, log_i, log_f):
    B, H, L, _ = q.shape
    nc = (L - N_META) // CHUNK
    carry = (jnp.zeros((B, H, M_DK, M_DV), jnp.float32),
             jnp.zeros((B, H, M_DK), jnp.float32),
             jnp.full((B, H), NEG, jnp.float32))
    ins = (q, k, v, log_i, log_f)
    carry, h_meta = mlstm_chunk(carry, tuple(t[:, :, :N_META] for t in ins))

    def to_chunks(t):
        r = t[:, :, N_META:]
        r = r.reshape((B, H, nc, CHUNK) + r.shape[3:])
        return jnp.moveaxis(r, 2, 0)

    _, h_real = lax.scan(mlstm_chunk, carry, tuple(to_chunks(t) for t in ins))
    h_real = jnp.moveaxis(h_real, 0, 2).reshape(B, H, L - N_META, M_DV)
    return jnp.concatenate([h_meta, h_real], axis=2)


def mlstm_branch(mq, mk, mv, mo, mif, conv_w, conv_b, b_if, norm_g):
    B, L, _ = mq.shape
    qk = jax.nn.silu(causal_dwconv(jnp.concatenate([mq, mk], -1), conv_w, conv_b))
    q, k = jnp.split(qk, 2, axis=-1)

    def heads(t, d):
        return t.reshape(B, L, M_HEADS, d).transpose(0, 2, 1, 3).astype(jnp.float32)

    q = heads(q, M_DK)
    k = heads(k, M_DK) * (M_DK ** -0.5)
    v = heads(mv, M_DV)
    gates = (mif + b_if).astype(jnp.float32).transpose(0, 2, 1)
    log_i = gates[:, :M_HEADS]
    log_f = jax.nn.log_sigmoid(gates[:, M_HEADS:])
    h = mlstm_chunkwise(q, k, v, log_i, log_f)
    mu = jnp.mean(h, -1, keepdims=True)
    var = jnp.mean(jnp.square(h - mu), -1, keepdims=True)
    h = ((h - mu) * lax.rsqrt(var + LN_EPS)).transpose(0, 2, 1, 3).reshape(B, L, M_WIDTH)
    return (h * norm_g * jax.nn.sigmoid(mo.astype(jnp.float32))).astype(mq.dtype)


def diff_attn_branch(aq, ak, av, lam_q1, lam_k1, lam_q2, lam_k2, norm_g, lam_init):
    B, L, _ = aq.shape
    q = aq.reshape(B, L, A_HEADS, 2, A_DK).transpose(0, 2, 3, 1, 4).astype(jnp.float32) * (A_DK ** -0.5)
    k = ak.reshape(B, L, A_HEADS, 2, A_DK).transpose(0, 2, 3, 1, 4).astype(jnp.float32)
    v = av.reshape(B, L, A_HEADS, A_DV).transpose(0, 2, 1, 3).astype(jnp.float32)
    f32 = jnp.float32
    lam = (jnp.exp(jnp.sum(lam_q1.astype(f32) * lam_k1.astype(f32)))
           - jnp.exp(jnp.sum(lam_q2.astype(f32) * lam_k2.astype(f32))) + lam_init)
    slopes = alibi_slopes()

    def attend(qb, tpos, kb, vb):
        spos = jnp.arange(kb.shape[3])
        dist = (tpos[:, None] - spos[None, :]).astype(f32)
        s = jnp.einsum('bhcqd,bhckd->bhcqk', qb, kb) - (slopes[:, None, None] * dist)[None, :, None]
        s = jnp.where(spos[None, :] <= tpos[:, None], s, NEG)
        p = jax.nn.softmax(s, axis=-1)
        return jnp.einsum('bhqk,bhkv->bhqv', p[:, :, 0] - lam * p[:, :, 1], vb)

    o_meta = attend(q[:, :, :, :N_META], jnp.arange(N_META), k[:, :, :, :N_META], v[:, :, :N_META])

    def real_block(j):
        start = N_META + j * Q_BLOCK
        qb = lax.dynamic_slice_in_dim(q, start, Q_BLOCK, axis=3)
        return attend(qb, start + jnp.arange(Q_BLOCK), k, v)

    nb = (L - N_META) // Q_BLOCK
    o_real = lax.map(real_block, jnp.arange(nb))
    o_real = jnp.moveaxis(o_real, 0, 2).reshape(B, A_HEADS, L - N_META, A_DV)
    o = jnp.concatenate([o_meta, o_real], axis=2)
    o = o * lax.rsqrt(jnp.mean(o * o, -1, keepdims=True) + LN_EPS) * (1.0 - lam_init)
    o = o.transpose(0, 2, 1, 3).reshape(B, L, A_WIDTH) * norm_g
    return o.astype(aq.dtype)


def hybrid_mixer(x, w_in, conv_w, conv_b, b_if, m_norm_g, lam_q1, lam_k1, lam_q2, lam_k2,
                 a_norm_g, w_bm, w_ba, b_gate, w_out, lam_init):
    proj = x @ w_in
    offs = np.cumsum(PROJ_SPLITS)[:-1].tolist()
    mq, mk, mv, mo, mif, aq, ak, av, g = jnp.split(proj, offs, axis=-1)
    y_m = mlstm_branch(mq, mk, mv, mo, mif, conv_w, conv_b, b_if, m_norm_g) @ w_bm
    y_a = diff_attn_branch(aq, ak, av, lam_q1, lam_k1, lam_q2, lam_k2, a_norm_g, lam_init) @ w_ba
    g = jax.nn.sigmoid(g + b_gate)
    g_m, g_a = jnp.split(g, 2, axis=-1)
    return (g_m * y_m + g_a * y_a) @ w_out


def setup_inputs(seed: int = 0) -> dict:
    key = jax.random.key(seed)
    ks = jax.random.split(key, 32)
    f32 = jnp.float32

    def nrm(k, shape, scale):
        return jax.random.normal(k, shape, f32) * scale

    Dp = DEPTH
    b_if = jnp.concatenate([
        nrm(ks[10], (Dp, M_HEADS), 0.1),
        jnp.broadcast_to(jnp.linspace(3.0, 6.0, M_HEADS, dtype=f32), (Dp, M_HEADS)) + nrm(ks[11], (Dp, M_HEADS), 0.1),
    ], axis=-1)
    return {
        "x": nrm(ks[0], (BATCH, SEQ, D_MODEL), 1.0),
        "meta": nrm(ks[1], (N_META, D_MODEL), 1.0),
        "ffn1_w_gate": nrm(ks[2], (Dp, D_MODEL, D_FF), D_MODEL ** -0.5),
        "ffn1_w_up": nrm(ks[3], (Dp, D_MODEL, D_FF), D_MODEL ** -0.5),
        "ffn1_w_down": nrm(ks[4], (Dp, D_FF, D_MODEL), BETA * D_FF ** -0.5),
        "ln1_g": 1.0 + nrm(ks[5], (Dp, D_MODEL), 0.02),
        "ln1_b": nrm(ks[6], (Dp, D_MODEL), 0.02),
        "w_in": nrm(ks[7], (Dp, D_MODEL, D_PROJ), D_MODEL ** -0.5),
        "conv_w": nrm(ks[8], (Dp, CONV_W, 2 * M_HEADS * M_DK), CONV_W ** -0.5),
        "conv_b": nrm(ks[9], (Dp, 2 * M_HEADS * M_DK), 0.01),
        "b_if": b_if,
        "m_norm_g": 1.0 + nrm(ks[12], (Dp, M_WIDTH), 0.02),
        "lam_q1": nrm(ks[13], (Dp, A_DK), 0.1),
        "lam_k1": nrm(ks[14], (Dp, A_DK), 0.1),
        "lam_q2": nrm(ks[15], (Dp, A_DK), 0.1),
        "lam_k2": nrm(ks[16], (Dp, A_DK), 0.1),
        "a_norm_g": 1.0 + nrm(ks[17], (Dp, A_WIDTH), 0.02),
        "w_bm": nrm(ks[18], (Dp, M_WIDTH, D_MODEL), BETA * M_WIDTH ** -0.5),
        "w_ba": nrm(ks[19], (Dp, A_WIDTH, D_MODEL), BETA * A_WIDTH ** -0.5),
        "b_gate": nrm(ks[20], (Dp, 2 * D_MODEL), 0.01),
        "w_out": nrm(ks[21], (Dp, D_MODEL, D_MODEL), BETA * D_MODEL ** -0.5),
        "ln2_g": 1.0 + nrm(ks[22], (Dp, D_MODEL), 0.02),
        "ln2_b": nrm(ks[23], (Dp, D_MODEL), 0.02),
        "ffn2_w_gate": nrm(ks[24], (Dp, D_MODEL, D_FF), D_MODEL ** -0.5),
        "ffn2_w_up": nrm(ks[25], (Dp, D_MODEL, D_FF), D_MODEL ** -0.5),
        "ffn2_w_down": nrm(ks[26], (Dp, D_FF, D_MODEL), BETA * D_FF ** -0.5),
        "ln3_g": 1.0 + nrm(ks[27], (Dp, D_MODEL), 0.02),
        "ln3_b": nrm(ks[28], (Dp, D_MODEL), 0.02),
    }


def reference(x, meta, ffn1_w_gate, ffn1_w_up, ffn1_w_down, ln1_g, ln1_b, w_in, conv_w, conv_b,
              b_if, m_norm_g, lam_q1, lam_k1, lam_q2, lam_k2, a_norm_g, w_bm, w_ba, b_gate, w_out,
              ln2_g, ln2_b, ffn2_w_gate, ffn2_w_up, ffn2_w_down, ln3_g, ln3_b):
    B = x.shape[0]
    h = jnp.concatenate([jnp.broadcast_to(meta.astype(x.dtype), (B, N_META, D_MODEL)), x], axis=1)
    for i in range(DEPTH):
        lam_init = 0.8 - 0.6 * math.exp(-0.3 * i)
        h = layer_norm(ALPHA * h + 0.5 * swiglu(h, ffn1_w_gate[i], ffn1_w_up[i], ffn1_w_down[i]), ln1_g[i], ln1_b[i])
        mix = hybrid_mixer(h, w_in[i], conv_w[i], conv_b[i], b_if[i], m_norm_g[i], lam_q1[i], lam_k1[i],
                           lam_q2[i], lam_k2[i], a_norm_g[i], w_bm[i], w_ba[i], b_gate[i], w_out[i], lam_init)
        h = layer_norm(ALPHA * h + mix, ln2_g[i], ln2_b[i])
        h = layer_norm(ALPHA * h + 0.5 * swiglu(h, ffn2_w_gate[i], ffn2_w_up[i], ffn2_w_down[i]), ln3_g[i], ln3_b[i])
    return h[:, N_META:]
```

```cpp
#include <hip/hip_runtime.h>
#include <hip/hip_cooperative_groups.h>
#include <cstdio>
#include <cstdint>
namespace cg = cooperative_groups;

__device__ __forceinline__ int tidx() { int t = threadIdx.x; asm volatile("" : "+v"(t)); return t; }
__device__ __forceinline__ int bidx() { int t = blockIdx.x; asm volatile("" : "+s"(t)); return t; }
namespace pg8 {
#define PG8_LAS __attribute__((address_space(3)))
typedef unsigned short bf16_t;
typedef short bf16x8 __attribute__((ext_vector_type(8)));
typedef float f32x4 __attribute__((ext_vector_type(4)));
typedef unsigned u32x4 __attribute__((ext_vector_type(4)));
constexpr int BM = 256, BK = 64, HALF = 128, HTB = HALF * BK * 2  , STAGE_BYTES = 8 * HTB, NXCD = 8, WGM = 8;

__host__ __device__ __forceinline__ int lds_byte(int r, int c) { const int st = (r >> 4) * 2 + (c >> 5), rr = r & 15, cc = c & 31, ob = rr * 64 + cc * 2; return st * 1024 + (ob ^ (((ob >> 9) & 1) << 5)); }
__host__ __device__ __forceinline__ void stage_rc(int b, int& R, int& C) { const int st = b / 1024, sb = b % 1024, swz = sb ^ (((sb >> 9) & 1) << 5); R = (st >> 1) * 16 + swz / 64; C = (st & 1) * 32 + (swz % 64) / 2; }
__host__ __device__ __forceinline__ int perm32(int rho) { const int n = rho >> 4, i = rho & 15; return 8 * (i >> 2) + 4 * n + (i & 3); }

struct Unit { int pm, pn; };
struct Gemm { const bf16_t* A; const bf16_t* Bt; int M, N, K; };

struct StaticOrder {
    int nM, nN, nwg, G, c;
    __host__ __device__ void init(int M, int N, int G_, int c_) { nM = M / BM; nN = N / BM; nwg = nM * nN; G = G_; c = c_; }
    __host__ __device__ bool next(int i, Unit& u) const {
        const long L = (long)i * G + c; if (L >= nwg) return false;
        int wgid = (int)L; { const int q = nwg / NXCD, r = nwg % NXCD, xcd = wgid % NXCD, off = wgid / NXCD; wgid = (xcd < r ? xcd * (q + 1) : r * (q + 1) + (xcd - r) * q) + off; }
        const int nig = WGM * nN, gid = wgid / nig, fm = gid * WGM, gsz = (nM - fm) < WGM ? (nM - fm) : WGM;
        u.pm = fm + ((wgid % nig) % gsz); u.pn = (wgid % nig) / gsz; return true;
    }
    __device__ __forceinline__ void a_ready(const Unit&) const {}
    __device__ __forceinline__ void done(const Unit&) const {}
};

__device__ __forceinline__ unsigned cvt_pk_bf16(float lo, float hi) { unsigned r; asm volatile("v_cvt_pk_bf16_f32 %0, %1, %2" : "=v"(r) : "v"(lo), "v"(hi)); return r; }
typedef float f32x2 __attribute__((ext_vector_type(2)));
__device__ __forceinline__ f32x2 gelu_pk(f32x2 v) {
    const f32x2 av = __builtin_elementwise_abs(v), d = av * 0.2316418882f + 1.0f;
    f32x2 t; t.x = __builtin_amdgcn_rcpf(d.x); t.y = __builtin_amdgcn_rcpf(d.y);
    f32x2 q = t * 0.5307027145f + (-0.7265760135f); q = q * t + 0.7107068705f; q = q * t + (-0.142248368f); q = q * t + 0.127414796f; q = q * t;
    const f32x2 s = (v * v) * (-0.72134752044f);
    f32x2 e; e.x = __builtin_amdgcn_exp2f(s.x); e.y = __builtin_amdgcn_exp2f(s.y);
    const f32x2 m = v * (q * e), r = v - m;
    f32x2 o; o.x = v.x < 0.f ? m.x : r.x; o.y = v.y < 0.f ? m.y : r.y; return o;
}

template <int ACT  > struct EpiBf16 {
    static constexpr bool PERM = true, AFTER_DRAIN = false; static_assert(ACT == 0 || ACT == 1, "EpiBf16: ACT is 0 (none) or 1 (gelu_pk)");
    bf16_t* O; int ldc; const float* bias; int split_cols; size_t split_stride; float scale0;
    __device__ __forceinline__ void operator()(const f32x4 (&acc)[2][2][4][2], const Unit& u, int wr, int wc, int fr, int fq) const {
        const int row0 = u.pm * BM + wr * 64 + fr; int colt = u.pn * BM; bf16_t* base = O;
        float sc = 1.f; if (split_cols) { const int t = colt / split_cols; base += (size_t)t * split_stride; colt -= t * split_cols; if (t == 0) sc = scale0; }
        const int col0 = colt + wc * 32 + 8 * fq, bcol0 = u.pn * BM + wc * 32 + 8 * fq;
        f32x4 bv[2][2];
#pragma unroll
        for (int bj = 0; bj < 2; ++bj)
#pragma unroll
            for (int n = 0; n < 2; ++n) bv[bj][n] = bias ? *(const f32x4*)(bias + bcol0 + bj * HALF + 4 * n) : (f32x4){0.f, 0.f, 0.f, 0.f};
#pragma unroll
        for (int ai = 0; ai < 2; ++ai)
#pragma unroll
            for (int m = 0; m < 4; ++m) { bf16_t* rowp = base + (size_t)(row0 + ai * HALF + m * 16) * ldc + col0;
#pragma unroll
                for (int bj = 0; bj < 2; ++bj) { f32x4 v0 = acc[ai][bj][m][0] + bv[bj][0], v1 = acc[ai][bj][m][1] + bv[bj][1];
                    if (ACT == 1) { f32x2 a = gelu_pk((f32x2){v0[0], v0[1]}), b = gelu_pk((f32x2){v0[2], v0[3]}), c = gelu_pk((f32x2){v1[0], v1[1]}), d = gelu_pk((f32x2){v1[2], v1[3]});
                        v0 = (f32x4){a.x, a.y, b.x, b.y}; v1 = (f32x4){c.x, c.y, d.x, d.y}; }
                    v0 = v0 * sc; v1 = v1 * sc; u32x4 w; w.x = cvt_pk_bf16(v0[0], v0[1]); w.y = cvt_pk_bf16(v0[2], v0[3]); w.z = cvt_pk_bf16(v1[0], v1[1]); w.w = cvt_pk_bf16(v1[2], v1[3]);
                    *(u32x4*)(rowp + bj * HALF) = w; } }
    }
};

struct PanelStats {
    unsigned* xbuf;
    unsigned* cnt;
    unsigned* tmo;
    int ntn; float eps;
    unsigned code;
    __device__ __forceinline__ bool run(const f32x4 (&v)[2][2][4][2], const Unit& u, int wr, int wc, int fr, int fq, PG8_LAS unsigned char* lds, int wid, int lane) const {
        typedef float f32x2v __attribute__((ext_vector_type(2)));
        PG8_LAS f32x2v* P = (PG8_LAS f32x2v*)lds;
        PG8_LAS f32x2v* S = (PG8_LAS f32x2v*)(lds + 8192);
        PG8_LAS unsigned* flag = (PG8_LAS unsigned*)(lds + 8192 + 2048);
#pragma unroll
        for (int ai = 0; ai < 2; ++ai)
#pragma unroll
            for (int m = 0; m < 4; ++m) {
                float s = 0.f;
#pragma unroll
                for (int bj = 0; bj < 2; ++bj)
#pragma unroll
                    for (int n = 0; n < 2; ++n) { const f32x4 x = v[ai][bj][m][n]; s += (x[0] + x[1]) + (x[2] + x[3]); }
                s += __shfl_xor(s, 16); s += __shfl_xor(s, 32);
                const float mw = s * (1.0f / 64.0f); float q = 0.f;
#pragma unroll
                for (int bj = 0; bj < 2; ++bj)
#pragma unroll
                    for (int n = 0; n < 2; ++n) { const f32x4 d = v[ai][bj][m][n] - mw; q += (d[0] * d[0] + d[1] * d[1]) + (d[2] * d[2] + d[3] * d[3]); }
                q += __shfl_xor(q, 16); q += __shfl_xor(q, 32);
                if (fq == 0) P[(ai * HALF + wr * 64 + m * 16 + fr) * 4 + wc] = (f32x2v){mw, q};
            }
        asm volatile("s_waitcnt lgkmcnt(0)" ::: "memory"); __builtin_amdgcn_s_barrier(); asm volatile("" ::: "memory");
#if defined(BROKEN_EXCHANGE_NO_WAIT)
#warning BROKEN CONTROL BUILD: the row-statistics exchange does not wait; results are wrong by design
        if (blockIdx.x >= 64) { const long long t0_ = clock64(); while (clock64() - t0_ < 60000) __builtin_amdgcn_s_sleep(8); }
#endif
        const int row = wid * 32 + (lane & 31);
        if (lane < 32) {
            const f32x2v a = P[row * 4 + 0], b = P[row * 4 + 1], c = P[row * 4 + 2], d = P[row * 4 + 3];
            const float mt = (a.x + b.x + c.x + d.x) * 0.25f;
            const float da = a.x - mt, db = b.x - mt, dc = c.x - mt, dd = d.x - mt;
            const float m2 = (a.y + b.y) + (c.y + d.y) + 64.0f * ((da * da + db * db) + (dc * dc + dd * dd));
            unsigned long long* slot = (unsigned long long*)xbuf + ((size_t)(u.pm * BM + row) * 4 + u.pn);
            __hip_atomic_store(slot, ((unsigned long long)__float_as_uint(m2) << 32) | __float_as_uint(mt), __ATOMIC_RELAXED, __HIP_MEMORY_SCOPE_AGENT);
        }
        asm volatile("s_waitcnt vmcnt(0)" ::: "memory");
        if (lane == 0) __hip_atomic_fetch_add(cnt + 64 * u.pm, 1u, __ATOMIC_RELAXED, __HIP_MEMORY_SCOPE_AGENT);
        if (wid == 0) {
            bool dead = false; const unsigned long long t0 = __builtin_amdgcn_s_memrealtime(); const unsigned want = 8u * (unsigned)ntn;
            for (;;) {
#if defined(BROKEN_EXCHANGE_NO_WAIT)
                break;
#endif
                if ((unsigned)__builtin_amdgcn_readfirstlane(__hip_atomic_load(cnt + 64 * u.pm, __ATOMIC_RELAXED, __HIP_MEMORY_SCOPE_AGENT)) >= want) break;
                if (__builtin_amdgcn_s_memrealtime() - t0 > 2000000ull) {
                    if (lane == 0) { unsigned expect = 0u; __hip_atomic_compare_exchange_strong(tmo + 1, &expect, code | (unsigned)(u.pm & 0xff), __ATOMIC_RELAXED, __ATOMIC_RELAXED, __HIP_MEMORY_SCOPE_AGENT);
                                     __hip_atomic_store(tmo, 1u, __ATOMIC_RELAXED, __HIP_MEMORY_SCOPE_AGENT); }
                    dead = true; break; }
                __builtin_amdgcn_s_sleep(2);
            }
            __builtin_amdgcn_fence(__ATOMIC_ACQUIRE, "agent");
            if (lane == 0) flag[0] = dead ? 1u : 0u;
        }
        asm volatile("s_waitcnt vmcnt(0) lgkmcnt(0)" ::: "memory"); __builtin_amdgcn_s_barrier(); asm volatile("" ::: "memory");
        const bool bad = flag[0] != 0u;
        if (lane < 32) {
            const unsigned long long* slot = (const unsigned long long*)xbuf + (size_t)(u.pm * BM + row) * 4; float mt[4], m2[4]; float ms = 0.f;
#pragma unroll
            for (int t = 0; t < 4; ++t) { if (t < ntn) { const unsigned long long w = __hip_atomic_load(slot + t, __ATOMIC_RELAXED, __HIP_MEMORY_SCOPE_AGENT); mt[t] = __uint_as_float((unsigned)w); m2[t] = __uint_as_float((unsigned)(w >> 32)); } else { mt[t] = 0.f; m2[t] = 0.f; } ms += mt[t]; }
            const float mean = ms / (float)ntn; float q = 0.f;
#pragma unroll
            for (int t = 0; t < 4; ++t) if (t < ntn) { const float dm = mt[t] - mean; q += m2[t] + 256.0f * dm * dm; }
            S[row] = (f32x2v){mean, 1.0f / sqrtf(q / (256.0f * (float)ntn) + eps)};
        }
        asm volatile("s_waitcnt lgkmcnt(0)" ::: "memory"); __builtin_amdgcn_s_barrier(); asm volatile("" ::: "memory");
        return bad;
    }
};
struct EpiLnRes {
    static constexpr bool PERM = false, AFTER_DRAIN = true;
    const float* base; float* out; int ldc; const float* bias; PanelStats st; unsigned poison;
    __device__ __forceinline__ void fused(f32x4 (&acc)[2][2][4][2], const Unit& u, int wr, int wc, int fr, int fq, PG8_LAS unsigned char* lds, int wid, int lane) const {
        typedef float f32x2v __attribute__((ext_vector_type(2)));
        const PG8_LAS f32x2v* S = (const PG8_LAS f32x2v*)(lds + 8192);
        const int col0 = u.pn * BM + wc * 32 + 4 * fq;
#pragma unroll
        for (int bj = 0; bj < 2; ++bj)
#pragma unroll
            for (int n = 0; n < 2; ++n) { const f32x4 bv = bias ? *(const f32x4*)(bias + col0 + bj * HALF + n * 16) : (f32x4){0.f, 0.f, 0.f, 0.f};
#pragma unroll
                for (int ai = 0; ai < 2; ++ai)
#pragma unroll
                    for (int m = 0; m < 4; ++m) acc[ai][bj][m][n] += bv; }
        f32x4 pre[4][2][2];
#pragma unroll
        for (int m = 0; m < 4; ++m) { const size_t off = (size_t)(u.pm * BM + wr * 64 + m * 16 + fr) * ldc + col0;
#pragma unroll
            for (int bj = 0; bj < 2; ++bj)
#pragma unroll
                for (int n = 0; n < 2; ++n) pre[m][bj][n] = *(const f32x4*)(base + off + bj * HALF + n * 16); }
        const bool bad = st.run(acc, u, wr, wc, fr, fq, lds, wid, lane) || poison != 0u;
        const float qnan = __builtin_nanf("");
#pragma unroll
        for (int ai = 0; ai < 2; ++ai)
#pragma unroll
            for (int m = 0; m < 4; ++m) { const int r = ai * HALF + wr * 64 + m * 16 + fr; const f32x2v sr = S[r]; const size_t off = (size_t)(u.pm * BM + r) * ldc + col0;
#pragma unroll
                for (int bj = 0; bj < 2; ++bj)
#pragma unroll
                    for (int n = 0; n < 2; ++n) { const f32x4 bs = ai == 0 ? pre[m][bj][n] : *(const f32x4*)(base + off + bj * HALF + n * 16); f32x4 o = bs + (acc[ai][bj][m][n] - sr.x) * sr.y;
                        if (bad) o = (f32x4){qnan, qnan, qnan, qnan}; *(f32x4*)(out + off + bj * HALF + n * 16) = o; }
                if (m & 1) asm volatile("" ::: "memory"); }
    }
};
struct EpiLnResLn {
    static constexpr bool PERM = false, AFTER_DRAIN = true;
    const float* base; float* out; bf16_t* xn; int ldc; const float* bias; PanelStats st1, st2; unsigned poison;
    __device__ __forceinline__ void fused(f32x4 (&acc)[2][2][4][2], const Unit& u, int wr, int wc, int fr, int fq, PG8_LAS unsigned char* lds, int wid, int lane) const {
        typedef float f32x2v __attribute__((ext_vector_type(2))); typedef unsigned u32x2v __attribute__((ext_vector_type(2)));
        const PG8_LAS f32x2v* S = (const PG8_LAS f32x2v*)(lds + 8192);
        const int col0 = u.pn * BM + wc * 32 + 4 * fq;
#pragma unroll
        for (int bj = 0; bj < 2; ++bj)
#pragma unroll
            for (int n = 0; n < 2; ++n) { const f32x4 bv = bias ? *(const f32x4*)(bias + col0 + bj * HALF + n * 16) : (f32x4){0.f, 0.f, 0.f, 0.f};
#pragma unroll
                for (int ai = 0; ai < 2; ++ai)
#pragma unroll
                    for (int m = 0; m < 4; ++m) acc[ai][bj][m][n] += bv; }
        bool bad = st1.run(acc, u, wr, wc, fr, fq, lds, wid, lane) || poison != 0u;
        const float qnan = __builtin_nanf("");
#pragma unroll
        for (int ai = 0; ai < 2; ++ai)
#pragma unroll
            for (int m = 0; m < 4; ++m) { const int r = ai * HALF + wr * 64 + m * 16 + fr; const f32x2v sr = S[r]; const size_t off = (size_t)(u.pm * BM + r) * ldc + col0;
#pragma unroll
                for (int bj = 0; bj < 2; ++bj)
#pragma unroll
                    for (int n = 0; n < 2; ++n) { const f32x4 bs = *(const f32x4*)(base + off + bj * HALF + n * 16); acc[ai][bj][m][n] = bs + (acc[ai][bj][m][n] - sr.x) * sr.y; }
                asm volatile("" : "+v"(acc[ai][0][m][0]), "+v"(acc[ai][0][m][1]), "+v"(acc[ai][1][m][0]), "+v"(acc[ai][1][m][1]));
                if (m & 1) asm volatile("" ::: "memory"); }
        const bool bad1 = bad;
        bad = st2.run(acc, u, wr, wc, fr, fq, lds, wid, lane) || bad;
#pragma unroll
        for (int ai = 0; ai < 2; ++ai)
#pragma unroll
            for (int m = 0; m < 4; ++m) { const int r = ai * HALF + wr * 64 + m * 16 + fr; const f32x2v sr = S[r]; const size_t off = (size_t)(u.pm * BM + r) * ldc + col0;
#pragma unroll
                for (int bj = 0; bj < 2; ++bj)
#pragma unroll
                    for (int n = 0; n < 2; ++n) { const f32x4 x1 = acc[ai][bj][m][n]; *(f32x4*)(out + off + bj * HALF + n * 16) = bad1 ? (f32x4){qnan, qnan, qnan, qnan} : x1;
                        const f32x4 o = (x1 - sr.x) * sr.y; u32x2v w; w.x = cvt_pk_bf16(o[0], o[1]); w.y = cvt_pk_bf16(o[2], o[3]);
                        if (bad) { w.x = 0x7fc07fc0u; w.y = 0x7fc07fc0u; } *(u32x2v*)(xn + off + bj * HALF + n * 16) = w; }
                asm volatile("" ::: "memory"); }
    }
};

template <class Epi, class Sched, bool ALIGN_EPI = false, bool SP2 = false>
__device__ __forceinline__ void gemm_phase(PG8_LAS unsigned char* lds, const Gemm g, const Sched& S, const Epi& E) {
    const int tid = tidx(), wid = __builtin_amdgcn_readfirstlane(tid >> 6), lane = tid & 63, wr = wid >> 2, wc = wid & 3, fr = lane & 15, fq = lane >> 4;
    const int K = g.K, nt = K / BK;
    unsigned voffA[2], voffB[2];
#pragma unroll
    for (int i = 0; i < 2; ++i) { int R, C; stage_rc(tid * 16 + i * 8192, R, C); const int Rb = Epi::PERM ? ((R & ~31) + perm32(R & 31)) : R;
        voffA[i] = (unsigned)(R * K + C) * 2u; voffB[i] = (unsigned)(Rb * K + C) * 2u; }
    const size_t kstep = (size_t)(BK * 2);
    const size_t hstep = (size_t)HALF * K * 2;
    const size_t tstep = 2 * hstep;
    const unsigned ldsw = (unsigned)wid * 1024u;
    const int aoff = lds_byte(wr * 64 + fr, fq * 8), boff = lds_byte(wc * 32 + fr, fq * 8);
#define PG8_SA(b, h) (((b) * 2 + (h)) * HTB)
#define PG8_SB(b, h) ((4 + (b) * 2 + (h)) * HTB)
#define PG8_STAGE(bufoff, gbase, voff) do { _Pragma("unroll") for (int _i = 0; _i < 2; ++_i) \
        __builtin_amdgcn_global_load_lds((const unsigned*)((const char*)(gbase) + (voff)[_i]), (PG8_LAS unsigned*)(lds + (bufoff) + ldsw + _i * 8192), 16, 0, 0); } while (0)
#define PG8_LDA(dst, b, h) do { _Pragma("unroll") for (int m = 0; m < 4; ++m) _Pragma("unroll") for (int k = 0; k < 2; ++k) dst[m][k] = *(const PG8_LAS bf16x8*)(lds + PG8_SA(b, h) + aoff + m * 2048 + k * 1024); } while (0)
#define PG8_LDB(dst, b, h) do { _Pragma("unroll") for (int n = 0; n < 2; ++n) _Pragma("unroll") for (int k = 0; k < 2; ++k) dst[n][k] = *(const PG8_LAS bf16x8*)(lds + PG8_SB(b, h) + boff + n * 2048 + k * 1024); } while (0)
#define PG8_MMA(ai, bj, At, Bt) do { __builtin_amdgcn_s_setprio(1); _Pragma("unroll") for (int m = 0; m < 4; ++m) _Pragma("unroll") for (int n = 0; n < 2; ++n) _Pragma("unroll") for (int k = 0; k < 2; ++k) \
        acc[ai][bj][m][n] = __builtin_amdgcn_mfma_f32_16x16x32_bf16(Bt[n][k], At[m][k], acc[ai][bj][m][n], 0, 0, 0); __builtin_amdgcn_s_setprio(0); } while (0)
#define PG8_WAIT_V(n) asm volatile("s_waitcnt vmcnt(" #n ")" ::: "memory")
#define PG8_WAIT_L(n) asm volatile("s_waitcnt lgkmcnt(" #n ")" ::: "memory")
#define PG8_BAR __builtin_amdgcn_s_barrier()
#define PG8_SCHED __builtin_amdgcn_sched_barrier(0)
    Unit cur, nxt; int ui = 0;
    if (!S.next(0, cur)) return;
    f32x4 acc[2][2][4][2];
#pragma unroll
    for (int a = 0; a < 2; ++a)
#pragma unroll
        for (int b = 0; b < 2; ++b)
#pragma unroll
            for (int m = 0; m < 4; ++m)
#pragma unroll
                for (int n = 0; n < 2; ++n) acc[a][b][m][n] = (f32x4){0.f, 0.f, 0.f, 0.f};
    bf16x8 At[4][2], B0[2][2], B1[2][2];
    const char* cA = (const char*)g.A + (size_t)cur.pm * tstep; const char* cB = (const char*)g.Bt + (size_t)cur.pn * tstep;
    S.a_ready(cur);
    if constexpr (SP2) {
        PG8_STAGE(PG8_SB(0, 0), cB, voffB); PG8_STAGE(PG8_SB(0, 1), cB + hstep, voffB); PG8_STAGE(PG8_SA(0, 0), cA, voffA); PG8_STAGE(PG8_SA(0, 1), cA + hstep, voffA);
        if (wr == 1) PG8_BAR;
        PG8_WAIT_V(2); PG8_BAR;
        PG8_STAGE(PG8_SB(1, 0), cB + kstep, voffB); PG8_STAGE(PG8_SA(1, 0), cA + kstep, voffA); PG8_STAGE(PG8_SB(1, 1), cB + hstep + kstep, voffB);
        PG8_WAIT_V(6); PG8_BAR;
    } else {
        PG8_STAGE(PG8_SB(0, 0), cB, voffB); PG8_STAGE(PG8_SA(0, 0), cA, voffA); PG8_STAGE(PG8_SB(0, 1), cB + hstep, voffB); PG8_STAGE(PG8_SA(0, 1), cA + hstep, voffA);
        if (wr == 1) PG8_BAR;
        PG8_WAIT_V(4); PG8_BAR;
        PG8_STAGE(PG8_SB(1, 0), cB + kstep, voffB); PG8_STAGE(PG8_SA(1, 0), cA + kstep, voffA); PG8_STAGE(PG8_SB(1, 1), cB + hstep + kstep, voffB);
        PG8_WAIT_V(6); PG8_BAR;
    }
    for (;;) {
        const bool has_next = S.next(ui + 1, nxt);
        const char* nA = has_next ? (const char*)g.A + (size_t)nxt.pm * tstep : cA; const char* nB = has_next ? (const char*)g.Bt + (size_t)nxt.pn * tstep : cB;
        for (int t = 0; t < nt; t += 2) {
            const bool last = (t == nt - 2);
            const char* a1 = cA + (size_t)(t + 1) * kstep;
            const char* a2 = last ? nA : cA + (size_t)(t + 2) * kstep; const char* b2 = last ? nB : cB + (size_t)(t + 2) * kstep;
            const char* a3 = a2 + kstep; const char* b3 = b2 + kstep;
            if (last && has_next) S.a_ready(nxt);
            if constexpr (SP2) {
            PG8_LDB(B0, 0, 0); PG8_LDB(B1, 0, 1); PG8_SCHED; PG8_LDA(At, 0, 0); PG8_STAGE(PG8_SA(1, 1), a1 + hstep, voffA);
            PG8_WAIT_V(8); PG8_WAIT_L(0); PG8_BAR; PG8_MMA(0, 0, At, B0); PG8_MMA(0, 1, At, B1); PG8_BAR; PG8_SCHED;
            PG8_LDA(At, 0, 1); PG8_STAGE(PG8_SB(0, 0), b2, voffB); PG8_STAGE(PG8_SB(0, 1), b2 + hstep, voffB); PG8_STAGE(PG8_SA(0, 0), a2, voffA);
            PG8_WAIT_V(8); PG8_WAIT_L(0); PG8_BAR; PG8_MMA(1, 0, At, B0); PG8_MMA(1, 1, At, B1); PG8_BAR; PG8_SCHED;
            PG8_LDB(B0, 1, 0); PG8_LDB(B1, 1, 1); PG8_SCHED; PG8_LDA(At, 1, 0); PG8_STAGE(PG8_SA(0, 1), a2 + hstep, voffA);
            PG8_WAIT_V(8); PG8_WAIT_L(0); PG8_BAR; PG8_MMA(0, 0, At, B0); PG8_MMA(0, 1, At, B1); PG8_BAR; PG8_SCHED;
            PG8_LDA(At, 1, 1); PG8_STAGE(PG8_SB(1, 0), b3, voffB); PG8_STAGE(PG8_SB(1, 1), b3 + hstep, voffB); PG8_STAGE(PG8_SA(1, 0), a3, voffA);
            PG8_WAIT_V(8); PG8_WAIT_L(0); PG8_BAR; PG8_MMA(1, 0, At, B0); PG8_MMA(1, 1, At, B1); PG8_BAR; PG8_SCHED;
            } else {
            PG8_LDB(B0, 0, 0); PG8_SCHED; PG8_LDA(At, 0, 0); PG8_STAGE(PG8_SA(1, 1), a1 + hstep, voffA);
            PG8_WAIT_L(8); PG8_BAR; PG8_WAIT_L(0); PG8_MMA(0, 0, At, B0); PG8_BAR; PG8_SCHED;
            PG8_LDB(B1, 0, 1); PG8_STAGE(PG8_SB(0, 0), b2, voffB);
            PG8_BAR; PG8_WAIT_L(0); PG8_MMA(0, 1, At, B1); PG8_BAR;
            PG8_LDA(At, 0, 1); PG8_STAGE(PG8_SA(0, 0), a2, voffA);
            PG8_BAR; PG8_WAIT_L(0); PG8_MMA(1, 0, At, B0); PG8_BAR; PG8_SCHED;
            PG8_STAGE(PG8_SB(0, 1), b2 + hstep, voffB);
            PG8_WAIT_V(6); PG8_BAR; PG8_MMA(1, 1, At, B1); PG8_BAR;
            PG8_LDB(B0, 1, 0); PG8_SCHED; PG8_LDA(At, 1, 0); PG8_STAGE(PG8_SA(0, 1), a2 + hstep, voffA);
            PG8_WAIT_L(8); PG8_BAR; PG8_WAIT_L(0); PG8_MMA(0, 0, At, B0); PG8_BAR; PG8_SCHED;
            PG8_LDB(B1, 1, 1); PG8_STAGE(PG8_SB(1, 0), b3, voffB);
            PG8_BAR; PG8_WAIT_L(0); PG8_MMA(0, 1, At, B1); PG8_BAR;
            PG8_LDA(At, 1, 1); PG8_STAGE(PG8_SA(1, 0), a3, voffA);
            PG8_BAR; PG8_WAIT_L(0); PG8_MMA(1, 0, At, B0); PG8_BAR; PG8_SCHED;
            PG8_STAGE(PG8_SB(1, 1), b3 + hstep, voffB);
            PG8_WAIT_V(6); PG8_BAR; PG8_MMA(1, 1, At, B1); PG8_BAR;
            }
        }
        if constexpr (ALIGN_EPI) { if (wr == 0) PG8_BAR; }
        if constexpr (!Epi::AFTER_DRAIN) { E(acc, cur, wr, wc, fr, fq); S.done(cur); }
        if (!has_next) break;
#pragma unroll
        for (int a = 0; a < 2; ++a)
#pragma unroll
            for (int b = 0; b < 2; ++b)
#pragma unroll
                for (int m = 0; m < 4; ++m)
#pragma unroll
                    for (int n = 0; n < 2; ++n) acc[a][b][m][n] = (f32x4){0.f, 0.f, 0.f, 0.f};
        cur = nxt; cA = nA; cB = nB; ++ui;
        if constexpr (ALIGN_EPI) { if (wr == 1) PG8_BAR; }
    }
    PG8_WAIT_V(0);
    if constexpr (!ALIGN_EPI) { if (wr == 0) PG8_BAR; }
    PG8_BAR;
    if constexpr (Epi::AFTER_DRAIN) { E.fused(acc, cur, wr, wc, fr, fq, lds, wid, lane); S.done(cur); }
#undef PG8_SA
#undef PG8_SB
#undef PG8_STAGE
#undef PG8_LDA
#undef PG8_LDB
#undef PG8_MMA
#undef PG8_WAIT_V
#undef PG8_WAIT_L
#undef PG8_BAR
#undef PG8_SCHED
}
}

#define LAS __attribute__((address_space(3)))
typedef unsigned short bf16_t;
typedef short bf16x8 __attribute__((ext_vector_type(8)));
typedef short s16x4 __attribute__((ext_vector_type(4)));
typedef short v4i16_t __attribute__((ext_vector_type(4)));
typedef float f32x4 __attribute__((ext_vector_type(4)));
typedef float f32x16 __attribute__((ext_vector_type(16)));
typedef unsigned u32x4 __attribute__((ext_vector_type(4)));
typedef unsigned u32x2 __attribute__((ext_vector_type(2)));

constexpr int DM = 1024, NB = 8, SEQ = 8192, NMETA = 16, LSEQ = SEQ + NMETA, MREAL = NB * SEQ, MROW0 = MREAL, MPAD = MREAL + 256;
constexpr int FF = 2816, NPB = 3584, DPROJ = 5640;
constexpr int NCH = 65;
constexpr float ALPHA = 1.41421356237f;
constexpr float LOG2E = 1.4426950408889634f;
constexpr float QSCALE = 0.125f * LOG2E;
constexpr float NEGF = -1e30f;
constexpr float LN_EPS = 1e-5f;

constexpr size_t OW_GU1 = 0, OW_D1 = 5767168, OW_PB = 8650752, OW_GM = 12320768, OW_BM = 14417920, OW_BA = 14942208, OW_OUT = 15466496, OW_GU2 = 16515072, OW_D2 = 22282240, OW_LAYER = 25165824;
constexpr size_t MiB = 1u << 20;
constexpr size_t WS_W = 0;
constexpr size_t WS_HB = 96 * MiB;
constexpr size_t WS_HFM = 225 * MiB;
constexpr size_t WS_GATES = 226 * MiB;
constexpr size_t WS_SC = 229 * MiB;
constexpr size_t WS_NST = 230 * MiB;
constexpr size_t WS_CST = 232 * MiB;
constexpr size_t WS_MA = 298 * MiB;
constexpr size_t WS_BIG = 427 * MiB;
constexpr size_t WS_END = 877 * MiB;

struct Params {
    const float* in[28];
    float* out; unsigned char* ws;
};

__device__ __forceinline__ unsigned f2bf(float f) { unsigned u = __builtin_bit_cast(unsigned, f); return (u + 0x7fffu + ((u >> 16) & 1u)) >> 16; }
__device__ __forceinline__ unsigned pk2(float lo, float hi) { return f2bf(lo) | (f2bf(hi) << 16); }
__device__ __forceinline__ float bflo(unsigned w) { return __builtin_bit_cast(float, w << 16); }
__device__ __forceinline__ float bfhi(unsigned w) { return __builtin_bit_cast(float, w & 0xffff0000u); }
__device__ __forceinline__ float ex2(float x) { return __builtin_amdgcn_exp2f(x); }
__device__ __forceinline__ float sigm(float x) { return __builtin_amdgcn_rcpf(1.f + ex2(-x * LOG2E)); }
__device__ __forceinline__ float siluf(float x) { return x * sigm(x); }
__device__ __forceinline__ float wave_sum(float v) {
#pragma unroll
    for (int o = 1; o < 64; o <<= 1) v += __shfl_xor(v, o);
    return v;
}
__device__ __forceinline__ float wave_max(float v) {
#pragma unroll
    for (int o = 1; o < 64; o <<= 1) v = fmaxf(v, __shfl_xor(v, o));
    return v;
}
__device__ __forceinline__ size_t seqrow(int b, int pos) { return pos < NMETA ? (size_t)(MROW0 + pos) : (size_t)b * SEQ + (size_t)(pos - NMETA); }
__device__ __forceinline__ f32x16 mfma32(bf16x8 a, bf16x8 b, f32x16 c) { return __builtin_amdgcn_mfma_f32_32x32x16_bf16(a, b, c, 0, 0, 0); }
__device__ __forceinline__ s16x4 vtr(const LAS unsigned char* p) { return __builtin_bit_cast(s16x4, __builtin_amdgcn_ds_read_tr16_b64_v4i16((LAS v4i16_t*)p)); }
__device__ __forceinline__ bf16x8 cat8(s16x4 lo, s16x4 hi) { return (bf16x8){lo[0], lo[1], lo[2], lo[3], hi[0], hi[1], hi[2], hi[3]}; }

namespace pg8 {
struct EpiSwiglu {
    static constexpr bool PERM = true, AFTER_DRAIN = false;
    bf16_t* O; int ldc;
    __device__ __forceinline__ void operator()(const f32x4 (&acc)[2][2][4][2], const Unit& u, int wr, int wc, int fr, int fq) const {
        const int row0 = u.pm * BM + wr * 64 + fr, col0 = u.pn * 128 + wc * 32 + 8 * fq;
#pragma unroll
        for (int ai = 0; ai < 2; ++ai)
#pragma unroll
            for (int m = 0; m < 4; ++m) {
                bf16_t* rowp = O + (size_t)(row0 + ai * HALF + m * 16) * ldc + col0;
                const f32x4 g0 = acc[ai][0][m][0], g1 = acc[ai][0][m][1], u0 = acc[ai][1][m][0], u1 = acc[ai][1][m][1];
                u32x4 w;
                w.x = cvt_pk_bf16(siluf(g0[0]) * u0[0], siluf(g0[1]) * u0[1]); w.y = cvt_pk_bf16(siluf(g0[2]) * u0[2], siluf(g0[3]) * u0[3]);
                w.z = cvt_pk_bf16(siluf(g1[0]) * u1[0], siluf(g1[1]) * u1[1]); w.w = cvt_pk_bf16(siluf(g1[2]) * u1[2], siluf(g1[3]) * u1[3]);
                *(u32x4*)rowp = w;
            }
    }
};
struct EpiPlain {
    static constexpr bool PERM = true, AFTER_DRAIN = false;
    bf16_t* O; int ldc; int coff; int slo, shi; float scale;
    __device__ __forceinline__ void operator()(const f32x4 (&acc)[2][2][4][2], const Unit& u, int wr, int wc, int fr, int fq) const {
        const int row0 = u.pm * BM + wr * 64 + fr, col0 = coff + u.pn * BM + wc * 32 + 8 * fq;
        const float sc = (u.pn >= slo && u.pn < shi) ? scale : 1.f;
#pragma unroll
        for (int ai = 0; ai < 2; ++ai)
#pragma unroll
            for (int m = 0; m < 4; ++m) {
                bf16_t* rowp = O + (size_t)(row0 + ai * HALF + m * 16) * ldc + col0;
#pragma unroll
                for (int bj = 0; bj < 2; ++bj) {
                    const f32x4 v0 = acc[ai][bj][m][0] * sc, v1 = acc[ai][bj][m][1] * sc;
                    u32x4 w; w.x = cvt_pk_bf16(v0[0], v0[1]); w.y = cvt_pk_bf16(v0[2], v0[3]); w.z = cvt_pk_bf16(v1[0], v1[1]); w.w = cvt_pk_bf16(v1[2], v1[3]);
                    *(u32x4*)(rowp + bj * HALF) = w;
                }
            }
    }
};
struct EpiResid {
    static constexpr bool PERM = true, AFTER_DRAIN = false;
    float* HF; float s;
    __device__ __forceinline__ void operator()(const f32x4 (&acc)[2][2][4][2], const Unit& u, int wr, int wc, int fr, int fq) const {
        const int row0 = u.pm * BM + wr * 64 + fr, col0 = u.pn * BM + wc * 32 + 8 * fq;
#pragma unroll
        for (int ai = 0; ai < 2; ++ai)
#pragma unroll
            for (int m = 0; m < 4; ++m) {
                float* rowp = HF + (size_t)(row0 + ai * HALF + m * 16) * DM + col0;
#pragma unroll
                for (int bj = 0; bj < 2; ++bj) {
                    f32x4 a = *(const f32x4*)(rowp + bj * HALF), b = *(const f32x4*)(rowp + bj * HALF + 4);
                    a = a * ALPHA + acc[ai][bj][m][0] * s; b = b * ALPHA + acc[ai][bj][m][1] * s;
                    *(f32x4*)(rowp + bj * HALF) = a; *(f32x4*)(rowp + bj * HALF + 4) = b;
                }
            }
    }
};
struct EpiGate {
    static constexpr bool PERM = true, AFTER_DRAIN = false;
    bf16_t* U; const bf16_t* Y; const float* bg;
    __device__ __forceinline__ void operator()(const f32x4 (&acc)[2][2][4][2], const Unit& u, int wr, int wc, int fr, int fq) const {
        const int row0 = u.pm * BM + wr * 64 + fr, col0 = u.pn * 128 + wc * 32 + 8 * fq;
        const f32x4 bm0 = *(const f32x4*)(bg + col0), bm1 = *(const f32x4*)(bg + col0 + 4), ba0 = *(const f32x4*)(bg + DM + col0), ba1 = *(const f32x4*)(bg + DM + col0 + 4);
#pragma unroll
        for (int ai = 0; ai < 2; ++ai)
#pragma unroll
            for (int m = 0; m < 4; ++m) {
                const size_t row = (size_t)(row0 + ai * HALF + m * 16);
                const u32x4 ym = *(const u32x4*)(Y + row * 2048 + col0), ya = *(const u32x4*)(Y + row * 2048 + DM + col0);
                const f32x4 gm0 = acc[ai][0][m][0] + bm0, gm1 = acc[ai][0][m][1] + bm1, ga0 = acc[ai][1][m][0] + ba0, ga1 = acc[ai][1][m][1] + ba1;
                u32x4 w;
                w.x = cvt_pk_bf16(sigm(gm0[0]) * bflo(ym.x) + sigm(ga0[0]) * bflo(ya.x), sigm(gm0[1]) * bfhi(ym.x) + sigm(ga0[1]) * bfhi(ya.x));
                w.y = cvt_pk_bf16(sigm(gm0[2]) * bflo(ym.y) + sigm(ga0[2]) * bflo(ya.y), sigm(gm0[3]) * bfhi(ym.y) + sigm(ga0[3]) * bfhi(ya.y));
                w.z = cvt_pk_bf16(sigm(gm1[0]) * bflo(ym.z) + sigm(ga1[0]) * bflo(ya.z), sigm(gm1[1]) * bfhi(ym.z) + sigm(ga1[1]) * bfhi(ya.z));
                w.w = cvt_pk_bf16(sigm(gm1[2]) * bflo(ym.w) + sigm(ga1[2]) * bflo(ya.w), sigm(gm1[3]) * bfhi(ym.w) + sigm(ga1[3]) * bfhi(ya.w));
                *(u32x4*)(U + row * DM + col0) = w;
            }
    }
};
}

__device__ __forceinline__ f32x4 sg_tile(const bf16_t* A, int lda, const bf16_t* Bt, int K, int n0, int lane) {
    const bf16_t* ap = A + (size_t)(lane & 15) * lda + 8 * (lane >> 4);
    const bf16_t* bp = Bt + (size_t)(n0 + (lane & 15)) * K + 8 * (lane >> 4);
    f32x4 acc = {0.f, 0.f, 0.f, 0.f};
#pragma unroll 8
    for (int k = 0; k < K; k += 32) {
        const bf16x8 a = *(const bf16x8*)(ap + k), b = *(const bf16x8*)(bp + k);
        acc = __builtin_amdgcn_mfma_f32_16x16x32_bf16(a, b, acc, 0, 0, 0);
    }
    return acc;
}

__device__ __forceinline__ void tr_item(const float* Wsrc, int ldw, int K, bf16_t* dst, int kb, LAS float* scr, int lane) {
    const int k0 = 64 * kb;
#pragma unroll 8
    for (int i = 0; i < 32; ++i) { const int kk = 2 * i + (lane >> 5); scr[kk * 33 + (lane & 31)] = Wsrc[(size_t)(k0 + kk) * ldw + (lane & 31)]; }
    asm volatile("s_waitcnt lgkmcnt(0)" ::: "memory");
    const int c = lane & 7;
#pragma unroll
    for (int j = 0; j < 4; ++j) {
        const int n = (lane >> 3) + 8 * j; const LAS float* s = scr + (8 * c) * 33 + n;
        u32x4 o; o.x = pk2(s[0 * 33], s[1 * 33]); o.y = pk2(s[2 * 33], s[3 * 33]); o.z = pk2(s[4 * 33], s[5 * 33]); o.w = pk2(s[6 * 33], s[7 * 33]);
        *(u32x4*)(dst + (size_t)n * K + k0 + 8 * c) = o;
    }
    asm volatile("s_waitcnt lgkmcnt(0)" ::: "memory");
}
__device__ __forceinline__ void conv_weight_item(const Params& P, int layer, int it, LAS float* scr, int lane) {
    bf16_t* W = (bf16_t*)(P.ws + WS_W) + (size_t)layer * OW_LAYER;
    const float* wg1 = P.in[2] + (size_t)layer * DM * FF; const float* wu1 = P.in[3] + (size_t)layer * DM * FF; const float* wd1 = P.in[4] + (size_t)layer * FF * DM;
    const float* win = P.in[7] + (size_t)layer * DM * DPROJ;
    const float* wbm = P.in[17] + (size_t)layer * 512 * DM; const float* wba = P.in[18] + (size_t)layer * 512 * DM; const float* wout = P.in[20] + (size_t)layer * DM * DM;
    const float* wg2 = P.in[23] + (size_t)layer * DM * FF; const float* wu2 = P.in[24] + (size_t)layer * DM * FF; const float* wd2 = P.in[25] + (size_t)layer * FF * DM;
    int r = it;
    if (r < 2816 * 2) {
        const int second = r >= 2816; if (second) r -= 2816;
        const int kb = r / 176, nb = r % 176, R0 = 32 * nb, pn = R0 >> 8, s = (R0 >> 7) & 1, i = R0 & 127;
        const float* src = (second ? (s ? wu2 : wg2) : (s ? wu1 : wg1)) + 128 * pn + i;
        tr_item(src, FF, DM, W + (second ? OW_GU2 : OW_GU1) + (size_t)R0 * DM, kb, scr, lane); return;
    }
    r -= 5632;
    if (r < 1408 * 2) {
        const int second = r >= 1408; if (second) r -= 1408;
        const int kb = r / 32, nb = r % 32, R0 = 32 * nb;
        tr_item((second ? wd2 : wd1) + R0, DM, FF, W + (second ? OW_D2 : OW_D1) + (size_t)R0 * FF, kb, scr, lane); return;
    }
    r -= 2816;
    if (r < 1792) {
        const int kb = r / 112, nb = r % 112, R0 = 32 * nb, c = R0 < 2048 ? R0 : R0 + 8;
        tr_item(win + c, DPROJ, DM, W + OW_PB + (size_t)R0 * DM, kb, scr, lane); return;
    }
    r -= 1792;
    if (r < 1024) {
        const int kb = r / 64, nb = r % 64, R0 = 32 * nb, pn = R0 >> 8, s = (R0 >> 7) & 1, i = R0 & 127, c = 3592 + 1024 * s + 128 * pn + i;
        tr_item(win + c, DPROJ, DM, W + OW_GM + (size_t)R0 * DM, kb, scr, lane); return;
    }
    r -= 1024;
    if (r < 512) {
        const int second = r >= 256; if (second) r -= 256;
        const int kb = r / 32, nb = r % 32, R0 = 32 * nb;
        tr_item((second ? wba : wbm) + R0, DM, 512, W + (second ? OW_BA : OW_BM) + (size_t)R0 * 512, kb, scr, lane); return;
    }
    r -= 512;
    { const int kb = r / 32, nb = r % 32, R0 = 32 * nb; tr_item(wout + R0, DM, DM, W + OW_OUT + (size_t)R0 * DM, kb, scr, lane); }
}

__device__ __forceinline__ void ln_phase(const Params& P, const float* gam, const float* bet, bool gates, const float* win_l, const float* bif_l, LAS unsigned char* lds) {
    const int tid = tidx(), lane = tid & 63, wid = tid >> 6;
    float* hfm = (float*)(P.ws + WS_HFM); bf16_t* HB = (bf16_t*)(P.ws + WS_HB); float* GT = (float*)(P.ws + WS_GATES);
    LAS float* gwl = (LAS float*)lds;
    if (gates) {
        for (int idx = tid; idx < 8192; idx += 512) { const int k = idx >> 3, g = idx & 7; gwl[g * 1024 + k] = win_l[(size_t)k * DPROJ + 2048 + g]; }
        __syncthreads();
    }
    const int gw = bidx() * 8 + wid, NGW = gridDim.x * 8;
    for (int row = gw; row < MREAL + NMETA; row += NGW) {
        float* hf = row < MREAL ? P.out + (size_t)row * DM : hfm + (size_t)(row - MREAL) * DM;
        f32x4 v[4]; float s = 0.f;
#pragma unroll
        for (int j = 0; j < 4; ++j) { v[j] = *(const f32x4*)(hf + 256 * j + 4 * lane); s += (v[j][0] + v[j][1]) + (v[j][2] + v[j][3]); }
        const float mean = wave_sum(s) * (1.f / DM); float s2 = 0.f;
#pragma unroll
        for (int j = 0; j < 4; ++j) { v[j] = v[j] - mean; s2 += (v[j][0] * v[j][0] + v[j][1] * v[j][1]) + (v[j][2] * v[j][2] + v[j][3] * v[j][3]); }
        const float rstd = 1.f / sqrtf(wave_sum(s2) * (1.f / DM) + LN_EPS);
#pragma unroll
        for (int j = 0; j < 4; ++j) {
            const f32x4 g4 = *(const f32x4*)(gam + 256 * j + 4 * lane), b4 = *(const f32x4*)(bet + 256 * j + 4 * lane);
            v[j] = v[j] * rstd * g4 + b4;
            *(f32x4*)(hf + 256 * j + 4 * lane) = v[j];
            u32x2 w; w.x = pk2(v[j][0], v[j][1]); w.y = pk2(v[j][2], v[j][3]);
            *(u32x2*)(HB + (size_t)row * DM + 256 * j + 4 * lane) = w;
        }
        if (gates) {
            float mine = 0.f;
#pragma unroll
            for (int g = 0; g < 8; ++g) {
                float d = 0.f;
#pragma unroll
                for (int j = 0; j < 4; ++j) { const f32x4 w4 = *(const LAS f32x4*)(gwl + g * 1024 + 256 * j + 4 * lane); d += (v[j][0] * w4[0] + v[j][1] * w4[1]) + (v[j][2] * w4[2] + v[j][3] * w4[3]); }
                d = wave_sum(d);
                if (lane == g) mine = d;
            }
            if (lane < 8) {
                const float z = mine + bif_l[lane];
                float o = z;
                if (lane >= 4) o = fminf(z, 0.f) - log1pf(expf(-fabsf(z)));
                GT[(size_t)row * 8 + lane] = o;
            }
        }
    }
}

__device__ __forceinline__ void conv8(const bf16_t* PB, const float* cw, const float* cb, int b, int pos, int chn, f32x4& o0, f32x4& o1) {
    o0 = *(const f32x4*)(cb + chn); o1 = *(const f32x4*)(cb + chn + 4);
#pragma unroll
    for (int j = 0; j < 4; ++j) {
        const int pp = pos - 3 + j;
        if (pp >= 0) {
            const u32x4 u = *(const u32x4*)(PB + seqrow(b, pp) * NPB + chn);
            const f32x4 w0 = *(const f32x4*)(cw + j * 1024 + chn), w1 = *(const f32x4*)(cw + j * 1024 + chn + 4);
            o0[0] += w0[0] * bflo(u.x); o0[1] += w0[1] * bfhi(u.x); o0[2] += w0[2] * bflo(u.y); o0[3] += w0[3] * bfhi(u.y);
            o1[0] += w1[0] * bflo(u.z); o1[1] += w1[1] * bfhi(u.z); o1[2] += w1[2] * bflo(u.w); o1[3] += w1[3] * bfhi(u.w);
        }
    }
#pragma unroll
    for (int e = 0; e < 4; ++e) { o0[e] = siluf(o0[e]); o1[e] = siluf(o1[e]); }
}
__device__ __forceinline__ u32x4 pack8(f32x4 a, f32x4 b) { u32x4 w; w.x = pk2(a[0], a[1]); w.y = pk2(a[2], a[3]); w.z = pk2(b[0], b[1]); w.w = pk2(b[2], b[3]); return w; }

__device__ __forceinline__ float wscan_add(float v, int lane) {
#pragma unroll
    for (int o = 1; o < 64; o <<= 1) { const float t = __shfl_up(v, o); if (lane >= o) v += t; }
    return v;
}
__device__ __forceinline__ float wscan_max(float v, int lane) {
#pragma unroll
    for (int o = 1; o < 64; o <<= 1) { const float t = __shfl_up(v, o); if (lane >= o) v = fmaxf(v, t); }
    return v;
}

constexpr int TSTR = 320;
constexpr int RSTR = 272;
__device__ __forceinline__ void m1_unit(const Params& P, int layer, int bh, int c, LAS unsigned char* lds) {
    const int tid = tidx(), lane = tid & 63, wid = __builtin_amdgcn_readfirstlane(tid >> 6);
    const int b = bh >> 2, hh = bh & 3;
    const int nvalid = c == 0 ? NMETA : 128, p0 = c == 0 ? 0 : NMETA + 128 * (c - 1);
    const bf16_t* PB = (const bf16_t*)(P.ws + WS_BIG); const float* GT = (const float*)(P.ws + WS_GATES);
    float* SC = (float*)(P.ws + WS_SC); float* NST = (float*)(P.ws + WS_NST); bf16_t* CST = (bf16_t*)(P.ws + WS_CST);
    const float* cw = P.in[8] + (size_t)layer * 4 * 1024; const float* cb = P.in[9] + (size_t)layer * 1024;
    LAS unsigned char* Kt = lds; LAS unsigned char* Vt = lds + 128 * TSTR; LAS float* sws = (LAS float*)(lds + 2 * 128 * TSTR);
    if (wid == 0) {
        const int i0 = 2 * lane, i1 = i0 + 1;
        float li0 = NEGF, li1 = NEGF, lf0 = 0.f, lf1 = 0.f;
        if (i0 < nvalid) { const size_t rw = seqrow(b, p0 + i0); li0 = GT[rw * 8 + hh]; lf0 = GT[rw * 8 + 4 + hh]; }
        if (i1 < nvalid) { const size_t rw = seqrow(b, p0 + i1); li1 = GT[rw * 8 + hh]; lf1 = GT[rw * 8 + 4 + hh]; }
        const float s = lf0 + lf1, incl = wscan_add(s, lane), excl = incl - s;
        const float b0 = excl + lf0, b1 = incl, g0 = li0 - b0, g1 = li1 - b1;
        const float gmax = wave_max(fmaxf(g0, g1));
        sws[i0] = i0 < nvalid ? ex2((g0 - gmax) * LOG2E) : 0.f;
        sws[i1] = i1 < nvalid ? ex2((g1 - gmax) * LOG2E) : 0.f;
        const float bend = __shfl(incl, 63);
        if (lane == 0) { SC[(size_t)(bh * NCH + c) * 2] = bend; SC[(size_t)(bh * NCH + c) * 2 + 1] = bend + gmax; }
    }
    __syncthreads();
#pragma unroll 1
    for (int it = 0; it < 4; ++it) {
        const int item = tid + 512 * it, i = item >> 4, ch = item & 15;
        u32x4 kw = {0u, 0u, 0u, 0u}, vw = {0u, 0u, 0u, 0u};
        if (i < nvalid) {
            f32x4 o0, o1; conv8(PB, cw, cb, b, p0 + i, 512 + hh * 128 + 8 * ch, o0, o1);
            const float sc = 0.08838834764831845f * sws[i];
            kw = pack8(o0 * sc, o1 * sc);
            vw = *(const u32x4*)(PB + seqrow(b, p0 + i) * NPB + 1024 + hh * 128 + 8 * ch);
        }
        *(LAS u32x4*)(Kt + i * TSTR + ch * 16) = kw; *(LAS u32x4*)(Vt + i * TSTR + ch * 16) = vw;
    }
    __syncthreads();
    {
        const int h = lane >> 5, g = lane >> 4, q = (lane & 15) >> 2, pp = lane & 3;
        const int dkt = wid >> 1, dvt0 = (wid & 1) * 2;
        f32x16 acc[2];
#pragma unroll
        for (int t = 0; t < 2; ++t)
#pragma unroll
            for (int e = 0; e < 16; ++e) acc[t][e] = 0.f;
#pragma unroll
        for (int ks = 0; ks < 8; ++ks) {
            const int rowa = 16 * ks + 8 * h + q;
            const LAS unsigned char* ka = Kt + rowa * TSTR + (32 * dkt + 16 * (g & 1) + 4 * pp) * 2;
            const bf16x8 af = cat8(vtr(ka), vtr(ka + 4 * TSTR));
#pragma unroll
            for (int t = 0; t < 2; ++t) {
                const LAS unsigned char* va = Vt + rowa * TSTR + (32 * (dvt0 + t) + 16 * (g & 1) + 4 * pp) * 2;
                const bf16x8 bf = cat8(vtr(va), vtr(va + 4 * TSTR));
                acc[t] = mfma32(af, bf, acc[t]);
            }
        }
        bf16_t* cdst = CST + (size_t)(bh * NCH + c) * 16384;
#pragma unroll
        for (int t = 0; t < 2; ++t) {
            const int dv = 32 * (dvt0 + t) + (lane & 31);
#pragma unroll
            for (int r4 = 0; r4 < 4; ++r4) {
                const int dk0 = 32 * dkt + 8 * r4 + 4 * h;
                u32x2 w; w.x = pk2(acc[t][4 * r4], acc[t][4 * r4 + 1]); w.y = pk2(acc[t][4 * r4 + 2], acc[t][4 * r4 + 3]);
                *(u32x2*)(cdst + (size_t)dv * 128 + dk0) = w;
            }
        }
    }
    if (tid < 128) {
        float s = 0.f;
        for (int i = 0; i < 128; ++i) s += __builtin_bit_cast(float, (unsigned)(*(const LAS unsigned short*)(Kt + i * TSTR + tid * 2)) << 16);
        NST[(size_t)(bh * NCH + c) * 128 + tid] = s;
    }
    __syncthreads();
}

__device__ __forceinline__ void m2_phase(const Params& P) {
    float* SC = (float*)(P.ws + WS_SC); float* MST = SC + 32 * NCH * 2; float* NST = (float*)(P.ws + WS_NST); bf16_t* CST = (bf16_t*)(P.ws + WS_CST);
    const int NT = gridDim.x * 512;
    for (int task = bidx() * 512 + tidx(); task < 65536 + 4096; task += NT) {
        if (task < 65536) {
            const int bh = task >> 11, e8 = task & 2047;
            bf16_t* ptr = CST + (size_t)bh * NCH * 16384 + (size_t)e8 * 8;
            float run[8];
#pragma unroll
            for (int e = 0; e < 8; ++e) run[e] = 0.f;
            float m = NEGF;
#pragma unroll 1
            for (int c0 = 0; c0 < NCH; c0 += 5) {
                u32x4 loc[5];
#pragma unroll
                for (int j = 0; j < 5; ++j) loc[j] = *(const u32x4*)(ptr + (size_t)(c0 + j) * 16384);
#pragma unroll
                for (int j = 0; j < 5; ++j) {
                    const int c = c0 + j;
                    const float bend = SC[(size_t)(bh * NCH + c) * 2], mloc = SC[(size_t)(bh * NCH + c) * 2 + 1];
                    const float mn = fmaxf(bend + m, mloc), a = ex2((bend + m - mn) * LOG2E), bt = ex2((mloc - mn) * LOG2E);
                    u32x4 w; w.x = pk2(run[0], run[1]); w.y = pk2(run[2], run[3]); w.z = pk2(run[4], run[5]); w.w = pk2(run[6], run[7]);
                    *(u32x4*)(ptr + (size_t)c * 16384) = w;
                    run[0] = a * run[0] + bt * bflo(loc[j].x); run[1] = a * run[1] + bt * bfhi(loc[j].x);
                    run[2] = a * run[2] + bt * bflo(loc[j].y); run[3] = a * run[3] + bt * bfhi(loc[j].y);
                    run[4] = a * run[4] + bt * bflo(loc[j].z); run[5] = a * run[5] + bt * bfhi(loc[j].z);
                    run[6] = a * run[6] + bt * bflo(loc[j].w); run[7] = a * run[7] + bt * bfhi(loc[j].w);
                    if (e8 == 0) MST[bh * NCH + c] = m;
                    m = mn;
                }
            }
        } else {
            const int t2 = task - 65536, bh = t2 >> 7, dk = t2 & 127;
            float* ptr = NST + (size_t)bh * NCH * 128 + dk;
            float run = 0.f, m = NEGF;
#pragma unroll 1
            for (int c = 0; c < NCH; ++c) {
                const float bend = SC[(size_t)(bh * NCH + c) * 2], mloc = SC[(size_t)(bh * NCH + c) * 2 + 1];
                const float mn = fmaxf(bend + m, mloc), a = ex2((bend + m - mn) * LOG2E), bt = ex2((mloc - mn) * LOG2E);
                const float loc = ptr[(size_t)c * 128]; ptr[(size_t)c * 128] = run; run = a * run + bt * loc; m = mn;
            }
        }
    }
}

__device__ __forceinline__ void m3_unit(const Params& P, int layer, int bh, int c, LAS unsigned char* lds) {
    const int tid = tidx(), lane = tid & 63, wid = __builtin_amdgcn_readfirstlane(tid >> 6);
    const int b = bh >> 2, hh = bh & 3;
    const int nvalid = c == 0 ? NMETA : 128, p0 = c == 0 ? 0 : NMETA + 128 * (c - 1);
    const bf16_t* PB = (const bf16_t*)(P.ws + WS_BIG); const float* GT = (const float*)(P.ws + WS_GATES);
    const float* SC = (const float*)(P.ws + WS_SC); const float* MST = SC + 32 * NCH * 2; const float* NST = (const float*)(P.ws + WS_NST); const bf16_t* CST = (const bf16_t*)(P.ws + WS_CST);
    bf16_t* MA = (bf16_t*)(P.ws + WS_MA);
    const float* cw = P.in[8] + (size_t)layer * 4 * 1024; const float* cb = P.in[9] + (size_t)layer * 1024; const float* mng = P.in[11] + (size_t)layer * 512;
    LAS unsigned char* Qt = lds; LAS unsigned char* Kt = lds + 128 * RSTR; LAS unsigned char* Vt = lds + 2 * 128 * RSTR;
    LAS float* sg2 = (LAS float*)(lds + 2 * 128 * RSTR + 128 * TSTR); LAS float* sr2 = sg2 + 128; LAS float* sw = sg2 + 256; LAS float* semt = sg2 + 384; LAS float* sqn = sg2 + 512;
    LAS float* sst = sg2 + 640; LAS float* sst2 = sg2 + 896;
    if (wid == 0) {
        const int i0 = 2 * lane, i1 = i0 + 1;
        float li0 = NEGF, li1 = NEGF, lf0 = 0.f, lf1 = 0.f;
        if (i0 < nvalid) { const size_t rw = seqrow(b, p0 + i0); li0 = GT[rw * 8 + hh]; lf0 = GT[rw * 8 + 4 + hh]; }
        if (i1 < nvalid) { const size_t rw = seqrow(b, p0 + i1); li1 = GT[rw * 8 + hh]; lf1 = GT[rw * 8 + 4 + hh]; }
        const float s = lf0 + lf1, incl = wscan_add(s, lane), excl = incl - s;
        const float b0 = excl + lf0, b1 = incl, g0 = li0 - b0, g1 = li1 - b1;
        const float inclm = wscan_max(fmaxf(g0, g1), lane);
        float exclm = __shfl_up(inclm, 1); if (lane == 0) exclm = NEGF;
        const float cm0 = fmaxf(exclm, g0), cm1 = inclm;
        const float mprev = MST[bh * NCH + c];
        const float M0 = fmaxf(mprev, cm0), M1 = fmaxf(mprev, cm1);
        sg2[i0] = g0 * LOG2E; sg2[i1] = g1 * LOG2E; sr2[i0] = -M0 * LOG2E; sr2[i1] = -M1 * LOG2E;
        sw[i0] = ex2((mprev - M0) * LOG2E); sw[i1] = ex2((mprev - M1) * LOG2E);
        semt[i0] = ex2(-(b0 + M0) * LOG2E); semt[i1] = ex2(-(b1 + M1) * LOG2E);
    }
#pragma unroll 1
    for (int it = 0; it < 4; ++it) {
        const int item = tid + 512 * it, i = item >> 4, ch = item & 15;
        u32x4 qw = {0u, 0u, 0u, 0u}, kw = {0u, 0u, 0u, 0u}, vw = {0u, 0u, 0u, 0u};
        if (i < nvalid) {
            f32x4 o0, o1;
            conv8(PB, cw, cb, b, p0 + i, hh * 128 + 8 * ch, o0, o1); qw = pack8(o0, o1);
            conv8(PB, cw, cb, b, p0 + i, 512 + hh * 128 + 8 * ch, o0, o1); kw = pack8(o0 * 0.08838834764831845f, o1 * 0.08838834764831845f);
            vw = *(const u32x4*)(PB + seqrow(b, p0 + i) * NPB + 1024 + hh * 128 + 8 * ch);
        }
        *(LAS u32x4*)(Qt + i * RSTR + ch * 16) = qw; *(LAS u32x4*)(Kt + i * RSTR + ch * 16) = kw; *(LAS u32x4*)(Vt + i * TSTR + ch * 16) = vw;
    }
    __syncthreads();
    {
        const int i = tid >> 2, part = tid & 3;
        const float* np = NST + (size_t)(bh * NCH + c) * 128 + 32 * part;
        float s = 0.f;
#pragma unroll
        for (int d8 = 0; d8 < 4; ++d8) {
            const u32x4 qv = *(const LAS u32x4*)(Qt + i * RSTR + (32 * part + 8 * d8) * 2);
            const f32x4 n0 = *(const f32x4*)(np + 8 * d8), n1 = *(const f32x4*)(np + 8 * d8 + 4);
            s += bflo(qv.x) * n0[0] + bfhi(qv.x) * n0[1] + bflo(qv.y) * n0[2] + bfhi(qv.y) * n0[3] + bflo(qv.z) * n1[0] + bfhi(qv.z) * n1[1] + bflo(qv.w) * n1[2] + bfhi(qv.w) * n1[3];
        }
        s += __shfl_xor(s, 1); s += __shfl_xor(s, 2);
        if (part == 0) sqn[i] = s;
    }
    const int r = lane & 31, h = lane >> 5, g = lane >> 4, q = (lane & 15) >> 2, pp = lane & 3;
    const int qb = wid >> 1, dvh = wid & 1, t = 32 * qb + r;
    bf16x8 qf[8];
#pragma unroll
    for (int ks = 0; ks < 8; ++ks) qf[ks] = *(const LAS bf16x8*)(Qt + t * RSTR + (16 * ks + 8 * h) * 2);
    f32x16 acc[2];
#pragma unroll
    for (int d = 0; d < 2; ++d)
#pragma unroll
        for (int e = 0; e < 16; ++e) acc[d][e] = 0.f;
    {
        const bf16_t* Cp = CST + (size_t)(bh * NCH + c) * 16384;
#pragma unroll
        for (int ks = 0; ks < 8; ++ks)
#pragma unroll
            for (int d = 0; d < 2; ++d) {
                const int dv = 32 * (2 * dvh + d) + r;
                const bf16x8 cf = *(const bf16x8*)(Cp + (size_t)dv * 128 + 16 * ks + 8 * h);
                acc[d] = mfma32(cf, qf[ks], acc[d]);
            }
    }
    __syncthreads();
    const float wt = sw[t], r2 = sr2[t];
#pragma unroll
    for (int d = 0; d < 2; ++d) acc[d] = acc[d] * wt;
    float den = 0.f;
#pragma unroll 1
    for (int kb = 0; kb <= qb; ++kb) {
        f32x16 st;
#pragma unroll
        for (int e = 0; e < 16; ++e) st[e] = 0.f;
#pragma unroll
        for (int ks = 0; ks < 8; ++ks) { const bf16x8 kf = *(const LAS bf16x8*)(Kt + (32 * kb + r) * RSTR + (16 * ks + 8 * h) * 2); st = mfma32(kf, qf[ks], st); }
#pragma unroll
        for (int r4 = 0; r4 < 4; ++r4) {
            const int s0 = 32 * kb + 8 * r4 + 4 * h;
            const f32x4 gs = *(const LAS f32x4*)(sg2 + s0);
#pragma unroll
            for (int e = 0; e < 4; ++e) {
                float v = st[4 * r4 + e] * ex2(r2 + gs[e]);
                if (s0 + e > t) v = 0.f;
                den += v; st[4 * r4 + e] = v;
            }
        }
#pragma unroll
        for (int s2 = 0; s2 < 2; ++s2) {
            u32x4 pw; pw.x = pk2(st[8 * s2], st[8 * s2 + 1]); pw.y = pk2(st[8 * s2 + 2], st[8 * s2 + 3]); pw.z = pk2(st[8 * s2 + 4], st[8 * s2 + 5]); pw.w = pk2(st[8 * s2 + 6], st[8 * s2 + 7]);
            const bf16x8 pf = __builtin_bit_cast(bf16x8, pw);
#pragma unroll
            for (int d = 0; d < 2; ++d) {
                const LAS unsigned char* va = Vt + (32 * kb + 16 * s2 + 4 * h + q) * TSTR + (32 * (2 * dvh + d) + 16 * (g & 1) + 4 * pp) * 2;
                const bf16x8 vf = cat8(vtr(va), vtr(va + 8 * TSTR));
                acc[d] = mfma32(vf, pf, acc[d]);
            }
        }
    }
    den += __shfl_xor(den, 32);
    den += wt * sqn[t];
    const float inv = 1.f / fmaxf(fabsf(den), semt[t]);
    float s1 = 0.f;
#pragma unroll
    for (int d = 0; d < 2; ++d)
#pragma unroll
        for (int e = 0; e < 16; ++e) { acc[d][e] *= inv; s1 += acc[d][e]; }
    s1 += __shfl_xor(s1, 32);
    if (h == 0) sst[wid * 32 + r] = s1;
    __syncthreads();
    const float mean = (s1 + sst[(wid ^ 1) * 32 + r]) * (1.f / 128.f);
    float q2 = 0.f;
#pragma unroll
    for (int d = 0; d < 2; ++d)
#pragma unroll
        for (int e = 0; e < 16; ++e) { acc[d][e] -= mean; q2 += acc[d][e] * acc[d][e]; }
    q2 += __shfl_xor(q2, 32);
    if (h == 0) sst2[wid * 32 + r] = q2;
    __syncthreads();
    const float rstd = 1.f / sqrtf((q2 + sst2[(wid ^ 1) * 32 + r]) * (1.f / 128.f) + LN_EPS);
    if (t < nvalid) {
        const size_t row = seqrow(b, p0 + t);
#pragma unroll
        for (int d = 0; d < 2; ++d)
#pragma unroll
            for (int r4 = 0; r4 < 4; ++r4) {
                const int col = hh * 128 + 32 * (2 * dvh + d) + 8 * r4 + 4 * h;
                const u32x2 mo = *(const u32x2*)(PB + row * NPB + 1536 + col);
                const f32x4 g4 = *(const f32x4*)(mng + col);
                const float o0 = acc[d][4 * r4] * rstd * g4[0] * sigm(bflo(mo.x)), o1 = acc[d][4 * r4 + 1] * rstd * g4[1] * sigm(bfhi(mo.x));
                const float o2 = acc[d][4 * r4 + 2] * rstd * g4[2] * sigm(bflo(mo.y)), o3 = acc[d][4 * r4 + 3] * rstd * g4[3] * sigm(bfhi(mo.y));
                u32x2 w; w.x = pk2(o0, o1); w.y = pk2(o2, o3);
                *(u32x2*)(MA + row * 512 + col) = w;
            }
    }
    __syncthreads();
}

constexpr int AT_KB = 64 * RSTR, AT_VB = 64 * TSTR, AT_BUF = AT_KB + AT_VB;
__device__ __forceinline__ void attn_unit(const Params& P, int layer, int b, int hd, int pq0, int nvalid, float lam, float lam_init, LAS unsigned char* lds) {
    const int tid = tidx(), lane = tid & 63, wid = __builtin_amdgcn_readfirstlane(tid >> 6);
    const int c = wid >> 2, wq = wid & 3, r = lane & 31, h = lane >> 5, g = lane >> 4, q = (lane & 15) >> 2, pp = lane & 3;
    const bf16_t* PB = (const bf16_t*)(P.ws + WS_BIG); bf16_t* AO = (bf16_t*)(P.ws + WS_MA) + (size_t)MPAD * 512;
    const float* ang = P.in[16] + (size_t)layer * 512;
    const int qi = 32 * wq + r, qp = pq0 + qi;
    bf16x8 qf[4];
    {
        const size_t qrow = seqrow(b, qp < LSEQ ? qp : LSEQ - 1);
#pragma unroll
        for (int ks = 0; ks < 4; ++ks) qf[ks] = *(const bf16x8*)(PB + qrow * NPB + 2048 + hd * 128 + c * 64 + 16 * ks + 8 * h);
    }
    const float slope2 = ex2(-2.f * (float)(hd + 1)) * LOG2E;
    const int ntiles = (pq0 + nvalid - 1) / 64 + 1;
    u32x4 pk[2], pv[2];
#define AT_LOAD(kt) do { _Pragma("unroll") for (int i_ = 0; i_ < 2; ++i_) { const int row_ = (tid + 512 * i_) >> 4, ch_ = tid & 15; int kp_ = 64 * (kt) + row_; kp_ = kp_ < LSEQ ? kp_ : LSEQ - 1; \
        const bf16_t* src_ = PB + seqrow(b, kp_) * NPB + hd * 128 + ch_ * 8; pk[i_] = *(const u32x4*)(src_ + 2560); pv[i_] = *(const u32x4*)(src_ + 3072); } } while (0)
#define AT_STORE(s) do { _Pragma("unroll") for (int i_ = 0; i_ < 2; ++i_) { const int row_ = (tid + 512 * i_) >> 4, ch_ = tid & 15; \
        *(LAS u32x4*)(lds + (s) * AT_BUF + row_ * RSTR + ch_ * 16) = pk[i_]; *(LAS u32x4*)(lds + (s) * AT_BUF + AT_KB + row_ * TSTR + ch_ * 16) = pv[i_]; } } while (0)
    AT_LOAD(0); AT_STORE(0);
    __syncthreads();
    float m_run = NEGF, l_run = 0.f;
    f32x16 o[4];
#pragma unroll
    for (int d = 0; d < 4; ++d)
#pragma unroll
        for (int e = 0; e < 16; ++e) o[d][e] = 0.f;
#pragma unroll 1
    for (int kt = 0; kt < ntiles; ++kt) {
        const int s = kt & 1;
        if (kt + 1 < ntiles) AT_LOAD(kt + 1);
        const LAS unsigned char* Kb = lds + s * AT_BUF; const LAS unsigned char* Vb = Kb + AT_KB;
        f32x16 st[2];
#pragma unroll
        for (int kb2 = 0; kb2 < 2; ++kb2) {
            const float tb = slope2 * (float)(64 * kt + 32 * kb2 - pq0 + 4 * h);
#pragma unroll
            for (int e = 0; e < 16; ++e) st[kb2][e] = tb + slope2 * (float)((e & 3) + 8 * (e >> 2));
#pragma unroll
            for (int ks = 0; ks < 4; ++ks) { const bf16x8 kf = *(const LAS bf16x8*)(Kb + (32 * kb2 + r) * RSTR + (c * 64 + 16 * ks + 8 * h) * 2); st[kb2] = mfma32(kf, qf[ks], st[kb2]); }
        }
        if (64 * kt + 63 > pq0 + 32 * wq) {
#pragma unroll
            for (int kb2 = 0; kb2 < 2; ++kb2)
#pragma unroll
                for (int e = 0; e < 16; ++e) { const int kp = 64 * kt + 32 * kb2 + (e & 3) + 8 * (e >> 2) + 4 * h; if (kp > qp) st[kb2][e] = NEGF; }
        }
        float mx = st[0][0];
#pragma unroll
        for (int e = 1; e < 16; ++e) mx = fmaxf(mx, st[0][e]);
#pragma unroll
        for (int e = 0; e < 16; ++e) mx = fmaxf(mx, st[1][e]);
        mx = fmaxf(mx, __shfl_xor(mx, 32));
        const float m_new = fmaxf(m_run, mx), alpha = ex2(m_run - m_new);
        m_run = m_new; l_run *= alpha;
#pragma unroll
        for (int d = 0; d < 4; ++d) o[d] = o[d] * alpha;
        float psum = 0.f;
#pragma unroll
        for (int kb2 = 0; kb2 < 2; ++kb2)
#pragma unroll
            for (int e = 0; e < 16; ++e) { const float p = ex2(st[kb2][e] - m_new); st[kb2][e] = p; psum += p; }
        l_run += psum;
#pragma unroll
        for (int kb2 = 0; kb2 < 2; ++kb2)
#pragma unroll
            for (int s2 = 0; s2 < 2; ++s2) {
                u32x4 pw; pw.x = pk2(st[kb2][8 * s2], st[kb2][8 * s2 + 1]); pw.y = pk2(st[kb2][8 * s2 + 2], st[kb2][8 * s2 + 3]); pw.z = pk2(st[kb2][8 * s2 + 4], st[kb2][8 * s2 + 5]); pw.w = pk2(st[kb2][8 * s2 + 6], st[kb2][8 * s2 + 7]);
                const bf16x8 pf = __builtin_bit_cast(bf16x8, pw);
#pragma unroll
                for (int d = 0; d < 4; ++d) {
                    const LAS unsigned char* va = Vb + (32 * kb2 + 16 * s2 + 4 * h + q) * TSTR + (32 * d + 16 * (g & 1) + 4 * pp) * 2;
                    const bf16x8 vf = cat8(vtr(va), vtr(va + 8 * TSTR));
                    o[d] = mfma32(vf, pf, o[d]);
                }
            }
        if (kt + 1 < ntiles) AT_STORE(s ^ 1);
        __syncthreads();
    }
#undef AT_LOAD
#undef AT_STORE
    const float l_tot = l_run + __shfl_xor(l_run, 32), inv = 1.f / l_tot;
    LAS float* xch = (LAS float*)lds;
    if (c == 1) {
#pragma unroll
        for (int d = 0; d < 4; ++d)
#pragma unroll
            for (int e = 0; e < 16; ++e) xch[((wq * 4 + d) * 16 + e) * 64 + lane] = o[d][e] * inv;
    }
    __syncthreads();
    if (c == 0) {
        float ss = 0.f;
#pragma unroll
        for (int d = 0; d < 4; ++d)
#pragma unroll
            for (int e = 0; e < 16; ++e) { const float v = o[d][e] * inv - lam * xch[((wq * 4 + d) * 16 + e) * 64 + lane]; o[d][e] = v; ss += v * v; }
        ss += __shfl_xor(ss, 32);
        const float rms = (1.f / sqrtf(ss * (1.f / 128.f) + LN_EPS)) * (1.f - lam_init);
        if (qi < nvalid) {
            const size_t row = seqrow(b, qp);
#pragma unroll
            for (int d = 0; d < 4; ++d)
#pragma unroll
                for (int r4 = 0; r4 < 4; ++r4) {
                    const int col = hd * 128 + 32 * d + 8 * r4 + 4 * h;
                    const f32x4 g4 = *(const f32x4*)(ang + col);
                    u32x2 w; w.x = pk2(o[d][4 * r4] * rms * g4[0], o[d][4 * r4 + 1] * rms * g4[1]); w.y = pk2(o[d][4 * r4 + 2] * rms * g4[2], o[d][4 * r4 + 3] * rms * g4[3]);
                    *(u32x2*)(AO + row * 512 + col) = w;
                }
        }
    }
    __syncthreads();
}

constexpr int LDS_BYTES = 147456;
constexpr int NSTEP = 14;
__global__ void __launch_bounds__(512) hybrid_fwd(Params P) {
    extern __shared__ __attribute__((aligned(16))) unsigned char smem[];
    LAS unsigned char* lds = (LAS unsigned char*)smem;
    cg::grid_group grid = cg::this_grid();

    {
        const int lane = tidx() & 63, wid = tidx() >> 6, gw = bidx() * 8 + wid, NGW = gridDim.x * 8;
        bf16_t* HB = (bf16_t*)(P.ws + WS_HB); float* HFM = (float*)(P.ws + WS_HFM);
        LAS float* scr = (LAS float*)(lds + wid * 16384);
        for (int it = gw; it < 2 * 12288; it += NGW) conv_weight_item(P, it / 12288, it % 12288, scr, lane);
        const float* x = P.in[0]; const float* meta = P.in[1];
        for (int row = gw; row < MREAL + NMETA; row += NGW) {
            const float* src = row < MREAL ? x + (size_t)row * DM : meta + (size_t)(row - MREAL) * DM;
            float* hf = row < MREAL ? P.out + (size_t)row * DM : HFM + (size_t)(row - MREAL) * DM;
#pragma unroll
            for (int j = 0; j < 4; ++j) {
                const f32x4 v = *(const f32x4*)(src + 256 * j + 4 * lane);
                *(f32x4*)(hf + 256 * j + 4 * lane) = v;
                u32x2 w; w.x = pk2(v[0], v[1]); w.y = pk2(v[2], v[3]);
                *(u32x2*)(HB + (size_t)row * DM + 256 * j + 4 * lane) = w;
            }
        }
    }
    grid.sync();

#pragma unroll 1
    for (int ph = 0; ph < 2 * NSTEP; ++ph) {
        const int layer = ph / NSTEP, step = ph % NSTEP;
        const int lane = tidx() & 63, wid = __builtin_amdgcn_readfirstlane(tidx() >> 6);
        const int G = gridDim.x, gw = bidx() * 8 + wid, NGW = G * 8;
        bf16_t* HB = (bf16_t*)(P.ws + WS_HB); float* HFM = (float*)(P.ws + WS_HFM);
        bf16_t* BIG = (bf16_t*)(P.ws + WS_BIG); bf16_t* MA = (bf16_t*)(P.ws + WS_MA);
        const bf16_t* Wl = (const bf16_t*)(P.ws + WS_W) + (size_t)layer * OW_LAYER;
        if (step == 0 || step == 11) {
            const bf16_t* Wgu = Wl + (step ? OW_GU2 : OW_GU1);
            pg8::Gemm gm{HB, Wgu, MREAL, 2 * FF, DM}; pg8::StaticOrder S; S.init(MREAL, 2 * FF, G, bidx());
            pg8::EpiSwiglu E{BIG, FF};
            pg8::gemm_phase<pg8::EpiSwiglu, pg8::StaticOrder, true, true>(lds, gm, S, E);
            for (int ct = gw; ct < FF / 16; ct += NGW) {
                const int c0 = 16 * ct, R0 = 256 * (c0 >> 7) + (c0 & 127);
                const f32x4 ag = sg_tile(HB + (size_t)MROW0 * DM, DM, Wgu, DM, R0, lane), au = sg_tile(HB + (size_t)MROW0 * DM, DM, Wgu, DM, R0 + 128, lane);
#pragma unroll
                for (int e = 0; e < 4; ++e) BIG[(size_t)(MROW0 + 4 * (lane >> 4) + e) * FF + c0 + (lane & 15)] = (bf16_t)f2bf(siluf(ag[e]) * au[e]);
            }
        } else if (step == 1 || step == 9 || step == 12) {
            const bf16_t* A = step == 9 ? MA : BIG; const bf16_t* Bt = Wl + (step == 1 ? OW_D1 : step == 9 ? OW_OUT : OW_D2);
            const int K = step == 9 ? DM : FF; const float sc = step == 9 ? 1.f : 0.5f;
            pg8::Gemm gm{A, Bt, MREAL, DM, K}; pg8::StaticOrder S; S.init(MREAL, DM, G, bidx());
            pg8::EpiResid E{P.out, sc};
            pg8::gemm_phase<pg8::EpiResid, pg8::StaticOrder, true, true>(lds, gm, S, E);
            for (int ct = gw; ct < 64; ct += NGW) {
                const f32x4 a = sg_tile(A + (size_t)MROW0 * K, K, Bt, K, 16 * ct, lane);
#pragma unroll
                for (int e = 0; e < 4; ++e) { float* p = HFM + (size_t)(4 * (lane >> 4) + e) * DM + 16 * ct + (lane & 15); *p = ALPHA * *p + sc * a[e]; }
            }
        } else if (step == 2 || step == 10 || step == 13) {
            const int gi = step == 2 ? 5 : step == 10 ? 21 : 26;
            ln_phase(P, P.in[gi] + (size_t)layer * DM, P.in[gi + 1] + (size_t)layer * DM, step == 2, P.in[7] + (size_t)layer * DM * DPROJ, P.in[10] + (size_t)layer * 8, lds);
        } else if (step == 3 || step == 7) {
            const int ng = step == 3 ? 1 : 2;
#pragma unroll 1
            for (int gi = 0; gi < ng; ++gi) {
                const bf16_t* A = step == 3 ? HB : MA + (size_t)gi * MPAD * 512;
                const bf16_t* Bt = Wl + (step == 3 ? OW_PB : gi ? OW_BA : OW_BM);
                const int N = step == 3 ? NPB : DM, K = step == 3 ? DM : 512, ldc = step == 3 ? NPB : 2048, coff = gi * DM;
                pg8::Gemm gm{A, Bt, MREAL, N, K}; pg8::StaticOrder S; S.init(MREAL, N, G, bidx());
                pg8::EpiPlain E{BIG, ldc, coff, step == 3 ? 8 : 0, step == 3 ? 10 : 0, QSCALE};
                pg8::gemm_phase<pg8::EpiPlain, pg8::StaticOrder, true, true>(lds, gm, S, E);
                for (int ct = gw; ct < N / 16; ct += NGW) {
                    const f32x4 a = sg_tile(A + (size_t)MROW0 * K, K, Bt, K, 16 * ct, lane);
                    const float sc = (step == 3 && 16 * ct >= 2048 && 16 * ct < 2560) ? QSCALE : 1.f;
#pragma unroll
                    for (int e = 0; e < 4; ++e) BIG[(size_t)(MROW0 + 4 * (lane >> 4) + e) * ldc + coff + 16 * ct + (lane & 15)] = (bf16_t)f2bf(a[e] * sc);
                }
            }
        } else if (step == 4) {
            for (int u = bidx(); u < 32 * NCH; u += G) m1_unit(P, layer, u / NCH, u % NCH, lds);
        } else if (step == 5) {
            m2_phase(P);
        } else if (step == 6) {
            const float lam_init = layer == 0 ? 0.2f : 0.35550906759f;
            float lam;
            {
                const float* l1 = P.in[12] + layer * 64; const float* k1 = P.in[13] + layer * 64; const float* l2 = P.in[14] + layer * 64; const float* k2 = P.in[15] + layer * 64;
                const float s1 = wave_sum(l1[lane] * k1[lane]), s2 = wave_sum(l2[lane] * k2[lane]);
                lam = expf(s1) - expf(s2) + lam_init;
            }
#pragma unroll 1
            for (int u = bidx(); u < 2048 + 4; u += G) {
                const int cbv = u & 255, i = u >> 8, sft = cbv & 7, j = (i & 1) ? (16 * (i >> 1) + 15 - sft) : (16 * (i >> 1) + sft);
                const bool real = u < 2048; const int bh = real ? (cbv >> 3) : (u - 2048);
                attn_unit(P, layer, bh >> 2, bh & 3, real ? NMETA + 128 * j : 0, real ? 128 : NMETA, lam, lam_init, lds);
            }
            for (int u = bidx(); u < 32 * NCH; u += G) m3_unit(P, layer, u / NCH, u % NCH, lds);
        } else if (step == 8) {
            const bf16_t* Y = BIG; const float* bg = P.in[19] + (size_t)layer * 2048;
            pg8::Gemm gm{HB, Wl + OW_GM, MREAL, 2048, DM}; pg8::StaticOrder S; S.init(MREAL, 2048, G, bidx());
            pg8::EpiGate E{MA, Y, bg};
            pg8::gemm_phase<pg8::EpiGate, pg8::StaticOrder, true, true>(lds, gm, S, E);
            for (int ct = gw; ct < 64; ct += NGW) {
                const int c0 = 16 * ct, R0 = 256 * (c0 >> 7) + (c0 & 127);
                const f32x4 am = sg_tile(HB + (size_t)MROW0 * DM, DM, Wl + OW_GM, DM, R0, lane), aa = sg_tile(HB + (size_t)MROW0 * DM, DM, Wl + OW_GM, DM, R0 + 128, lane);
                const int col = c0 + (lane & 15);
#pragma unroll
                for (int e = 0; e < 4; ++e) {
                    const size_t row = (size_t)(MROW0 + 4 * (lane >> 4) + e);
                    const float ym = bflo((unsigned)Y[row * 2048 + col]), ya = bflo((unsigned)Y[row * 2048 + DM + col]);
                    MA[row * DM + col] = (bf16_t)f2bf(sigm(am[e] + bg[col]) * ym + sigm(aa[e] + bg[DM + col]) * ya);
                }
            }
        }
        grid.sync();
    }
}

extern "C" void kernel_launch(void* const* d_in, const int* in_sizes, int n_in, void* d_out, int out_size, void* d_ws, size_t ws_size, hipStream_t stream) {
    static int grid = 0;
    if (grid == 0) {
        if (n_in != 28 || out_size != MREAL * DM || ws_size < WS_END) { fprintf(stderr, "kernel_launch: unexpected shapes (n_in %d out %d ws %zu)\n", n_in, out_size, ws_size); grid = -1; return; }
        int dev = 0, cus = 0, per_cu = 0;
        hipGetDevice(&dev); hipDeviceGetAttribute(&cus, hipDeviceAttributeMultiprocessorCount, dev);
        hipFuncSetAttribute((const void*)hybrid_fwd, hipFuncAttributeMaxDynamicSharedMemorySize, LDS_BYTES);
        hipOccupancyMaxActiveBlocksPerMultiprocessor(&per_cu, (const void*)hybrid_fwd, 512, LDS_BYTES);
        if (per_cu < 1) per_cu = 1;
        grid = cus * per_cu;
        (void)hipGetLastError();
    }
    if (grid < 0) return;
    Params p{};
    for (int i = 0; i < 28; ++i) p.in[i] = (const float*)d_in[i];
    p.out = (float*)d_out; p.ws = (unsigned char*)d_ws;
    void* args[] = {&p};
    hipError_t e = hipLaunchCooperativeKernel((const void*)hybrid_fwd, dim3(grid), dim3(512), args, LDS_BYTES, stream);
    if (e != hipSuccess) fprintf(stderr, "cooperative launch failed: %s (grid %d)\n", hipGetErrorString(e), grid);
}
```

```cpp
#include <hip/hip_runtime.h>
#include <hip/hip_cooperative_groups.h>
#include <cstdio>
#include <cstdint>
namespace cg = cooperative_groups;

__device__ __forceinline__ int tidx() { int t = threadIdx.x; asm volatile("" : "+v"(t)); return t; }
__device__ __forceinline__ int bidx() { int t = blockIdx.x; asm volatile("" : "+s"(t)); return t; }
namespace pg8 {
#define PG8_LAS __attribute__((address_space(3)))
typedef unsigned short bf16_t;
typedef short bf16x8 __attribute__((ext_vector_type(8)));
typedef float f32x4 __attribute__((ext_vector_type(4)));
typedef unsigned u32x4 __attribute__((ext_vector_type(4)));
constexpr int BM = 256, BK = 64, HALF = 128, HTB = HALF * BK * 2  , STAGE_BYTES = 8 * HTB, NXCD = 8, WGM = 8;

__host__ __device__ __forceinline__ int lds_byte(int r, int c) { const int st = (r >> 4) * 2 + (c >> 5), rr = r & 15, cc = c & 31, ob = rr * 64 + cc * 2; return st * 1024 + (ob ^ (((ob >> 9) & 1) << 5)); }
__host__ __device__ __forceinline__ void stage_rc(int b, int& R, int& C) { const int st = b / 1024, sb = b % 1024, swz = sb ^ (((sb >> 9) & 1) << 5); R = (st >> 1) * 16 + swz / 64; C = (st & 1) * 32 + (swz % 64) / 2; }
__host__ __device__ __forceinline__ int perm32(int rho) { const int n = rho >> 4, i = rho & 15; return 8 * (i >> 2) + 4 * n + (i & 3); }

struct Unit { int pm, pn; };
struct Gemm { const bf16_t* A; const bf16_t* Bt; int M, N, K; };

struct StaticOrder {
    int nM, nN, nwg, G, c;
    __host__ __device__ void init(int M, int N, int G_, int c_) { nM = M / BM; nN = N / BM; nwg = nM * nN; G = G_; c = c_; }
    __host__ __device__ bool next(int i, Unit& u) const {
        const long L = (long)i * G + c; if (L >= nwg) return false;
        int wgid = (int)L; { const int q = nwg / NXCD, r = nwg % NXCD, xcd = wgid % NXCD, off = wgid / NXCD; wgid = (xcd < r ? xcd * (q + 1) : r * (q + 1) + (xcd - r) * q) + off; }
        const int nig = WGM * nN, gid = wgid / nig, fm = gid * WGM, gsz = (nM - fm) < WGM ? (nM - fm) : WGM;
        u.pm = fm + ((wgid % nig) % gsz); u.pn = (wgid % nig) / gsz; return true;
    }
    __device__ __forceinline__ void a_ready(const Unit&) const {}
    __device__ __forceinline__ void done(const Unit&) const {}
};

__device__ __forceinline__ unsigned cvt_pk_bf16(float lo, float hi) { unsigned r; asm volatile("v_cvt_pk_bf16_f32 %0, %1, %2" : "=v"(r) : "v"(lo), "v"(hi)); return r; }
typedef float f32x2 __attribute__((ext_vector_type(2)));
__device__ __forceinline__ f32x2 gelu_pk(f32x2 v) {
    const f32x2 av = __builtin_elementwise_abs(v), d = av * 0.2316418882f + 1.0f;
    f32x2 t; t.x = __builtin_amdgcn_rcpf(d.x); t.y = __builtin_amdgcn_rcpf(d.y);
    f32x2 q = t * 0.5307027145f + (-0.7265760135f); q = q * t + 0.7107068705f; q = q * t + (-0.142248368f); q = q * t + 0.127414796f; q = q * t;
    const f32x2 s = (v * v) * (-0.72134752044f);
    f32x2 e; e.x = __builtin_amdgcn_exp2f(s.x); e.y = __builtin_amdgcn_exp2f(s.y);
    const f32x2 m = v * (q * e), r = v - m;
    f32x2 o; o.x = v.x < 0.f ? m.x : r.x; o.y = v.y < 0.f ? m.y : r.y; return o;
}

template <int ACT  > struct EpiBf16 {
    static constexpr bool PERM = true, AFTER_DRAIN = false; static_assert(ACT == 0 || ACT == 1, "EpiBf16: ACT is 0 (none) or 1 (gelu_pk)");
    bf16_t* O; int ldc; const float* bias; int split_cols; size_t split_stride; float scale0;
    __device__ __forceinline__ void operator()(const f32x4 (&acc)[2][2][4][2], const Unit& u, int wr, int wc, int fr, int fq) const {
        const int row0 = u.pm * BM + wr * 64 + fr; int colt = u.pn * BM; bf16_t* base = O;
        float sc = 1.f; if (split_cols) { const int t = colt / split_cols; base += (size_t)t * split_stride; colt -= t * split_cols; if (t == 0) sc = scale0; }
        const int col0 = colt + wc * 32 + 8 * fq, bcol0 = u.pn * BM + wc * 32 + 8 * fq;
        f32x4 bv[2][2];
#pragma unroll
        for (int bj = 0; bj < 2; ++bj)
#pragma unroll
            for (int n = 0; n < 2; ++n) bv[bj][n] = bias ? *(const f32x4*)(bias + bcol0 + bj * HALF + 4 * n) : (f32x4){0.f, 0.f, 0.f, 0.f};
#pragma unroll
        for (int ai = 0; ai < 2; ++ai)
#pragma unroll
            for (int m = 0; m < 4; ++m) { bf16_t* rowp = base + (size_t)(row0 + ai * HALF + m * 16) * ldc + col0;
#pragma unroll
                for (int bj = 0; bj < 2; ++bj) { f32x4 v0 = acc[ai][bj][m][0] + bv[bj][0], v1 = acc[ai][bj][m][1] + bv[bj][1];
                    if (ACT == 1) { f32x2 a = gelu_pk((f32x2){v0[0], v0[1]}), b = gelu_pk((f32x2){v0[2], v0[3]}), c = gelu_pk((f32x2){v1[0], v1[1]}), d = gelu_pk((f32x2){v1[2], v1[3]});
                        v0 = (f32x4){a.x, a.y, b.x, b.y}; v1 = (f32x4){c.x, c.y, d.x, d.y}; }
                    v0 = v0 * sc; v1 = v1 * sc; u32x4 w; w.x = cvt_pk_bf16(v0[0], v0[1]); w.y = cvt_pk_bf16(v0[2], v0[3]); w.z = cvt_pk_bf16(v1[0], v1[1]); w.w = cvt_pk_bf16(v1[2], v1[3]);
                    *(u32x4*)(rowp + bj * HALF) = w; } }
    }
};

struct PanelStats {
    unsigned* xbuf;
    unsigned* cnt;
    unsigned* tmo;
    int ntn; float eps;
    unsigned code;
    __device__ __forceinline__ bool run(const f32x4 (&v)[2][2][4][2], const Unit& u, int wr, int wc, int fr, int fq, PG8_LAS unsigned char* lds, int wid, int lane) const {
        typedef float f32x2v __attribute__((ext_vector_type(2)));
        PG8_LAS f32x2v* P = (PG8_LAS f32x2v*)lds;
        PG8_LAS f32x2v* S = (PG8_LAS f32x2v*)(lds + 8192);
        PG8_LAS unsigned* flag = (PG8_LAS unsigned*)(lds + 8192 + 2048);
#pragma unroll
        for (int ai = 0; ai < 2; ++ai)
#pragma unroll
            for (int m = 0; m < 4; ++m) {
                float s = 0.f;
#pragma unroll
                for (int bj = 0; bj < 2; ++bj)
#pragma unroll
                    for (int n = 0; n < 2; ++n) { const f32x4 x = v[ai][bj][m][n]; s += (x[0] + x[1]) + (x[2] + x[3]); }
                s += __shfl_xor(s, 16); s += __shfl_xor(s, 32);
                const float mw = s * (1.0f / 64.0f); float q = 0.f;
#pragma unroll
                for (int bj = 0; bj < 2; ++bj)
#pragma unroll
                    for (int n = 0; n < 2; ++n) { const f32x4 d = v[ai][bj][m][n] - mw; q += (d[0] * d[0] + d[1] * d[1]) + (d[2] * d[2] + d[3] * d[3]); }
                q += __shfl_xor(q, 16); q += __shfl_xor(q, 32);
                if (fq == 0) P[(ai * HALF + wr * 64 + m * 16 + fr) * 4 + wc] = (f32x2v){mw, q};
            }
        asm volatile("s_waitcnt lgkmcnt(0)" ::: "memory"); __builtin_amdgcn_s_barrier(); asm volatile("" ::: "memory");
#if defined(BROKEN_EXCHANGE_NO_WAIT)
#warning BROKEN CONTROL BUILD: the row-statistics exchange does not wait; results are wrong by design
        if (blockIdx.x >= 64) { const long long t0_ = clock64(); while (clock64() - t0_ < 60000) __builtin_amdgcn_s_sleep(8); }
#endif
        const int row = wid * 32 + (lane & 31);
        if (lane < 32) {
            const f32x2v a = P[row * 4 + 0], b = P[row * 4 + 1], c = P[row * 4 + 2], d = P[row * 4 + 3];
            const float mt = (a.x + b.x + c.x + d.x) * 0.25f;
            const float da = a.x - mt, db = b.x - mt, dc = c.x - mt, dd = d.x - mt;
            const float m2 = (a.y + b.y) + (c.y + d.y) + 64.0f * ((da * da + db * db) + (dc * dc + dd * dd));
            unsigned long long* slot = (unsigned long long*)xbuf + ((size_t)(u.pm * BM + row) * 4 + u.pn);
            __hip_atomic_store(slot, ((unsigned long long)__float_as_uint(m2) << 32) | __float_as_uint(mt), __ATOMIC_RELAXED, __HIP_MEMORY_SCOPE_AGENT);
        }
        asm volatile("s_waitcnt vmcnt(0)" ::: "memory");
        if (lane == 0) __hip_atomic_fetch_add(cnt + 64 * u.pm, 1u, __ATOMIC_RELAXED, __HIP_MEMORY_SCOPE_AGENT);
        if (wid == 0) {
            bool dead = false; const unsigned long long t0 = __builtin_amdgcn_s_memrealtime(); const unsigned want = 8u * (unsigned)ntn;
            for (;;) {
#if defined(BROKEN_EXCHANGE_NO_WAIT)
                break;
#endif
                if ((unsigned)__builtin_amdgcn_readfirstlane(__hip_atomic_load(cnt + 64 * u.pm, __ATOMIC_RELAXED, __HIP_MEMORY_SCOPE_AGENT)) >= want) break;
                if (__builtin_amdgcn_s_memrealtime() - t0 > 2000000ull) {
                    if (lane == 0) { unsigned expect = 0u; __hip_atomic_compare_exchange_strong(tmo + 1, &expect, code | (unsigned)(u.pm & 0xff), __ATOMIC_RELAXED, __ATOMIC_RELAXED, __HIP_MEMORY_SCOPE_AGENT);
                                     __hip_atomic_store(tmo, 1u, __ATOMIC_RELAXED, __HIP_MEMORY_SCOPE_AGENT); }
                    dead = true; break; }
                __builtin_amdgcn_s_sleep(2);
            }
            __builtin_amdgcn_fence(__ATOMIC_ACQUIRE, "agent");
            if (lane == 0) flag[0] = dead ? 1u : 0u;
        }
        asm volatile("s_waitcnt vmcnt(0) lgkmcnt(0)" ::: "memory"); __builtin_amdgcn_s_barrier(); asm volatile("" ::: "memory");
        const bool bad = flag[0] != 0u;
        if (lane < 32) {
            const unsigned long long* slot = (const unsigned long long*)xbuf + (size_t)(u.pm * BM + row) * 4; float mt[4], m2[4]; float ms = 0.f;
#pragma unroll
            for (int t = 0; t < 4; ++t) { if (t < ntn) { const unsigned long long w = __hip_atomic_load(slot + t, __ATOMIC_RELAXED, __HIP_MEMORY_SCOPE_AGENT); mt[t] = __uint_as_float((unsigned)w); m2[t] = __uint_as_float((unsigned)(w >> 32)); } else { mt[t] = 0.f; m2[t] = 0.f; } ms += mt[t]; }
            const float mean = ms / (float)ntn; float q = 0.f;
#pragma unroll
            for (int t = 0; t < 4; ++t) if (t < ntn) { const float dm = mt[t] - mean; q += m2[t] + 256.0f * dm * dm; }
            S[row] = (f32x2v){mean, 1.0f / sqrtf(q / (256.0f * (float)ntn) + eps)};
        }
        asm volatile("s_waitcnt lgkmcnt(0)" ::: "memory"); __builtin_amdgcn_s_barrier(); asm volatile("" ::: "memory");
        return bad;
    }
};
struct EpiLnRes {
    static constexpr bool PERM = false, AFTER_DRAIN = true;
    const float* base; float* out; int ldc; const float* bias; PanelStats st; unsigned poison;
    __device__ __forceinline__ void fused(f32x4 (&acc)[2][2][4][2], const Unit& u, int wr, int wc, int fr, int fq, PG8_LAS unsigned char* lds, int wid, int lane) const {
        typedef float f32x2v __attribute__((ext_vector_type(2)));
        const PG8_LAS f32x2v* S = (const PG8_LAS f32x2v*)(lds + 8192);
        const int col0 = u.pn * BM + wc * 32 + 4 * fq;
#pragma unroll
        for (int bj = 0; bj < 2; ++bj)
#pragma unroll
            for (int n = 0; n < 2; ++n) { const f32x4 bv = bias ? *(const f32x4*)(bias + col0 + bj * HALF + n * 16) : (f32x4){0.f, 0.f, 0.f, 0.f};
#pragma unroll
                for (int ai = 0; ai < 2; ++ai)
#pragma unroll
                    for (int m = 0; m < 4; ++m) acc[ai][bj][m][n] += bv; }
        f32x4 pre[4][2][2];
#pragma unroll
        for (int m = 0; m < 4; ++m) { const size_t off = (size_t)(u.pm * BM + wr * 64 + m * 16 + fr) * ldc + col0;
#pragma unroll
            for (int bj = 0; bj < 2; ++bj)
#pragma unroll
                for (int n = 0; n < 2; ++n) pre[m][bj][n] = *(const f32x4*)(base + off + bj * HALF + n * 16); }
        const bool bad = st.run(acc, u, wr, wc, fr, fq, lds, wid, lane) || poison != 0u;
        const float qnan = __builtin_nanf("");
#pragma unroll
        for (int ai = 0; ai < 2; ++ai)
#pragma unroll
            for (int m = 0; m < 4; ++m) { const int r = ai * HALF + wr * 64 + m * 16 + fr; const f32x2v sr = S[r]; const size_t off = (size_t)(u.pm * BM + r) * ldc + col0;
#pragma unroll
                for (int bj = 0; bj < 2; ++bj)
#pragma unroll
                    for (int n = 0; n < 2; ++n) { const f32x4 bs = ai == 0 ? pre[m][bj][n] : *(const f32x4*)(base + off + bj * HALF + n * 16); f32x4 o = bs + (acc[ai][bj][m][n] - sr.x) * sr.y;
                        if (bad) o = (f32x4){qnan, qnan, qnan, qnan}; *(f32x4*)(out + off + bj * HALF + n * 16) = o; }
                if (m & 1) asm volatile("" ::: "memory"); }
    }
};
struct EpiLnResLn {
    static constexpr bool PERM = false, AFTER_DRAIN = true;
    const float* base; float* out; bf16_t* xn; int ldc; const float* bias; PanelStats st1, st2; unsigned poison;
    __device__ __forceinline__ void fused(f32x4 (&acc)[2][2][4][2], const Unit& u, int wr, int wc, int fr, int fq, PG8_LAS unsigned char* lds, int wid, int lane) const {
        typedef float f32x2v __attribute__((ext_vector_type(2))); typedef unsigned u32x2v __attribute__((ext_vector_type(2)));
        const PG8_LAS f32x2v* S = (const PG8_LAS f32x2v*)(lds + 8192);
        const int col0 = u.pn * BM + wc * 32 + 4 * fq;
#pragma unroll
        for (int bj = 0; bj < 2; ++bj)
#pragma unroll
            for (int n = 0; n < 2; ++n) { const f32x4 bv = bias ? *(const f32x4*)(bias + col0 + bj * HALF + n * 16) : (f32x4){0.f, 0.f, 0.f, 0.f};
#pragma unroll
                for (int ai = 0; ai < 2; ++ai)
#pragma unroll
                    for (int m = 0; m < 4; ++m) acc[ai][bj][m][n] += bv; }
        bool bad = st1.run(acc, u, wr, wc, fr, fq, lds, wid, lane) || poison != 0u;
        const float qnan = __builtin_nanf("");
#pragma unroll
        for (int ai = 0; ai < 2; ++ai)
#pragma unroll
            for (int m = 0; m < 4; ++m) { const int r = ai * HALF + wr * 64 + m * 16 + fr; const f32x2v sr = S[r]; const size_t off = (size_t)(u.pm * BM + r) * ldc + col0;
#pragma unroll
                for (int bj = 0; bj < 2; ++bj)
#pragma unroll
                    for (int n = 0; n < 2; ++n) { const f32x4 bs = *(const f32x4*)(base + off + bj * HALF + n * 16); acc[ai][bj][m][n] = bs + (acc[ai][bj][m][n] - sr.x) * sr.y; }
                asm volatile("" : "+v"(acc[ai][0][m][0]), "+v"(acc[ai][0][m][1]), "+v"(acc[ai][1][m][0]), "+v"(acc[ai][1][m][1]));
                if (m & 1) asm volatile("" ::: "memory"); }
        const bool bad1 = bad;
        bad = st2.run(acc, u, wr, wc, fr, fq, lds, wid, lane) || bad;
#pragma unroll
        for (int ai = 0; ai < 2; ++ai)
#pragma unroll
            for (int m = 0; m < 4; ++m) { const int r = ai * HALF + wr * 64 + m * 16 + fr; const f32x2v sr = S[r]; const size_t off = (size_t)(u.pm * BM + r) * ldc + col0;
#pragma unroll
                for (int bj = 0; bj < 2; ++bj)
#pragma unroll
                    for (int n = 0; n < 2; ++n) { const f32x4 x1 = acc[ai][bj][m][n]; *(f32x4*)(out + off + bj * HALF + n * 16) = bad1 ? (f32x4){qnan, qnan, qnan, qnan} : x1;
                        const f32x4 o = (x1 - sr.x) * sr.y; u32x2v w; w.x = cvt_pk_bf16(o[0], o[1]); w.y = cvt_pk_bf16(o[2], o[3]);
                        if (bad) { w.x = 0x7fc07fc0u; w.y = 0x7fc07fc0u; } *(u32x2v*)(xn + off + bj * HALF + n * 16) = w; }
                asm volatile("" ::: "memory"); }
    }
};

template <class Epi, class Sched, bool ALIGN_EPI = false, bool SP2 = false>
__device__ __forceinline__ void gemm_phase(PG8_LAS unsigned char* lds, const Gemm g, const Sched& S, const Epi& E) {
    const int tid = tidx(), wid = __builtin_amdgcn_readfirstlane(tid >> 6), lane = tid & 63, wr = wid >> 2, wc = wid & 3, fr = lane & 15, fq = lane >> 4;
    const int K = g.K, nt = K / BK;
    unsigned voffA[2], voffB[2];
#pragma unroll
    for (int i = 0; i < 2; ++i) { int R, C; stage_rc(tid * 16 + i * 8192, R, C); const int Rb = Epi::PERM ? ((R & ~31) + perm32(R & 31)) : R;
        voffA[i] = (unsigned)(R * K + C) * 2u; voffB[i] = (unsigned)(Rb * K + C) * 2u; }
    const size_t kstep = (size_t)(BK * 2);
    const size_t hstep = (size_t)HALF * K * 2;
    const size_t tstep = 2 * hstep;
    const unsigned ldsw = (unsigned)wid * 1024u;
    const int aoff = lds_byte(wr * 64 + fr, fq * 8), boff = lds_byte(wc * 32 + fr, fq * 8);
#define PG8_SA(b, h) (((b) * 2 + (h)) * HTB)
#define PG8_SB(b, h) ((4 + (b) * 2 + (h)) * HTB)
#define PG8_STAGE(bufoff, gbase, voff) do { _Pragma("unroll") for (int _i = 0; _i < 2; ++_i) \
        __builtin_amdgcn_global_load_lds((const unsigned*)((const char*)(gbase) + (voff)[_i]), (PG8_LAS unsigned*)(lds + (bufoff) + ldsw + _i * 8192), 16, 0, 0); } while (0)
#define PG8_LDA(dst, b, h) do { _Pragma("unroll") for (int m = 0; m < 4; ++m) _Pragma("unroll") for (int k = 0; k < 2; ++k) dst[m][k] = *(const PG8_LAS bf16x8*)(lds + PG8_SA(b, h) + aoff + m * 2048 + k * 1024); } while (0)
#define PG8_LDB(dst, b, h) do { _Pragma("unroll") for (int n = 0; n < 2; ++n) _Pragma("unroll") for (int k = 0; k < 2; ++k) dst[n][k] = *(const PG8_LAS bf16x8*)(lds + PG8_SB(b, h) + boff + n * 2048 + k * 1024); } while (0)
#define PG8_MMA(ai, bj, At, Bt) do { __builtin_amdgcn_s_setprio(1); _Pragma("unroll") for (int m = 0; m < 4; ++m) _Pragma("unroll") for (int n = 0; n < 2; ++n) _Pragma("unroll") for (int k = 0; k < 2; ++k) \
        acc[ai][bj][m][n] = __builtin_amdgcn_mfma_f32_16x16x32_bf16(Bt[n][k], At[m][k], acc[ai][bj][m][n], 0, 0, 0); __builtin_amdgcn_s_setprio(0); } while (0)
#define PG8_WAIT_V(n) asm volatile("s_waitcnt vmcnt(" #n ")" ::: "memory")
#define PG8_WAIT_L(n) asm volatile("s_waitcnt lgkmcnt(" #n ")" ::: "memory")
#define PG8_BAR __builtin_amdgcn_s_barrier()
#define PG8_SCHED __builtin_amdgcn_sched_barrier(0)
    Unit cur, nxt; int ui = 0;
    if (!S.next(0, cur)) return;
    E.prefetch(cur, tid, lds + 135168);
    f32x4 acc[2][2][4][2];
#pragma unroll
    for (int a = 0; a < 2; ++a)
#pragma unroll
        for (int b = 0; b < 2; ++b)
#pragma unroll
            for (int m = 0; m < 4; ++m)
#pragma unroll
                for (int n = 0; n < 2; ++n) acc[a][b][m][n] = (f32x4){0.f, 0.f, 0.f, 0.f};
    bf16x8 At[4][2], B0[2][2], B1[2][2];
    const char* cA = (const char*)g.A + (size_t)cur.pm * tstep; const char* cB = (const char*)g.Bt + (size_t)cur.pn * tstep;
    S.a_ready(cur);
    if constexpr (SP2) {
        PG8_STAGE(PG8_SB(0, 0), cB, voffB); PG8_STAGE(PG8_SB(0, 1), cB + hstep, voffB); PG8_STAGE(PG8_SA(0, 0), cA, voffA); PG8_STAGE(PG8_SA(0, 1), cA + hstep, voffA);
        if (wr == 1) PG8_BAR;
        PG8_WAIT_V(2); PG8_BAR;
        PG8_STAGE(PG8_SB(1, 0), cB + kstep, voffB); PG8_STAGE(PG8_SA(1, 0), cA + kstep, voffA); PG8_STAGE(PG8_SB(1, 1), cB + hstep + kstep, voffB);
        PG8_WAIT_V(6); PG8_BAR;
    } else {
        PG8_STAGE(PG8_SB(0, 0), cB, voffB); PG8_STAGE(PG8_SA(0, 0), cA, voffA); PG8_STAGE(PG8_SB(0, 1), cB + hstep, voffB); PG8_STAGE(PG8_SA(0, 1), cA + hstep, voffA);
        if (wr == 1) PG8_BAR;
        PG8_WAIT_V(4); PG8_BAR;
        PG8_STAGE(PG8_SB(1, 0), cB + kstep, voffB); PG8_STAGE(PG8_SA(1, 0), cA + kstep, voffA); PG8_STAGE(PG8_SB(1, 1), cB + hstep + kstep, voffB);
        PG8_WAIT_V(6); PG8_BAR;
    }
    for (;;) {
        const bool has_next = S.next(ui + 1, nxt);
        const char* nA = has_next ? (const char*)g.A + (size_t)nxt.pm * tstep : cA; const char* nB = has_next ? (const char*)g.Bt + (size_t)nxt.pn * tstep : cB;
        for (int t = 0; t < nt; t += 2) {
            const bool last = (t == nt - 2);
            const char* a1 = cA + (size_t)(t + 1) * kstep;
            const char* a2 = last ? nA : cA + (size_t)(t + 2) * kstep; const char* b2 = last ? nB : cB + (size_t)(t + 2) * kstep;
            const char* a3 = a2 + kstep; const char* b3 = b2 + kstep;
            if (last && has_next) S.a_ready(nxt);
            if constexpr (SP2) {
            PG8_LDB(B0, 0, 0); PG8_LDB(B1, 0, 1); PG8_SCHED; PG8_LDA(At, 0, 0); PG8_STAGE(PG8_SA(1, 1), a1 + hstep, voffA);
            PG8_WAIT_V(8); PG8_WAIT_L(0); PG8_BAR; PG8_MMA(0, 0, At, B0); PG8_MMA(0, 1, At, B1); PG8_BAR; PG8_SCHED;
            PG8_LDA(At, 0, 1); PG8_STAGE(PG8_SB(0, 0), b2, voffB); PG8_STAGE(PG8_SB(0, 1), b2 + hstep, voffB); PG8_STAGE(PG8_SA(0, 0), a2, voffA);
            PG8_WAIT_V(8); PG8_WAIT_L(0); PG8_BAR; PG8_MMA(1, 0, At, B0); PG8_MMA(1, 1, At, B1); PG8_BAR; PG8_SCHED;
            PG8_LDB(B0, 1, 0); PG8_LDB(B1, 1, 1); PG8_SCHED; PG8_LDA(At, 1, 0); PG8_STAGE(PG8_SA(0, 1), a2 + hstep, voffA);
            PG8_WAIT_V(8); PG8_WAIT_L(0); PG8_BAR; PG8_MMA(0, 0, At, B0); PG8_MMA(0, 1, At, B1); PG8_BAR; PG8_SCHED;
            PG8_LDA(At, 1, 1); PG8_STAGE(PG8_SB(1, 0), b3, voffB); PG8_STAGE(PG8_SB(1, 1), b3 + hstep, voffB); PG8_STAGE(PG8_SA(1, 0), a3, voffA);
            PG8_WAIT_V(8); PG8_WAIT_L(0); PG8_BAR; PG8_MMA(1, 0, At, B0); PG8_MMA(1, 1, At, B1); PG8_BAR; PG8_SCHED;
            } else {
            PG8_LDB(B0, 0, 0); PG8_SCHED; PG8_LDA(At, 0, 0); PG8_STAGE(PG8_SA(1, 1), a1 + hstep, voffA);
            PG8_WAIT_L(8); PG8_BAR; PG8_WAIT_L(0); PG8_MMA(0, 0, At, B0); PG8_BAR; PG8_SCHED;
            PG8_LDB(B1, 0, 1); PG8_STAGE(PG8_SB(0, 0), b2, voffB);
            PG8_BAR; PG8_WAIT_L(0); PG8_MMA(0, 1, At, B1); PG8_BAR;
            PG8_LDA(At, 0, 1); PG8_STAGE(PG8_SA(0, 0), a2, voffA);
            PG8_BAR; PG8_WAIT_L(0); PG8_MMA(1, 0, At, B0); PG8_BAR; PG8_SCHED;
            PG8_STAGE(PG8_SB(0, 1), b2 + hstep, voffB);
            PG8_WAIT_V(6); PG8_BAR; PG8_MMA(1, 1, At, B1); PG8_BAR;
            PG8_LDB(B0, 1, 0); PG8_SCHED; PG8_LDA(At, 1, 0); PG8_STAGE(PG8_SA(0, 1), a2 + hstep, voffA);
            PG8_WAIT_L(8); PG8_BAR; PG8_WAIT_L(0); PG8_MMA(0, 0, At, B0); PG8_BAR; PG8_SCHED;
            PG8_LDB(B1, 1, 1); PG8_STAGE(PG8_SB(1, 0), b3, voffB);
            PG8_BAR; PG8_WAIT_L(0); PG8_MMA(0, 1, At, B1); PG8_BAR;
            PG8_LDA(At, 1, 1); PG8_STAGE(PG8_SA(1, 0), a3, voffA);
            PG8_BAR; PG8_WAIT_L(0); PG8_MMA(1, 0, At, B0); PG8_BAR; PG8_SCHED;
            PG8_STAGE(PG8_SB(1, 1), b3 + hstep, voffB);
            PG8_WAIT_V(6); PG8_BAR; PG8_MMA(1, 1, At, B1); PG8_BAR;
            }
        }
        if constexpr (ALIGN_EPI) { if (wr == 0) PG8_BAR; }
        if constexpr (!Epi::AFTER_DRAIN) { E(acc, cur, wr, wc, fr, fq, lds + 135168 + (ui & 1) * 4096); if (has_next) E.prefetch(nxt, tid, lds + 135168 + ((ui + 1) & 1) * 4096); S.done(cur); }
        if (!has_next) break;
#pragma unroll
        for (int a = 0; a < 2; ++a)
#pragma unroll
            for (int b = 0; b < 2; ++b)
#pragma unroll
                for (int m = 0; m < 4; ++m)
#pragma unroll
                    for (int n = 0; n < 2; ++n) acc[a][b][m][n] = (f32x4){0.f, 0.f, 0.f, 0.f};
        cur = nxt; cA = nA; cB = nB; ++ui;
        if constexpr (ALIGN_EPI) { if (wr == 1) PG8_BAR; }
    }
    PG8_WAIT_V(0);
    if constexpr (!ALIGN_EPI) { if (wr == 0) PG8_BAR; }
    PG8_BAR;
    if constexpr (Epi::AFTER_DRAIN) { E.fused(acc, cur, wr, wc, fr, fq, lds, wid, lane); S.done(cur); }
#undef PG8_SA
#undef PG8_SB
#undef PG8_STAGE
#undef PG8_LDA
#undef PG8_LDB
#undef PG8_MMA
#undef PG8_WAIT_V
#undef PG8_WAIT_L
#undef PG8_BAR
#undef PG8_SCHED
}
}

#define LAS __attribute__((address_space(3)))
typedef unsigned short bf16_t;
typedef short bf16x8 __attribute__((ext_vector_type(8)));
typedef short s16x4 __attribute__((ext_vector_type(4)));
typedef short v4i16_t __attribute__((ext_vector_type(4)));
typedef float f32x4 __attribute__((ext_vector_type(4)));
typedef float f32x16 __attribute__((ext_vector_type(16)));
typedef unsigned u32x4 __attribute__((ext_vector_type(4)));
typedef unsigned u32x2 __attribute__((ext_vector_type(2)));

constexpr int DM = 1024, NB = 8, SEQ = 8192, NMETA = 16, LSEQ = SEQ + NMETA, MREAL = NB * SEQ, MROW0 = MREAL, MPAD = MREAL + 256;
constexpr int FF = 2816, NPB = 3584, NPBW = 3840, DPROJ = 5640;
constexpr int NCH = 65;
constexpr float ALPHA = 1.41421356237f;
constexpr float LOG2E = 1.4426950408889634f;
constexpr float QSCALE = 0.125f * LOG2E;
constexpr float NEGF = -1e30f;
constexpr float LN_EPS = 1e-5f;

constexpr size_t OW_GU1 = 0, OW_D1 = 5767168, OW_PB = 8650752, OW_GM = 12582912, OW_BM = 14680064, OW_BA = 15204352, OW_OUT = 15728640, OW_GU2 = 16777216, OW_D2 = 22544384, OW_LAYER = 25427968;
constexpr int OC_GU1 = 0, OC_PB = 5632, OC_GM = 9472, OC_GU2 = 11520, OC_N = 17152;
constexpr size_t MiB = 1u << 20;
constexpr size_t WS_ROWS = 0;
constexpr size_t WS_CSBW = 4 * MiB;
constexpr size_t WS_HFM = 5 * MiB;
constexpr size_t WS_GATES = 6 * MiB;
constexpr size_t WS_BAR = 9 * MiB;
constexpr size_t WS_KM = WS_BAR + 16384;
constexpr size_t WS_SC = 10 * MiB;
constexpr size_t WS_NST = 11 * MiB;
constexpr size_t WS_STATS = 13 * MiB;
constexpr size_t WS_W = 16 * MiB;
constexpr size_t WS_HB = 113 * MiB;
constexpr size_t WS_LO = 242 * MiB;
constexpr size_t WS_CST = 371 * MiB;
constexpr size_t WS_MA = 436 * MiB;
constexpr size_t WS_BIG = 565 * MiB;
constexpr size_t WS_END = 1015 * MiB;

struct Params {
    const float* in[28];
    float* out; unsigned char* ws;
};

__device__ __forceinline__ unsigned f2bf(float f) { unsigned u = __builtin_bit_cast(unsigned, f); return (u + 0x7fffu + ((u >> 16) & 1u)) >> 16; }
typedef float f32x2_t __attribute__((ext_vector_type(2))); typedef __bf16 bf16x2_t __attribute__((ext_vector_type(2)));
__device__ __forceinline__ unsigned pk2(float lo, float hi) { f32x2_t v = {lo, hi}; bf16x2_t b = __builtin_convertvector(v, bf16x2_t); return __builtin_bit_cast(unsigned, b); }
__device__ __forceinline__ u32x4 pack8(f32x4 a, f32x4 b) { u32x4 w; w.x = pk2(a[0], a[1]); w.y = pk2(a[2], a[3]); w.z = pk2(b[0], b[1]); w.w = pk2(b[2], b[3]); return w; }
__device__ __forceinline__ float bflo(unsigned w) { return __builtin_bit_cast(float, w << 16); }
__device__ __forceinline__ float bfhi(unsigned w) { return __builtin_bit_cast(float, w & 0xffff0000u); }
__device__ __forceinline__ float ex2(float x) { return __builtin_amdgcn_exp2f(x); }
__device__ __forceinline__ float sigm(float x) { return __builtin_amdgcn_rcpf(1.f + ex2(-x * LOG2E)); }
__device__ __forceinline__ float siluf(float x) { return x * sigm(x); }
__device__ __forceinline__ float wave_sum(float v) {
#pragma unroll
    for (int o = 1; o < 64; o <<= 1) v += __shfl_xor(v, o);
    return v;
}
__device__ __forceinline__ float wave_max(float v) {
#pragma unroll
    for (int o = 1; o < 64; o <<= 1) v = fmaxf(v, __shfl_xor(v, o));
    return v;
}
__device__ __forceinline__ size_t seqrow(int b, int pos) { return pos < NMETA ? (size_t)(MROW0 + pos) : (size_t)b * SEQ + (size_t)(pos - NMETA); }
__device__ __forceinline__ f32x16 mfma32(bf16x8 a, bf16x8 b, f32x16 c) { return __builtin_amdgcn_mfma_f32_32x32x16_bf16(a, b, c, 0, 0, 0); }
__device__ __forceinline__ s16x4 vtr(const LAS unsigned char* p) { return __builtin_bit_cast(s16x4, __builtin_amdgcn_ds_read_tr16_b64_v4i16((LAS v4i16_t*)p)); }
__device__ __forceinline__ bf16x8 cat8(s16x4 lo, s16x4 hi) { return (bf16x8){lo[0], lo[1], lo[2], lo[3], hi[0], hi[1], hi[2], hi[3]}; }

namespace pg8 {
__device__ __forceinline__ void tab_prefetch(const float* rows, const float* v0, const float* v1, int pm, int cbase, int tid, PG8_LAS unsigned char* tab) {
    const int wid = __builtin_amdgcn_readfirstlane(tid >> 6), lane = tid & 63;
    if (rows) __builtin_amdgcn_global_load_lds((const unsigned*)(rows + (size_t)pm * 512 + tid), (PG8_LAS unsigned*)(tab + wid * 256), 4, 0, 0);
    const float* src = (wid < 4 ? v0 + (wid * 64 + lane) : v1 + ((wid - 4) * 64 + lane)) + cbase;
    __builtin_amdgcn_global_load_lds((const unsigned*)src, (PG8_LAS unsigned*)(tab + 2048 + wid * 256), 4, 0, 0);
}
__device__ __forceinline__ void tab_ready() { asm volatile("s_waitcnt vmcnt(14)" ::: "memory"); __builtin_amdgcn_s_barrier(); asm volatile("" ::: "memory"); }
__device__ __forceinline__ void tab_stats(const PG8_LAS unsigned char* tab, int rloc, float& mu, float& r) {
    const f32x2_t st = *(const PG8_LAS f32x2_t*)(tab + rloc * 8); mu = st.x * (1.f / DM); r = __builtin_amdgcn_rsqf(st.y * (1.f / DM) - mu * mu + LN_EPS);
}
struct LnFix {
    const float* rows; const float* cs; const float* bw; int on;
    __device__ __forceinline__ void stats(size_t row, float& mu, float& r) const {
        const f32x2_t st = *(const f32x2_t*)(rows + row * 2); mu = st.x * (1.f / DM); r = __builtin_amdgcn_rsqf(st.y * (1.f / DM) - mu * mu + LN_EPS);
    }
};
struct EpiSwiglu {
    static constexpr bool PERM = true, AFTER_DRAIN = false;
    bf16_t* O; int ldc; LnFix fx;
    __device__ __forceinline__ void prefetch(const Unit& u, int tid, PG8_LAS unsigned char* tab) const { if (fx.on) tab_prefetch(fx.rows, fx.cs, fx.bw, u.pm, u.pn * BM, tid, tab); }
    __device__ __forceinline__ void operator()(const f32x4 (&acc)[2][2][4][2], const Unit& u, int wr, int wc, int fr, int fq, const PG8_LAS unsigned char* tab) const {
        const int row0 = u.pm * BM + wr * 64 + fr, col0 = u.pn * 128 + wc * 32 + 8 * fq, cl = wc * 32 + 8 * fq;
        if (fx.on) tab_ready();
#pragma unroll
        for (int ai = 0; ai < 2; ++ai)
#pragma unroll
            for (int m = 0; m < 4; ++m) {
                const size_t row = (size_t)(row0 + ai * HALF + m * 16);
                float mu = 0.f, r = 1.f; if (fx.on) tab_stats(tab, wr * 64 + fr + ai * HALF + m * 16, mu, r);
                u32x4 w;
#pragma unroll
                for (int n = 0; n < 2; ++n) {
                    f32x4 csg = {0.f, 0.f, 0.f, 0.f}, bwg = csg, csu = csg, bwu = csg;
                    if (fx.on) { csg = *(const PG8_LAS f32x4*)(tab + 2048 + (cl + 4 * n) * 4); bwg = *(const PG8_LAS f32x4*)(tab + 3072 + (cl + 4 * n) * 4); csu = *(const PG8_LAS f32x4*)(tab + 2048 + (cl + HALF + 4 * n) * 4); bwu = *(const PG8_LAS f32x4*)(tab + 3072 + (cl + HALF + 4 * n) * 4); }
                    const f32x4 g = (acc[ai][0][m][n] - csg * mu) * r + bwg, up = (acc[ai][1][m][n] - csu * mu) * r + bwu;
                    const unsigned lo = pk2(siluf(g[0]) * up[0], siluf(g[1]) * up[1]), hi = pk2(siluf(g[2]) * up[2], siluf(g[3]) * up[3]);
                    if (n == 0) { w.x = lo; w.y = hi; } else { w.z = lo; w.w = hi; }
                }
                *(u32x4*)(O + row * ldc + col0) = w;
            }
    }
};
struct EpiPlain {
    static constexpr bool PERM = true, AFTER_DRAIN = false;
    bf16_t* O; int ldc; int coff; int slo, shi; float scale; LnFix fx; float* GT; const float* bif;
    __device__ __forceinline__ void prefetch(const Unit& u, int tid, PG8_LAS unsigned char* tab) const { if (fx.on) tab_prefetch(fx.rows, fx.cs, fx.bw, u.pm, u.pn * BM, tid, tab); }
    __device__ __forceinline__ void operator()(const f32x4 (&acc)[2][2][4][2], const Unit& u, int wr, int wc, int fr, int fq, const PG8_LAS unsigned char* tab) const {
        const int row0 = u.pm * BM + wr * 64 + fr, col0 = coff + u.pn * BM + wc * 32 + 8 * fq, cl = wc * 32 + 8 * fq;
        if (fx.on) tab_ready();
        if (GT && u.pn == 14) {
            if (wc == 0 && fq == 0) {
                const f32x4 cs0 = *(const PG8_LAS f32x4*)(tab + 2048 + cl * 4), cs1 = *(const PG8_LAS f32x4*)(tab + 2048 + (cl + 4) * 4);
                const f32x4 bw0 = *(const PG8_LAS f32x4*)(tab + 3072 + cl * 4) + *(const f32x4*)(bif), bw1 = *(const PG8_LAS f32x4*)(tab + 3072 + (cl + 4) * 4) + *(const f32x4*)(bif + 4);
#pragma unroll
                for (int ai = 0; ai < 2; ++ai)
#pragma unroll
                    for (int m = 0; m < 4; ++m) {
                        const size_t row = (size_t)(row0 + ai * HALF + m * 16);
                        float mu, r; tab_stats(tab, wr * 64 + fr + ai * HALF + m * 16, mu, r);
                        const f32x4 li = (acc[ai][0][m][0] - cs0 * mu) * r + bw0, z = (acc[ai][0][m][1] - cs1 * mu) * r + bw1;
                        f32x4 lf;
#pragma unroll
                        for (int e = 0; e < 4; ++e) lf[e] = fminf(z[e], 0.f) - __logf(1.f + __expf(-fabsf(z[e])));
                        *(f32x4*)(GT + row * 8) = li; *(f32x4*)(GT + row * 8 + 4) = lf;
                    }
            }
            return;
        }
        const float sc = (u.pn >= slo && u.pn < shi) ? scale : 1.f;
#pragma unroll
        for (int ai = 0; ai < 2; ++ai)
#pragma unroll
            for (int m = 0; m < 4; ++m) {
                const size_t row = (size_t)(row0 + ai * HALF + m * 16);
                float mu = 0.f, r = 1.f; if (fx.on) tab_stats(tab, wr * 64 + fr + ai * HALF + m * 16, mu, r);
#pragma unroll
                for (int bj = 0; bj < 2; ++bj) {
                    u32x4 w;
#pragma unroll
                    for (int n = 0; n < 2; ++n) {
                        f32x4 cs4 = {0.f, 0.f, 0.f, 0.f}, bw4 = cs4;
                        if (fx.on) { cs4 = *(const PG8_LAS f32x4*)(tab + 2048 + (cl + bj * HALF + 4 * n) * 4); bw4 = *(const PG8_LAS f32x4*)(tab + 3072 + (cl + bj * HALF + 4 * n) * 4); }
                        const f32x4 v = ((acc[ai][bj][m][n] - cs4 * mu) * r + bw4) * sc;
                        if (n == 0) { w.x = pk2(v[0], v[1]); w.y = pk2(v[2], v[3]); } else { w.z = pk2(v[0], v[1]); w.w = pk2(v[2], v[3]); }
                    }
                    *(u32x4*)(O + row * ldc + col0 + bj * HALF) = w;
                }
            }
    }
};
struct EpiResid {
    static constexpr bool PERM = true, AFTER_DRAIN = false;
    const float* src; bf16_t* LO; bf16_t* HB; const float* rows_prev; float* rows_cur; const float* gam; const float* bet; float s; int raw;
    __device__ __forceinline__ void prefetch(const Unit& u, int tid, PG8_LAS unsigned char* tab) const { if (!raw) tab_prefetch(rows_prev, gam, bet, u.pm, u.pn * BM, tid, tab); }
    __device__ __forceinline__ void operator()(const f32x4 (&acc)[2][2][4][2], const Unit& u, int wr, int wc, int fr, int fq, const PG8_LAS unsigned char* tab) const {
        const int row0 = u.pm * BM + wr * 64 + fr, col0 = u.pn * BM + wc * 32 + 8 * fq, cl = wc * 32 + 8 * fq;
        if (!raw) tab_ready();
#pragma unroll
        for (int ai = 0; ai < 2; ++ai)
#pragma unroll
            for (int m = 0; m < 4; ++m) {
                const size_t row = (size_t)(row0 + ai * HALF + m * 16);
                float mu = 0.f, rs = 1.f;
                if (!raw) tab_stats(tab, wr * 64 + fr + ai * HALF + m * 16, mu, rs);
                const float ar = ALPHA * rs, am = -ALPHA * rs * mu;
                float s1 = 0.f, s2 = 0.f;
#pragma unroll
                for (int bj = 0; bj < 2; ++bj) {
                    f32x4 g0 = {1.f, 1.f, 1.f, 1.f}, g1 = g0, b0 = {0.f, 0.f, 0.f, 0.f}, b1 = b0;
                    if (!raw) { g0 = *(const PG8_LAS f32x4*)(tab + 2048 + (cl + bj * HALF) * 4); g1 = *(const PG8_LAS f32x4*)(tab + 2048 + (cl + bj * HALF + 4) * 4); b0 = *(const PG8_LAS f32x4*)(tab + 3072 + (cl + bj * HALF) * 4); b1 = *(const PG8_LAS f32x4*)(tab + 3072 + (cl + bj * HALF + 4) * 4); }
                    f32x4 x0, x1;
                    if (raw) { x0 = *(const f32x4*)(src + row * DM + col0 + bj * HALF); x1 = *(const f32x4*)(src + row * DM + col0 + bj * HALF + 4); }
                    else { const u32x4 hi = *(const u32x4*)(HB + row * DM + col0 + bj * HALF), lo = *(const u32x4*)(LO + row * DM + col0 + bj * HALF);
                        x0 = (f32x4){bflo(hi.x) + bflo(lo.x), bfhi(hi.x) + bfhi(lo.x), bflo(hi.y) + bflo(lo.y), bfhi(hi.y) + bfhi(lo.y)};
                        x1 = (f32x4){bflo(hi.z) + bflo(lo.z), bfhi(hi.z) + bfhi(lo.z), bflo(hi.w) + bflo(lo.w), bfhi(hi.w) + bfhi(lo.w)}; }
                    const f32x4 o0 = (x0 * ar + am) * g0 + b0 * ALPHA + acc[ai][bj][m][0] * s, o1 = (x1 * ar + am) * g1 + b1 * ALPHA + acc[ai][bj][m][1] * s;
                    const u32x4 nh = pack8(o0, o1);
                    const f32x4 d0 = {o0[0] - bflo(nh.x), o0[1] - bfhi(nh.x), o0[2] - bflo(nh.y), o0[3] - bfhi(nh.y)}, d1 = {o1[0] - bflo(nh.z), o1[1] - bfhi(nh.z), o1[2] - bflo(nh.w), o1[3] - bfhi(nh.w)};
                    *(u32x4*)(HB + row * DM + col0 + bj * HALF) = nh; *(u32x4*)(LO + row * DM + col0 + bj * HALF) = pack8(d0, d1);
                    s1 += ((o0[0] + o0[1]) + (o0[2] + o0[3])) + ((o1[0] + o1[1]) + (o1[2] + o1[3]));
                    s2 += ((o0[0] * o0[0] + o0[1] * o0[1]) + (o0[2] * o0[2] + o0[3] * o0[3])) + ((o1[0] * o1[0] + o1[1] * o1[1]) + (o1[2] * o1[2] + o1[3] * o1[3]));
                }
                s1 += __shfl_xor(s1, 16); s1 += __shfl_xor(s1, 32); s2 += __shfl_xor(s2, 16); s2 += __shfl_xor(s2, 32);
                if (fq == 0) { float* rp = rows_cur + row * 2; atomicAdd(rp, s1); atomicAdd(rp + 1, s2); }
                asm volatile("" ::: "memory");
            }
    }
};
struct EpiGate {
    static constexpr bool PERM = true, AFTER_DRAIN = false;
    bf16_t* U; const bf16_t* Y; const float* bg; LnFix fx;
    __device__ __forceinline__ void prefetch(const Unit& u, int tid, PG8_LAS unsigned char* tab) const { tab_prefetch(fx.rows, fx.cs, fx.bw, u.pm, u.pn * BM, tid, tab); }
    __device__ __forceinline__ void operator()(const f32x4 (&acc)[2][2][4][2], const Unit& u, int wr, int wc, int fr, int fq, const PG8_LAS unsigned char* tab) const {
        const int row0 = u.pm * BM + wr * 64 + fr, col0 = u.pn * 128 + wc * 32 + 8 * fq, cl = wc * 32 + 8 * fq;
        tab_ready();
#pragma unroll
        for (int ai = 0; ai < 2; ++ai)
#pragma unroll
            for (int m = 0; m < 4; ++m) {
                const size_t row = (size_t)(row0 + ai * HALF + m * 16);
                float mu, r; tab_stats(tab, wr * 64 + fr + ai * HALF + m * 16, mu, r);
                const u32x4 ym = *(const u32x4*)(Y + row * 2048 + col0), ya = *(const u32x4*)(Y + row * 2048 + DM + col0);
                u32x4 w;
#pragma unroll
                for (int n = 0; n < 2; ++n) {
                    const f32x4 csm = *(const PG8_LAS f32x4*)(tab + 2048 + (cl + 4 * n) * 4), bm = *(const PG8_LAS f32x4*)(tab + 3072 + (cl + 4 * n) * 4);
                    const f32x4 csa = *(const PG8_LAS f32x4*)(tab + 2048 + (cl + HALF + 4 * n) * 4), ba = *(const PG8_LAS f32x4*)(tab + 3072 + (cl + HALF + 4 * n) * 4);
                    const f32x4 gm = (acc[ai][0][m][n] - csm * mu) * r + bm, ga = (acc[ai][1][m][n] - csa * mu) * r + ba;
                    const unsigned y0 = n ? ym.z : ym.x, y1 = n ? ym.w : ym.y, a0 = n ? ya.z : ya.x, a1 = n ? ya.w : ya.y;
                    const unsigned lo = pk2(sigm(gm[0]) * bflo(y0) + sigm(ga[0]) * bflo(a0), sigm(gm[1]) * bfhi(y0) + sigm(ga[1]) * bfhi(a0));
                    const unsigned hi = pk2(sigm(gm[2]) * bflo(y1) + sigm(ga[2]) * bflo(a1), sigm(gm[3]) * bfhi(y1) + sigm(ga[3]) * bfhi(a1));
                    if (n == 0) { w.x = lo; w.y = hi; } else { w.z = lo; w.w = hi; }
                }
                *(u32x4*)(U + row * DM + col0) = w;
            }
    }
};
}

__device__ __forceinline__ f32x4 sg_tile(const bf16_t* A, int lda, const bf16_t* Bt, int K, int n0, int lane) {
    const bf16_t* ap = A + (size_t)(lane & 15) * lda + 8 * (lane >> 4);
    const bf16_t* bp = Bt + (size_t)(n0 + (lane & 15)) * K + 8 * (lane >> 4);
    f32x4 acc = {0.f, 0.f, 0.f, 0.f};
#pragma unroll 8
    for (int k = 0; k < K; k += 32) {
        const bf16x8 a = *(const bf16x8*)(ap + k), b = *(const bf16x8*)(bp + k);
        acc = __builtin_amdgcn_mfma_f32_16x16x32_bf16(a, b, acc, 0, 0, 0);
    }
    return acc;
}

__device__ __forceinline__ f32x4 sg_tile_blk(const bf16_t* A, int lda, const bf16_t* Bt, int K, int n0, int lane, int wid, LAS float* red) {
    const int K8 = K >> 3;
    const bf16_t* ap = A + (size_t)(lane & 15) * lda + 8 * (lane >> 4) + wid * K8;
    const bf16_t* bp = Bt + (size_t)(n0 + (lane & 15)) * K + 8 * (lane >> 4) + wid * K8;
    f32x4 acc = {0.f, 0.f, 0.f, 0.f};
#pragma unroll 4
    for (int k = 0; k < K8; k += 32) {
        const bf16x8 a = *(const bf16x8*)(ap + k), b = *(const bf16x8*)(bp + k);
        acc = __builtin_amdgcn_mfma_f32_16x16x32_bf16(a, b, acc, 0, 0, 0);
    }
    *(LAS f32x4*)(red + wid * 256 + lane * 4) = acc;
    __syncthreads();
    f32x4 sum = {0.f, 0.f, 0.f, 0.f};
    if (wid == 0) {
#pragma unroll
        for (int w = 0; w < 8; ++w) sum = sum + *(const LAS f32x4*)(red + w * 256 + lane * 4);
    }
    __syncthreads();
    return sum;
}

__device__ __forceinline__ void tr_rows(const float* Wsrc, int ldw, int K, bf16_t* dst, int kb0, int nkb, int nv4, const float* g, const float* bb, float* cs, float* bw, LAS float* scr, int lane, const float* addb = nullptr) {
    float csp[4] = {0.f, 0.f, 0.f, 0.f}, bwp[4] = {0.f, 0.f, 0.f, 0.f};
    const int c = lane & 7;
#pragma unroll 1
    for (int kb = kb0; kb < kb0 + nkb; ++kb) {
        const int k0 = 64 * kb;
#pragma unroll
        for (int i = 0; i < 8; ++i) { const int kk = 8 * i + (lane >> 3), n4 = (lane & 7) * 4;
            f32x4 v = {0.f, 0.f, 0.f, 0.f}; if ((lane & 7) < nv4) v = *(const f32x4*)(Wsrc + (size_t)(k0 + kk) * ldw + n4);
            scr[kk * 33 + n4] = v[0]; scr[kk * 33 + n4 + 1] = v[1]; scr[kk * 33 + n4 + 2] = v[2]; scr[kk * 33 + n4 + 3] = v[3]; }
        f32x4 g0 = {1.f, 1.f, 1.f, 1.f}, g1 = g0, b0 = {0.f, 0.f, 0.f, 0.f}, b1 = b0;
        if (g) { g0 = *(const f32x4*)(g + k0 + 8 * c); g1 = *(const f32x4*)(g + k0 + 8 * c + 4); b0 = *(const f32x4*)(bb + k0 + 8 * c); b1 = *(const f32x4*)(bb + k0 + 8 * c + 4); }
        asm volatile("s_waitcnt lgkmcnt(0)" ::: "memory");
#pragma unroll
        for (int j = 0; j < 4; ++j) {
            const int n = (lane >> 3) + 8 * j; const LAS float* sp = scr + (8 * c) * 33 + n;
            const float x0 = sp[0 * 33], x1 = sp[1 * 33], x2 = sp[2 * 33], x3 = sp[3 * 33], x4 = sp[4 * 33], x5 = sp[5 * 33], x6 = sp[6 * 33], x7 = sp[7 * 33];
            u32x4 o; o.x = pk2(x0 * g0[0], x1 * g0[1]); o.y = pk2(x2 * g0[2], x3 * g0[3]); o.z = pk2(x4 * g1[0], x5 * g1[1]); o.w = pk2(x6 * g1[2], x7 * g1[3]);
            *(u32x4*)(dst + (size_t)n * K + k0 + 8 * c) = o;
            csp[j] += ((bflo(o.x) + bfhi(o.x)) + (bflo(o.y) + bfhi(o.y))) + ((bflo(o.z) + bfhi(o.z)) + (bflo(o.w) + bfhi(o.w)));
            bwp[j] += ((x0 * b0[0] + x1 * b0[1]) + (x2 * b0[2] + x3 * b0[3])) + ((x4 * b1[0] + x5 * b1[1]) + (x6 * b1[2] + x7 * b1[3]));
        }
        asm volatile("s_waitcnt lgkmcnt(0)" ::: "memory");
    }
    if (g) {
#pragma unroll
        for (int j = 0; j < 4; ++j) {
            float a = csp[j], b = bwp[j];
            a += __shfl_xor(a, 1); a += __shfl_xor(a, 2); a += __shfl_xor(a, 4); b += __shfl_xor(b, 1); b += __shfl_xor(b, 2); b += __shfl_xor(b, 4);
            if (c == 0) { cs[(lane >> 3) + 8 * j] = a; bw[(lane >> 3) + 8 * j] = b + (addb ? addb[(lane >> 3) + 8 * j] : 0.f); }
        }
    }
}
constexpr int CW_ITEMS = 824;
__device__ __forceinline__ void conv_weight_item(const Params& P, int layer, int it, LAS float* scr, int lane) {
    bf16_t* W = (bf16_t*)(P.ws + WS_W) + (size_t)layer * OW_LAYER;
    float* CS = (float*)(P.ws + WS_CSBW) + (size_t)layer * 2 * OC_N; float* BW = CS + OC_N;
    const float* wg1 = P.in[2] + (size_t)layer * DM * FF; const float* wu1 = P.in[3] + (size_t)layer * DM * FF; const float* wd1 = P.in[4] + (size_t)layer * FF * DM;
    const float* win = P.in[7] + (size_t)layer * DM * DPROJ;
    const float* wbm = P.in[17] + (size_t)layer * 512 * DM; const float* wba = P.in[18] + (size_t)layer * 512 * DM; const float* wout = P.in[20] + (size_t)layer * DM * DM;
    const float* wg2 = P.in[23] + (size_t)layer * DM * FF; const float* wu2 = P.in[24] + (size_t)layer * DM * FF; const float* wd2 = P.in[25] + (size_t)layer * FF * DM;
    const float* ln1g = P.in[5] + (size_t)layer * DM; const float* ln1b = P.in[6] + (size_t)layer * DM;
    const float* ln2g = P.in[21] + (size_t)layer * DM; const float* ln2b = P.in[22] + (size_t)layer * DM;
    const float* ln3g = layer ? P.in[26] + (size_t)(layer - 1) * DM : nullptr; const float* ln3b = layer ? P.in[27] + (size_t)(layer - 1) * DM : nullptr;
    int r = it;
    if (r < 352) {
        const int second = r >= 176; if (second) r -= 176;
        const int R0 = 32 * r, pn = R0 >> 8, sgu = (R0 >> 7) & 1, i = R0 & 127;
        const float* src = (second ? (sgu ? wu2 : wg2) : (sgu ? wu1 : wg1)) + 128 * pn + i;
        const int oc = second ? OC_GU2 : OC_GU1;
        tr_rows(src, FF, DM, W + (second ? OW_GU2 : OW_GU1) + (size_t)R0 * DM, 0, 16, 8, second ? ln2g : ln3g, second ? ln2b : ln3b, CS + oc + R0, BW + oc + R0, scr, lane); return;
    }
    r -= 352;
    if (r < 192) {
        const int second = r >= 96; if (second) r -= 96;
        const int nb = r / 3, seg = r % 3, R0 = 32 * nb;
        tr_rows((second ? wd2 : wd1) + R0, DM, FF, W + (second ? OW_D2 : OW_D1) + (size_t)R0 * FF, 16 * seg, seg == 2 ? 12 : 16, 8, nullptr, nullptr, nullptr, nullptr, scr, lane); return;
    }
    r -= 192;
    if (r < 120) {
        const int R0 = 32 * r, csrc = R0 < 2048 ? R0 : (R0 < 3584 ? R0 + 8 : 2048);
        tr_rows(win + csrc, DPROJ, DM, W + OW_PB + (size_t)R0 * DM, 0, 16, R0 < 3584 ? 8 : (R0 == 3584 ? 2 : 0), ln1g, ln1b, CS + OC_PB + R0, BW + OC_PB + R0, scr, lane); return;
    }
    r -= 120;
    if (r < 64) {
        const int R0 = 32 * r, pn = R0 >> 8, sg = (R0 >> 7) & 1, i = R0 & 127, csrc = 3592 + 1024 * sg + 128 * pn + i;
        tr_rows(win + csrc, DPROJ, DM, W + OW_GM + (size_t)R0 * DM, 0, 16, 8, ln1g, ln1b, CS + OC_GM + R0, BW + OC_GM + R0, scr, lane, P.in[19] + (size_t)layer * 2048 + 1024 * sg + 128 * pn + i); return;
    }
    r -= 64;
    if (r < 64) {
        const int second = r >= 32; if (second) r -= 32;
        const int R0 = 32 * r;
        tr_rows((second ? wba : wbm) + R0, DM, 512, W + (second ? OW_BA : OW_BM) + (size_t)R0 * 512, 0, 8, 8, nullptr, nullptr, nullptr, nullptr, scr, lane); return;
    }
    r -= 64;
    { const int R0 = 32 * r; tr_rows(wout + R0, DM, DM, W + OW_OUT + (size_t)R0 * DM, 0, 16, 8, nullptr, nullptr, nullptr, nullptr, scr, lane); }
}

__device__ __forceinline__ void ln_row(const f32x4 (&vin)[4], int row, float* hf, const float* gam, const float* bet, bool gates, bool fin, const float* bif_l, LAS float* gwl, bf16_t* HB, float* ST, float* GT, int lane) {
    f32x4 v[4]; float s = 0.f;
#pragma unroll
    for (int j = 0; j < 4; ++j) { v[j] = vin[j]; s += (v[j][0] + v[j][1]) + (v[j][2] + v[j][3]); }
    const float mean = wave_sum(s) * (1.f / DM); float s2 = 0.f;
#pragma unroll
    for (int j = 0; j < 4; ++j) { v[j] = v[j] - mean; s2 += (v[j][0] * v[j][0] + v[j][1] * v[j][1]) + (v[j][2] * v[j][2] + v[j][3] * v[j][3]); }
    const float rstd = 1.f / sqrtf(wave_sum(s2) * (1.f / DM) + LN_EPS);
    if (lane == 0) { f32x2_t st = {mean, rstd}; *(f32x2_t*)(ST + (size_t)row * 2) = st; }
#pragma unroll
    for (int j = 0; j < 4; ++j) {
        const f32x4 g4 = *(const f32x4*)(gam + 256 * j + 4 * lane), b4 = *(const f32x4*)(bet + 256 * j + 4 * lane);
        v[j] = v[j] * rstd * g4 + b4;
        if (fin) *(f32x4*)(hf + 256 * j + 4 * lane) = v[j];
        if (!fin) { u32x2 w; w.x = pk2(v[j][0], v[j][1]); w.y = pk2(v[j][2], v[j][3]); *(u32x2*)(HB + (size_t)row * DM + 256 * j + 4 * lane) = w; }
    }
    if (gates) {
        float mine = 0.f;
#pragma unroll
        for (int g = 0; g < 8; ++g) {
            float d = 0.f;
#pragma unroll
            for (int j = 0; j < 4; ++j) { const f32x4 w4 = *(const LAS f32x4*)(gwl + g * 1024 + 256 * j + 4 * lane); d += (v[j][0] * w4[0] + v[j][1] * w4[1]) + (v[j][2] * w4[2] + v[j][3] * w4[3]); }
            d = wave_sum(d);
            if (lane == g) mine = d;
        }
        if (lane < 8) {
            const float z = mine + bif_l[lane];
            float o = z;
            if (lane >= 4) o = fminf(z, 0.f) - __logf(1.f + __expf(-fabsf(z)));
            GT[(size_t)row * 8 + lane] = o;
        }
    }
}
__device__ __forceinline__ void ln_phase(const Params& P, const float* gam, const float* bet, bool gates, bool fin, const float* win_l, const float* bif_l, LAS unsigned char* lds) {
    const int tid = tidx(), lane = tid & 63, wid = tid >> 6;
    float* hfm = (float*)(P.ws + WS_HFM); bf16_t* HB = (bf16_t*)(P.ws + WS_HB); float* GT = (float*)(P.ws + WS_GATES); float* ST = (float*)(P.ws + WS_STATS);
    LAS float* gwl = (LAS float*)lds;
    if (gates) {
        for (int idx = tid; idx < 8192; idx += 512) { const int k = idx >> 3, g = idx & 7; gwl[g * 1024 + k] = win_l[(size_t)k * DPROJ + 2048 + g]; }
        __syncthreads();
    }
    const int gw = bidx() * 8 + wid, NGW = gridDim.x * 8;
    constexpr int NR = MREAL;
    int row = 4 * gw;
    f32x4 a[4][4];
#define LN_ROWP(r_) (P.out + (size_t)(r_) * DM)
    const bf16_t* LOp = (const bf16_t*)(P.ws + WS_LO);
#define LN_LOAD(dst_, r_, j_) do { const u32x2 hi_ = *(const u32x2*)(HB + (size_t)(r_) * DM + 256 * (j_) + 4 * lane), lo_ = *(const u32x2*)(LOp + (size_t)(r_) * DM + 256 * (j_) + 4 * lane); \
        dst_ = (f32x4){bflo(hi_.x) + bflo(lo_.x), bfhi(hi_.x) + bfhi(lo_.x), bflo(hi_.y) + bflo(lo_.y), bfhi(hi_.y) + bfhi(lo_.y)}; } while (0)
    if (row < NR) {
#pragma unroll
        for (int q4 = 0; q4 < 4; ++q4) {
#pragma unroll
            for (int j = 0; j < 4; ++j) LN_LOAD(a[q4][j], row + q4, j); }
    }
    while (row < NR) {
        f32x4 ca[4][4];
#pragma unroll
        for (int q4 = 0; q4 < 4; ++q4)
#pragma unroll
            for (int j = 0; j < 4; ++j) ca[q4][j] = a[q4][j];
        const int nrow = row + 4 * NGW;
        if (nrow < NR) {
#pragma unroll
            for (int q4 = 0; q4 < 4; ++q4) {
#pragma unroll
                for (int j = 0; j < 4; ++j) LN_LOAD(a[q4][j], nrow + q4, j); }
        }
#pragma unroll
        for (int q4 = 0; q4 < 4; ++q4) ln_row(ca[q4], row + q4, LN_ROWP(row + q4), gam, bet, gates, fin, bif_l, gwl, HB, ST, GT, lane);
        row = nrow;
    }
#undef LN_ROWP
#undef LN_LOAD
}

__device__ __forceinline__ void conv8(const bf16_t* PB, const float* cw, const float* cb, int b, int pos, int chn, f32x4& o0, f32x4& o1) {
    o0 = *(const f32x4*)(cb + chn); o1 = *(const f32x4*)(cb + chn + 4);
#pragma unroll
    for (int j = 0; j < 4; ++j) {
        const int pp = pos - 3 + j;
        if (pp >= 0) {
            const u32x4 u = *(const u32x4*)(PB + seqrow(b, pp) * NPB + chn);
            const f32x4 w0 = *(const f32x4*)(cw + j * 1024 + chn), w1 = *(const f32x4*)(cw + j * 1024 + chn + 4);
            o0[0] += w0[0] * bflo(u.x); o0[1] += w0[1] * bfhi(u.x); o0[2] += w0[2] * bflo(u.y); o0[3] += w0[3] * bfhi(u.y);
            o1[0] += w1[0] * bflo(u.z); o1[1] += w1[1] * bfhi(u.z); o1[2] += w1[2] * bflo(u.w); o1[3] += w1[3] * bfhi(u.w);
        }
    }
#pragma unroll
    for (int e = 0; e < 4; ++e) { o0[e] = siluf(o0[e]); o1[e] = siluf(o1[e]); }
}
struct ConvW { f32x4 w[4][2]; f32x4 b[2]; };
__device__ __forceinline__ void convw_load(ConvW& cw8, const float* cw, const float* cb, int chn) {
    cw8.b[0] = *(const f32x4*)(cb + chn); cw8.b[1] = *(const f32x4*)(cb + chn + 4);
#pragma unroll
    for (int j = 0; j < 4; ++j) { cw8.w[j][0] = *(const f32x4*)(cw + j * 1024 + chn); cw8.w[j][1] = *(const f32x4*)(cw + j * 1024 + chn + 4); }
}
__device__ __forceinline__ void conv8w(const bf16_t* PB, const ConvW& cw8, int b, int pos, int chn, f32x4& o0, f32x4& o1) {
    o0 = cw8.b[0]; o1 = cw8.b[1];
#pragma unroll
    for (int j = 0; j < 4; ++j) {
        const int pp = pos - 3 + j;
        if (pp >= 0) {
            const u32x4 u = *(const u32x4*)(PB + seqrow(b, pp) * NPB + chn);
            const f32x4 w0 = cw8.w[j][0], w1 = cw8.w[j][1];
            o0[0] += w0[0] * bflo(u.x); o0[1] += w0[1] * bfhi(u.x); o0[2] += w0[2] * bflo(u.y); o0[3] += w0[3] * bfhi(u.y);
            o1[0] += w1[0] * bflo(u.z); o1[1] += w1[1] * bfhi(u.z); o1[2] += w1[2] * bflo(u.w); o1[3] += w1[3] * bfhi(u.w);
        }
    }
#pragma unroll
    for (int e = 0; e < 4; ++e) { o0[e] = siluf(o0[e]); o1[e] = siluf(o1[e]); }
}

__device__ __forceinline__ float wscan_add(float v, int lane) {
#pragma unroll
    for (int o = 1; o < 64; o <<= 1) { const float t = __shfl_up(v, o); if (lane >= o) v += t; }
    return v;
}
__device__ __forceinline__ float wscan_max(float v, int lane) {
#pragma unroll
    for (int o = 1; o < 64; o <<= 1) { const float t = __shfl_up(v, o); if (lane >= o) v = fmaxf(v, t); }
    return v;
}

__device__ __forceinline__ void lds_barrier() { asm volatile("s_waitcnt lgkmcnt(0)\n\ts_barrier" ::: "memory"); }

constexpr int TSTR = 320;
constexpr int RSTR = 272;
__device__ __forceinline__ void m1_unit(const Params& P, int layer, int bh, int c, LAS unsigned char* lds) {
    const int tid = tidx(), lane = tid & 63, wid = __builtin_amdgcn_readfirstlane(tid >> 6);
    const int b = bh >> 2, hh = bh & 3;
    const int nvalid = c == 0 ? NMETA : 128, p0 = c == 0 ? 0 : NMETA + 128 * (c - 1);
    const int nrep = c == 0 ? NB : 1;
    const bf16_t* PB = (const bf16_t*)(P.ws + WS_BIG); const float* GT = (const float*)(P.ws + WS_GATES);
    float* SC = (float*)(P.ws + WS_SC); float* NST = (float*)(P.ws + WS_NST); bf16_t* CST = (bf16_t*)(P.ws + WS_CST);
    const float* cw = P.in[8] + (size_t)layer * 4 * 1024; const float* cb = P.in[9] + (size_t)layer * 1024;
    LAS unsigned char* Kt = lds; LAS unsigned char* Vt = lds + 128 * TSTR; LAS float* sws = (LAS float*)(lds + 2 * 128 * TSTR);
    if (wid == 0) {
        const int i0 = 2 * lane, i1 = i0 + 1;
        float li0 = NEGF, li1 = NEGF, lf0 = 0.f, lf1 = 0.f;
        if (i0 < nvalid) { const size_t rw = seqrow(b, p0 + i0); li0 = GT[rw * 8 + hh]; lf0 = GT[rw * 8 + 4 + hh]; }
        if (i1 < nvalid) { const size_t rw = seqrow(b, p0 + i1); li1 = GT[rw * 8 + hh]; lf1 = GT[rw * 8 + 4 + hh]; }
        const float s = lf0 + lf1, incl = wscan_add(s, lane), excl = incl - s;
        const float b0 = excl + lf0, b1 = incl, g0 = li0 - b0, g1 = li1 - b1;
        const float gmax = wave_max(fmaxf(g0, g1));
        sws[i0] = i0 < nvalid ? ex2((g0 - gmax) * LOG2E) : 0.f;
        sws[i1] = i1 < nvalid ? ex2((g1 - gmax) * LOG2E) : 0.f;
        const float bend = __shfl(incl, 63);
        if (lane == 0) { for (int bb = 0; bb < nrep; ++bb) { SC[(size_t)((bh + 4 * bb) * NCH + c) * 2] = bend; SC[(size_t)((bh + 4 * bb) * NCH + c) * 2 + 1] = bend + gmax; } }
    }
    __syncthreads();
    ConvW ckw; convw_load(ckw, cw, cb, 512 + hh * 128 + 8 * (tid & 15));
#pragma unroll 2
    for (int it = 0; it < 4; ++it) {
        const int item = tid + 512 * it, i = item >> 4, ch = item & 15;
        u32x4 kw = {0u, 0u, 0u, 0u}, vw = {0u, 0u, 0u, 0u};
        if (i < nvalid) {
            f32x4 o0, o1; conv8w(PB, ckw, b, p0 + i, 512 + hh * 128 + 8 * ch, o0, o1);
            const float sc = 0.08838834764831845f * sws[i];
            kw = pack8(o0 * sc, o1 * sc);
            vw = *(const u32x4*)(PB + seqrow(b, p0 + i) * NPB + 1024 + hh * 128 + 8 * ch);
        }
        *(LAS u32x4*)(Kt + i * TSTR + ch * 16) = kw; *(LAS u32x4*)(Vt + i * TSTR + ch * 16) = vw;
    }
    __syncthreads();
    {
        const int h = lane >> 5, g = lane >> 4, q = (lane & 15) >> 2, pp = lane & 3;
        const int dkt = wid >> 1, dvt0 = (wid & 1) * 2;
        f32x16 acc[2];
#pragma unroll
        for (int t = 0; t < 2; ++t)
#pragma unroll
            for (int e = 0; e < 16; ++e) acc[t][e] = 0.f;
#pragma unroll
        for (int ks = 0; ks < 8; ++ks) {
            const int rowa = 16 * ks + 8 * h + q;
            const LAS unsigned char* ka = Kt + rowa * TSTR + (32 * dkt + 16 * (g & 1) + 4 * pp) * 2;
            const bf16x8 af = cat8(vtr(ka), vtr(ka + 4 * TSTR));
#pragma unroll
            for (int t = 0; t < 2; ++t) {
                const LAS unsigned char* va = Vt + rowa * TSTR + (32 * (dvt0 + t) + 16 * (g & 1) + 4 * pp) * 2;
                const bf16x8 bf = cat8(vtr(va), vtr(va + 4 * TSTR));
                acc[t] = mfma32(af, bf, acc[t]);
            }
        }
#pragma unroll
        for (int t = 0; t < 2; ++t) {
            const int dv = 32 * (dvt0 + t) + (lane & 31);
#pragma unroll
            for (int r4 = 0; r4 < 4; ++r4) {
                const int dk0 = 32 * dkt + 8 * r4 + 4 * h;
                u32x2 w; w.x = pk2(acc[t][4 * r4], acc[t][4 * r4 + 1]); w.y = pk2(acc[t][4 * r4 + 2], acc[t][4 * r4 + 3]);
                for (int bb = 0; bb < nrep; ++bb) *(u32x2*)(CST + (size_t)((bh + 4 * bb) * NCH + c) * 16384 + (size_t)dv * 128 + dk0) = w;
            }
        }
    }
    {
        LAS float* red = sws + 256;
        const int dk = tid & 127, part = tid >> 7;
        float sacc = 0.f;
#pragma unroll 8
        for (int i = 0; i < 32; ++i) sacc += __builtin_bit_cast(float, (unsigned)(*(const LAS unsigned short*)(Kt + (32 * part + i) * TSTR + dk * 2)) << 16);
        red[part * 128 + dk] = sacc;
        __syncthreads();
        if (tid < 128) { const float nsum = (red[tid] + red[128 + tid]) + (red[256 + tid] + red[384 + tid]); for (int bb = 0; bb < nrep; ++bb) NST[(size_t)((bh + 4 * bb) * NCH + c) * 128 + tid] = nsum; }
    }
    lds_barrier();
}

__device__ __forceinline__ void m2_phase(const Params& P) {
    float* SC = (float*)(P.ws + WS_SC); float* MST = SC + 32 * NCH * 2; float* NST = (float*)(P.ws + WS_NST); bf16_t* CST = (bf16_t*)(P.ws + WS_CST);
    const int NT = gridDim.x * 512;
    for (int task = bidx() * 512 + tidx(); task < 65536 + 4096; task += NT) {
        if (task < 65536) {
            const int bh = task >> 11, e8 = task & 2047;
            bf16_t* ptr = CST + (size_t)bh * NCH * 16384 + (size_t)e8 * 8;
            float run[8];
#pragma unroll
            for (int e = 0; e < 8; ++e) run[e] = 0.f;
            float m = NEGF;
#pragma unroll 1
            for (int c0 = 0; c0 < NCH; c0 += 5) {
                u32x4 loc[5];
#pragma unroll
                for (int j = 0; j < 5; ++j) loc[j] = *(const u32x4*)(ptr + (size_t)(c0 + j) * 16384);
#pragma unroll
                for (int j = 0; j < 5; ++j) {
                    const int c = c0 + j;
                    const float bend = SC[(size_t)(bh * NCH + c) * 2], mloc = SC[(size_t)(bh * NCH + c) * 2 + 1];
                    const float mn = fmaxf(bend + m, mloc), a = ex2((bend + m - mn) * LOG2E), bt = ex2((mloc - mn) * LOG2E);
                    u32x4 w; w.x = pk2(run[0], run[1]); w.y = pk2(run[2], run[3]); w.z = pk2(run[4], run[5]); w.w = pk2(run[6], run[7]);
                    *(u32x4*)(ptr + (size_t)c * 16384) = w;
                    run[0] = a * run[0] + bt * bflo(loc[j].x); run[1] = a * run[1] + bt * bfhi(loc[j].x);
                    run[2] = a * run[2] + bt * bflo(loc[j].y); run[3] = a * run[3] + bt * bfhi(loc[j].y);
                    run[4] = a * run[4] + bt * bflo(loc[j].z); run[5] = a * run[5] + bt * bfhi(loc[j].z);
                    run[6] = a * run[6] + bt * bflo(loc[j].w); run[7] = a * run[7] + bt * bfhi(loc[j].w);
                    if (e8 == 0) MST[bh * NCH + c] = m;
                    m = mn;
                }
            }
        } else {
            const int t2 = task - 65536, bh = t2 >> 7, dk = t2 & 127;
            float* ptr = NST + (size_t)bh * NCH * 128 + dk;
            float run = 0.f, m = NEGF;
#pragma unroll 1
            for (int c = 0; c < NCH; ++c) {
                const float bend = SC[(size_t)(bh * NCH + c) * 2], mloc = SC[(size_t)(bh * NCH + c) * 2 + 1];
                const float mn = fmaxf(bend + m, mloc), a = ex2((bend + m - mn) * LOG2E), bt = ex2((mloc - mn) * LOG2E);
                const float loc = ptr[(size_t)c * 128]; ptr[(size_t)c * 128] = run; run = a * run + bt * loc; m = mn;
            }
        }
    }
}

__device__ __forceinline__ void m3_unit(const Params& P, int layer, int bh, int c, LAS unsigned char* lds) {
    const int tid = tidx(), lane = tid & 63, wid = __builtin_amdgcn_readfirstlane(tid >> 6);
    const int b = bh >> 2, hh = bh & 3;
    const int nvalid = c == 0 ? NMETA : 128, p0 = c == 0 ? 0 : NMETA + 128 * (c - 1);
    const bf16_t* PB = (const bf16_t*)(P.ws + WS_BIG); const float* GT = (const float*)(P.ws + WS_GATES);
    const float* SC = (const float*)(P.ws + WS_SC); const float* MST = SC + 32 * NCH * 2; const float* NST = (const float*)(P.ws + WS_NST); const bf16_t* CST = (const bf16_t*)(P.ws + WS_CST);
    bf16_t* MA = (bf16_t*)(P.ws + WS_MA);
    const float* cw = P.in[8] + (size_t)layer * 4 * 1024; const float* cb = P.in[9] + (size_t)layer * 1024; const float* mng = P.in[11] + (size_t)layer * 512;
    LAS unsigned char* Qt = lds; LAS unsigned char* Kt = lds + 128 * RSTR; LAS unsigned char* Vt = lds + 2 * 128 * RSTR;
    LAS float* sg2 = (LAS float*)(lds + 2 * 128 * RSTR + 128 * TSTR); LAS float* sr2 = sg2 + 128; LAS float* sw = sg2 + 256; LAS float* semt = sg2 + 384; LAS float* sqn = sg2 + 512;
    LAS float* sst = sg2 + 640; LAS float* sst2 = sg2 + 896;
    if (wid == 0) {
        const int i0 = 2 * lane, i1 = i0 + 1;
        float li0 = NEGF, li1 = NEGF, lf0 = 0.f, lf1 = 0.f;
        if (i0 < nvalid) { const size_t rw = seqrow(b, p0 + i0); li0 = GT[rw * 8 + hh]; lf0 = GT[rw * 8 + 4 + hh]; }
        if (i1 < nvalid) { const size_t rw = seqrow(b, p0 + i1); li1 = GT[rw * 8 + hh]; lf1 = GT[rw * 8 + 4 + hh]; }
        const float s = lf0 + lf1, incl = wscan_add(s, lane), excl = incl - s;
        const float b0 = excl + lf0, b1 = incl, g0 = li0 - b0, g1 = li1 - b1;
        const float inclm = wscan_max(fmaxf(g0, g1), lane);
        float exclm = __shfl_up(inclm, 1); if (lane == 0) exclm = NEGF;
        const float cm0 = fmaxf(exclm, g0), cm1 = inclm;
        const float mprev = MST[bh * NCH + c];
        const float M0 = fmaxf(mprev, cm0), M1 = fmaxf(mprev, cm1);
        sg2[i0] = g0 * LOG2E; sg2[i1] = g1 * LOG2E; sr2[i0] = -M0 * LOG2E; sr2[i1] = -M1 * LOG2E;
        sw[i0] = ex2((mprev - M0) * LOG2E); sw[i1] = ex2((mprev - M1) * LOG2E);
        semt[i0] = ex2(-(b0 + M0) * LOG2E); semt[i1] = ex2(-(b1 + M1) * LOG2E);
    }
    ConvW cqw, ckw; convw_load(cqw, cw, cb, hh * 128 + 8 * (tid & 15)); convw_load(ckw, cw, cb, 512 + hh * 128 + 8 * (tid & 15));
#pragma unroll 2
    for (int it = 0; it < 4; ++it) {
        const int item = tid + 512 * it, i = item >> 4, ch = item & 15;
        u32x4 qw = {0u, 0u, 0u, 0u}, kw = {0u, 0u, 0u, 0u}, vw = {0u, 0u, 0u, 0u};
        if (i < nvalid) {
            f32x4 o0, o1;
            conv8w(PB, cqw, b, p0 + i, hh * 128 + 8 * ch, o0, o1); qw = pack8(o0, o1);
            conv8w(PB, ckw, b, p0 + i, 512 + hh * 128 + 8 * ch, o0, o1); kw = pack8(o0 * 0.08838834764831845f, o1 * 0.08838834764831845f);
            vw = *(const u32x4*)(PB + seqrow(b, p0 + i) * NPB + 1024 + hh * 128 + 8 * ch);
        }
        *(LAS u32x4*)(Qt + i * RSTR + ch * 16) = qw; *(LAS u32x4*)(Kt + i * RSTR + ch * 16) = kw; *(LAS u32x4*)(Vt + i * TSTR + ch * 16) = vw;
    }
    __syncthreads();
    {
        const int i = tid >> 2, part = tid & 3;
        const float* np = NST + (size_t)(bh * NCH + c) * 128 + 32 * part;
        float s = 0.f;
#pragma unroll
        for (int d8 = 0; d8 < 4; ++d8) {
            const u32x4 qv = *(const LAS u32x4*)(Qt + i * RSTR + (32 * part + 8 * d8) * 2);
            const f32x4 n0 = *(const f32x4*)(np + 8 * d8), n1 = *(const f32x4*)(np + 8 * d8 + 4);
            s += bflo(qv.x) * n0[0] + bfhi(qv.x) * n0[1] + bflo(qv.y) * n0[2] + bfhi(qv.y) * n0[3] + bflo(qv.z) * n1[0] + bfhi(qv.z) * n1[1] + bflo(qv.w) * n1[2] + bfhi(qv.w) * n1[3];
        }
        s += __shfl_xor(s, 1); s += __shfl_xor(s, 2);
        if (part == 0) sqn[i] = s;
    }
    const int r = lane & 31, h = lane >> 5, g = lane >> 4, q = (lane & 15) >> 2, pp = lane & 3;
    const int qb = wid >> 1, dvh = wid & 1, t = 32 * qb + r;
    bf16x8 qf[8];
#pragma unroll
    for (int ks = 0; ks < 8; ++ks) qf[ks] = *(const LAS bf16x8*)(Qt + t * RSTR + (16 * ks + 8 * h) * 2);
    f32x16 acc[2];
#pragma unroll
    for (int d = 0; d < 2; ++d)
#pragma unroll
        for (int e = 0; e < 16; ++e) acc[d][e] = 0.f;
    {
        const bf16_t* Cp = CST + (size_t)(bh * NCH + c) * 16384;
#pragma unroll
        for (int ks = 0; ks < 8; ++ks)
#pragma unroll
            for (int d = 0; d < 2; ++d) {
                const int dv = 32 * (2 * dvh + d) + r;
                const bf16x8 cf = *(const bf16x8*)(Cp + (size_t)dv * 128 + 16 * ks + 8 * h);
                acc[d] = mfma32(cf, qf[ks], acc[d]);
            }
    }
    __syncthreads();
    const float wt = sw[t], r2 = sr2[t];
#pragma unroll
    for (int d = 0; d < 2; ++d) acc[d] = acc[d] * wt;
    float den = 0.f;
#pragma unroll 1
    for (int kb = 0; kb <= qb; ++kb) {
        f32x16 st;
#pragma unroll
        for (int e = 0; e < 16; ++e) st[e] = 0.f;
#pragma unroll
        for (int ks = 0; ks < 8; ++ks) { const bf16x8 kf = *(const LAS bf16x8*)(Kt + (32 * kb + r) * RSTR + (16 * ks + 8 * h) * 2); st = mfma32(kf, qf[ks], st); }
#pragma unroll
        for (int r4 = 0; r4 < 4; ++r4) {
            const int s0 = 32 * kb + 8 * r4 + 4 * h;
            const f32x4 gs = *(const LAS f32x4*)(sg2 + s0);
#pragma unroll
            for (int e = 0; e < 4; ++e) {
                float v = st[4 * r4 + e] * ex2(r2 + gs[e]);
                if (s0 + e > t) v = 0.f;
                den += v; st[4 * r4 + e] = v;
            }
        }
#pragma unroll
        for (int s2 = 0; s2 < 2; ++s2) {
            u32x4 pw; pw.x = pk2(st[8 * s2], st[8 * s2 + 1]); pw.y = pk2(st[8 * s2 + 2], st[8 * s2 + 3]); pw.z = pk2(st[8 * s2 + 4], st[8 * s2 + 5]); pw.w = pk2(st[8 * s2 + 6], st[8 * s2 + 7]);
            const bf16x8 pf = __builtin_bit_cast(bf16x8, pw);
#pragma unroll
            for (int d = 0; d < 2; ++d) {
                const LAS unsigned char* va = Vt + (32 * kb + 16 * s2 + 4 * h + q) * TSTR + (32 * (2 * dvh + d) + 16 * (g & 1) + 4 * pp) * 2;
                const bf16x8 vf = cat8(vtr(va), vtr(va + 8 * TSTR));
                acc[d] = mfma32(vf, pf, acc[d]);
            }
        }
    }
    den += __shfl_xor(den, 32);
    den += wt * sqn[t];
    const float inv = 1.f / fmaxf(fabsf(den), semt[t]);
    float s1 = 0.f;
#pragma unroll
    for (int d = 0; d < 2; ++d)
#pragma unroll
        for (int e = 0; e < 16; ++e) { acc[d][e] *= inv; s1 += acc[d][e]; }
    s1 += __shfl_xor(s1, 32);
    if (h == 0) sst[wid * 32 + r] = s1;
    __syncthreads();
    const float mean = (s1 + sst[(wid ^ 1) * 32 + r]) * (1.f / 128.f);
    float q2 = 0.f;
#pragma unroll
    for (int d = 0; d < 2; ++d)
#pragma unroll
        for (int e = 0; e < 16; ++e) { acc[d][e] -= mean; q2 += acc[d][e] * acc[d][e]; }
    q2 += __shfl_xor(q2, 32);
    if (h == 0) sst2[wid * 32 + r] = q2;
    __syncthreads();
    const float rstd = 1.f / sqrtf((q2 + sst2[(wid ^ 1) * 32 + r]) * (1.f / 128.f) + LN_EPS);
    if (t < nvalid) {
        const size_t row = seqrow(b, p0 + t);
#pragma unroll
        for (int d = 0; d < 2; ++d)
#pragma unroll
            for (int r4 = 0; r4 < 4; ++r4) {
                const int col = hh * 128 + 32 * (2 * dvh + d) + 8 * r4 + 4 * h;
                const u32x2 mo = *(const u32x2*)(PB + row * NPB + 1536 + col);
                const f32x4 g4 = *(const f32x4*)(mng + col);
                const float o0 = acc[d][4 * r4] * rstd * g4[0] * sigm(bflo(mo.x)), o1 = acc[d][4 * r4 + 1] * rstd * g4[1] * sigm(bfhi(mo.x));
                const float o2 = acc[d][4 * r4 + 2] * rstd * g4[2] * sigm(bflo(mo.y)), o3 = acc[d][4 * r4 + 3] * rstd * g4[3] * sigm(bfhi(mo.y));
                u32x2 w; w.x = pk2(o0, o1); w.y = pk2(o2, o3);
                *(u32x2*)(MA + row * 512 + col) = w;
            }
    }
    lds_barrier();
}

constexpr int AT_KB = 64 * RSTR, AT_VB = 64 * TSTR, AT_BUF = AT_KB + AT_VB;
__device__ __forceinline__ void attn_unit(const Params& P, int layer, int b, int hd, int pq0, int nvalid, float lam, float lam_init, LAS unsigned char* lds) {
    const int tid = tidx(), lane = tid & 63, wid = __builtin_amdgcn_readfirstlane(tid >> 6);
    const int c = wid >> 2, wq = wid & 3, r = lane & 31, h = lane >> 5, g = lane >> 4, q = (lane & 15) >> 2, pp = lane & 3;
    const bf16_t* PB = (const bf16_t*)(P.ws + WS_BIG); bf16_t* AO = (bf16_t*)(P.ws + WS_MA) + (size_t)MPAD * 512;
    const float* ang = P.in[16] + (size_t)layer * 512;
    const int qi = 32 * wq + r, qp = pq0 + qi;
    bf16x8 qf[4];
    {
        const size_t qrow = seqrow(b, qp < LSEQ ? qp : LSEQ - 1);
#pragma unroll
        for (int ks = 0; ks < 4; ++ks) qf[ks] = *(const bf16x8*)(PB + qrow * NPB + 2048 + hd * 128 + c * 64 + 16 * ks + 8 * h);
    }
    const float slope2 = ex2(-2.f * (float)(hd + 1)) * LOG2E;
    const int ntiles = (pq0 + nvalid - 1) / 64 + 1;
    float qkb;
    {
        float ss = 0.f;
#pragma unroll
        for (int ks = 0; ks < 4; ++ks)
#pragma unroll
            for (int j = 0; j < 8; ++j) { const float v = __builtin_bit_cast(float, (unsigned)(unsigned short)qf[ks][j] << 16); ss += v * v; }
        ss += __shfl_xor(ss, 32);
        const float* KM = (const float*)(P.ws + WS_KM) + layer * 72;
        const float k2 = fmaxf(KM[b * 8 + hd * 2 + c], KM[64 + hd * 2 + c]);
        qkb = sqrtf(ss) * sqrtf(k2) * 1.001f + 0.01f;
    }
    LAS unsigned* votes = (LAS unsigned*)(lds + 131072 + 2048);
    if (tid < 16) votes[tid] = 0u;
    u32x4 pk[2], pv[2];
#define AT_LOAD(kt) do { _Pragma("unroll") for (int i_ = 0; i_ < 2; ++i_) { const int row_ = (tid + 512 * i_) >> 4, ch_ = tid & 15; int kp_ = 64 * (kt) + row_; kp_ = kp_ < LSEQ ? kp_ : LSEQ - 1; \
        const bf16_t* src_ = PB + seqrow(b, kp_) * NPB + hd * 128 + ch_ * 8; pk[i_] = *(const u32x4*)(src_ + 2560); pv[i_] = *(const u32x4*)(src_ + 3072); } } while (0)
#define AT_STORE(s) do { _Pragma("unroll") for (int i_ = 0; i_ < 2; ++i_) { const int row_ = (tid + 512 * i_) >> 4, ch_ = tid & 15; \
        *(LAS u32x4*)(lds + (s) * AT_BUF + row_ * RSTR + ch_ * 16) = pk[i_]; *(LAS u32x4*)(lds + (s) * AT_BUF + AT_KB + row_ * TSTR + ch_ * 16) = pv[i_]; } } while (0)
    AT_LOAD(ntiles - 1); AT_STORE((ntiles - 1) & 1);
    __syncthreads();
    float m_run = NEGF, l_run = 0.f;
    f32x16 o[4];
#pragma unroll
    for (int d = 0; d < 4; ++d)
#pragma unroll
        for (int e = 0; e < 16; ++e) o[d][e] = 0.f;
#pragma unroll 1
    for (int kt = ntiles - 1; kt >= 0; --kt) {
        const int s = kt & 1;
        if (kt > 0) AT_LOAD(kt - 1);
        const LAS unsigned char* Kb = lds + s * AT_BUF; const LAS unsigned char* Vb = Kb + AT_KB;
        if (64 * kt <= pq0 + 32 * wq + 31) {
        f32x16 st[2];
#pragma unroll
        for (int kb2 = 0; kb2 < 2; ++kb2) {
            const float tb = slope2 * (float)(64 * kt + 32 * kb2 - pq0 + 4 * h);
#pragma unroll
            for (int e = 0; e < 16; ++e) st[kb2][e] = tb + slope2 * (float)((e & 3) + 8 * (e >> 2));
#pragma unroll
            for (int ks = 0; ks < 4; ++ks) { const bf16x8 kf = *(const LAS bf16x8*)(Kb + (32 * kb2 + r) * RSTR + (c * 64 + 16 * ks + 8 * h) * 2); st[kb2] = mfma32(kf, qf[ks], st[kb2]); }
        }
        if (64 * kt + 63 > pq0 + 32 * wq) {
#pragma unroll
            for (int kb2 = 0; kb2 < 2; ++kb2)
#pragma unroll
                for (int e = 0; e < 16; ++e) { const int kp = 64 * kt + 32 * kb2 + (e & 3) + 8 * (e >> 2) + 4 * h; if (kp > qp) st[kb2][e] = NEGF; }
        }
        float mx = st[0][0];
#pragma unroll
        for (int e = 1; e < 16; ++e) mx = fmaxf(mx, st[0][e]);
#pragma unroll
        for (int e = 0; e < 16; ++e) mx = fmaxf(mx, st[1][e]);
        mx = fmaxf(mx, __shfl_xor(mx, 32));
        if (__any(mx > m_run + 8.f)) {
            const float m_new = fmaxf(m_run, mx), alpha = ex2(m_run - m_new);
            m_run = m_new; l_run *= alpha;
#pragma unroll
            for (int d = 0; d < 4; ++d) o[d] = o[d] * alpha;
        }
        const float m_new = m_run;
        float psum = 0.f;
#pragma unroll
        for (int kb2 = 0; kb2 < 2; ++kb2)
#pragma unroll
            for (int e = 0; e < 16; ++e) { const float p = ex2(st[kb2][e] - m_new); st[kb2][e] = p; psum += p; }
        l_run += psum;
#pragma unroll
        for (int kb2 = 0; kb2 < 2; ++kb2)
#pragma unroll
            for (int s2 = 0; s2 < 2; ++s2) {
                u32x4 pw; pw.x = pk2(st[kb2][8 * s2], st[kb2][8 * s2 + 1]); pw.y = pk2(st[kb2][8 * s2 + 2], st[kb2][8 * s2 + 3]); pw.z = pk2(st[kb2][8 * s2 + 4], st[kb2][8 * s2 + 5]); pw.w = pk2(st[kb2][8 * s2 + 6], st[kb2][8 * s2 + 7]);
                const bf16x8 pf = __builtin_bit_cast(bf16x8, pw);
#pragma unroll
                for (int d = 0; d < 4; ++d) {
                    const LAS unsigned char* va = Vb + (32 * kb2 + 16 * s2 + 4 * h + q) * TSTR + (32 * d + 16 * (g & 1) + 4 * pp) * 2;
                    const bf16x8 vf = cat8(vtr(va), vtr(va + 8 * TSTR));
                    o[d] = mfma32(vf, pf, o[d]);
                }
            }
        }
        if (kt > 0) {
            const float bnd = qkb + slope2 * (float)(64 * (kt - 1) + 63 - pq0);
            const bool dn = !__any(bnd >= m_run - 44.f);
            if (lane == 0) votes[s * 8 + wid] = dn ? 1u : 0u;
            AT_STORE(s ^ 1);
        }
        __syncthreads();
        if (kt > 0) {
            const u32x4 v0 = *(const LAS u32x4*)(votes + s * 8), v1 = *(const LAS u32x4*)(votes + s * 8 + 4);
            const unsigned all = (unsigned)__builtin_amdgcn_readfirstlane((int)((v0.x & v0.y) & (v0.z & v0.w) & (v1.x & v1.y) & (v1.z & v1.w)));
            if (all) break;
        }
    }
#undef AT_LOAD
#undef AT_STORE
    const float l_tot = l_run + __shfl_xor(l_run, 32), inv = 1.f / l_tot;
    LAS float* xch = (LAS float*)lds;
    if (c == 1) {
#pragma unroll
        for (int d = 0; d < 4; ++d)
#pragma unroll
            for (int e = 0; e < 16; ++e) xch[((wq * 4 + d) * 16 + e) * 64 + lane] = o[d][e] * inv;
    }
    __syncthreads();
    if (c == 0) {
        float ss = 0.f;
#pragma unroll
        for (int d = 0; d < 4; ++d)
#pragma unroll
            for (int e = 0; e < 16; ++e) { const float v = o[d][e] * inv - lam * xch[((wq * 4 + d) * 16 + e) * 64 + lane]; o[d][e] = v; ss += v * v; }
        ss += __shfl_xor(ss, 32);
        const float rms = (1.f / sqrtf(ss * (1.f / 128.f) + LN_EPS)) * (1.f - lam_init);
        if (qi < nvalid) {
            const size_t row = seqrow(b, qp);
#pragma unroll
            for (int d = 0; d < 4; ++d)
#pragma unroll
                for (int r4 = 0; r4 < 4; ++r4) {
                    const int col = hd * 128 + 32 * d + 8 * r4 + 4 * h;
                    const f32x4 g4 = *(const f32x4*)(ang + col);
                    u32x2 w; w.x = pk2(o[d][4 * r4] * rms * g4[0], o[d][4 * r4 + 1] * rms * g4[1]); w.y = pk2(o[d][4 * r4 + 2] * rms * g4[2], o[d][4 * r4 + 3] * rms * g4[3]);
                    *(u32x2*)(AO + row * 512 + col) = w;
                }
        }
    }
    lds_barrier();
}

#define XB_TMO      128
#define XB_XCNT(j)  (256  + 64 * (j))
#define XB_XSUB(j)  (1280 + 64 * (j))
#define XB_XGEN(j)  (2304 + 64 * (j))
#define XB_TOP      3328
#define XB_TOPGEN   3392
#define XCD_BAR_WORDS 3456
#define XB_SPIN_CAP (1u << 18)

__device__ __forceinline__ unsigned xb_ld(unsigned* p)              { return __hip_atomic_load(p, __ATOMIC_RELAXED, __HIP_MEMORY_SCOPE_AGENT); }
__device__ __forceinline__ unsigned xb_add(unsigned* p, unsigned v) { return __hip_atomic_fetch_add(p, v, __ATOMIC_RELAXED, __HIP_MEMORY_SCOPE_AGENT); }
__device__ __forceinline__ unsigned xb_xcc_id() { return (unsigned)__builtin_amdgcn_s_getreg((3 << 11) | 20) & 0xFu; }
#define XB_SPIN(cond, bar) do { unsigned _sp = 0; while (cond) { __builtin_amdgcn_s_sleep(1); \
    if ((++_sp & 255u) == 0u) { if (xb_ld(&(bar)[XB_TMO])) break; if (_sp > XB_SPIN_CAP) { atomicAdd(&(bar)[XB_TMO], 1u); break; } } } } while (0)

struct XcdBarrier {
    unsigned* bar; unsigned x;
    volatile LAS unsigned* st;
};

__device__ __forceinline__ XcdBarrier xcd_barrier_post(unsigned* bar, volatile LAS unsigned* st) {
    XcdBarrier b; b.bar = bar; b.x = xb_xcc_id(); b.st = st;
    if (threadIdx.x == 0) (void)xb_add(&bar[XB_XCNT(b.x)], 1u);
    return b;
}
__device__ __forceinline__ void xcd_barrier_complete(unsigned* bar, unsigned x, unsigned& nloc, unsigned& nx) {
    const unsigned G = gridDim.x * gridDim.y * gridDim.z;
    unsigned sum, cnt, mine, sp = 0u;
    for (;;) {
        sum = 0u; cnt = 0u; mine = 0u;
#pragma unroll
        for (unsigned j = 0; j < 16; ++j) { const unsigned c = xb_ld(&bar[XB_XCNT(j)]); sum += c; cnt += (c > 0u) ? 1u : 0u; mine = (j == x) ? c : mine; }
        if (sum == G) break;
        __builtin_amdgcn_s_sleep(1);
        if ((++sp & 255u) == 0u) { if (xb_ld(&bar[XB_TMO])) break; if (sp > XB_SPIN_CAP) { atomicAdd(&bar[XB_TMO], 1u); break; } }
    }
    nloc = mine > 0u ? mine : 1u; nx = cnt > 0u ? cnt : 1u;
}

__device__ __forceinline__ void xcd_barrier(const XcdBarrier& b) {
    asm volatile("s_waitcnt vmcnt(0)" ::: "memory");
    __syncthreads();
    if (threadIdx.x == 0) {
        unsigned* bar = b.bar;
        __builtin_amdgcn_s_waitcnt(0);
        unsigned nloc = b.st[0], nx = b.st[1];
        if (nloc == 0u) { xcd_barrier_complete(bar, b.x, nloc, nx); b.st[0] = nloc; b.st[1] = nx; }
        const unsigned old = xb_add(&bar[XB_XSUB(b.x)], 1u);
        const unsigned gen = old / nloc;
        if (old + 1u == (gen + 1u) * nloc) {
            __builtin_amdgcn_fence(__ATOMIC_RELEASE, "agent");
            asm volatile("s_waitcnt vmcnt(0)" ::: "memory");
            const unsigned og = xb_add(&bar[XB_TOP], 1u);
            const unsigned tg = og / nx;
            if (og + 1u == (tg + 1u) * nx) xb_add(&bar[XB_TOPGEN], 1u);
            else XB_SPIN(xb_ld(&bar[XB_TOPGEN]) == tg, bar);
            __builtin_amdgcn_fence(__ATOMIC_ACQUIRE, "agent");
            xb_add(&bar[XB_XGEN(b.x)], 1u);
            asm volatile("s_waitcnt vmcnt(0)" ::: "memory");
        } else {
            XB_SPIN(xb_ld(&bar[XB_XGEN(b.x)]) == gen, bar);
            __builtin_amdgcn_fence(__ATOMIC_ACQUIRE, "agent");
            asm volatile("s_waitcnt vmcnt(0)" ::: "memory");
        }
    }
    __syncthreads();
}

#ifndef PROBE_ATT
#define PROBE_ATT 1
#endif
#ifndef PROBE_M3
#define PROBE_M3 1
#endif
constexpr int LDS_BYTES = 147456;
#ifndef PROG_LAYER
#define PROG_LAYER(L) 16*L+0, 16*L+1, 16*L+3, 16*L+4, 16*L+5, 16*L+6, 16*L+7, 16*L+8, 16*L+9, 16*L+11, 16*L+12
#endif
__device__ const unsigned char PROG[] = { PROG_LAYER(0), PROG_LAYER(1), 16 * 1 + 13 };
constexpr int NSTEP = 14;
__global__ void __launch_bounds__(512) hybrid_fwd(Params P) {
    extern __shared__ __attribute__((aligned(16))) unsigned char smem[];
    LAS unsigned char* lds = (LAS unsigned char*)smem;
    cg::grid_group grid = cg::this_grid();
    unsigned* barw = (unsigned*)(P.ws + WS_BAR);
    volatile LAS unsigned* bst = (volatile LAS unsigned*)(lds + 131072 + 1024);
    if (blockIdx.x == 0) for (int i = threadIdx.x; i < XCD_BAR_WORDS; i += 512) __hip_atomic_store(barw + i, 0u, __ATOMIC_RELAXED, __HIP_MEMORY_SCOPE_AGENT);
    if (blockIdx.x == 0 && threadIdx.x < 144) __hip_atomic_store((unsigned*)(P.ws + WS_KM) + threadIdx.x, 0u, __ATOMIC_RELAXED, __HIP_MEMORY_SCOPE_AGENT);
    if (threadIdx.x < 2) bst[threadIdx.x] = 0u;
    __syncthreads();

#ifndef PROBE_P0
#define PROBE_P0 1
#endif
#pragma unroll 1
    for (int rep0_ = 0; rep0_ < PROBE_P0; ++rep0_)
    {
        const int lane = tidx() & 63, wid = tidx() >> 6, gw = bidx() * 8 + wid, NGW = gridDim.x * 8;
        bf16_t* HB = (bf16_t*)(P.ws + WS_HB); float* HFM = (float*)(P.ws + WS_HFM);
        LAS float* scr = (LAS float*)(lds + wid * 16384);
        for (int it = gw; it < 2 * CW_ITEMS; it += NGW) conv_weight_item(P, it / CW_ITEMS, it % CW_ITEMS, scr, lane);
        const float* x = P.in[0]; const float* meta = P.in[1];
        {
            const size_t NT8 = (size_t)gridDim.x * 512, n8 = (size_t)MREAL * DM / 8;
#pragma unroll 4
            for (size_t i = (size_t)bidx() * 512 + tidx(); i < n8; i += NT8) {
                const f32x4 v0 = *(const f32x4*)(x + i * 8), v1 = *(const f32x4*)(x + i * 8 + 4);
                *(u32x4*)(HB + i * 8) = pack8(v0, v1);
            }
        }
        for (int row = gw; row < NMETA; row += NGW) {
#pragma unroll
            for (int j = 0; j < 4; ++j) {
                const f32x4 v = *(const f32x4*)(meta + (size_t)row * DM + 256 * j + 4 * lane);
                *(f32x4*)(HFM + (size_t)row * DM + 256 * j + 4 * lane) = v;
                u32x2 w; w.x = pk2(v[0], v[1]); w.y = pk2(v[2], v[3]);
                *(u32x2*)(HB + (size_t)(MROW0 + row) * DM + 256 * j + 4 * lane) = w;
            }
        }
    }
    grid.sync();
    (void)xcd_barrier_post(barw, bst);

#pragma unroll 1
    for (int ph = 0; ph < (int)sizeof(PROG); ++ph) {
        const int layer = PROG[ph] >> 4, step = PROG[ph] & 15;
        const int G = gridDim.x;
#define TIDV const int tid_ = tidx(), lane = tid_ & 63, wid = __builtin_amdgcn_readfirstlane(tid_ >> 6); (void)lane; (void)wid;
        bf16_t* HB = (bf16_t*)(P.ws + WS_HB); float* HFM = (float*)(P.ws + WS_HFM);
        bf16_t* BIG = (bf16_t*)(P.ws + WS_BIG); bf16_t* MA = (bf16_t*)(P.ws + WS_MA);
        const bf16_t* Wl = (const bf16_t*)(P.ws + WS_W) + (size_t)layer * OW_LAYER;
#define LNCTX float* ROWS = (float*)(P.ws + WS_ROWS); const float* CSl = (const float*)(P.ws + WS_CSBW) + (size_t)layer * 2 * OC_N; const float* BWl = CSl + OC_N; \
        const int tlast = 3 * layer + (step <= 1 ? -1 : step <= 9 ? 0 : step <= 12 ? 1 : 2);   \
        const float* rows_last = ROWS + (size_t)((tlast & 1) * MPAD) * 2; (void)CSl; (void)BWl; (void)rows_last;
        if (step == 0 || step == 3 || step == 11) {
            LNCTX
            float* z = ROWS + (size_t)(((tlast + 1) & 1) * MPAD) * 2;
            for (int i = bidx() * 512 + tidx(); i < MPAD * 2 / 4; i += G * 512) *(f32x4*)(z + 4 * i) = (f32x4){0.f, 0.f, 0.f, 0.f};
        }
        if (step == 0 || step == 11) {
            LNCTX
            const bf16_t* Wgu = Wl + (step ? OW_GU2 : OW_GU1); const int oc = step ? OC_GU2 : OC_GU1;
            const pg8::LnFix fx{rows_last, CSl + oc, BWl + oc, tlast >= 0 ? 1 : 0};
            pg8::Gemm gm{HB, Wgu, MREAL, 2 * FF, DM}; pg8::StaticOrder S; S.init(MREAL, 2 * FF, G, bidx());
            pg8::EpiSwiglu E{BIG, FF, fx};
            pg8::gemm_phase<pg8::EpiSwiglu, pg8::StaticOrder, true, true>(lds, gm, S, E);
            for (int ct = bidx(); ct < FF / 16; ct += G) {
                TIDV
                const int c0 = 16 * ct, R0 = 256 * (c0 >> 7) + (c0 & 127);
                const f32x4 ag = sg_tile_blk(HB + (size_t)MROW0 * DM, DM, Wgu, DM, R0, lane, wid, (LAS float*)lds), au = sg_tile_blk(HB + (size_t)MROW0 * DM, DM, Wgu, DM, R0 + 128, lane, wid, (LAS float*)lds);
                if (wid == 0) {
                    const int rb = R0 + (lane & 15);
#pragma unroll
                    for (int e = 0; e < 4; ++e) {
                        const size_t row = (size_t)(MROW0 + 4 * (lane >> 4) + e);
                        float gv = ag[e], uv = au[e];
                        if (fx.on) { float mu, r; fx.stats(row, mu, r); gv = (gv - fx.cs[rb] * mu) * r + fx.bw[rb]; uv = (uv - fx.cs[rb + 128] * mu) * r + fx.bw[rb + 128]; }
                        BIG[row * FF + c0 + (lane & 15)] = (bf16_t)f2bf(siluf(gv) * uv);
                    }
                }
            }
        } else if (step == 1 || step == 9 || step == 12) {
            LNCTX
            const bf16_t* A = step == 9 ? MA : BIG; const bf16_t* Bt = Wl + (step == 1 ? OW_D1 : step == 9 ? OW_OUT : OW_D2);
            const int K = step == 9 ? DM : FF; const float sc = step == 9 ? 1.f : 0.5f;
            pg8::Gemm gm{A, Bt, MREAL, DM, K}; pg8::StaticOrder S; S.init(MREAL, DM, G, bidx());
            const int raw = tlast < 0 ? 1 : 0;
            const int gi = step == 1 ? (layer == 0 ? 5 : 26) : step == 9 ? 5 : 21;
            const int gl = step == 1 ? (layer == 0 ? 0 : layer - 1) : layer;
            const float* gam = P.in[gi] + (size_t)gl * DM; const float* bet = P.in[gi + 1] + (size_t)gl * DM;
            float* rows_cur = ROWS + (size_t)(((tlast + 1) & 1) * MPAD) * 2;
            pg8::EpiResid E{P.in[0], (bf16_t*)(P.ws + WS_LO), HB, rows_last, rows_cur, gam, bet, sc, raw};
            pg8::gemm_phase<pg8::EpiResid, pg8::StaticOrder, true, true>(lds, gm, S, E);
            for (int ct = bidx(); ct < 64; ct += G) {
                TIDV
                const f32x4 a = sg_tile_blk(A + (size_t)MROW0 * K, K, Bt, K, 16 * ct, lane, wid, (LAS float*)lds);
                const int col = 16 * ct + (lane & 15);
                if (wid == 0) {
#pragma unroll
                    for (int e = 0; e < 4; ++e) {
                        const int mr = 4 * (lane >> 4) + e; float* p = HFM + (size_t)mr * DM + col;
                        float h = *p;
                        if (!raw) { const float s1 = rows_last[(size_t)(MROW0 + mr) * 2], s2 = rows_last[(size_t)(MROW0 + mr) * 2 + 1], mu = s1 * (1.f / DM), r = __builtin_amdgcn_rsqf(s2 * (1.f / DM) - mu * mu + LN_EPS);
                            h = (h - mu) * r * gam[col] + bet[col]; }
                        const float y = ALPHA * h + sc * a[e];
                        *p = y; HB[(size_t)(MROW0 + mr) * DM + col] = (bf16_t)f2bf(y);
                        float q1 = y, q2 = y * y;
                        q1 += __shfl_xor(q1, 1); q1 += __shfl_xor(q1, 2); q1 += __shfl_xor(q1, 4); q1 += __shfl_xor(q1, 8);
                        q2 += __shfl_xor(q2, 1); q2 += __shfl_xor(q2, 2); q2 += __shfl_xor(q2, 4); q2 += __shfl_xor(q2, 8);
                        if ((lane & 15) == 0) { atomicAdd(rows_cur + (size_t)(MROW0 + mr) * 2, q1); atomicAdd(rows_cur + (size_t)(MROW0 + mr) * 2 + 1, q2); }
                    }
                }
            }
        } else if (step == 13) {
            ln_phase(P, P.in[26] + (size_t)layer * DM, P.in[27] + (size_t)layer * DM, false, true, nullptr, nullptr, lds);
        } else if (step == 3 || step == 7) {
            LNCTX
            const int ng = step == 3 ? 1 : 2;
            float* GT = (float*)(P.ws + WS_GATES); const float* bif = P.in[10] + (size_t)layer * 8;
#pragma unroll 1
            for (int gi = 0; gi < ng; ++gi) {
                const bf16_t* A = step == 3 ? HB : MA + (size_t)gi * MPAD * 512;
                const bf16_t* Bt = Wl + (step == 3 ? OW_PB : gi ? OW_BA : OW_BM);
                const int N = step == 3 ? NPBW : DM, K = step == 3 ? DM : 512, ldc = step == 3 ? NPB : 2048, coff = gi * DM;
                const pg8::LnFix fx{rows_last, CSl + OC_PB, BWl + OC_PB, step == 3 ? 1 : 0};
                pg8::Gemm gm{A, Bt, MREAL, N, K}; pg8::StaticOrder S; S.init(MREAL, N, G, bidx());
                pg8::EpiPlain E{BIG, ldc, coff, step == 3 ? 8 : 0, step == 3 ? 10 : 0, QSCALE, fx, step == 3 ? GT : nullptr, bif};
                pg8::gemm_phase<pg8::EpiPlain, pg8::StaticOrder, true, true>(lds, gm, S, E);
                const int ntile = step == 3 ? NPB / 16 + 1 : N / 16;
                for (int ct = bidx(); ct < ntile; ct += G) {
                    TIDV
                    const f32x4 a = sg_tile_blk(A + (size_t)MROW0 * K, K, Bt, K, 16 * ct, lane, wid, (LAS float*)lds);
                    const float sc = (step == 3 && 16 * ct >= 2048 && 16 * ct < 2560) ? QSCALE : 1.f;
                    if (wid == 0) {
                        const int rb = 16 * ct + (lane & 15);
#pragma unroll
                        for (int e = 0; e < 4; ++e) {
                            const size_t row = (size_t)(MROW0 + 4 * (lane >> 4) + e);
                            float v = a[e];
                            if (fx.on) { float mu, r; fx.stats(row, mu, r); v = (v - fx.cs[rb] * mu) * r + fx.bw[rb]; }
                            if (step == 3 && ct == NPB / 16) {
                                if ((lane & 15) < 8) { const float z = v + bif[lane & 15]; GT[row * 8 + (lane & 15)] = (lane & 15) < 4 ? z : fminf(z, 0.f) - __logf(1.f + __expf(-fabsf(z))); }
                            } else BIG[row * ldc + coff + rb] = (bf16_t)f2bf(v * sc);
                        }
                    }
                }
            }
        } else if (step == 4) {
            {
                float* KM = (float*)(P.ws + WS_KM) + layer * 72;
                TIDV
                const int gw = bidx() * 8 + wid, NGW = G * 8;
#pragma unroll 1
                for (int task = gw; task < 2049; task += NGW) {
                    const int real = task < 2048, slot = real ? task >> 8 : 8, nr = real ? 32 : NMETA;
                    const size_t r0 = real ? (size_t)(task >> 8) * SEQ + (size_t)(task & 255) * 32 : (size_t)MROW0;
                    float mxv = 0.f;
#pragma unroll 4
                    for (int i = 0; i < nr; ++i) {
                        const u32x4 v = *(const u32x4*)(BIG + (r0 + i) * NPB + 2560 + lane * 8);
                        float ss = bflo(v.x) * bflo(v.x) + bfhi(v.x) * bfhi(v.x) + bflo(v.y) * bflo(v.y) + bfhi(v.y) * bfhi(v.y) + bflo(v.z) * bflo(v.z) + bfhi(v.z) * bfhi(v.z) + bflo(v.w) * bflo(v.w) + bfhi(v.w) * bfhi(v.w);
                        ss += __shfl_xor(ss, 1); ss += __shfl_xor(ss, 2); ss += __shfl_xor(ss, 4);
                        mxv = fmaxf(mxv, ss);
                    }
                    if ((lane & 7) == 0) atomicMax((unsigned*)KM + slot * 8 + (lane >> 3), __builtin_bit_cast(unsigned, mxv));
                }
            }
            for (int u = bidx(); u < 2048 + 4; u += G) { const int bh_ = u < 2048 ? u >> 6 : u - 2048, c_ = u < 2048 ? 1 + (u & 63) : 0; m1_unit(P, layer, bh_, c_, lds); }
        } else if (step == 5) {
            m2_phase(P);
        } else if (step == 6) {
            const float lam_init = layer == 0 ? 0.2f : 0.35550906759f;
            float lam;
            {
                TIDV
                const float* l1 = P.in[12] + layer * 64; const float* k1 = P.in[13] + layer * 64; const float* l2 = P.in[14] + layer * 64; const float* k2 = P.in[15] + layer * 64;
                const float s1 = wave_sum(l1[lane] * k1[lane]), s2 = wave_sum(l2[lane] * k2[lane]);
                lam = expf(s1) - expf(s2) + lam_init;
            }
#pragma unroll 1
            for (int rep_ = 0; rep_ < PROBE_ATT; ++rep_)
#pragma unroll 1
            for (int u = bidx(); u < 2048 + 4; u += G) {
                const int cbv = u & 255, i = u >> 8, jj = cbv & 31, j = (i & 4) ? 63 - jj : jj;
                const bool real = u < 2048; const int bh = real ? ((cbv >> 5) * 4 + (i & 3)) : (u - 2048);
                attn_unit(P, layer, bh >> 2, bh & 3, real ? NMETA + 128 * j : 0, real ? 128 : NMETA, lam, lam_init, lds);
            }
#pragma unroll 1
            for (int rep_ = 0; rep_ < PROBE_M3; ++rep_)
#pragma unroll 1
            for (int u = bidx(); u < 2048 + 4; u += G) { const int bh_ = u < 2048 ? u >> 6 : u - 2048, c_ = u < 2048 ? 1 + (u & 63) : 0; m3_unit(P, layer, bh_, c_, lds); }
        } else if (step == 8) {
            const bf16_t* Y = BIG; const float* bg = P.in[19] + (size_t)layer * 2048;
            pg8::Gemm gm{HB, Wl + OW_GM, MREAL, 2048, DM}; pg8::StaticOrder S; S.init(MREAL, 2048, G, bidx());
            LNCTX
            const pg8::LnFix fx{rows_last, CSl + OC_GM, BWl + OC_GM, 1};
            pg8::EpiGate E{MA, Y, bg, fx};
            pg8::gemm_phase<pg8::EpiGate, pg8::StaticOrder, true, true>(lds, gm, S, E);
            for (int ct = bidx(); ct < 64; ct += G) {
                TIDV
                const int c0 = 16 * ct, R0 = 256 * (c0 >> 7) + (c0 & 127);
                const f32x4 am = sg_tile_blk(HB + (size_t)MROW0 * DM, DM, Wl + OW_GM, DM, R0, lane, wid, (LAS float*)lds), aa = sg_tile_blk(HB + (size_t)MROW0 * DM, DM, Wl + OW_GM, DM, R0 + 128, lane, wid, (LAS float*)lds);
                const int col = c0 + (lane & 15), rb = R0 + (lane & 15);
                if (wid == 0) {
#pragma unroll
                    for (int e = 0; e < 4; ++e) {
                        const size_t row = (size_t)(MROW0 + 4 * (lane >> 4) + e);
                        float mu, r; fx.stats(row, mu, r);
                        const float gmv = (am[e] - fx.cs[rb] * mu) * r + fx.bw[rb], gav = (aa[e] - fx.cs[rb + 128] * mu) * r + fx.bw[rb + 128];
                        const float ym = bflo((unsigned)Y[row * 2048 + col]), ya = bflo((unsigned)Y[row * 2048 + DM + col]);
                        MA[row * DM + col] = (bf16_t)f2bf(sigm(gmv) * ym + sigm(gav) * ya);
                    }
                }
            }
        }
        {
            unsigned char* wsb = P.ws; asm volatile("" : "+s"(wsb));
            XcdBarrier xb; xb.bar = (unsigned*)(wsb + WS_BAR); xb.x = xb_xcc_id(); xb.st = (volatile LAS unsigned*)(lds + 131072 + 1024);
            xcd_barrier(xb);
#ifdef PROBE_SYNC
            for (int i_ = 0; i_ < PROBE_SYNC; ++i_) xcd_barrier(xb);
#endif
        }
    }
}

extern "C" void kernel_launch(void* const* d_in, const int* in_sizes, int n_in, void* d_out, int out_size, void* d_ws, size_t ws_size, hipStream_t stream) {
    static int grid = 0;
    if (grid == 0) {
        if (n_in != 28 || out_size != MREAL * DM || ws_size < WS_END) { fprintf(stderr, "kernel_launch: unexpected shapes (n_in %d out %d ws %zu)\n", n_in, out_size, ws_size); grid = -1; return; }
        int dev = 0, cus = 0, per_cu = 0;
        hipGetDevice(&dev); hipDeviceGetAttribute(&cus, hipDeviceAttributeMultiprocessorCount, dev);
        hipFuncSetAttribute((const void*)hybrid_fwd, hipFuncAttributeMaxDynamicSharedMemorySize, LDS_BYTES);
        hipOccupancyMaxActiveBlocksPerMultiprocessor(&per_cu, (const void*)hybrid_fwd, 512, LDS_BYTES);
        if (per_cu < 1) per_cu = 1;
        grid = cus * per_cu;
        (void)hipGetLastError();
    }
    if (grid < 0) return;
    Params p{};
    for (int i = 0; i < 28; ++i) p.in[i] = (const float*)d_in[i];
    p.out = (float*)d_out; p.ws = (unsigned char*)d_ws;
    void* args[] = {&p};
    hipError_t e = hipLaunchCooperativeKernel((const void*)hybrid_fwd, dim3(grid), dim3(512), args, LDS_BYTES, stream);
    if (e != hipSuccess) fprintf(stderr, "cooperative launch failed: %s (grid %d)\n", hipGetErrorString(e), grid);
}
```

```cpp
#include <hip/hip_runtime.h>
#include <hip/hip_cooperative_groups.h>
#include <cstdio>
#include <cstdint>
namespace cg = cooperative_groups;

__device__ __forceinline__ int tidx() { int t = threadIdx.x; asm volatile("" : "+v"(t)); return t; }
__device__ __forceinline__ int bidx() { int t = blockIdx.x; asm volatile("" : "+s"(t)); return t; }
namespace pg8 {
#define PG8_LAS __attribute__((address_space(3)))
typedef unsigned short bf16_t;
typedef short bf16x8 __attribute__((ext_vector_type(8)));
typedef float f32x4 __attribute__((ext_vector_type(4)));
typedef unsigned u32x4 __attribute__((ext_vector_type(4)));
constexpr int BM = 256, BK = 64, HALF = 128, HTB = HALF * BK * 2  , STAGE_BYTES = 8 * HTB, NXCD = 8, WGM = 8;

__host__ __device__ __forceinline__ int lds_byte(int r, int c) { const int st = (r >> 4) * 2 + (c >> 5), rr = r & 15, cc = c & 31, ob = rr * 64 + cc * 2; return st * 1024 + (ob ^ (((ob >> 9) & 1) << 5)); }
__host__ __device__ __forceinline__ void stage_rc(int b, int& R, int& C) { const int st = b / 1024, sb = b % 1024, swz = sb ^ (((sb >> 9) & 1) << 5); R = (st >> 1) * 16 + swz / 64; C = (st & 1) * 32 + (swz % 64) / 2; }
__host__ __device__ __forceinline__ int perm32(int rho) { const int n = rho >> 4, i = rho & 15; return 8 * (i >> 2) + 4 * n + (i & 3); }

struct Unit { int pm, pn; };
struct Gemm { const bf16_t* A; const bf16_t* Bt; int M, N, K; };

struct StaticOrder {
    int nM, nN, nwg, G, c;
    __host__ __device__ void init(int M, int N, int G_, int c_) { nM = M / BM; nN = N / BM; nwg = nM * nN; G = G_; c = c_; }
    __host__ __device__ bool next(int i, Unit& u) const {
        const long L = (long)i * G + c; if (L >= nwg) return false;
        int wgid = (int)L; { const int q = nwg / NXCD, r = nwg % NXCD, xcd = wgid % NXCD, off = wgid / NXCD; wgid = (xcd < r ? xcd * (q + 1) : r * (q + 1) + (xcd - r) * q) + off; }
        const int nig = WGM * nN, gid = wgid / nig, fm = gid * WGM, gsz = (nM - fm) < WGM ? (nM - fm) : WGM;
        u.pm = fm + ((wgid % nig) % gsz); u.pn = (wgid % nig) / gsz; return true;
    }
    __device__ __forceinline__ void a_ready(const Unit&) const {}
    __device__ __forceinline__ void done(const Unit&) const {}
};

__device__ __forceinline__ unsigned cvt_pk_bf16(float lo, float hi) { unsigned r; asm volatile("v_cvt_pk_bf16_f32 %0, %1, %2" : "=v"(r) : "v"(lo), "v"(hi)); return r; }
typedef float f32x2 __attribute__((ext_vector_type(2)));
__device__ __forceinline__ f32x2 gelu_pk(f32x2 v) {
    const f32x2 av = __builtin_elementwise_abs(v), d = av * 0.2316418882f + 1.0f;
    f32x2 t; t.x = __builtin_amdgcn_rcpf(d.x); t.y = __builtin_amdgcn_rcpf(d.y);
    f32x2 q = t * 0.5307027145f + (-0.7265760135f); q = q * t + 0.7107068705f; q = q * t + (-0.142248368f); q = q * t + 0.127414796f; q = q * t;
    const f32x2 s = (v * v) * (-0.72134752044f);
    f32x2 e; e.x = __builtin_amdgcn_exp2f(s.x); e.y = __builtin_amdgcn_exp2f(s.y);
    const f32x2 m = v * (q * e), r = v - m;
    f32x2 o; o.x = v.x < 0.f ? m.x : r.x; o.y = v.y < 0.f ? m.y : r.y; return o;
}

template <int ACT  > struct EpiBf16 {
    static constexpr bool PERM = true, AFTER_DRAIN = false; static_assert(ACT == 0 || ACT == 1, "EpiBf16: ACT is 0 (none) or 1 (gelu_pk)");
    bf16_t* O; int ldc; const float* bias; int split_cols; size_t split_stride; float scale0;
    __device__ __forceinline__ void operator()(const f32x4 (&acc)[2][2][4][2], const Unit& u, int wr, int wc, int fr, int fq) const {
        const int row0 = u.pm * BM + wr * 64 + fr; int colt = u.pn * BM; bf16_t* base = O;
        float sc = 1.f; if (split_cols) { const int t = colt / split_cols; base += (size_t)t * split_stride; colt -= t * split_cols; if (t == 0) sc = scale0; }
        const int col0 = colt + wc * 32 + 8 * fq, bcol0 = u.pn * BM + wc * 32 + 8 * fq;
        f32x4 bv[2][2];
#pragma unroll
        for (int bj = 0; bj < 2; ++bj)
#pragma unroll
            for (int n = 0; n < 2; ++n) bv[bj][n] = bias ? *(const f32x4*)(bias + bcol0 + bj * HALF + 4 * n) : (f32x4){0.f, 0.f, 0.f, 0.f};
#pragma unroll
        for (int ai = 0; ai < 2; ++ai)
#pragma unroll
            for (int m = 0; m < 4; ++m) { bf16_t* rowp = base + (size_t)(row0 + ai * HALF + m * 16) * ldc + col0;
#pragma unroll
                for (int bj = 0; bj < 2; ++bj) { f32x4 v0 = acc[ai][bj][m][0] + bv[bj][0], v1 = acc[ai][bj][m][1] + bv[bj][1];
                    if (ACT == 1) { f32x2 a = gelu_pk((f32x2){v0[0], v0[1]}), b = gelu_pk((f32x2){v0[2], v0[3]}), c = gelu_pk((f32x2){v1[0], v1[1]}), d = gelu_pk((f32x2){v1[2], v1[3]});
                        v0 = (f32x4){a.x, a.y, b.x, b.y}; v1 = (f32x4){c.x, c.y, d.x, d.y}; }
                    v0 = v0 * sc; v1 = v1 * sc; u32x4 w; w.x = cvt_pk_bf16(v0[0], v0[1]); w.y = cvt_pk_bf16(v0[2], v0[3]); w.z = cvt_pk_bf16(v1[0], v1[1]); w.w = cvt_pk_bf16(v1[2], v1[3]);
                    *(u32x4*)(rowp + bj * HALF) = w; } }
    }
};

struct PanelStats {
    unsigned* xbuf;
    unsigned* cnt;
    unsigned* tmo;
    int ntn; float eps;
    unsigned code;
    __device__ __forceinline__ bool run(const f32x4 (&v)[2][2][4][2], const Unit& u, int wr, int wc, int fr, int fq, PG8_LAS unsigned char* lds, int wid, int lane) const {
        typedef float f32x2v __attribute__((ext_vector_type(2)));
        PG8_LAS f32x2v* P = (PG8_LAS f32x2v*)lds;
        PG8_LAS f32x2v* S = (PG8_LAS f32x2v*)(lds + 8192);
        PG8_LAS unsigned* flag = (PG8_LAS unsigned*)(lds + 8192 + 2048);
#pragma unroll
        for (int ai = 0; ai < 2; ++ai)
#pragma unroll
            for (int m = 0; m < 4; ++m) {
                float s = 0.f;
#pragma unroll
                for (int bj = 0; bj < 2; ++bj)
#pragma unroll
                    for (int n = 0; n < 2; ++n) { const f32x4 x = v[ai][bj][m][n]; s += (x[0] + x[1]) + (x[2] + x[3]); }
                s += __shfl_xor(s, 16); s += __shfl_xor(s, 32);
                const float mw = s * (1.0f / 64.0f); float q = 0.f;
#pragma unroll
                for (int bj = 0; bj < 2; ++bj)
#pragma unroll
                    for (int n = 0; n < 2; ++n) { const f32x4 d = v[ai][bj][m][n] - mw; q += (d[0] * d[0] + d[1] * d[1]) + (d[2] * d[2] + d[3] * d[3]); }
                q += __shfl_xor(q, 16); q += __shfl_xor(q, 32);
                if (fq == 0) P[(ai * HALF + wr * 64 + m * 16 + fr) * 4 + wc] = (f32x2v){mw, q};
            }
        asm volatile("s_waitcnt lgkmcnt(0)" ::: "memory"); __builtin_amdgcn_s_barrier(); asm volatile("" ::: "memory");
#if defined(BROKEN_EXCHANGE_NO_WAIT)
#warning BROKEN CONTROL BUILD: the row-statistics exchange does not wait; results are wrong by design
        if (blockIdx.x >= 64) { const long long t0_ = clock64(); while (clock64() - t0_ < 60000) __builtin_amdgcn_s_sleep(8); }
#endif
        const int row = wid * 32 + (lane & 31);
        if (lane < 32) {
            const f32x2v a = P[row * 4 + 0], b = P[row * 4 + 1], c = P[row * 4 + 2], d = P[row * 4 + 3];
            const float mt = (a.x + b.x + c.x + d.x) * 0.25f;
            const float da = a.x - mt, db = b.x - mt, dc = c.x - mt, dd = d.x - mt;
            const float m2 = (a.y + b.y) + (c.y + d.y) + 64.0f * ((da * da + db * db) + (dc * dc + dd * dd));
            unsigned long long* slot = (unsigned long long*)xbuf + ((size_t)(u.pm * BM + row) * 4 + u.pn);
            __hip_atomic_store(slot, ((unsigned long long)__float_as_uint(m2) << 32) | __float_as_uint(mt), __ATOMIC_RELAXED, __HIP_MEMORY_SCOPE_AGENT);
        }
        asm volatile("s_waitcnt vmcnt(0)" ::: "memory");
        if (lane == 0) __hip_atomic_fetch_add(cnt + 64 * u.pm, 1u, __ATOMIC_RELAXED, __HIP_MEMORY_SCOPE_AGENT);
        if (wid == 0) {
            bool dead = false; const unsigned long long t0 = __builtin_amdgcn_s_memrealtime(); const unsigned want = 8u * (unsigned)ntn;
            for (;;) {
#if defined(BROKEN_EXCHANGE_NO_WAIT)
                break;
#endif
                if ((unsigned)__builtin_amdgcn_readfirstlane(__hip_atomic_load(cnt + 64 * u.pm, __ATOMIC_RELAXED, __HIP_MEMORY_SCOPE_AGENT)) >= want) break;
                if (__builtin_amdgcn_s_memrealtime() - t0 > 2000000ull) {
                    if (lane == 0) { unsigned expect = 0u; __hip_atomic_compare_exchange_strong(tmo + 1, &expect, code | (unsigned)(u.pm & 0xff), __ATOMIC_RELAXED, __ATOMIC_RELAXED, __HIP_MEMORY_SCOPE_AGENT);
                                     __hip_atomic_store(tmo, 1u, __ATOMIC_RELAXED, __HIP_MEMORY_SCOPE_AGENT); }
                    dead = true; break; }
                __builtin_amdgcn_s_sleep(2);
            }
            __builtin_amdgcn_fence(__ATOMIC_ACQUIRE, "agent");
            if (lane == 0) flag[0] = dead ? 1u : 0u;
        }
        asm volatile("s_waitcnt vmcnt(0) lgkmcnt(0)" ::: "memory"); __builtin_amdgcn_s_barrier(); asm volatile("" ::: "memory");
        const bool bad = flag[0] != 0u;
        if (lane < 32) {
            const unsigned long long* slot = (const unsigned long long*)xbuf + (size_t)(u.pm * BM + row) * 4; float mt[4], m2[4]; float ms = 0.f;
#pragma unroll
            for (int t = 0; t < 4; ++t) { if (t < ntn) { const unsigned long long w = __hip_atomic_load(slot + t, __ATOMIC_RELAXED, __HIP_MEMORY_SCOPE_AGENT); mt[t] = __uint_as_float((unsigned)w); m2[t] = __uint_as_float((unsigned)(w >> 32)); } else { mt[t] = 0.f; m2[t] = 0.f; } ms += mt[t]; }
            const float mean = ms / (float)ntn; float q = 0.f;
#pragma unroll
            for (int t = 0; t < 4; ++t) if (t < ntn) { const float dm = mt[t] - mean; q += m2[t] + 256.0f * dm * dm; }
            S[row] = (f32x2v){mean, 1.0f / sqrtf(q / (256.0f * (float)ntn) + eps)};
        }
        asm volatile("s_waitcnt lgkmcnt(0)" ::: "memory"); __builtin_amdgcn_s_barrier(); asm volatile("" ::: "memory");
        return bad;
    }
};
struct EpiLnRes {
    static constexpr bool PERM = false, AFTER_DRAIN = true;
    const float* base; float* out; int ldc; const float* bias; PanelStats st; unsigned poison;
    __device__ __forceinline__ void fused(f32x4 (&acc)[2][2][4][2], const Unit& u, int wr, int wc, int fr, int fq, PG8_LAS unsigned char* lds, int wid, int lane) const {
        typedef float f32x2v __attribute__((ext_vector_type(2)));
        const PG8_LAS f32x2v* S = (const PG8_LAS f32x2v*)(lds + 8192);
        const int col0 = u.pn * BM + wc * 32 + 4 * fq;
#pragma unroll
        for (int bj = 0; bj < 2; ++bj)
#pragma unroll
            for (int n = 0; n < 2; ++n) { const f32x4 bv = bias ? *(const f32x4*)(bias + col0 + bj * HALF + n * 16) : (f32x4){0.f, 0.f, 0.f, 0.f};
#pragma unroll
                for (int ai = 0; ai < 2; ++ai)
#pragma unroll
                    for (int m = 0; m < 4; ++m) acc[ai][bj][m][n] += bv; }
        f32x4 pre[4][2][2];
#pragma unroll
        for (int m = 0; m < 4; ++m) { const size_t off = (size_t)(u.pm * BM + wr * 64 + m * 16 + fr) * ldc + col0;
#pragma unroll
            for (int bj = 0; bj < 2; ++bj)
#pragma unroll
                for (int n = 0; n < 2; ++n) pre[m][bj][n] = *(const f32x4*)(base + off + bj * HALF + n * 16); }
        const bool bad = st.run(acc, u, wr, wc, fr, fq, lds, wid, lane) || poison != 0u;
        const float qnan = __builtin_nanf("");
#pragma unroll
        for (int ai = 0; ai < 2; ++ai)
#pragma unroll
            for (int m = 0; m < 4; ++m) { const int r = ai * HALF + wr * 64 + m * 16 + fr; const f32x2v sr = S[r]; const size_t off = (size_t)(u.pm * BM + r) * ldc + col0;
#pragma unroll
                for (int bj = 0; bj < 2; ++bj)
#pragma unroll
                    for (int n = 0; n < 2; ++n) { const f32x4 bs = ai == 0 ? pre[m][bj][n] : *(const f32x4*)(base + off + bj * HALF + n * 16); f32x4 o = bs + (acc[ai][bj][m][n] - sr.x) * sr.y;
                        if (bad) o = (f32x4){qnan, qnan, qnan, qnan}; *(f32x4*)(out + off + bj * HALF + n * 16) = o; }
                if (m & 1) asm volatile("" ::: "memory"); }
    }
};
struct EpiLnResLn {
    static constexpr bool PERM = false, AFTER_DRAIN = true;
    const float* base; float* out; bf16_t* xn; int ldc; const float* bias; PanelStats st1, st2; unsigned poison;
    __device__ __forceinline__ void fused(f32x4 (&acc)[2][2][4][2], const Unit& u, int wr, int wc, int fr, int fq, PG8_LAS unsigned char* lds, int wid, int lane) const {
        typedef float f32x2v __attribute__((ext_vector_type(2))); typedef unsigned u32x2v __attribute__((ext_vector_type(2)));
        const PG8_LAS f32x2v* S = (const PG8_LAS f32x2v*)(lds + 8192);
        const int col0 = u.pn * BM + wc * 32 + 4 * fq;
#pragma unroll
        for (int bj = 0; bj < 2; ++bj)
#pragma unroll
            for (int n = 0; n < 2; ++n) { const f32x4 bv = bias ? *(const f32x4*)(bias + col0 + bj * HALF + n * 16) : (f32x4){0.f, 0.f, 0.f, 0.f};
#pragma unroll
                for (int ai = 0; ai < 2; ++ai)
#pragma unroll
                    for (int m = 0; m < 4; ++m) acc[ai][bj][m][n] += bv; }
        bool bad = st1.run(acc, u, wr, wc, fr, fq, lds, wid, lane) || poison != 0u;
        const float qnan = __builtin_nanf("");
#pragma unroll
        for (int ai = 0; ai < 2; ++ai)
#pragma unroll
            for (int m = 0; m < 4; ++m) { const int r = ai * HALF + wr * 64 + m * 16 + fr; const f32x2v sr = S[r]; const size_t off = (size_t)(u.pm * BM + r) * ldc + col0;
#pragma unroll
                for (int bj = 0; bj < 2; ++bj)
#pragma unroll
                    for (int n = 0; n < 2; ++n) { const f32x4 bs = *(const f32x4*)(base + off + bj * HALF + n * 16); acc[ai][bj][m][n] = bs + (acc[ai][bj][m][n] - sr.x) * sr.y; }
                asm volatile("" : "+v"(acc[ai][0][m][0]), "+v"(acc[ai][0][m][1]), "+v"(acc[ai][1][m][0]), "+v"(acc[ai][1][m][1]));
                if (m & 1) asm volatile("" ::: "memory"); }
        const bool bad1 = bad;
        bad = st2.run(acc, u, wr, wc, fr, fq, lds, wid, lane) || bad;
#pragma unroll
        for (int ai = 0; ai < 2; ++ai)
#pragma unroll
            for (int m = 0; m < 4; ++m) { const int r = ai * HALF + wr * 64 + m * 16 + fr; const f32x2v sr = S[r]; const size_t off = (size_t)(u.pm * BM + r) * ldc + col0;
#pragma unroll
                for (int bj = 0; bj < 2; ++bj)
#pragma unroll
                    for (int n = 0; n < 2; ++n) { const f32x4 x1 = acc[ai][bj][m][n]; *(f32x4*)(out + off + bj * HALF + n * 16) = bad1 ? (f32x4){qnan, qnan, qnan, qnan} : x1;
                        const f32x4 o = (x1 - sr.x) * sr.y; u32x2v w; w.x = cvt_pk_bf16(o[0], o[1]); w.y = cvt_pk_bf16(o[2], o[3]);
                        if (bad) { w.x = 0x7fc07fc0u; w.y = 0x7fc07fc0u; } *(u32x2v*)(xn + off + bj * HALF + n * 16) = w; }
                asm volatile("" ::: "memory"); }
    }
};

template <class Epi, class Sched, bool ALIGN_EPI = false, bool SP2 = false>
__device__ __forceinline__ void gemm_phase(PG8_LAS unsigned char* lds, const Gemm g, const Sched& S, const Epi& E) {
    const int tid = tidx(), wid = __builtin_amdgcn_readfirstlane(tid >> 6), lane = tid & 63, wr = wid >> 2, wc = wid & 3, fr = lane & 15, fq = lane >> 4;
    const int K = g.K, nt = K / BK;
    unsigned voffA[2], voffB[2];
#pragma unroll
    for (int i = 0; i < 2; ++i) { int R, C; stage_rc(tid * 16 + i * 8192, R, C); const int Rb = Epi::PERM ? ((R & ~31) + perm32(R & 31)) : R;
        voffA[i] = (unsigned)(R * K + C) * 2u; voffB[i] = (unsigned)(Rb * K + C) * 2u; }
    const size_t kstep = (size_t)(BK * 2);
    const size_t hstep = (size_t)HALF * K * 2;
    const size_t tstep = 2 * hstep;
    const unsigned ldsw = (unsigned)wid * 1024u;
    const int aoff = lds_byte(wr * 64 + fr, fq * 8), boff = lds_byte(wc * 32 + fr, fq * 8);
#define PG8_SA(b, h) (((b) * 2 + (h)) * HTB)
#define PG8_SB(b, h) ((4 + (b) * 2 + (h)) * HTB)
#define PG8_STAGE(bufoff, gbase, voff) do { _Pragma("unroll") for (int _i = 0; _i < 2; ++_i) \
        __builtin_amdgcn_global_load_lds((const unsigned*)((const char*)(gbase) + (voff)[_i]), (PG8_LAS unsigned*)(lds + (bufoff) + ldsw + _i * 8192), 16, 0, 0); } while (0)
#define PG8_LDA(dst, b, h) do { _Pragma("unroll") for (int m = 0; m < 4; ++m) _Pragma("unroll") for (int k = 0; k < 2; ++k) dst[m][k] = *(const PG8_LAS bf16x8*)(lds + PG8_SA(b, h) + aoff + m * 2048 + k * 1024); } while (0)
#define PG8_LDB(dst, b, h) do { _Pragma("unroll") for (int n = 0; n < 2; ++n) _Pragma("unroll") for (int k = 0; k < 2; ++k) dst[n][k] = *(const PG8_LAS bf16x8*)(lds + PG8_SB(b, h) + boff + n * 2048 + k * 1024); } while (0)
#define PG8_MMA(ai, bj, At, Bt) do { __builtin_amdgcn_s_setprio(1); _Pragma("unroll") for (int m = 0; m < 4; ++m) _Pragma("unroll") for (int n = 0; n < 2; ++n) _Pragma("unroll") for (int k = 0; k < 2; ++k) \
        acc[ai][bj][m][n] = __builtin_amdgcn_mfma_f32_16x16x32_bf16(Bt[n][k], At[m][k], acc[ai][bj][m][n], 0, 0, 0); __builtin_amdgcn_s_setprio(0); } while (0)
#define PG8_WAIT_V(n) asm volatile("s_waitcnt vmcnt(" #n ")" ::: "memory")
#define PG8_WAIT_L(n) asm volatile("s_waitcnt lgkmcnt(" #n ")" ::: "memory")
#define PG8_BAR __builtin_amdgcn_s_barrier()
#define PG8_SCHED __builtin_amdgcn_sched_barrier(0)
    Unit cur, nxt; int ui = 0;
    if (!S.next(0, cur)) return;
    E.prefetch(cur, tid, lds + 135168);
    f32x4 acc[2][2][4][2];
#pragma unroll
    for (int a = 0; a < 2; ++a)
#pragma unroll
        for (int b = 0; b < 2; ++b)
#pragma unroll
            for (int m = 0; m < 4; ++m)
#pragma unroll
                for (int n = 0; n < 2; ++n) acc[a][b][m][n] = (f32x4){0.f, 0.f, 0.f, 0.f};
    bf16x8 At[4][2], B0[2][2], B1[2][2];
    const char* cA = (const char*)g.A + (size_t)cur.pm * tstep; const char* cB = (const char*)g.Bt + (size_t)cur.pn * tstep;
    S.a_ready(cur);
    if constexpr (SP2) {
        PG8_STAGE(PG8_SB(0, 0), cB, voffB); PG8_STAGE(PG8_SB(0, 1), cB + hstep, voffB); PG8_STAGE(PG8_SA(0, 0), cA, voffA); PG8_STAGE(PG8_SA(0, 1), cA + hstep, voffA);
        if (wr == 1) PG8_BAR;
        PG8_WAIT_V(2); PG8_BAR;
        PG8_STAGE(PG8_SB(1, 0), cB + kstep, voffB); PG8_STAGE(PG8_SA(1, 0), cA + kstep, voffA); PG8_STAGE(PG8_SB(1, 1), cB + hstep + kstep, voffB);
        PG8_WAIT_V(6); PG8_BAR;
    } else {
        PG8_STAGE(PG8_SB(0, 0), cB, voffB); PG8_STAGE(PG8_SA(0, 0), cA, voffA); PG8_STAGE(PG8_SB(0, 1), cB + hstep, voffB); PG8_STAGE(PG8_SA(0, 1), cA + hstep, voffA);
        if (wr == 1) PG8_BAR;
        PG8_WAIT_V(4); PG8_BAR;
        PG8_STAGE(PG8_SB(1, 0), cB + kstep, voffB); PG8_STAGE(PG8_SA(1, 0), cA + kstep, voffA); PG8_STAGE(PG8_SB(1, 1), cB + hstep + kstep, voffB);
        PG8_WAIT_V(6); PG8_BAR;
    }
    for (;;) {
        const bool has_next = S.next(ui + 1, nxt);
        const char* nA = has_next ? (const char*)g.A + (size_t)nxt.pm * tstep : cA; const char* nB = has_next ? (const char*)g.Bt + (size_t)nxt.pn * tstep : cB;
        for (int t = 0; t < nt; t += 2) {
            const bool last = (t == nt - 2);
            const char* a1 = cA + (size_t)(t + 1) * kstep;
            const char* a2 = last ? nA : cA + (size_t)(t + 2) * kstep; const char* b2 = last ? nB : cB + (size_t)(t + 2) * kstep;
            const char* a3 = a2 + kstep; const char* b3 = b2 + kstep;
            if (last && has_next) S.a_ready(nxt);
            if constexpr (SP2) {
            PG8_LDB(B0, 0, 0); PG8_LDB(B1, 0, 1); PG8_SCHED; PG8_LDA(At, 0, 0); PG8_STAGE(PG8_SA(1, 1), a1 + hstep, voffA);
            PG8_WAIT_V(8); PG8_WAIT_L(0); PG8_BAR; PG8_MMA(0, 0, At, B0); PG8_MMA(0, 1, At, B1); PG8_BAR; PG8_SCHED;
            PG8_LDA(At, 0, 1); PG8_STAGE(PG8_SB(0, 0), b2, voffB); PG8_STAGE(PG8_SB(0, 1), b2 + hstep, voffB); PG8_STAGE(PG8_SA(0, 0), a2, voffA);
            PG8_WAIT_V(8); PG8_WAIT_L(0); PG8_BAR; PG8_MMA(1, 0, At, B0); PG8_MMA(1, 1, At, B1); PG8_BAR; PG8_SCHED;
            PG8_LDB(B0, 1, 0); PG8_LDB(B1, 1, 1); PG8_SCHED; PG8_LDA(At, 1, 0); PG8_STAGE(PG8_SA(0, 1), a2 + hstep, voffA);
            PG8_WAIT_V(8); PG8_WAIT_L(0); PG8_BAR; PG8_MMA(0, 0, At, B0); PG8_MMA(0, 1, At, B1); PG8_BAR; PG8_SCHED;
            PG8_LDA(At, 1, 1); PG8_STAGE(PG8_SB(1, 0), b3, voffB); PG8_STAGE(PG8_SB(1, 1), b3 + hstep, voffB); PG8_STAGE(PG8_SA(1, 0), a3, voffA);
            PG8_WAIT_V(8); PG8_WAIT_L(0); PG8_BAR; PG8_MMA(1, 0, At, B0); PG8_MMA(1, 1, At, B1); PG8_BAR; PG8_SCHED;
            } else {
            PG8_LDB(B0, 0, 0); PG8_SCHED; PG8_LDA(At, 0, 0); PG8_STAGE(PG8_SA(1, 1), a1 + hstep, voffA);
            PG8_WAIT_L(8); PG8_BAR; PG8_WAIT_L(0); PG8_MMA(0, 0, At, B0); PG8_BAR; PG8_SCHED;
            PG8_LDB(B1, 0, 1); PG8_STAGE(PG8_SB(0, 0), b2, voffB);
            PG8_BAR; PG8_WAIT_L(0); PG8_MMA(0, 1, At, B1); PG8_BAR;
            PG8_LDA(At, 0, 1); PG8_STAGE(PG8_SA(0, 0), a2, voffA);
            PG8_BAR; PG8_WAIT_L(0); PG8_MMA(1, 0, At, B0); PG8_BAR; PG8_SCHED;
            PG8_STAGE(PG8_SB(0, 1), b2 + hstep, voffB);
            PG8_WAIT_V(6); PG8_BAR; PG8_MMA(1, 1, At, B1); PG8_BAR;
            PG8_LDB(B0, 1, 0); PG8_SCHED; PG8_LDA(At, 1, 0); PG8_STAGE(PG8_SA(0, 1), a2 + hstep, voffA);
            PG8_WAIT_L(8); PG8_BAR; PG8_WAIT_L(0); PG8_MMA(0, 0, At, B0); PG8_BAR; PG8_SCHED;
            PG8_LDB(B1, 1, 1); PG8_STAGE(PG8_SB(1, 0), b3, voffB);
            PG8_BAR; PG8_WAIT_L(0); PG8_MMA(0, 1, At, B1); PG8_BAR;
            PG8_LDA(At, 1, 1); PG8_STAGE(PG8_SA(1, 0), a3, voffA);
            PG8_BAR; PG8_WAIT_L(0); PG8_MMA(1, 0, At, B0); PG8_BAR; PG8_SCHED;
            PG8_STAGE(PG8_SB(1, 1), b3 + hstep, voffB);
            PG8_WAIT_V(6); PG8_BAR; PG8_MMA(1, 1, At, B1); PG8_BAR;
            }
        }
        if constexpr (ALIGN_EPI) { if (wr == 0) PG8_BAR; }
        if constexpr (!Epi::AFTER_DRAIN) { E(acc, cur, wr, wc, fr, fq, lds + 135168 + (ui & 1) * 4096); if (has_next) E.prefetch(nxt, tid, lds + 135168 + ((ui + 1) & 1) * 4096); S.done(cur); }
        if (!has_next) break;
#pragma unroll
        for (int a = 0; a < 2; ++a)
#pragma unroll
            for (int b = 0; b < 2; ++b)
#pragma unroll
                for (int m = 0; m < 4; ++m)
#pragma unroll
                    for (int n = 0; n < 2; ++n) acc[a][b][m][n] = (f32x4){0.f, 0.f, 0.f, 0.f};
        cur = nxt; cA = nA; cB = nB; ++ui;
        if constexpr (ALIGN_EPI) { if (wr == 1) PG8_BAR; }
    }
    PG8_WAIT_V(0);
    if constexpr (!ALIGN_EPI) { if (wr == 0) PG8_BAR; }
    PG8_BAR;
    if constexpr (Epi::AFTER_DRAIN) { E.fused(acc, cur, wr, wc, fr, fq, lds, wid, lane); S.done(cur); }
#undef PG8_SA
#undef PG8_SB
#undef PG8_STAGE
#undef PG8_LDA
#undef PG8_LDB
#undef PG8_MMA
#undef PG8_WAIT_V
#undef PG8_WAIT_L
#undef PG8_BAR
#undef PG8_SCHED
}
}

#define LAS __attribute__((address_space(3)))
typedef unsigned short bf16_t;
typedef short bf16x8 __attribute__((ext_vector_type(8)));
typedef short s16x4 __attribute__((ext_vector_type(4)));
typedef short v4i16_t __attribute__((ext_vector_type(4)));
typedef float f32x4 __attribute__((ext_vector_type(4)));
typedef float f32x16 __attribute__((ext_vector_type(16)));
typedef unsigned u32x4 __attribute__((ext_vector_type(4)));
typedef unsigned u32x2 __attribute__((ext_vector_type(2)));

constexpr int DM = 1024, NB = 8, SEQ = 8192, NMETA = 16, LSEQ = SEQ + NMETA, MREAL = NB * SEQ, MROW0 = MREAL, MPAD = MREAL + 256;
constexpr int FF = 2816, NPB = 3584, NPBW = 3840, DPROJ = 5640;
constexpr int NCH = 65;
constexpr float ALPHA = 1.41421356237f;
constexpr float LOG2E = 1.4426950408889634f;
constexpr float QSCALE = 0.125f * LOG2E;
constexpr float NEGF = -1e30f;
constexpr float LN_EPS = 1e-5f;

constexpr size_t OW_GU1 = 0, OW_D1 = 5767168, OW_PB = 8650752, OW_GM = 12582912, OW_BM = 14680064, OW_BA = 15204352, OW_OUT = 15728640, OW_GU2 = 16777216, OW_D2 = 22544384, OW_LAYER = 25427968;
constexpr int OC_GU1 = 0, OC_PB = 5632, OC_GM = 9472, OC_GU2 = 11520, OC_N = 17152;
constexpr size_t MiB = 1u << 20;
constexpr size_t WS_ROWS = 0;
constexpr size_t WS_CSBW = 4 * MiB;
constexpr size_t WS_HFM = 5 * MiB;
constexpr size_t WS_GATES = 6 * MiB;
constexpr size_t WS_BAR = 9 * MiB;
constexpr size_t WS_KM = WS_BAR + 16384;
constexpr size_t WS_SC = 10 * MiB;
constexpr size_t WS_NST = 11 * MiB;
constexpr size_t WS_STATS = 13 * MiB;
constexpr size_t WS_W = 16 * MiB;
constexpr size_t WS_HB = 113 * MiB;
constexpr size_t WS_LO = 242 * MiB;
constexpr size_t WS_CST = 371 * MiB;
constexpr size_t WS_MA = 436 * MiB;
constexpr size_t WS_BIG = 565 * MiB;
constexpr size_t WS_END = 1015 * MiB;

struct Params {
    const float* in[28];
    float* out; unsigned char* ws;
};

__device__ __forceinline__ unsigned f2bf(float f) { unsigned u = __builtin_bit_cast(unsigned, f); return (u + 0x7fffu + ((u >> 16) & 1u)) >> 16; }
typedef float f32x2_t __attribute__((ext_vector_type(2))); typedef __bf16 bf16x2_t __attribute__((ext_vector_type(2)));
__device__ __forceinline__ unsigned pk2(float lo, float hi) { f32x2_t v = {lo, hi}; bf16x2_t b = __builtin_convertvector(v, bf16x2_t); return __builtin_bit_cast(unsigned, b); }
__device__ __forceinline__ u32x4 pack8(f32x4 a, f32x4 b) { u32x4 w; w.x = pk2(a[0], a[1]); w.y = pk2(a[2], a[3]); w.z = pk2(b[0], b[1]); w.w = pk2(b[2], b[3]); return w; }
__device__ __forceinline__ float bflo(unsigned w) { return __builtin_bit_cast(float, w << 16); }
__device__ __forceinline__ float bfhi(unsigned w) { return __builtin_bit_cast(float, w & 0xffff0000u); }
__device__ __forceinline__ float ex2(float x) { return __builtin_amdgcn_exp2f(x); }
__device__ __forceinline__ float sigm(float x) { return __builtin_amdgcn_rcpf(1.f + ex2(-x * LOG2E)); }
__device__ __forceinline__ float siluf(float x) { return x * sigm(x); }
__device__ __forceinline__ float wave_sum(float v) {
#pragma unroll
    for (int o = 1; o < 64; o <<= 1) v += __shfl_xor(v, o);
    return v;
}
__device__ __forceinline__ float wave_max(float v) {
#pragma unroll
    for (int o = 1; o < 64; o <<= 1) v = fmaxf(v, __shfl_xor(v, o));
    return v;
}
__device__ __forceinline__ size_t seqrow(int b, int pos) { return pos < NMETA ? (size_t)(MROW0 + pos) : (size_t)b * SEQ + (size_t)(pos - NMETA); }
__device__ __forceinline__ f32x16 mfma32(bf16x8 a, bf16x8 b, f32x16 c) { return __builtin_amdgcn_mfma_f32_32x32x16_bf16(a, b, c, 0, 0, 0); }
__device__ __forceinline__ s16x4 vtr(const LAS unsigned char* p) { return __builtin_bit_cast(s16x4, __builtin_amdgcn_ds_read_tr16_b64_v4i16((LAS v4i16_t*)p)); }
__device__ __forceinline__ bf16x8 cat8(s16x4 lo, s16x4 hi) { return (bf16x8){lo[0], lo[1], lo[2], lo[3], hi[0], hi[1], hi[2], hi[3]}; }

namespace pg8 {
__device__ __forceinline__ void tab_prefetch(const float* rows, const float* v0, const float* v1, int pm, int cbase, int tid, PG8_LAS unsigned char* tab) {
    const int wid = __builtin_amdgcn_readfirstlane(tid >> 6), lane = tid & 63;
    if (rows) __builtin_amdgcn_global_load_lds((const unsigned*)(rows + (size_t)pm * 512 + tid), (PG8_LAS unsigned*)(tab + wid * 256), 4, 0, 0);
    const float* src = (wid < 4 ? v0 + (wid * 64 + lane) : v1 + ((wid - 4) * 64 + lane)) + cbase;
    __builtin_amdgcn_global_load_lds((const unsigned*)src, (PG8_LAS unsigned*)(tab + 2048 + wid * 256), 4, 0, 0);
}
__device__ __forceinline__ void tab_ready() { asm volatile("s_waitcnt vmcnt(14)" ::: "memory"); __builtin_amdgcn_s_barrier(); asm volatile("" ::: "memory"); }
__device__ __forceinline__ void tab_stats(const PG8_LAS unsigned char* tab, int rloc, float& mu, float& r) {
    const f32x2_t st = *(const PG8_LAS f32x2_t*)(tab + rloc * 8); mu = st.x * (1.f / DM); r = __builtin_amdgcn_rsqf(st.y * (1.f / DM) - mu * mu + LN_EPS);
}
struct LnFix {
    const float* rows; const float* cs; const float* bw; int on;
    __device__ __forceinline__ void stats(size_t row, float& mu, float& r) const {
        const f32x2_t st = *(const f32x2_t*)(rows + row * 2); mu = st.x * (1.f / DM); r = __builtin_amdgcn_rsqf(st.y * (1.f / DM) - mu * mu + LN_EPS);
    }
};
struct EpiSwiglu {
    static constexpr bool PERM = true, AFTER_DRAIN = false;
    bf16_t* O; int ldc; LnFix fx;
    __device__ __forceinline__ void prefetch(const Unit& u, int tid, PG8_LAS unsigned char* tab) const { if (fx.on) tab_prefetch(fx.rows, fx.cs, fx.bw, u.pm, u.pn * BM, tid, tab); }
    __device__ __forceinline__ void operator()(const f32x4 (&acc)[2][2][4][2], const Unit& u, int wr, int wc, int fr, int fq, const PG8_LAS unsigned char* tab) const {
        const int row0 = u.pm * BM + wr * 64 + fr, col0 = u.pn * 128 + wc * 32 + 8 * fq, cl = wc * 32 + 8 * fq;
        if (fx.on) tab_ready();
#pragma unroll
        for (int ai = 0; ai < 2; ++ai)
#pragma unroll
            for (int m = 0; m < 4; ++m) {
                const size_t row = (size_t)(row0 + ai * HALF + m * 16);
                float mu = 0.f, r = 1.f; if (fx.on) tab_stats(tab, wr * 64 + fr + ai * HALF + m * 16, mu, r);
                u32x4 w;
#pragma unroll
                for (int n = 0; n < 2; ++n) {
                    f32x4 csg = {0.f, 0.f, 0.f, 0.f}, bwg = csg, csu = csg, bwu = csg;
                    if (fx.on) { csg = *(const PG8_LAS f32x4*)(tab + 2048 + (cl + 4 * n) * 4); bwg = *(const PG8_LAS f32x4*)(tab + 3072 + (cl + 4 * n) * 4); csu = *(const PG8_LAS f32x4*)(tab + 2048 + (cl + HALF + 4 * n) * 4); bwu = *(const PG8_LAS f32x4*)(tab + 3072 + (cl + HALF + 4 * n) * 4); }
                    const f32x4 g = (acc[ai][0][m][n] - csg * mu) * r + bwg, up = (acc[ai][1][m][n] - csu * mu) * r + bwu;
                    const unsigned lo = pk2(siluf(g[0]) * up[0], siluf(g[1]) * up[1]), hi = pk2(siluf(g[2]) * up[2], siluf(g[3]) * up[3]);
                    if (n == 0) { w.x = lo; w.y = hi; } else { w.z = lo; w.w = hi; }
                }
                *(u32x4*)(O + row * ldc + col0) = w;
            }
    }
};
struct EpiPlain {
    static constexpr bool PERM = true, AFTER_DRAIN = false;
    bf16_t* O; int ldc; int coff; int slo, shi; float scale; LnFix fx; float* GT; const float* bif;
    __device__ __forceinline__ void prefetch(const Unit& u, int tid, PG8_LAS unsigned char* tab) const { if (fx.on) tab_prefetch(fx.rows, fx.cs, fx.bw, u.pm, u.pn * BM, tid, tab); }
    __device__ __forceinline__ void operator()(const f32x4 (&acc)[2][2][4][2], const Unit& u, int wr, int wc, int fr, int fq, const PG8_LAS unsigned char* tab) const {
        const int row0 = u.pm * BM + wr * 64 + fr, col0 = coff + u.pn * BM + wc * 32 + 8 * fq, cl = wc * 32 + 8 * fq;
        if (fx.on) tab_ready();
        if (GT && u.pn == 14) {
            if (wc == 0 && fq == 0) {
                const f32x4 cs0 = *(const PG8_LAS f32x4*)(tab + 2048 + cl * 4), cs1 = *(const PG8_LAS f32x4*)(tab + 2048 + (cl + 4) * 4);
                const f32x4 bw0 = *(const PG8_LAS f32x4*)(tab + 3072 + cl * 4) + *(const f32x4*)(bif), bw1 = *(const PG8_LAS f32x4*)(tab + 3072 + (cl + 4) * 4) + *(const f32x4*)(bif + 4);
#pragma unroll
                for (int ai = 0; ai < 2; ++ai)
#pragma unroll
                    for (int m = 0; m < 4; ++m) {
                        const size_t row = (size_t)(row0 + ai * HALF + m * 16);
                        float mu, r; tab_stats(tab, wr * 64 + fr + ai * HALF + m * 16, mu, r);
                        const f32x4 li = (acc[ai][0][m][0] - cs0 * mu) * r + bw0, z = (acc[ai][0][m][1] - cs1 * mu) * r + bw1;
                        f32x4 lf;
#pragma unroll
                        for (int e = 0; e < 4; ++e) lf[e] = fminf(z[e], 0.f) - __logf(1.f + __expf(-fabsf(z[e])));
                        *(f32x4*)(GT + row * 8) = li; *(f32x4*)(GT + row * 8 + 4) = lf;
                    }
            }
            return;
        }
        const float sc = (u.pn >= slo && u.pn < shi) ? scale : 1.f;
#pragma unroll
        for (int ai = 0; ai < 2; ++ai)
#pragma unroll
            for (int m = 0; m < 4; ++m) {
                const size_t row = (size_t)(row0 + ai * HALF + m * 16);
                float mu = 0.f, r = 1.f; if (fx.on) tab_stats(tab, wr * 64 + fr + ai * HALF + m * 16, mu, r);
#pragma unroll
                for (int bj = 0; bj < 2; ++bj) {
                    u32x4 w;
#pragma unroll
                    for (int n = 0; n < 2; ++n) {
                        f32x4 cs4 = {0.f, 0.f, 0.f, 0.f}, bw4 = cs4;
                        if (fx.on) { cs4 = *(const PG8_LAS f32x4*)(tab + 2048 + (cl + bj * HALF + 4 * n) * 4); bw4 = *(const PG8_LAS f32x4*)(tab + 3072 + (cl + bj * HALF + 4 * n) * 4); }
                        const f32x4 v = ((acc[ai][bj][m][n] - cs4 * mu) * r + bw4) * sc;
                        if (n == 0) { w.x = pk2(v[0], v[1]); w.y = pk2(v[2], v[3]); } else { w.z = pk2(v[0], v[1]); w.w = pk2(v[2], v[3]); }
                    }
                    *(u32x4*)(O + row * ldc + col0 + bj * HALF) = w;
                }
            }
    }
};
struct EpiResid {
    static constexpr bool PERM = true, AFTER_DRAIN = false;
    const float* src; bf16_t* LO; bf16_t* HB; const float* rows_prev; float* rows_cur; const float* gam; const float* bet; float s; int raw;
    __device__ __forceinline__ void prefetch(const Unit& u, int tid, PG8_LAS unsigned char* tab) const { if (!raw) tab_prefetch(rows_prev, gam, bet, u.pm, u.pn * BM, tid, tab); }
    __device__ __forceinline__ void operator()(const f32x4 (&acc)[2][2][4][2], const Unit& u, int wr, int wc, int fr, int fq, const PG8_LAS unsigned char* tab) const {
        const int row0 = u.pm * BM + wr * 64 + fr, col0 = u.pn * BM + wc * 32 + 8 * fq, cl = wc * 32 + 8 * fq;
        if (!raw) tab_ready();
#pragma unroll
        for (int ai = 0; ai < 2; ++ai)
#pragma unroll
            for (int m = 0; m < 4; ++m) {
                const size_t row = (size_t)(row0 + ai * HALF + m * 16);
                float mu = 0.f, rs = 1.f;
                if (!raw) tab_stats(tab, wr * 64 + fr + ai * HALF + m * 16, mu, rs);
                const float ar = ALPHA * rs, am = -ALPHA * rs * mu;
                float s1 = 0.f, s2 = 0.f;
#pragma unroll
                for (int bj = 0; bj < 2; ++bj) {
                    f32x4 g0 = {1.f, 1.f, 1.f, 1.f}, g1 = g0, b0 = {0.f, 0.f, 0.f, 0.f}, b1 = b0;
                    if (!raw) { g0 = *(const PG8_LAS f32x4*)(tab + 2048 + (cl + bj * HALF) * 4); g1 = *(const PG8_LAS f32x4*)(tab + 2048 + (cl + bj * HALF + 4) * 4); b0 = *(const PG8_LAS f32x4*)(tab + 3072 + (cl + bj * HALF) * 4); b1 = *(const PG8_LAS f32x4*)(tab + 3072 + (cl + bj * HALF + 4) * 4); }
                    f32x4 x0, x1;
                    if (raw) { x0 = *(const f32x4*)(src + row * DM + col0 + bj * HALF); x1 = *(const f32x4*)(src + row * DM + col0 + bj * HALF + 4); }
                    else { const u32x4 hi = *(const u32x4*)(HB + row * DM + col0 + bj * HALF), lo = *(const u32x4*)(LO + row * DM + col0 + bj * HALF);
                        x0 = (f32x4){bflo(hi.x) + bflo(lo.x), bfhi(hi.x) + bfhi(lo.x), bflo(hi.y) + bflo(lo.y), bfhi(hi.y) + bfhi(lo.y)};
                        x1 = (f32x4){bflo(hi.z) + bflo(lo.z), bfhi(hi.z) + bfhi(lo.z), bflo(hi.w) + bflo(lo.w), bfhi(hi.w) + bfhi(lo.w)}; }
                    const f32x4 o0 = (x0 * ar + am) * g0 + b0 * ALPHA + acc[ai][bj][m][0] * s, o1 = (x1 * ar + am) * g1 + b1 * ALPHA + acc[ai][bj][m][1] * s;
                    const u32x4 nh = pack8(o0, o1);
                    const f32x4 d0 = {o0[0] - bflo(nh.x), o0[1] - bfhi(nh.x), o0[2] - bflo(nh.y), o0[3] - bfhi(nh.y)}, d1 = {o1[0] - bflo(nh.z), o1[1] - bfhi(nh.z), o1[2] - bflo(nh.w), o1[3] - bfhi(nh.w)};
                    *(u32x4*)(HB + row * DM + col0 + bj * HALF) = nh; *(u32x4*)(LO + row * DM + col0 + bj * HALF) = pack8(d0, d1);
                    s1 += ((o0[0] + o0[1]) + (o0[2] + o0[3])) + ((o1[0] + o1[1]) + (o1[2] + o1[3]));
                    s2 += ((o0[0] * o0[0] + o0[1] * o0[1]) + (o0[2] * o0[2] + o0[3] * o0[3])) + ((o1[0] * o1[0] + o1[1] * o1[1]) + (o1[2] * o1[2] + o1[3] * o1[3]));
                }
                s1 += __shfl_xor(s1, 16); s1 += __shfl_xor(s1, 32); s2 += __shfl_xor(s2, 16); s2 += __shfl_xor(s2, 32);
                if (fq == 0) { float* rp = rows_cur + row * 2; atomicAdd(rp, s1); atomicAdd(rp + 1, s2); }
                asm volatile("" ::: "memory");
            }
    }
};
struct EpiGate {
    static constexpr bool PERM = true, AFTER_DRAIN = false;
    bf16_t* U; const bf16_t* Y; const float* bg; LnFix fx;
    __device__ __forceinline__ void prefetch(const Unit& u, int tid, PG8_LAS unsigned char* tab) const { tab_prefetch(fx.rows, fx.cs, fx.bw, u.pm, u.pn * BM, tid, tab); }
    __device__ __forceinline__ void operator()(const f32x4 (&acc)[2][2][4][2], const Unit& u, int wr, int wc, int fr, int fq, const PG8_LAS unsigned char* tab) const {
        const int row0 = u.pm * BM + wr * 64 + fr, col0 = u.pn * 128 + wc * 32 + 8 * fq, cl = wc * 32 + 8 * fq;
        tab_ready();
#pragma unroll
        for (int ai = 0; ai < 2; ++ai)
#pragma unroll
            for (int m = 0; m < 4; ++m) {
                const size_t row = (size_t)(row0 + ai * HALF + m * 16);
                float mu, r; tab_stats(tab, wr * 64 + fr + ai * HALF + m * 16, mu, r);
                const u32x4 ym = *(const u32x4*)(Y + row * 2048 + col0), ya = *(const u32x4*)(Y + row * 2048 + DM + col0);
                u32x4 w;
#pragma unroll
                for (int n = 0; n < 2; ++n) {
                    const f32x4 csm = *(const PG8_LAS f32x4*)(tab + 2048 + (cl + 4 * n) * 4), bm = *(const PG8_LAS f32x4*)(tab + 3072 + (cl + 4 * n) * 4);
                    const f32x4 csa = *(const PG8_LAS f32x4*)(tab + 2048 + (cl + HALF + 4 * n) * 4), ba = *(const PG8_LAS f32x4*)(tab + 3072 + (cl + HALF + 4 * n) * 4);
                    const f32x4 gm = (acc[ai][0][m][n] - csm * mu) * r + bm, ga = (acc[ai][1][m][n] - csa * mu) * r + ba;
                    const unsigned y0 = n ? ym.z : ym.x, y1 = n ? ym.w : ym.y, a0 = n ? ya.z : ya.x, a1 = n ? ya.w : ya.y;
                    const unsigned lo = pk2(sigm(gm[0]) * bflo(y0) + sigm(ga[0]) * bflo(a0), sigm(gm[1]) * bfhi(y0) + sigm(ga[1]) * bfhi(a0));
                    const unsigned hi = pk2(sigm(gm[2]) * bflo(y1) + sigm(ga[2]) * bflo(a1), sigm(gm[3]) * bfhi(y1) + sigm(ga[3]) * bfhi(a1));
                    if (n == 0) { w.x = lo; w.y = hi; } else { w.z = lo; w.w = hi; }
                }
                *(u32x4*)(U + row * DM + col0) = w;
            }
    }
};
}

__device__ __forceinline__ f32x4 sg_tile(const bf16_t* A, int lda, const bf16_t* Bt, int K, int n0, int lane) {
    const bf16_t* ap = A + (size_t)(lane & 15) * lda + 8 * (lane >> 4);
    const bf16_t* bp = Bt + (size_t)(n0 + (lane & 15)) * K + 8 * (lane >> 4);
    f32x4 acc = {0.f, 0.f, 0.f, 0.f};
#pragma unroll 8
    for (int k = 0; k < K; k += 32) {
        const bf16x8 a = *(const bf16x8*)(ap + k), b = *(const bf16x8*)(bp + k);
        acc = __builtin_amdgcn_mfma_f32_16x16x32_bf16(a, b, acc, 0, 0, 0);
    }
    return acc;
}

__device__ __forceinline__ f32x4 sg_tile_blk(const bf16_t* A, int lda, const bf16_t* Bt, int K, int n0, int lane, int wid, LAS float* red) {
    const int K8 = K >> 3;
    const bf16_t* ap = A + (size_t)(lane & 15) * lda + 8 * (lane >> 4) + wid * K8;
    const bf16_t* bp = Bt + (size_t)(n0 + (lane & 15)) * K + 8 * (lane >> 4) + wid * K8;
    f32x4 acc = {0.f, 0.f, 0.f, 0.f};
#pragma unroll 4
    for (int k = 0; k < K8; k += 32) {
        const bf16x8 a = *(const bf16x8*)(ap + k), b = *(const bf16x8*)(bp + k);
        acc = __builtin_amdgcn_mfma_f32_16x16x32_bf16(a, b, acc, 0, 0, 0);
    }
    *(LAS f32x4*)(red + wid * 256 + lane * 4) = acc;
    __syncthreads();
    f32x4 sum = {0.f, 0.f, 0.f, 0.f};
    if (wid == 0) {
#pragma unroll
        for (int w = 0; w < 8; ++w) sum = sum + *(const LAS f32x4*)(red + w * 256 + lane * 4);
    }
    __syncthreads();
    return sum;
}

__device__ __forceinline__ void tr_rows(const float* Wsrc, int ldw, int K, bf16_t* dst, int kb0, int nkb, int nv4, const float* g, const float* bb, float* cs, float* bw, LAS float* scr, int lane, const float* addb = nullptr) {
    float csp[4] = {0.f, 0.f, 0.f, 0.f}, bwp[4] = {0.f, 0.f, 0.f, 0.f};
    const int c = lane & 7;
#pragma unroll 1
    for (int kb = kb0; kb < kb0 + nkb; ++kb) {
        const int k0 = 64 * kb;
#pragma unroll
        for (int i = 0; i < 8; ++i) { const int kk = 8 * i + (lane >> 3), n4 = (lane & 7) * 4;
            f32x4 v = {0.f, 0.f, 0.f, 0.f}; if ((lane & 7) < nv4) v = *(const f32x4*)(Wsrc + (size_t)(k0 + kk) * ldw + n4);
            scr[kk * 33 + n4] = v[0]; scr[kk * 33 + n4 + 1] = v[1]; scr[kk * 33 + n4 + 2] = v[2]; scr[kk * 33 + n4 + 3] = v[3]; }
        f32x4 g0 = {1.f, 1.f, 1.f, 1.f}, g1 = g0, b0 = {0.f, 0.f, 0.f, 0.f}, b1 = b0;
        if (g) { g0 = *(const f32x4*)(g + k0 + 8 * c); g1 = *(const f32x4*)(g + k0 + 8 * c + 4); b0 = *(const f32x4*)(bb + k0 + 8 * c); b1 = *(const f32x4*)(bb + k0 + 8 * c + 4); }
        asm volatile("s_waitcnt lgkmcnt(0)" ::: "memory");
#pragma unroll
        for (int j = 0; j < 4; ++j) {
            const int n = (lane >> 3) + 8 * j; const LAS float* sp = scr + (8 * c) * 33 + n;
            const float x0 = sp[0 * 33], x1 = sp[1 * 33], x2 = sp[2 * 33], x3 = sp[3 * 33], x4 = sp[4 * 33], x5 = sp[5 * 33], x6 = sp[6 * 33], x7 = sp[7 * 33];
            u32x4 o; o.x = pk2(x0 * g0[0], x1 * g0[1]); o.y = pk2(x2 * g0[2], x3 * g0[3]); o.z = pk2(x4 * g1[0], x5 * g1[1]); o.w = pk2(x6 * g1[2], x7 * g1[3]);
            *(u32x4*)(dst + (size_t)n * K + k0 + 8 * c) = o;
            csp[j] += ((bflo(o.x) + bfhi(o.x)) + (bflo(o.y) + bfhi(o.y))) + ((bflo(o.z) + bfhi(o.z)) + (bflo(o.w) + bfhi(o.w)));
            bwp[j] += ((x0 * b0[0] + x1 * b0[1]) + (x2 * b0[2] + x3 * b0[3])) + ((x4 * b1[0] + x5 * b1[1]) + (x6 * b1[2] + x7 * b1[3]));
        }
        asm volatile("s_waitcnt lgkmcnt(0)" ::: "memory");
    }
    if (g) {
#pragma unroll
        for (int j = 0; j < 4; ++j) {
            float a = csp[j], b = bwp[j];
            a += __shfl_xor(a, 1); a += __shfl_xor(a, 2); a += __shfl_xor(a, 4); b += __shfl_xor(b, 1); b += __shfl_xor(b, 2); b += __shfl_xor(b, 4);
            if (c == 0) { cs[(lane >> 3) + 8 * j] = a; bw[(lane >> 3) + 8 * j] = b + (addb ? addb[(lane >> 3) + 8 * j] : 0.f); }
        }
    }
}
constexpr int CW_ITEMS = 824;
__device__ __forceinline__ void conv_weight_item(const Params& P, int layer, int it, LAS float* scr, int lane) {
    bf16_t* W = (bf16_t*)(P.ws + WS_W) + (size_t)layer * OW_LAYER;
    float* CS = (float*)(P.ws + WS_CSBW) + (size_t)layer * 2 * OC_N; float* BW = CS + OC_N;
    const float* wg1 = P.in[2] + (size_t)layer * DM * FF; const float* wu1 = P.in[3] + (size_t)layer * DM * FF; const float* wd1 = P.in[4] + (size_t)layer * FF * DM;
    const float* win = P.in[7] + (size_t)layer * DM * DPROJ;
    const float* wbm = P.in[17] + (size_t)layer * 512 * DM; const float* wba = P.in[18] + (size_t)layer * 512 * DM; const float* wout = P.in[20] + (size_t)layer * DM * DM;
    const float* wg2 = P.in[23] + (size_t)layer * DM * FF; const float* wu2 = P.in[24] + (size_t)layer * DM * FF; const float* wd2 = P.in[25] + (size_t)layer * FF * DM;
    const float* ln1g = P.in[5] + (size_t)layer * DM; const float* ln1b = P.in[6] + (size_t)layer * DM;
    const float* ln2g = P.in[21] + (size_t)layer * DM; const float* ln2b = P.in[22] + (size_t)layer * DM;
    const float* ln3g = layer ? P.in[26] + (size_t)(layer - 1) * DM : nullptr; const float* ln3b = layer ? P.in[27] + (size_t)(layer - 1) * DM : nullptr;
    int r = it;
    if (r < 352) {
        const int second = r >= 176; if (second) r -= 176;
        const int R0 = 32 * r, pn = R0 >> 8, sgu = (R0 >> 7) & 1, i = R0 & 127;
        const float* src = (second ? (sgu ? wu2 : wg2) : (sgu ? wu1 : wg1)) + 128 * pn + i;
        const int oc = second ? OC_GU2 : OC_GU1;
        tr_rows(src, FF, DM, W + (second ? OW_GU2 : OW_GU1) + (size_t)R0 * DM, 0, 16, 8, second ? ln2g : ln3g, second ? ln2b : ln3b, CS + oc + R0, BW + oc + R0, scr, lane); return;
    }
    r -= 352;
    if (r < 192) {
        const int second = r >= 96; if (second) r -= 96;
        const int nb = r / 3, seg = r % 3, R0 = 32 * nb;
        tr_rows((second ? wd2 : wd1) + R0, DM, FF, W + (second ? OW_D2 : OW_D1) + (size_t)R0 * FF, 16 * seg, seg == 2 ? 12 : 16, 8, nullptr, nullptr, nullptr, nullptr, scr, lane); return;
    }
    r -= 192;
    if (r < 120) {
        const int R0 = 32 * r, csrc = R0 < 2048 ? R0 : (R0 < 3584 ? R0 + 8 : 2048);
        tr_rows(win + csrc, DPROJ, DM, W + OW_PB + (size_t)R0 * DM, 0, 16, R0 < 3584 ? 8 : (R0 == 3584 ? 2 : 0), ln1g, ln1b, CS + OC_PB + R0, BW + OC_PB + R0, scr, lane); return;
    }
    r -= 120;
    if (r < 64) {
        const int R0 = 32 * r, pn = R0 >> 8, sg = (R0 >> 7) & 1, i = R0 & 127, csrc = 3592 + 1024 * sg + 128 * pn + i;
        tr_rows(win + csrc, DPROJ, DM, W + OW_GM + (size_t)R0 * DM, 0, 16, 8, ln1g, ln1b, CS + OC_GM + R0, BW + OC_GM + R0, scr, lane, P.in[19] + (size_t)layer * 2048 + 1024 * sg + 128 * pn + i); return;
    }
    r -= 64;
    if (r < 64) {
        const int second = r >= 32; if (second) r -= 32;
        const int R0 = 32 * r;
        tr_rows((second ? wba : wbm) + R0, DM, 512, W + (second ? OW_BA : OW_BM) + (size_t)R0 * 512, 0, 8, 8, nullptr, nullptr, nullptr, nullptr, scr, lane); return;
    }
    r -= 64;
    { const int R0 = 32 * r; tr_rows(wout + R0, DM, DM, W + OW_OUT + (size_t)R0 * DM, 0, 16, 8, nullptr, nullptr, nullptr, nullptr, scr, lane); }
}

__device__ __forceinline__ void ln_row(const f32x4 (&vin)[4], int row, float* hf, const float* gam, const float* bet, bool gates, bool fin, const float* bif_l, LAS float* gwl, bf16_t* HB, float* ST, float* GT, int lane) {
    f32x4 v[4]; float s = 0.f;
#pragma unroll
    for (int j = 0; j < 4; ++j) { v[j] = vin[j]; s += (v[j][0] + v[j][1]) + (v[j][2] + v[j][3]); }
    const float mean = wave_sum(s) * (1.f / DM); float s2 = 0.f;
#pragma unroll
    for (int j = 0; j < 4; ++j) { v[j] = v[j] - mean; s2 += (v[j][0] * v[j][0] + v[j][1] * v[j][1]) + (v[j][2] * v[j][2] + v[j][3] * v[j][3]); }
    const float rstd = 1.f / sqrtf(wave_sum(s2) * (1.f / DM) + LN_EPS);
    if (lane == 0) { f32x2_t st = {mean, rstd}; *(f32x2_t*)(ST + (size_t)row * 2) = st; }
#pragma unroll
    for (int j = 0; j < 4; ++j) {
        const f32x4 g4 = *(const f32x4*)(gam + 256 * j + 4 * lane), b4 = *(const f32x4*)(bet + 256 * j + 4 * lane);
        v[j] = v[j] * rstd * g4 + b4;
        if (fin) *(f32x4*)(hf + 256 * j + 4 * lane) = v[j];
        if (!fin) { u32x2 w; w.x = pk2(v[j][0], v[j][1]); w.y = pk2(v[j][2], v[j][3]); *(u32x2*)(HB + (size_t)row * DM + 256 * j + 4 * lane) = w; }
    }
    if (gates) {
        float mine = 0.f;
#pragma unroll
        for (int g = 0; g < 8; ++g) {
            float d = 0.f;
#pragma unroll
            for (int j = 0; j < 4; ++j) { const f32x4 w4 = *(const LAS f32x4*)(gwl + g * 1024 + 256 * j + 4 * lane); d += (v[j][0] * w4[0] + v[j][1] * w4[1]) + (v[j][2] * w4[2] + v[j][3] * w4[3]); }
            d = wave_sum(d);
            if (lane == g) mine = d;
        }
        if (lane < 8) {
            const float z = mine + bif_l[lane];
            float o = z;
            if (lane >= 4) o = fminf(z, 0.f) - __logf(1.f + __expf(-fabsf(z)));
            GT[(size_t)row * 8 + lane] = o;
        }
    }
}
__device__ __forceinline__ void ln_phase(const Params& P, const float* gam, const float* bet, bool gates, bool fin, const float* win_l, const float* bif_l, LAS unsigned char* lds) {
    const int tid = tidx(), lane = tid & 63, wid = tid >> 6;
    float* hfm = (float*)(P.ws + WS_HFM); bf16_t* HB = (bf16_t*)(P.ws + WS_HB); float* GT = (float*)(P.ws + WS_GATES); float* ST = (float*)(P.ws + WS_STATS);
    LAS float* gwl = (LAS float*)lds;
    if (gates) {
        for (int idx = tid; idx < 8192; idx += 512) { const int k = idx >> 3, g = idx & 7; gwl[g * 1024 + k] = win_l[(size_t)k * DPROJ + 2048 + g]; }
        __syncthreads();
    }
    const int gw = bidx() * 8 + wid, NGW = gridDim.x * 8;
    constexpr int NR = MREAL;
    int row = 4 * gw;
    f32x4 a[4][4];
#define LN_ROWP(r_) (P.out + (size_t)(r_) * DM)
    const bf16_t* LOp = (const bf16_t*)(P.ws + WS_LO);
#define LN_LOAD(dst_, r_, j_) do { const u32x2 hi_ = *(const u32x2*)(HB + (size_t)(r_) * DM + 256 * (j_) + 4 * lane), lo_ = *(const u32x2*)(LOp + (size_t)(r_) * DM + 256 * (j_) + 4 * lane); \
        dst_ = (f32x4){bflo(hi_.x) + bflo(lo_.x), bfhi(hi_.x) + bfhi(lo_.x), bflo(hi_.y) + bflo(lo_.y), bfhi(hi_.y) + bfhi(lo_.y)}; } while (0)
    if (row < NR) {
#pragma unroll
        for (int q4 = 0; q4 < 4; ++q4) {
#pragma unroll
            for (int j = 0; j < 4; ++j) LN_LOAD(a[q4][j], row + q4, j); }
    }
    while (row < NR) {
        f32x4 ca[4][4];
#pragma unroll
        for (int q4 = 0; q4 < 4; ++q4)
#pragma unroll
            for (int j = 0; j < 4; ++j) ca[q4][j] = a[q4][j];
        const int nrow = row + 4 * NGW;
        if (nrow < NR) {
#pragma unroll
            for (int q4 = 0; q4 < 4; ++q4) {
#pragma unroll
                for (int j = 0; j < 4; ++j) LN_LOAD(a[q4][j], nrow + q4, j); }
        }
#pragma unroll
        for (int q4 = 0; q4 < 4; ++q4) ln_row(ca[q4], row + q4, LN_ROWP(row + q4), gam, bet, gates, fin, bif_l, gwl, HB, ST, GT, lane);
        row = nrow;
    }
#undef LN_ROWP
#undef LN_LOAD
}

__device__ __forceinline__ void conv8(const bf16_t* PB, const float* cw, const float* cb, int b, int pos, int chn, f32x4& o0, f32x4& o1) {
    o0 = *(const f32x4*)(cb + chn); o1 = *(const f32x4*)(cb + chn + 4);
#pragma unroll
    for (int j = 0; j < 4; ++j) {
        const int pp = pos - 3 + j;
        if (pp >= 0) {
            const u32x4 u = *(const u32x4*)(PB + seqrow(b, pp) * NPB + chn);
            const f32x4 w0 = *(const f32x4*)(cw + j * 1024 + chn), w1 = *(const f32x4*)(cw + j * 1024 + chn + 4);
            o0[0] += w0[0] * bflo(u.x); o0[1] += w0[1] * bfhi(u.x); o0[2] += w0[2] * bflo(u.y); o0[3] += w0[3] * bfhi(u.y);
            o1[0] += w1[0] * bflo(u.z); o1[1] += w1[1] * bfhi(u.z); o1[2] += w1[2] * bflo(u.w); o1[3] += w1[3] * bfhi(u.w);
        }
    }
#pragma unroll
    for (int e = 0; e < 4; ++e) { o0[e] = siluf(o0[e]); o1[e] = siluf(o1[e]); }
}
struct ConvW { f32x4 w[4][2]; f32x4 b[2]; };
__device__ __forceinline__ void convw_load(ConvW& cw8, const float* cw, const float* cb, int chn) {
    cw8.b[0] = *(const f32x4*)(cb + chn); cw8.b[1] = *(const f32x4*)(cb + chn + 4);
#pragma unroll
    for (int j = 0; j < 4; ++j) { cw8.w[j][0] = *(const f32x4*)(cw + j * 1024 + chn); cw8.w[j][1] = *(const f32x4*)(cw + j * 1024 + chn + 4); }
}
__device__ __forceinline__ void conv8w(const bf16_t* PB, const ConvW& cw8, int b, int pos, int chn, f32x4& o0, f32x4& o1) {
    o0 = cw8.b[0]; o1 = cw8.b[1];
#pragma unroll
    for (int j = 0; j < 4; ++j) {
        const int pp = pos - 3 + j;
        if (pp >= 0) {
            const u32x4 u = *(const u32x4*)(PB + seqrow(b, pp) * NPB + chn);
            const f32x4 w0 = cw8.w[j][0], w1 = cw8.w[j][1];
            o0[0] += w0[0] * bflo(u.x); o0[1] += w0[1] * bfhi(u.x); o0[2] += w0[2] * bflo(u.y); o0[3] += w0[3] * bfhi(u.y);
            o1[0] += w1[0] * bflo(u.z); o1[1] += w1[1] * bfhi(u.z); o1[2] += w1[2] * bflo(u.w); o1[3] += w1[3] * bfhi(u.w);
        }
    }
#pragma unroll
    for (int e = 0; e < 4; ++e) { o0[e] = siluf(o0[e]); o1[e] = siluf(o1[e]); }
}

__device__ __forceinline__ float wscan_add(float v, int lane) {
#pragma unroll
    for (int o = 1; o < 64; o <<= 1) { const float t = __shfl_up(v, o); if (lane >= o) v += t; }
    return v;
}
__device__ __forceinline__ float wscan_max(float v, int lane) {
#pragma unroll
    for (int o = 1; o < 64; o <<= 1) { const float t = __shfl_up(v, o); if (lane >= o) v = fmaxf(v, t); }
    return v;
}

__device__ __forceinline__ void lds_barrier() { asm volatile("s_waitcnt lgkmcnt(0)\n\ts_barrier" ::: "memory"); }

constexpr int TSTR = 320;
constexpr int RSTR = 272;
__device__ __forceinline__ void m1_unit(const Params& P, int layer, int bh, int c, LAS unsigned char* lds) {
    const int tid = tidx(), lane = tid & 63, wid = __builtin_amdgcn_readfirstlane(tid >> 6);
    const int b = bh >> 2, hh = bh & 3;
    const int nvalid = c == 0 ? NMETA : 128, p0 = c == 0 ? 0 : NMETA + 128 * (c - 1);
    const int nrep = c == 0 ? NB : 1;
    const bf16_t* PB = (const bf16_t*)(P.ws + WS_BIG); const float* GT = (const float*)(P.ws + WS_GATES);
    float* SC = (float*)(P.ws + WS_SC); float* NST = (float*)(P.ws + WS_NST); bf16_t* CST = (bf16_t*)(P.ws + WS_CST);
    const float* cw = P.in[8] + (size_t)layer * 4 * 1024; const float* cb = P.in[9] + (size_t)layer * 1024;
    LAS unsigned char* Kt = lds; LAS unsigned char* Vt = lds + 128 * TSTR; LAS float* sws = (LAS float*)(lds + 2 * 128 * TSTR);
    if (wid == 0) {
        const int i0 = 2 * lane, i1 = i0 + 1;
        float li0 = NEGF, li1 = NEGF, lf0 = 0.f, lf1 = 0.f;
        if (i0 < nvalid) { const size_t rw = seqrow(b, p0 + i0); li0 = GT[rw * 8 + hh]; lf0 = GT[rw * 8 + 4 + hh]; }
        if (i1 < nvalid) { const size_t rw = seqrow(b, p0 + i1); li1 = GT[rw * 8 + hh]; lf1 = GT[rw * 8 + 4 + hh]; }
        const float s = lf0 + lf1, incl = wscan_add(s, lane), excl = incl - s;
        const float b0 = excl + lf0, b1 = incl, g0 = li0 - b0, g1 = li1 - b1;
        const float gmax = wave_max(fmaxf(g0, g1));
        sws[i0] = i0 < nvalid ? ex2((g0 - gmax) * LOG2E) : 0.f;
        sws[i1] = i1 < nvalid ? ex2((g1 - gmax) * LOG2E) : 0.f;
        const float bend = __shfl(incl, 63);
        if (lane == 0) { for (int bb = 0; bb < nrep; ++bb) { SC[(size_t)((bh + 4 * bb) * NCH + c) * 2] = bend; SC[(size_t)((bh + 4 * bb) * NCH + c) * 2 + 1] = bend + gmax; } }
    }
    __syncthreads();
    ConvW ckw; convw_load(ckw, cw, cb, 512 + hh * 128 + 8 * (tid & 15));
#pragma unroll 2
    for (int it = 0; it < 4; ++it) {
        const int item = tid + 512 * it, i = item >> 4, ch = item & 15;
        u32x4 kw = {0u, 0u, 0u, 0u}, vw = {0u, 0u, 0u, 0u};
        if (i < nvalid) {
            f32x4 o0, o1; conv8w(PB, ckw, b, p0 + i, 512 + hh * 128 + 8 * ch, o0, o1);
            const float sc = 0.08838834764831845f * sws[i];
            kw = pack8(o0 * sc, o1 * sc);
            vw = *(const u32x4*)(PB + seqrow(b, p0 + i) * NPB + 1024 + hh * 128 + 8 * ch);
        }
        *(LAS u32x4*)(Kt + i * TSTR + ch * 16) = kw; *(LAS u32x4*)(Vt + i * TSTR + ch * 16) = vw;
    }
    __syncthreads();
    {
        const int h = lane >> 5, g = lane >> 4, q = (lane & 15) >> 2, pp = lane & 3;
        const int dkt = wid >> 1, dvt0 = (wid & 1) * 2;
        f32x16 acc[2];
#pragma unroll
        for (int t = 0; t < 2; ++t)
#pragma unroll
            for (int e = 0; e < 16; ++e) acc[t][e] = 0.f;
#pragma unroll
        for (int ks = 0; ks < 8; ++ks) {
            const int rowa = 16 * ks + 8 * h + q;
            const LAS unsigned char* ka = Kt + rowa * TSTR + (32 * dkt + 16 * (g & 1) + 4 * pp) * 2;
            const bf16x8 af = cat8(vtr(ka), vtr(ka + 4 * TSTR));
#pragma unroll
            for (int t = 0; t < 2; ++t) {
                const LAS unsigned char* va = Vt + rowa * TSTR + (32 * (dvt0 + t) + 16 * (g & 1) + 4 * pp) * 2;
                const bf16x8 bf = cat8(vtr(va), vtr(va + 4 * TSTR));
                acc[t] = mfma32(af, bf, acc[t]);
            }
        }
#pragma unroll
        for (int t = 0; t < 2; ++t) {
            const int dv = 32 * (dvt0 + t) + (lane & 31);
#pragma unroll
            for (int r4 = 0; r4 < 4; ++r4) {
                const int dk0 = 32 * dkt + 8 * r4 + 4 * h;
                u32x2 w; w.x = pk2(acc[t][4 * r4], acc[t][4 * r4 + 1]); w.y = pk2(acc[t][4 * r4 + 2], acc[t][4 * r4 + 3]);
                for (int bb = 0; bb < nrep; ++bb) *(u32x2*)(CST + (size_t)((bh + 4 * bb) * NCH + c) * 16384 + (size_t)dv * 128 + dk0) = w;
            }
        }
    }
    {
        LAS float* red = sws + 256;
        const int dk = tid & 127, part = tid >> 7;
        float sacc = 0.f;
#pragma unroll 8
        for (int i = 0; i < 32; ++i) sacc += __builtin_bit_cast(float, (unsigned)(*(const LAS unsigned short*)(Kt + (32 * part + i) * TSTR + dk * 2)) << 16);
        red[part * 128 + dk] = sacc;
        __syncthreads();
        if (tid < 128) { const float nsum = (red[tid] + red[128 + tid]) + (red[256 + tid] + red[384 + tid]); for (int bb = 0; bb < nrep; ++bb) NST[(size_t)((bh + 4 * bb) * NCH + c) * 128 + tid] = nsum; }
    }
    lds_barrier();
}

__device__ __forceinline__ void m2_phase(const Params& P) {
    float* SC = (float*)(P.ws + WS_SC); float* MST = SC + 32 * NCH * 2; float* NST = (float*)(P.ws + WS_NST); bf16_t* CST = (bf16_t*)(P.ws + WS_CST);
    const int NT = gridDim.x * 512;
    for (int task = bidx() * 512 + tidx(); task < 65536 + 4096; task += NT) {
        if (task < 65536) {
            const int bh = task >> 11, e8 = task & 2047;
            bf16_t* ptr = CST + (size_t)bh * NCH * 16384 + (size_t)e8 * 8;
            float run[8];
#pragma unroll
            for (int e = 0; e < 8; ++e) run[e] = 0.f;
            float m = NEGF;
#pragma unroll 1
            for (int c0 = 0; c0 < NCH; c0 += 5) {
                u32x4 loc[5];
#pragma unroll
                for (int j = 0; j < 5; ++j) loc[j] = *(const u32x4*)(ptr + (size_t)(c0 + j) * 16384);
#pragma unroll
                for (int j = 0; j < 5; ++j) {
                    const int c = c0 + j;
                    const float bend = SC[(size_t)(bh * NCH + c) * 2], mloc = SC[(size_t)(bh * NCH + c) * 2 + 1];
                    const float mn = fmaxf(bend + m, mloc), a = ex2((bend + m - mn) * LOG2E), bt = ex2((mloc - mn) * LOG2E);
                    u32x4 w; w.x = pk2(run[0], run[1]); w.y = pk2(run[2], run[3]); w.z = pk2(run[4], run[5]); w.w = pk2(run[6], run[7]);
                    *(u32x4*)(ptr + (size_t)c * 16384) = w;
                    run[0] = a * run[0] + bt * bflo(loc[j].x); run[1] = a * run[1] + bt * bfhi(loc[j].x);
                    run[2] = a * run[2] + bt * bflo(loc[j].y); run[3] = a * run[3] + bt * bfhi(loc[j].y);
                    run[4] = a * run[4] + bt * bflo(loc[j].z); run[5] = a * run[5] + bt * bfhi(loc[j].z);
                    run[6] = a * run[6] + bt * bflo(loc[j].w); run[7] = a * run[7] + bt * bfhi(loc[j].w);
                    if (e8 == 0) MST[bh * NCH + c] = m;
                    m = mn;
                }
            }
        } else {
            const int t2 = task - 65536, bh = t2 >> 7, dk = t2 & 127;
            float* ptr = NST + (size_t)bh * NCH * 128 + dk;
            float run = 0.f, m = NEGF;
#pragma unroll 1
            for (int c = 0; c < NCH; ++c) {
                const float bend = SC[(size_t)(bh * NCH + c) * 2], mloc = SC[(size_t)(bh * NCH + c) * 2 + 1];
                const float mn = fmaxf(bend + m, mloc), a = ex2((bend + m - mn) * LOG2E), bt = ex2((mloc - mn) * LOG2E);
                const float loc = ptr[(size_t)c * 128]; ptr[(size_t)c * 128] = run; run = a * run + bt * loc; m = mn;
            }
        }
    }
}

__device__ __forceinline__ void m3_unit(const Params& P, int layer, int bh, int c, LAS unsigned char* lds) {
    const int tid = tidx(), lane = tid & 63, wid = __builtin_amdgcn_readfirstlane(tid >> 6);
    const int b = bh >> 2, hh = bh & 3;
    const int nvalid = c == 0 ? NMETA : 128, p0 = c == 0 ? 0 : NMETA + 128 * (c - 1);
    const bf16_t* PB = (const bf16_t*)(P.ws + WS_BIG); const float* GT = (const float*)(P.ws + WS_GATES);
    const float* SC = (const float*)(P.ws + WS_SC); const float* MST = SC + 32 * NCH * 2; const float* NST = (const float*)(P.ws + WS_NST); const bf16_t* CST = (const bf16_t*)(P.ws + WS_CST);
    bf16_t* MA = (bf16_t*)(P.ws + WS_MA);
    const float* cw = P.in[8] + (size_t)layer * 4 * 1024; const float* cb = P.in[9] + (size_t)layer * 1024; const float* mng = P.in[11] + (size_t)layer * 512;
    LAS unsigned char* Qt = lds; LAS unsigned char* Kt = lds + 128 * RSTR; LAS unsigned char* Vt = lds + 2 * 128 * RSTR;
    LAS float* sg2 = (LAS float*)(lds + 2 * 128 * RSTR + 128 * TSTR); LAS float* sr2 = sg2 + 128; LAS float* sw = sg2 + 256; LAS float* semt = sg2 + 384; LAS float* sqn = sg2 + 512;
    LAS float* sst = sg2 + 640; LAS float* sst2 = sg2 + 896;
    if (wid == 0) {
        const int i0 = 2 * lane, i1 = i0 + 1;
        float li0 = NEGF, li1 = NEGF, lf0 = 0.f, lf1 = 0.f;
        if (i0 < nvalid) { const size_t rw = seqrow(b, p0 + i0); li0 = GT[rw * 8 + hh]; lf0 = GT[rw * 8 + 4 + hh]; }
        if (i1 < nvalid) { const size_t rw = seqrow(b, p0 + i1); li1 = GT[rw * 8 + hh]; lf1 = GT[rw * 8 + 4 + hh]; }
        const float s = lf0 + lf1, incl = wscan_add(s, lane), excl = incl - s;
        const float b0 = excl + lf0, b1 = incl, g0 = li0 - b0, g1 = li1 - b1;
        const float inclm = wscan_max(fmaxf(g0, g1), lane);
        float exclm = __shfl_up(inclm, 1); if (lane == 0) exclm = NEGF;
        const float cm0 = fmaxf(exclm, g0), cm1 = inclm;
        const float mprev = MST[bh * NCH + c];
        const float M0 = fmaxf(mprev, cm0), M1 = fmaxf(mprev, cm1);
        sg2[i0] = g0 * LOG2E; sg2[i1] = g1 * LOG2E; sr2[i0] = -M0 * LOG2E; sr2[i1] = -M1 * LOG2E;
        sw[i0] = ex2((mprev - M0) * LOG2E); sw[i1] = ex2((mprev - M1) * LOG2E);
        semt[i0] = ex2(-(b0 + M0) * LOG2E); semt[i1] = ex2(-(b1 + M1) * LOG2E);
    }
    ConvW cqw, ckw; convw_load(cqw, cw, cb, hh * 128 + 8 * (tid & 15)); convw_load(ckw, cw, cb, 512 + hh * 128 + 8 * (tid & 15));
#pragma unroll 2
    for (int it = 0; it < 4; ++it) {
        const int item = tid + 512 * it, i = item >> 4, ch = item & 15;
        u32x4 qw = {0u, 0u, 0u, 0u}, kw = {0u, 0u, 0u, 0u}, vw = {0u, 0u, 0u, 0u};
        if (i < nvalid) {
            f32x4 o0, o1;
            conv8w(PB, cqw, b, p0 + i, hh * 128 + 8 * ch, o0, o1); qw = pack8(o0, o1);
            conv8w(PB, ckw, b, p0 + i, 512 + hh * 128 + 8 * ch, o0, o1); kw = pack8(o0 * 0.08838834764831845f, o1 * 0.08838834764831845f);
            vw = *(const u32x4*)(PB + seqrow(b, p0 + i) * NPB + 1024 + hh * 128 + 8 * ch);
        }
        *(LAS u32x4*)(Qt + i * RSTR + ch * 16) = qw; *(LAS u32x4*)(Kt + i * RSTR + ch * 16) = kw; *(LAS u32x4*)(Vt + i * TSTR + ch * 16) = vw;
    }
    __syncthreads();
    {
        const int i = tid >> 2, part = tid & 3;
        const float* np = NST + (size_t)(bh * NCH + c) * 128 + 32 * part;
        float s = 0.f;
#pragma unroll
        for (int d8 = 0; d8 < 4; ++d8) {
            const u32x4 qv = *(const LAS u32x4*)(Qt + i * RSTR + (32 * part + 8 * d8) * 2);
            const f32x4 n0 = *(const f32x4*)(np + 8 * d8), n1 = *(const f32x4*)(np + 8 * d8 + 4);
            s += bflo(qv.x) * n0[0] + bfhi(qv.x) * n0[1] + bflo(qv.y) * n0[2] + bfhi(qv.y) * n0[3] + bflo(qv.z) * n1[0] + bfhi(qv.z) * n1[1] + bflo(qv.w) * n1[2] + bfhi(qv.w) * n1[3];
        }
        s += __shfl_xor(s, 1); s += __shfl_xor(s, 2);
        if (part == 0) sqn[i] = s;
    }
    const int r = lane & 31, h = lane >> 5, g = lane >> 4, q = (lane & 15) >> 2, pp = lane & 3;
    const int qb = wid >> 1, dvh = wid & 1, t = 32 * qb + r;
    bf16x8 qf[8];
#pragma unroll
    for (int ks = 0; ks < 8; ++ks) qf[ks] = *(const LAS bf16x8*)(Qt + t * RSTR + (16 * ks + 8 * h) * 2);
    f32x16 acc[2];
#pragma unroll
    for (int d = 0; d < 2; ++d)
#pragma unroll
        for (int e = 0; e < 16; ++e) acc[d][e] = 0.f;
    {
        const bf16_t* Cp = CST + (size_t)(bh * NCH + c) * 16384;
#pragma unroll
        for (int ks = 0; ks < 8; ++ks)
#pragma unroll
            for (int d = 0; d < 2; ++d) {
                const int dv = 32 * (2 * dvh + d) + r;
                const bf16x8 cf = *(const bf16x8*)(Cp + (size_t)dv * 128 + 16 * ks + 8 * h);
                acc[d] = mfma32(cf, qf[ks], acc[d]);
            }
    }
    __syncthreads();
    const float wt = sw[t], r2 = sr2[t];
#pragma unroll
    for (int d = 0; d < 2; ++d) acc[d] = acc[d] * wt;
    float den = 0.f;
#pragma unroll 1
    for (int kb = 0; kb <= qb; ++kb) {
        f32x16 st;
#pragma unroll
        for (int e = 0; e < 16; ++e) st[e] = 0.f;
#pragma unroll
        for (int ks = 0; ks < 8; ++ks) { const bf16x8 kf = *(const LAS bf16x8*)(Kt + (32 * kb + r) * RSTR + (16 * ks + 8 * h) * 2); st = mfma32(kf, qf[ks], st); }
#pragma unroll
        for (int r4 = 0; r4 < 4; ++r4) {
            const int s0 = 32 * kb + 8 * r4 + 4 * h;
            const f32x4 gs = *(const LAS f32x4*)(sg2 + s0);
#pragma unroll
            for (int e = 0; e < 4; ++e) {
                float v = st[4 * r4 + e] * ex2(r2 + gs[e]);
                if (s0 + e > t) v = 0.f;
                den += v; st[4 * r4 + e] = v;
            }
        }
#pragma unroll
        for (int s2 = 0; s2 < 2; ++s2) {
            u32x4 pw; pw.x = pk2(st[8 * s2], st[8 * s2 + 1]); pw.y = pk2(st[8 * s2 + 2], st[8 * s2 + 3]); pw.z = pk2(st[8 * s2 + 4], st[8 * s2 + 5]); pw.w = pk2(st[8 * s2 + 6], st[8 * s2 + 7]);
            const bf16x8 pf = __builtin_bit_cast(bf16x8, pw);
#pragma unroll
            for (int d = 0; d < 2; ++d) {
                const LAS unsigned char* va = Vt + (32 * kb + 16 * s2 + 4 * h + q) * TSTR + (32 * (2 * dvh + d) + 16 * (g & 1) + 4 * pp) * 2;
                const bf16x8 vf = cat8(vtr(va), vtr(va + 8 * TSTR));
                acc[d] = mfma32(vf, pf, acc[d]);
            }
        }
    }
    u32x2 mo_[2][4]; f32x4 gn_[2][4];
    {
        const size_t rowp = seqrow(b, p0 + (t < nvalid ? t : 0));
#pragma unroll
        for (int d = 0; d < 2; ++d)
#pragma unroll
            for (int r4 = 0; r4 < 4; ++r4) {
                const int col = hh * 128 + 32 * (2 * dvh + d) + 8 * r4 + 4 * h;
                mo_[d][r4] = *(const u32x2*)(PB + rowp * NPB + 1536 + col); gn_[d][r4] = *(const f32x4*)(mng + col);
            }
    }
    den += __shfl_xor(den, 32);
    den += wt * sqn[t];
    const float inv = 1.f / fmaxf(fabsf(den), semt[t]);
    float s1 = 0.f;
#pragma unroll
    for (int d = 0; d < 2; ++d)
#pragma unroll
        for (int e = 0; e < 16; ++e) { acc[d][e] *= inv; s1 += acc[d][e]; }
    s1 += __shfl_xor(s1, 32);
    if (h == 0) sst[wid * 32 + r] = s1;
    __syncthreads();
    const float mean = (s1 + sst[(wid ^ 1) * 32 + r]) * (1.f / 128.f);
    float q2 = 0.f;
#pragma unroll
    for (int d = 0; d < 2; ++d)
#pragma unroll
        for (int e = 0; e < 16; ++e) { acc[d][e] -= mean; q2 += acc[d][e] * acc[d][e]; }
    q2 += __shfl_xor(q2, 32);
    if (h == 0) sst2[wid * 32 + r] = q2;
    __syncthreads();
    const float rstd = 1.f / sqrtf((q2 + sst2[(wid ^ 1) * 32 + r]) * (1.f / 128.f) + LN_EPS);
    if (t < nvalid) {
        const size_t row = seqrow(b, p0 + t);
#pragma unroll
        for (int d = 0; d < 2; ++d)
#pragma unroll
            for (int r4 = 0; r4 < 4; ++r4) {
                const int col = hh * 128 + 32 * (2 * dvh + d) + 8 * r4 + 4 * h;
                const u32x2 mo = mo_[d][r4];
                const f32x4 g4 = gn_[d][r4];
                const float o0 = acc[d][4 * r4] * rstd * g4[0] * sigm(bflo(mo.x)), o1 = acc[d][4 * r4 + 1] * rstd * g4[1] * sigm(bfhi(mo.x));
                const float o2 = acc[d][4 * r4 + 2] * rstd * g4[2] * sigm(bflo(mo.y)), o3 = acc[d][4 * r4 + 3] * rstd * g4[3] * sigm(bfhi(mo.y));
                u32x2 w; w.x = pk2(o0, o1); w.y = pk2(o2, o3);
                *(u32x2*)(MA + row * 512 + col) = w;
            }
    }
    lds_barrier();
}

constexpr int AT_KB = 64 * RSTR, AT_VB = 64 * TSTR, AT_BUF = AT_KB + AT_VB;
__device__ __forceinline__ void attn_unit(const Params& P, int layer, int b, int hd, int pq0, int nvalid, float lam, float lam_init, LAS unsigned char* lds) {
    const int tid = tidx(), lane = tid & 63, wid = __builtin_amdgcn_readfirstlane(tid >> 6);
    const int c = wid >> 2, wq = wid & 3, r = lane & 31, h = lane >> 5, g = lane >> 4, q = (lane & 15) >> 2, pp = lane & 3;
    const bf16_t* PB = (const bf16_t*)(P.ws + WS_BIG); bf16_t* AO = (bf16_t*)(P.ws + WS_MA) + (size_t)MPAD * 512;
    const float* ang = P.in[16] + (size_t)layer * 512;
    const int qi = 32 * wq + r, qp = pq0 + qi;
    bf16x8 qf[4];
    {
        const size_t qrow = seqrow(b, qp < LSEQ ? qp : LSEQ - 1);
#pragma unroll
        for (int ks = 0; ks < 4; ++ks) qf[ks] = *(const bf16x8*)(PB + qrow * NPB + 2048 + hd * 128 + c * 64 + 16 * ks + 8 * h);
    }
    const float slope2 = ex2(-2.f * (float)(hd + 1)) * LOG2E;
    const int ntiles = (pq0 + nvalid - 1) / 64 + 1;
    float qkb;
    {
        float ss = 0.f;
#pragma unroll
        for (int ks = 0; ks < 4; ++ks)
#pragma unroll
            for (int j = 0; j < 8; ++j) { const float v = __builtin_bit_cast(float, (unsigned)(unsigned short)qf[ks][j] << 16); ss += v * v; }
        ss += __shfl_xor(ss, 32);
        const float* KM = (const float*)(P.ws + WS_KM) + layer * 72;
        const float k2 = fmaxf(KM[b * 8 + hd * 2 + c], KM[64 + hd * 2 + c]);
        qkb = sqrtf(ss) * sqrtf(k2) * 1.001f + 0.01f;
    }
    LAS unsigned* votes = (LAS unsigned*)(lds + 131072 + 2048);
    if (tid < 16) votes[tid] = 0u;
    u32x4 pk[2], pv[2];
#define AT_LOAD(kt) do { _Pragma("unroll") for (int i_ = 0; i_ < 2; ++i_) { const int row_ = (tid + 512 * i_) >> 4, ch_ = tid & 15; int kp_ = 64 * (kt) + row_; kp_ = kp_ < LSEQ ? kp_ : LSEQ - 1; \
        const bf16_t* src_ = PB + seqrow(b, kp_) * NPB + hd * 128 + ch_ * 8; pk[i_] = *(const u32x4*)(src_ + 2560); pv[i_] = *(const u32x4*)(src_ + 3072); } } while (0)
#define AT_STORE(s) do { _Pragma("unroll") for (int i_ = 0; i_ < 2; ++i_) { const int row_ = (tid + 512 * i_) >> 4, ch_ = tid & 15; \
        *(LAS u32x4*)(lds + (s) * AT_BUF + row_ * RSTR + ch_ * 16) = pk[i_]; *(LAS u32x4*)(lds + (s) * AT_BUF + AT_KB + row_ * TSTR + ch_ * 16) = pv[i_]; } } while (0)
    AT_LOAD(ntiles - 1); AT_STORE((ntiles - 1) & 1);
    __syncthreads();
    float m_run = NEGF, l_run = 0.f;
    f32x16 o[4];
#pragma unroll
    for (int d = 0; d < 4; ++d)
#pragma unroll
        for (int e = 0; e < 16; ++e) o[d][e] = 0.f;
#pragma unroll 1
    for (int kt = ntiles - 1; kt >= 0; --kt) {
        const int s = kt & 1;
        if (kt > 0) AT_LOAD(kt - 1);
        const LAS unsigned char* Kb = lds + s * AT_BUF; const LAS unsigned char* Vb = Kb + AT_KB;
        if (64 * kt <= pq0 + 32 * wq + 31) {
        f32x16 st[2];
#pragma unroll
        for (int kb2 = 0; kb2 < 2; ++kb2) {
            const float tb = slope2 * (float)(64 * kt + 32 * kb2 - pq0 + 4 * h);
#pragma unroll
            for (int e = 0; e < 16; ++e) st[kb2][e] = tb + slope2 * (float)((e & 3) + 8 * (e >> 2));
#pragma unroll
            for (int ks = 0; ks < 4; ++ks) { const bf16x8 kf = *(const LAS bf16x8*)(Kb + (32 * kb2 + r) * RSTR + (c * 64 + 16 * ks + 8 * h) * 2); st[kb2] = mfma32(kf, qf[ks], st[kb2]); }
        }
        if (64 * kt + 63 > pq0 + 32 * wq) {
#pragma unroll
            for (int kb2 = 0; kb2 < 2; ++kb2)
#pragma unroll
                for (int e = 0; e < 16; ++e) { const int kp = 64 * kt + 32 * kb2 + (e & 3) + 8 * (e >> 2) + 4 * h; if (kp > qp) st[kb2][e] = NEGF; }
        }
        float mx = st[0][0];
#pragma unroll
        for (int e = 1; e < 16; ++e) mx = fmaxf(mx, st[0][e]);
#pragma unroll
        for (int e = 0; e < 16; ++e) mx = fmaxf(mx, st[1][e]);
        mx = fmaxf(mx, __shfl_xor(mx, 32));
        if (__any(mx > m_run + 8.f)) {
            const float m_new = fmaxf(m_run, mx), alpha = ex2(m_run - m_new);
            m_run = m_new; l_run *= alpha;
#pragma unroll
            for (int d = 0; d < 4; ++d) o[d] = o[d] * alpha;
        }
        const float m_new = m_run;
        float psum = 0.f;
#pragma unroll
        for (int kb2 = 0; kb2 < 2; ++kb2)
#pragma unroll
            for (int e = 0; e < 16; ++e) { const float p = ex2(st[kb2][e] - m_new); st[kb2][e] = p; psum += p; }
        l_run += psum;
#pragma unroll
        for (int kb2 = 0; kb2 < 2; ++kb2)
#pragma unroll
            for (int s2 = 0; s2 < 2; ++s2) {
                u32x4 pw; pw.x = pk2(st[kb2][8 * s2], st[kb2][8 * s2 + 1]); pw.y = pk2(st[kb2][8 * s2 + 2], st[kb2][8 * s2 + 3]); pw.z = pk2(st[kb2][8 * s2 + 4], st[kb2][8 * s2 + 5]); pw.w = pk2(st[kb2][8 * s2 + 6], st[kb2][8 * s2 + 7]);
                const bf16x8 pf = __builtin_bit_cast(bf16x8, pw);
#pragma unroll
                for (int d = 0; d < 4; ++d) {
                    const LAS unsigned char* va = Vb + (32 * kb2 + 16 * s2 + 4 * h + q) * TSTR + (32 * d + 16 * (g & 1) + 4 * pp) * 2;
                    const bf16x8 vf = cat8(vtr(va), vtr(va + 8 * TSTR));
                    o[d] = mfma32(vf, pf, o[d]);
                }
            }
        }
        if (kt > 0) {
            const float bnd = qkb + slope2 * (float)(64 * (kt - 1) + 63 - pq0);
            const bool dn = !__any(bnd >= m_run - 44.f);
            if (lane == 0) votes[s * 8 + wid] = dn ? 1u : 0u;
            AT_STORE(s ^ 1);
        }
        __syncthreads();
        if (kt > 0) {
            const u32x4 v0 = *(const LAS u32x4*)(votes + s * 8), v1 = *(const LAS u32x4*)(votes + s * 8 + 4);
            const unsigned all = (unsigned)__builtin_amdgcn_readfirstlane((int)((v0.x & v0.y) & (v0.z & v0.w) & (v1.x & v1.y) & (v1.z & v1.w)));
            if (all) break;
        }
    }
#undef AT_LOAD
#undef AT_STORE
    const float l_tot = l_run + __shfl_xor(l_run, 32), inv = 1.f / l_tot;
    LAS float* xch = (LAS float*)lds;
    if (c == 1) {
#pragma unroll
        for (int d = 0; d < 4; ++d)
#pragma unroll
            for (int e = 0; e < 16; ++e) xch[((wq * 4 + d) * 16 + e) * 64 + lane] = o[d][e] * inv;
    }
    __syncthreads();
    if (c == 0) {
        float ss = 0.f;
#pragma unroll
        for (int d = 0; d < 4; ++d)
#pragma unroll
            for (int e = 0; e < 16; ++e) { const float v = o[d][e] * inv - lam * xch[((wq * 4 + d) * 16 + e) * 64 + lane]; o[d][e] = v; ss += v * v; }
        ss += __shfl_xor(ss, 32);
        const float rms = (1.f / sqrtf(ss * (1.f / 128.f) + LN_EPS)) * (1.f - lam_init);
        f32x4 ga_[4][4];
#pragma unroll
        for (int d = 0; d < 4; ++d)
#pragma unroll
            for (int r4 = 0; r4 < 4; ++r4) ga_[d][r4] = *(const f32x4*)(ang + hd * 128 + 32 * d + 8 * r4 + 4 * h);
        if (qi < nvalid) {
            const size_t row = seqrow(b, qp);
#pragma unroll
            for (int d = 0; d < 4; ++d)
#pragma unroll
                for (int r4 = 0; r4 < 4; ++r4) {
                    const int col = hd * 128 + 32 * d + 8 * r4 + 4 * h;
                    const f32x4 g4 = ga_[d][r4];
                    u32x2 w; w.x = pk2(o[d][4 * r4] * rms * g4[0], o[d][4 * r4 + 1] * rms * g4[1]); w.y = pk2(o[d][4 * r4 + 2] * rms * g4[2], o[d][4 * r4 + 3] * rms * g4[3]);
                    *(u32x2*)(AO + row * 512 + col) = w;
                }
        }
    }
    lds_barrier();
}

#define XB_TMO      128
#define XB_XCNT(j)  (256  + 64 * (j))
#define XB_XSUB(j)  (1280 + 64 * (j))
#define XB_XGEN(j)  (2304 + 64 * (j))
#define XB_TOP      3328
#define XB_TOPGEN   3392
#define XCD_BAR_WORDS 3456
#define XB_SPIN_CAP (1u << 18)

__device__ __forceinline__ unsigned xb_ld(unsigned* p)              { return __hip_atomic_load(p, __ATOMIC_RELAXED, __HIP_MEMORY_SCOPE_AGENT); }
__device__ __forceinline__ unsigned xb_add(unsigned* p, unsigned v) { return __hip_atomic_fetch_add(p, v, __ATOMIC_RELAXED, __HIP_MEMORY_SCOPE_AGENT); }
__device__ __forceinline__ unsigned xb_xcc_id() { return (unsigned)__builtin_amdgcn_s_getreg((3 << 11) | 20) & 0xFu; }
#define XB_SPIN(cond, bar) do { unsigned _sp = 0; while (cond) { __builtin_amdgcn_s_sleep(1); \
    if ((++_sp & 255u) == 0u) { if (xb_ld(&(bar)[XB_TMO])) break; if (_sp > XB_SPIN_CAP) { atomicAdd(&(bar)[XB_TMO], 1u); break; } } } } while (0)

struct XcdBarrier {
    unsigned* bar; unsigned x;
    volatile LAS unsigned* st;
};

__device__ __forceinline__ XcdBarrier xcd_barrier_post(unsigned* bar, volatile LAS unsigned* st) {
    XcdBarrier b; b.bar = bar; b.x = xb_xcc_id(); b.st = st;
    if (threadIdx.x == 0) (void)xb_add(&bar[XB_XCNT(b.x)], 1u);
    return b;
}
__device__ __forceinline__ void xcd_barrier_complete(unsigned* bar, unsigned x, unsigned& nloc, unsigned& nx) {
    const unsigned G = gridDim.x * gridDim.y * gridDim.z;
    unsigned sum, cnt, mine, sp = 0u;
    for (;;) {
        sum = 0u; cnt = 0u; mine = 0u;
#pragma unroll
        for (unsigned j = 0; j < 16; ++j) { const unsigned c = xb_ld(&bar[XB_XCNT(j)]); sum += c; cnt += (c > 0u) ? 1u : 0u; mine = (j == x) ? c : mine; }
        if (sum == G) break;
        __builtin_amdgcn_s_sleep(1);
        if ((++sp & 255u) == 0u) { if (xb_ld(&bar[XB_TMO])) break; if (sp > XB_SPIN_CAP) { atomicAdd(&bar[XB_TMO], 1u); break; } }
    }
    nloc = mine > 0u ? mine : 1u; nx = cnt > 0u ? cnt : 1u;
}

__device__ __forceinline__ void xcd_barrier(const XcdBarrier& b) {
    asm volatile("s_waitcnt vmcnt(0)" ::: "memory");
    __syncthreads();
    if (threadIdx.x == 0) {
        unsigned* bar = b.bar;
        __builtin_amdgcn_s_waitcnt(0);
        unsigned nloc = b.st[0], nx = b.st[1];
        if (nloc == 0u) { xcd_barrier_complete(bar, b.x, nloc, nx); b.st[0] = nloc; b.st[1] = nx; }
        const unsigned old = xb_add(&bar[XB_XSUB(b.x)], 1u);
        const unsigned gen = old / nloc;
        if (old + 1u == (gen + 1u) * nloc) {
            __builtin_amdgcn_fence(__ATOMIC_RELEASE, "agent");
            asm volatile("s_waitcnt vmcnt(0)" ::: "memory");
            const unsigned og = xb_add(&bar[XB_TOP], 1u);
            const unsigned tg = og / nx;
            if (og + 1u == (tg + 1u) * nx) xb_add(&bar[XB_TOPGEN], 1u);
            else XB_SPIN(xb_ld(&bar[XB_TOPGEN]) == tg, bar);
            __builtin_amdgcn_fence(__ATOMIC_ACQUIRE, "agent");
            xb_add(&bar[XB_XGEN(b.x)], 1u);
            asm volatile("s_waitcnt vmcnt(0)" ::: "memory");
        } else {
            XB_SPIN(xb_ld(&bar[XB_XGEN(b.x)]) == gen, bar);
            __builtin_amdgcn_fence(__ATOMIC_ACQUIRE, "agent");
            asm volatile("s_waitcnt vmcnt(0)" ::: "memory");
        }
    }
    __syncthreads();
}

#ifndef PROBE_ATT
#define PROBE_ATT 1
#endif
#ifndef PROBE_M3
#define PROBE_M3 1
#endif
constexpr int LDS_BYTES = 147456;
#ifndef PROG_LAYER
#define PROG_LAYER(L) 16*L+0, 16*L+1, 16*L+3, 16*L+4, 16*L+5, 16*L+6, 16*L+7, 16*L+8, 16*L+9, 16*L+11, 16*L+12
#endif
__device__ const unsigned char PROG[] = { PROG_LAYER(0), PROG_LAYER(1), 16 * 1 + 13 };
constexpr int NSTEP = 14;
__global__ void __launch_bounds__(512) hybrid_fwd(Params P) {
    extern __shared__ __attribute__((aligned(16))) unsigned char smem[];
    LAS unsigned char* lds = (LAS unsigned char*)smem;
    cg::grid_group grid = cg::this_grid();
    unsigned* barw = (unsigned*)(P.ws + WS_BAR);
    volatile LAS unsigned* bst = (volatile LAS unsigned*)(lds + 131072 + 1024);
    if (blockIdx.x == 0) for (int i = threadIdx.x; i < XCD_BAR_WORDS; i += 512) __hip_atomic_store(barw + i, 0u, __ATOMIC_RELAXED, __HIP_MEMORY_SCOPE_AGENT);
    if (blockIdx.x == 0 && threadIdx.x < 144) __hip_atomic_store((unsigned*)(P.ws + WS_KM) + threadIdx.x, 0u, __ATOMIC_RELAXED, __HIP_MEMORY_SCOPE_AGENT);
    if (threadIdx.x < 2) bst[threadIdx.x] = 0u;
    __syncthreads();

#ifndef PROBE_P0
#define PROBE_P0 1
#endif
#pragma unroll 1
    for (int rep0_ = 0; rep0_ < PROBE_P0; ++rep0_)
    {
        const int lane = tidx() & 63, wid = tidx() >> 6, gw = bidx() * 8 + wid, NGW = gridDim.x * 8;
        bf16_t* HB = (bf16_t*)(P.ws + WS_HB); float* HFM = (float*)(P.ws + WS_HFM);
        LAS float* scr = (LAS float*)(lds + wid * 16384);
        for (int it = gw; it < 2 * CW_ITEMS; it += NGW) conv_weight_item(P, it / CW_ITEMS, it % CW_ITEMS, scr, lane);
        const float* x = P.in[0]; const float* meta = P.in[1];
        {
            const size_t NT8 = (size_t)gridDim.x * 512, n8 = (size_t)MREAL * DM / 8;
#pragma unroll 4
            for (size_t i = (size_t)bidx() * 512 + tidx(); i < n8; i += NT8) {
                const f32x4 v0 = *(const f32x4*)(x + i * 8), v1 = *(const f32x4*)(x + i * 8 + 4);
                *(u32x4*)(HB + i * 8) = pack8(v0, v1);
            }
        }
        for (int row = gw; row < NMETA; row += NGW) {
#pragma unroll
            for (int j = 0; j < 4; ++j) {
                const f32x4 v = *(const f32x4*)(meta + (size_t)row * DM + 256 * j + 4 * lane);
                *(f32x4*)(HFM + (size_t)row * DM + 256 * j + 4 * lane) = v;
                u32x2 w; w.x = pk2(v[0], v[1]); w.y = pk2(v[2], v[3]);
                *(u32x2*)(HB + (size_t)(MROW0 + row) * DM + 256 * j + 4 * lane) = w;
            }
        }
    }
    grid.sync();
    (void)xcd_barrier_post(barw, bst);

#pragma unroll 1
    for (int ph = 0; ph < (int)sizeof(PROG); ++ph) {
        const int layer = PROG[ph] >> 4, step = PROG[ph] & 15;
        const int G = gridDim.x;
#define TIDV const int tid_ = tidx(), lane = tid_ & 63, wid = __builtin_amdgcn_readfirstlane(tid_ >> 6); (void)lane; (void)wid;
        bf16_t* HB = (bf16_t*)(P.ws + WS_HB); float* HFM = (float*)(P.ws + WS_HFM);
        bf16_t* BIG = (bf16_t*)(P.ws + WS_BIG); bf16_t* MA = (bf16_t*)(P.ws + WS_MA);
        const bf16_t* Wl = (const bf16_t*)(P.ws + WS_W) + (size_t)layer * OW_LAYER;
#define LNCTX float* ROWS = (float*)(P.ws + WS_ROWS); const float* CSl = (const float*)(P.ws + WS_CSBW) + (size_t)layer * 2 * OC_N; const float* BWl = CSl + OC_N; \
        const int tlast = 3 * layer + (step <= 1 ? -1 : step <= 9 ? 0 : step <= 12 ? 1 : 2);   \
        const float* rows_last = ROWS + (size_t)((tlast & 1) * MPAD) * 2; (void)CSl; (void)BWl; (void)rows_last;
        if (step == 0 || step == 3 || step == 11) {
            LNCTX
            float* z = ROWS + (size_t)(((tlast + 1) & 1) * MPAD) * 2;
            for (int i = bidx() * 512 + tidx(); i < MPAD * 2 / 4; i += G * 512) *(f32x4*)(z + 4 * i) = (f32x4){0.f, 0.f, 0.f, 0.f};
        }
        if (step == 0 || step == 11) {
            LNCTX
            const bf16_t* Wgu = Wl + (step ? OW_GU2 : OW_GU1); const int oc = step ? OC_GU2 : OC_GU1;
            const pg8::LnFix fx{rows_last, CSl + oc, BWl + oc, tlast >= 0 ? 1 : 0};
            pg8::Gemm gm{HB, Wgu, MREAL, 2 * FF, DM}; pg8::StaticOrder S; S.init(MREAL, 2 * FF, G, bidx());
            pg8::EpiSwiglu E{BIG, FF, fx};
            pg8::gemm_phase<pg8::EpiSwiglu, pg8::StaticOrder, true, true>(lds, gm, S, E);
            for (int ct = bidx(); ct < FF / 16; ct += G) {
                TIDV
                const int c0 = 16 * ct, R0 = 256 * (c0 >> 7) + (c0 & 127);
                const f32x4 ag = sg_tile_blk(HB + (size_t)MROW0 * DM, DM, Wgu, DM, R0, lane, wid, (LAS float*)lds), au = sg_tile_blk(HB + (size_t)MROW0 * DM, DM, Wgu, DM, R0 + 128, lane, wid, (LAS float*)lds);
                if (wid == 0) {
                    const int rb = R0 + (lane & 15);
#pragma unroll
                    for (int e = 0; e < 4; ++e) {
                        const size_t row = (size_t)(MROW0 + 4 * (lane >> 4) + e);
                        float gv = ag[e], uv = au[e];
                        if (fx.on) { float mu, r; fx.stats(row, mu, r); gv = (gv - fx.cs[rb] * mu) * r + fx.bw[rb]; uv = (uv - fx.cs[rb + 128] * mu) * r + fx.bw[rb + 128]; }
                        BIG[row * FF + c0 + (lane & 15)] = (bf16_t)f2bf(siluf(gv) * uv);
                    }
                }
            }
        } else if (step == 1 || step == 9 || step == 12) {
            LNCTX
            const bf16_t* A = step == 9 ? MA : BIG; const bf16_t* Bt = Wl + (step == 1 ? OW_D1 : step == 9 ? OW_OUT : OW_D2);
            const int K = step == 9 ? DM : FF; const float sc = step == 9 ? 1.f : 0.5f;
            pg8::Gemm gm{A, Bt, MREAL, DM, K}; pg8::StaticOrder S; S.init(MREAL, DM, G, bidx());
            const int raw = tlast < 0 ? 1 : 0;
            const int gi = step == 1 ? (layer == 0 ? 5 : 26) : step == 9 ? 5 : 21;
            const int gl = step == 1 ? (layer == 0 ? 0 : layer - 1) : layer;
            const float* gam = P.in[gi] + (size_t)gl * DM; const float* bet = P.in[gi + 1] + (size_t)gl * DM;
            float* rows_cur = ROWS + (size_t)(((tlast + 1) & 1) * MPAD) * 2;
            pg8::EpiResid E{P.in[0], (bf16_t*)(P.ws + WS_LO), HB, rows_last, rows_cur, gam, bet, sc, raw};
            pg8::gemm_phase<pg8::EpiResid, pg8::StaticOrder, true, true>(lds, gm, S, E);
            for (int ct = bidx(); ct < 64; ct += G) {
                TIDV
                const f32x4 a = sg_tile_blk(A + (size_t)MROW0 * K, K, Bt, K, 16 * ct, lane, wid, (LAS float*)lds);
                const int col = 16 * ct + (lane & 15);
                if (wid == 0) {
#pragma unroll
                    for (int e = 0; e < 4; ++e) {
                        const int mr = 4 * (lane >> 4) + e; float* p = HFM + (size_t)mr * DM + col;
                        float h = *p;
                        if (!raw) { const float s1 = rows_last[(size_t)(MROW0 + mr) * 2], s2 = rows_last[(size_t)(MROW0 + mr) * 2 + 1], mu = s1 * (1.f / DM), r = __builtin_amdgcn_rsqf(s2 * (1.f / DM) - mu * mu + LN_EPS);
                            h = (h - mu) * r * gam[col] + bet[col]; }
                        const float y = ALPHA * h + sc * a[e];
                        *p = y; HB[(size_t)(MROW0 + mr) * DM + col] = (bf16_t)f2bf(y);
                        float q1 = y, q2 = y * y;
                        q1 += __shfl_xor(q1, 1); q1 += __shfl_xor(q1, 2); q1 += __shfl_xor(q1, 4); q1 += __shfl_xor(q1, 8);
                        q2 += __shfl_xor(q2, 1); q2 += __shfl_xor(q2, 2); q2 += __shfl_xor(q2, 4); q2 += __shfl_xor(q2, 8);
                        if ((lane & 15) == 0) { atomicAdd(rows_cur + (size_t)(MROW0 + mr) * 2, q1); atomicAdd(rows_cur + (size_t)(MROW0 + mr) * 2 + 1, q2); }
                    }
                }
            }
        } else if (step == 13) {
            ln_phase(P, P.in[26] + (size_t)layer * DM, P.in[27] + (size_t)layer * DM, false, true, nullptr, nullptr, lds);
        } else if (step == 3 || step == 7) {
            LNCTX
            const int ng = step == 3 ? 1 : 2;
            float* GT = (float*)(P.ws + WS_GATES); const float* bif = P.in[10] + (size_t)layer * 8;
#pragma unroll 1
            for (int gi = 0; gi < ng; ++gi) {
                const bf16_t* A = step == 3 ? HB : MA + (size_t)gi * MPAD * 512;
                const bf16_t* Bt = Wl + (step == 3 ? OW_PB : gi ? OW_BA : OW_BM);
                const int N = step == 3 ? NPBW : DM, K = step == 3 ? DM : 512, ldc = step == 3 ? NPB : 2048, coff = gi * DM;
                const pg8::LnFix fx{rows_last, CSl + OC_PB, BWl + OC_PB, step == 3 ? 1 : 0};
                pg8::Gemm gm{A, Bt, MREAL, N, K}; pg8::StaticOrder S; S.init(MREAL, N, G, bidx());
                pg8::EpiPlain E{BIG, ldc, coff, step == 3 ? 8 : 0, step == 3 ? 10 : 0, QSCALE, fx, step == 3 ? GT : nullptr, bif};
                pg8::gemm_phase<pg8::EpiPlain, pg8::StaticOrder, true, true>(lds, gm, S, E);
                const int ntile = step == 3 ? NPB / 16 + 1 : N / 16;
                for (int ct = bidx(); ct < ntile; ct += G) {
                    TIDV
                    const f32x4 a = sg_tile_blk(A + (size_t)MROW0 * K, K, Bt, K, 16 * ct, lane, wid, (LAS float*)lds);
                    const float sc = (step == 3 && 16 * ct >= 2048 && 16 * ct < 2560) ? QSCALE : 1.f;
                    if (wid == 0) {
                        const int rb = 16 * ct + (lane & 15);
#pragma unroll
                        for (int e = 0; e < 4; ++e) {
                            const size_t row = (size_t)(MROW0 + 4 * (lane >> 4) + e);
                            float v = a[e];
                            if (fx.on) { float mu, r; fx.stats(row, mu, r); v = (v - fx.cs[rb] * mu) * r + fx.bw[rb]; }
                            if (step == 3 && ct == NPB / 16) {
                                if ((lane & 15) < 8) { const float z = v + bif[lane & 15]; GT[row * 8 + (lane & 15)] = (lane & 15) < 4 ? z : fminf(z, 0.f) - __logf(1.f + __expf(-fabsf(z))); }
                            } else BIG[row * ldc + coff + rb] = (bf16_t)f2bf(v * sc);
                        }
                    }
                }
            }
        } else if (step == 4) {
            {
                float* KM = (float*)(P.ws + WS_KM) + layer * 72;
                TIDV
                const int gw = bidx() * 8 + wid, NGW = G * 8;
#pragma unroll 1
                for (int task = gw; task < 2049; task += NGW) {
                    const int real = task < 2048, slot = real ? task >> 8 : 8, nr = real ? 32 : NMETA;
                    const size_t r0 = real ? (size_t)(task >> 8) * SEQ + (size_t)(task & 255) * 32 : (size_t)MROW0;
                    float mxv = 0.f;
#pragma unroll 4
                    for (int i = 0; i < nr; ++i) {
                        const u32x4 v = *(const u32x4*)(BIG + (r0 + i) * NPB + 2560 + lane * 8);
                        float ss = bflo(v.x) * bflo(v.x) + bfhi(v.x) * bfhi(v.x) + bflo(v.y) * bflo(v.y) + bfhi(v.y) * bfhi(v.y) + bflo(v.z) * bflo(v.z) + bfhi(v.z) * bfhi(v.z) + bflo(v.w) * bflo(v.w) + bfhi(v.w) * bfhi(v.w);
                        ss += __shfl_xor(ss, 1); ss += __shfl_xor(ss, 2); ss += __shfl_xor(ss, 4);
                        mxv = fmaxf(mxv, ss);
                    }
                    if ((lane & 7) == 0) atomicMax((unsigned*)KM + slot * 8 + (lane >> 3), __builtin_bit_cast(unsigned, mxv));
                }
            }
            for (int u = bidx(); u < 2048 + 4; u += G) { const int bh_ = u < 2048 ? u >> 6 : u - 2048, c_ = u < 2048 ? 1 + (u & 63) : 0; m1_unit(P, layer, bh_, c_, lds); }
        } else if (step == 5) {
            m2_phase(P);
        } else if (step == 6) {
            const float lam_init = layer == 0 ? 0.2f : 0.35550906759f;
            float lam;
            {
                TIDV
                const float* l1 = P.in[12] + layer * 64; const float* k1 = P.in[13] + layer * 64; const float* l2 = P.in[14] + layer * 64; const float* k2 = P.in[15] + layer * 64;
                const float s1 = wave_sum(l1[lane] * k1[lane]), s2 = wave_sum(l2[lane] * k2[lane]);
                lam = expf(s1) - expf(s2) + lam_init;
            }
#pragma unroll 1
            for (int rep_ = 0; rep_ < PROBE_ATT; ++rep_)
#pragma unroll 1
            for (int u = bidx(); u < 2048 + 4; u += G) {
                const int cbv = u & 255, i = u >> 8, jj = cbv & 31, j = (i & 4) ? 63 - jj : jj;
                const bool real = u < 2048; const int bh = real ? ((cbv >> 5) * 4 + (i & 3)) : (u - 2048);
                attn_unit(P, layer, bh >> 2, bh & 3, real ? NMETA + 128 * j : 0, real ? 128 : NMETA, lam, lam_init, lds);
            }
#pragma unroll 1
            for (int rep_ = 0; rep_ < PROBE_M3; ++rep_)
#pragma unroll 1
            for (int u = bidx(); u < 2048 + 4; u += G) { const int bh_ = u < 2048 ? u >> 6 : u - 2048, c_ = u < 2048 ? 1 + (u & 63) : 0; m3_unit(P, layer, bh_, c_, lds); }
        } else if (step == 8) {
            const bf16_t* Y = BIG; const float* bg = P.in[19] + (size_t)layer * 2048;
            pg8::Gemm gm{HB, Wl + OW_GM, MREAL, 2048, DM}; pg8::StaticOrder S; S.init(MREAL, 2048, G, bidx());
            LNCTX
            const pg8::LnFix fx{rows_last, CSl + OC_GM, BWl + OC_GM, 1};
            pg8::EpiGate E{MA, Y, bg, fx};
            pg8::gemm_phase<pg8::EpiGate, pg8::StaticOrder, true, true>(lds, gm, S, E);
            for (int ct = bidx(); ct < 64; ct += G) {
                TIDV
                const int c0 = 16 * ct, R0 = 256 * (c0 >> 7) + (c0 & 127);
                const f32x4 am = sg_tile_blk(HB + (size_t)MROW0 * DM, DM, Wl + OW_GM, DM, R0, lane, wid, (LAS float*)lds), aa = sg_tile_blk(HB + (size_t)MROW0 * DM, DM, Wl + OW_GM, DM, R0 + 128, lane, wid, (LAS float*)lds);
                const int col = c0 + (lane & 15), rb = R0 + (lane & 15);
                if (wid == 0) {
#pragma unroll
                    for (int e = 0; e < 4; ++e) {
                        const size_t row = (size_t)(MROW0 + 4 * (lane >> 4) + e);
                        float mu, r; fx.stats(row, mu, r);
                        const float gmv = (am[e] - fx.cs[rb] * mu) * r + fx.bw[rb], gav = (aa[e] - fx.cs[rb + 128] * mu) * r + fx.bw[rb + 128];
                        const float ym = bflo((unsigned)Y[row * 2048 + col]), ya = bflo((unsigned)Y[row * 2048 + DM + col]);
                        MA[row * DM + col] = (bf16_t)f2bf(sigm(gmv) * ym + sigm(gav) * ya);
                    }
                }
            }
        }
        {
            unsigned char* wsb = P.ws; asm volatile("" : "+s"(wsb));
            XcdBarrier xb; xb.bar = (unsigned*)(wsb + WS_BAR); xb.x = xb_xcc_id(); xb.st = (volatile LAS unsigned*)(lds + 131072 + 1024);
            xcd_barrier(xb);
#ifdef PROBE_SYNC
            for (int i_ = 0; i_ < PROBE_SYNC; ++i_) xcd_barrier(xb);
#endif
        }
    }
}

extern "C" void kernel_launch(void* const* d_in, const int* in_sizes, int n_in, void* d_out, int out_size, void* d_ws, size_t ws_size, hipStream_t stream) {
    static int grid = 0;
    if (grid == 0) {
        if (n_in != 28 || out_size != MREAL * DM || ws_size < WS_END) { fprintf(stderr, "kernel_launch: unexpected shapes (n_in %d out %d ws %zu)\n", n_in, out_size, ws_size); grid = -1; return; }
        int dev = 0, cus = 0, per_cu = 0;
        hipGetDevice(&dev); hipDeviceGetAttribute(&cus, hipDeviceAttributeMultiprocessorCount, dev);
        hipFuncSetAttribute((const void*)hybrid_fwd, hipFuncAttributeMaxDynamicSharedMemorySize, LDS_BYTES);
        hipOccupancyMaxActiveBlocksPerMultiprocessor(&per_cu, (const void*)hybrid_fwd, 512, LDS_BYTES);
        if (per_cu < 1) per_cu = 1;
        grid = cus * per_cu;
        (void)hipGetLastError();
    }
    if (grid < 0) return;
    Params p{};
    for (int i = 0; i < 28; ++i) p.in[i] = (const float*)d_in[i];
    p.out = (float*)d_out; p.ws = (unsigned char*)d_ws;
    void* args[] = {&p};
    hipError_t e = hipLaunchCooperativeKernel((const void*)hybrid_fwd, dim3(grid), dim3(512), args, LDS_BYTES, stream);
    if (e != hipSuccess) fprintf(stderr, "cooperative launch failed: %s (grid %d)\n", hipGetErrorString(e), grid);
}
```

```cpp
#include <hip/hip_runtime.h>
#include <hip/hip_cooperative_groups.h>
#include <cstdio>
#include <cstdint>
namespace cg = cooperative_groups;

__device__ __forceinline__ int tidx() { int t = threadIdx.x; asm volatile("" : "+v"(t)); return t; }
__device__ __forceinline__ int bidx() { int t = blockIdx.x; asm volatile("" : "+s"(t)); return t; }
namespace pg8 {
#define PG8_LAS __attribute__((address_space(3)))
typedef unsigned short bf16_t;
typedef short bf16x8 __attribute__((ext_vector_type(8)));
typedef float f32x4 __attribute__((ext_vector_type(4)));
typedef unsigned u32x4 __attribute__((ext_vector_type(4)));
constexpr int BM = 256, BK = 64, HALF = 128, HTB = HALF * BK * 2  , STAGE_BYTES = 8 * HTB, NXCD = 8, WGM = 8;

__host__ __device__ __forceinline__ int lds_byte(int r, int c) { const int st = (r >> 4) * 2 + (c >> 5), rr = r & 15, cc = c & 31, ob = rr * 64 + cc * 2; return st * 1024 + (ob ^ (((ob >> 9) & 1) << 5)); }
__host__ __device__ __forceinline__ void stage_rc(int b, int& R, int& C) { const int st = b / 1024, sb = b % 1024, swz = sb ^ (((sb >> 9) & 1) << 5); R = (st >> 1) * 16 + swz / 64; C = (st & 1) * 32 + (swz % 64) / 2; }
__host__ __device__ __forceinline__ int perm32(int rho) { const int n = rho >> 4, i = rho & 15; return 8 * (i >> 2) + 4 * n + (i & 3); }

struct Unit { int pm, pn; };
struct Gemm { const bf16_t* A; const bf16_t* Bt; int M, N, K; };

struct StaticOrder {
    int nM, nN, nwg, G, c;
    __host__ __device__ void init(int M, int N, int G_, int c_) { nM = M / BM; nN = N / BM; nwg = nM * nN; G = G_; c = c_; }
    __host__ __device__ bool next(int i, Unit& u) const {
        const long L = (long)i * G + c; if (L >= nwg) return false;
        int wgid = (int)L; { const int q = nwg / NXCD, r = nwg % NXCD, xcd = wgid % NXCD, off = wgid / NXCD; wgid = (xcd < r ? xcd * (q + 1) : r * (q + 1) + (xcd - r) * q) + off; }
        const int nig = WGM * nN, gid = wgid / nig, fm = gid * WGM, gsz = (nM - fm) < WGM ? (nM - fm) : WGM;
        u.pm = fm + ((wgid % nig) % gsz); u.pn = (wgid % nig) / gsz; return true;
    }
    __device__ __forceinline__ void a_ready(const Unit&) const {}
    __device__ __forceinline__ void done(const Unit&) const {}
};

__device__ __forceinline__ unsigned cvt_pk_bf16(float lo, float hi) { unsigned r; asm volatile("v_cvt_pk_bf16_f32 %0, %1, %2" : "=v"(r) : "v"(lo), "v"(hi)); return r; }
typedef float f32x2 __attribute__((ext_vector_type(2)));
__device__ __forceinline__ f32x2 gelu_pk(f32x2 v) {
    const f32x2 av = __builtin_elementwise_abs(v), d = av * 0.2316418882f + 1.0f;
    f32x2 t; t.x = __builtin_amdgcn_rcpf(d.x); t.y = __builtin_amdgcn_rcpf(d.y);
    f32x2 q = t * 0.5307027145f + (-0.7265760135f); q = q * t + 0.7107068705f; q = q * t + (-0.142248368f); q = q * t + 0.127414796f; q = q * t;
    const f32x2 s = (v * v) * (-0.72134752044f);
    f32x2 e; e.x = __builtin_amdgcn_exp2f(s.x); e.y = __builtin_amdgcn_exp2f(s.y);
    const f32x2 m = v * (q * e), r = v - m;
    f32x2 o; o.x = v.x < 0.f ? m.x : r.x; o.y = v.y < 0.f ? m.y : r.y; return o;
}

template <int ACT  > struct EpiBf16 {
    static constexpr bool PERM = true, AFTER_DRAIN = false; static_assert(ACT == 0 || ACT == 1, "EpiBf16: ACT is 0 (none) or 1 (gelu_pk)");
    bf16_t* O; int ldc; const float* bias; int split_cols; size_t split_stride; float scale0;
    __device__ __forceinline__ void operator()(const f32x4 (&acc)[2][2][4][2], const Unit& u, int wr, int wc, int fr, int fq) const {
        const int row0 = u.pm * BM + wr * 64 + fr; int colt = u.pn * BM; bf16_t* base = O;
        float sc = 1.f; if (split_cols) { const int t = colt / split_cols; base += (size_t)t * split_stride; colt -= t * split_cols; if (t == 0) sc = scale0; }
        const int col0 = colt + wc * 32 + 8 * fq, bcol0 = u.pn * BM + wc * 32 + 8 * fq;
        f32x4 bv[2][2];
#pragma unroll
        for (int bj = 0; bj < 2; ++bj)
#pragma unroll
            for (int n = 0; n < 2; ++n) bv[bj][n] = bias ? *(const f32x4*)(bias + bcol0 + bj * HALF + 4 * n) : (f32x4){0.f, 0.f, 0.f, 0.f};
#pragma unroll
        for (int ai = 0; ai < 2; ++ai)
#pragma unroll
            for (int m = 0; m < 4; ++m) { bf16_t* rowp = base + (size_t)(row0 + ai * HALF + m * 16) * ldc + col0;
#pragma unroll
                for (int bj = 0; bj < 2; ++bj) { f32x4 v0 = acc[ai][bj][m][0] + bv[bj][0], v1 = acc[ai][bj][m][1] + bv[bj][1];
                    if (ACT == 1) { f32x2 a = gelu_pk((f32x2){v0[0], v0[1]}), b = gelu_pk((f32x2){v0[2], v0[3]}), c = gelu_pk((f32x2){v1[0], v1[1]}), d = gelu_pk((f32x2){v1[2], v1[3]});
                        v0 = (f32x4){a.x, a.y, b.x, b.y}; v1 = (f32x4){c.x, c.y, d.x, d.y}; }
                    v0 = v0 * sc; v1 = v1 * sc; u32x4 w; w.x = cvt_pk_bf16(v0[0], v0[1]); w.y = cvt_pk_bf16(v0[2], v0[3]); w.z = cvt_pk_bf16(v1[0], v1[1]); w.w = cvt_pk_bf16(v1[2], v1[3]);
                    *(u32x4*)(rowp + bj * HALF) = w; } }
    }
};

struct PanelStats {
    unsigned* xbuf;
    unsigned* cnt;
    unsigned* tmo;
    int ntn; float eps;
    unsigned code;
    __device__ __forceinline__ bool run(const f32x4 (&v)[2][2][4][2], const Unit& u, int wr, int wc, int fr, int fq, PG8_LAS unsigned char* lds, int wid, int lane) const {
        typedef float f32x2v __attribute__((ext_vector_type(2)));
        PG8_LAS f32x2v* P = (PG8_LAS f32x2v*)lds;
        PG8_LAS f32x2v* S = (PG8_LAS f32x2v*)(lds + 8192);
        PG8_LAS unsigned* flag = (PG8_LAS unsigned*)(lds + 8192 + 2048);
#pragma unroll
        for (int ai = 0; ai < 2; ++ai)
#pragma unroll
            for (int m = 0; m < 4; ++m) {
                float s = 0.f;
#pragma unroll
                for (int bj = 0; bj < 2; ++bj)
#pragma unroll
                    for (int n = 0; n < 2; ++n) { const f32x4 x = v[ai][bj][m][n]; s += (x[0] + x[1]) + (x[2] + x[3]); }
                s += __shfl_xor(s, 16); s += __shfl_xor(s, 32);
                const float mw = s * (1.0f / 64.0f); float q = 0.f;
#pragma unroll
                for (int bj = 0; bj < 2; ++bj)
#pragma unroll
                    for (int n = 0; n < 2; ++n) { const f32x4 d = v[ai][bj][m][n] - mw; q += (d[0] * d[0] + d[1] * d[1]) + (d[2] * d[2] + d[3] * d[3]); }
                q += __shfl_xor(q, 16); q += __shfl_xor(q, 32);
                if (fq == 0) P[(ai * HALF + wr * 64 + m * 16 + fr) * 4 + wc] = (f32x2v){mw, q};
            }
        asm volatile("s_waitcnt lgkmcnt(0)" ::: "memory"); __builtin_amdgcn_s_barrier(); asm volatile("" ::: "memory");
#if defined(BROKEN_EXCHANGE_NO_WAIT)
#warning BROKEN CONTROL BUILD: the row-statistics exchange does not wait; results are wrong by design
        if (blockIdx.x >= 64) { const long long t0_ = clock64(); while (clock64() - t0_ < 60000) __builtin_amdgcn_s_sleep(8); }
#endif
        const int row = wid * 32 + (lane & 31);
        if (lane < 32) {
            const f32x2v a = P[row * 4 + 0], b = P[row * 4 + 1], c = P[row * 4 + 2], d = P[row * 4 + 3];
            const float mt = (a.x + b.x + c.x + d.x) * 0.25f;
            const float da = a.x - mt, db = b.x - mt, dc = c.x - mt, dd = d.x - mt;
            const float m2 = (a.y + b.y) + (c.y + d.y) + 64.0f * ((da * da + db * db) + (dc * dc + dd * dd));
            unsigned long long* slot = (unsigned long long*)xbuf + ((size_t)(u.pm * BM + row) * 4 + u.pn);
            __hip_atomic_store(slot, ((unsigned long long)__float_as_uint(m2) << 32) | __float_as_uint(mt), __ATOMIC_RELAXED, __HIP_MEMORY_SCOPE_AGENT);
        }
        asm volatile("s_waitcnt vmcnt(0)" ::: "memory");
        if (lane == 0) __hip_atomic_fetch_add(cnt + 64 * u.pm, 1u, __ATOMIC_RELAXED, __HIP_MEMORY_SCOPE_AGENT);
        if (wid == 0) {
            bool dead = false; const unsigned long long t0 = __builtin_amdgcn_s_memrealtime(); const unsigned want = 8u * (unsigned)ntn;
            for (;;) {
#if defined(BROKEN_EXCHANGE_NO_WAIT)
                break;
#endif
                if ((unsigned)__builtin_amdgcn_readfirstlane(__hip_atomic_load(cnt + 64 * u.pm, __ATOMIC_RELAXED, __HIP_MEMORY_SCOPE_AGENT)) >= want) break;
                if (__builtin_amdgcn_s_memrealtime() - t0 > 2000000ull) {
                    if (lane == 0) { unsigned expect = 0u; __hip_atomic_compare_exchange_strong(tmo + 1, &expect, code | (unsigned)(u.pm & 0xff), __ATOMIC_RELAXED, __ATOMIC_RELAXED, __HIP_MEMORY_SCOPE_AGENT);
                                     __hip_atomic_store(tmo, 1u, __ATOMIC_RELAXED, __HIP_MEMORY_SCOPE_AGENT); }
                    dead = true; break; }
                __builtin_amdgcn_s_sleep(2);
            }
            __builtin_amdgcn_fence(__ATOMIC_ACQUIRE, "agent");
            if (lane == 0) flag[0] = dead ? 1u : 0u;
        }
        asm volatile("s_waitcnt vmcnt(0) lgkmcnt(0)" ::: "memory"); __builtin_amdgcn_s_barrier(); asm volatile("" ::: "memory");
        const bool bad = flag[0] != 0u;
        if (lane < 32) {
            const unsigned long long* slot = (const unsigned long long*)xbuf + (size_t)(u.pm * BM + row) * 4; float mt[4], m2[4]; float ms = 0.f;
#pragma unroll
            for (int t = 0; t < 4; ++t) { if (t < ntn) { const unsigned long long w = __hip_atomic_load(slot + t, __ATOMIC_RELAXED, __HIP_MEMORY_SCOPE_AGENT); mt[t] = __uint_as_float((unsigned)w); m2[t] = __uint_as_float((unsigned)(w >> 32)); } else { mt[t] = 0.f; m2[t] = 0.f; } ms += mt[t]; }
            const float mean = ms / (float)ntn; float q = 0.f;
#pragma unroll
            for (int t = 0; t < 4; ++t) if (t < ntn) { const float dm = mt[t] - mean; q += m2[t] + 256.0f * dm * dm; }
            S[row] = (f32x2v){mean, 1.0f / sqrtf(q / (256.0f * (float)ntn) + eps)};
        }
        asm volatile("s_waitcnt lgkmcnt(0)" ::: "memory"); __builtin_amdgcn_s_barrier(); asm volatile("" ::: "memory");
        return bad;
    }
};
struct EpiLnRes {
    static constexpr bool PERM = false, AFTER_DRAIN = true;
    const float* base; float* out; int ldc; const float* bias; PanelStats st; unsigned poison;
    __device__ __forceinline__ void fused(f32x4 (&acc)[2][2][4][2], const Unit& u, int wr, int wc, int fr, int fq, PG8_LAS unsigned char* lds, int wid, int lane) const {
        typedef float f32x2v __attribute__((ext_vector_type(2)));
        const PG8_LAS f32x2v* S = (const PG8_LAS f32x2v*)(lds + 8192);
        const int col0 = u.pn * BM + wc * 32 + 4 * fq;
#pragma unroll
        for (int bj = 0; bj < 2; ++bj)
#pragma unroll
            for (int n = 0; n < 2; ++n) { const f32x4 bv = bias ? *(const f32x4*)(bias + col0 + bj * HALF + n * 16) : (f32x4){0.f, 0.f, 0.f, 0.f};
#pragma unroll
                for (int ai = 0; ai < 2; ++ai)
#pragma unroll
                    for (int m = 0; m < 4; ++m) acc[ai][bj][m][n] += bv; }
        f32x4 pre[4][2][2];
#pragma unroll
        for (int m = 0; m < 4; ++m) { const size_t off = (size_t)(u.pm * BM + wr * 64 + m * 16 + fr) * ldc + col0;
#pragma unroll
            for (int bj = 0; bj < 2; ++bj)
#pragma unroll
                for (int n = 0; n < 2; ++n) pre[m][bj][n] = *(const f32x4*)(base + off + bj * HALF + n * 16); }
        const bool bad = st.run(acc, u, wr, wc, fr, fq, lds, wid, lane) || poison != 0u;
        const float qnan = __builtin_nanf("");
#pragma unroll
        for (int ai = 0; ai < 2; ++ai)
#pragma unroll
            for (int m = 0; m < 4; ++m) { const int r = ai * HALF + wr * 64 + m * 16 + fr; const f32x2v sr = S[r]; const size_t off = (size_t)(u.pm * BM + r) * ldc + col0;
#pragma unroll
                for (int bj = 0; bj < 2; ++bj)
#pragma unroll
                    for (int n = 0; n < 2; ++n) { const f32x4 bs = ai == 0 ? pre[m][bj][n] : *(const f32x4*)(base + off + bj * HALF + n * 16); f32x4 o = bs + (acc[ai][bj][m][n] - sr.x) * sr.y;
                        if (bad) o = (f32x4){qnan, qnan, qnan, qnan}; *(f32x4*)(out + off + bj * HALF + n * 16) = o; }
                if (m & 1) asm volatile("" ::: "memory"); }
    }
};
struct EpiLnResLn {
    static constexpr bool PERM = false, AFTER_DRAIN = true;
    const float* base; float* out; bf16_t* xn; int ldc; const float* bias; PanelStats st1, st2; unsigned poison;
    __device__ __forceinline__ void fused(f32x4 (&acc)[2][2][4][2], const Unit& u, int wr, int wc, int fr, int fq, PG8_LAS unsigned char* lds, int wid, int lane) const {
        typedef float f32x2v __attribute__((ext_vector_type(2))); typedef unsigned u32x2v __attribute__((ext_vector_type(2)));
        const PG8_LAS f32x2v* S = (const PG8_LAS f32x2v*)(lds + 8192);
        const int col0 = u.pn * BM + wc * 32 + 4 * fq;
#pragma unroll
        for (int bj = 0; bj < 2; ++bj)
#pragma unroll
            for (int n = 0; n < 2; ++n) { const f32x4 bv = bias ? *(const f32x4*)(bias + col0 + bj * HALF + n * 16) : (f32x4){0.f, 0.f, 0.f, 0.f};
#pragma unroll
                for (int ai = 0; ai < 2; ++ai)
#pragma unroll
                    for (int m = 0; m < 4; ++m) acc[ai][bj][m][n] += bv; }
        bool bad = st1.run(acc, u, wr, wc, fr, fq, lds, wid, lane) || poison != 0u;
        const float qnan = __builtin_nanf("");
#pragma unroll
        for (int ai = 0; ai < 2; ++ai)
#pragma unroll
            for (int m = 0; m < 4; ++m) { const int r = ai * HALF + wr * 64 + m * 16 + fr; const f32x2v sr = S[r]; const size_t off = (size_t)(u.pm * BM + r) * ldc + col0;
#pragma unroll
                for (int bj = 0; bj < 2; ++bj)
#pragma unroll
                    for (int n = 0; n < 2; ++n) { const f32x4 bs = *(const f32x4*)(base + off + bj * HALF + n * 16); acc[ai][bj][m][n] = bs + (acc[ai][bj][m][n] - sr.x) * sr.y; }
                asm volatile("" : "+v"(acc[ai][0][m][0]), "+v"(acc[ai][0][m][1]), "+v"(acc[ai][1][m][0]), "+v"(acc[ai][1][m][1]));
                if (m & 1) asm volatile("" ::: "memory"); }
        const bool bad1 = bad;
        bad = st2.run(acc, u, wr, wc, fr, fq, lds, wid, lane) || bad;
#pragma unroll
        for (int ai = 0; ai < 2; ++ai)
#pragma unroll
            for (int m = 0; m < 4; ++m) { const int r = ai * HALF + wr * 64 + m * 16 + fr; const f32x2v sr = S[r]; const size_t off = (size_t)(u.pm * BM + r) * ldc + col0;
#pragma unroll
                for (int bj = 0; bj < 2; ++bj)
#pragma unroll
                    for (int n = 0; n < 2; ++n) { const f32x4 x1 = acc[ai][bj][m][n]; *(f32x4*)(out + off + bj * HALF + n * 16) = bad1 ? (f32x4){qnan, qnan, qnan, qnan} : x1;
                        const f32x4 o = (x1 - sr.x) * sr.y; u32x2v w; w.x = cvt_pk_bf16(o[0], o[1]); w.y = cvt_pk_bf16(o[2], o[3]);
                        if (bad) { w.x = 0x7fc07fc0u; w.y = 0x7fc07fc0u; } *(u32x2v*)(xn + off + bj * HALF + n * 16) = w; }
                asm volatile("" ::: "memory"); }
    }
};

template <class Epi, class Sched, bool ALIGN_EPI = false, bool SP2 = false>
__device__ __forceinline__ void gemm_phase(PG8_LAS unsigned char* lds, const Gemm g, const Sched& S, const Epi& E) {
    const int tid = tidx(), wid = __builtin_amdgcn_readfirstlane(tid >> 6), lane = tid & 63, wr = wid >> 2, wc = wid & 3, fr = lane & 15, fq = lane >> 4;
    const int K = g.K, nt = K / BK;
    unsigned voffA[2], voffB[2];
#pragma unroll
    for (int i = 0; i < 2; ++i) { int R, C; stage_rc(tid * 16 + i * 8192, R, C); const int Rb = Epi::PERM ? ((R & ~31) + perm32(R & 31)) : R;
        voffA[i] = (unsigned)(R * K + C) * 2u; voffB[i] = (unsigned)(Rb * K + C) * 2u; }
    const size_t kstep = (size_t)(BK * 2);
    const size_t hstep = (size_t)HALF * K * 2;
    const size_t tstep = 2 * hstep;
    const unsigned ldsw = (unsigned)wid * 1024u;
    const int aoff = lds_byte(wr * 64 + fr, fq * 8), boff = lds_byte(wc * 32 + fr, fq * 8);
#define PG8_SA(b, h) (((b) * 2 + (h)) * HTB)
#define PG8_SB(b, h) ((4 + (b) * 2 + (h)) * HTB)
#define PG8_STAGE(bufoff, gbase, voff) do { _Pragma("unroll") for (int _i = 0; _i < 2; ++_i) \
        __builtin_amdgcn_global_load_lds((const unsigned*)((const char*)(gbase) + (voff)[_i]), (PG8_LAS unsigned*)(lds + (bufoff) + ldsw + _i * 8192), 16, 0, 0); } while (0)
#define PG8_LDA(dst, b, h) do { _Pragma("unroll") for (int m = 0; m < 4; ++m) _Pragma("unroll") for (int k = 0; k < 2; ++k) dst[m][k] = *(const PG8_LAS bf16x8*)(lds + PG8_SA(b, h) + aoff + m * 2048 + k * 1024); } while (0)
#define PG8_LDB(dst, b, h) do { _Pragma("unroll") for (int n = 0; n < 2; ++n) _Pragma("unroll") for (int k = 0; k < 2; ++k) dst[n][k] = *(const PG8_LAS bf16x8*)(lds + PG8_SB(b, h) + boff + n * 2048 + k * 1024); } while (0)
#define PG8_MMA(ai, bj, At, Bt) do { __builtin_amdgcn_s_setprio(1); _Pragma("unroll") for (int m = 0; m < 4; ++m) _Pragma("unroll") for (int n = 0; n < 2; ++n) _Pragma("unroll") for (int k = 0; k < 2; ++k) \
        acc[ai][bj][m][n] = __builtin_amdgcn_mfma_f32_16x16x32_bf16(Bt[n][k], At[m][k], acc[ai][bj][m][n], 0, 0, 0); __builtin_amdgcn_s_setprio(0); } while (0)
#define PG8_WAIT_V(n) asm volatile("s_waitcnt vmcnt(" #n ")" ::: "memory")
#define PG8_WAIT_L(n) asm volatile("s_waitcnt lgkmcnt(" #n ")" ::: "memory")
#define PG8_BAR __builtin_amdgcn_s_barrier()
#define PG8_SCHED __builtin_amdgcn_sched_barrier(0)
    Unit cur, nxt; int ui = 0;
    if (!S.next(0, cur)) return;
    E.prefetch(cur, tid, lds + 135168);
    f32x4 acc[2][2][4][2];
#pragma unroll
    for (int a = 0; a < 2; ++a)
#pragma unroll
        for (int b = 0; b < 2; ++b)
#pragma unroll
            for (int m = 0; m < 4; ++m)
#pragma unroll
                for (int n = 0; n < 2; ++n) acc[a][b][m][n] = (f32x4){0.f, 0.f, 0.f, 0.f};
    bf16x8 At[4][2], B0[2][2], B1[2][2];
    const char* cA = (const char*)g.A + (size_t)cur.pm * tstep; const char* cB = (const char*)g.Bt + (size_t)cur.pn * tstep;
    S.a_ready(cur);
    if constexpr (SP2) {
        PG8_STAGE(PG8_SB(0, 0), cB, voffB); PG8_STAGE(PG8_SB(0, 1), cB + hstep, voffB); PG8_STAGE(PG8_SA(0, 0), cA, voffA); PG8_STAGE(PG8_SA(0, 1), cA + hstep, voffA);
        if (wr == 1) PG8_BAR;
        PG8_WAIT_V(2); PG8_BAR;
        PG8_STAGE(PG8_SB(1, 0), cB + kstep, voffB); PG8_STAGE(PG8_SA(1, 0), cA + kstep, voffA); PG8_STAGE(PG8_SB(1, 1), cB + hstep + kstep, voffB);
        PG8_WAIT_V(6); PG8_BAR;
    } else {
        PG8_STAGE(PG8_SB(0, 0), cB, voffB); PG8_STAGE(PG8_SA(0, 0), cA, voffA); PG8_STAGE(PG8_SB(0, 1), cB + hstep, voffB); PG8_STAGE(PG8_SA(0, 1), cA + hstep, voffA);
        if (wr == 1) PG8_BAR;
        PG8_WAIT_V(4); PG8_BAR;
        PG8_STAGE(PG8_SB(1, 0), cB + kstep, voffB); PG8_STAGE(PG8_SA(1, 0), cA + kstep, voffA); PG8_STAGE(PG8_SB(1, 1), cB + hstep + kstep, voffB);
        PG8_WAIT_V(6); PG8_BAR;
    }
    for (;;) {
        const bool has_next = S.next(ui + 1, nxt);
        const char* nA = has_next ? (const char*)g.A + (size_t)nxt.pm * tstep : cA; const char* nB = has_next ? (const char*)g.Bt + (size_t)nxt.pn * tstep : cB;
        for (int t = 0; t < nt; t += 2) {
            const bool last = (t == nt - 2);
            const char* a1 = cA + (size_t)(t + 1) * kstep;
            const char* a2 = last ? nA : cA + (size_t)(t + 2) * kstep; const char* b2 = last ? nB : cB + (size_t)(t + 2) * kstep;
            const char* a3 = a2 + kstep; const char* b3 = b2 + kstep;
            if (last && has_next) S.a_ready(nxt);
            if constexpr (SP2) {
            PG8_LDB(B0, 0, 0); PG8_LDB(B1, 0, 1); PG8_SCHED; PG8_LDA(At, 0, 0); PG8_STAGE(PG8_SA(1, 1), a1 + hstep, voffA);
            PG8_WAIT_V(8); PG8_WAIT_L(0); PG8_BAR; PG8_MMA(0, 0, At, B0); PG8_MMA(0, 1, At, B1); PG8_BAR; PG8_SCHED;
            PG8_LDA(At, 0, 1); PG8_STAGE(PG8_SB(0, 0), b2, voffB); PG8_STAGE(PG8_SB(0, 1), b2 + hstep, voffB); PG8_STAGE(PG8_SA(0, 0), a2, voffA);
            PG8_WAIT_V(8); PG8_WAIT_L(0); PG8_BAR; PG8_MMA(1, 0, At, B0); PG8_MMA(1, 1, At, B1); PG8_BAR; PG8_SCHED;
            PG8_LDB(B0, 1, 0); PG8_LDB(B1, 1, 1); PG8_SCHED; PG8_LDA(At, 1, 0); PG8_STAGE(PG8_SA(0, 1), a2 + hstep, voffA);
            PG8_WAIT_V(8); PG8_WAIT_L(0); PG8_BAR; PG8_MMA(0, 0, At, B0); PG8_MMA(0, 1, At, B1); PG8_BAR; PG8_SCHED;
            PG8_LDA(At, 1, 1); PG8_STAGE(PG8_SB(1, 0), b3, voffB); PG8_STAGE(PG8_SB(1, 1), b3 + hstep, voffB); PG8_STAGE(PG8_SA(1, 0), a3, voffA);
            PG8_WAIT_V(8); PG8_WAIT_L(0); PG8_BAR; PG8_MMA(1, 0, At, B0); PG8_MMA(1, 1, At, B1); PG8_BAR; PG8_SCHED;
            } else {
            PG8_LDB(B0, 0, 0); PG8_SCHED; PG8_LDA(At, 0, 0); PG8_STAGE(PG8_SA(1, 1), a1 + hstep, voffA);
            PG8_WAIT_L(8); PG8_BAR; PG8_WAIT_L(0); PG8_MMA(0, 0, At, B0); PG8_BAR; PG8_SCHED;
            PG8_LDB(B1, 0, 1); PG8_STAGE(PG8_SB(0, 0), b2, voffB);
            PG8_BAR; PG8_WAIT_L(0); PG8_MMA(0, 1, At, B1); PG8_BAR;
            PG8_LDA(At, 0, 1); PG8_STAGE(PG8_SA(0, 0), a2, voffA);
            PG8_BAR; PG8_WAIT_L(0); PG8_MMA(1, 0, At, B0); PG8_BAR; PG8_SCHED;
            PG8_STAGE(PG8_SB(0, 1), b2 + hstep, voffB);
            PG8_WAIT_V(6); PG8_BAR; PG8_MMA(1, 1, At, B1); PG8_BAR;
            PG8_LDB(B0, 1, 0); PG8_SCHED; PG8_LDA(At, 1, 0); PG8_STAGE(PG8_SA(0, 1), a2 + hstep, voffA);
            PG8_WAIT_L(8); PG8_BAR; PG8_WAIT_L(0); PG8_MMA(0, 0, At, B0); PG8_BAR; PG8_SCHED;
            PG8_LDB(B1, 1, 1); PG8_STAGE(PG8_SB(1, 0), b3, voffB);
            PG8_BAR; PG8_WAIT_L(0); PG8_MMA(0, 1, At, B1); PG8_BAR;
            PG8_LDA(At, 1, 1); PG8_STAGE(PG8_SA(1, 0), a3, voffA);
            PG8_BAR; PG8_WAIT_L(0); PG8_MMA(1, 0, At, B0); PG8_BAR; PG8_SCHED;
            PG8_STAGE(PG8_SB(1, 1), b3 + hstep, voffB);
            PG8_WAIT_V(6); PG8_BAR; PG8_MMA(1, 1, At, B1); PG8_BAR;
            }
        }
        if constexpr (ALIGN_EPI) { if (wr == 0) PG8_BAR; }
        if constexpr (!Epi::AFTER_DRAIN) { E(acc, cur, wr, wc, fr, fq, lds + 135168 + (ui & 1) * 4096); if (has_next) E.prefetch(nxt, tid, lds + 135168 + ((ui + 1) & 1) * 4096); S.done(cur); }
        if (!has_next) break;
#pragma unroll
        for (int a = 0; a < 2; ++a)
#pragma unroll
            for (int b = 0; b < 2; ++b)
#pragma unroll
                for (int m = 0; m < 4; ++m)
#pragma unroll
                    for (int n = 0; n < 2; ++n) acc[a][b][m][n] = (f32x4){0.f, 0.f, 0.f, 0.f};
        cur = nxt; cA = nA; cB = nB; ++ui;
        if constexpr (ALIGN_EPI) { if (wr == 1) PG8_BAR; }
    }
    PG8_WAIT_V(0);
    if constexpr (!ALIGN_EPI) { if (wr == 0) PG8_BAR; }
    PG8_BAR;
    if constexpr (Epi::AFTER_DRAIN) { E.fused(acc, cur, wr, wc, fr, fq, lds, wid, lane); S.done(cur); }
#undef PG8_SA
#undef PG8_SB
#undef PG8_STAGE
#undef PG8_LDA
#undef PG8_LDB
#undef PG8_MMA
#undef PG8_WAIT_V
#undef PG8_WAIT_L
#undef PG8_BAR
#undef PG8_SCHED
}
}

#define LAS __attribute__((address_space(3)))
typedef unsigned short bf16_t;
typedef short bf16x8 __attribute__((ext_vector_type(8)));
typedef short s16x4 __attribute__((ext_vector_type(4)));
typedef short v4i16_t __attribute__((ext_vector_type(4)));
typedef float f32x4 __attribute__((ext_vector_type(4)));
typedef float f32x16 __attribute__((ext_vector_type(16)));
typedef unsigned u32x4 __attribute__((ext_vector_type(4)));
typedef unsigned u32x2 __attribute__((ext_vector_type(2)));

constexpr int DM = 1024, NB = 8, SEQ = 8192, NMETA = 16, LSEQ = SEQ + NMETA, MREAL = NB * SEQ, MROW0 = MREAL, MPAD = MREAL + 256;
constexpr int FF = 2816, NPB = 3584, NPBW = 3840, DPROJ = 5640;
constexpr int NCH = 65;
constexpr float ALPHA = 1.41421356237f;
constexpr float LOG2E = 1.4426950408889634f;
constexpr float QSCALE = 0.125f * LOG2E;
constexpr float NEGF = -1e30f;
constexpr float LN_EPS = 1e-5f;

constexpr size_t OW_GU1 = 0, OW_D1 = 5767168, OW_PB = 8650752, OW_GM = 12582912, OW_BM = 14680064, OW_BA = 15204352, OW_OUT = 15728640, OW_GU2 = 16777216, OW_D2 = 22544384, OW_LAYER = 25427968;
constexpr int OC_GU1 = 0, OC_PB = 5632, OC_GM = 9472, OC_GU2 = 11520, OC_N = 17152;
constexpr size_t MiB = 1u << 20;
constexpr size_t WS_ROWS = 0;
constexpr size_t WS_CSBW = 4 * MiB;
constexpr size_t WS_HFM = 5 * MiB;
constexpr size_t WS_GATES = 6 * MiB;
constexpr size_t WS_BAR = 9 * MiB;
constexpr size_t WS_KM = WS_BAR + 16384;
constexpr size_t WS_SC = 10 * MiB;
constexpr size_t WS_NST = 11 * MiB;
constexpr size_t WS_STATS = 13 * MiB;
constexpr size_t WS_W = 16 * MiB;
constexpr size_t WS_HB = 113 * MiB;
constexpr size_t WS_LO = 242 * MiB;
constexpr size_t WS_CST = 371 * MiB;
constexpr size_t WS_MA = 436 * MiB;
constexpr size_t WS_BIG = 565 * MiB;
constexpr size_t WS_END = 1015 * MiB;

struct Params {
    const float* in[28];
    float* out; unsigned char* ws;
};

__device__ __forceinline__ unsigned f2bf(float f) { unsigned u = __builtin_bit_cast(unsigned, f); return (u + 0x7fffu + ((u >> 16) & 1u)) >> 16; }
typedef float f32x2_t __attribute__((ext_vector_type(2))); typedef __bf16 bf16x2_t __attribute__((ext_vector_type(2)));
__device__ __forceinline__ unsigned pk2(float lo, float hi) { f32x2_t v = {lo, hi}; bf16x2_t b = __builtin_convertvector(v, bf16x2_t); return __builtin_bit_cast(unsigned, b); }
__device__ __forceinline__ u32x4 pack8(f32x4 a, f32x4 b) { u32x4 w; w.x = pk2(a[0], a[1]); w.y = pk2(a[2], a[3]); w.z = pk2(b[0], b[1]); w.w = pk2(b[2], b[3]); return w; }
__device__ __forceinline__ float bflo(unsigned w) { return __builtin_bit_cast(float, w << 16); }
__device__ __forceinline__ float bfhi(unsigned w) { return __builtin_bit_cast(float, w & 0xffff0000u); }
__device__ __forceinline__ float ex2(float x) { return __builtin_amdgcn_exp2f(x); }
__device__ __forceinline__ float sigm(float x) { return __builtin_amdgcn_rcpf(1.f + ex2(-x * LOG2E)); }
__device__ __forceinline__ float siluf(float x) { return x * sigm(x); }
__device__ __forceinline__ float wave_sum(float v) {
#pragma unroll
    for (int o = 1; o < 64; o <<= 1) v += __shfl_xor(v, o);
    return v;
}
__device__ __forceinline__ float wave_max(float v) {
#pragma unroll
    for (int o = 1; o < 64; o <<= 1) v = fmaxf(v, __shfl_xor(v, o));
    return v;
}
__device__ __forceinline__ size_t seqrow(int b, int pos) { return pos < NMETA ? (size_t)(MROW0 + pos) : (size_t)b * SEQ + (size_t)(pos - NMETA); }
__device__ __forceinline__ f32x16 mfma32(bf16x8 a, bf16x8 b, f32x16 c) { return __builtin_amdgcn_mfma_f32_32x32x16_bf16(a, b, c, 0, 0, 0); }
__device__ __forceinline__ s16x4 vtr(const LAS unsigned char* p) { return __builtin_bit_cast(s16x4, __builtin_amdgcn_ds_read_tr16_b64_v4i16((LAS v4i16_t*)p)); }
__device__ __forceinline__ bf16x8 cat8(s16x4 lo, s16x4 hi) { return (bf16x8){lo[0], lo[1], lo[2], lo[3], hi[0], hi[1], hi[2], hi[3]}; }

namespace pg8 {
__device__ __forceinline__ void tab_prefetch(const float* rows, const float* v0, const float* v1, int pm, int cbase, int tid, PG8_LAS unsigned char* tab) {
    const int wid = __builtin_amdgcn_readfirstlane(tid >> 6), lane = tid & 63;
    if (rows) __builtin_amdgcn_global_load_lds((const unsigned*)(rows + (size_t)pm * 512 + tid), (PG8_LAS unsigned*)(tab + wid * 256), 4, 0, 0);
    const float* src = (wid < 4 ? v0 + (wid * 64 + lane) : v1 + ((wid - 4) * 64 + lane)) + cbase;
    __builtin_amdgcn_global_load_lds((const unsigned*)src, (PG8_LAS unsigned*)(tab + 2048 + wid * 256), 4, 0, 0);
}
__device__ __forceinline__ void tab_ready() { asm volatile("s_waitcnt vmcnt(14)" ::: "memory"); __builtin_amdgcn_s_barrier(); asm volatile("" ::: "memory"); }
__device__ __forceinline__ void tab_stats(const PG8_LAS unsigned char* tab, int rloc, float& mu, float& r) {
    const f32x2_t st = *(const PG8_LAS f32x2_t*)(tab + rloc * 8); mu = st.x * (1.f / DM); r = __builtin_amdgcn_rsqf(st.y * (1.f / DM) - mu * mu + LN_EPS);
}
struct LnFix {
    const float* rows; const float* cs; const float* bw; int on;
    __device__ __forceinline__ void stats(size_t row, float& mu, float& r) const {
        const f32x2_t st = *(const f32x2_t*)(rows + row * 2); mu = st.x * (1.f / DM); r = __builtin_amdgcn_rsqf(st.y * (1.f / DM) - mu * mu + LN_EPS);
    }
};
struct EpiSwiglu {
    static constexpr bool PERM = true, AFTER_DRAIN = false;
    bf16_t* O; int ldc; LnFix fx;
    __device__ __forceinline__ void prefetch(const Unit& u, int tid, PG8_LAS unsigned char* tab) const { if (fx.on) tab_prefetch(fx.rows, fx.cs, fx.bw, u.pm, u.pn * BM, tid, tab); }
    __device__ __forceinline__ void operator()(const f32x4 (&acc)[2][2][4][2], const Unit& u, int wr, int wc, int fr, int fq, const PG8_LAS unsigned char* tab) const {
        const int row0 = u.pm * BM + wr * 64 + fr, col0 = u.pn * 128 + wc * 32 + 8 * fq, cl = wc * 32 + 8 * fq;
        if (fx.on) tab_ready();
#pragma unroll
        for (int ai = 0; ai < 2; ++ai)
#pragma unroll
            for (int m = 0; m < 4; ++m) {
                const size_t row = (size_t)(row0 + ai * HALF + m * 16);
                float mu = 0.f, r = 1.f; if (fx.on) tab_stats(tab, wr * 64 + fr + ai * HALF + m * 16, mu, r);
                u32x4 w;
#pragma unroll
                for (int n = 0; n < 2; ++n) {
                    f32x4 csg = {0.f, 0.f, 0.f, 0.f}, bwg = csg, csu = csg, bwu = csg;
                    if (fx.on) { csg = *(const PG8_LAS f32x4*)(tab + 2048 + (cl + 4 * n) * 4); bwg = *(const PG8_LAS f32x4*)(tab + 3072 + (cl + 4 * n) * 4); csu = *(const PG8_LAS f32x4*)(tab + 2048 + (cl + HALF + 4 * n) * 4); bwu = *(const PG8_LAS f32x4*)(tab + 3072 + (cl + HALF + 4 * n) * 4); }
                    const f32x4 g = (acc[ai][0][m][n] - csg * mu) * r + bwg, up = (acc[ai][1][m][n] - csu * mu) * r + bwu;
                    const unsigned lo = pk2(siluf(g[0]) * up[0], siluf(g[1]) * up[1]), hi = pk2(siluf(g[2]) * up[2], siluf(g[3]) * up[3]);
                    if (n == 0) { w.x = lo; w.y = hi; } else { w.z = lo; w.w = hi; }
                }
                *(u32x4*)(O + row * ldc + col0) = w;
            }
    }
};
struct EpiPlain {
    static constexpr bool PERM = true, AFTER_DRAIN = false;
    bf16_t* O; int ldc; int coff; int slo, shi; float scale; LnFix fx; float* GT; const float* bif;
    __device__ __forceinline__ void prefetch(const Unit& u, int tid, PG8_LAS unsigned char* tab) const { if (fx.on) tab_prefetch(fx.rows, fx.cs, fx.bw, u.pm, u.pn * BM, tid, tab); }
    __device__ __forceinline__ void operator()(const f32x4 (&acc)[2][2][4][2], const Unit& u, int wr, int wc, int fr, int fq, const PG8_LAS unsigned char* tab) const {
        const int row0 = u.pm * BM + wr * 64 + fr, col0 = coff + u.pn * BM + wc * 32 + 8 * fq, cl = wc * 32 + 8 * fq;
        if (fx.on) tab_ready();
        if (GT && u.pn == 14) {
            if (wc == 0 && fq == 0) {
                const f32x4 cs0 = *(const PG8_LAS f32x4*)(tab + 2048 + cl * 4), cs1 = *(const PG8_LAS f32x4*)(tab + 2048 + (cl + 4) * 4);
                const f32x4 bw0 = *(const PG8_LAS f32x4*)(tab + 3072 + cl * 4) + *(const f32x4*)(bif), bw1 = *(const PG8_LAS f32x4*)(tab + 3072 + (cl + 4) * 4) + *(const f32x4*)(bif + 4);
#pragma unroll
                for (int ai = 0; ai < 2; ++ai)
#pragma unroll
                    for (int m = 0; m < 4; ++m) {
                        const size_t row = (size_t)(row0 + ai * HALF + m * 16);
                        float mu, r; tab_stats(tab, wr * 64 + fr + ai * HALF + m * 16, mu, r);
                        const f32x4 li = (acc[ai][0][m][0] - cs0 * mu) * r + bw0, z = (acc[ai][0][m][1] - cs1 * mu) * r + bw1;
                        f32x4 lf;
#pragma unroll
                        for (int e = 0; e < 4; ++e) lf[e] = fminf(z[e], 0.f) - __logf(1.f + __expf(-fabsf(z[e])));
                        *(f32x4*)(GT + row * 8) = li; *(f32x4*)(GT + row * 8 + 4) = lf;
                    }
            }
            return;
        }
        const float sc = (u.pn >= slo && u.pn < shi) ? scale : 1.f;
#pragma unroll
        for (int ai = 0; ai < 2; ++ai)
#pragma unroll
            for (int m = 0; m < 4; ++m) {
                const size_t row = (size_t)(row0 + ai * HALF + m * 16);
                float mu = 0.f, r = 1.f; if (fx.on) tab_stats(tab, wr * 64 + fr + ai * HALF + m * 16, mu, r);
#pragma unroll
                for (int bj = 0; bj < 2; ++bj) {
                    u32x4 w;
#pragma unroll
                    for (int n = 0; n < 2; ++n) {
                        f32x4 cs4 = {0.f, 0.f, 0.f, 0.f}, bw4 = cs4;
                        if (fx.on) { cs4 = *(const PG8_LAS f32x4*)(tab + 2048 + (cl + bj * HALF + 4 * n) * 4); bw4 = *(const PG8_LAS f32x4*)(tab + 3072 + (cl + bj * HALF + 4 * n) * 4); }
                        const f32x4 v = ((acc[ai][bj][m][n] - cs4 * mu) * r + bw4) * sc;
                        if (n == 0) { w.x = pk2(v[0], v[1]); w.y = pk2(v[2], v[3]); } else { w.z = pk2(v[0], v[1]); w.w = pk2(v[2], v[3]); }
                    }
                    *(u32x4*)(O + row * ldc + col0 + bj * HALF) = w;
                }
            }
    }
};
struct EpiResid {
    static constexpr bool PERM = true, AFTER_DRAIN = false;
    const float* src; bf16_t* LO; bf16_t* HB; const float* rows_prev; float* rows_cur; const float* gam; const float* bet; float s; int raw;
    __device__ __forceinline__ void prefetch(const Unit& u, int tid, PG8_LAS unsigned char* tab) const { if (!raw) tab_prefetch(rows_prev, gam, bet, u.pm, u.pn * BM, tid, tab); }
    __device__ __forceinline__ void operator()(const f32x4 (&acc)[2][2][4][2], const Unit& u, int wr, int wc, int fr, int fq, const PG8_LAS unsigned char* tab) const {
        const int row0 = u.pm * BM + wr * 64 + fr, col0 = u.pn * BM + wc * 32 + 8 * fq, cl = wc * 32 + 8 * fq;
        if (!raw) tab_ready();
#pragma unroll
        for (int ai = 0; ai < 2; ++ai)
#pragma unroll
            for (int m = 0; m < 4; ++m) {
                const size_t row = (size_t)(row0 + ai * HALF + m * 16);
                float mu = 0.f, rs = 1.f;
                if (!raw) tab_stats(tab, wr * 64 + fr + ai * HALF + m * 16, mu, rs);
                const float ar = ALPHA * rs, am = -ALPHA * rs * mu;
                float s1 = 0.f, s2 = 0.f;
#pragma unroll
                for (int bj = 0; bj < 2; ++bj) {
                    f32x4 g0 = {1.f, 1.f, 1.f, 1.f}, g1 = g0, b0 = {0.f, 0.f, 0.f, 0.f}, b1 = b0;
                    if (!raw) { g0 = *(const PG8_LAS f32x4*)(tab + 2048 + (cl + bj * HALF) * 4); g1 = *(const PG8_LAS f32x4*)(tab + 2048 + (cl + bj * HALF + 4) * 4); b0 = *(const PG8_LAS f32x4*)(tab + 3072 + (cl + bj * HALF) * 4); b1 = *(const PG8_LAS f32x4*)(tab + 3072 + (cl + bj * HALF + 4) * 4); }
                    f32x4 x0, x1;
                    if (raw) { x0 = *(const f32x4*)(src + row * DM + col0 + bj * HALF); x1 = *(const f32x4*)(src + row * DM + col0 + bj * HALF + 4); }
                    else { const u32x4 hi = *(const u32x4*)(HB + row * DM + col0 + bj * HALF), lo = *(const u32x4*)(LO + row * DM + col0 + bj * HALF);
                        x0 = (f32x4){bflo(hi.x) + bflo(lo.x), bfhi(hi.x) + bfhi(lo.x), bflo(hi.y) + bflo(lo.y), bfhi(hi.y) + bfhi(lo.y)};
                        x1 = (f32x4){bflo(hi.z) + bflo(lo.z), bfhi(hi.z) + bfhi(lo.z), bflo(hi.w) + bflo(lo.w), bfhi(hi.w) + bfhi(lo.w)}; }
                    const f32x4 o0 = (x0 * ar + am) * g0 + b0 * ALPHA + acc[ai][bj][m][0] * s, o1 = (x1 * ar + am) * g1 + b1 * ALPHA + acc[ai][bj][m][1] * s;
                    const u32x4 nh = pack8(o0, o1);
                    const f32x4 d0 = {o0[0] - bflo(nh.x), o0[1] - bfhi(nh.x), o0[2] - bflo(nh.y), o0[3] - bfhi(nh.y)}, d1 = {o1[0] - bflo(nh.z), o1[1] - bfhi(nh.z), o1[2] - bflo(nh.w), o1[3] - bfhi(nh.w)};
                    *(u32x4*)(HB + row * DM + col0 + bj * HALF) = nh; *(u32x4*)(LO + row * DM + col0 + bj * HALF) = pack8(d0, d1);
                    s1 += ((o0[0] + o0[1]) + (o0[2] + o0[3])) + ((o1[0] + o1[1]) + (o1[2] + o1[3]));
                    s2 += ((o0[0] * o0[0] + o0[1] * o0[1]) + (o0[2] * o0[2] + o0[3] * o0[3])) + ((o1[0] * o1[0] + o1[1] * o1[1]) + (o1[2] * o1[2] + o1[3] * o1[3]));
                }
                s1 += __shfl_xor(s1, 16); s1 += __shfl_xor(s1, 32); s2 += __shfl_xor(s2, 16); s2 += __shfl_xor(s2, 32);
                if (fq == 0) { float* rp = rows_cur + row * 2; atomicAdd(rp, s1); atomicAdd(rp + 1, s2); }
                asm volatile("" ::: "memory");
            }
    }
};
struct EpiGate {
    static constexpr bool PERM = true, AFTER_DRAIN = false;
    bf16_t* U; const bf16_t* Y; const float* bg; LnFix fx;
    __device__ __forceinline__ void prefetch(const Unit& u, int tid, PG8_LAS unsigned char* tab) const { tab_prefetch(fx.rows, fx.cs, fx.bw, u.pm, u.pn * BM, tid, tab); }
    __device__ __forceinline__ void operator()(const f32x4 (&acc)[2][2][4][2], const Unit& u, int wr, int wc, int fr, int fq, const PG8_LAS unsigned char* tab) const {
        const int row0 = u.pm * BM + wr * 64 + fr, col0 = u.pn * 128 + wc * 32 + 8 * fq, cl = wc * 32 + 8 * fq;
        tab_ready();
#pragma unroll
        for (int ai = 0; ai < 2; ++ai)
#pragma unroll
            for (int m = 0; m < 4; ++m) {
                const size_t row = (size_t)(row0 + ai * HALF + m * 16);
                float mu, r; tab_stats(tab, wr * 64 + fr + ai * HALF + m * 16, mu, r);
                const u32x4 ym = *(const u32x4*)(Y + row * 2048 + col0), ya = *(const u32x4*)(Y + row * 2048 + DM + col0);
                u32x4 w;
#pragma unroll
                for (int n = 0; n < 2; ++n) {
                    const f32x4 csm = *(const PG8_LAS f32x4*)(tab + 2048 + (cl + 4 * n) * 4), bm = *(const PG8_LAS f32x4*)(tab + 3072 + (cl + 4 * n) * 4);
                    const f32x4 csa = *(const PG8_LAS f32x4*)(tab + 2048 + (cl + HALF + 4 * n) * 4), ba = *(const PG8_LAS f32x4*)(tab + 3072 + (cl + HALF + 4 * n) * 4);
                    const f32x4 gm = (acc[ai][0][m][n] - csm * mu) * r + bm, ga = (acc[ai][1][m][n] - csa * mu) * r + ba;
                    const unsigned y0 = n ? ym.z : ym.x, y1 = n ? ym.w : ym.y, a0 = n ? ya.z : ya.x, a1 = n ? ya.w : ya.y;
                    const unsigned lo = pk2(sigm(gm[0]) * bflo(y0) + sigm(ga[0]) * bflo(a0), sigm(gm[1]) * bfhi(y0) + sigm(ga[1]) * bfhi(a0));
                    const unsigned hi = pk2(sigm(gm[2]) * bflo(y1) + sigm(ga[2]) * bflo(a1), sigm(gm[3]) * bfhi(y1) + sigm(ga[3]) * bfhi(a1));
                    if (n == 0) { w.x = lo; w.y = hi; } else { w.z = lo; w.w = hi; }
                }
                *(u32x4*)(U + row * DM + col0) = w;
            }
    }
};
}

__device__ __forceinline__ f32x4 sg_tile(const bf16_t* A, int lda, const bf16_t* Bt, int K, int n0, int lane) {
    const bf16_t* ap = A + (size_t)(lane & 15) * lda + 8 * (lane >> 4);
    const bf16_t* bp = Bt + (size_t)(n0 + (lane & 15)) * K + 8 * (lane >> 4);
    f32x4 acc = {0.f, 0.f, 0.f, 0.f};
#pragma unroll 8
    for (int k = 0; k < K; k += 32) {
        const bf16x8 a = *(const bf16x8*)(ap + k), b = *(const bf16x8*)(bp + k);
        acc = __builtin_amdgcn_mfma_f32_16x16x32_bf16(a, b, acc, 0, 0, 0);
    }
    return acc;
}

__device__ __forceinline__ f32x4 sg_tile_blk(const bf16_t* A, int lda, const bf16_t* Bt, int K, int n0, int lane, int wid, LAS float* red) {
    const int K8 = K >> 3;
    const bf16_t* ap = A + (size_t)(lane & 15) * lda + 8 * (lane >> 4) + wid * K8;
    const bf16_t* bp = Bt + (size_t)(n0 + (lane & 15)) * K + 8 * (lane >> 4) + wid * K8;
    f32x4 acc = {0.f, 0.f, 0.f, 0.f};
#pragma unroll 4
    for (int k = 0; k < K8; k += 32) {
        const bf16x8 a = *(const bf16x8*)(ap + k), b = *(const bf16x8*)(bp + k);
        acc = __builtin_amdgcn_mfma_f32_16x16x32_bf16(a, b, acc, 0, 0, 0);
    }
    *(LAS f32x4*)(red + wid * 256 + lane * 4) = acc;
    __syncthreads();
    f32x4 sum = {0.f, 0.f, 0.f, 0.f};
    if (wid == 0) {
#pragma unroll
        for (int w = 0; w < 8; ++w) sum = sum + *(const LAS f32x4*)(red + w * 256 + lane * 4);
    }
    __syncthreads();
    return sum;
}

__device__ __forceinline__ void tr_rows(const float* Wsrc, int ldw, int K, bf16_t* dst, int kb0, int nkb, int nv4, const float* g, const float* bb, float* cs, float* bw, LAS float* scr, int lane, const float* addb = nullptr) {
    float csp[4] = {0.f, 0.f, 0.f, 0.f}, bwp[4] = {0.f, 0.f, 0.f, 0.f};
    const int c = lane & 7;
#pragma unroll 1
    for (int kb = kb0; kb < kb0 + nkb; ++kb) {
        const int k0 = 64 * kb;
#pragma unroll
        for (int i = 0; i < 8; ++i) { const int kk = 8 * i + (lane >> 3), n4 = (lane & 7) * 4;
            f32x4 v = {0.f, 0.f, 0.f, 0.f}; if ((lane & 7) < nv4) v = *(const f32x4*)(Wsrc + (size_t)(k0 + kk) * ldw + n4);
            scr[kk * 33 + n4] = v[0]; scr[kk * 33 + n4 + 1] = v[1]; scr[kk * 33 + n4 + 2] = v[2]; scr[kk * 33 + n4 + 3] = v[3]; }
        f32x4 g0 = {1.f, 1.f, 1.f, 1.f}, g1 = g0, b0 = {0.f, 0.f, 0.f, 0.f}, b1 = b0;
        if (g) { g0 = *(const f32x4*)(g + k0 + 8 * c); g1 = *(const f32x4*)(g + k0 + 8 * c + 4); b0 = *(const f32x4*)(bb + k0 + 8 * c); b1 = *(const f32x4*)(bb + k0 + 8 * c + 4); }
        asm volatile("s_waitcnt lgkmcnt(0)" ::: "memory");
#pragma unroll
        for (int j = 0; j < 4; ++j) {
            const int n = (lane >> 3) + 8 * j; const LAS float* sp = scr + (8 * c) * 33 + n;
            const float x0 = sp[0 * 33], x1 = sp[1 * 33], x2 = sp[2 * 33], x3 = sp[3 * 33], x4 = sp[4 * 33], x5 = sp[5 * 33], x6 = sp[6 * 33], x7 = sp[7 * 33];
            u32x4 o; o.x = pk2(x0 * g0[0], x1 * g0[1]); o.y = pk2(x2 * g0[2], x3 * g0[3]); o.z = pk2(x4 * g1[0], x5 * g1[1]); o.w = pk2(x6 * g1[2], x7 * g1[3]);
            *(u32x4*)(dst + (size_t)n * K + k0 + 8 * c) = o;
            csp[j] += ((bflo(o.x) + bfhi(o.x)) + (bflo(o.y) + bfhi(o.y))) + ((bflo(o.z) + bfhi(o.z)) + (bflo(o.w) + bfhi(o.w)));
            bwp[j] += ((x0 * b0[0] + x1 * b0[1]) + (x2 * b0[2] + x3 * b0[3])) + ((x4 * b1[0] + x5 * b1[1]) + (x6 * b1[2] + x7 * b1[3]));
        }
        asm volatile("s_waitcnt lgkmcnt(0)" ::: "memory");
    }
    if (g) {
#pragma unroll
        for (int j = 0; j < 4; ++j) {
            float a = csp[j], b = bwp[j];
            a += __shfl_xor(a, 1); a += __shfl_xor(a, 2); a += __shfl_xor(a, 4); b += __shfl_xor(b, 1); b += __shfl_xor(b, 2); b += __shfl_xor(b, 4);
            if (c == 0) { cs[(lane >> 3) + 8 * j] = a; bw[(lane >> 3) + 8 * j] = b + (addb ? addb[(lane >> 3) + 8 * j] : 0.f); }
        }
    }
}
constexpr int CW_ITEMS = 824;
__device__ __forceinline__ void conv_weight_item(const Params& P, int layer, int it, LAS float* scr, int lane) {
    bf16_t* W = (bf16_t*)(P.ws + WS_W) + (size_t)layer * OW_LAYER;
    float* CS = (float*)(P.ws + WS_CSBW) + (size_t)layer * 2 * OC_N; float* BW = CS + OC_N;
    const float* wg1 = P.in[2] + (size_t)layer * DM * FF; const float* wu1 = P.in[3] + (size_t)layer * DM * FF; const float* wd1 = P.in[4] + (size_t)layer * FF * DM;
    const float* win = P.in[7] + (size_t)layer * DM * DPROJ;
    const float* wbm = P.in[17] + (size_t)layer * 512 * DM; const float* wba = P.in[18] + (size_t)layer * 512 * DM; const float* wout = P.in[20] + (size_t)layer * DM * DM;
    const float* wg2 = P.in[23] + (size_t)layer * DM * FF; const float* wu2 = P.in[24] + (size_t)layer * DM * FF; const float* wd2 = P.in[25] + (size_t)layer * FF * DM;
    const float* ln1g = P.in[5] + (size_t)layer * DM; const float* ln1b = P.in[6] + (size_t)layer * DM;
    const float* ln2g = P.in[21] + (size_t)layer * DM; const float* ln2b = P.in[22] + (size_t)layer * DM;
    const float* ln3g = layer ? P.in[26] + (size_t)(layer - 1) * DM : nullptr; const float* ln3b = layer ? P.in[27] + (size_t)(layer - 1) * DM : nullptr;
    int r = it;
    if (r < 352) {
        const int second = r >= 176; if (second) r -= 176;
        const int R0 = 32 * r, pn = R0 >> 8, sgu = (R0 >> 7) & 1, i = R0 & 127;
        const float* src = (second ? (sgu ? wu2 : wg2) : (sgu ? wu1 : wg1)) + 128 * pn + i;
        const int oc = second ? OC_GU2 : OC_GU1;
        tr_rows(src, FF, DM, W + (second ? OW_GU2 : OW_GU1) + (size_t)R0 * DM, 0, 16, 8, second ? ln2g : ln3g, second ? ln2b : ln3b, CS + oc + R0, BW + oc + R0, scr, lane); return;
    }
    r -= 352;
    if (r < 192) {
        const int second = r >= 96; if (second) r -= 96;
        const int nb = r / 3, seg = r % 3, R0 = 32 * nb;
        tr_rows((second ? wd2 : wd1) + R0, DM, FF, W + (second ? OW_D2 : OW_D1) + (size_t)R0 * FF, 16 * seg, seg == 2 ? 12 : 16, 8, nullptr, nullptr, nullptr, nullptr, scr, lane); return;
    }
    r -= 192;
    if (r < 120) {
        const int R0 = 32 * r, csrc = R0 < 2048 ? R0 : (R0 < 3584 ? R0 + 8 : 2048);
        tr_rows(win + csrc, DPROJ, DM, W + OW_PB + (size_t)R0 * DM, 0, 16, R0 < 3584 ? 8 : (R0 == 3584 ? 2 : 0), ln1g, ln1b, CS + OC_PB + R0, BW + OC_PB + R0, scr, lane); return;
    }
    r -= 120;
    if (r < 64) {
        const int R0 = 32 * r, pn = R0 >> 8, sg = (R0 >> 7) & 1, i = R0 & 127, csrc = 3592 + 1024 * sg + 128 * pn + i;
        tr_rows(win + csrc, DPROJ, DM, W + OW_GM + (size_t)R0 * DM, 0, 16, 8, ln1g, ln1b, CS + OC_GM + R0, BW + OC_GM + R0, scr, lane, P.in[19] + (size_t)layer * 2048 + 1024 * sg + 128 * pn + i); return;
    }
    r -= 64;
    if (r < 64) {
        const int second = r >= 32; if (second) r -= 32;
        const int R0 = 32 * r;
        tr_rows((second ? wba : wbm) + R0, DM, 512, W + (second ? OW_BA : OW_BM) + (size_t)R0 * 512, 0, 8, 8, nullptr, nullptr, nullptr, nullptr, scr, lane); return;
    }
    r -= 64;
    { const int R0 = 32 * r; tr_rows(wout + R0, DM, DM, W + OW_OUT + (size_t)R0 * DM, 0, 16, 8, nullptr, nullptr, nullptr, nullptr, scr, lane); }
}

__device__ __forceinline__ void ln_row(const f32x4 (&vin)[4], int row, float* hf, const float* gam, const float* bet, bool gates, bool fin, const float* bif_l, LAS float* gwl, bf16_t* HB, float* ST, float* GT, int lane) {
    f32x4 v[4]; float s = 0.f;
#pragma unroll
    for (int j = 0; j < 4; ++j) { v[j] = vin[j]; s += (v[j][0] + v[j][1]) + (v[j][2] + v[j][3]); }
    const float mean = wave_sum(s) * (1.f / DM); float s2 = 0.f;
#pragma unroll
    for (int j = 0; j < 4; ++j) { v[j] = v[j] - mean; s2 += (v[j][0] * v[j][0] + v[j][1] * v[j][1]) + (v[j][2] * v[j][2] + v[j][3] * v[j][3]); }
    const float rstd = 1.f / sqrtf(wave_sum(s2) * (1.f / DM) + LN_EPS);
    if (lane == 0) { f32x2_t st = {mean, rstd}; *(f32x2_t*)(ST + (size_t)row * 2) = st; }
#pragma unroll
    for (int j = 0; j < 4; ++j) {
        const f32x4 g4 = *(const f32x4*)(gam + 256 * j + 4 * lane), b4 = *(const f32x4*)(bet + 256 * j + 4 * lane);
        v[j] = v[j] * rstd * g4 + b4;
        if (fin) *(f32x4*)(hf + 256 * j + 4 * lane) = v[j];
        if (!fin) { u32x2 w; w.x = pk2(v[j][0], v[j][1]); w.y = pk2(v[j][2], v[j][3]); *(u32x2*)(HB + (size_t)row * DM + 256 * j + 4 * lane) = w; }
    }
    if (gates) {
        float mine = 0.f;
#pragma unroll
        for (int g = 0; g < 8; ++g) {
            float d = 0.f;
#pragma unroll
            for (int j = 0; j < 4; ++j) { const f32x4 w4 = *(const LAS f32x4*)(gwl + g * 1024 + 256 * j + 4 * lane); d += (v[j][0] * w4[0] + v[j][1] * w4[1]) + (v[j][2] * w4[2] + v[j][3] * w4[3]); }
            d = wave_sum(d);
            if (lane == g) mine = d;
        }
        if (lane < 8) {
            const float z = mine + bif_l[lane];
            float o = z;
            if (lane >= 4) o = fminf(z, 0.f) - __logf(1.f + __expf(-fabsf(z)));
            GT[(size_t)row * 8 + lane] = o;
        }
    }
}
__device__ __forceinline__ void ln_phase(const Params& P, const float* gam, const float* bet, bool gates, bool fin, const float* win_l, const float* bif_l, LAS unsigned char* lds) {
    const int tid = tidx(), lane = tid & 63, wid = tid >> 6;
    float* hfm = (float*)(P.ws + WS_HFM); bf16_t* HB = (bf16_t*)(P.ws + WS_HB); float* GT = (float*)(P.ws + WS_GATES); float* ST = (float*)(P.ws + WS_STATS);
    LAS float* gwl = (LAS float*)lds;
    if (gates) {
        for (int idx = tid; idx < 8192; idx += 512) { const int k = idx >> 3, g = idx & 7; gwl[g * 1024 + k] = win_l[(size_t)k * DPROJ + 2048 + g]; }
        __syncthreads();
    }
    const int gw = bidx() * 8 + wid, NGW = gridDim.x * 8;
    constexpr int NR = MREAL;
    int row = 4 * gw;
    f32x4 a[4][4];
#define LN_ROWP(r_) (P.out + (size_t)(r_) * DM)
    const bf16_t* LOp = (const bf16_t*)(P.ws + WS_LO);
#define LN_LOAD(dst_, r_, j_) do { const u32x2 hi_ = *(const u32x2*)(HB + (size_t)(r_) * DM + 256 * (j_) + 4 * lane), lo_ = *(const u32x2*)(LOp + (size_t)(r_) * DM + 256 * (j_) + 4 * lane); \
        dst_ = (f32x4){bflo(hi_.x) + bflo(lo_.x), bfhi(hi_.x) + bfhi(lo_.x), bflo(hi_.y) + bflo(lo_.y), bfhi(hi_.y) + bfhi(lo_.y)}; } while (0)
    if (row < NR) {
#pragma unroll
        for (int q4 = 0; q4 < 4; ++q4) {
#pragma unroll
            for (int j = 0; j < 4; ++j) LN_LOAD(a[q4][j], row + q4, j); }
    }
    while (row < NR) {
        f32x4 ca[4][4];
#pragma unroll
        for (int q4 = 0; q4 < 4; ++q4)
#pragma unroll
            for (int j = 0; j < 4; ++j) ca[q4][j] = a[q4][j];
        const int nrow = row + 4 * NGW;
        if (nrow < NR) {
#pragma unroll
            for (int q4 = 0; q4 < 4; ++q4) {
#pragma unroll
                for (int j = 0; j < 4; ++j) LN_LOAD(a[q4][j], nrow + q4, j); }
        }
#pragma unroll
        for (int q4 = 0; q4 < 4; ++q4) ln_row(ca[q4], row + q4, LN_ROWP(row + q4), gam, bet, gates, fin, bif_l, gwl, HB, ST, GT, lane);
        row = nrow;
    }
#undef LN_ROWP
#undef LN_LOAD
}

__device__ __forceinline__ void conv8(const bf16_t* PB, const float* cw, const float* cb, int b, int pos, int chn, f32x4& o0, f32x4& o1) {
    o0 = *(const f32x4*)(cb + chn); o1 = *(const f32x4*)(cb + chn + 4);
#pragma unroll
    for (int j = 0; j < 4; ++j) {
        const int pp = pos - 3 + j;
        if (pp >= 0) {
            const u32x4 u = *(const u32x4*)(PB + seqrow(b, pp) * NPB + chn);
            const f32x4 w0 = *(const f32x4*)(cw + j * 1024 + chn), w1 = *(const f32x4*)(cw + j * 1024 + chn + 4);
            o0[0] += w0[0] * bflo(u.x); o0[1] += w0[1] * bfhi(u.x); o0[2] += w0[2] * bflo(u.y); o0[3] += w0[3] * bfhi(u.y);
            o1[0] += w1[0] * bflo(u.z); o1[1] += w1[1] * bfhi(u.z); o1[2] += w1[2] * bflo(u.w); o1[3] += w1[3] * bfhi(u.w);
        }
    }
#pragma unroll
    for (int e = 0; e < 4; ++e) { o0[e] = siluf(o0[e]); o1[e] = siluf(o1[e]); }
}
struct ConvW { f32x4 w[4][2]; f32x4 b[2]; };
__device__ __forceinline__ void convw_load(ConvW& cw8, const float* cw, const float* cb, int chn) {
    cw8.b[0] = *(const f32x4*)(cb + chn); cw8.b[1] = *(const f32x4*)(cb + chn + 4);
#pragma unroll
    for (int j = 0; j < 4; ++j) { cw8.w[j][0] = *(const f32x4*)(cw + j * 1024 + chn); cw8.w[j][1] = *(const f32x4*)(cw + j * 1024 + chn + 4); }
}
__device__ __forceinline__ void conv8w(const bf16_t* PB, const ConvW& cw8, int b, int pos, int chn, f32x4& o0, f32x4& o1) {
    o0 = cw8.b[0]; o1 = cw8.b[1];
    u32x4 u4[4];
#pragma unroll
    for (int j = 0; j < 4; ++j) {
        const int pp = pos - 3 + j;
        u4[j] = *(const u32x4*)(PB + seqrow(b, pp < 0 ? 0 : pp) * NPB + chn);
    }
#pragma unroll
    for (int j = 0; j < 4; ++j) {
        const bool ok = pos - 3 + j >= 0;
        const u32x4 u = {ok ? u4[j].x : 0u, ok ? u4[j].y : 0u, ok ? u4[j].z : 0u, ok ? u4[j].w : 0u};
        const f32x4 w0 = cw8.w[j][0], w1 = cw8.w[j][1];
        o0[0] += w0[0] * bflo(u.x); o0[1] += w0[1] * bfhi(u.x); o0[2] += w0[2] * bflo(u.y); o0[3] += w0[3] * bfhi(u.y);
        o1[0] += w1[0] * bflo(u.z); o1[1] += w1[1] * bfhi(u.z); o1[2] += w1[2] * bflo(u.w); o1[3] += w1[3] * bfhi(u.w);
    }
#pragma unroll
    for (int e = 0; e < 4; ++e) { o0[e] = siluf(o0[e]); o1[e] = siluf(o1[e]); }
}

__device__ __forceinline__ float wscan_add(float v, int lane) {
#pragma unroll
    for (int o = 1; o < 64; o <<= 1) { const float t = __shfl_up(v, o); if (lane >= o) v += t; }
    return v;
}
__device__ __forceinline__ float wscan_max(float v, int lane) {
#pragma unroll
    for (int o = 1; o < 64; o <<= 1) { const float t = __shfl_up(v, o); if (lane >= o) v = fmaxf(v, t); }
    return v;
}

__device__ __forceinline__ void lds_barrier() { asm volatile("s_waitcnt lgkmcnt(0)\n\ts_barrier" ::: "memory"); }

constexpr int TSTR = 320;
constexpr int RSTR = 272;
__device__ __forceinline__ void m1_unit(const Params& P, int layer, int bh, int c, LAS unsigned char* lds) {
    const int tid = tidx(), lane = tid & 63, wid = __builtin_amdgcn_readfirstlane(tid >> 6);
    const int b = bh >> 2, hh = bh & 3;
    const int nvalid = c == 0 ? NMETA : 128, p0 = c == 0 ? 0 : NMETA + 128 * (c - 1);
    const int nrep = c == 0 ? NB : 1;
    const bf16_t* PB = (const bf16_t*)(P.ws + WS_BIG); const float* GT = (const float*)(P.ws + WS_GATES);
    float* SC = (float*)(P.ws + WS_SC); float* NST = (float*)(P.ws + WS_NST); bf16_t* CST = (bf16_t*)(P.ws + WS_CST);
    const float* cw = P.in[8] + (size_t)layer * 4 * 1024; const float* cb = P.in[9] + (size_t)layer * 1024;
    LAS unsigned char* Kt = lds; LAS unsigned char* Vt = lds + 128 * TSTR; LAS float* sws = (LAS float*)(lds + 2 * 128 * TSTR);
    if (wid == 0) {
        const int i0 = 2 * lane, i1 = i0 + 1;
        float li0 = NEGF, li1 = NEGF, lf0 = 0.f, lf1 = 0.f;
        if (i0 < nvalid) { const size_t rw = seqrow(b, p0 + i0); li0 = GT[rw * 8 + hh]; lf0 = GT[rw * 8 + 4 + hh]; }
        if (i1 < nvalid) { const size_t rw = seqrow(b, p0 + i1); li1 = GT[rw * 8 + hh]; lf1 = GT[rw * 8 + 4 + hh]; }
        const float s = lf0 + lf1, incl = wscan_add(s, lane), excl = incl - s;
        const float b0 = excl + lf0, b1 = incl, g0 = li0 - b0, g1 = li1 - b1;
        const float gmax = wave_max(fmaxf(g0, g1));
        sws[i0] = i0 < nvalid ? ex2((g0 - gmax) * LOG2E) : 0.f;
        sws[i1] = i1 < nvalid ? ex2((g1 - gmax) * LOG2E) : 0.f;
        const float bend = __shfl(incl, 63);
        if (lane == 0) { for (int bb = 0; bb < nrep; ++bb) { SC[(size_t)((bh + 4 * bb) * NCH + c) * 2] = bend; SC[(size_t)((bh + 4 * bb) * NCH + c) * 2 + 1] = bend + gmax; } }
    }
    __syncthreads();
    ConvW ckw; convw_load(ckw, cw, cb, 512 + hh * 128 + 8 * (tid & 15));
#pragma unroll 2
    for (int it = 0; it < 4; ++it) {
        const int item = tid + 512 * it, i = item >> 4, ch = item & 15;
        u32x4 kw, vw;
        {
            const int ic = i < nvalid ? i : nvalid - 1;
            f32x4 o0, o1; conv8w(PB, ckw, b, p0 + ic, 512 + hh * 128 + 8 * ch, o0, o1);
            const float sc = 0.08838834764831845f * sws[i];
            kw = pack8(o0 * sc, o1 * sc);
            vw = *(const u32x4*)(PB + seqrow(b, p0 + ic) * NPB + 1024 + hh * 128 + 8 * ch);
            if (i >= nvalid) { kw = (u32x4){0u, 0u, 0u, 0u}; vw = kw; }
        }
        *(LAS u32x4*)(Kt + i * TSTR + ch * 16) = kw; *(LAS u32x4*)(Vt + i * TSTR + ch * 16) = vw;
    }
    __syncthreads();
    {
        const int h = lane >> 5, g = lane >> 4, q = (lane & 15) >> 2, pp = lane & 3;
        const int dkt = wid >> 1, dvt0 = (wid & 1) * 2;
        f32x16 acc[2];
#pragma unroll
        for (int t = 0; t < 2; ++t)
#pragma unroll
            for (int e = 0; e < 16; ++e) acc[t][e] = 0.f;
#pragma unroll
        for (int ks = 0; ks < 8; ++ks) {
            const int rowa = 16 * ks + 8 * h + q;
            const LAS unsigned char* ka = Kt + rowa * TSTR + (32 * dkt + 16 * (g & 1) + 4 * pp) * 2;
            const bf16x8 af = cat8(vtr(ka), vtr(ka + 4 * TSTR));
#pragma unroll
            for (int t = 0; t < 2; ++t) {
                const LAS unsigned char* va = Vt + rowa * TSTR + (32 * (dvt0 + t) + 16 * (g & 1) + 4 * pp) * 2;
                const bf16x8 bf = cat8(vtr(va), vtr(va + 4 * TSTR));
                acc[t] = mfma32(af, bf, acc[t]);
            }
        }
#pragma unroll
        for (int t = 0; t < 2; ++t) {
            const int dv = 32 * (dvt0 + t) + (lane & 31);
#pragma unroll
            for (int r4 = 0; r4 < 4; ++r4) {
                const int dk0 = 32 * dkt + 8 * r4 + 4 * h;
                u32x2 w; w.x = pk2(acc[t][4 * r4], acc[t][4 * r4 + 1]); w.y = pk2(acc[t][4 * r4 + 2], acc[t][4 * r4 + 3]);
                for (int bb = 0; bb < nrep; ++bb) *(u32x2*)(CST + (size_t)((bh + 4 * bb) * NCH + c) * 16384 + (size_t)dv * 128 + dk0) = w;
            }
        }
    }
    {
        LAS float* red = sws + 256;
        const int dk = tid & 127, part = tid >> 7;
        float sacc = 0.f;
#pragma unroll 8
        for (int i = 0; i < 32; ++i) sacc += __builtin_bit_cast(float, (unsigned)(*(const LAS unsigned short*)(Kt + (32 * part + i) * TSTR + dk * 2)) << 16);
        red[part * 128 + dk] = sacc;
        __syncthreads();
        if (tid < 128) { const float nsum = (red[tid] + red[128 + tid]) + (red[256 + tid] + red[384 + tid]); for (int bb = 0; bb < nrep; ++bb) NST[(size_t)((bh + 4 * bb) * NCH + c) * 128 + tid] = nsum; }
    }
    lds_barrier();
}

__device__ __forceinline__ void m2_phase(const Params& P) {
    float* SC = (float*)(P.ws + WS_SC); float* MST = SC + 32 * NCH * 2; float* NST = (float*)(P.ws + WS_NST); bf16_t* CST = (bf16_t*)(P.ws + WS_CST);
    const int NT = gridDim.x * 512;
    for (int task = bidx() * 512 + tidx(); task < 65536 + 4096; task += NT) {
        if (task < 65536) {
            const int bh = task >> 11, e8 = task & 2047;
            bf16_t* ptr = CST + (size_t)bh * NCH * 16384 + (size_t)e8 * 8;
            float run[8];
#pragma unroll
            for (int e = 0; e < 8; ++e) run[e] = 0.f;
            float m = NEGF;
#pragma unroll 1
            for (int c0 = 0; c0 < NCH; c0 += 5) {
                u32x4 loc[5];
#pragma unroll
                for (int j = 0; j < 5; ++j) loc[j] = *(const u32x4*)(ptr + (size_t)(c0 + j) * 16384);
#pragma unroll
                for (int j = 0; j < 5; ++j) {
                    const int c = c0 + j;
                    const float bend = SC[(size_t)(bh * NCH + c) * 2], mloc = SC[(size_t)(bh * NCH + c) * 2 + 1];
                    const float mn = fmaxf(bend + m, mloc), a = ex2((bend + m - mn) * LOG2E), bt = ex2((mloc - mn) * LOG2E);
                    u32x4 w; w.x = pk2(run[0], run[1]); w.y = pk2(run[2], run[3]); w.z = pk2(run[4], run[5]); w.w = pk2(run[6], run[7]);
                    *(u32x4*)(ptr + (size_t)c * 16384) = w;
                    run[0] = a * run[0] + bt * bflo(loc[j].x); run[1] = a * run[1] + bt * bfhi(loc[j].x);
                    run[2] = a * run[2] + bt * bflo(loc[j].y); run[3] = a * run[3] + bt * bfhi(loc[j].y);
                    run[4] = a * run[4] + bt * bflo(loc[j].z); run[5] = a * run[5] + bt * bfhi(loc[j].z);
                    run[6] = a * run[6] + bt * bflo(loc[j].w); run[7] = a * run[7] + bt * bfhi(loc[j].w);
                    if (e8 == 0) MST[bh * NCH + c] = m;
                    m = mn;
                }
            }
        } else {
            const int t2 = task - 65536, bh = t2 >> 7, dk = t2 & 127;
            float* ptr = NST + (size_t)bh * NCH * 128 + dk;
            float run = 0.f, m = NEGF;
#pragma unroll 1
            for (int c = 0; c < NCH; ++c) {
                const float bend = SC[(size_t)(bh * NCH + c) * 2], mloc = SC[(size_t)(bh * NCH + c) * 2 + 1];
                const float mn = fmaxf(bend + m, mloc), a = ex2((bend + m - mn) * LOG2E), bt = ex2((mloc - mn) * LOG2E);
                const float loc = ptr[(size_t)c * 128]; ptr[(size_t)c * 128] = run; run = a * run + bt * loc; m = mn;
            }
        }
    }
}

__device__ __forceinline__ void m3_unit(const Params& P, int layer, int bh, int c, LAS unsigned char* lds) {
    const int tid = tidx(), lane = tid & 63, wid = __builtin_amdgcn_readfirstlane(tid >> 6);
    const int b = bh >> 2, hh = bh & 3;
    const int nvalid = c == 0 ? NMETA : 128, p0 = c == 0 ? 0 : NMETA + 128 * (c - 1);
    const bf16_t* PB = (const bf16_t*)(P.ws + WS_BIG); const float* GT = (const float*)(P.ws + WS_GATES);
    const float* SC = (const float*)(P.ws + WS_SC); const float* MST = SC + 32 * NCH * 2; const float* NST = (const float*)(P.ws + WS_NST); const bf16_t* CST = (const bf16_t*)(P.ws + WS_CST);
    bf16_t* MA = (bf16_t*)(P.ws + WS_MA);
    const float* cw = P.in[8] + (size_t)layer * 4 * 1024; const float* cb = P.in[9] + (size_t)layer * 1024; const float* mng = P.in[11] + (size_t)layer * 512;
    LAS unsigned char* Qt = lds; LAS unsigned char* Kt = lds + 128 * RSTR; LAS unsigned char* Vt = lds + 2 * 128 * RSTR;
    LAS float* sg2 = (LAS float*)(lds + 2 * 128 * RSTR + 128 * TSTR); LAS float* sr2 = sg2 + 128; LAS float* sw = sg2 + 256; LAS float* semt = sg2 + 384; LAS float* sqn = sg2 + 512;
    LAS float* sst = sg2 + 640; LAS float* sst2 = sg2 + 896; LAS float* snp = sg2 + 1152;
    constexpr int CT_OFF = 116736;
    {
        const bf16_t* Cp = CST + (size_t)(bh * NCH + c) * 16384;
#pragma unroll
        for (int k = 0; k < 4; ++k) {
            const int S = (k * 8 + wid) * 64 + lane, row = S >> 4, cch = (S & 15) ^ (row & 15);
            __builtin_amdgcn_global_load_lds((const unsigned*)(Cp + (size_t)row * 128 + cch * 8), (LAS unsigned*)(lds + CT_OFF + (k * 8 + wid) * 1024), 16, 0, 0);
        }
    }
    const float npv = tid < 128 ? NST[(size_t)(bh * NCH + c) * 128 + tid] : 0.f;
    float li0 = NEGF, li1 = NEGF, lf0 = 0.f, lf1 = 0.f, mprev = 0.f;
    if (wid == 0) {
        const int i0 = 2 * lane, i1 = i0 + 1;
        if (i0 < nvalid) { const size_t rw = seqrow(b, p0 + i0); li0 = GT[rw * 8 + hh]; lf0 = GT[rw * 8 + 4 + hh]; }
        if (i1 < nvalid) { const size_t rw = seqrow(b, p0 + i1); li1 = GT[rw * 8 + hh]; lf1 = GT[rw * 8 + 4 + hh]; }
        mprev = MST[bh * NCH + c];
    }
    ConvW cqw, ckw; convw_load(cqw, cw, cb, hh * 128 + 8 * (tid & 15)); convw_load(ckw, cw, cb, 512 + hh * 128 + 8 * (tid & 15));
    if (wid == 0) {
        const int i0 = 2 * lane, i1 = i0 + 1;
        const float s = lf0 + lf1, incl = wscan_add(s, lane), excl = incl - s;
        const float b0 = excl + lf0, b1 = incl, g0 = li0 - b0, g1 = li1 - b1;
        const float inclm = wscan_max(fmaxf(g0, g1), lane);
        float exclm = __shfl_up(inclm, 1); if (lane == 0) exclm = NEGF;
        const float cm0 = fmaxf(exclm, g0), cm1 = inclm;
        const float M0 = fmaxf(mprev, cm0), M1 = fmaxf(mprev, cm1);
        sg2[i0] = g0 * LOG2E; sg2[i1] = g1 * LOG2E; sr2[i0] = -M0 * LOG2E; sr2[i1] = -M1 * LOG2E;
        sw[i0] = ex2((mprev - M0) * LOG2E); sw[i1] = ex2((mprev - M1) * LOG2E);
        semt[i0] = ex2(-(b0 + M0) * LOG2E); semt[i1] = ex2(-(b1 + M1) * LOG2E);
    }
#pragma unroll 2
    for (int it = 0; it < 4; ++it) {
        const int item = tid + 512 * it, i = item >> 4, ch = item & 15;
        u32x4 qw, kw, vw;
        {
            const int ic = i < nvalid ? i : nvalid - 1;
            f32x4 o0, o1;
            conv8w(PB, cqw, b, p0 + ic, hh * 128 + 8 * ch, o0, o1); qw = pack8(o0, o1);
            conv8w(PB, ckw, b, p0 + ic, 512 + hh * 128 + 8 * ch, o0, o1); kw = pack8(o0 * 0.08838834764831845f, o1 * 0.08838834764831845f);
            vw = *(const u32x4*)(PB + seqrow(b, p0 + ic) * NPB + 1024 + hh * 128 + 8 * ch);
            if (i >= nvalid) { qw = (u32x4){0u, 0u, 0u, 0u}; kw = qw; vw = qw; }
        }
        *(LAS u32x4*)(Qt + i * RSTR + ch * 16) = qw; *(LAS u32x4*)(Kt + i * RSTR + ch * 16) = kw; *(LAS u32x4*)(Vt + i * TSTR + ch * 16) = vw;
    }
    if (tid < 128) snp[tid] = npv;
    asm volatile("s_waitcnt vmcnt(0)" ::: "memory");
    __syncthreads();
    const int r = lane & 31, h = lane >> 5, g = lane >> 4, q = (lane & 15) >> 2, pp = lane & 3;
    const int qb = wid >> 1, dvh = wid & 1, t = 32 * qb + r;
    u32x2 mo_[2][4]; f32x4 gn_[2][4];
    {
        const size_t rowp = seqrow(b, p0 + (t < nvalid ? t : 0));
#pragma unroll
        for (int d = 0; d < 2; ++d)
#pragma unroll
            for (int r4 = 0; r4 < 4; ++r4) {
                const int col = hh * 128 + 32 * (2 * dvh + d) + 8 * r4 + 4 * h;
                mo_[d][r4] = *(const u32x2*)(PB + rowp * NPB + 1536 + col); gn_[d][r4] = *(const f32x4*)(mng + col);
            }
    }
    {
        const int i = tid >> 2, part = tid & 3;
        const LAS float* np = snp + 32 * part;
        float s = 0.f;
#pragma unroll
        for (int d8 = 0; d8 < 4; ++d8) {
            const u32x4 qv = *(const LAS u32x4*)(Qt + i * RSTR + (32 * part + 8 * d8) * 2);
            const f32x4 n0 = *(const LAS f32x4*)(np + 8 * d8), n1 = *(const LAS f32x4*)(np + 8 * d8 + 4);
            s += bflo(qv.x) * n0[0] + bfhi(qv.x) * n0[1] + bflo(qv.y) * n0[2] + bfhi(qv.y) * n0[3] + bflo(qv.z) * n1[0] + bfhi(qv.z) * n1[1] + bflo(qv.w) * n1[2] + bfhi(qv.w) * n1[3];
        }
        s += __shfl_xor(s, 1); s += __shfl_xor(s, 2);
        if (part == 0) sqn[i] = s;
    }
    bf16x8 qf[8];
#pragma unroll
    for (int ks = 0; ks < 8; ++ks) qf[ks] = *(const LAS bf16x8*)(Qt + t * RSTR + (16 * ks + 8 * h) * 2);
    f32x16 acc[2];
#pragma unroll
    for (int d = 0; d < 2; ++d)
#pragma unroll
        for (int e = 0; e < 16; ++e) acc[d][e] = 0.f;
    {
#pragma unroll
        for (int ks = 0; ks < 8; ++ks)
#pragma unroll
            for (int d = 0; d < 2; ++d) {
                const int dv = 32 * (2 * dvh + d) + r;
                const bf16x8 cf = *(const LAS bf16x8*)(lds + CT_OFF + (dv * 16 + ((2 * ks + h) ^ (dv & 15))) * 16);
                acc[d] = mfma32(cf, qf[ks], acc[d]);
            }
    }
    __syncthreads();
    const float wt = sw[t], r2 = sr2[t];
#pragma unroll
    for (int d = 0; d < 2; ++d) acc[d] = acc[d] * wt;
    float den = 0.f;
#pragma unroll 1
    for (int kb = 0; kb <= qb; ++kb) {
        f32x16 st;
#pragma unroll
        for (int e = 0; e < 16; ++e) st[e] = 0.f;
#pragma unroll
        for (int ks = 0; ks < 8; ++ks) { const bf16x8 kf = *(const LAS bf16x8*)(Kt + (32 * kb + r) * RSTR + (16 * ks + 8 * h) * 2); st = mfma32(kf, qf[ks], st); }
#pragma unroll
        for (int r4 = 0; r4 < 4; ++r4) {
            const int s0 = 32 * kb + 8 * r4 + 4 * h;
            const f32x4 gs = *(const LAS f32x4*)(sg2 + s0);
#pragma unroll
            for (int e = 0; e < 4; ++e) {
                float v = st[4 * r4 + e] * ex2(r2 + gs[e]);
                if (s0 + e > t) v = 0.f;
                den += v; st[4 * r4 + e] = v;
            }
        }
#pragma unroll
        for (int s2 = 0; s2 < 2; ++s2) {
            u32x4 pw; pw.x = pk2(st[8 * s2], st[8 * s2 + 1]); pw.y = pk2(st[8 * s2 + 2], st[8 * s2 + 3]); pw.z = pk2(st[8 * s2 + 4], st[8 * s2 + 5]); pw.w = pk2(st[8 * s2 + 6], st[8 * s2 + 7]);
            const bf16x8 pf = __builtin_bit_cast(bf16x8, pw);
#pragma unroll
            for (int d = 0; d < 2; ++d) {
                const LAS unsigned char* va = Vt + (32 * kb + 16 * s2 + 4 * h + q) * TSTR + (32 * (2 * dvh + d) + 16 * (g & 1) + 4 * pp) * 2;
                const bf16x8 vf = cat8(vtr(va), vtr(va + 8 * TSTR));
                acc[d] = mfma32(vf, pf, acc[d]);
            }
        }
    }
    den += __shfl_xor(den, 32);
    den += wt * sqn[t];
    const float inv = 1.f / fmaxf(fabsf(den), semt[t]);
    float s1 = 0.f;
#pragma unroll
    for (int d = 0; d < 2; ++d)
#pragma unroll
        for (int e = 0; e < 16; ++e) { acc[d][e] *= inv; s1 += acc[d][e]; }
    s1 += __shfl_xor(s1, 32);
    if (h == 0) sst[wid * 32 + r] = s1;
    __syncthreads();
    const float mean = (s1 + sst[(wid ^ 1) * 32 + r]) * (1.f / 128.f);
    float q2 = 0.f;
#pragma unroll
    for (int d = 0; d < 2; ++d)
#pragma unroll
        for (int e = 0; e < 16; ++e) { acc[d][e] -= mean; q2 += acc[d][e] * acc[d][e]; }
    q2 += __shfl_xor(q2, 32);
    if (h == 0) sst2[wid * 32 + r] = q2;
    __syncthreads();
    const float rstd = 1.f / sqrtf((q2 + sst2[(wid ^ 1) * 32 + r]) * (1.f / 128.f) + LN_EPS);
    if (t < nvalid) {
        const size_t row = seqrow(b, p0 + t);
#pragma unroll
        for (int d = 0; d < 2; ++d)
#pragma unroll
            for (int r4 = 0; r4 < 4; ++r4) {
                const int col = hh * 128 + 32 * (2 * dvh + d) + 8 * r4 + 4 * h;
                const u32x2 mo = mo_[d][r4];
                const f32x4 g4 = gn_[d][r4];
                const float o0 = acc[d][4 * r4] * rstd * g4[0] * sigm(bflo(mo.x)), o1 = acc[d][4 * r4 + 1] * rstd * g4[1] * sigm(bfhi(mo.x));
                const float o2 = acc[d][4 * r4 + 2] * rstd * g4[2] * sigm(bflo(mo.y)), o3 = acc[d][4 * r4 + 3] * rstd * g4[3] * sigm(bfhi(mo.y));
                u32x2 w; w.x = pk2(o0, o1); w.y = pk2(o2, o3);
                *(u32x2*)(MA + row * 512 + col) = w;
            }
    }
    lds_barrier();
}

constexpr int AT_KB = 64 * RSTR, AT_VB = 64 * TSTR, AT_BUF = AT_KB + AT_VB;
__device__ __forceinline__ void attn_unit(const Params& P, int layer, int b, int hd, int pq0, int nvalid, float lam, float lam_init, LAS unsigned char* lds) {
    const int tid = tidx(), lane = tid & 63, wid = __builtin_amdgcn_readfirstlane(tid >> 6);
    const int c = wid >> 2, wq = wid & 3, r = lane & 31, h = lane >> 5, g = lane >> 4, q = (lane & 15) >> 2, pp = lane & 3;
    const bf16_t* PB = (const bf16_t*)(P.ws + WS_BIG); bf16_t* AO = (bf16_t*)(P.ws + WS_MA) + (size_t)MPAD * 512;
    const float* ang = P.in[16] + (size_t)layer * 512;
    const int qi = 32 * wq + r, qp = pq0 + qi;
    bf16x8 qf[4];
    {
        const size_t qrow = seqrow(b, qp < LSEQ ? qp : LSEQ - 1);
#pragma unroll
        for (int ks = 0; ks < 4; ++ks) qf[ks] = *(const bf16x8*)(PB + qrow * NPB + 2048 + hd * 128 + c * 64 + 16 * ks + 8 * h);
    }
    const float slope2 = ex2(-2.f * (float)(hd + 1)) * LOG2E;
    const int ntiles = (pq0 + nvalid - 1) / 64 + 1;
    float qkb;
    {
        float ss = 0.f;
#pragma unroll
        for (int ks = 0; ks < 4; ++ks)
#pragma unroll
            for (int j = 0; j < 8; ++j) { const float v = __builtin_bit_cast(float, (unsigned)(unsigned short)qf[ks][j] << 16); ss += v * v; }
        ss += __shfl_xor(ss, 32);
        const float* KM = (const float*)(P.ws + WS_KM) + layer * 72;
        const float k2 = fmaxf(KM[b * 8 + hd * 2 + c], KM[64 + hd * 2 + c]);
        qkb = sqrtf(ss) * sqrtf(k2) * 1.001f + 0.01f;
    }
    LAS unsigned* votes = (LAS unsigned*)(lds + 131072 + 2048);
    if (tid < 16) votes[tid] = 0u;
    u32x4 pk[2], pv[2];
#define AT_LOAD(kt) do { _Pragma("unroll") for (int i_ = 0; i_ < 2; ++i_) { const int row_ = (tid + 512 * i_) >> 4, ch_ = tid & 15; int kp_ = 64 * (kt) + row_; kp_ = kp_ < LSEQ ? kp_ : LSEQ - 1; \
        const bf16_t* src_ = PB + seqrow(b, kp_) * NPB + hd * 128 + ch_ * 8; pk[i_] = *(const u32x4*)(src_ + 2560); pv[i_] = *(const u32x4*)(src_ + 3072); } } while (0)
#define AT_STORE(s) do { _Pragma("unroll") for (int i_ = 0; i_ < 2; ++i_) { const int row_ = (tid + 512 * i_) >> 4, ch_ = tid & 15; \
        *(LAS u32x4*)(lds + (s) * AT_BUF + row_ * RSTR + ch_ * 16) = pk[i_]; *(LAS u32x4*)(lds + (s) * AT_BUF + AT_KB + row_ * TSTR + ch_ * 16) = pv[i_]; } } while (0)
    AT_LOAD(ntiles - 1); AT_STORE((ntiles - 1) & 1);
    __syncthreads();
    float m_run = NEGF, l_run = 0.f;
    f32x16 o[4];
#pragma unroll
    for (int d = 0; d < 4; ++d)
#pragma unroll
        for (int e = 0; e < 16; ++e) o[d][e] = 0.f;
#pragma unroll 1
    for (int kt = ntiles - 1; kt >= 0; --kt) {
        const int s = kt & 1;
        if (kt > 0) AT_LOAD(kt - 1);
        const LAS unsigned char* Kb = lds + s * AT_BUF; const LAS unsigned char* Vb = Kb + AT_KB;
        if (64 * kt <= pq0 + 32 * wq + 31) {
        f32x16 st[2];
#pragma unroll
        for (int kb2 = 0; kb2 < 2; ++kb2) {
            const float tb = slope2 * (float)(64 * kt + 32 * kb2 - pq0 + 4 * h);
#pragma unroll
            for (int e = 0; e < 16; ++e) st[kb2][e] = tb + slope2 * (float)((e & 3) + 8 * (e >> 2));
#pragma unroll
            for (int ks = 0; ks < 4; ++ks) { const bf16x8 kf = *(const LAS bf16x8*)(Kb + (32 * kb2 + r) * RSTR + (c * 64 + 16 * ks + 8 * h) * 2); st[kb2] = mfma32(kf, qf[ks], st[kb2]); }
        }
        if (64 * kt + 63 > pq0 + 32 * wq) {
#pragma unroll
            for (int kb2 = 0; kb2 < 2; ++kb2)
#pragma unroll
                for (int e = 0; e < 16; ++e) { const int kp = 64 * kt + 32 * kb2 + (e & 3) + 8 * (e >> 2) + 4 * h; if (kp > qp) st[kb2][e] = NEGF; }
        }
        float mx = st[0][0];
#pragma unroll
        for (int e = 1; e < 16; ++e) mx = fmaxf(mx, st[0][e]);
#pragma unroll
        for (int e = 0; e < 16; ++e) mx = fmaxf(mx, st[1][e]);
        mx = fmaxf(mx, __shfl_xor(mx, 32));
        if (__any(mx > m_run + 8.f)) {
            const float m_new = fmaxf(m_run, mx), alpha = ex2(m_run - m_new);
            m_run = m_new; l_run *= alpha;
#pragma unroll
            for (int d = 0; d < 4; ++d) o[d] = o[d] * alpha;
        }
        const float m_new = m_run;
        float psum = 0.f;
#pragma unroll
        for (int kb2 = 0; kb2 < 2; ++kb2)
#pragma unroll
            for (int e = 0; e < 16; ++e) { const float p = ex2(st[kb2][e] - m_new); st[kb2][e] = p; psum += p; }
        l_run += psum;
#pragma unroll
        for (int kb2 = 0; kb2 < 2; ++kb2)
#pragma unroll
            for (int s2 = 0; s2 < 2; ++s2) {
                u32x4 pw; pw.x = pk2(st[kb2][8 * s2], st[kb2][8 * s2 + 1]); pw.y = pk2(st[kb2][8 * s2 + 2], st[kb2][8 * s2 + 3]); pw.z = pk2(st[kb2][8 * s2 + 4], st[kb2][8 * s2 + 5]); pw.w = pk2(st[kb2][8 * s2 + 6], st[kb2][8 * s2 + 7]);
                const bf16x8 pf = __builtin_bit_cast(bf16x8, pw);
#pragma unroll
                for (int d = 0; d < 4; ++d) {
                    const LAS unsigned char* va = Vb + (32 * kb2 + 16 * s2 + 4 * h + q) * TSTR + (32 * d + 16 * (g & 1) + 4 * pp) * 2;
                    const bf16x8 vf = cat8(vtr(va), vtr(va + 8 * TSTR));
                    o[d] = mfma32(vf, pf, o[d]);
                }
            }
        }
        if (kt > 0) {
            const float bnd = qkb + slope2 * (float)(64 * (kt - 1) + 63 - pq0);
            const bool dn = !__any(bnd >= m_run - 44.f);
            if (lane == 0) votes[s * 8 + wid] = dn ? 1u : 0u;
            AT_STORE(s ^ 1);
        }
        __syncthreads();
        if (kt > 0) {
            const u32x4 v0 = *(const LAS u32x4*)(votes + s * 8), v1 = *(const LAS u32x4*)(votes + s * 8 + 4);
            const unsigned all = (unsigned)__builtin_amdgcn_readfirstlane((int)((v0.x & v0.y) & (v0.z & v0.w) & (v1.x & v1.y) & (v1.z & v1.w)));
            if (all) break;
        }
    }
#undef AT_LOAD
#undef AT_STORE
    const float l_tot = l_run + __shfl_xor(l_run, 32), inv = 1.f / l_tot;
    LAS float* xch = (LAS float*)lds;
    if (c == 1) {
#pragma unroll
        for (int d = 0; d < 4; ++d)
#pragma unroll
            for (int e = 0; e < 16; ++e) xch[((wq * 4 + d) * 16 + e) * 64 + lane] = o[d][e] * inv;
    }
    __syncthreads();
    if (c == 0) {
        float ss = 0.f;
#pragma unroll
        for (int d = 0; d < 4; ++d)
#pragma unroll
            for (int e = 0; e < 16; ++e) { const float v = o[d][e] * inv - lam * xch[((wq * 4 + d) * 16 + e) * 64 + lane]; o[d][e] = v; ss += v * v; }
        ss += __shfl_xor(ss, 32);
        const float rms = (1.f / sqrtf(ss * (1.f / 128.f) + LN_EPS)) * (1.f - lam_init);
        f32x4 ga_[4][4];
#pragma unroll
        for (int d = 0; d < 4; ++d)
#pragma unroll
            for (int r4 = 0; r4 < 4; ++r4) ga_[d][r4] = *(const f32x4*)(ang + hd * 128 + 32 * d + 8 * r4 + 4 * h);
        if (qi < nvalid) {
            const size_t row = seqrow(b, qp);
#pragma unroll
            for (int d = 0; d < 4; ++d)
#pragma unroll
                for (int r4 = 0; r4 < 4; ++r4) {
                    const int col = hd * 128 + 32 * d + 8 * r4 + 4 * h;
                    const f32x4 g4 = ga_[d][r4];
                    u32x2 w; w.x = pk2(o[d][4 * r4] * rms * g4[0], o[d][4 * r4 + 1] * rms * g4[1]); w.y = pk2(o[d][4 * r4 + 2] * rms * g4[2], o[d][4 * r4 + 3] * rms * g4[3]);
                    *(u32x2*)(AO + row * 512 + col) = w;
                }
        }
    }
    lds_barrier();
}

#define XB_TMO      128
#define XB_XCNT(j)  (256  + 64 * (j))
#define XB_XSUB(j)  (1280 + 64 * (j))
#define XB_XGEN(j)  (2304 + 64 * (j))
#define XB_TOP      3328
#define XB_TOPGEN   3392
#define XCD_BAR_WORDS 3456
#define XB_SPIN_CAP (1u << 18)

__device__ __forceinline__ unsigned xb_ld(unsigned* p)              { return __hip_atomic_load(p, __ATOMIC_RELAXED, __HIP_MEMORY_SCOPE_AGENT); }
__device__ __forceinline__ unsigned xb_add(unsigned* p, unsigned v) { return __hip_atomic_fetch_add(p, v, __ATOMIC_RELAXED, __HIP_MEMORY_SCOPE_AGENT); }
__device__ __forceinline__ unsigned xb_xcc_id() { return (unsigned)__builtin_amdgcn_s_getreg((3 << 11) | 20) & 0xFu; }
#define XB_SPIN(cond, bar) do { unsigned _sp = 0; while (cond) { __builtin_amdgcn_s_sleep(1); \
    if ((++_sp & 255u) == 0u) { if (xb_ld(&(bar)[XB_TMO])) break; if (_sp > XB_SPIN_CAP) { atomicAdd(&(bar)[XB_TMO], 1u); break; } } } } while (0)

struct XcdBarrier {
    unsigned* bar; unsigned x;
    volatile LAS unsigned* st;
};

__device__ __forceinline__ XcdBarrier xcd_barrier_post(unsigned* bar, volatile LAS unsigned* st) {
    XcdBarrier b; b.bar = bar; b.x = xb_xcc_id(); b.st = st;
    if (threadIdx.x == 0) (void)xb_add(&bar[XB_XCNT(b.x)], 1u);
    return b;
}
__device__ __forceinline__ void xcd_barrier_complete(unsigned* bar, unsigned x, unsigned& nloc, unsigned& nx) {
    const unsigned G = gridDim.x * gridDim.y * gridDim.z;
    unsigned sum, cnt, mine, sp = 0u;
    for (;;) {
        sum = 0u; cnt = 0u; mine = 0u;
#pragma unroll
        for (unsigned j = 0; j < 16; ++j) { const unsigned c = xb_ld(&bar[XB_XCNT(j)]); sum += c; cnt += (c > 0u) ? 1u : 0u; mine = (j == x) ? c : mine; }
        if (sum == G) break;
        __builtin_amdgcn_s_sleep(1);
        if ((++sp & 255u) == 0u) { if (xb_ld(&bar[XB_TMO])) break; if (sp > XB_SPIN_CAP) { atomicAdd(&bar[XB_TMO], 1u); break; } }
    }
    nloc = mine > 0u ? mine : 1u; nx = cnt > 0u ? cnt : 1u;
}

__device__ __forceinline__ void xcd_barrier(const XcdBarrier& b) {
    asm volatile("s_waitcnt vmcnt(0)" ::: "memory");
    __syncthreads();
    if (threadIdx.x == 0) {
        unsigned* bar = b.bar;
        __builtin_amdgcn_s_waitcnt(0);
        unsigned nloc = b.st[0], nx = b.st[1];
        if (nloc == 0u) { xcd_barrier_complete(bar, b.x, nloc, nx); b.st[0] = nloc; b.st[1] = nx; }
        const unsigned old = xb_add(&bar[XB_XSUB(b.x)], 1u);
        const unsigned gen = old / nloc;
        if (old + 1u == (gen + 1u) * nloc) {
            __builtin_amdgcn_fence(__ATOMIC_RELEASE, "agent");
            asm volatile("s_waitcnt vmcnt(0)" ::: "memory");
            const unsigned og = xb_add(&bar[XB_TOP], 1u);
            const unsigned tg = og / nx;
            if (og + 1u == (tg + 1u) * nx) xb_add(&bar[XB_TOPGEN], 1u);
            else XB_SPIN(xb_ld(&bar[XB_TOPGEN]) == tg, bar);
            __builtin_amdgcn_fence(__ATOMIC_ACQUIRE, "agent");
            xb_add(&bar[XB_XGEN(b.x)], 1u);
            asm volatile("s_waitcnt vmcnt(0)" ::: "memory");
        } else {
            XB_SPIN(xb_ld(&bar[XB_XGEN(b.x)]) == gen, bar);
            __builtin_amdgcn_fence(__ATOMIC_ACQUIRE, "agent");
            asm volatile("s_waitcnt vmcnt(0)" ::: "memory");
        }
    }
    __syncthreads();
}

#ifndef PROBE_ATT
#define PROBE_ATT 1
#endif
#ifndef PROBE_M3
#define PROBE_M3 1
#endif
constexpr int LDS_BYTES = 155648;
constexpr int LDS_BST = LDS_BYTES - 64;
#ifndef PROG_LAYER
#define PROG_LAYER(L) 16*L+0, 16*L+1, 16*L+3, 16*L+4, 16*L+5, 16*L+6, 16*L+7, 16*L+8, 16*L+9, 16*L+11, 16*L+12
#endif
__device__ const unsigned char PROG[] = { PROG_LAYER(0), PROG_LAYER(1), 16 * 1 + 13 };
constexpr int NSTEP = 14;
__global__ void __launch_bounds__(512) hybrid_fwd(Params P) {
    extern __shared__ __attribute__((aligned(16))) unsigned char smem[];
    LAS unsigned char* lds = (LAS unsigned char*)smem;
    cg::grid_group grid = cg::this_grid();
    unsigned* barw = (unsigned*)(P.ws + WS_BAR);
    volatile LAS unsigned* bst = (volatile LAS unsigned*)(lds + LDS_BST);
    if (blockIdx.x == 0) for (int i = threadIdx.x; i < XCD_BAR_WORDS; i += 512) __hip_atomic_store(barw + i, 0u, __ATOMIC_RELAXED, __HIP_MEMORY_SCOPE_AGENT);
    if (blockIdx.x == 0 && threadIdx.x < 144) __hip_atomic_store((unsigned*)(P.ws + WS_KM) + threadIdx.x, 0u, __ATOMIC_RELAXED, __HIP_MEMORY_SCOPE_AGENT);
    if (threadIdx.x < 2) bst[threadIdx.x] = 0u;
    __syncthreads();

#ifndef PROBE_P0
#define PROBE_P0 1
#endif
#pragma unroll 1
    for (int rep0_ = 0; rep0_ < PROBE_P0; ++rep0_)
    {
        const int lane = tidx() & 63, wid = tidx() >> 6, gw = bidx() * 8 + wid, NGW = gridDim.x * 8;
        bf16_t* HB = (bf16_t*)(P.ws + WS_HB); float* HFM = (float*)(P.ws + WS_HFM);
        LAS float* scr = (LAS float*)(lds + wid * 16384);
        for (int it = gw; it < 2 * CW_ITEMS; it += NGW) conv_weight_item(P, it / CW_ITEMS, it % CW_ITEMS, scr, lane);
        const float* x = P.in[0]; const float* meta = P.in[1];
        {
            const size_t NT8 = (size_t)gridDim.x * 512, n8 = (size_t)MREAL * DM / 8;
#pragma unroll 4
            for (size_t i = (size_t)bidx() * 512 + tidx(); i < n8; i += NT8) {
                const f32x4 v0 = *(const f32x4*)(x + i * 8), v1 = *(const f32x4*)(x + i * 8 + 4);
                *(u32x4*)(HB + i * 8) = pack8(v0, v1);
            }
        }
        for (int row = gw; row < NMETA; row += NGW) {
#pragma unroll
            for (int j = 0; j < 4; ++j) {
                const f32x4 v = *(const f32x4*)(meta + (size_t)row * DM + 256 * j + 4 * lane);
                *(f32x4*)(HFM + (size_t)row * DM + 256 * j + 4 * lane) = v;
                u32x2 w; w.x = pk2(v[0], v[1]); w.y = pk2(v[2], v[3]);
                *(u32x2*)(HB + (size_t)(MROW0 + row) * DM + 256 * j + 4 * lane) = w;
            }
        }
    }
    grid.sync();
    (void)xcd_barrier_post(barw, bst);

#pragma unroll 1
    for (int ph = 0; ph < (int)sizeof(PROG); ++ph) {
        const int layer = PROG[ph] >> 4, step = PROG[ph] & 15;
        const int G = gridDim.x;
#define TIDV const int tid_ = tidx(), lane = tid_ & 63, wid = __builtin_amdgcn_readfirstlane(tid_ >> 6); (void)lane; (void)wid;
        bf16_t* HB = (bf16_t*)(P.ws + WS_HB); float* HFM = (float*)(P.ws + WS_HFM);
        bf16_t* BIG = (bf16_t*)(P.ws + WS_BIG); bf16_t* MA = (bf16_t*)(P.ws + WS_MA);
        const bf16_t* Wl = (const bf16_t*)(P.ws + WS_W) + (size_t)layer * OW_LAYER;
#define LNCTX float* ROWS = (float*)(P.ws + WS_ROWS); const float* CSl = (const float*)(P.ws + WS_CSBW) + (size_t)layer * 2 * OC_N; const float* BWl = CSl + OC_N; \
        const int tlast = 3 * layer + (step <= 1 ? -1 : step <= 9 ? 0 : step <= 12 ? 1 : 2);   \
        const float* rows_last = ROWS + (size_t)((tlast & 1) * MPAD) * 2; (void)CSl; (void)BWl; (void)rows_last;
        if (step == 0 || step == 3 || step == 11) {
            LNCTX
            float* z = ROWS + (size_t)(((tlast + 1) & 1) * MPAD) * 2;
            for (int i = bidx() * 512 + tidx(); i < MPAD * 2 / 4; i += G * 512) *(f32x4*)(z + 4 * i) = (f32x4){0.f, 0.f, 0.f, 0.f};
        }
        if (step == 0 || step == 11) {
            LNCTX
            const bf16_t* Wgu = Wl + (step ? OW_GU2 : OW_GU1); const int oc = step ? OC_GU2 : OC_GU1;
            const pg8::LnFix fx{rows_last, CSl + oc, BWl + oc, tlast >= 0 ? 1 : 0};
            pg8::Gemm gm{HB, Wgu, MREAL, 2 * FF, DM}; pg8::StaticOrder S; S.init(MREAL, 2 * FF, G, bidx());
            pg8::EpiSwiglu E{BIG, FF, fx};
            pg8::gemm_phase<pg8::EpiSwiglu, pg8::StaticOrder, true, true>(lds, gm, S, E);
            for (int ct = bidx(); ct < FF / 16; ct += G) {
                TIDV
                const int c0 = 16 * ct, R0 = 256 * (c0 >> 7) + (c0 & 127);
                const f32x4 ag = sg_tile_blk(HB + (size_t)MROW0 * DM, DM, Wgu, DM, R0, lane, wid, (LAS float*)lds), au = sg_tile_blk(HB + (size_t)MROW0 * DM, DM, Wgu, DM, R0 + 128, lane, wid, (LAS float*)lds);
                if (wid == 0) {
                    const int rb = R0 + (lane & 15);
#pragma unroll
                    for (int e = 0; e < 4; ++e) {
                        const size_t row = (size_t)(MROW0 + 4 * (lane >> 4) + e);
                        float gv = ag[e], uv = au[e];
                        if (fx.on) { float mu, r; fx.stats(row, mu, r); gv = (gv - fx.cs[rb] * mu) * r + fx.bw[rb]; uv = (uv - fx.cs[rb + 128] * mu) * r + fx.bw[rb + 128]; }
                        BIG[row * FF + c0 + (lane & 15)] = (bf16_t)f2bf(siluf(gv) * uv);
                    }
                }
            }
        } else if (step == 1 || step == 9 || step == 12) {
            LNCTX
            const bf16_t* A = step == 9 ? MA : BIG; const bf16_t* Bt = Wl + (step == 1 ? OW_D1 : step == 9 ? OW_OUT : OW_D2);
            const int K = step == 9 ? DM : FF; const float sc = step == 9 ? 1.f : 0.5f;
            pg8::Gemm gm{A, Bt, MREAL, DM, K}; pg8::StaticOrder S; S.init(MREAL, DM, G, bidx());
            const int raw = tlast < 0 ? 1 : 0;
            const int gi = step == 1 ? (layer == 0 ? 5 : 26) : step == 9 ? 5 : 21;
            const int gl = step == 1 ? (layer == 0 ? 0 : layer - 1) : layer;
            const float* gam = P.in[gi] + (size_t)gl * DM; const float* bet = P.in[gi + 1] + (size_t)gl * DM;
            float* rows_cur = ROWS + (size_t)(((tlast + 1) & 1) * MPAD) * 2;
            pg8::EpiResid E{P.in[0], (bf16_t*)(P.ws + WS_LO), HB, rows_last, rows_cur, gam, bet, sc, raw};
            pg8::gemm_phase<pg8::EpiResid, pg8::StaticOrder, true, true>(lds, gm, S, E);
            for (int ct = bidx(); ct < 64; ct += G) {
                TIDV
                const f32x4 a = sg_tile_blk(A + (size_t)MROW0 * K, K, Bt, K, 16 * ct, lane, wid, (LAS float*)lds);
                const int col = 16 * ct + (lane & 15);
                if (wid == 0) {
#pragma unroll
                    for (int e = 0; e < 4; ++e) {
                        const int mr = 4 * (lane >> 4) + e; float* p = HFM + (size_t)mr * DM + col;
                        float h = *p;
                        if (!raw) { const float s1 = rows_last[(size_t)(MROW0 + mr) * 2], s2 = rows_last[(size_t)(MROW0 + mr) * 2 + 1], mu = s1 * (1.f / DM), r = __builtin_amdgcn_rsqf(s2 * (1.f / DM) - mu * mu + LN_EPS);
                            h = (h - mu) * r * gam[col] + bet[col]; }
                        const float y = ALPHA * h + sc * a[e];
                        *p = y; HB[(size_t)(MROW0 + mr) * DM + col] = (bf16_t)f2bf(y);
                        float q1 = y, q2 = y * y;
                        q1 += __shfl_xor(q1, 1); q1 += __shfl_xor(q1, 2); q1 += __shfl_xor(q1, 4); q1 += __shfl_xor(q1, 8);
                        q2 += __shfl_xor(q2, 1); q2 += __shfl_xor(q2, 2); q2 += __shfl_xor(q2, 4); q2 += __shfl_xor(q2, 8);
                        if ((lane & 15) == 0) { atomicAdd(rows_cur + (size_t)(MROW0 + mr) * 2, q1); atomicAdd(rows_cur + (size_t)(MROW0 + mr) * 2 + 1, q2); }
                    }
                }
            }
        } else if (step == 13) {
            ln_phase(P, P.in[26] + (size_t)layer * DM, P.in[27] + (size_t)layer * DM, false, true, nullptr, nullptr, lds);
        } else if (step == 3 || step == 7) {
            LNCTX
            const int ng = step == 3 ? 1 : 2;
            float* GT = (float*)(P.ws + WS_GATES); const float* bif = P.in[10] + (size_t)layer * 8;
#pragma unroll 1
            for (int gi = 0; gi < ng; ++gi) {
                const bf16_t* A = step == 3 ? HB : MA + (size_t)gi * MPAD * 512;
                const bf16_t* Bt = Wl + (step == 3 ? OW_PB : gi ? OW_BA : OW_BM);
                const int N = step == 3 ? NPBW : DM, K = step == 3 ? DM : 512, ldc = step == 3 ? NPB : 2048, coff = gi * DM;
                const pg8::LnFix fx{rows_last, CSl + OC_PB, BWl + OC_PB, step == 3 ? 1 : 0};
                pg8::Gemm gm{A, Bt, MREAL, N, K}; pg8::StaticOrder S; S.init(MREAL, N, G, bidx());
                pg8::EpiPlain E{BIG, ldc, coff, step == 3 ? 8 : 0, step == 3 ? 10 : 0, QSCALE, fx, step == 3 ? GT : nullptr, bif};
                pg8::gemm_phase<pg8::EpiPlain, pg8::StaticOrder, true, true>(lds, gm, S, E);
                const int ntile = step == 3 ? NPB / 16 + 1 : N / 16;
                for (int ct = bidx(); ct < ntile; ct += G) {
                    TIDV
                    const f32x4 a = sg_tile_blk(A + (size_t)MROW0 * K, K, Bt, K, 16 * ct, lane, wid, (LAS float*)lds);
                    const float sc = (step == 3 && 16 * ct >= 2048 && 16 * ct < 2560) ? QSCALE : 1.f;
                    if (wid == 0) {
                        const int rb = 16 * ct + (lane & 15);
#pragma unroll
                        for (int e = 0; e < 4; ++e) {
                            const size_t row = (size_t)(MROW0 + 4 * (lane >> 4) + e);
                            float v = a[e];
                            if (fx.on) { float mu, r; fx.stats(row, mu, r); v = (v - fx.cs[rb] * mu) * r + fx.bw[rb]; }
                            if (step == 3 && ct == NPB / 16) {
                                if ((lane & 15) < 8) { const float z = v + bif[lane & 15]; GT[row * 8 + (lane & 15)] = (lane & 15) < 4 ? z : fminf(z, 0.f) - __logf(1.f + __expf(-fabsf(z))); }
                            } else BIG[row * ldc + coff + rb] = (bf16_t)f2bf(v * sc);
                        }
                    }
                }
            }
        } else if (step == 4) {
            {
                float* KM = (float*)(P.ws + WS_KM) + layer * 72;
                TIDV
                const int gw = bidx() * 8 + wid, NGW = G * 8;
#pragma unroll 1
                for (int task = gw; task < 2049; task += NGW) {
                    const int real = task < 2048, slot = real ? task >> 8 : 8, nr = real ? 32 : NMETA;
                    const size_t r0 = real ? (size_t)(task >> 8) * SEQ + (size_t)(task & 255) * 32 : (size_t)MROW0;
                    float mxv = 0.f;
#pragma unroll 4
                    for (int i = 0; i < nr; ++i) {
                        const u32x4 v = *(const u32x4*)(BIG + (r0 + i) * NPB + 2560 + lane * 8);
                        float ss = bflo(v.x) * bflo(v.x) + bfhi(v.x) * bfhi(v.x) + bflo(v.y) * bflo(v.y) + bfhi(v.y) * bfhi(v.y) + bflo(v.z) * bflo(v.z) + bfhi(v.z) * bfhi(v.z) + bflo(v.w) * bflo(v.w) + bfhi(v.w) * bfhi(v.w);
                        ss += __shfl_xor(ss, 1); ss += __shfl_xor(ss, 2); ss += __shfl_xor(ss, 4);
                        mxv = fmaxf(mxv, ss);
                    }
                    if ((lane & 7) == 0) atomicMax((unsigned*)KM + slot * 8 + (lane >> 3), __builtin_bit_cast(unsigned, mxv));
                }
            }
            for (int u = bidx(); u < 2048 + 4; u += G) { const int bh_ = u < 2048 ? u >> 6 : u - 2048, c_ = u < 2048 ? 1 + (u & 63) : 0; m1_unit(P, layer, bh_, c_, lds); }
        } else if (step == 5) {
            m2_phase(P);
        } else if (step == 6) {
            const float lam_init = layer == 0 ? 0.2f : 0.35550906759f;
            float lam;
            {
                TIDV
                const float* l1 = P.in[12] + layer * 64; const float* k1 = P.in[13] + layer * 64; const float* l2 = P.in[14] + layer * 64; const float* k2 = P.in[15] + layer * 64;
                const float s1 = wave_sum(l1[lane] * k1[lane]), s2 = wave_sum(l2[lane] * k2[lane]);
                lam = expf(s1) - expf(s2) + lam_init;
            }
#pragma unroll 1
            for (int rep_ = 0; rep_ < PROBE_ATT; ++rep_)
#pragma unroll 1
            for (int u = bidx(); u < 2048 + 4; u += G) {
                const int cbv = u & 255, i = u >> 8, jj = cbv & 31, j = (i & 4) ? 63 - jj : jj;
                const bool real = u < 2048; const int bh = real ? ((cbv >> 5) * 4 + (i & 3)) : (u - 2048);
                attn_unit(P, layer, bh >> 2, bh & 3, real ? NMETA + 128 * j : 0, real ? 128 : NMETA, lam, lam_init, lds);
            }
#pragma unroll 1
            for (int rep_ = 0; rep_ < PROBE_M3; ++rep_)
#pragma unroll 1
            for (int u = bidx(); u < 2048 + 4; u += G) { const int bh_ = u < 2048 ? u >> 6 : u - 2048, c_ = u < 2048 ? 1 + (u & 63) : 0; m3_unit(P, layer, bh_, c_, lds); }
        } else if (step == 8) {
            const bf16_t* Y = BIG; const float* bg = P.in[19] + (size_t)layer * 2048;
            pg8::Gemm gm{HB, Wl + OW_GM, MREAL, 2048, DM}; pg8::StaticOrder S; S.init(MREAL, 2048, G, bidx());
            LNCTX
            const pg8::LnFix fx{rows_last, CSl + OC_GM, BWl + OC_GM, 1};
            pg8::EpiGate E{MA, Y, bg, fx};
            pg8::gemm_phase<pg8::EpiGate, pg8::StaticOrder, true, true>(lds, gm, S, E);
            for (int ct = bidx(); ct < 64; ct += G) {
                TIDV
                const int c0 = 16 * ct, R0 = 256 * (c0 >> 7) + (c0 & 127);
                const f32x4 am = sg_tile_blk(HB + (size_t)MROW0 * DM, DM, Wl + OW_GM, DM, R0, lane, wid, (LAS float*)lds), aa = sg_tile_blk(HB + (size_t)MROW0 * DM, DM, Wl + OW_GM, DM, R0 + 128, lane, wid, (LAS float*)lds);
                const int col = c0 + (lane & 15), rb = R0 + (lane & 15);
                if (wid == 0) {
#pragma unroll
                    for (int e = 0; e < 4; ++e) {
                        const size_t row = (size_t)(MROW0 + 4 * (lane >> 4) + e);
                        float mu, r; fx.stats(row, mu, r);
                        const float gmv = (am[e] - fx.cs[rb] * mu) * r + fx.bw[rb], gav = (aa[e] - fx.cs[rb + 128] * mu) * r + fx.bw[rb + 128];
                        const float ym = bflo((unsigned)Y[row * 2048 + col]), ya = bflo((unsigned)Y[row * 2048 + DM + col]);
                        MA[row * DM + col] = (bf16_t)f2bf(sigm(gmv) * ym + sigm(gav) * ya);
                    }
                }
            }
        }
        {
            unsigned char* wsb = P.ws; asm volatile("" : "+s"(wsb));
            XcdBarrier xb; xb.bar = (unsigned*)(wsb + WS_BAR); xb.x = xb_xcc_id(); xb.st = (volatile LAS unsigned*)(lds + LDS_BST);
            xcd_barrier(xb);
#ifdef PROBE_SYNC
            for (int i_ = 0; i_ < PROBE_SYNC; ++i_) xcd_barrier(xb);
#endif
        }
    }
}

extern "C" void kernel_launch(void* const* d_in, const int* in_sizes, int n_in, void* d_out, int out_size, void* d_ws, size_t ws_size, hipStream_t stream) {
    static int grid = 0;
    if (grid == 0) {
        if (n_in != 28 || out_size != MREAL * DM || ws_size < WS_END) { fprintf(stderr, "kernel_launch: unexpected shapes (n_in %d out %d ws %zu)\n", n_in, out_size, ws_size); grid = -1; return; }
        int dev = 0, cus = 0, per_cu = 0;
        hipGetDevice(&dev); hipDeviceGetAttribute(&cus, hipDeviceAttributeMultiprocessorCount, dev);
        hipFuncSetAttribute((const void*)hybrid_fwd, hipFuncAttributeMaxDynamicSharedMemorySize, LDS_BYTES);
        hipOccupancyMaxActiveBlocksPerMultiprocessor(&per_cu, (const void*)hybrid_fwd, 512, LDS_BYTES);
        if (per_cu < 1) per_cu = 1;
        grid = cus * per_cu;
        (void)hipGetLastError();
    }
    if (grid < 0) return;
    Params p{};
    for (int i = 0; i < 28; ++i) p.in[i] = (const float*)d_in[i];
    p.out = (float*)d_out; p.ws = (unsigned char*)d_ws;
    void* args[] = {&p};
    hipError_t e = hipLaunchCooperativeKernel((const void*)hybrid_fwd, dim3(grid), dim3(512), args, LDS_BYTES, stream);
    if (e != hipSuccess) fprintf(stderr, "cooperative launch failed: %s (grid %d)\n", hipGetErrorString(e), grid);
}
```

```cpp
#include <hip/hip_runtime.h>
#include <hip/hip_cooperative_groups.h>
#include <cstdio>
#include <cstdint>
namespace cg = cooperative_groups;

__device__ __forceinline__ int tidx() { int t = threadIdx.x; asm volatile("" : "+v"(t)); return t; }
__device__ __forceinline__ int bidx() { int t = blockIdx.x; asm volatile("" : "+s"(t)); return t; }
namespace pg8 {
#define PG8_LAS __attribute__((address_space(3)))
typedef unsigned short bf16_t;
typedef short bf16x8 __attribute__((ext_vector_type(8)));
typedef float f32x4 __attribute__((ext_vector_type(4)));
typedef unsigned u32x4 __attribute__((ext_vector_type(4)));
constexpr int BM = 256, BK = 64, HALF = 128, HTB = HALF * BK * 2  , STAGE_BYTES = 8 * HTB, NXCD = 8, WGM = 8;

__host__ __device__ __forceinline__ int lds_byte(int r, int c) { const int st = (r >> 4) * 2 + (c >> 5), rr = r & 15, cc = c & 31, ob = rr * 64 + cc * 2; return st * 1024 + (ob ^ (((ob >> 9) & 1) << 5)); }
__host__ __device__ __forceinline__ void stage_rc(int b, int& R, int& C) { const int st = b / 1024, sb = b % 1024, swz = sb ^ (((sb >> 9) & 1) << 5); R = (st >> 1) * 16 + swz / 64; C = (st & 1) * 32 + (swz % 64) / 2; }
__host__ __device__ __forceinline__ int perm32(int rho) { const int n = rho >> 4, i = rho & 15; return 8 * (i >> 2) + 4 * n + (i & 3); }

struct Unit { int pm, pn; };
struct Gemm { const bf16_t* A; const bf16_t* Bt; int M, N, K; };

struct StaticOrder {
    int nM, nN, nwg, G, c;
    __host__ __device__ void init(int M, int N, int G_, int c_) { nM = M / BM; nN = N / BM; nwg = nM * nN; G = G_; c = c_; }
    __host__ __device__ bool next(int i, Unit& u) const {
        const long L = (long)i * G + c; if (L >= nwg) return false;
        int wgid = (int)L; { const int q = nwg / NXCD, r = nwg % NXCD, xcd = wgid % NXCD, off = wgid / NXCD; wgid = (xcd < r ? xcd * (q + 1) : r * (q + 1) + (xcd - r) * q) + off; }
        const int nig = WGM * nN, gid = wgid / nig, fm = gid * WGM, gsz = (nM - fm) < WGM ? (nM - fm) : WGM;
        u.pm = fm + ((wgid % nig) % gsz); u.pn = (wgid % nig) / gsz; return true;
    }
    __device__ __forceinline__ void a_ready(const Unit&) const {}
    __device__ __forceinline__ void done(const Unit&) const {}
};

__device__ __forceinline__ unsigned cvt_pk_bf16(float lo, float hi) { unsigned r; asm volatile("v_cvt_pk_bf16_f32 %0, %1, %2" : "=v"(r) : "v"(lo), "v"(hi)); return r; }
typedef float f32x2 __attribute__((ext_vector_type(2)));
__device__ __forceinline__ f32x2 gelu_pk(f32x2 v) {
    const f32x2 av = __builtin_elementwise_abs(v), d = av * 0.2316418882f + 1.0f;
    f32x2 t; t.x = __builtin_amdgcn_rcpf(d.x); t.y = __builtin_amdgcn_rcpf(d.y);
    f32x2 q = t * 0.5307027145f + (-0.7265760135f); q = q * t + 0.7107068705f; q = q * t + (-0.142248368f); q = q * t + 0.127414796f; q = q * t;
    const f32x2 s = (v * v) * (-0.72134752044f);
    f32x2 e; e.x = __builtin_amdgcn_exp2f(s.x); e.y = __builtin_amdgcn_exp2f(s.y);
    const f32x2 m = v * (q * e), r = v - m;
    f32x2 o; o.x = v.x < 0.f ? m.x : r.x; o.y = v.y < 0.f ? m.y : r.y; return o;
}

template <int ACT  > struct EpiBf16 {
    static constexpr bool PERM = true, AFTER_DRAIN = false; static_assert(ACT == 0 || ACT == 1, "EpiBf16: ACT is 0 (none) or 1 (gelu_pk)");
    bf16_t* O; int ldc; const float* bias; int split_cols; size_t split_stride; float scale0;
    __device__ __forceinline__ void operator()(const f32x4 (&acc)[2][2][4][2], const Unit& u, int wr, int wc, int fr, int fq) const {
        const int row0 = u.pm * BM + wr * 64 + fr; int colt = u.pn * BM; bf16_t* base = O;
        float sc = 1.f; if (split_cols) { const int t = colt / split_cols; base += (size_t)t * split_stride; colt -= t * split_cols; if (t == 0) sc = scale0; }
        const int col0 = colt + wc * 32 + 8 * fq, bcol0 = u.pn * BM + wc * 32 + 8 * fq;
        f32x4 bv[2][2];
#pragma unroll
        for (int bj = 0; bj < 2; ++bj)
#pragma unroll
            for (int n = 0; n < 2; ++n) bv[bj][n] = bias ? *(const f32x4*)(bias + bcol0 + bj * HALF + 4 * n) : (f32x4){0.f, 0.f, 0.f, 0.f};
#pragma unroll
        for (int ai = 0; ai < 2; ++ai)
#pragma unroll
            for (int m = 0; m < 4; ++m) { bf16_t* rowp = base + (size_t)(row0 + ai * HALF + m * 16) * ldc + col0;
#pragma unroll
                for (int bj = 0; bj < 2; ++bj) { f32x4 v0 = acc[ai][bj][m][0] + bv[bj][0], v1 = acc[ai][bj][m][1] + bv[bj][1];
                    if (ACT == 1) { f32x2 a = gelu_pk((f32x2){v0[0], v0[1]}), b = gelu_pk((f32x2){v0[2], v0[3]}), c = gelu_pk((f32x2){v1[0], v1[1]}), d = gelu_pk((f32x2){v1[2], v1[3]});
                        v0 = (f32x4){a.x, a.y, b.x, b.y}; v1 = (f32x4){c.x, c.y, d.x, d.y}; }
                    v0 = v0 * sc; v1 = v1 * sc; u32x4 w; w.x = cvt_pk_bf16(v0[0], v0[1]); w.y = cvt_pk_bf16(v0[2], v0[3]); w.z = cvt_pk_bf16(v1[0], v1[1]); w.w = cvt_pk_bf16(v1[2], v1[3]);
                    *(u32x4*)(rowp + bj * HALF) = w; } }
    }
};

struct PanelStats {
    unsigned* xbuf;
    unsigned* cnt;
    unsigned* tmo;
    int ntn; float eps;
    unsigned code;
    __device__ __forceinline__ bool run(const f32x4 (&v)[2][2][4][2], const Unit& u, int wr, int wc, int fr, int fq, PG8_LAS unsigned char* lds, int wid, int lane) const {
        typedef float f32x2v __attribute__((ext_vector_type(2)));
        PG8_LAS f32x2v* P = (PG8_LAS f32x2v*)lds;
        PG8_LAS f32x2v* S = (PG8_LAS f32x2v*)(lds + 8192);
        PG8_LAS unsigned* flag = (PG8_LAS unsigned*)(lds + 8192 + 2048);
#pragma unroll
        for (int ai = 0; ai < 2; ++ai)
#pragma unroll
            for (int m = 0; m < 4; ++m) {
                float s = 0.f;
#pragma unroll
                for (int bj = 0; bj < 2; ++bj)
#pragma unroll
                    for (int n = 0; n < 2; ++n) { const f32x4 x = v[ai][bj][m][n]; s += (x[0] + x[1]) + (x[2] + x[3]); }
                s += __shfl_xor(s, 16); s += __shfl_xor(s, 32);
                const float mw = s * (1.0f / 64.0f); float q = 0.f;
#pragma unroll
                for (int bj = 0; bj < 2; ++bj)
#pragma unroll
                    for (int n = 0; n < 2; ++n) { const f32x4 d = v[ai][bj][m][n] - mw; q += (d[0] * d[0] + d[1] * d[1]) + (d[2] * d[2] + d[3] * d[3]); }
                q += __shfl_xor(q, 16); q += __shfl_xor(q, 32);
                if (fq == 0) P[(ai * HALF + wr * 64 + m * 16 + fr) * 4 + wc] = (f32x2v){mw, q};
            }
        asm volatile("s_waitcnt lgkmcnt(0)" ::: "memory"); __builtin_amdgcn_s_barrier(); asm volatile("" ::: "memory");
#if defined(BROKEN_EXCHANGE_NO_WAIT)
#warning BROKEN CONTROL BUILD: the row-statistics exchange does not wait; results are wrong by design
        if (blockIdx.x >= 64) { const long long t0_ = clock64(); while (clock64() - t0_ < 60000) __builtin_amdgcn_s_sleep(8); }
#endif
        const int row = wid * 32 + (lane & 31);
        if (lane < 32) {
            const f32x2v a = P[row * 4 + 0], b = P[row * 4 + 1], c = P[row * 4 + 2], d = P[row * 4 + 3];
            const float mt = (a.x + b.x + c.x + d.x) * 0.25f;
            const float da = a.x - mt, db = b.x - mt, dc = c.x - mt, dd = d.x - mt;
            const float m2 = (a.y + b.y) + (c.y + d.y) + 64.0f * ((da * da + db * db) + (dc * dc + dd * dd));
            unsigned long long* slot = (unsigned long long*)xbuf + ((size_t)(u.pm * BM + row) * 4 + u.pn);
            __hip_atomic_store(slot, ((unsigned long long)__float_as_uint(m2) << 32) | __float_as_uint(mt), __ATOMIC_RELAXED, __HIP_MEMORY_SCOPE_AGENT);
        }
        asm volatile("s_waitcnt vmcnt(0)" ::: "memory");
        if (lane == 0) __hip_atomic_fetch_add(cnt + 64 * u.pm, 1u, __ATOMIC_RELAXED, __HIP_MEMORY_SCOPE_AGENT);
        if (wid == 0) {
            bool dead = false; const unsigned long long t0 = __builtin_amdgcn_s_memrealtime(); const unsigned want = 8u * (unsigned)ntn;
            for (;;) {
#if defined(BROKEN_EXCHANGE_NO_WAIT)
                break;
#endif
                if ((unsigned)__builtin_amdgcn_readfirstlane(__hip_atomic_load(cnt + 64 * u.pm, __ATOMIC_RELAXED, __HIP_MEMORY_SCOPE_AGENT)) >= want) break;
                if (__builtin_amdgcn_s_memrealtime() - t0 > 2000000ull) {
                    if (lane == 0) { unsigned expect = 0u; __hip_atomic_compare_exchange_strong(tmo + 1, &expect, code | (unsigned)(u.pm & 0xff), __ATOMIC_RELAXED, __ATOMIC_RELAXED, __HIP_MEMORY_SCOPE_AGENT);
                                     __hip_atomic_store(tmo, 1u, __ATOMIC_RELAXED, __HIP_MEMORY_SCOPE_AGENT); }
                    dead = true; break; }
                __builtin_amdgcn_s_sleep(2);
            }
            __builtin_amdgcn_fence(__ATOMIC_ACQUIRE, "agent");
            if (lane == 0) flag[0] = dead ? 1u : 0u;
        }
        asm volatile("s_waitcnt vmcnt(0) lgkmcnt(0)" ::: "memory"); __builtin_amdgcn_s_barrier(); asm volatile("" ::: "memory");
        const bool bad = flag[0] != 0u;
        if (lane < 32) {
            const unsigned long long* slot = (const unsigned long long*)xbuf + (size_t)(u.pm * BM + row) * 4; float mt[4], m2[4]; float ms = 0.f;
#pragma unroll
            for (int t = 0; t < 4; ++t) { if (t < ntn) { const unsigned long long w = __hip_atomic_load(slot + t, __ATOMIC_RELAXED, __HIP_MEMORY_SCOPE_AGENT); mt[t] = __uint_as_float((unsigned)w); m2[t] = __uint_as_float((unsigned)(w >> 32)); } else { mt[t] = 0.f; m2[t] = 0.f; } ms += mt[t]; }
            const float mean = ms / (float)ntn; float q = 0.f;
#pragma unroll
            for (int t = 0; t < 4; ++t) if (t < ntn) { const float dm = mt[t] - mean; q += m2[t] + 256.0f * dm * dm; }
            S[row] = (f32x2v){mean, 1.0f / sqrtf(q / (256.0f * (float)ntn) + eps)};
        }
        asm volatile("s_waitcnt lgkmcnt(0)" ::: "memory"); __builtin_amdgcn_s_barrier(); asm volatile("" ::: "memory");
        return bad;
    }
};
struct EpiLnRes {
    static constexpr bool PERM = false, AFTER_DRAIN = true;
    const float* base; float* out; int ldc; const float* bias; PanelStats st; unsigned poison;
    __device__ __forceinline__ void fused(f32x4 (&acc)[2][2][4][2], const Unit& u, int wr, int wc, int fr, int fq, PG8_LAS unsigned char* lds, int wid, int lane) const {
        typedef float f32x2v __attribute__((ext_vector_type(2)));
        const PG8_LAS f32x2v* S = (const PG8_LAS f32x2v*)(lds + 8192);
        const int col0 = u.pn * BM + wc * 32 + 4 * fq;
#pragma unroll
        for (int bj = 0; bj < 2; ++bj)
#pragma unroll
            for (int n = 0; n < 2; ++n) { const f32x4 bv = bias ? *(const f32x4*)(bias + col0 + bj * HALF + n * 16) : (f32x4){0.f, 0.f, 0.f, 0.f};
#pragma unroll
                for (int ai = 0; ai < 2; ++ai)
#pragma unroll
                    for (int m = 0; m < 4; ++m) acc[ai][bj][m][n] += bv; }
        f32x4 pre[4][2][2];
#pragma unroll
        for (int m = 0; m < 4; ++m) { const size_t off = (size_t)(u.pm * BM + wr * 64 + m * 16 + fr) * ldc + col0;
#pragma unroll
            for (int bj = 0; bj < 2; ++bj)
#pragma unroll
                for (int n = 0; n < 2; ++n) pre[m][bj][n] = *(const f32x4*)(base + off + bj * HALF + n * 16); }
        const bool bad = st.run(acc, u, wr, wc, fr, fq, lds, wid, lane) || poison != 0u;
        const float qnan = __builtin_nanf("");
#pragma unroll
        for (int ai = 0; ai < 2; ++ai)
#pragma unroll
            for (int m = 0; m < 4; ++m) { const int r = ai * HALF + wr * 64 + m * 16 + fr; const f32x2v sr = S[r]; const size_t off = (size_t)(u.pm * BM + r) * ldc + col0;
#pragma unroll
                for (int bj = 0; bj < 2; ++bj)
#pragma unroll
                    for (int n = 0; n < 2; ++n) { const f32x4 bs = ai == 0 ? pre[m][bj][n] : *(const f32x4*)(base + off + bj * HALF + n * 16); f32x4 o = bs + (acc[ai][bj][m][n] - sr.x) * sr.y;
                        if (bad) o = (f32x4){qnan, qnan, qnan, qnan}; *(f32x4*)(out + off + bj * HALF + n * 16) = o; }
                if (m & 1) asm volatile("" ::: "memory"); }
    }
};
struct EpiLnResLn {
    static constexpr bool PERM = false, AFTER_DRAIN = true;
    const float* base; float* out; bf16_t* xn; int ldc; const float* bias; PanelStats st1, st2; unsigned poison;
    __device__ __forceinline__ void fused(f32x4 (&acc)[2][2][4][2], const Unit& u, int wr, int wc, int fr, int fq, PG8_LAS unsigned char* lds, int wid, int lane) const {
        typedef float f32x2v __attribute__((ext_vector_type(2))); typedef unsigned u32x2v __attribute__((ext_vector_type(2)));
        const PG8_LAS f32x2v* S = (const PG8_LAS f32x2v*)(lds + 8192);
        const int col0 = u.pn * BM + wc * 32 + 4 * fq;
#pragma unroll
        for (int bj = 0; bj < 2; ++bj)
#pragma unroll
            for (int n = 0; n < 2; ++n) { const f32x4 bv = bias ? *(const f32x4*)(bias + col0 + bj * HALF + n * 16) : (f32x4){0.f, 0.f, 0.f, 0.f};
#pragma unroll
                for (int ai = 0; ai < 2; ++ai)
#pragma unroll
                    for (int m = 0; m < 4; ++m) acc[ai][bj][m][n] += bv; }
        bool bad = st1.run(acc, u, wr, wc, fr, fq, lds, wid, lane) || poison != 0u;
        const float qnan = __builtin_nanf("");
#pragma unroll
        for (int ai = 0; ai < 2; ++ai)
#pragma unroll
            for (int m = 0; m < 4; ++m) { const int r = ai * HALF + wr * 64 + m * 16 + fr; const f32x2v sr = S[r]; const size_t off = (size_t)(u.pm * BM + r) * ldc + col0;
#pragma unroll
                for (int bj = 0; bj < 2; ++bj)
#pragma unroll
                    for (int n = 0; n < 2; ++n) { const f32x4 bs = *(const f32x4*)(base + off + bj * HALF + n * 16); acc[ai][bj][m][n] = bs + (acc[ai][bj][m][n] - sr.x) * sr.y; }
                asm volatile("" : "+v"(acc[ai][0][m][0]), "+v"(acc[ai][0][m][1]), "+v"(acc[ai][1][m][0]), "+v"(acc[ai][1][m][1]));
                if (m & 1) asm volatile("" ::: "memory"); }
        const bool bad1 = bad;
        bad = st2.run(acc, u, wr, wc, fr, fq, lds, wid, lane) || bad;
#pragma unroll
        for (int ai = 0; ai < 2; ++ai)
#pragma unroll
            for (int m = 0; m < 4; ++m) { const int r = ai * HALF + wr * 64 + m * 16 + fr; const f32x2v sr = S[r]; const size_t off = (size_t)(u.pm * BM + r) * ldc + col0;
#pragma unroll
                for (int bj = 0; bj < 2; ++bj)
#pragma unroll
                    for (int n = 0; n < 2; ++n) { const f32x4 x1 = acc[ai][bj][m][n]; *(f32x4*)(out + off + bj * HALF + n * 16) = bad1 ? (f32x4){qnan, qnan, qnan, qnan} : x1;
                        const f32x4 o = (x1 - sr.x) * sr.y; u32x2v w; w.x = cvt_pk_bf16(o[0], o[1]); w.y = cvt_pk_bf16(o[2], o[3]);
                        if (bad) { w.x = 0x7fc07fc0u; w.y = 0x7fc07fc0u; } *(u32x2v*)(xn + off + bj * HALF + n * 16) = w; }
                asm volatile("" ::: "memory"); }
    }
};

template <class Epi, class Sched, bool ALIGN_EPI = false, bool SP2 = false>
__device__ __forceinline__ void gemm_phase(PG8_LAS unsigned char* lds, const Gemm g, const Sched& S, const Epi& E) {
    const int tid = tidx(), wid = __builtin_amdgcn_readfirstlane(tid >> 6), lane = tid & 63, wr = wid >> 2, wc = wid & 3, fr = lane & 15, fq = lane >> 4;
    const int K = g.K, nt = K / BK;
    unsigned voffA[2], voffB[2];
#pragma unroll
    for (int i = 0; i < 2; ++i) { int R, C; stage_rc(tid * 16 + i * 8192, R, C); const int Rb = Epi::PERM ? ((R & ~31) + perm32(R & 31)) : R;
        voffA[i] = (unsigned)(R * K + C) * 2u; voffB[i] = (unsigned)(Rb * K + C) * 2u; }
    const size_t kstep = (size_t)(BK * 2);
    const size_t hstep = (size_t)HALF * K * 2;
    const size_t tstep = 2 * hstep;
    const unsigned ldsw = (unsigned)wid * 1024u;
    const int aoff = lds_byte(wr * 64 + fr, fq * 8), boff = lds_byte(wc * 32 + fr, fq * 8);
#define PG8_SA(b, h) (((b) * 2 + (h)) * HTB)
#define PG8_SB(b, h) ((4 + (b) * 2 + (h)) * HTB)
#define PG8_STAGE(bufoff, gbase, voff) do { _Pragma("unroll") for (int _i = 0; _i < 2; ++_i) \
        __builtin_amdgcn_global_load_lds((const unsigned*)((const char*)(gbase) + (voff)[_i]), (PG8_LAS unsigned*)(lds + (bufoff) + ldsw + _i * 8192), 16, 0, 0); } while (0)
#define PG8_LDA(dst, b, h) do { _Pragma("unroll") for (int m = 0; m < 4; ++m) _Pragma("unroll") for (int k = 0; k < 2; ++k) dst[m][k] = *(const PG8_LAS bf16x8*)(lds + PG8_SA(b, h) + aoff + m * 2048 + k * 1024); } while (0)
#define PG8_LDB(dst, b, h) do { _Pragma("unroll") for (int n = 0; n < 2; ++n) _Pragma("unroll") for (int k = 0; k < 2; ++k) dst[n][k] = *(const PG8_LAS bf16x8*)(lds + PG8_SB(b, h) + boff + n * 2048 + k * 1024); } while (0)
#define PG8_MMA(ai, bj, At, Bt) do { __builtin_amdgcn_s_setprio(1); _Pragma("unroll") for (int m = 0; m < 4; ++m) _Pragma("unroll") for (int n = 0; n < 2; ++n) _Pragma("unroll") for (int k = 0; k < 2; ++k) \
        acc[ai][bj][m][n] = __builtin_amdgcn_mfma_f32_16x16x32_bf16(Bt[n][k], At[m][k], acc[ai][bj][m][n], 0, 0, 0); __builtin_amdgcn_s_setprio(0); } while (0)
#define PG8_WAIT_V(n) asm volatile("s_waitcnt vmcnt(" #n ")" ::: "memory")
#define PG8_WAIT_L(n) asm volatile("s_waitcnt lgkmcnt(" #n ")" ::: "memory")
#define PG8_BAR __builtin_amdgcn_s_barrier()
#define PG8_SCHED __builtin_amdgcn_sched_barrier(0)
    Unit cur, nxt; int ui = 0;
    if (!S.next(0, cur)) return;
    E.prefetch(cur, tid, lds + 135168);
    f32x4 acc[2][2][4][2];
#pragma unroll
    for (int a = 0; a < 2; ++a)
#pragma unroll
        for (int b = 0; b < 2; ++b)
#pragma unroll
            for (int m = 0; m < 4; ++m)
#pragma unroll
                for (int n = 0; n < 2; ++n) acc[a][b][m][n] = (f32x4){0.f, 0.f, 0.f, 0.f};
    bf16x8 At[4][2], B0[2][2], B1[2][2];
    const char* cA = (const char*)g.A + (size_t)cur.pm * tstep; const char* cB = (const char*)g.Bt + (size_t)cur.pn * tstep;
    S.a_ready(cur);
    if constexpr (SP2) {
        PG8_STAGE(PG8_SB(0, 0), cB, voffB); PG8_STAGE(PG8_SB(0, 1), cB + hstep, voffB); PG8_STAGE(PG8_SA(0, 0), cA, voffA); PG8_STAGE(PG8_SA(0, 1), cA + hstep, voffA);
        if (wr == 1) PG8_BAR;
        PG8_WAIT_V(2); PG8_BAR;
        PG8_STAGE(PG8_SB(1, 0), cB + kstep, voffB); PG8_STAGE(PG8_SA(1, 0), cA + kstep, voffA); PG8_STAGE(PG8_SB(1, 1), cB + hstep + kstep, voffB);
        PG8_WAIT_V(6); PG8_BAR;
    } else {
        PG8_STAGE(PG8_SB(0, 0), cB, voffB); PG8_STAGE(PG8_SA(0, 0), cA, voffA); PG8_STAGE(PG8_SB(0, 1), cB + hstep, voffB); PG8_STAGE(PG8_SA(0, 1), cA + hstep, voffA);
        if (wr == 1) PG8_BAR;
        PG8_WAIT_V(4); PG8_BAR;
        PG8_STAGE(PG8_SB(1, 0), cB + kstep, voffB); PG8_STAGE(PG8_SA(1, 0), cA + kstep, voffA); PG8_STAGE(PG8_SB(1, 1), cB + hstep + kstep, voffB);
        PG8_WAIT_V(6); PG8_BAR;
    }
    for (;;) {
        const bool has_next = S.next(ui + 1, nxt);
        const char* nA = has_next ? (const char*)g.A + (size_t)nxt.pm * tstep : cA; const char* nB = has_next ? (const char*)g.Bt + (size_t)nxt.pn * tstep : cB;
        for (int t = 0; t < nt; t += 2) {
            const bool last = (t == nt - 2);
            const char* a1 = cA + (size_t)(t + 1) * kstep;
            const char* a2 = last ? nA : cA + (size_t)(t + 2) * kstep; const char* b2 = last ? nB : cB + (size_t)(t + 2) * kstep;
            const char* a3 = a2 + kstep; const char* b3 = b2 + kstep;
            if (last && has_next) S.a_ready(nxt);
            if constexpr (SP2) {
            PG8_LDB(B0, 0, 0); PG8_LDB(B1, 0, 1); PG8_SCHED; PG8_LDA(At, 0, 0); PG8_STAGE(PG8_SA(1, 1), a1 + hstep, voffA);
            PG8_WAIT_V(8); PG8_WAIT_L(0); PG8_BAR; PG8_MMA(0, 0, At, B0); PG8_MMA(0, 1, At, B1); PG8_BAR; PG8_SCHED;
            PG8_LDA(At, 0, 1); PG8_STAGE(PG8_SB(0, 0), b2, voffB); PG8_STAGE(PG8_SB(0, 1), b2 + hstep, voffB); PG8_STAGE(PG8_SA(0, 0), a2, voffA);
            PG8_WAIT_V(8); PG8_WAIT_L(0); PG8_BAR; PG8_MMA(1, 0, At, B0); PG8_MMA(1, 1, At, B1); PG8_BAR; PG8_SCHED;
            PG8_LDB(B0, 1, 0); PG8_LDB(B1, 1, 1); PG8_SCHED; PG8_LDA(At, 1, 0); PG8_STAGE(PG8_SA(0, 1), a2 + hstep, voffA);
            PG8_WAIT_V(8); PG8_WAIT_L(0); PG8_BAR; PG8_MMA(0, 0, At, B0); PG8_MMA(0, 1, At, B1); PG8_BAR; PG8_SCHED;
            PG8_LDA(At, 1, 1); PG8_STAGE(PG8_SB(1, 0), b3, voffB); PG8_STAGE(PG8_SB(1, 1), b3 + hstep, voffB); PG8_STAGE(PG8_SA(1, 0), a3, voffA);
            PG8_WAIT_V(8); PG8_WAIT_L(0); PG8_BAR; PG8_MMA(1, 0, At, B0); PG8_MMA(1, 1, At, B1); PG8_BAR; PG8_SCHED;
            } else {
            PG8_LDB(B0, 0, 0); PG8_SCHED; PG8_LDA(At, 0, 0); PG8_STAGE(PG8_SA(1, 1), a1 + hstep, voffA);
            PG8_WAIT_L(8); PG8_BAR; PG8_WAIT_L(0); PG8_MMA(0, 0, At, B0); PG8_BAR; PG8_SCHED;
            PG8_LDB(B1, 0, 1); PG8_STAGE(PG8_SB(0, 0), b2, voffB);
            PG8_BAR; PG8_WAIT_L(0); PG8_MMA(0, 1, At, B1); PG8_BAR;
            PG8_LDA(At, 0, 1); PG8_STAGE(PG8_SA(0, 0), a2, voffA);
            PG8_BAR; PG8_WAIT_L(0); PG8_MMA(1, 0, At, B0); PG8_BAR; PG8_SCHED;
            PG8_STAGE(PG8_SB(0, 1), b2 + hstep, voffB);
            PG8_WAIT_V(6); PG8_BAR; PG8_MMA(1, 1, At, B1); PG8_BAR;
            PG8_LDB(B0, 1, 0); PG8_SCHED; PG8_LDA(At, 1, 0); PG8_STAGE(PG8_SA(0, 1), a2 + hstep, voffA);
            PG8_WAIT_L(8); PG8_BAR; PG8_WAIT_L(0); PG8_MMA(0, 0, At, B0); PG8_BAR; PG8_SCHED;
            PG8_LDB(B1, 1, 1); PG8_STAGE(PG8_SB(1, 0), b3, voffB);
            PG8_BAR; PG8_WAIT_L(0); PG8_MMA(0, 1, At, B1); PG8_BAR;
            PG8_LDA(At, 1, 1); PG8_STAGE(PG8_SA(1, 0), a3, voffA);
            PG8_BAR; PG8_WAIT_L(0); PG8_MMA(1, 0, At, B0); PG8_BAR; PG8_SCHED;
            PG8_STAGE(PG8_SB(1, 1), b3 + hstep, voffB);
            PG8_WAIT_V(6); PG8_BAR; PG8_MMA(1, 1, At, B1); PG8_BAR;
            }
        }
        if constexpr (ALIGN_EPI) { if (wr == 0) PG8_BAR; }
        if constexpr (!Epi::AFTER_DRAIN) { E(acc, cur, wr, wc, fr, fq, lds + 135168 + (ui & 1) * 4096); if (has_next) E.prefetch(nxt, tid, lds + 135168 + ((ui + 1) & 1) * 4096); S.done(cur); }
        if (!has_next) break;
#pragma unroll
        for (int a = 0; a < 2; ++a)
#pragma unroll
            for (int b = 0; b < 2; ++b)
#pragma unroll
                for (int m = 0; m < 4; ++m)
#pragma unroll
                    for (int n = 0; n < 2; ++n) acc[a][b][m][n] = (f32x4){0.f, 0.f, 0.f, 0.f};
        cur = nxt; cA = nA; cB = nB; ++ui;
        if constexpr (ALIGN_EPI) { if (wr == 1) PG8_BAR; }
    }
    PG8_WAIT_V(0);
    if constexpr (!ALIGN_EPI) { if (wr == 0) PG8_BAR; }
    PG8_BAR;
    if constexpr (Epi::AFTER_DRAIN) { E.fused(acc, cur, wr, wc, fr, fq, lds, wid, lane); S.done(cur); }
#undef PG8_SA
#undef PG8_SB
#undef PG8_STAGE
#undef PG8_LDA
#undef PG8_LDB
#undef PG8_MMA
#undef PG8_WAIT_V
#undef PG8_WAIT_L
#undef PG8_BAR
#undef PG8_SCHED
}
}

#define LAS __attribute__((address_space(3)))
typedef unsigned short bf16_t;
typedef short bf16x8 __attribute__((ext_vector_type(8)));
typedef short s16x4 __attribute__((ext_vector_type(4)));
typedef short v4i16_t __attribute__((ext_vector_type(4)));
typedef float f32x4 __attribute__((ext_vector_type(4)));
typedef float f32x16 __attribute__((ext_vector_type(16)));
typedef unsigned u32x4 __attribute__((ext_vector_type(4)));
typedef unsigned u32x2 __attribute__((ext_vector_type(2)));

constexpr int DM = 1024, NB = 8, SEQ = 8192, NMETA = 16, LSEQ = SEQ + NMETA, MREAL = NB * SEQ, MROW0 = MREAL, MPAD = MREAL + 256;
constexpr int FF = 2816, NPB = 3584, NPBW = 3840, DPROJ = 5640;
constexpr int NCH = 65;
constexpr float ALPHA = 1.41421356237f;
constexpr float LOG2E = 1.4426950408889634f;
constexpr float QSCALE = 0.125f * LOG2E;
constexpr float NEGF = -1e30f;
constexpr float LN_EPS = 1e-5f;

constexpr size_t OW_GU1 = 0, OW_D1 = 5767168, OW_PB = 8650752, OW_GM = 12582912, OW_BM = 14680064, OW_BA = 15204352, OW_OUT = 15728640, OW_GU2 = 16777216, OW_D2 = 22544384, OW_LAYER = 25427968;
constexpr int OC_GU1 = 0, OC_PB = 5632, OC_GM = 9472, OC_GU2 = 11520, OC_N = 17152;
constexpr size_t MiB = 1u << 20;
constexpr size_t WS_ROWS = 0;
constexpr size_t WS_CSBW = 4 * MiB;
constexpr size_t WS_HFM = 5 * MiB;
constexpr size_t WS_GATES = 6 * MiB;
constexpr size_t WS_BAR = 9 * MiB;
constexpr size_t WS_KM = WS_BAR + 16384;
constexpr size_t WS_SC = 10 * MiB;
constexpr size_t WS_NST = 11 * MiB;
constexpr size_t WS_STATS = 13 * MiB;
constexpr size_t WS_W = 16 * MiB;
constexpr size_t WS_HB = 113 * MiB;
constexpr size_t WS_LO = 242 * MiB;
constexpr size_t WS_CST = 371 * MiB;
constexpr size_t WS_MA = 436 * MiB;
constexpr size_t WS_BIG = 565 * MiB;
constexpr size_t WS_END = 1015 * MiB;

struct Params {
    const float* in[28];
    float* out; unsigned char* ws;
};

__device__ __forceinline__ unsigned f2bf(float f) { unsigned u = __builtin_bit_cast(unsigned, f); return (u + 0x7fffu + ((u >> 16) & 1u)) >> 16; }
typedef float f32x2_t __attribute__((ext_vector_type(2))); typedef __bf16 bf16x2_t __attribute__((ext_vector_type(2)));
__device__ __forceinline__ unsigned pk2(float lo, float hi) { f32x2_t v = {lo, hi}; bf16x2_t b = __builtin_convertvector(v, bf16x2_t); return __builtin_bit_cast(unsigned, b); }
__device__ __forceinline__ u32x4 pack8(f32x4 a, f32x4 b) { u32x4 w; w.x = pk2(a[0], a[1]); w.y = pk2(a[2], a[3]); w.z = pk2(b[0], b[1]); w.w = pk2(b[2], b[3]); return w; }
__device__ __forceinline__ float bflo(unsigned w) { return __builtin_bit_cast(float, w << 16); }
__device__ __forceinline__ float bfhi(unsigned w) { return __builtin_bit_cast(float, w & 0xffff0000u); }
__device__ __forceinline__ float ex2(float x) { return __builtin_amdgcn_exp2f(x); }
__device__ __forceinline__ float sigm(float x) { return __builtin_amdgcn_rcpf(1.f + ex2(-x * LOG2E)); }
__device__ __forceinline__ float siluf(float x) { return x * sigm(x); }
__device__ __forceinline__ float wave_sum(float v) {
#pragma unroll
    for (int o = 1; o < 64; o <<= 1) v += __shfl_xor(v, o);
    return v;
}
__device__ __forceinline__ float wave_max(float v) {
#pragma unroll
    for (int o = 1; o < 64; o <<= 1) v = fmaxf(v, __shfl_xor(v, o));
    return v;
}
__device__ __forceinline__ size_t seqrow(int b, int pos) { return pos < NMETA ? (size_t)(MROW0 + pos) : (size_t)b * SEQ + (size_t)(pos - NMETA); }
__device__ __forceinline__ f32x16 mfma32(bf16x8 a, bf16x8 b, f32x16 c) { return __builtin_amdgcn_mfma_f32_32x32x16_bf16(a, b, c, 0, 0, 0); }
__device__ __forceinline__ s16x4 vtr(const LAS unsigned char* p) { return __builtin_bit_cast(s16x4, __builtin_amdgcn_ds_read_tr16_b64_v4i16((LAS v4i16_t*)p)); }
__device__ __forceinline__ bf16x8 cat8(s16x4 lo, s16x4 hi) { return (bf16x8){lo[0], lo[1], lo[2], lo[3], hi[0], hi[1], hi[2], hi[3]}; }

namespace pg8 {
__device__ __forceinline__ void tab_prefetch(const float* rows, const float* v0, const float* v1, int pm, int cbase, int tid, PG8_LAS unsigned char* tab) {
    const int wid = __builtin_amdgcn_readfirstlane(tid >> 6), lane = tid & 63;
    if (rows) __builtin_amdgcn_global_load_lds((const unsigned*)(rows + (size_t)pm * 512 + tid), (PG8_LAS unsigned*)(tab + wid * 256), 4, 0, 0);
    const float* src = (wid < 4 ? v0 + (wid * 64 + lane) : v1 + ((wid - 4) * 64 + lane)) + cbase;
    __builtin_amdgcn_global_load_lds((const unsigned*)src, (PG8_LAS unsigned*)(tab + 2048 + wid * 256), 4, 0, 0);
}
__device__ __forceinline__ void tab_ready() { asm volatile("s_waitcnt vmcnt(14)" ::: "memory"); __builtin_amdgcn_s_barrier(); asm volatile("" ::: "memory"); }
__device__ __forceinline__ void tab_stats(const PG8_LAS unsigned char* tab, int rloc, float& mu, float& r) {
    const f32x2_t st = *(const PG8_LAS f32x2_t*)(tab + rloc * 8); mu = st.x * (1.f / DM); r = __builtin_amdgcn_rsqf(st.y * (1.f / DM) - mu * mu + LN_EPS);
}
struct LnFix {
    const float* rows; const float* cs; const float* bw; int on;
    __device__ __forceinline__ void stats(size_t row, float& mu, float& r) const {
        const f32x2_t st = *(const f32x2_t*)(rows + row * 2); mu = st.x * (1.f / DM); r = __builtin_amdgcn_rsqf(st.y * (1.f / DM) - mu * mu + LN_EPS);
    }
};
struct EpiSwiglu {
    static constexpr bool PERM = true, AFTER_DRAIN = false;
    bf16_t* O; int ldc; LnFix fx;
    __device__ __forceinline__ void prefetch(const Unit& u, int tid, PG8_LAS unsigned char* tab) const { if (fx.on) tab_prefetch(fx.rows, fx.cs, fx.bw, u.pm, u.pn * BM, tid, tab); }
    __device__ __forceinline__ void operator()(const f32x4 (&acc)[2][2][4][2], const Unit& u, int wr, int wc, int fr, int fq, const PG8_LAS unsigned char* tab) const {
        const int row0 = u.pm * BM + wr * 64 + fr, col0 = u.pn * 128 + wc * 32 + 8 * fq, cl = wc * 32 + 8 * fq;
        if (fx.on) tab_ready();
#pragma unroll
        for (int ai = 0; ai < 2; ++ai)
#pragma unroll
            for (int m = 0; m < 4; ++m) {
                const size_t row = (size_t)(row0 + ai * HALF + m * 16);
                float mu = 0.f, r = 1.f; if (fx.on) tab_stats(tab, wr * 64 + fr + ai * HALF + m * 16, mu, r);
                u32x4 w;
#pragma unroll
                for (int n = 0; n < 2; ++n) {
                    f32x4 csg = {0.f, 0.f, 0.f, 0.f}, bwg = csg, csu = csg, bwu = csg;
                    if (fx.on) { csg = *(const PG8_LAS f32x4*)(tab + 2048 + (cl + 4 * n) * 4); bwg = *(const PG8_LAS f32x4*)(tab + 3072 + (cl + 4 * n) * 4); csu = *(const PG8_LAS f32x4*)(tab + 2048 + (cl + HALF + 4 * n) * 4); bwu = *(const PG8_LAS f32x4*)(tab + 3072 + (cl + HALF + 4 * n) * 4); }
                    const f32x4 g = (acc[ai][0][m][n] - csg * mu) * r + bwg, up = (acc[ai][1][m][n] - csu * mu) * r + bwu;
                    const unsigned lo = pk2(siluf(g[0]) * up[0], siluf(g[1]) * up[1]), hi = pk2(siluf(g[2]) * up[2], siluf(g[3]) * up[3]);
                    if (n == 0) { w.x = lo; w.y = hi; } else { w.z = lo; w.w = hi; }
                }
                *(u32x4*)(O + row * ldc + col0) = w;
            }
    }
};
struct EpiPlain {
    static constexpr bool PERM = true, AFTER_DRAIN = false;
    bf16_t* O; int ldc; int coff; int slo, shi; float scale; LnFix fx; float* GT; const float* bif;
    __device__ __forceinline__ void prefetch(const Unit& u, int tid, PG8_LAS unsigned char* tab) const { if (fx.on) tab_prefetch(fx.rows, fx.cs, fx.bw, u.pm, u.pn * BM, tid, tab); }
    __device__ __forceinline__ void operator()(const f32x4 (&acc)[2][2][4][2], const Unit& u, int wr, int wc, int fr, int fq, const PG8_LAS unsigned char* tab) const {
        const int row0 = u.pm * BM + wr * 64 + fr, col0 = coff + u.pn * BM + wc * 32 + 8 * fq, cl = wc * 32 + 8 * fq;
        if (fx.on) tab_ready();
        if (GT && u.pn == 14) {
            if (wc == 0 && fq == 0) {
                const f32x4 cs0 = *(const PG8_LAS f32x4*)(tab + 2048 + cl * 4), cs1 = *(const PG8_LAS f32x4*)(tab + 2048 + (cl + 4) * 4);
                const f32x4 bw0 = *(const PG8_LAS f32x4*)(tab + 3072 + cl * 4) + *(const f32x4*)(bif), bw1 = *(const PG8_LAS f32x4*)(tab + 3072 + (cl + 4) * 4) + *(const f32x4*)(bif + 4);
#pragma unroll
                for (int ai = 0; ai < 2; ++ai)
#pragma unroll
                    for (int m = 0; m < 4; ++m) {
                        const size_t row = (size_t)(row0 + ai * HALF + m * 16);
                        float mu, r; tab_stats(tab, wr * 64 + fr + ai * HALF + m * 16, mu, r);
                        const f32x4 li = (acc[ai][0][m][0] - cs0 * mu) * r + bw0, z = (acc[ai][0][m][1] - cs1 * mu) * r + bw1;
                        f32x4 lf;
#pragma unroll
                        for (int e = 0; e < 4; ++e) lf[e] = fminf(z[e], 0.f) - __logf(1.f + __expf(-fabsf(z[e])));
                        *(f32x4*)(GT + row * 8) = li; *(f32x4*)(GT + row * 8 + 4) = lf;
                    }
            }
            return;
        }
        const float sc = (u.pn >= slo && u.pn < shi) ? scale : 1.f;
#pragma unroll
        for (int ai = 0; ai < 2; ++ai)
#pragma unroll
            for (int m = 0; m < 4; ++m) {
                const size_t row = (size_t)(row0 + ai * HALF + m * 16);
                float mu = 0.f, r = 1.f; if (fx.on) tab_stats(tab, wr * 64 + fr + ai * HALF + m * 16, mu, r);
#pragma unroll
                for (int bj = 0; bj < 2; ++bj) {
                    u32x4 w;
#pragma unroll
                    for (int n = 0; n < 2; ++n) {
                        f32x4 cs4 = {0.f, 0.f, 0.f, 0.f}, bw4 = cs4;
                        if (fx.on) { cs4 = *(const PG8_LAS f32x4*)(tab + 2048 + (cl + bj * HALF + 4 * n) * 4); bw4 = *(const PG8_LAS f32x4*)(tab + 3072 + (cl + bj * HALF + 4 * n) * 4); }
                        const f32x4 v = ((acc[ai][bj][m][n] - cs4 * mu) * r + bw4) * sc;
                        if (n == 0) { w.x = pk2(v[0], v[1]); w.y = pk2(v[2], v[3]); } else { w.z = pk2(v[0], v[1]); w.w = pk2(v[2], v[3]); }
                    }
                    *(u32x4*)(O + row * ldc + col0 + bj * HALF) = w;
                }
            }
    }
};
struct EpiResid {
    static constexpr bool PERM = true, AFTER_DRAIN = false;
    const float* src; bf16_t* LO; bf16_t* HB; const float* rows_prev; float* rows_cur; const float* gam; const float* bet; float s; int raw;
    __device__ __forceinline__ void prefetch(const Unit& u, int tid, PG8_LAS unsigned char* tab) const { if (!raw) tab_prefetch(rows_prev, gam, bet, u.pm, u.pn * BM, tid, tab); }
    __device__ __forceinline__ void operator()(const f32x4 (&acc)[2][2][4][2], const Unit& u, int wr, int wc, int fr, int fq, const PG8_LAS unsigned char* tab) const {
        const int row0 = u.pm * BM + wr * 64 + fr, col0 = u.pn * BM + wc * 32 + 8 * fq, cl = wc * 32 + 8 * fq;
        if (!raw) tab_ready();
#pragma unroll
        for (int ai = 0; ai < 2; ++ai)
#pragma unroll
            for (int m = 0; m < 4; ++m) {
                const size_t row = (size_t)(row0 + ai * HALF + m * 16);
                float mu = 0.f, rs = 1.f;
                if (!raw) tab_stats(tab, wr * 64 + fr + ai * HALF + m * 16, mu, rs);
                const float ar = ALPHA * rs, am = -ALPHA * rs * mu;
                float s1 = 0.f, s2 = 0.f;
#pragma unroll
                for (int bj = 0; bj < 2; ++bj) {
                    f32x4 g0 = {1.f, 1.f, 1.f, 1.f}, g1 = g0, b0 = {0.f, 0.f, 0.f, 0.f}, b1 = b0;
                    if (!raw) { g0 = *(const PG8_LAS f32x4*)(tab + 2048 + (cl + bj * HALF) * 4); g1 = *(const PG8_LAS f32x4*)(tab + 2048 + (cl + bj * HALF + 4) * 4); b0 = *(const PG8_LAS f32x4*)(tab + 3072 + (cl + bj * HALF) * 4); b1 = *(const PG8_LAS f32x4*)(tab + 3072 + (cl + bj * HALF + 4) * 4); }
                    f32x4 x0, x1;
                    if (raw) { x0 = *(const f32x4*)(src + row * DM + col0 + bj * HALF); x1 = *(const f32x4*)(src + row * DM + col0 + bj * HALF + 4); }
                    else { const u32x4 hi = *(const u32x4*)(HB + row * DM + col0 + bj * HALF), lo = *(const u32x4*)(LO + row * DM + col0 + bj * HALF);
                        x0 = (f32x4){bflo(hi.x) + bflo(lo.x), bfhi(hi.x) + bfhi(lo.x), bflo(hi.y) + bflo(lo.y), bfhi(hi.y) + bfhi(lo.y)};
                        x1 = (f32x4){bflo(hi.z) + bflo(lo.z), bfhi(hi.z) + bfhi(lo.z), bflo(hi.w) + bflo(lo.w), bfhi(hi.w) + bfhi(lo.w)}; }
                    const f32x4 o0 = (x0 * ar + am) * g0 + b0 * ALPHA + acc[ai][bj][m][0] * s, o1 = (x1 * ar + am) * g1 + b1 * ALPHA + acc[ai][bj][m][1] * s;
                    const u32x4 nh = pack8(o0, o1);
                    const f32x4 d0 = {o0[0] - bflo(nh.x), o0[1] - bfhi(nh.x), o0[2] - bflo(nh.y), o0[3] - bfhi(nh.y)}, d1 = {o1[0] - bflo(nh.z), o1[1] - bfhi(nh.z), o1[2] - bflo(nh.w), o1[3] - bfhi(nh.w)};
                    *(u32x4*)(HB + row * DM + col0 + bj * HALF) = nh; *(u32x4*)(LO + row * DM + col0 + bj * HALF) = pack8(d0, d1);
                    s1 += ((o0[0] + o0[1]) + (o0[2] + o0[3])) + ((o1[0] + o1[1]) + (o1[2] + o1[3]));
                    s2 += ((o0[0] * o0[0] + o0[1] * o0[1]) + (o0[2] * o0[2] + o0[3] * o0[3])) + ((o1[0] * o1[0] + o1[1] * o1[1]) + (o1[2] * o1[2] + o1[3] * o1[3]));
                }
                s1 += __shfl_xor(s1, 16); s1 += __shfl_xor(s1, 32); s2 += __shfl_xor(s2, 16); s2 += __shfl_xor(s2, 32);
                if (fq == 0) { float* rp = rows_cur + row * 2; atomicAdd(rp, s1); atomicAdd(rp + 1, s2); }
                asm volatile("" ::: "memory");
            }
    }
};
struct EpiGate {
    static constexpr bool PERM = true, AFTER_DRAIN = false;
    bf16_t* U; const bf16_t* Y; const float* bg; LnFix fx;
    __device__ __forceinline__ void prefetch(const Unit& u, int tid, PG8_LAS unsigned char* tab) const { tab_prefetch(fx.rows, fx.cs, fx.bw, u.pm, u.pn * BM, tid, tab); }
    __device__ __forceinline__ void operator()(const f32x4 (&acc)[2][2][4][2], const Unit& u, int wr, int wc, int fr, int fq, const PG8_LAS unsigned char* tab) const {
        const int row0 = u.pm * BM + wr * 64 + fr, col0 = u.pn * 128 + wc * 32 + 8 * fq, cl = wc * 32 + 8 * fq;
        tab_ready();
#pragma unroll
        for (int ai = 0; ai < 2; ++ai)
#pragma unroll
            for (int m = 0; m < 4; ++m) {
                const size_t row = (size_t)(row0 + ai * HALF + m * 16);
                float mu, r; tab_stats(tab, wr * 64 + fr + ai * HALF + m * 16, mu, r);
                const u32x4 ym = *(const u32x4*)(Y + row * 2048 + col0), ya = *(const u32x4*)(Y + row * 2048 + DM + col0);
                u32x4 w;
#pragma unroll
                for (int n = 0; n < 2; ++n) {
                    const f32x4 csm = *(const PG8_LAS f32x4*)(tab + 2048 + (cl + 4 * n) * 4), bm = *(const PG8_LAS f32x4*)(tab + 3072 + (cl + 4 * n) * 4);
                    const f32x4 csa = *(const PG8_LAS f32x4*)(tab + 2048 + (cl + HALF + 4 * n) * 4), ba = *(const PG8_LAS f32x4*)(tab + 3072 + (cl + HALF + 4 * n) * 4);
                    const f32x4 gm = (acc[ai][0][m][n] - csm * mu) * r + bm, ga = (acc[ai][1][m][n] - csa * mu) * r + ba;
                    const unsigned y0 = n ? ym.z : ym.x, y1 = n ? ym.w : ym.y, a0 = n ? ya.z : ya.x, a1 = n ? ya.w : ya.y;
                    const unsigned lo = pk2(sigm(gm[0]) * bflo(y0) + sigm(ga[0]) * bflo(a0), sigm(gm[1]) * bfhi(y0) + sigm(ga[1]) * bfhi(a0));
                    const unsigned hi = pk2(sigm(gm[2]) * bflo(y1) + sigm(ga[2]) * bflo(a1), sigm(gm[3]) * bfhi(y1) + sigm(ga[3]) * bfhi(a1));
                    if (n == 0) { w.x = lo; w.y = hi; } else { w.z = lo; w.w = hi; }
                }
                *(u32x4*)(U + row * DM + col0) = w;
            }
    }
};
}

__device__ __forceinline__ f32x4 sg_tile(const bf16_t* A, int lda, const bf16_t* Bt, int K, int n0, int lane) {
    const bf16_t* ap = A + (size_t)(lane & 15) * lda + 8 * (lane >> 4);
    const bf16_t* bp = Bt + (size_t)(n0 + (lane & 15)) * K + 8 * (lane >> 4);
    f32x4 acc = {0.f, 0.f, 0.f, 0.f};
#pragma unroll 8
    for (int k = 0; k < K; k += 32) {
        const bf16x8 a = *(const bf16x8*)(ap + k), b = *(const bf16x8*)(bp + k);
        acc = __builtin_amdgcn_mfma_f32_16x16x32_bf16(a, b, acc, 0, 0, 0);
    }
    return acc;
}

__device__ __forceinline__ f32x4 sg_tile_blk(const bf16_t* A, int lda, const bf16_t* Bt, int K, int n0, int lane, int wid, LAS float* red) {
    const int K8 = K >> 3;
    const bf16_t* ap = A + (size_t)(lane & 15) * lda + 8 * (lane >> 4) + wid * K8;
    const bf16_t* bp = Bt + (size_t)(n0 + (lane & 15)) * K + 8 * (lane >> 4) + wid * K8;
    f32x4 acc = {0.f, 0.f, 0.f, 0.f};
#pragma unroll 1
    for (int k = 0; k < K8; k += 128) {
        bf16x8 av[4], bv[4];
#pragma unroll
        for (int j = 0; j < 4; ++j) { const int kk = k + 32 * j < K8 ? k + 32 * j : k; av[j] = *(const bf16x8*)(ap + kk); bv[j] = *(const bf16x8*)(bp + kk); }
        asm volatile("" : "+v"(av[0]), "+v"(av[1]), "+v"(av[2]), "+v"(av[3]), "+v"(bv[0]), "+v"(bv[1]), "+v"(bv[2]), "+v"(bv[3]));
#pragma unroll
        for (int j = 0; j < 4; ++j) if (k + 32 * j < K8) acc = __builtin_amdgcn_mfma_f32_16x16x32_bf16(av[j], bv[j], acc, 0, 0, 0);
    }
    *(LAS f32x4*)(red + wid * 256 + lane * 4) = acc;
    __syncthreads();
    f32x4 sum = {0.f, 0.f, 0.f, 0.f};
    if (wid == 0) {
#pragma unroll
        for (int w = 0; w < 8; ++w) sum = sum + *(const LAS f32x4*)(red + w * 256 + lane * 4);
    }
    __syncthreads();
    return sum;
}

__device__ __forceinline__ void tr_rows(const float* Wsrc, int ldw, int K, bf16_t* dst, int kb0, int nkb, int nv4, const float* g, const float* bb, float* cs, float* bw, LAS float* scr, int lane, const float* addb = nullptr) {
    float csp[4] = {0.f, 0.f, 0.f, 0.f}, bwp[4] = {0.f, 0.f, 0.f, 0.f};
    const int c = lane & 7;
#pragma unroll 1
    for (int kb = kb0; kb < kb0 + nkb; ++kb) {
        const int k0 = 64 * kb;
        f32x4 vv[8];
        const bool okl = (lane & 7) < nv4; const int n4 = (lane & 7) * 4;
#pragma unroll
        for (int i = 0; i < 8; ++i) vv[i] = *(const f32x4*)(Wsrc + (size_t)(k0 + 8 * i + (lane >> 3)) * ldw + (okl ? n4 : 0));
        asm volatile("" : "+v"(vv[0]), "+v"(vv[1]), "+v"(vv[2]), "+v"(vv[3]), "+v"(vv[4]), "+v"(vv[5]), "+v"(vv[6]), "+v"(vv[7]));
#pragma unroll
        for (int i = 0; i < 8; ++i) { const int kk = 8 * i + (lane >> 3); f32x4 v = vv[i]; if (!okl) v = (f32x4){0.f, 0.f, 0.f, 0.f};
            scr[kk * 33 + n4] = v[0]; scr[kk * 33 + n4 + 1] = v[1]; scr[kk * 33 + n4 + 2] = v[2]; scr[kk * 33 + n4 + 3] = v[3]; }
        f32x4 g0 = {1.f, 1.f, 1.f, 1.f}, g1 = g0, b0 = {0.f, 0.f, 0.f, 0.f}, b1 = b0;
        if (g) { g0 = *(const f32x4*)(g + k0 + 8 * c); g1 = *(const f32x4*)(g + k0 + 8 * c + 4); b0 = *(const f32x4*)(bb + k0 + 8 * c); b1 = *(const f32x4*)(bb + k0 + 8 * c + 4); }
        asm volatile("s_waitcnt lgkmcnt(0)" ::: "memory");
#pragma unroll
        for (int j = 0; j < 4; ++j) {
            const int n = (lane >> 3) + 8 * j; const LAS float* sp = scr + (8 * c) * 33 + n;
            const float x0 = sp[0 * 33], x1 = sp[1 * 33], x2 = sp[2 * 33], x3 = sp[3 * 33], x4 = sp[4 * 33], x5 = sp[5 * 33], x6 = sp[6 * 33], x7 = sp[7 * 33];
            u32x4 o; o.x = pk2(x0 * g0[0], x1 * g0[1]); o.y = pk2(x2 * g0[2], x3 * g0[3]); o.z = pk2(x4 * g1[0], x5 * g1[1]); o.w = pk2(x6 * g1[2], x7 * g1[3]);
            *(u32x4*)(dst + (size_t)n * K + k0 + 8 * c) = o;
            csp[j] += ((bflo(o.x) + bfhi(o.x)) + (bflo(o.y) + bfhi(o.y))) + ((bflo(o.z) + bfhi(o.z)) + (bflo(o.w) + bfhi(o.w)));
            bwp[j] += ((x0 * b0[0] + x1 * b0[1]) + (x2 * b0[2] + x3 * b0[3])) + ((x4 * b1[0] + x5 * b1[1]) + (x6 * b1[2] + x7 * b1[3]));
        }
        asm volatile("s_waitcnt lgkmcnt(0)" ::: "memory");
    }
    if (g) {
#pragma unroll
        for (int j = 0; j < 4; ++j) {
            float a = csp[j], b = bwp[j];
            a += __shfl_xor(a, 1); a += __shfl_xor(a, 2); a += __shfl_xor(a, 4); b += __shfl_xor(b, 1); b += __shfl_xor(b, 2); b += __shfl_xor(b, 4);
            if (c == 0) { cs[(lane >> 3) + 8 * j] = a; bw[(lane >> 3) + 8 * j] = b + (addb ? addb[(lane >> 3) + 8 * j] : 0.f); }
        }
    }
}
constexpr int CW_ITEMS = 824;
__device__ __forceinline__ void conv_weight_item(const Params& P, int layer, int it, LAS float* scr, int lane) {
    bf16_t* W = (bf16_t*)(P.ws + WS_W) + (size_t)layer * OW_LAYER;
    float* CS = (float*)(P.ws + WS_CSBW) + (size_t)layer * 2 * OC_N; float* BW = CS + OC_N;
    const float* wg1 = P.in[2] + (size_t)layer * DM * FF; const float* wu1 = P.in[3] + (size_t)layer * DM * FF; const float* wd1 = P.in[4] + (size_t)layer * FF * DM;
    const float* win = P.in[7] + (size_t)layer * DM * DPROJ;
    const float* wbm = P.in[17] + (size_t)layer * 512 * DM; const float* wba = P.in[18] + (size_t)layer * 512 * DM; const float* wout = P.in[20] + (size_t)layer * DM * DM;
    const float* wg2 = P.in[23] + (size_t)layer * DM * FF; const float* wu2 = P.in[24] + (size_t)layer * DM * FF; const float* wd2 = P.in[25] + (size_t)layer * FF * DM;
    const float* ln1g = P.in[5] + (size_t)layer * DM; const float* ln1b = P.in[6] + (size_t)layer * DM;
    const float* ln2g = P.in[21] + (size_t)layer * DM; const float* ln2b = P.in[22] + (size_t)layer * DM;
    const float* ln3g = layer ? P.in[26] + (size_t)(layer - 1) * DM : nullptr; const float* ln3b = layer ? P.in[27] + (size_t)(layer - 1) * DM : nullptr;
    int r = it;
    if (r < 352) {
        const int second = r >= 176; if (second) r -= 176;
        const int R0 = 32 * r, pn = R0 >> 8, sgu = (R0 >> 7) & 1, i = R0 & 127;
        const float* src = (second ? (sgu ? wu2 : wg2) : (sgu ? wu1 : wg1)) + 128 * pn + i;
        const int oc = second ? OC_GU2 : OC_GU1;
        tr_rows(src, FF, DM, W + (second ? OW_GU2 : OW_GU1) + (size_t)R0 * DM, 0, 16, 8, second ? ln2g : ln3g, second ? ln2b : ln3b, CS + oc + R0, BW + oc + R0, scr, lane); return;
    }
    r -= 352;
    if (r < 192) {
        const int second = r >= 96; if (second) r -= 96;
        const int nb = r / 3, seg = r % 3, R0 = 32 * nb;
        tr_rows((second ? wd2 : wd1) + R0, DM, FF, W + (second ? OW_D2 : OW_D1) + (size_t)R0 * FF, 16 * seg, seg == 2 ? 12 : 16, 8, nullptr, nullptr, nullptr, nullptr, scr, lane); return;
    }
    r -= 192;
    if (r < 120) {
        const int R0 = 32 * r, csrc = R0 < 2048 ? R0 : (R0 < 3584 ? R0 + 8 : 2048);
        tr_rows(win + csrc, DPROJ, DM, W + OW_PB + (size_t)R0 * DM, 0, 16, R0 < 3584 ? 8 : (R0 == 3584 ? 2 : 0), ln1g, ln1b, CS + OC_PB + R0, BW + OC_PB + R0, scr, lane); return;
    }
    r -= 120;
    if (r < 64) {
        const int R0 = 32 * r, pn = R0 >> 8, sg = (R0 >> 7) & 1, i = R0 & 127, csrc = 3592 + 1024 * sg + 128 * pn + i;
        tr_rows(win + csrc, DPROJ, DM, W + OW_GM + (size_t)R0 * DM, 0, 16, 8, ln1g, ln1b, CS + OC_GM + R0, BW + OC_GM + R0, scr, lane, P.in[19] + (size_t)layer * 2048 + 1024 * sg + 128 * pn + i); return;
    }
    r -= 64;
    if (r < 64) {
        const int second = r >= 32; if (second) r -= 32;
        const int R0 = 32 * r;
        tr_rows((second ? wba : wbm) + R0, DM, 512, W + (second ? OW_BA : OW_BM) + (size_t)R0 * 512, 0, 8, 8, nullptr, nullptr, nullptr, nullptr, scr, lane); return;
    }
    r -= 64;
    { const int R0 = 32 * r; tr_rows(wout + R0, DM, DM, W + OW_OUT + (size_t)R0 * DM, 0, 16, 8, nullptr, nullptr, nullptr, nullptr, scr, lane); }
}

__device__ __forceinline__ void ln_row(const f32x4 (&vin)[4], int row, float* hf, const f32x4 (&gv)[4], const f32x4 (&bv)[4], bool gates, bool fin, const float* bif_l, LAS float* gwl, bf16_t* HB, float* ST, float* GT, int lane) {
    f32x4 v[4]; float s = 0.f;
#pragma unroll
    for (int j = 0; j < 4; ++j) { v[j] = vin[j]; s += (v[j][0] + v[j][1]) + (v[j][2] + v[j][3]); }
    const float mean = wave_sum(s) * (1.f / DM); float s2 = 0.f;
#pragma unroll
    for (int j = 0; j < 4; ++j) { v[j] = v[j] - mean; s2 += (v[j][0] * v[j][0] + v[j][1] * v[j][1]) + (v[j][2] * v[j][2] + v[j][3] * v[j][3]); }
    const float rstd = 1.f / sqrtf(wave_sum(s2) * (1.f / DM) + LN_EPS);
    if (lane == 0) { f32x2_t st = {mean, rstd}; *(f32x2_t*)(ST + (size_t)row * 2) = st; }
#pragma unroll
    for (int j = 0; j < 4; ++j) {
        v[j] = v[j] * rstd * gv[j] + bv[j];
        if (fin) *(f32x4*)(hf + 256 * j + 4 * lane) = v[j];
        if (!fin) { u32x2 w; w.x = pk2(v[j][0], v[j][1]); w.y = pk2(v[j][2], v[j][3]); *(u32x2*)(HB + (size_t)row * DM + 256 * j + 4 * lane) = w; }
    }
    if (gates) {
        float mine = 0.f;
#pragma unroll
        for (int g = 0; g < 8; ++g) {
            float d = 0.f;
#pragma unroll
            for (int j = 0; j < 4; ++j) { const f32x4 w4 = *(const LAS f32x4*)(gwl + g * 1024 + 256 * j + 4 * lane); d += (v[j][0] * w4[0] + v[j][1] * w4[1]) + (v[j][2] * w4[2] + v[j][3] * w4[3]); }
            d = wave_sum(d);
            if (lane == g) mine = d;
        }
        if (lane < 8) {
            const float z = mine + bif_l[lane];
            float o = z;
            if (lane >= 4) o = fminf(z, 0.f) - __logf(1.f + __expf(-fabsf(z)));
            GT[(size_t)row * 8 + lane] = o;
        }
    }
}
__device__ __forceinline__ void ln_phase(const Params& P, const float* gam, const float* bet, bool gates, bool fin, const float* win_l, const float* bif_l, LAS unsigned char* lds) {
    const int tid = tidx(), lane = tid & 63, wid = tid >> 6;
    float* hfm = (float*)(P.ws + WS_HFM); bf16_t* HB = (bf16_t*)(P.ws + WS_HB); float* GT = (float*)(P.ws + WS_GATES); float* ST = (float*)(P.ws + WS_STATS);
    LAS float* gwl = (LAS float*)lds;
    if (gates) {
        for (int idx = tid; idx < 8192; idx += 512) { const int k = idx >> 3, g = idx & 7; gwl[g * 1024 + k] = win_l[(size_t)k * DPROJ + 2048 + g]; }
        __syncthreads();
    }
    const int gw = bidx() * 8 + wid, NGW = gridDim.x * 8;
    f32x4 gv[4], bv[4];
#pragma unroll
    for (int j = 0; j < 4; ++j) { gv[j] = *(const f32x4*)(gam + 256 * j + 4 * lane); bv[j] = *(const f32x4*)(bet + 256 * j + 4 * lane); }
    constexpr int NR = MREAL;
    int row = 4 * gw;
    u32x2 ah[4][4], al[4][4];
#define LN_ROWP(r_) (P.out + (size_t)(r_) * DM)
    const bf16_t* LOp = (const bf16_t*)(P.ws + WS_LO);
#define LN_LOADRAW(h_, l_, r_, j_) do { h_ = *(const u32x2*)(HB + (size_t)(r_) * DM + 256 * (j_) + 4 * lane); l_ = *(const u32x2*)(LOp + (size_t)(r_) * DM + 256 * (j_) + 4 * lane); } while (0)
#define LN_COMB(dst_, hi_, lo_) dst_ = (f32x4){bflo(hi_.x) + bflo(lo_.x), bfhi(hi_.x) + bfhi(lo_.x), bflo(hi_.y) + bflo(lo_.y), bfhi(hi_.y) + bfhi(lo_.y)}
    if (row < NR) {
#pragma unroll
        for (int q4 = 0; q4 < 4; ++q4) {
#pragma unroll
            for (int j = 0; j < 4; ++j) LN_LOADRAW(ah[q4][j], al[q4][j], row + q4, j); }
    }
    while (row < NR) {
        f32x4 ca[4][4];
#pragma unroll
        for (int q4 = 0; q4 < 4; ++q4)
#pragma unroll
            for (int j = 0; j < 4; ++j) LN_COMB(ca[q4][j], ah[q4][j], al[q4][j]);
        const int nrow = row + 4 * NGW;
        if (nrow < NR) {
#pragma unroll
            for (int q4 = 0; q4 < 4; ++q4) {
#pragma unroll
                for (int j = 0; j < 4; ++j) LN_LOADRAW(ah[q4][j], al[q4][j], nrow + q4, j); }
        }
#pragma unroll
        for (int q4 = 0; q4 < 4; ++q4) ln_row(ca[q4], row + q4, LN_ROWP(row + q4), gv, bv, gates, fin, bif_l, gwl, HB, ST, GT, lane);
        row = nrow;
    }
#undef LN_ROWP
#undef LN_LOADRAW
#undef LN_COMB
}

__device__ __forceinline__ void conv8(const bf16_t* PB, const float* cw, const float* cb, int b, int pos, int chn, f32x4& o0, f32x4& o1) {
    o0 = *(const f32x4*)(cb + chn); o1 = *(const f32x4*)(cb + chn + 4);
#pragma unroll
    for (int j = 0; j < 4; ++j) {
        const int pp = pos - 3 + j;
        if (pp >= 0) {
            const u32x4 u = *(const u32x4*)(PB + seqrow(b, pp) * NPB + chn);
            const f32x4 w0 = *(const f32x4*)(cw + j * 1024 + chn), w1 = *(const f32x4*)(cw + j * 1024 + chn + 4);
            o0[0] += w0[0] * bflo(u.x); o0[1] += w0[1] * bfhi(u.x); o0[2] += w0[2] * bflo(u.y); o0[3] += w0[3] * bfhi(u.y);
            o1[0] += w1[0] * bflo(u.z); o1[1] += w1[1] * bfhi(u.z); o1[2] += w1[2] * bflo(u.w); o1[3] += w1[3] * bfhi(u.w);
        }
    }
#pragma unroll
    for (int e = 0; e < 4; ++e) { o0[e] = siluf(o0[e]); o1[e] = siluf(o1[e]); }
}
struct ConvW { f32x4 w[4][2]; f32x4 b[2]; };
__device__ __forceinline__ void convw_load(ConvW& cw8, const float* cw, const float* cb, int chn) {
    cw8.b[0] = *(const f32x4*)(cb + chn); cw8.b[1] = *(const f32x4*)(cb + chn + 4);
#pragma unroll
    for (int j = 0; j < 4; ++j) { cw8.w[j][0] = *(const f32x4*)(cw + j * 1024 + chn); cw8.w[j][1] = *(const f32x4*)(cw + j * 1024 + chn + 4); }
}
__device__ __forceinline__ void conv8w(const bf16_t* PB, const ConvW& cw8, int b, int pos, int chn, f32x4& o0, f32x4& o1) {
    o0 = cw8.b[0]; o1 = cw8.b[1];
    u32x4 u4[4];
#pragma unroll
    for (int j = 0; j < 4; ++j) {
        const int pp = pos - 3 + j;
        u4[j] = *(const u32x4*)(PB + seqrow(b, pp < 0 ? 0 : pp) * NPB + chn);
    }
#pragma unroll
    for (int j = 0; j < 4; ++j) {
        const bool ok = pos - 3 + j >= 0;
        const u32x4 u = {ok ? u4[j].x : 0u, ok ? u4[j].y : 0u, ok ? u4[j].z : 0u, ok ? u4[j].w : 0u};
        const f32x4 w0 = cw8.w[j][0], w1 = cw8.w[j][1];
        o0[0] += w0[0] * bflo(u.x); o0[1] += w0[1] * bfhi(u.x); o0[2] += w0[2] * bflo(u.y); o0[3] += w0[3] * bfhi(u.y);
        o1[0] += w1[0] * bflo(u.z); o1[1] += w1[1] * bfhi(u.z); o1[2] += w1[2] * bflo(u.w); o1[3] += w1[3] * bfhi(u.w);
    }
#pragma unroll
    for (int e = 0; e < 4; ++e) { o0[e] = siluf(o0[e]); o1[e] = siluf(o1[e]); }
}

__device__ __forceinline__ float wscan_add(float v, int lane) {
#pragma unroll
    for (int o = 1; o < 64; o <<= 1) { const float t = __shfl_up(v, o); if (lane >= o) v += t; }
    return v;
}
__device__ __forceinline__ float wscan_max(float v, int lane) {
#pragma unroll
    for (int o = 1; o < 64; o <<= 1) { const float t = __shfl_up(v, o); if (lane >= o) v = fmaxf(v, t); }
    return v;
}

__device__ __forceinline__ void lds_barrier() { asm volatile("s_waitcnt lgkmcnt(0)\n\ts_barrier" ::: "memory"); }

constexpr int TSTR = 320;
constexpr int RSTR = 272;
__device__ __forceinline__ void m1_unit(const Params& P, int layer, int bh, int c, LAS unsigned char* lds) {
    const int tid = tidx(), lane = tid & 63, wid = __builtin_amdgcn_readfirstlane(tid >> 6);
    const int b = bh >> 2, hh = bh & 3;
    const int nvalid = c == 0 ? NMETA : 128, p0 = c == 0 ? 0 : NMETA + 128 * (c - 1);
    const int nrep = c == 0 ? NB : 1;
    const bf16_t* PB = (const bf16_t*)(P.ws + WS_BIG); const float* GT = (const float*)(P.ws + WS_GATES);
    float* SC = (float*)(P.ws + WS_SC); float* NST = (float*)(P.ws + WS_NST); bf16_t* CST = (bf16_t*)(P.ws + WS_CST);
    const float* cw = P.in[8] + (size_t)layer * 4 * 1024; const float* cb = P.in[9] + (size_t)layer * 1024;
    LAS unsigned char* Kt = lds; LAS unsigned char* Vt = lds + 128 * TSTR; LAS float* sws = (LAS float*)(lds + 2 * 128 * TSTR);
    if (wid == 0) {
        const int i0 = 2 * lane, i1 = i0 + 1;
        float li0, li1, lf0, lf1;
        { const size_t rw0 = seqrow(b, p0 + (i0 < nvalid ? i0 : 0)), rw1 = seqrow(b, p0 + (i1 < nvalid ? i1 : 0));
          li0 = GT[rw0 * 8 + hh]; lf0 = GT[rw0 * 8 + 4 + hh]; li1 = GT[rw1 * 8 + hh]; lf1 = GT[rw1 * 8 + 4 + hh];
          if (i0 >= nvalid) { li0 = NEGF; lf0 = 0.f; } if (i1 >= nvalid) { li1 = NEGF; lf1 = 0.f; } }
        const float s = lf0 + lf1, incl = wscan_add(s, lane), excl = incl - s;
        const float b0 = excl + lf0, b1 = incl, g0 = li0 - b0, g1 = li1 - b1;
        const float gmax = wave_max(fmaxf(g0, g1));
        sws[i0] = i0 < nvalid ? ex2((g0 - gmax) * LOG2E) : 0.f;
        sws[i1] = i1 < nvalid ? ex2((g1 - gmax) * LOG2E) : 0.f;
        const float bend = __shfl(incl, 63);
        if (lane == 0) { for (int bb = 0; bb < nrep; ++bb) { SC[(size_t)((bh + 4 * bb) * NCH + c) * 2] = bend; SC[(size_t)((bh + 4 * bb) * NCH + c) * 2 + 1] = bend + gmax; } }
    }
    __syncthreads();
    ConvW ckw; convw_load(ckw, cw, cb, 512 + hh * 128 + 8 * (tid & 15));
#pragma unroll 2
    for (int it = 0; it < 4; ++it) {
        const int item = tid + 512 * it, i = item >> 4, ch = item & 15;
        u32x4 kw, vw;
        {
            const int ic = i < nvalid ? i : nvalid - 1;
            f32x4 o0, o1; conv8w(PB, ckw, b, p0 + ic, 512 + hh * 128 + 8 * ch, o0, o1);
            const float sc = 0.08838834764831845f * sws[i];
            kw = pack8(o0 * sc, o1 * sc);
            vw = *(const u32x4*)(PB + seqrow(b, p0 + ic) * NPB + 1024 + hh * 128 + 8 * ch);
            if (i >= nvalid) { kw = (u32x4){0u, 0u, 0u, 0u}; vw = kw; }
        }
        *(LAS u32x4*)(Kt + i * TSTR + ch * 16) = kw; *(LAS u32x4*)(Vt + i * TSTR + ch * 16) = vw;
    }
    __syncthreads();
    {
        const int h = lane >> 5, g = lane >> 4, q = (lane & 15) >> 2, pp = lane & 3;
        const int dkt = wid >> 1, dvt0 = (wid & 1) * 2;
        f32x16 acc[2];
#pragma unroll
        for (int t = 0; t < 2; ++t)
#pragma unroll
            for (int e = 0; e < 16; ++e) acc[t][e] = 0.f;
#pragma unroll
        for (int ks = 0; ks < 8; ++ks) {
            const int rowa = 16 * ks + 8 * h + q;
            const LAS unsigned char* ka = Kt + rowa * TSTR + (32 * dkt + 16 * (g & 1) + 4 * pp) * 2;
            const bf16x8 af = cat8(vtr(ka), vtr(ka + 4 * TSTR));
#pragma unroll
            for (int t = 0; t < 2; ++t) {
                const LAS unsigned char* va = Vt + rowa * TSTR + (32 * (dvt0 + t) + 16 * (g & 1) + 4 * pp) * 2;
                const bf16x8 bf = cat8(vtr(va), vtr(va + 4 * TSTR));
                acc[t] = mfma32(af, bf, acc[t]);
            }
        }
#pragma unroll
        for (int t = 0; t < 2; ++t) {
            const int dv = 32 * (dvt0 + t) + (lane & 31);
#pragma unroll
            for (int r4 = 0; r4 < 4; ++r4) {
                const int dk0 = 32 * dkt + 8 * r4 + 4 * h;
                u32x2 w; w.x = pk2(acc[t][4 * r4], acc[t][4 * r4 + 1]); w.y = pk2(acc[t][4 * r4 + 2], acc[t][4 * r4 + 3]);
                for (int bb = 0; bb < nrep; ++bb) *(u32x2*)(CST + (size_t)((bh + 4 * bb) * NCH + c) * 16384 + (size_t)dv * 128 + dk0) = w;
            }
        }
    }
    {
        LAS float* red = sws + 256;
        const int dk = tid & 127, part = tid >> 7;
        float sacc = 0.f;
#pragma unroll 8
        for (int i = 0; i < 32; ++i) sacc += __builtin_bit_cast(float, (unsigned)(*(const LAS unsigned short*)(Kt + (32 * part + i) * TSTR + dk * 2)) << 16);
        red[part * 128 + dk] = sacc;
        __syncthreads();
        if (tid < 128) { const float nsum = (red[tid] + red[128 + tid]) + (red[256 + tid] + red[384 + tid]); for (int bb = 0; bb < nrep; ++bb) NST[(size_t)((bh + 4 * bb) * NCH + c) * 128 + tid] = nsum; }
    }
    lds_barrier();
}

__device__ __forceinline__ void m2_phase(const Params& P) {
    float* SC = (float*)(P.ws + WS_SC); float* MST = SC + 32 * NCH * 2; float* NST = (float*)(P.ws + WS_NST); bf16_t* CST = (bf16_t*)(P.ws + WS_CST);
    const int NT = gridDim.x * 512;
    for (int task = bidx() * 512 + tidx(); task < 65536 + 4096; task += NT) {
        if (task < 65536) {
            const int bh = task >> 11, e8 = task & 2047;
            bf16_t* ptr = CST + (size_t)bh * NCH * 16384 + (size_t)e8 * 8;
            float run[8];
#pragma unroll
            for (int e = 0; e < 8; ++e) run[e] = 0.f;
            float m = NEGF;
#pragma unroll 1
            for (int c0 = 0; c0 < NCH; c0 += 5) {
                u32x4 loc[5]; float bendv[5], mlocv[5];
#pragma unroll
                for (int j = 0; j < 5; ++j) { loc[j] = *(const u32x4*)(ptr + (size_t)(c0 + j) * 16384); bendv[j] = SC[(size_t)(bh * NCH + c0 + j) * 2]; mlocv[j] = SC[(size_t)(bh * NCH + c0 + j) * 2 + 1]; }
#pragma unroll
                for (int j = 0; j < 5; ++j) {
                    const int c = c0 + j;
                    const float bend = bendv[j], mloc = mlocv[j];
                    const float mn = fmaxf(bend + m, mloc), a = ex2((bend + m - mn) * LOG2E), bt = ex2((mloc - mn) * LOG2E);
                    u32x4 w; w.x = pk2(run[0], run[1]); w.y = pk2(run[2], run[3]); w.z = pk2(run[4], run[5]); w.w = pk2(run[6], run[7]);
                    *(u32x4*)(ptr + (size_t)c * 16384) = w;
                    run[0] = a * run[0] + bt * bflo(loc[j].x); run[1] = a * run[1] + bt * bfhi(loc[j].x);
                    run[2] = a * run[2] + bt * bflo(loc[j].y); run[3] = a * run[3] + bt * bfhi(loc[j].y);
                    run[4] = a * run[4] + bt * bflo(loc[j].z); run[5] = a * run[5] + bt * bfhi(loc[j].z);
                    run[6] = a * run[6] + bt * bflo(loc[j].w); run[7] = a * run[7] + bt * bfhi(loc[j].w);
                    if (e8 == 0) MST[bh * NCH + c] = m;
                    m = mn;
                }
            }
        } else {
            const int t2 = task - 65536, bh = t2 >> 7, dk = t2 & 127;
            float* ptr = NST + (size_t)bh * NCH * 128 + dk;
            float run = 0.f, m = NEGF;
#pragma unroll 1
            for (int c0 = 0; c0 < NCH; c0 += 13) {
                float locv[13], bendv[13], mlocv[13];
#pragma unroll
                for (int j = 0; j < 13; ++j) { locv[j] = ptr[(size_t)(c0 + j) * 128]; bendv[j] = SC[(size_t)(bh * NCH + c0 + j) * 2]; mlocv[j] = SC[(size_t)(bh * NCH + c0 + j) * 2 + 1]; }
#pragma unroll
                for (int j = 0; j < 13; ++j) {
                    const float mn = fmaxf(bendv[j] + m, mlocv[j]), a = ex2((bendv[j] + m - mn) * LOG2E), bt = ex2((mlocv[j] - mn) * LOG2E);
                    ptr[(size_t)(c0 + j) * 128] = run; run = a * run + bt * locv[j]; m = mn;
                }
            }
        }
    }
}

__device__ __forceinline__ void m3_unit(const Params& P, int layer, int bh, int c, LAS unsigned char* lds) {
    const int tid = tidx(), lane = tid & 63, wid = __builtin_amdgcn_readfirstlane(tid >> 6);
    const int b = bh >> 2, hh = bh & 3;
    const int nvalid = c == 0 ? NMETA : 128, p0 = c == 0 ? 0 : NMETA + 128 * (c - 1);
    const bf16_t* PB = (const bf16_t*)(P.ws + WS_BIG); const float* GT = (const float*)(P.ws + WS_GATES);
    const float* SC = (const float*)(P.ws + WS_SC); const float* MST = SC + 32 * NCH * 2; const float* NST = (const float*)(P.ws + WS_NST); const bf16_t* CST = (const bf16_t*)(P.ws + WS_CST);
    bf16_t* MA = (bf16_t*)(P.ws + WS_MA);
    const float* cw = P.in[8] + (size_t)layer * 4 * 1024; const float* cb = P.in[9] + (size_t)layer * 1024; const float* mng = P.in[11] + (size_t)layer * 512;
    LAS unsigned char* Qt = lds; LAS unsigned char* Kt = lds + 128 * RSTR; LAS unsigned char* Vt = lds + 2 * 128 * RSTR;
    LAS float* sg2 = (LAS float*)(lds + 2 * 128 * RSTR + 128 * TSTR); LAS float* sr2 = sg2 + 128; LAS float* sw = sg2 + 256; LAS float* semt = sg2 + 384; LAS float* sqn = sg2 + 512;
    LAS float* sst = sg2 + 640; LAS float* sst2 = sg2 + 896; LAS float* snp = sg2 + 1152;
    constexpr int CT_OFF = 116736;
    {
        const bf16_t* Cp = CST + (size_t)(bh * NCH + c) * 16384;
#pragma unroll
        for (int k = 0; k < 4; ++k) {
            const int S = (k * 8 + wid) * 64 + lane, row = S >> 4, cch = (S & 15) ^ (row & 15);
            __builtin_amdgcn_global_load_lds((const unsigned*)(Cp + (size_t)row * 128 + cch * 8), (LAS unsigned*)(lds + CT_OFF + (k * 8 + wid) * 1024), 16, 0, 0);
        }
    }
    const float npv = tid < 128 ? NST[(size_t)(bh * NCH + c) * 128 + tid] : 0.f;
    float li0 = NEGF, li1 = NEGF, lf0 = 0.f, lf1 = 0.f, mprev = 0.f;
    if (wid == 0) {
        const int i0 = 2 * lane, i1 = i0 + 1;
        const size_t rw0 = seqrow(b, p0 + (i0 < nvalid ? i0 : 0)), rw1 = seqrow(b, p0 + (i1 < nvalid ? i1 : 0));
        li0 = GT[rw0 * 8 + hh]; lf0 = GT[rw0 * 8 + 4 + hh]; li1 = GT[rw1 * 8 + hh]; lf1 = GT[rw1 * 8 + 4 + hh];
        if (i0 >= nvalid) { li0 = NEGF; lf0 = 0.f; } if (i1 >= nvalid) { li1 = NEGF; lf1 = 0.f; }
        mprev = MST[bh * NCH + c];
    }
    ConvW cqw, ckw; convw_load(cqw, cw, cb, hh * 128 + 8 * (tid & 15)); convw_load(ckw, cw, cb, 512 + hh * 128 + 8 * (tid & 15));
    if (wid == 0) {
        const int i0 = 2 * lane, i1 = i0 + 1;
        const float s = lf0 + lf1, incl = wscan_add(s, lane), excl = incl - s;
        const float b0 = excl + lf0, b1 = incl, g0 = li0 - b0, g1 = li1 - b1;
        const float inclm = wscan_max(fmaxf(g0, g1), lane);
        float exclm = __shfl_up(inclm, 1); if (lane == 0) exclm = NEGF;
        const float cm0 = fmaxf(exclm, g0), cm1 = inclm;
        const float M0 = fmaxf(mprev, cm0), M1 = fmaxf(mprev, cm1);
        sg2[i0] = g0 * LOG2E; sg2[i1] = g1 * LOG2E; sr2[i0] = -M0 * LOG2E; sr2[i1] = -M1 * LOG2E;
        sw[i0] = ex2((mprev - M0) * LOG2E); sw[i1] = ex2((mprev - M1) * LOG2E);
        semt[i0] = ex2(-(b0 + M0) * LOG2E); semt[i1] = ex2(-(b1 + M1) * LOG2E);
    }
#pragma unroll 2
    for (int it = 0; it < 4; ++it) {
        const int item = tid + 512 * it, i = item >> 4, ch = item & 15;
        u32x4 qw, kw, vw;
        {
            const int ic = i < nvalid ? i : nvalid - 1;
            f32x4 o0, o1;
            conv8w(PB, cqw, b, p0 + ic, hh * 128 + 8 * ch, o0, o1); qw = pack8(o0, o1);
            conv8w(PB, ckw, b, p0 + ic, 512 + hh * 128 + 8 * ch, o0, o1); kw = pack8(o0 * 0.08838834764831845f, o1 * 0.08838834764831845f);
            vw = *(const u32x4*)(PB + seqrow(b, p0 + ic) * NPB + 1024 + hh * 128 + 8 * ch);
            if (i >= nvalid) { qw = (u32x4){0u, 0u, 0u, 0u}; kw = qw; vw = qw; }
        }
        *(LAS u32x4*)(Qt + i * RSTR + ch * 16) = qw; *(LAS u32x4*)(Kt + i * RSTR + ch * 16) = kw; *(LAS u32x4*)(Vt + i * TSTR + ch * 16) = vw;
    }
    if (tid < 128) snp[tid] = npv;
    asm volatile("s_waitcnt vmcnt(0)" ::: "memory");
    __syncthreads();
    const int r = lane & 31, h = lane >> 5, g = lane >> 4, q = (lane & 15) >> 2, pp = lane & 3;
    const int qb = wid >> 1, dvh = wid & 1, t = 32 * qb + r;
    u32x2 mo_[2][4]; f32x4 gn_[2][4];
    {
        const size_t rowp = seqrow(b, p0 + (t < nvalid ? t : 0));
#pragma unroll
        for (int d = 0; d < 2; ++d)
#pragma unroll
            for (int r4 = 0; r4 < 4; ++r4) {
                const int col = hh * 128 + 32 * (2 * dvh + d) + 8 * r4 + 4 * h;
                mo_[d][r4] = *(const u32x2*)(PB + rowp * NPB + 1536 + col); gn_[d][r4] = *(const f32x4*)(mng + col);
            }
    }
    {
        const int i = tid >> 2, part = tid & 3;
        const LAS float* np = snp + 32 * part;
        float s = 0.f;
#pragma unroll
        for (int d8 = 0; d8 < 4; ++d8) {
            const u32x4 qv = *(const LAS u32x4*)(Qt + i * RSTR + (32 * part + 8 * d8) * 2);
            const f32x4 n0 = *(const LAS f32x4*)(np + 8 * d8), n1 = *(const LAS f32x4*)(np + 8 * d8 + 4);
            s += bflo(qv.x) * n0[0] + bfhi(qv.x) * n0[1] + bflo(qv.y) * n0[2] + bfhi(qv.y) * n0[3] + bflo(qv.z) * n1[0] + bfhi(qv.z) * n1[1] + bflo(qv.w) * n1[2] + bfhi(qv.w) * n1[3];
        }
        s += __shfl_xor(s, 1); s += __shfl_xor(s, 2);
        if (part == 0) sqn[i] = s;
    }
    bf16x8 qf[8];
#pragma unroll
    for (int ks = 0; ks < 8; ++ks) qf[ks] = *(const LAS bf16x8*)(Qt + t * RSTR + (16 * ks + 8 * h) * 2);
    f32x16 acc[2];
#pragma unroll
    for (int d = 0; d < 2; ++d)
#pragma unroll
        for (int e = 0; e < 16; ++e) acc[d][e] = 0.f;
    {
#pragma unroll
        for (int ks = 0; ks < 8; ++ks)
#pragma unroll
            for (int d = 0; d < 2; ++d) {
                const int dv = 32 * (2 * dvh + d) + r;
                const bf16x8 cf = *(const LAS bf16x8*)(lds + CT_OFF + (dv * 16 + ((2 * ks + h) ^ (dv & 15))) * 16);
                acc[d] = mfma32(cf, qf[ks], acc[d]);
            }
    }
    __syncthreads();
    const float wt = sw[t], r2 = sr2[t];
#pragma unroll
    for (int d = 0; d < 2; ++d) acc[d] = acc[d] * wt;
    float den = 0.f;
#pragma unroll 1
    for (int kb = 0; kb <= qb; ++kb) {
        f32x16 st;
#pragma unroll
        for (int e = 0; e < 16; ++e) st[e] = 0.f;
#pragma unroll
        for (int ks = 0; ks < 8; ++ks) { const bf16x8 kf = *(const LAS bf16x8*)(Kt + (32 * kb + r) * RSTR + (16 * ks + 8 * h) * 2); st = mfma32(kf, qf[ks], st); }
#pragma unroll
        for (int r4 = 0; r4 < 4; ++r4) {
            const int s0 = 32 * kb + 8 * r4 + 4 * h;
            const f32x4 gs = *(const LAS f32x4*)(sg2 + s0);
#pragma unroll
            for (int e = 0; e < 4; ++e) {
                float v = st[4 * r4 + e] * ex2(r2 + gs[e]);
                if (s0 + e > t) v = 0.f;
                den += v; st[4 * r4 + e] = v;
            }
        }
#pragma unroll
        for (int s2 = 0; s2 < 2; ++s2) {
            u32x4 pw; pw.x = pk2(st[8 * s2], st[8 * s2 + 1]); pw.y = pk2(st[8 * s2 + 2], st[8 * s2 + 3]); pw.z = pk2(st[8 * s2 + 4], st[8 * s2 + 5]); pw.w = pk2(st[8 * s2 + 6], st[8 * s2 + 7]);
            const bf16x8 pf = __builtin_bit_cast(bf16x8, pw);
#pragma unroll
            for (int d = 0; d < 2; ++d) {
                const LAS unsigned char* va = Vt + (32 * kb + 16 * s2 + 4 * h + q) * TSTR + (32 * (2 * dvh + d) + 16 * (g & 1) + 4 * pp) * 2;
                const bf16x8 vf = cat8(vtr(va), vtr(va + 8 * TSTR));
                acc[d] = mfma32(vf, pf, acc[d]);
            }
        }
    }
    den += __shfl_xor(den, 32);
    den += wt * sqn[t];
    const float inv = 1.f / fmaxf(fabsf(den), semt[t]);
    float s1 = 0.f;
#pragma unroll
    for (int d = 0; d < 2; ++d)
#pragma unroll
        for (int e = 0; e < 16; ++e) { acc[d][e] *= inv; s1 += acc[d][e]; }
    s1 += __shfl_xor(s1, 32);
    if (h == 0) sst[wid * 32 + r] = s1;
    __syncthreads();
    const float mean = (s1 + sst[(wid ^ 1) * 32 + r]) * (1.f / 128.f);
    float q2 = 0.f;
#pragma unroll
    for (int d = 0; d < 2; ++d)
#pragma unroll
        for (int e = 0; e < 16; ++e) { acc[d][e] -= mean; q2 += acc[d][e] * acc[d][e]; }
    q2 += __shfl_xor(q2, 32);
    if (h == 0) sst2[wid * 32 + r] = q2;
    __syncthreads();
    const float rstd = 1.f / sqrtf((q2 + sst2[(wid ^ 1) * 32 + r]) * (1.f / 128.f) + LN_EPS);
    if (t < nvalid) {
        const size_t row = seqrow(b, p0 + t);
#pragma unroll
        for (int d = 0; d < 2; ++d)
#pragma unroll
            for (int r4 = 0; r4 < 4; ++r4) {
                const int col = hh * 128 + 32 * (2 * dvh + d) + 8 * r4 + 4 * h;
                const u32x2 mo = mo_[d][r4];
                const f32x4 g4 = gn_[d][r4];
                const float o0 = acc[d][4 * r4] * rstd * g4[0] * sigm(bflo(mo.x)), o1 = acc[d][4 * r4 + 1] * rstd * g4[1] * sigm(bfhi(mo.x));
                const float o2 = acc[d][4 * r4 + 2] * rstd * g4[2] * sigm(bflo(mo.y)), o3 = acc[d][4 * r4 + 3] * rstd * g4[3] * sigm(bfhi(mo.y));
                u32x2 w; w.x = pk2(o0, o1); w.y = pk2(o2, o3);
                *(u32x2*)(MA + row * 512 + col) = w;
            }
    }
    lds_barrier();
}

constexpr int AT_KB = 64 * RSTR, AT_VB = 64 * TSTR, AT_BUF = AT_KB + AT_VB;
__device__ __forceinline__ void attn_unit(const Params& P, int layer, int b, int hd, int pq0, int nvalid, float lam, float lam_init, LAS unsigned char* lds) {
    const int tid = tidx(), lane = tid & 63, wid = __builtin_amdgcn_readfirstlane(tid >> 6);
    const int c = wid >> 2, wq = wid & 3, r = lane & 31, h = lane >> 5, g = lane >> 4, q = (lane & 15) >> 2, pp = lane & 3;
    const bf16_t* PB = (const bf16_t*)(P.ws + WS_BIG); bf16_t* AO = (bf16_t*)(P.ws + WS_MA) + (size_t)MPAD * 512;
    const float* ang = P.in[16] + (size_t)layer * 512;
    const int qi = 32 * wq + r, qp = pq0 + qi;
    bf16x8 qf[4];
    {
        const size_t qrow = seqrow(b, qp < LSEQ ? qp : LSEQ - 1);
#pragma unroll
        for (int ks = 0; ks < 4; ++ks) qf[ks] = *(const bf16x8*)(PB + qrow * NPB + 2048 + hd * 128 + c * 64 + 16 * ks + 8 * h);
    }
    const float slope2 = ex2(-2.f * (float)(hd + 1)) * LOG2E;
    const int ntiles = (pq0 + nvalid - 1) / 64 + 1;
    float qkb;
    {
        float ss = 0.f;
#pragma unroll
        for (int ks = 0; ks < 4; ++ks)
#pragma unroll
            for (int j = 0; j < 8; ++j) { const float v = __builtin_bit_cast(float, (unsigned)(unsigned short)qf[ks][j] << 16); ss += v * v; }
        ss += __shfl_xor(ss, 32);
        const float* KM = (const float*)(P.ws + WS_KM) + layer * 72;
        const float k2 = fmaxf(KM[b * 8 + hd * 2 + c], KM[64 + hd * 2 + c]);
        qkb = sqrtf(ss) * sqrtf(k2) * 1.001f + 0.01f;
    }
    LAS unsigned* votes = (LAS unsigned*)(lds + 131072 + 2048);
    if (tid < 16) votes[tid] = 0u;
    u32x4 pk[2], pv[2];
#define AT_LOAD(kt) do { _Pragma("unroll") for (int i_ = 0; i_ < 2; ++i_) { const int row_ = (tid + 512 * i_) >> 4, ch_ = tid & 15; int kp_ = 64 * (kt) + row_; kp_ = kp_ < LSEQ ? kp_ : LSEQ - 1; \
        const bf16_t* src_ = PB + seqrow(b, kp_) * NPB + hd * 128 + ch_ * 8; pk[i_] = *(const u32x4*)(src_ + 2560); pv[i_] = *(const u32x4*)(src_ + 3072); } } while (0)
#define AT_STORE(s) do { _Pragma("unroll") for (int i_ = 0; i_ < 2; ++i_) { const int row_ = (tid + 512 * i_) >> 4, ch_ = tid & 15; \
        *(LAS u32x4*)(lds + (s) * AT_BUF + row_ * RSTR + ch_ * 16) = pk[i_]; *(LAS u32x4*)(lds + (s) * AT_BUF + AT_KB + row_ * TSTR + ch_ * 16) = pv[i_]; } } while (0)
    AT_LOAD(ntiles - 1); AT_STORE((ntiles - 1) & 1);
    __syncthreads();
    float m_run = NEGF, l_run = 0.f;
    f32x16 o[4];
#pragma unroll
    for (int d = 0; d < 4; ++d)
#pragma unroll
        for (int e = 0; e < 16; ++e) o[d][e] = 0.f;
#pragma unroll 1
    for (int kt = ntiles - 1; kt >= 0; --kt) {
        const int s = kt & 1;
        if (kt > 0) AT_LOAD(kt - 1);
        const LAS unsigned char* Kb = lds + s * AT_BUF; const LAS unsigned char* Vb = Kb + AT_KB;
        if (64 * kt <= pq0 + 32 * wq + 31) {
        f32x16 st[2];
#pragma unroll
        for (int kb2 = 0; kb2 < 2; ++kb2) {
            const float tb = slope2 * (float)(64 * kt + 32 * kb2 - pq0 + 4 * h);
#pragma unroll
            for (int e = 0; e < 16; ++e) st[kb2][e] = tb + slope2 * (float)((e & 3) + 8 * (e >> 2));
#pragma unroll
            for (int ks = 0; ks < 4; ++ks) { const bf16x8 kf = *(const LAS bf16x8*)(Kb + (32 * kb2 + r) * RSTR + (c * 64 + 16 * ks + 8 * h) * 2); st[kb2] = mfma32(kf, qf[ks], st[kb2]); }
        }
        if (64 * kt + 63 > pq0 + 32 * wq) {
#pragma unroll
            for (int kb2 = 0; kb2 < 2; ++kb2)
#pragma unroll
                for (int e = 0; e < 16; ++e) { const int kp = 64 * kt + 32 * kb2 + (e & 3) + 8 * (e >> 2) + 4 * h; if (kp > qp) st[kb2][e] = NEGF; }
        }
        float mx = st[0][0];
#pragma unroll
        for (int e = 1; e < 16; ++e) mx = fmaxf(mx, st[0][e]);
#pragma unroll
        for (int e = 0; e < 16; ++e) mx = fmaxf(mx, st[1][e]);
        mx = fmaxf(mx, __shfl_xor(mx, 32));
        if (__any(mx > m_run + 8.f)) {
            const float m_new = fmaxf(m_run, mx), alpha = ex2(m_run - m_new);
            m_run = m_new; l_run *= alpha;
#pragma unroll
            for (int d = 0; d < 4; ++d) o[d] = o[d] * alpha;
        }
        const float m_new = m_run;
        float psum = 0.f;
#pragma unroll
        for (int kb2 = 0; kb2 < 2; ++kb2)
#pragma unroll
            for (int e = 0; e < 16; ++e) { const float p = ex2(st[kb2][e] - m_new); st[kb2][e] = p; psum += p; }
        l_run += psum;
#pragma unroll
        for (int kb2 = 0; kb2 < 2; ++kb2)
#pragma unroll
            for (int s2 = 0; s2 < 2; ++s2) {
                u32x4 pw; pw.x = pk2(st[kb2][8 * s2], st[kb2][8 * s2 + 1]); pw.y = pk2(st[kb2][8 * s2 + 2], st[kb2][8 * s2 + 3]); pw.z = pk2(st[kb2][8 * s2 + 4], st[kb2][8 * s2 + 5]); pw.w = pk2(st[kb2][8 * s2 + 6], st[kb2][8 * s2 + 7]);
                const bf16x8 pf = __builtin_bit_cast(bf16x8, pw);
#pragma unroll
                for (int d = 0; d < 4; ++d) {
                    const LAS unsigned char* va = Vb + (32 * kb2 + 16 * s2 + 4 * h + q) * TSTR + (32 * d + 16 * (g & 1) + 4 * pp) * 2;
                    const bf16x8 vf = cat8(vtr(va), vtr(va + 8 * TSTR));
                    o[d] = mfma32(vf, pf, o[d]);
                }
            }
        }
        if (kt > 0) {
            const float bnd = qkb + slope2 * (float)(64 * (kt - 1) + 63 - pq0);
            const bool dn = !__any(bnd >= m_run - 44.f);
            if (lane == 0) votes[s * 8 + wid] = dn ? 1u : 0u;
            AT_STORE(s ^ 1);
        }
        __syncthreads();
        if (kt > 0) {
            const u32x4 v0 = *(const LAS u32x4*)(votes + s * 8), v1 = *(const LAS u32x4*)(votes + s * 8 + 4);
            const unsigned all = (unsigned)__builtin_amdgcn_readfirstlane((int)((v0.x & v0.y) & (v0.z & v0.w) & (v1.x & v1.y) & (v1.z & v1.w)));
            if (all) break;
        }
    }
#undef AT_LOAD
#undef AT_STORE
    const float l_tot = l_run + __shfl_xor(l_run, 32), inv = 1.f / l_tot;
    LAS float* xch = (LAS float*)lds;
    if (c == 1) {
#pragma unroll
        for (int d = 0; d < 4; ++d)
#pragma unroll
            for (int e = 0; e < 16; ++e) xch[((wq * 4 + d) * 16 + e) * 64 + lane] = o[d][e] * inv;
    }
    __syncthreads();
    if (c == 0) {
        float ss = 0.f;
#pragma unroll
        for (int d = 0; d < 4; ++d)
#pragma unroll
            for (int e = 0; e < 16; ++e) { const float v = o[d][e] * inv - lam * xch[((wq * 4 + d) * 16 + e) * 64 + lane]; o[d][e] = v; ss += v * v; }
        ss += __shfl_xor(ss, 32);
        const float rms = (1.f / sqrtf(ss * (1.f / 128.f) + LN_EPS)) * (1.f - lam_init);
        f32x4 ga_[4][4];
#pragma unroll
        for (int d = 0; d < 4; ++d)
#pragma unroll
            for (int r4 = 0; r4 < 4; ++r4) ga_[d][r4] = *(const f32x4*)(ang + hd * 128 + 32 * d + 8 * r4 + 4 * h);
        if (qi < nvalid) {
            const size_t row = seqrow(b, qp);
#pragma unroll
            for (int d = 0; d < 4; ++d)
#pragma unroll
                for (int r4 = 0; r4 < 4; ++r4) {
                    const int col = hd * 128 + 32 * d + 8 * r4 + 4 * h;
                    const f32x4 g4 = ga_[d][r4];
                    u32x2 w; w.x = pk2(o[d][4 * r4] * rms * g4[0], o[d][4 * r4 + 1] * rms * g4[1]); w.y = pk2(o[d][4 * r4 + 2] * rms * g4[2], o[d][4 * r4 + 3] * rms * g4[3]);
                    *(u32x2*)(AO + row * 512 + col) = w;
                }
        }
    }
    lds_barrier();
}

#define XB_TMO      128
#define XB_XCNT(j)  (256  + 64 * (j))
#define XB_XSUB(j)  (1280 + 64 * (j))
#define XB_XGEN(j)  (2304 + 64 * (j))
#define XB_TOP      3328
#define XB_TOPGEN   3392
#define XCD_BAR_WORDS 3456
#define XB_SPIN_CAP (1u << 18)

__device__ __forceinline__ unsigned xb_ld(unsigned* p)              { return __hip_atomic_load(p, __ATOMIC_RELAXED, __HIP_MEMORY_SCOPE_AGENT); }
__device__ __forceinline__ unsigned xb_add(unsigned* p, unsigned v) { return __hip_atomic_fetch_add(p, v, __ATOMIC_RELAXED, __HIP_MEMORY_SCOPE_AGENT); }
__device__ __forceinline__ unsigned xb_xcc_id() { return (unsigned)__builtin_amdgcn_s_getreg((3 << 11) | 20) & 0xFu; }
#define XB_SPIN(cond, bar) do { unsigned _sp = 0; while (cond) { __builtin_amdgcn_s_sleep(1); \
    if ((++_sp & 255u) == 0u) { if (xb_ld(&(bar)[XB_TMO])) break; if (_sp > XB_SPIN_CAP) { atomicAdd(&(bar)[XB_TMO], 1u); break; } } } } while (0)

struct XcdBarrier {
    unsigned* bar; unsigned x;
    volatile LAS unsigned* st;
};

__device__ __forceinline__ XcdBarrier xcd_barrier_post(unsigned* bar, volatile LAS unsigned* st) {
    XcdBarrier b; b.bar = bar; b.x = xb_xcc_id(); b.st = st;
    if (threadIdx.x == 0) (void)xb_add(&bar[XB_XCNT(b.x)], 1u);
    return b;
}
__device__ __forceinline__ void xcd_barrier_complete(unsigned* bar, unsigned x, unsigned& nloc, unsigned& nx) {
    const unsigned G = gridDim.x * gridDim.y * gridDim.z;
    unsigned sum, cnt, mine, sp = 0u;
    for (;;) {
        sum = 0u; cnt = 0u; mine = 0u;
#pragma unroll
        for (unsigned j = 0; j < 16; ++j) { const unsigned c = xb_ld(&bar[XB_XCNT(j)]); sum += c; cnt += (c > 0u) ? 1u : 0u; mine = (j == x) ? c : mine; }
        if (sum == G) break;
        __builtin_amdgcn_s_sleep(1);
        if ((++sp & 255u) == 0u) { if (xb_ld(&bar[XB_TMO])) break; if (sp > XB_SPIN_CAP) { atomicAdd(&bar[XB_TMO], 1u); break; } }
    }
    nloc = mine > 0u ? mine : 1u; nx = cnt > 0u ? cnt : 1u;
}

__device__ __forceinline__ void xcd_barrier(const XcdBarrier& b) {
    asm volatile("s_waitcnt vmcnt(0)" ::: "memory");
    __syncthreads();
    if (threadIdx.x == 0) {
        unsigned* bar = b.bar;
        __builtin_amdgcn_s_waitcnt(0);
        unsigned nloc = b.st[0], nx = b.st[1];
        if (nloc == 0u) { xcd_barrier_complete(bar, b.x, nloc, nx); b.st[0] = nloc; b.st[1] = nx; }
        const unsigned old = xb_add(&bar[XB_XSUB(b.x)], 1u);
        const unsigned gen = old / nloc;
        if (old + 1u == (gen + 1u) * nloc) {
            __builtin_amdgcn_fence(__ATOMIC_RELEASE, "agent");
            asm volatile("s_waitcnt vmcnt(0)" ::: "memory");
            const unsigned og = xb_add(&bar[XB_TOP], 1u);
            const unsigned tg = og / nx;
            if (og + 1u == (tg + 1u) * nx) xb_add(&bar[XB_TOPGEN], 1u);
            else XB_SPIN(xb_ld(&bar[XB_TOPGEN]) == tg, bar);
            __builtin_amdgcn_fence(__ATOMIC_ACQUIRE, "agent");
            xb_add(&bar[XB_XGEN(b.x)], 1u);
            asm volatile("s_waitcnt vmcnt(0)" ::: "memory");
        } else {
            XB_SPIN(xb_ld(&bar[XB_XGEN(b.x)]) == gen, bar);
            __builtin_amdgcn_fence(__ATOMIC_ACQUIRE, "agent");
            asm volatile("s_waitcnt vmcnt(0)" ::: "memory");
        }
    }
    __syncthreads();
}

#ifndef PROBE_ATT
#define PROBE_ATT 1
#endif
#ifndef PROBE_M3
#define PROBE_M3 1
#endif
constexpr int LDS_BYTES = 155648;
constexpr int LDS_BST = LDS_BYTES - 64;
#ifndef PROG_LAYER
#define PROG_LAYER(L) 16*L+0, 16*L+1, 16*L+3, 16*L+4, 16*L+5, 16*L+6, 16*L+7, 16*L+8, 16*L+9, 16*L+11, 16*L+12
#endif
__device__ const unsigned char PROG[] = { PROG_LAYER(0), PROG_LAYER(1), 16 * 1 + 13 };
constexpr int NSTEP = 14;
__global__ void __launch_bounds__(512) hybrid_fwd(Params P) {
    extern __shared__ __attribute__((aligned(16))) unsigned char smem[];
    LAS unsigned char* lds = (LAS unsigned char*)smem;
    cg::grid_group grid = cg::this_grid();
    unsigned* barw = (unsigned*)(P.ws + WS_BAR);
    volatile LAS unsigned* bst = (volatile LAS unsigned*)(lds + LDS_BST);
    if (blockIdx.x == 0) for (int i = threadIdx.x; i < XCD_BAR_WORDS; i += 512) __hip_atomic_store(barw + i, 0u, __ATOMIC_RELAXED, __HIP_MEMORY_SCOPE_AGENT);
    if (blockIdx.x == 0 && threadIdx.x < 144) __hip_atomic_store((unsigned*)(P.ws + WS_KM) + threadIdx.x, 0u, __ATOMIC_RELAXED, __HIP_MEMORY_SCOPE_AGENT);
    if (threadIdx.x < 2) bst[threadIdx.x] = 0u;
    __syncthreads();

#ifndef PROBE_P0
#define PROBE_P0 1
#endif
#pragma unroll 1
    for (int rep0_ = 0; rep0_ < PROBE_P0; ++rep0_)
    {
        const int lane = tidx() & 63, wid = tidx() >> 6, gw = bidx() * 8 + wid, NGW = gridDim.x * 8;
        bf16_t* HB = (bf16_t*)(P.ws + WS_HB); float* HFM = (float*)(P.ws + WS_HFM);
        LAS float* scr = (LAS float*)(lds + wid * 16384);
        for (int it = gw; it < 2 * CW_ITEMS; it += NGW) conv_weight_item(P, it / CW_ITEMS, it % CW_ITEMS, scr, lane);
        const float* x = P.in[0]; const float* meta = P.in[1];
        {
            const size_t NT8 = (size_t)gridDim.x * 512, n8 = (size_t)MREAL * DM / 8;
#pragma unroll 1
            for (size_t i = (size_t)bidx() * 512 + tidx(); i < n8; i += 4 * NT8) {
                f32x4 v0[4], v1[4];
#pragma unroll
                for (int j = 0; j < 4; ++j) { const size_t ii = i + j * NT8 < n8 ? i + j * NT8 : i; v0[j] = *(const f32x4*)(x + ii * 8); v1[j] = *(const f32x4*)(x + ii * 8 + 4); }
                asm volatile("" : "+v"(v0[0]), "+v"(v0[1]), "+v"(v0[2]), "+v"(v0[3]), "+v"(v1[0]), "+v"(v1[1]), "+v"(v1[2]), "+v"(v1[3]));
#pragma unroll
                for (int j = 0; j < 4; ++j) if (i + j * NT8 < n8) *(u32x4*)(HB + (i + j * NT8) * 8) = pack8(v0[j], v1[j]);
            }
        }
        for (int row = gw; row < NMETA; row += NGW) {
#pragma unroll
            for (int j = 0; j < 4; ++j) {
                const f32x4 v = *(const f32x4*)(meta + (size_t)row * DM + 256 * j + 4 * lane);
                *(f32x4*)(HFM + (size_t)row * DM + 256 * j + 4 * lane) = v;
                u32x2 w; w.x = pk2(v[0], v[1]); w.y = pk2(v[2], v[3]);
                *(u32x2*)(HB + (size_t)(MROW0 + row) * DM + 256 * j + 4 * lane) = w;
            }
        }
    }
    grid.sync();
    (void)xcd_barrier_post(barw, bst);

#pragma unroll 1
    for (int ph = 0; ph < (int)sizeof(PROG); ++ph) {
        const int layer = PROG[ph] >> 4, step = PROG[ph] & 15;
        const int G = gridDim.x;
#define TIDV const int tid_ = tidx(), lane = tid_ & 63, wid = __builtin_amdgcn_readfirstlane(tid_ >> 6); (void)lane; (void)wid;
        bf16_t* HB = (bf16_t*)(P.ws + WS_HB); float* HFM = (float*)(P.ws + WS_HFM);
        bf16_t* BIG = (bf16_t*)(P.ws + WS_BIG); bf16_t* MA = (bf16_t*)(P.ws + WS_MA);
        const bf16_t* Wl = (const bf16_t*)(P.ws + WS_W) + (size_t)layer * OW_LAYER;
#define LNCTX float* ROWS = (float*)(P.ws + WS_ROWS); const float* CSl = (const float*)(P.ws + WS_CSBW) + (size_t)layer * 2 * OC_N; const float* BWl = CSl + OC_N; \
        const int tlast = 3 * layer + (step <= 1 ? -1 : step <= 9 ? 0 : step <= 12 ? 1 : 2);   \
        const float* rows_last = ROWS + (size_t)((tlast & 1) * MPAD) * 2; (void)CSl; (void)BWl; (void)rows_last;
        if (step == 0 || step == 3 || step == 11) {
            LNCTX
            float* z = ROWS + (size_t)(((tlast + 1) & 1) * MPAD) * 2;
            for (int i = bidx() * 512 + tidx(); i < MPAD * 2 / 4; i += G * 512) *(f32x4*)(z + 4 * i) = (f32x4){0.f, 0.f, 0.f, 0.f};
        }
        if (step == 0 || step == 11) {
            LNCTX
            const bf16_t* Wgu = Wl + (step ? OW_GU2 : OW_GU1); const int oc = step ? OC_GU2 : OC_GU1;
            const pg8::LnFix fx{rows_last, CSl + oc, BWl + oc, tlast >= 0 ? 1 : 0};
            pg8::Gemm gm{HB, Wgu, MREAL, 2 * FF, DM}; pg8::StaticOrder S; S.init(MREAL, 2 * FF, G, bidx());
            pg8::EpiSwiglu E{BIG, FF, fx};
            pg8::gemm_phase<pg8::EpiSwiglu, pg8::StaticOrder, true, true>(lds, gm, S, E);
            for (int ct = bidx(); ct < FF / 16; ct += G) {
                TIDV
                const int c0 = 16 * ct, R0 = 256 * (c0 >> 7) + (c0 & 127);
                const f32x4 ag = sg_tile_blk(HB + (size_t)MROW0 * DM, DM, Wgu, DM, R0, lane, wid, (LAS float*)lds), au = sg_tile_blk(HB + (size_t)MROW0 * DM, DM, Wgu, DM, R0 + 128, lane, wid, (LAS float*)lds);
                if (wid == 0) {
                    const int rb = R0 + (lane & 15);
                    float mu4[4] = {0.f, 0.f, 0.f, 0.f}, r4v[4] = {1.f, 1.f, 1.f, 1.f}, csg = 0.f, bwg = 0.f, csu = 0.f, bwu = 0.f;
                    if (fx.on) { csg = fx.cs[rb]; bwg = fx.bw[rb]; csu = fx.cs[rb + 128]; bwu = fx.bw[rb + 128];
#pragma unroll
                        for (int e = 0; e < 4; ++e) fx.stats((size_t)(MROW0 + 4 * (lane >> 4) + e), mu4[e], r4v[e]); }
#pragma unroll
                    for (int e = 0; e < 4; ++e) {
                        const size_t row = (size_t)(MROW0 + 4 * (lane >> 4) + e);
                        const float gv = (ag[e] - csg * mu4[e]) * r4v[e] + bwg, uv = (au[e] - csu * mu4[e]) * r4v[e] + bwu;
                        BIG[row * FF + c0 + (lane & 15)] = (bf16_t)f2bf(siluf(gv) * uv);
                    }
                }
            }
        } else if (step == 1 || step == 9 || step == 12) {
            LNCTX
            const bf16_t* A = step == 9 ? MA : BIG; const bf16_t* Bt = Wl + (step == 1 ? OW_D1 : step == 9 ? OW_OUT : OW_D2);
            const int K = step == 9 ? DM : FF; const float sc = step == 9 ? 1.f : 0.5f;
            pg8::Gemm gm{A, Bt, MREAL, DM, K}; pg8::StaticOrder S; S.init(MREAL, DM, G, bidx());
            const int raw = tlast < 0 ? 1 : 0;
            const int gi = step == 1 ? (layer == 0 ? 5 : 26) : step == 9 ? 5 : 21;
            const int gl = step == 1 ? (layer == 0 ? 0 : layer - 1) : layer;
            const float* gam = P.in[gi] + (size_t)gl * DM; const float* bet = P.in[gi + 1] + (size_t)gl * DM;
            float* rows_cur = ROWS + (size_t)(((tlast + 1) & 1) * MPAD) * 2;
            pg8::EpiResid E{P.in[0], (bf16_t*)(P.ws + WS_LO), HB, rows_last, rows_cur, gam, bet, sc, raw};
            pg8::gemm_phase<pg8::EpiResid, pg8::StaticOrder, true, true>(lds, gm, S, E);
            for (int ct = bidx(); ct < 64; ct += G) {
                TIDV
                const f32x4 a = sg_tile_blk(A + (size_t)MROW0 * K, K, Bt, K, 16 * ct, lane, wid, (LAS float*)lds);
                const int col = 16 * ct + (lane & 15);
                if (wid == 0) {
                    float hv[4], s1v[4] = {0.f, 0.f, 0.f, 0.f}, s2v[4] = {1.f, 1.f, 1.f, 1.f}, gcol = 1.f, bcol = 0.f;
#pragma unroll
                    for (int e = 0; e < 4; ++e) { const int mr = 4 * (lane >> 4) + e; hv[e] = HFM[(size_t)mr * DM + col]; if (!raw) { s1v[e] = rows_last[(size_t)(MROW0 + mr) * 2]; s2v[e] = rows_last[(size_t)(MROW0 + mr) * 2 + 1]; } }
                    if (!raw) { gcol = gam[col]; bcol = bet[col]; }
#pragma unroll
                    for (int e = 0; e < 4; ++e) {
                        const int mr = 4 * (lane >> 4) + e; float* p = HFM + (size_t)mr * DM + col;
                        float h = hv[e];
                        if (!raw) { const float mu = s1v[e] * (1.f / DM), r = __builtin_amdgcn_rsqf(s2v[e] * (1.f / DM) - mu * mu + LN_EPS);
                            h = (h - mu) * r * gcol + bcol; }
                        const float y = ALPHA * h + sc * a[e];
                        *p = y; HB[(size_t)(MROW0 + mr) * DM + col] = (bf16_t)f2bf(y);
                        float q1 = y, q2 = y * y;
                        q1 += __shfl_xor(q1, 1); q1 += __shfl_xor(q1, 2); q1 += __shfl_xor(q1, 4); q1 += __shfl_xor(q1, 8);
                        q2 += __shfl_xor(q2, 1); q2 += __shfl_xor(q2, 2); q2 += __shfl_xor(q2, 4); q2 += __shfl_xor(q2, 8);
                        if ((lane & 15) == 0) { atomicAdd(rows_cur + (size_t)(MROW0 + mr) * 2, q1); atomicAdd(rows_cur + (size_t)(MROW0 + mr) * 2 + 1, q2); }
                    }
                }
            }
        } else if (step == 13) {
            ln_phase(P, P.in[26] + (size_t)layer * DM, P.in[27] + (size_t)layer * DM, false, true, nullptr, nullptr, lds);
        } else if (step == 3 || step == 7) {
            LNCTX
            const int ng = step == 3 ? 1 : 2;
            float* GT = (float*)(P.ws + WS_GATES); const float* bif = P.in[10] + (size_t)layer * 8;
#pragma unroll 1
            for (int gi = 0; gi < ng; ++gi) {
                const bf16_t* A = step == 3 ? HB : MA + (size_t)gi * MPAD * 512;
                const bf16_t* Bt = Wl + (step == 3 ? OW_PB : gi ? OW_BA : OW_BM);
                const int N = step == 3 ? NPBW : DM, K = step == 3 ? DM : 512, ldc = step == 3 ? NPB : 2048, coff = gi * DM;
                const pg8::LnFix fx{rows_last, CSl + OC_PB, BWl + OC_PB, step == 3 ? 1 : 0};
                pg8::Gemm gm{A, Bt, MREAL, N, K}; pg8::StaticOrder S; S.init(MREAL, N, G, bidx());
                pg8::EpiPlain E{BIG, ldc, coff, step == 3 ? 8 : 0, step == 3 ? 10 : 0, QSCALE, fx, step == 3 ? GT : nullptr, bif};
                pg8::gemm_phase<pg8::EpiPlain, pg8::StaticOrder, true, true>(lds, gm, S, E);
                const int ntile = step == 3 ? NPB / 16 + 1 : N / 16;
                for (int ct = bidx(); ct < ntile; ct += G) {
                    TIDV
                    const f32x4 a = sg_tile_blk(A + (size_t)MROW0 * K, K, Bt, K, 16 * ct, lane, wid, (LAS float*)lds);
                    const float sc = (step == 3 && 16 * ct >= 2048 && 16 * ct < 2560) ? QSCALE : 1.f;
                    if (wid == 0) {
                        const int rb = 16 * ct + (lane & 15);
                        float mu4[4] = {0.f, 0.f, 0.f, 0.f}, r4v[4] = {1.f, 1.f, 1.f, 1.f}, cs1 = 0.f, bw1 = 0.f;
                        if (fx.on) { cs1 = fx.cs[rb]; bw1 = fx.bw[rb];
#pragma unroll
                            for (int e = 0; e < 4; ++e) fx.stats((size_t)(MROW0 + 4 * (lane >> 4) + e), mu4[e], r4v[e]); }
#pragma unroll
                        for (int e = 0; e < 4; ++e) {
                            const size_t row = (size_t)(MROW0 + 4 * (lane >> 4) + e);
                            const float v = (a[e] - cs1 * mu4[e]) * r4v[e] + bw1;
                            if (step == 3 && ct == NPB / 16) {
                                if ((lane & 15) < 8) { const float z = v + bif[lane & 15]; GT[row * 8 + (lane & 15)] = (lane & 15) < 4 ? z : fminf(z, 0.f) - __logf(1.f + __expf(-fabsf(z))); }
                            } else BIG[row * ldc + coff + rb] = (bf16_t)f2bf(v * sc);
                        }
                    }
                }
            }
        } else if (step == 4) {
            {
                float* KM = (float*)(P.ws + WS_KM) + layer * 72;
                TIDV
                const int gw = bidx() * 8 + wid, NGW = G * 8;
#pragma unroll 1
                for (int task = gw; task < 2049; task += NGW) {
                    const int real = task < 2048, slot = real ? task >> 8 : 8, nr = real ? 32 : NMETA;
                    const size_t r0 = real ? (size_t)(task >> 8) * SEQ + (size_t)(task & 255) * 32 : (size_t)MROW0;
                    float mxv = 0.f;
#pragma unroll 1
                    for (int i0 = 0; i0 < nr; i0 += 8) {
                        u32x4 vr[8];
#pragma unroll
                        for (int j = 0; j < 8; ++j) vr[j] = *(const u32x4*)(BIG + (r0 + i0 + j) * NPB + 2560 + lane * 8);
                        asm volatile("" : "+v"(vr[0]), "+v"(vr[1]), "+v"(vr[2]), "+v"(vr[3]), "+v"(vr[4]), "+v"(vr[5]), "+v"(vr[6]), "+v"(vr[7]));
#pragma unroll
                        for (int j = 0; j < 8; ++j) {
                            const u32x4 v = vr[j];
                            float ss = bflo(v.x) * bflo(v.x) + bfhi(v.x) * bfhi(v.x) + bflo(v.y) * bflo(v.y) + bfhi(v.y) * bfhi(v.y) + bflo(v.z) * bflo(v.z) + bfhi(v.z) * bfhi(v.z) + bflo(v.w) * bflo(v.w) + bfhi(v.w) * bfhi(v.w);
                            ss += __shfl_xor(ss, 1); ss += __shfl_xor(ss, 2); ss += __shfl_xor(ss, 4);
                            mxv = fmaxf(mxv, ss);
                        }
                    }
                    if ((lane & 7) == 0) atomicMax((unsigned*)KM + slot * 8 + (lane >> 3), __builtin_bit_cast(unsigned, mxv));
                }
            }
            for (int u = bidx(); u < 2048 + 4; u += G) { const int bh_ = u < 2048 ? u >> 6 : u - 2048, c_ = u < 2048 ? 1 + (u & 63) : 0; m1_unit(P, layer, bh_, c_, lds); }
        } else if (step == 5) {
            m2_phase(P);
        } else if (step == 6) {
            const float lam_init = layer == 0 ? 0.2f : 0.35550906759f;
            float lam;
            {
                TIDV
                const float* l1 = P.in[12] + layer * 64; const float* k1 = P.in[13] + layer * 64; const float* l2 = P.in[14] + layer * 64; const float* k2 = P.in[15] + layer * 64;
                const float s1 = wave_sum(l1[lane] * k1[lane]), s2 = wave_sum(l2[lane] * k2[lane]);
                lam = expf(s1) - expf(s2) + lam_init;
            }
#pragma unroll 1
            for (int rep_ = 0; rep_ < PROBE_ATT; ++rep_)
#pragma unroll 1
            for (int u = bidx(); u < 2048 + 4; u += G) {
                const int cbv = u & 255, i = u >> 8, jj = cbv & 31, j = (i & 4) ? 63 - jj : jj;
                const bool real = u < 2048; const int bh = real ? ((cbv >> 5) * 4 + (i & 3)) : (u - 2048);
                attn_unit(P, layer, bh >> 2, bh & 3, real ? NMETA + 128 * j : 0, real ? 128 : NMETA, lam, lam_init, lds);
            }
#pragma unroll 1
            for (int rep_ = 0; rep_ < PROBE_M3; ++rep_)
#pragma unroll 1
            for (int u = bidx(); u < 2048 + 4; u += G) { const int bh_ = u < 2048 ? u >> 6 : u - 2048, c_ = u < 2048 ? 1 + (u & 63) : 0; m3_unit(P, layer, bh_, c_, lds); }
        } else if (step == 8) {
            const bf16_t* Y = BIG; const float* bg = P.in[19] + (size_t)layer * 2048;
            pg8::Gemm gm{HB, Wl + OW_GM, MREAL, 2048, DM}; pg8::StaticOrder S; S.init(MREAL, 2048, G, bidx());
            LNCTX
            const pg8::LnFix fx{rows_last, CSl + OC_GM, BWl + OC_GM, 1};
            pg8::EpiGate E{MA, Y, bg, fx};
            pg8::gemm_phase<pg8::EpiGate, pg8::StaticOrder, true, true>(lds, gm, S, E);
            for (int ct = bidx(); ct < 64; ct += G) {
                TIDV
                const int c0 = 16 * ct, R0 = 256 * (c0 >> 7) + (c0 & 127);
                const f32x4 am = sg_tile_blk(HB + (size_t)MROW0 * DM, DM, Wl + OW_GM, DM, R0, lane, wid, (LAS float*)lds), aa = sg_tile_blk(HB + (size_t)MROW0 * DM, DM, Wl + OW_GM, DM, R0 + 128, lane, wid, (LAS float*)lds);
                const int col = c0 + (lane & 15), rb = R0 + (lane & 15);
                if (wid == 0) {
                    float mu4[4], r4v[4], ymv[4], yav[4];
                    const float csm = fx.cs[rb], bwm = fx.bw[rb], csa = fx.cs[rb + 128], bwa = fx.bw[rb + 128];
#pragma unroll
                    for (int e = 0; e < 4; ++e) { const size_t rowl = (size_t)(MROW0 + 4 * (lane >> 4) + e); fx.stats(rowl, mu4[e], r4v[e]); ymv[e] = bflo((unsigned)Y[rowl * 2048 + col]); yav[e] = bflo((unsigned)Y[rowl * 2048 + DM + col]); }
#pragma unroll
                    for (int e = 0; e < 4; ++e) {
                        const size_t row = (size_t)(MROW0 + 4 * (lane >> 4) + e);
                        const float gmv = (am[e] - csm * mu4[e]) * r4v[e] + bwm, gav = (aa[e] - csa * mu4[e]) * r4v[e] + bwa;
                        const float ym = ymv[e], ya = yav[e];
                        MA[row * DM + col] = (bf16_t)f2bf(sigm(gmv) * ym + sigm(gav) * ya);
                    }
                }
            }
        }
        {
            unsigned char* wsb = P.ws; asm volatile("" : "+s"(wsb));
            XcdBarrier xb; xb.bar = (unsigned*)(wsb + WS_BAR); xb.x = xb_xcc_id(); xb.st = (volatile LAS unsigned*)(lds + LDS_BST);
            xcd_barrier(xb);
#ifdef PROBE_SYNC
            for (int i_ = 0; i_ < PROBE_SYNC; ++i_) xcd_barrier(xb);
#endif
        }
    }
}

extern "C" void kernel_launch(void* const* d_in, const int* in_sizes, int n_in, void* d_out, int out_size, void* d_ws, size_t ws_size, hipStream_t stream) {
    static int grid = 0;
    if (grid == 0) {
        if (n_in != 28 || out_size != MREAL * DM || ws_size < WS_END) { fprintf(stderr, "kernel_launch: unexpected shapes (n_in %d out %d ws %zu)\n", n_in, out_size, ws_size); grid = -1; return; }
        int dev = 0, cus = 0, per_cu = 0;
        hipGetDevice(&dev); hipDeviceGetAttribute(&cus, hipDeviceAttributeMultiprocessorCount, dev);
        hipFuncSetAttribute((const void*)hybrid_fwd, hipFuncAttributeMaxDynamicSharedMemorySize, LDS_BYTES);
        hipOccupancyMaxActiveBlocksPerMultiprocessor(&per_cu, (const void*)hybrid_fwd, 512, LDS_BYTES);
        if (per_cu < 1) per_cu = 1;
        grid = cus * per_cu;
        (void)hipGetLastError();
    }
    if (grid < 0) return;
    Params p{};
    for (int i = 0; i < 28; ++i) p.in[i] = (const float*)d_in[i];
    p.out = (float*)d_out; p.ws = (unsigned char*)d_ws;
    void* args[] = {&p};
    hipError_t e = hipLaunchCooperativeKernel((const void*)hybrid_fwd, dim3(grid), dim3(512), args, LDS_BYTES, stream);
    if (e != hipSuccess) fprintf(stderr, "cooperative launch failed: %s (grid %d)\n", hipGetErrorString(e), grid);
}
```

```cpp
#include <hip/hip_runtime.h>
#include <hip/hip_cooperative_groups.h>
#include <cstdio>
#include <cstdint>
namespace cg = cooperative_groups;

__device__ __forceinline__ int tidx() { int t = threadIdx.x; asm volatile("" : "+v"(t)); return t; }
__device__ __forceinline__ int bidx() { int t = blockIdx.x; asm volatile("" : "+s"(t)); return t; }
namespace pg8 {
#define PG8_LAS __attribute__((address_space(3)))
typedef unsigned short bf16_t;
typedef short bf16x8 __attribute__((ext_vector_type(8)));
typedef float f32x4 __attribute__((ext_vector_type(4)));
typedef unsigned u32x4 __attribute__((ext_vector_type(4)));
constexpr int BM = 256, BK = 64, HALF = 128, HTB = HALF * BK * 2  , STAGE_BYTES = 8 * HTB, NXCD = 8, WGM = 8;

__host__ __device__ __forceinline__ int lds_byte(int r, int c) { const int st = (r >> 4) * 2 + (c >> 5), rr = r & 15, cc = c & 31, ob = rr * 64 + cc * 2; return st * 1024 + (ob ^ (((ob >> 9) & 1) << 5)); }
__host__ __device__ __forceinline__ void stage_rc(int b, int& R, int& C) { const int st = b / 1024, sb = b % 1024, swz = sb ^ (((sb >> 9) & 1) << 5); R = (st >> 1) * 16 + swz / 64; C = (st & 1) * 32 + (swz % 64) / 2; }
__host__ __device__ __forceinline__ int perm32(int rho) { const int n = rho >> 4, i = rho & 15; return 8 * (i >> 2) + 4 * n + (i & 3); }

struct Unit { int pm, pn; };
struct Gemm { const bf16_t* A; const bf16_t* Bt; int M, N, K; };

struct StaticOrder {
    int nM, nN, nwg, G, c;
    __host__ __device__ void init(int M, int N, int G_, int c_) { nM = M / BM; nN = N / BM; nwg = nM * nN; G = G_; c = c_; }
    __host__ __device__ bool next(int i, Unit& u) const {
        const long L = (long)i * G + c; if (L >= nwg) return false;
        int wgid = (int)L; { const int q = nwg / NXCD, r = nwg % NXCD, xcd = wgid % NXCD, off = wgid / NXCD; wgid = (xcd < r ? xcd * (q + 1) : r * (q + 1) + (xcd - r) * q) + off; }
        const int nig = WGM * nN, gid = wgid / nig, fm = gid * WGM, gsz = (nM - fm) < WGM ? (nM - fm) : WGM;
        u.pm = fm + ((wgid % nig) % gsz); u.pn = (wgid % nig) / gsz; return true;
    }
    __device__ __forceinline__ void a_ready(const Unit&) const {}
    __device__ __forceinline__ void done(const Unit&) const {}
};

__device__ __forceinline__ unsigned cvt_pk_bf16(float lo, float hi) { unsigned r; asm volatile("v_cvt_pk_bf16_f32 %0, %1, %2" : "=v"(r) : "v"(lo), "v"(hi)); return r; }
typedef float f32x2 __attribute__((ext_vector_type(2)));
__device__ __forceinline__ f32x2 gelu_pk(f32x2 v) {
    const f32x2 av = __builtin_elementwise_abs(v), d = av * 0.2316418882f + 1.0f;
    f32x2 t; t.x = __builtin_amdgcn_rcpf(d.x); t.y = __builtin_amdgcn_rcpf(d.y);
    f32x2 q = t * 0.5307027145f + (-0.7265760135f); q = q * t + 0.7107068705f; q = q * t + (-0.142248368f); q = q * t + 0.127414796f; q = q * t;
    const f32x2 s = (v * v) * (-0.72134752044f);
    f32x2 e; e.x = __builtin_amdgcn_exp2f(s.x); e.y = __builtin_amdgcn_exp2f(s.y);
    const f32x2 m = v * (q * e), r = v - m;
    f32x2 o; o.x = v.x < 0.f ? m.x : r.x; o.y = v.y < 0.f ? m.y : r.y; return o;
}

template <int ACT  > struct EpiBf16 {
    static constexpr bool PERM = true, AFTER_DRAIN = false; static_assert(ACT == 0 || ACT == 1, "EpiBf16: ACT is 0 (none) or 1 (gelu_pk)");
    bf16_t* O; int ldc; const float* bias; int split_cols; size_t split_stride; float scale0;
    __device__ __forceinline__ void operator()(const f32x4 (&acc)[2][2][4][2], const Unit& u, int wr, int wc, int fr, int fq) const {
        const int row0 = u.pm * BM + wr * 64 + fr; int colt = u.pn * BM; bf16_t* base = O;
        float sc = 1.f; if (split_cols) { const int t = colt / split_cols; base += (size_t)t * split_stride; colt -= t * split_cols; if (t == 0) sc = scale0; }
        const int col0 = colt + wc * 32 + 8 * fq, bcol0 = u.pn * BM + wc * 32 + 8 * fq;
        f32x4 bv[2][2];
#pragma unroll
        for (int bj = 0; bj < 2; ++bj)
#pragma unroll
            for (int n = 0; n < 2; ++n) bv[bj][n] = bias ? *(const f32x4*)(bias + bcol0 + bj * HALF + 4 * n) : (f32x4){0.f, 0.f, 0.f, 0.f};
#pragma unroll
        for (int ai = 0; ai < 2; ++ai)
#pragma unroll
            for (int m = 0; m < 4; ++m) { bf16_t* rowp = base + (size_t)(row0 + ai * HALF + m * 16) * ldc + col0;
#pragma unroll
                for (int bj = 0; bj < 2; ++bj) { f32x4 v0 = acc[ai][bj][m][0] + bv[bj][0], v1 = acc[ai][bj][m][1] + bv[bj][1];
                    if (ACT == 1) { f32x2 a = gelu_pk((f32x2){v0[0], v0[1]}), b = gelu_pk((f32x2){v0[2], v0[3]}), c = gelu_pk((f32x2){v1[0], v1[1]}), d = gelu_pk((f32x2){v1[2], v1[3]});
                        v0 = (f32x4){a.x, a.y, b.x, b.y}; v1 = (f32x4){c.x, c.y, d.x, d.y}; }
                    v0 = v0 * sc; v1 = v1 * sc; u32x4 w; w.x = cvt_pk_bf16(v0[0], v0[1]); w.y = cvt_pk_bf16(v0[2], v0[3]); w.z = cvt_pk_bf16(v1[0], v1[1]); w.w = cvt_pk_bf16(v1[2], v1[3]);
                    *(u32x4*)(rowp + bj * HALF) = w; } }
    }
};

struct PanelStats {
    unsigned* xbuf;
    unsigned* cnt;
    unsigned* tmo;
    int ntn; float eps;
    unsigned code;
    __device__ __forceinline__ bool run(const f32x4 (&v)[2][2][4][2], const Unit& u, int wr, int wc, int fr, int fq, PG8_LAS unsigned char* lds, int wid, int lane) const {
        typedef float f32x2v __attribute__((ext_vector_type(2)));
        PG8_LAS f32x2v* P = (PG8_LAS f32x2v*)lds;
        PG8_LAS f32x2v* S = (PG8_LAS f32x2v*)(lds + 8192);
        PG8_LAS unsigned* flag = (PG8_LAS unsigned*)(lds + 8192 + 2048);
#pragma unroll
        for (int ai = 0; ai < 2; ++ai)
#pragma unroll
            for (int m = 0; m < 4; ++m) {
                float s = 0.f;
#pragma unroll
                for (int bj = 0; bj < 2; ++bj)
#pragma unroll
                    for (int n = 0; n < 2; ++n) { const f32x4 x = v[ai][bj][m][n]; s += (x[0] + x[1]) + (x[2] + x[3]); }
                s += __shfl_xor(s, 16); s += __shfl_xor(s, 32);
                const float mw = s * (1.0f / 64.0f); float q = 0.f;
#pragma unroll
                for (int bj = 0; bj < 2; ++bj)
#pragma unroll
                    for (int n = 0; n < 2; ++n) { const f32x4 d = v[ai][bj][m][n] - mw; q += (d[0] * d[0] + d[1] * d[1]) + (d[2] * d[2] + d[3] * d[3]); }
                q += __shfl_xor(q, 16); q += __shfl_xor(q, 32);
                if (fq == 0) P[(ai * HALF + wr * 64 + m * 16 + fr) * 4 + wc] = (f32x2v){mw, q};
            }
        asm volatile("s_waitcnt lgkmcnt(0)" ::: "memory"); __builtin_amdgcn_s_barrier(); asm volatile("" ::: "memory");
#if defined(BROKEN_EXCHANGE_NO_WAIT)
#warning BROKEN CONTROL BUILD: the row-statistics exchange does not wait; results are wrong by design
        if (blockIdx.x >= 64) { const long long t0_ = clock64(); while (clock64() - t0_ < 60000) __builtin_amdgcn_s_sleep(8); }
#endif
        const int row = wid * 32 + (lane & 31);
        if (lane < 32) {
            const f32x2v a = P[row * 4 + 0], b = P[row * 4 + 1], c = P[row * 4 + 2], d = P[row * 4 + 3];
            const float mt = (a.x + b.x + c.x + d.x) * 0.25f;
            const float da = a.x - mt, db = b.x - mt, dc = c.x - mt, dd = d.x - mt;
            const float m2 = (a.y + b.y) + (c.y + d.y) + 64.0f * ((da * da + db * db) + (dc * dc + dd * dd));
            unsigned long long* slot = (unsigned long long*)xbuf + ((size_t)(u.pm * BM + row) * 4 + u.pn);
            __hip_atomic_store(slot, ((unsigned long long)__float_as_uint(m2) << 32) | __float_as_uint(mt), __ATOMIC_RELAXED, __HIP_MEMORY_SCOPE_AGENT);
        }
        asm volatile("s_waitcnt vmcnt(0)" ::: "memory");
        if (lane == 0) __hip_atomic_fetch_add(cnt + 64 * u.pm, 1u, __ATOMIC_RELAXED, __HIP_MEMORY_SCOPE_AGENT);
        if (wid == 0) {
            bool dead = false; const unsigned long long t0 = __builtin_amdgcn_s_memrealtime(); const unsigned want = 8u * (unsigned)ntn;
            for (;;) {
#if defined(BROKEN_EXCHANGE_NO_WAIT)
                break;
#endif
                if ((unsigned)__builtin_amdgcn_readfirstlane(__hip_atomic_load(cnt + 64 * u.pm, __ATOMIC_RELAXED, __HIP_MEMORY_SCOPE_AGENT)) >= want) break;
                if (__builtin_amdgcn_s_memrealtime() - t0 > 2000000ull) {
                    if (lane == 0) { unsigned expect = 0u; __hip_atomic_compare_exchange_strong(tmo + 1, &expect, code | (unsigned)(u.pm & 0xff), __ATOMIC_RELAXED, __ATOMIC_RELAXED, __HIP_MEMORY_SCOPE_AGENT);
                                     __hip_atomic_store(tmo, 1u, __ATOMIC_RELAXED, __HIP_MEMORY_SCOPE_AGENT); }
                    dead = true; break; }
                __builtin_amdgcn_s_sleep(2);
            }
            __builtin_amdgcn_fence(__ATOMIC_ACQUIRE, "agent");
            if (lane == 0) flag[0] = dead ? 1u : 0u;
        }
        asm volatile("s_waitcnt vmcnt(0) lgkmcnt(0)" ::: "memory"); __builtin_amdgcn_s_barrier(); asm volatile("" ::: "memory");
        const bool bad = flag[0] != 0u;
        if (lane < 32) {
            const unsigned long long* slot = (const unsigned long long*)xbuf + (size_t)(u.pm * BM + row) * 4; float mt[4], m2[4]; float ms = 0.f;
#pragma unroll
            for (int t = 0; t < 4; ++t) { if (t < ntn) { const unsigned long long w = __hip_atomic_load(slot + t, __ATOMIC_RELAXED, __HIP_MEMORY_SCOPE_AGENT); mt[t] = __uint_as_float((unsigned)w); m2[t] = __uint_as_float((unsigned)(w >> 32)); } else { mt[t] = 0.f; m2[t] = 0.f; } ms += mt[t]; }
            const float mean = ms / (float)ntn; float q = 0.f;
#pragma unroll
            for (int t = 0; t < 4; ++t) if (t < ntn) { const float dm = mt[t] - mean; q += m2[t] + 256.0f * dm * dm; }
            S[row] = (f32x2v){mean, 1.0f / sqrtf(q / (256.0f * (float)ntn) + eps)};
        }
        asm volatile("s_waitcnt lgkmcnt(0)" ::: "memory"); __builtin_amdgcn_s_barrier(); asm volatile("" ::: "memory");
        return bad;
    }
};
struct EpiLnRes {
    static constexpr bool PERM = false, AFTER_DRAIN = true;
    const float* base; float* out; int ldc; const float* bias; PanelStats st; unsigned poison;
    __device__ __forceinline__ void fused(f32x4 (&acc)[2][2][4][2], const Unit& u, int wr, int wc, int fr, int fq, PG8_LAS unsigned char* lds, int wid, int lane) const {
        typedef float f32x2v __attribute__((ext_vector_type(2)));
        const PG8_LAS f32x2v* S = (const PG8_LAS f32x2v*)(lds + 8192);
        const int col0 = u.pn * BM + wc * 32 + 4 * fq;
#pragma unroll
        for (int bj = 0; bj < 2; ++bj)
#pragma unroll
            for (int n = 0; n < 2; ++n) { const f32x4 bv = bias ? *(const f32x4*)(bias + col0 + bj * HALF + n * 16) : (f32x4){0.f, 0.f, 0.f, 0.f};
#pragma unroll
                for (int ai = 0; ai < 2; ++ai)
#pragma unroll
                    for (int m = 0; m < 4; ++m) acc[ai][bj][m][n] += bv; }
        f32x4 pre[4][2][2];
#pragma unroll
        for (int m = 0; m < 4; ++m) { const size_t off = (size_t)(u.pm * BM + wr * 64 + m * 16 + fr) * ldc + col0;
#pragma unroll
            for (int bj = 0; bj < 2; ++bj)
#pragma unroll
                for (int n = 0; n < 2; ++n) pre[m][bj][n] = *(const f32x4*)(base + off + bj * HALF + n * 16); }
        const bool bad = st.run(acc, u, wr, wc, fr, fq, lds, wid, lane) || poison != 0u;
        const float qnan = __builtin_nanf("");
#pragma unroll
        for (int ai = 0; ai < 2; ++ai)
#pragma unroll
            for (int m = 0; m < 4; ++m) { const int r = ai * HALF + wr * 64 + m * 16 + fr; const f32x2v sr = S[r]; const size_t off = (size_t)(u.pm * BM + r) * ldc + col0;
#pragma unroll
                for (int bj = 0; bj < 2; ++bj)
#pragma unroll
                    for (int n = 0; n < 2; ++n) { const f32x4 bs = ai == 0 ? pre[m][bj][n] : *(const f32x4*)(base + off + bj * HALF + n * 16); f32x4 o = bs + (acc[ai][bj][m][n] - sr.x) * sr.y;
                        if (bad) o = (f32x4){qnan, qnan, qnan, qnan}; *(f32x4*)(out + off + bj * HALF + n * 16) = o; }
                if (m & 1) asm volatile("" ::: "memory"); }
    }
};
struct EpiLnResLn {
    static constexpr bool PERM = false, AFTER_DRAIN = true;
    const float* base; float* out; bf16_t* xn; int ldc; const float* bias; PanelStats st1, st2; unsigned poison;
    __device__ __forceinline__ void fused(f32x4 (&acc)[2][2][4][2], const Unit& u, int wr, int wc, int fr, int fq, PG8_LAS unsigned char* lds, int wid, int lane) const {
        typedef float f32x2v __attribute__((ext_vector_type(2))); typedef unsigned u32x2v __attribute__((ext_vector_type(2)));
        const PG8_LAS f32x2v* S = (const PG8_LAS f32x2v*)(lds + 8192);
        const int col0 = u.pn * BM + wc * 32 + 4 * fq;
#pragma unroll
        for (int bj = 0; bj < 2; ++bj)
#pragma unroll
            for (int n = 0; n < 2; ++n) { const f32x4 bv = bias ? *(const f32x4*)(bias + col0 + bj * HALF + n * 16) : (f32x4){0.f, 0.f, 0.f, 0.f};
#pragma unroll
                for (int ai = 0; ai < 2; ++ai)
#pragma unroll
                    for (int m = 0; m < 4; ++m) acc[ai][bj][m][n] += bv; }
        bool bad = st1.run(acc, u, wr, wc, fr, fq, lds, wid, lane) || poison != 0u;
        const float qnan = __builtin_nanf("");
#pragma unroll
        for (int ai = 0; ai < 2; ++ai)
#pragma unroll
            for (int m = 0; m < 4; ++m) { const int r = ai * HALF + wr * 64 + m * 16 + fr; const f32x2v sr = S[r]; const size_t off = (size_t)(u.pm * BM + r) * ldc + col0;
#pragma unroll
                for (int bj = 0; bj < 2; ++bj)
#pragma unroll
                    for (int n = 0; n < 2; ++n) { const f32x4 bs = *(const f32x4*)(base + off + bj * HALF + n * 16); acc[ai][bj][m][n] = bs + (acc[ai][bj][m][n] - sr.x) * sr.y; }
                asm volatile("" : "+v"(acc[ai][0][m][0]), "+v"(acc[ai][0][m][1]), "+v"(acc[ai][1][m][0]), "+v"(acc[ai][1][m][1]));
                if (m & 1) asm volatile("" ::: "memory"); }
        const bool bad1 = bad;
        bad = st2.run(acc, u, wr, wc, fr, fq, lds, wid, lane) || bad;
#pragma unroll
        for (int ai = 0; ai < 2; ++ai)
#pragma unroll
            for (int m = 0; m < 4; ++m) { const int r = ai * HALF + wr * 64 + m * 16 + fr; const f32x2v sr = S[r]; const size_t off = (size_t)(u.pm * BM + r) * ldc + col0;
#pragma unroll
                for (int bj = 0; bj < 2; ++bj)
#pragma unroll
                    for (int n = 0; n < 2; ++n) { const f32x4 x1 = acc[ai][bj][m][n]; *(f32x4*)(out + off + bj * HALF + n * 16) = bad1 ? (f32x4){qnan, qnan, qnan, qnan} : x1;
                        const f32x4 o = (x1 - sr.x) * sr.y; u32x2v w; w.x = cvt_pk_bf16(o[0], o[1]); w.y = cvt_pk_bf16(o[2], o[3]);
                        if (bad) { w.x = 0x7fc07fc0u; w.y = 0x7fc07fc0u; } *(u32x2v*)(xn + off + bj * HALF + n * 16) = w; }
                asm volatile("" ::: "memory"); }
    }
};

template <class Epi, class Sched, bool ALIGN_EPI = false, bool SP2 = false>
__device__ __forceinline__ void gemm_phase(PG8_LAS unsigned char* lds, const Gemm g, const Sched& S, const Epi& E) {
    const int tid = tidx(), wid = __builtin_amdgcn_readfirstlane(tid >> 6), lane = tid & 63, wr = wid >> 2, wc = wid & 3, fr = lane & 15, fq = lane >> 4;
    const int K = g.K, nt = K / BK;
    unsigned voffA[2], voffB[2];
#pragma unroll
    for (int i = 0; i < 2; ++i) { int R, C; stage_rc(tid * 16 + i * 8192, R, C); const int Rb = Epi::PERM ? ((R & ~31) + perm32(R & 31)) : R;
        voffA[i] = (unsigned)(R * K + C) * 2u; voffB[i] = (unsigned)(Rb * K + C) * 2u; }
    const size_t kstep = (size_t)(BK * 2);
    const size_t hstep = (size_t)HALF * K * 2;
    const size_t tstep = 2 * hstep;
    const unsigned ldsw = (unsigned)wid * 1024u;
    const int aoff = lds_byte(wr * 64 + fr, fq * 8), boff = lds_byte(wc * 32 + fr, fq * 8);
#define PG8_SA(b, h) (((b) * 2 + (h)) * HTB)
#define PG8_SB(b, h) ((4 + (b) * 2 + (h)) * HTB)
#define PG8_STAGE(bufoff, gbase, voff) do { _Pragma("unroll") for (int _i = 0; _i < 2; ++_i) \
        __builtin_amdgcn_global_load_lds((const unsigned*)((const char*)(gbase) + (voff)[_i]), (PG8_LAS unsigned*)(lds + (bufoff) + ldsw + _i * 8192), 16, 0, 0); } while (0)
#define PG8_LDA(dst, b, h) do { _Pragma("unroll") for (int m = 0; m < 4; ++m) _Pragma("unroll") for (int k = 0; k < 2; ++k) dst[m][k] = *(const PG8_LAS bf16x8*)(lds + PG8_SA(b, h) + aoff + m * 2048 + k * 1024); } while (0)
#define PG8_LDB(dst, b, h) do { _Pragma("unroll") for (int n = 0; n < 2; ++n) _Pragma("unroll") for (int k = 0; k < 2; ++k) dst[n][k] = *(const PG8_LAS bf16x8*)(lds + PG8_SB(b, h) + boff + n * 2048 + k * 1024); } while (0)
#define PG8_MMA(ai, bj, At, Bt) do { __builtin_amdgcn_s_setprio(1); _Pragma("unroll") for (int m = 0; m < 4; ++m) _Pragma("unroll") for (int n = 0; n < 2; ++n) _Pragma("unroll") for (int k = 0; k < 2; ++k) \
        acc[ai][bj][m][n] = __builtin_amdgcn_mfma_f32_16x16x32_bf16(Bt[n][k], At[m][k], acc[ai][bj][m][n], 0, 0, 0); __builtin_amdgcn_s_setprio(0); } while (0)
#define PG8_WAIT_V(n) asm volatile("s_waitcnt vmcnt(" #n ")" ::: "memory")
#define PG8_WAIT_L(n) asm volatile("s_waitcnt lgkmcnt(" #n ")" ::: "memory")
#define PG8_BAR __builtin_amdgcn_s_barrier()
#define PG8_SCHED __builtin_amdgcn_sched_barrier(0)
    Unit cur, nxt; int ui = 0;
    if (!S.next(0, cur)) return;
    E.prefetch(cur, tid, lds + 135168);
    f32x4 acc[2][2][4][2];
#pragma unroll
    for (int a = 0; a < 2; ++a)
#pragma unroll
        for (int b = 0; b < 2; ++b)
#pragma unroll
            for (int m = 0; m < 4; ++m)
#pragma unroll
                for (int n = 0; n < 2; ++n) acc[a][b][m][n] = (f32x4){0.f, 0.f, 0.f, 0.f};
    bf16x8 At[4][2], B0[2][2], B1[2][2];
    const char* cA = (const char*)g.A + (size_t)cur.pm * tstep; const char* cB = (const char*)g.Bt + (size_t)cur.pn * tstep;
    S.a_ready(cur);
    if constexpr (SP2) {
        PG8_STAGE(PG8_SB(0, 0), cB, voffB); PG8_STAGE(PG8_SB(0, 1), cB + hstep, voffB); PG8_STAGE(PG8_SA(0, 0), cA, voffA); PG8_STAGE(PG8_SA(0, 1), cA + hstep, voffA);
        if (wr == 1) PG8_BAR;
        PG8_WAIT_V(2); PG8_BAR;
        PG8_STAGE(PG8_SB(1, 0), cB + kstep, voffB); PG8_STAGE(PG8_SA(1, 0), cA + kstep, voffA); PG8_STAGE(PG8_SB(1, 1), cB + hstep + kstep, voffB);
        PG8_WAIT_V(6); PG8_BAR;
    } else {
        PG8_STAGE(PG8_SB(0, 0), cB, voffB); PG8_STAGE(PG8_SA(0, 0), cA, voffA); PG8_STAGE(PG8_SB(0, 1), cB + hstep, voffB); PG8_STAGE(PG8_SA(0, 1), cA + hstep, voffA);
        if (wr == 1) PG8_BAR;
        PG8_WAIT_V(4); PG8_BAR;
        PG8_STAGE(PG8_SB(1, 0), cB + kstep, voffB); PG8_STAGE(PG8_SA(1, 0), cA + kstep, voffA); PG8_STAGE(PG8_SB(1, 1), cB + hstep + kstep, voffB);
        PG8_WAIT_V(6); PG8_BAR;
    }
    for (;;) {
        const bool has_next = S.next(ui + 1, nxt);
        const char* nA = has_next ? (const char*)g.A + (size_t)nxt.pm * tstep : cA; const char* nB = has_next ? (const char*)g.Bt + (size_t)nxt.pn * tstep : cB;
        for (int t = 0; t < nt; t += 2) {
            const bool last = (t == nt - 2);
            const char* a1 = cA + (size_t)(t + 1) * kstep;
            const char* a2 = last ? nA : cA + (size_t)(t + 2) * kstep; const char* b2 = last ? nB : cB + (size_t)(t + 2) * kstep;
            const char* a3 = a2 + kstep; const char* b3 = b2 + kstep;
            if (last && has_next) S.a_ready(nxt);
            if constexpr (SP2) {
            PG8_LDB(B0, 0, 0); PG8_LDB(B1, 0, 1); PG8_SCHED; PG8_LDA(At, 0, 0); PG8_STAGE(PG8_SA(1, 1), a1 + hstep, voffA);
            PG8_WAIT_V(8); PG8_WAIT_L(0); PG8_BAR; PG8_MMA(0, 0, At, B0); PG8_MMA(0, 1, At, B1); PG8_BAR; PG8_SCHED;
            PG8_LDA(At, 0, 1); PG8_STAGE(PG8_SB(0, 0), b2, voffB); PG8_STAGE(PG8_SB(0, 1), b2 + hstep, voffB); PG8_STAGE(PG8_SA(0, 0), a2, voffA);
            PG8_WAIT_V(8); PG8_WAIT_L(0); PG8_BAR; PG8_MMA(1, 0, At, B0); PG8_MMA(1, 1, At, B1); PG8_BAR; PG8_SCHED;
            PG8_LDB(B0, 1, 0); PG8_LDB(B1, 1, 1); PG8_SCHED; PG8_LDA(At, 1, 0); PG8_STAGE(PG8_SA(0, 1), a2 + hstep, voffA);
            PG8_WAIT_V(8); PG8_WAIT_L(0); PG8_BAR; PG8_MMA(0, 0, At, B0); PG8_MMA(0, 1, At, B1); PG8_BAR; PG8_SCHED;
            PG8_LDA(At, 1, 1); PG8_STAGE(PG8_SB(1, 0), b3, voffB); PG8_STAGE(PG8_SB(1, 1), b3 + hstep, voffB); PG8_STAGE(PG8_SA(1, 0), a3, voffA);
            PG8_WAIT_V(8); PG8_WAIT_L(0); PG8_BAR; PG8_MMA(1, 0, At, B0); PG8_MMA(1, 1, At, B1); PG8_BAR; PG8_SCHED;
            } else {
            PG8_LDB(B0, 0, 0); PG8_SCHED; PG8_LDA(At, 0, 0); PG8_STAGE(PG8_SA(1, 1), a1 + hstep, voffA);
            PG8_WAIT_L(8); PG8_BAR; PG8_WAIT_L(0); PG8_MMA(0, 0, At, B0); PG8_BAR; PG8_SCHED;
            PG8_LDB(B1, 0, 1); PG8_STAGE(PG8_SB(0, 0), b2, voffB);
            PG8_BAR; PG8_WAIT_L(0); PG8_MMA(0, 1, At, B1); PG8_BAR;
            PG8_LDA(At, 0, 1); PG8_STAGE(PG8_SA(0, 0), a2, voffA);
            PG8_BAR; PG8_WAIT_L(0); PG8_MMA(1, 0, At, B0); PG8_BAR; PG8_SCHED;
            PG8_STAGE(PG8_SB(0, 1), b2 + hstep, voffB);
            PG8_WAIT_V(6); PG8_BAR; PG8_MMA(1, 1, At, B1); PG8_BAR;
            PG8_LDB(B0, 1, 0); PG8_SCHED; PG8_LDA(At, 1, 0); PG8_STAGE(PG8_SA(0, 1), a2 + hstep, voffA);
            PG8_WAIT_L(8); PG8_BAR; PG8_WAIT_L(0); PG8_MMA(0, 0, At, B0); PG8_BAR; PG8_SCHED;
            PG8_LDB(B1, 1, 1); PG8_STAGE(PG8_SB(1, 0), b3, voffB);
            PG8_BAR; PG8_WAIT_L(0); PG8_MMA(0, 1, At, B1); PG8_BAR;
            PG8_LDA(At, 1, 1); PG8_STAGE(PG8_SA(1, 0), a3, voffA);
            PG8_BAR; PG8_WAIT_L(0); PG8_MMA(1, 0, At, B0); PG8_BAR; PG8_SCHED;
            PG8_STAGE(PG8_SB(1, 1), b3 + hstep, voffB);
            PG8_WAIT_V(6); PG8_BAR; PG8_MMA(1, 1, At, B1); PG8_BAR;
            }
        }
        if constexpr (ALIGN_EPI) { if (wr == 0) PG8_BAR; }
        if constexpr (!Epi::AFTER_DRAIN) { E(acc, cur, wr, wc, fr, fq, lds + 135168 + (ui & 1) * 4096); if (has_next) E.prefetch(nxt, tid, lds + 135168 + ((ui + 1) & 1) * 4096); S.done(cur); }
        if (!has_next) break;
#pragma unroll
        for (int a = 0; a < 2; ++a)
#pragma unroll
            for (int b = 0; b < 2; ++b)
#pragma unroll
                for (int m = 0; m < 4; ++m)
#pragma unroll
                    for (int n = 0; n < 2; ++n) acc[a][b][m][n] = (f32x4){0.f, 0.f, 0.f, 0.f};
        cur = nxt; cA = nA; cB = nB; ++ui;
        if constexpr (ALIGN_EPI) { if (wr == 1) PG8_BAR; }
    }
    PG8_WAIT_V(0);
    if constexpr (!ALIGN_EPI) { if (wr == 0) PG8_BAR; }
    PG8_BAR;
    if constexpr (Epi::AFTER_DRAIN) { E.fused(acc, cur, wr, wc, fr, fq, lds, wid, lane); S.done(cur); }
#undef PG8_SA
#undef PG8_SB
#undef PG8_STAGE
#undef PG8_LDA
#undef PG8_LDB
#undef PG8_MMA
#undef PG8_WAIT_V
#undef PG8_WAIT_L
#undef PG8_BAR
#undef PG8_SCHED
}
}

#define LAS __attribute__((address_space(3)))
typedef unsigned short bf16_t;
typedef short bf16x8 __attribute__((ext_vector_type(8)));
typedef short s16x4 __attribute__((ext_vector_type(4)));
typedef short v4i16_t __attribute__((ext_vector_type(4)));
typedef float f32x4 __attribute__((ext_vector_type(4)));
typedef float f32x16 __attribute__((ext_vector_type(16)));
typedef unsigned u32x4 __attribute__((ext_vector_type(4)));
typedef unsigned u32x2 __attribute__((ext_vector_type(2)));

constexpr int DM = 1024, NB = 8, SEQ = 8192, NMETA = 16, LSEQ = SEQ + NMETA, MREAL = NB * SEQ, MROW0 = MREAL, MPAD = MREAL + 256;
constexpr int FF = 2816, NPB = 3584, NPBW = 3840, DPROJ = 5640;
constexpr int NCH = 65;
constexpr float ALPHA = 1.41421356237f;
constexpr float LOG2E = 1.4426950408889634f;
constexpr float QSCALE = 0.125f * LOG2E;
constexpr float NEGF = -1e30f;
constexpr float LN_EPS = 1e-5f;

constexpr size_t OW_GU1 = 0, OW_D1 = 5767168, OW_PB = 8650752, OW_GM = 12582912, OW_BM = 14680064, OW_BA = 15204352, OW_OUT = 15728640, OW_GU2 = 16777216, OW_D2 = 22544384, OW_LAYER = 25427968;
constexpr int OC_GU1 = 0, OC_PB = 5632, OC_GM = 9472, OC_GU2 = 11520, OC_N = 17152;
constexpr size_t MiB = 1u << 20;
constexpr size_t WS_ROWS = 0;
constexpr size_t WS_CSBW = 4 * MiB;
constexpr size_t WS_HFM = 5 * MiB;
constexpr size_t WS_GATES = 6 * MiB;
constexpr size_t WS_BAR = 9 * MiB;
constexpr size_t WS_KM = WS_BAR + 16384;
constexpr size_t WS_SC = 10 * MiB;
constexpr size_t WS_NST = 11 * MiB;
constexpr size_t WS_STATS = 13 * MiB;
constexpr size_t WS_W = 16 * MiB;
constexpr size_t WS_HB = 113 * MiB;
constexpr size_t WS_LO = 242 * MiB;
constexpr size_t WS_CST = 371 * MiB;
constexpr size_t WS_MA = 436 * MiB;
constexpr size_t WS_BIG = 565 * MiB;
constexpr size_t WS_END = 1015 * MiB;

struct Params {
    const float* in[28];
    float* out; unsigned char* ws;
};

__device__ __forceinline__ unsigned f2bf(float f) { unsigned u = __builtin_bit_cast(unsigned, f); return (u + 0x7fffu + ((u >> 16) & 1u)) >> 16; }
typedef float f32x2_t __attribute__((ext_vector_type(2))); typedef __bf16 bf16x2_t __attribute__((ext_vector_type(2)));
__device__ __forceinline__ unsigned pk2(float lo, float hi) { f32x2_t v = {lo, hi}; bf16x2_t b = __builtin_convertvector(v, bf16x2_t); return __builtin_bit_cast(unsigned, b); }
__device__ __forceinline__ u32x4 pack8(f32x4 a, f32x4 b) { u32x4 w; w.x = pk2(a[0], a[1]); w.y = pk2(a[2], a[3]); w.z = pk2(b[0], b[1]); w.w = pk2(b[2], b[3]); return w; }
__device__ __forceinline__ float bflo(unsigned w) { return __builtin_bit_cast(float, w << 16); }
__device__ __forceinline__ float bfhi(unsigned w) { return __builtin_bit_cast(float, w & 0xffff0000u); }
__device__ __forceinline__ float ex2(float x) { return __builtin_amdgcn_exp2f(x); }
__device__ __forceinline__ float sigm(float x) { return __builtin_amdgcn_rcpf(1.f + ex2(-x * LOG2E)); }
__device__ __forceinline__ float siluf(float x) { return x * sigm(x); }
__device__ __forceinline__ float wave_sum(float v) {
#pragma unroll
    for (int o = 1; o < 64; o <<= 1) v += __shfl_xor(v, o);
    return v;
}
__device__ __forceinline__ float wave_max(float v) {
#pragma unroll
    for (int o = 1; o < 64; o <<= 1) v = fmaxf(v, __shfl_xor(v, o));
    return v;
}
__device__ __forceinline__ size_t seqrow(int b, int pos) { return pos < NMETA ? (size_t)(MROW0 + pos) : (size_t)b * SEQ + (size_t)(pos - NMETA); }
__device__ __forceinline__ f32x16 mfma32(bf16x8 a, bf16x8 b, f32x16 c) { return __builtin_amdgcn_mfma_f32_32x32x16_bf16(a, b, c, 0, 0, 0); }
__device__ __forceinline__ s16x4 vtr(const LAS unsigned char* p) { return __builtin_bit_cast(s16x4, __builtin_amdgcn_ds_read_tr16_b64_v4i16((LAS v4i16_t*)p)); }
__device__ __forceinline__ bf16x8 cat8(s16x4 lo, s16x4 hi) { return (bf16x8){lo[0], lo[1], lo[2], lo[3], hi[0], hi[1], hi[2], hi[3]}; }

namespace pg8 {
__device__ __forceinline__ void tab_prefetch(const float* rows, const float* v0, const float* v1, int pm, int cbase, int tid, PG8_LAS unsigned char* tab) {
    const int wid = __builtin_amdgcn_readfirstlane(tid >> 6), lane = tid & 63;
    if (rows) __builtin_amdgcn_global_load_lds((const unsigned*)(rows + (size_t)pm * 512 + tid), (PG8_LAS unsigned*)(tab + wid * 256), 4, 0, 0);
    const float* src = (wid < 4 ? v0 + (wid * 64 + lane) : v1 + ((wid - 4) * 64 + lane)) + cbase;
    __builtin_amdgcn_global_load_lds((const unsigned*)src, (PG8_LAS unsigned*)(tab + 2048 + wid * 256), 4, 0, 0);
}
__device__ __forceinline__ void tab_ready() { asm volatile("s_waitcnt vmcnt(14)" ::: "memory"); __builtin_amdgcn_s_barrier(); asm volatile("" ::: "memory"); }
__device__ __forceinline__ void tab_stats(const PG8_LAS unsigned char* tab, int rloc, float& mu, float& r) {
    const f32x2_t st = *(const PG8_LAS f32x2_t*)(tab + rloc * 8); mu = st.x * (1.f / DM); r = __builtin_amdgcn_rsqf(st.y * (1.f / DM) - mu * mu + LN_EPS);
}
struct LnFix {
    const float* rows; const float* cs; const float* bw; int on;
    __device__ __forceinline__ void stats(size_t row, float& mu, float& r) const {
        const f32x2_t st = *(const f32x2_t*)(rows + row * 2); mu = st.x * (1.f / DM); r = __builtin_amdgcn_rsqf(st.y * (1.f / DM) - mu * mu + LN_EPS);
    }
};
struct EpiSwiglu {
    static constexpr bool PERM = true, AFTER_DRAIN = false;
    bf16_t* O; int ldc; LnFix fx;
    __device__ __forceinline__ void prefetch(const Unit& u, int tid, PG8_LAS unsigned char* tab) const { if (fx.on) tab_prefetch(fx.rows, fx.cs, fx.bw, u.pm, u.pn * BM, tid, tab); }
    __device__ __forceinline__ void operator()(const f32x4 (&acc)[2][2][4][2], const Unit& u, int wr, int wc, int fr, int fq, const PG8_LAS unsigned char* tab) const {
        const int row0 = u.pm * BM + wr * 64 + fr, col0 = u.pn * 128 + wc * 32 + 8 * fq, cl = wc * 32 + 8 * fq;
        if (fx.on) tab_ready();
#pragma unroll
        for (int ai = 0; ai < 2; ++ai)
#pragma unroll
            for (int m = 0; m < 4; ++m) {
                const size_t row = (size_t)(row0 + ai * HALF + m * 16);
                float mu = 0.f, r = 1.f; if (fx.on) tab_stats(tab, wr * 64 + fr + ai * HALF + m * 16, mu, r);
                u32x4 w;
#pragma unroll
                for (int n = 0; n < 2; ++n) {
                    f32x4 csg = {0.f, 0.f, 0.f, 0.f}, bwg = csg, csu = csg, bwu = csg;
                    if (fx.on) { csg = *(const PG8_LAS f32x4*)(tab + 2048 + (cl + 4 * n) * 4); bwg = *(const PG8_LAS f32x4*)(tab + 3072 + (cl + 4 * n) * 4); csu = *(const PG8_LAS f32x4*)(tab + 2048 + (cl + HALF + 4 * n) * 4); bwu = *(const PG8_LAS f32x4*)(tab + 3072 + (cl + HALF + 4 * n) * 4); }
                    const f32x4 g = (acc[ai][0][m][n] - csg * mu) * r + bwg, up = (acc[ai][1][m][n] - csu * mu) * r + bwu;
                    const unsigned lo = pk2(siluf(g[0]) * up[0], siluf(g[1]) * up[1]), hi = pk2(siluf(g[2]) * up[2], siluf(g[3]) * up[3]);
                    if (n == 0) { w.x = lo; w.y = hi; } else { w.z = lo; w.w = hi; }
                }
                *(u32x4*)(O + row * ldc + col0) = w;
            }
    }
};
struct EpiPlain {
    static constexpr bool PERM = true, AFTER_DRAIN = false;
    bf16_t* O; int ldc; int coff; int slo, shi; float scale; LnFix fx; float* GT; const float* bif;
    __device__ __forceinline__ void prefetch(const Unit& u, int tid, PG8_LAS unsigned char* tab) const { if (fx.on) tab_prefetch(fx.rows, fx.cs, fx.bw, u.pm, u.pn * BM, tid, tab); }
    __device__ __forceinline__ void operator()(const f32x4 (&acc)[2][2][4][2], const Unit& u, int wr, int wc, int fr, int fq, const PG8_LAS unsigned char* tab) const {
        const int row0 = u.pm * BM + wr * 64 + fr, col0 = coff + u.pn * BM + wc * 32 + 8 * fq, cl = wc * 32 + 8 * fq;
        if (fx.on) tab_ready();
        if (GT && u.pn == 14) {
            if (wc == 0 && fq == 0) {
                const f32x4 cs0 = *(const PG8_LAS f32x4*)(tab + 2048 + cl * 4), cs1 = *(const PG8_LAS f32x4*)(tab + 2048 + (cl + 4) * 4);
                const f32x4 bw0 = *(const PG8_LAS f32x4*)(tab + 3072 + cl * 4) + *(const f32x4*)(bif), bw1 = *(const PG8_LAS f32x4*)(tab + 3072 + (cl + 4) * 4) + *(const f32x4*)(bif + 4);
#pragma unroll
                for (int ai = 0; ai < 2; ++ai)
#pragma unroll
                    for (int m = 0; m < 4; ++m) {
                        const size_t row = (size_t)(row0 + ai * HALF + m * 16);
                        float mu, r; tab_stats(tab, wr * 64 + fr + ai * HALF + m * 16, mu, r);
                        const f32x4 li = (acc[ai][0][m][0] - cs0 * mu) * r + bw0, z = (acc[ai][0][m][1] - cs1 * mu) * r + bw1;
                        f32x4 lf;
#pragma unroll
                        for (int e = 0; e < 4; ++e) lf[e] = fminf(z[e], 0.f) - __logf(1.f + __expf(-fabsf(z[e])));
                        *(f32x4*)(GT + row * 8) = li; *(f32x4*)(GT + row * 8 + 4) = lf;
                    }
            }
            return;
        }
        const float sc = (u.pn >= slo && u.pn < shi) ? scale : 1.f;
#pragma unroll
        for (int ai = 0; ai < 2; ++ai)
#pragma unroll
            for (int m = 0; m < 4; ++m) {
                const size_t row = (size_t)(row0 + ai * HALF + m * 16);
                float mu = 0.f, r = 1.f; if (fx.on) tab_stats(tab, wr * 64 + fr + ai * HALF + m * 16, mu, r);
#pragma unroll
                for (int bj = 0; bj < 2; ++bj) {
                    u32x4 w;
#pragma unroll
                    for (int n = 0; n < 2; ++n) {
                        f32x4 cs4 = {0.f, 0.f, 0.f, 0.f}, bw4 = cs4;
                        if (fx.on) { cs4 = *(const PG8_LAS f32x4*)(tab + 2048 + (cl + bj * HALF + 4 * n) * 4); bw4 = *(const PG8_LAS f32x4*)(tab + 3072 + (cl + bj * HALF + 4 * n) * 4); }
                        const f32x4 v = ((acc[ai][bj][m][n] - cs4 * mu) * r + bw4) * sc;
                        if (n == 0) { w.x = pk2(v[0], v[1]); w.y = pk2(v[2], v[3]); } else { w.z = pk2(v[0], v[1]); w.w = pk2(v[2], v[3]); }
                    }
                    *(u32x4*)(O + row * ldc + col0 + bj * HALF) = w;
                }
            }
    }
};
struct EpiResid {
    static constexpr bool PERM = true, AFTER_DRAIN = false;
    const float* src; bf16_t* LO; bf16_t* HB; const float* rows_prev; float* rows_cur; const float* gam; const float* bet; float s; int raw;
    __device__ __forceinline__ void prefetch(const Unit& u, int tid, PG8_LAS unsigned char* tab) const { if (!raw) tab_prefetch(rows_prev, gam, bet, u.pm, u.pn * BM, tid, tab); }
    __device__ __forceinline__ void operator()(const f32x4 (&acc)[2][2][4][2], const Unit& u, int wr, int wc, int fr, int fq, const PG8_LAS unsigned char* tab) const {
        const int row0 = u.pm * BM + wr * 64 + fr, col0 = u.pn * BM + wc * 32 + 8 * fq, cl = wc * 32 + 8 * fq;
        if (!raw) tab_ready();
#pragma unroll
        for (int ai = 0; ai < 2; ++ai)
#pragma unroll
            for (int m = 0; m < 4; ++m) {
                const size_t row = (size_t)(row0 + ai * HALF + m * 16);
                float mu = 0.f, rs = 1.f;
                if (!raw) tab_stats(tab, wr * 64 + fr + ai * HALF + m * 16, mu, rs);
                const float ar = ALPHA * rs, am = -ALPHA * rs * mu;
                float s1 = 0.f, s2 = 0.f;
#pragma unroll
                for (int bj = 0; bj < 2; ++bj) {
                    f32x4 g0 = {1.f, 1.f, 1.f, 1.f}, g1 = g0, b0 = {0.f, 0.f, 0.f, 0.f}, b1 = b0;
                    if (!raw) { g0 = *(const PG8_LAS f32x4*)(tab + 2048 + (cl + bj * HALF) * 4); g1 = *(const PG8_LAS f32x4*)(tab + 2048 + (cl + bj * HALF + 4) * 4); b0 = *(const PG8_LAS f32x4*)(tab + 3072 + (cl + bj * HALF) * 4); b1 = *(const PG8_LAS f32x4*)(tab + 3072 + (cl + bj * HALF + 4) * 4); }
                    f32x4 x0, x1;
                    if (raw) { x0 = *(const f32x4*)(src + row * DM + col0 + bj * HALF); x1 = *(const f32x4*)(src + row * DM + col0 + bj * HALF + 4); }
                    else { const u32x4 hi = *(const u32x4*)(HB + row * DM + col0 + bj * HALF), lo = *(const u32x4*)(LO + row * DM + col0 + bj * HALF);
                        x0 = (f32x4){bflo(hi.x) + bflo(lo.x), bfhi(hi.x) + bfhi(lo.x), bflo(hi.y) + bflo(lo.y), bfhi(hi.y) + bfhi(lo.y)};
                        x1 = (f32x4){bflo(hi.z) + bflo(lo.z), bfhi(hi.z) + bfhi(lo.z), bflo(hi.w) + bflo(lo.w), bfhi(hi.w) + bfhi(lo.w)}; }
                    const f32x4 o0 = (x0 * ar + am) * g0 + b0 * ALPHA + acc[ai][bj][m][0] * s, o1 = (x1 * ar + am) * g1 + b1 * ALPHA + acc[ai][bj][m][1] * s;
                    const u32x4 nh = pack8(o0, o1);
                    const f32x4 d0 = {o0[0] - bflo(nh.x), o0[1] - bfhi(nh.x), o0[2] - bflo(nh.y), o0[3] - bfhi(nh.y)}, d1 = {o1[0] - bflo(nh.z), o1[1] - bfhi(nh.z), o1[2] - bflo(nh.w), o1[3] - bfhi(nh.w)};
                    *(u32x4*)(HB + row * DM + col0 + bj * HALF) = nh; *(u32x4*)(LO + row * DM + col0 + bj * HALF) = pack8(d0, d1);
                    s1 += ((o0[0] + o0[1]) + (o0[2] + o0[3])) + ((o1[0] + o1[1]) + (o1[2] + o1[3]));
                    s2 += ((o0[0] * o0[0] + o0[1] * o0[1]) + (o0[2] * o0[2] + o0[3] * o0[3])) + ((o1[0] * o1[0] + o1[1] * o1[1]) + (o1[2] * o1[2] + o1[3] * o1[3]));
                }
                s1 += __shfl_xor(s1, 16); s1 += __shfl_xor(s1, 32); s2 += __shfl_xor(s2, 16); s2 += __shfl_xor(s2, 32);
                if (fq == 0) { float* rp = rows_cur + row * 2; atomicAdd(rp, s1); atomicAdd(rp + 1, s2); }
                asm volatile("" ::: "memory");
            }
    }
};
struct EpiGate {
    static constexpr bool PERM = true, AFTER_DRAIN = false;
    bf16_t* U; const bf16_t* Y; const float* bg; LnFix fx;
    __device__ __forceinline__ void prefetch(const Unit& u, int tid, PG8_LAS unsigned char* tab) const { tab_prefetch(fx.rows, fx.cs, fx.bw, u.pm, u.pn * BM, tid, tab); }
    __device__ __forceinline__ void operator()(const f32x4 (&acc)[2][2][4][2], const Unit& u, int wr, int wc, int fr, int fq, const PG8_LAS unsigned char* tab) const {
        const int row0 = u.pm * BM + wr * 64 + fr, col0 = u.pn * 128 + wc * 32 + 8 * fq, cl = wc * 32 + 8 * fq;
        tab_ready();
#pragma unroll
        for (int ai = 0; ai < 2; ++ai)
#pragma unroll
            for (int m = 0; m < 4; ++m) {
                const size_t row = (size_t)(row0 + ai * HALF + m * 16);
                float mu, r; tab_stats(tab, wr * 64 + fr + ai * HALF + m * 16, mu, r);
                const u32x4 ym = *(const u32x4*)(Y + row * 2048 + col0), ya = *(const u32x4*)(Y + row * 2048 + DM + col0);
                u32x4 w;
#pragma unroll
                for (int n = 0; n < 2; ++n) {
                    const f32x4 csm = *(const PG8_LAS f32x4*)(tab + 2048 + (cl + 4 * n) * 4), bm = *(const PG8_LAS f32x4*)(tab + 3072 + (cl + 4 * n) * 4);
                    const f32x4 csa = *(const PG8_LAS f32x4*)(tab + 2048 + (cl + HALF + 4 * n) * 4), ba = *(const PG8_LAS f32x4*)(tab + 3072 + (cl + HALF + 4 * n) * 4);
                    const f32x4 gm = (acc[ai][0][m][n] - csm * mu) * r + bm, ga = (acc[ai][1][m][n] - csa * mu) * r + ba;
                    const unsigned y0 = n ? ym.z : ym.x, y1 = n ? ym.w : ym.y, a0 = n ? ya.z : ya.x, a1 = n ? ya.w : ya.y;
                    const unsigned lo = pk2(sigm(gm[0]) * bflo(y0) + sigm(ga[0]) * bflo(a0), sigm(gm[1]) * bfhi(y0) + sigm(ga[1]) * bfhi(a0));
                    const unsigned hi = pk2(sigm(gm[2]) * bflo(y1) + sigm(ga[2]) * bflo(a1), sigm(gm[3]) * bfhi(y1) + sigm(ga[3]) * bfhi(a1));
                    if (n == 0) { w.x = lo; w.y = hi; } else { w.z = lo; w.w = hi; }
                }
                *(u32x4*)(U + row * DM + col0) = w;
            }
    }
};
}

__device__ __forceinline__ f32x4 sg_tile(const bf16_t* A, int lda, const bf16_t* Bt, int K, int n0, int lane) {
    const bf16_t* ap = A + (size_t)(lane & 15) * lda + 8 * (lane >> 4);
    const bf16_t* bp = Bt + (size_t)(n0 + (lane & 15)) * K + 8 * (lane >> 4);
    f32x4 acc = {0.f, 0.f, 0.f, 0.f};
#pragma unroll 8
    for (int k = 0; k < K; k += 32) {
        const bf16x8 a = *(const bf16x8*)(ap + k), b = *(const bf16x8*)(bp + k);
        acc = __builtin_amdgcn_mfma_f32_16x16x32_bf16(a, b, acc, 0, 0, 0);
    }
    return acc;
}

__device__ __forceinline__ f32x4 sg_tile_blk(const bf16_t* A, int lda, const bf16_t* Bt, int K, int n0, int lane, int wid, LAS float* red) {
    const int K8 = K >> 3;
    const bf16_t* ap = A + (size_t)(lane & 15) * lda + 8 * (lane >> 4) + wid * K8;
    const bf16_t* bp = Bt + (size_t)(n0 + (lane & 15)) * K + 8 * (lane >> 4) + wid * K8;
    f32x4 acc = {0.f, 0.f, 0.f, 0.f};
#pragma unroll 1
    for (int k = 0; k < K8; k += 128) {
        bf16x8 av[4], bv[4];
#pragma unroll
        for (int j = 0; j < 4; ++j) { const int kk = k + 32 * j < K8 ? k + 32 * j : k; av[j] = *(const bf16x8*)(ap + kk); bv[j] = *(const bf16x8*)(bp + kk); }
        asm volatile("" : "+v"(av[0]), "+v"(av[1]), "+v"(av[2]), "+v"(av[3]), "+v"(bv[0]), "+v"(bv[1]), "+v"(bv[2]), "+v"(bv[3]));
#pragma unroll
        for (int j = 0; j < 4; ++j) if (k + 32 * j < K8) acc = __builtin_amdgcn_mfma_f32_16x16x32_bf16(av[j], bv[j], acc, 0, 0, 0);
    }
    *(LAS f32x4*)(red + wid * 256 + lane * 4) = acc;
    __syncthreads();
    f32x4 sum = {0.f, 0.f, 0.f, 0.f};
    if (wid == 0) {
#pragma unroll
        for (int w = 0; w < 8; ++w) sum = sum + *(const LAS f32x4*)(red + w * 256 + lane * 4);
    }
    __syncthreads();
    return sum;
}

__device__ __forceinline__ void tr_rows(const float* Wsrc, int ldw, int K, bf16_t* dst, int kb0, int nkb, int nv4, const float* g, const float* bb, float* cs, float* bw, LAS float* scr, int lane, const float* addb = nullptr) {
    float csp[4] = {0.f, 0.f, 0.f, 0.f}, bwp[4] = {0.f, 0.f, 0.f, 0.f};
    const int c = lane & 7;
#pragma unroll 1
    for (int kb = kb0; kb < kb0 + nkb; ++kb) {
        const int k0 = 64 * kb;
        f32x4 vv[8];
        const bool okl = (lane & 7) < nv4; const int n4 = (lane & 7) * 4;
#pragma unroll
        for (int i = 0; i < 8; ++i) vv[i] = *(const f32x4*)(Wsrc + (size_t)(k0 + 8 * i + (lane >> 3)) * ldw + (okl ? n4 : 0));
        asm volatile("" : "+v"(vv[0]), "+v"(vv[1]), "+v"(vv[2]), "+v"(vv[3]), "+v"(vv[4]), "+v"(vv[5]), "+v"(vv[6]), "+v"(vv[7]));
#pragma unroll
        for (int i = 0; i < 8; ++i) { const int kk = 8 * i + (lane >> 3); f32x4 v = vv[i]; if (!okl) v = (f32x4){0.f, 0.f, 0.f, 0.f};
            scr[kk * 33 + n4] = v[0]; scr[kk * 33 + n4 + 1] = v[1]; scr[kk * 33 + n4 + 2] = v[2]; scr[kk * 33 + n4 + 3] = v[3]; }
        f32x4 g0 = {1.f, 1.f, 1.f, 1.f}, g1 = g0, b0 = {0.f, 0.f, 0.f, 0.f}, b1 = b0;
        if (g) { g0 = *(const f32x4*)(g + k0 + 8 * c); g1 = *(const f32x4*)(g + k0 + 8 * c + 4); b0 = *(const f32x4*)(bb + k0 + 8 * c); b1 = *(const f32x4*)(bb + k0 + 8 * c + 4); }
        asm volatile("s_waitcnt lgkmcnt(0)" ::: "memory");
#pragma unroll
        for (int j = 0; j < 4; ++j) {
            const int n = (lane >> 3) + 8 * j; const LAS float* sp = scr + (8 * c) * 33 + n;
            const float x0 = sp[0 * 33], x1 = sp[1 * 33], x2 = sp[2 * 33], x3 = sp[3 * 33], x4 = sp[4 * 33], x5 = sp[5 * 33], x6 = sp[6 * 33], x7 = sp[7 * 33];
            u32x4 o; o.x = pk2(x0 * g0[0], x1 * g0[1]); o.y = pk2(x2 * g0[2], x3 * g0[3]); o.z = pk2(x4 * g1[0], x5 * g1[1]); o.w = pk2(x6 * g1[2], x7 * g1[3]);
            *(u32x4*)(dst + (size_t)n * K + k0 + 8 * c) = o;
            csp[j] += ((bflo(o.x) + bfhi(o.x)) + (bflo(o.y) + bfhi(o.y))) + ((bflo(o.z) + bfhi(o.z)) + (bflo(o.w) + bfhi(o.w)));
            bwp[j] += ((x0 * b0[0] + x1 * b0[1]) + (x2 * b0[2] + x3 * b0[3])) + ((x4 * b1[0] + x5 * b1[1]) + (x6 * b1[2] + x7 * b1[3]));
        }
        asm volatile("s_waitcnt lgkmcnt(0)" ::: "memory");
    }
    if (g) {
#pragma unroll
        for (int j = 0; j < 4; ++j) {
            float a = csp[j], b = bwp[j];
            a += __shfl_xor(a, 1); a += __shfl_xor(a, 2); a += __shfl_xor(a, 4); b += __shfl_xor(b, 1); b += __shfl_xor(b, 2); b += __shfl_xor(b, 4);
            if (c == 0) { cs[(lane >> 3) + 8 * j] = a; bw[(lane >> 3) + 8 * j] = b + (addb ? addb[(lane >> 3) + 8 * j] : 0.f); }
        }
    }
}
constexpr int CW_ITEMS = 824;
__device__ __forceinline__ void conv_weight_item(const Params& P, int layer, int it, LAS float* scr, int lane) {
    bf16_t* W = (bf16_t*)(P.ws + WS_W) + (size_t)layer * OW_LAYER;
    float* CS = (float*)(P.ws + WS_CSBW) + (size_t)layer * 2 * OC_N; float* BW = CS + OC_N;
    const float* wg1 = P.in[2] + (size_t)layer * DM * FF; const float* wu1 = P.in[3] + (size_t)layer * DM * FF; const float* wd1 = P.in[4] + (size_t)layer * FF * DM;
    const float* win = P.in[7] + (size_t)layer * DM * DPROJ;
    const float* wbm = P.in[17] + (size_t)layer * 512 * DM; const float* wba = P.in[18] + (size_t)layer * 512 * DM; const float* wout = P.in[20] + (size_t)layer * DM * DM;
    const float* wg2 = P.in[23] + (size_t)layer * DM * FF; const float* wu2 = P.in[24] + (size_t)layer * DM * FF; const float* wd2 = P.in[25] + (size_t)layer * FF * DM;
    const float* ln1g = P.in[5] + (size_t)layer * DM; const float* ln1b = P.in[6] + (size_t)layer * DM;
    const float* ln2g = P.in[21] + (size_t)layer * DM; const float* ln2b = P.in[22] + (size_t)layer * DM;
    const float* ln3g = layer ? P.in[26] + (size_t)(layer - 1) * DM : nullptr; const float* ln3b = layer ? P.in[27] + (size_t)(layer - 1) * DM : nullptr;
    int r = it;
    if (r < 352) {
        const int second = r >= 176; if (second) r -= 176;
        const int R0 = 32 * r, pn = R0 >> 8, sgu = (R0 >> 7) & 1, i = R0 & 127;
        const float* src = (second ? (sgu ? wu2 : wg2) : (sgu ? wu1 : wg1)) + 128 * pn + i;
        const int oc = second ? OC_GU2 : OC_GU1;
        tr_rows(src, FF, DM, W + (second ? OW_GU2 : OW_GU1) + (size_t)R0 * DM, 0, 16, 8, second ? ln2g : ln3g, second ? ln2b : ln3b, CS + oc + R0, BW + oc + R0, scr, lane); return;
    }
    r -= 352;
    if (r < 192) {
        const int second = r >= 96; if (second) r -= 96;
        const int nb = r / 3, seg = r % 3, R0 = 32 * nb;
        tr_rows((second ? wd2 : wd1) + R0, DM, FF, W + (second ? OW_D2 : OW_D1) + (size_t)R0 * FF, 16 * seg, seg == 2 ? 12 : 16, 8, nullptr, nullptr, nullptr, nullptr, scr, lane); return;
    }
    r -= 192;
    if (r < 120) {
        const int R0 = 32 * r, csrc = R0 < 2048 ? R0 : (R0 < 3584 ? R0 + 8 : 2048);
        tr_rows(win + csrc, DPROJ, DM, W + OW_PB + (size_t)R0 * DM, 0, 16, R0 < 3584 ? 8 : (R0 == 3584 ? 2 : 0), ln1g, ln1b, CS + OC_PB + R0, BW + OC_PB + R0, scr, lane); return;
    }
    r -= 120;
    if (r < 64) {
        const int R0 = 32 * r, pn = R0 >> 8, sg = (R0 >> 7) & 1, i = R0 & 127, csrc = 3592 + 1024 * sg + 128 * pn + i;
        tr_rows(win + csrc, DPROJ, DM, W + OW_GM + (size_t)R0 * DM, 0, 16, 8, ln1g, ln1b, CS + OC_GM + R0, BW + OC_GM + R0, scr, lane, P.in[19] + (size_t)layer * 2048 + 1024 * sg + 128 * pn + i); return;
    }
    r -= 64;
    if (r < 64) {
        const int second = r >= 32; if (second) r -= 32;
        const int R0 = 32 * r;
        tr_rows((second ? wba : wbm) + R0, DM, 512, W + (second ? OW_BA : OW_BM) + (size_t)R0 * 512, 0, 8, 8, nullptr, nullptr, nullptr, nullptr, scr, lane); return;
    }
    r -= 64;
    { const int R0 = 32 * r; tr_rows(wout + R0, DM, DM, W + OW_OUT + (size_t)R0 * DM, 0, 16, 8, nullptr, nullptr, nullptr, nullptr, scr, lane); }
}

__device__ __forceinline__ void ln_row(const f32x4 (&vin)[4], int row, float* hf, const f32x4 (&gv)[4], const f32x4 (&bv)[4], bool gates, bool fin, const float* bif_l, LAS float* gwl, bf16_t* HB, float* ST, float* GT, int lane) {
    f32x4 v[4]; float s = 0.f;
#pragma unroll
    for (int j = 0; j < 4; ++j) { v[j] = vin[j]; s += (v[j][0] + v[j][1]) + (v[j][2] + v[j][3]); }
    const float mean = wave_sum(s) * (1.f / DM); float s2 = 0.f;
#pragma unroll
    for (int j = 0; j < 4; ++j) { v[j] = v[j] - mean; s2 += (v[j][0] * v[j][0] + v[j][1] * v[j][1]) + (v[j][2] * v[j][2] + v[j][3] * v[j][3]); }
    const float rstd = 1.f / sqrtf(wave_sum(s2) * (1.f / DM) + LN_EPS);
    if (lane == 0) { f32x2_t st = {mean, rstd}; *(f32x2_t*)(ST + (size_t)row * 2) = st; }
#pragma unroll
    for (int j = 0; j < 4; ++j) {
        v[j] = v[j] * rstd * gv[j] + bv[j];
        if (fin) *(f32x4*)(hf + 256 * j + 4 * lane) = v[j];
        if (!fin) { u32x2 w; w.x = pk2(v[j][0], v[j][1]); w.y = pk2(v[j][2], v[j][3]); *(u32x2*)(HB + (size_t)row * DM + 256 * j + 4 * lane) = w; }
    }
    if (gates) {
        float mine = 0.f;
#pragma unroll
        for (int g = 0; g < 8; ++g) {
            float d = 0.f;
#pragma unroll
            for (int j = 0; j < 4; ++j) { const f32x4 w4 = *(const LAS f32x4*)(gwl + g * 1024 + 256 * j + 4 * lane); d += (v[j][0] * w4[0] + v[j][1] * w4[1]) + (v[j][2] * w4[2] + v[j][3] * w4[3]); }
            d = wave_sum(d);
            if (lane == g) mine = d;
        }
        if (lane < 8) {
            const float z = mine + bif_l[lane];
            float o = z;
            if (lane >= 4) o = fminf(z, 0.f) - __logf(1.f + __expf(-fabsf(z)));
            GT[(size_t)row * 8 + lane] = o;
        }
    }
}
__device__ __forceinline__ void ln_phase(const Params& P, const float* gam, const float* bet, bool gates, bool fin, const float* win_l, const float* bif_l, LAS unsigned char* lds) {
    const int tid = tidx(), lane = tid & 63, wid = tid >> 6;
    float* hfm = (float*)(P.ws + WS_HFM); bf16_t* HB = (bf16_t*)(P.ws + WS_HB); float* GT = (float*)(P.ws + WS_GATES); float* ST = (float*)(P.ws + WS_STATS);
    LAS float* gwl = (LAS float*)lds;
    if (gates) {
        for (int idx = tid; idx < 8192; idx += 512) { const int k = idx >> 3, g = idx & 7; gwl[g * 1024 + k] = win_l[(size_t)k * DPROJ + 2048 + g]; }
        __syncthreads();
    }
    const int gw = bidx() * 8 + wid, NGW = gridDim.x * 8;
    f32x4 gv[4], bv[4];
#pragma unroll
    for (int j = 0; j < 4; ++j) { gv[j] = *(const f32x4*)(gam + 256 * j + 4 * lane); bv[j] = *(const f32x4*)(bet + 256 * j + 4 * lane); }
    constexpr int NR = MREAL;
    int row = 4 * gw;
    u32x2 ah[4][4], al[4][4];
#define LN_ROWP(r_) (P.out + (size_t)(r_) * DM)
    const bf16_t* LOp = (const bf16_t*)(P.ws + WS_LO);
#define LN_LOADRAW(h_, l_, r_, j_) do { h_ = *(const u32x2*)(HB + (size_t)(r_) * DM + 256 * (j_) + 4 * lane); l_ = *(const u32x2*)(LOp + (size_t)(r_) * DM + 256 * (j_) + 4 * lane); } while (0)
#define LN_COMB(dst_, hi_, lo_) dst_ = (f32x4){bflo(hi_.x) + bflo(lo_.x), bfhi(hi_.x) + bfhi(lo_.x), bflo(hi_.y) + bflo(lo_.y), bfhi(hi_.y) + bfhi(lo_.y)}
    if (row < NR) {
#pragma unroll
        for (int q4 = 0; q4 < 4; ++q4) {
#pragma unroll
            for (int j = 0; j < 4; ++j) LN_LOADRAW(ah[q4][j], al[q4][j], row + q4, j); }
    }
    while (row < NR) {
        f32x4 ca[4][4];
#pragma unroll
        for (int q4 = 0; q4 < 4; ++q4)
#pragma unroll
            for (int j = 0; j < 4; ++j) LN_COMB(ca[q4][j], ah[q4][j], al[q4][j]);
        const int nrow = row + 4 * NGW;
        if (nrow < NR) {
#pragma unroll
            for (int q4 = 0; q4 < 4; ++q4) {
#pragma unroll
                for (int j = 0; j < 4; ++j) LN_LOADRAW(ah[q4][j], al[q4][j], nrow + q4, j); }
        }
#pragma unroll
        for (int q4 = 0; q4 < 4; ++q4) ln_row(ca[q4], row + q4, LN_ROWP(row + q4), gv, bv, gates, fin, bif_l, gwl, HB, ST, GT, lane);
        row = nrow;
    }
#undef LN_ROWP
#undef LN_LOADRAW
#undef LN_COMB
}

__device__ __forceinline__ void conv8(const bf16_t* PB, const float* cw, const float* cb, int b, int pos, int chn, f32x4& o0, f32x4& o1) {
    o0 = *(const f32x4*)(cb + chn); o1 = *(const f32x4*)(cb + chn + 4);
#pragma unroll
    for (int j = 0; j < 4; ++j) {
        const int pp = pos - 3 + j;
        if (pp >= 0) {
            const u32x4 u = *(const u32x4*)(PB + seqrow(b, pp) * NPB + chn);
            const f32x4 w0 = *(const f32x4*)(cw + j * 1024 + chn), w1 = *(const f32x4*)(cw + j * 1024 + chn + 4);
            o0[0] += w0[0] * bflo(u.x); o0[1] += w0[1] * bfhi(u.x); o0[2] += w0[2] * bflo(u.y); o0[3] += w0[3] * bfhi(u.y);
            o1[0] += w1[0] * bflo(u.z); o1[1] += w1[1] * bfhi(u.z); o1[2] += w1[2] * bflo(u.w); o1[3] += w1[3] * bfhi(u.w);
        }
    }
#pragma unroll
    for (int e = 0; e < 4; ++e) { o0[e] = siluf(o0[e]); o1[e] = siluf(o1[e]); }
}
struct ConvW { f32x4 w[4][2]; f32x4 b[2]; };
__device__ __forceinline__ void convw_load(ConvW& cw8, const float* cw, const float* cb, int chn) {
    cw8.b[0] = *(const f32x4*)(cb + chn); cw8.b[1] = *(const f32x4*)(cb + chn + 4);
#pragma unroll
    for (int j = 0; j < 4; ++j) { cw8.w[j][0] = *(const f32x4*)(cw + j * 1024 + chn); cw8.w[j][1] = *(const f32x4*)(cw + j * 1024 + chn + 4); }
}
__device__ __forceinline__ void conv8w(const bf16_t* PB, const ConvW& cw8, int b, int pos, int chn, f32x4& o0, f32x4& o1) {
    o0 = cw8.b[0]; o1 = cw8.b[1];
    u32x4 u4[4];
#pragma unroll
    for (int j = 0; j < 4; ++j) {
        const int pp = pos - 3 + j;
        u4[j] = *(const u32x4*)(PB + seqrow(b, pp < 0 ? 0 : pp) * NPB + chn);
    }
#pragma unroll
    for (int j = 0; j < 4; ++j) {
        const bool ok = pos - 3 + j >= 0;
        const u32x4 u = {ok ? u4[j].x : 0u, ok ? u4[j].y : 0u, ok ? u4[j].z : 0u, ok ? u4[j].w : 0u};
        const f32x4 w0 = cw8.w[j][0], w1 = cw8.w[j][1];
        o0[0] += w0[0] * bflo(u.x); o0[1] += w0[1] * bfhi(u.x); o0[2] += w0[2] * bflo(u.y); o0[3] += w0[3] * bfhi(u.y);
        o1[0] += w1[0] * bflo(u.z); o1[1] += w1[1] * bfhi(u.z); o1[2] += w1[2] * bflo(u.w); o1[3] += w1[3] * bfhi(u.w);
    }
#pragma unroll
    for (int e = 0; e < 4; ++e) { o0[e] = siluf(o0[e]); o1[e] = siluf(o1[e]); }
}

__device__ __forceinline__ float wscan_add(float v, int lane) {
#pragma unroll
    for (int o = 1; o < 64; o <<= 1) { const float t = __shfl_up(v, o); if (lane >= o) v += t; }
    return v;
}
__device__ __forceinline__ float wscan_max(float v, int lane) {
#pragma unroll
    for (int o = 1; o < 64; o <<= 1) { const float t = __shfl_up(v, o); if (lane >= o) v = fmaxf(v, t); }
    return v;
}

__device__ __forceinline__ void lds_barrier() { asm volatile("s_waitcnt lgkmcnt(0)\n\ts_barrier" ::: "memory"); }

constexpr int TSTR = 320;
constexpr int RSTR = 272;
__device__ __forceinline__ void m1_unit(const Params& P, int layer, int bh, int c, LAS unsigned char* lds) {
    const int tid = tidx(), lane = tid & 63, wid = __builtin_amdgcn_readfirstlane(tid >> 6);
    const int b = bh >> 2, hh = bh & 3;
    const int nvalid = c == 0 ? NMETA : 128, p0 = c == 0 ? 0 : NMETA + 128 * (c - 1);
    const int nrep = c == 0 ? NB : 1;
    const bf16_t* PB = (const bf16_t*)(P.ws + WS_BIG); const float* GT = (const float*)(P.ws + WS_GATES);
    float* SC = (float*)(P.ws + WS_SC); float* NST = (float*)(P.ws + WS_NST); bf16_t* CST = (bf16_t*)(P.ws + WS_CST);
    const float* cw = P.in[8] + (size_t)layer * 4 * 1024; const float* cb = P.in[9] + (size_t)layer * 1024;
    LAS unsigned char* Kt = lds; LAS unsigned char* Vt = lds + 128 * TSTR; LAS float* sws = (LAS float*)(lds + 2 * 128 * TSTR);
    float li0 = NEGF, li1 = NEGF, lf0 = 0.f, lf1 = 0.f;
    if (wid == 0) {
        const int i0 = 2 * lane, i1 = i0 + 1;
        const size_t rw0 = seqrow(b, p0 + (i0 < nvalid ? i0 : 0)), rw1 = seqrow(b, p0 + (i1 < nvalid ? i1 : 0));
        li0 = GT[rw0 * 8 + hh]; lf0 = GT[rw0 * 8 + 4 + hh]; li1 = GT[rw1 * 8 + hh]; lf1 = GT[rw1 * 8 + 4 + hh];
        if (i0 >= nvalid) { li0 = NEGF; lf0 = 0.f; } if (i1 >= nvalid) { li1 = NEGF; lf1 = 0.f; }
    }
    ConvW ckw; convw_load(ckw, cw, cb, 512 + hh * 128 + 8 * (tid & 15));
    f32x4 kc0[4], kc1[4]; u32x4 vraw[4];
#pragma unroll
    for (int it = 0; it < 4; ++it) {
        const int item = tid + 512 * it, i = item >> 4, ch = item & 15;
        const int ic = i < nvalid ? i : nvalid - 1;
        conv8w(PB, ckw, b, p0 + ic, 512 + hh * 128 + 8 * ch, kc0[it], kc1[it]);
        vraw[it] = *(const u32x4*)(PB + seqrow(b, p0 + ic) * NPB + 1024 + hh * 128 + 8 * ch);
    }
    if (wid == 0) {
        const int i0 = 2 * lane, i1 = i0 + 1;
        const float s = lf0 + lf1, incl = wscan_add(s, lane), excl = incl - s;
        const float b0 = excl + lf0, b1 = incl, g0 = li0 - b0, g1 = li1 - b1;
        const float gmax = wave_max(fmaxf(g0, g1));
        sws[i0] = i0 < nvalid ? ex2((g0 - gmax) * LOG2E) : 0.f;
        sws[i1] = i1 < nvalid ? ex2((g1 - gmax) * LOG2E) : 0.f;
        const float bend = __shfl(incl, 63);
        if (lane == 0) { for (int bb = 0; bb < nrep; ++bb) { SC[(size_t)((bh + 4 * bb) * NCH + c) * 2] = bend; SC[(size_t)((bh + 4 * bb) * NCH + c) * 2 + 1] = bend + gmax; } }
    }
    __syncthreads();
#pragma unroll
    for (int it = 0; it < 4; ++it) {
        const int item = tid + 512 * it, i = item >> 4, ch = item & 15;
        const float sc = 0.08838834764831845f * sws[i];
        u32x4 kw = pack8(kc0[it] * sc, kc1[it] * sc), vw = vraw[it];
        if (i >= nvalid) { kw = (u32x4){0u, 0u, 0u, 0u}; vw = kw; }
        *(LAS u32x4*)(Kt + i * TSTR + ch * 16) = kw; *(LAS u32x4*)(Vt + i * TSTR + ch * 16) = vw;
    }
    __syncthreads();
    {
        const int h = lane >> 5, g = lane >> 4, q = (lane & 15) >> 2, pp = lane & 3;
        const int dkt = wid >> 1, dvt0 = (wid & 1) * 2;
        f32x16 acc[2];
#pragma unroll
        for (int t = 0; t < 2; ++t)
#pragma unroll
            for (int e = 0; e < 16; ++e) acc[t][e] = 0.f;
#pragma unroll
        for (int ks = 0; ks < 8; ++ks) {
            const int rowa = 16 * ks + 8 * h + q;
            const LAS unsigned char* ka = Kt + rowa * TSTR + (32 * dkt + 16 * (g & 1) + 4 * pp) * 2;
            const bf16x8 af = cat8(vtr(ka), vtr(ka + 4 * TSTR));
#pragma unroll
            for (int t = 0; t < 2; ++t) {
                const LAS unsigned char* va = Vt + rowa * TSTR + (32 * (dvt0 + t) + 16 * (g & 1) + 4 * pp) * 2;
                const bf16x8 bf = cat8(vtr(va), vtr(va + 4 * TSTR));
                acc[t] = mfma32(af, bf, acc[t]);
            }
        }
#pragma unroll
        for (int t = 0; t < 2; ++t) {
            const int dv = 32 * (dvt0 + t) + (lane & 31);
#pragma unroll
            for (int r4 = 0; r4 < 4; ++r4) {
                const int dk0 = 32 * dkt + 8 * r4 + 4 * h;
                u32x2 w; w.x = pk2(acc[t][4 * r4], acc[t][4 * r4 + 1]); w.y = pk2(acc[t][4 * r4 + 2], acc[t][4 * r4 + 3]);
                for (int bb = 0; bb < nrep; ++bb) *(u32x2*)(CST + (size_t)((bh + 4 * bb) * NCH + c) * 16384 + (size_t)dv * 128 + dk0) = w;
            }
        }
    }
    {
        LAS float* red = sws + 256;
        const int dk = tid & 127, part = tid >> 7;
        float sacc = 0.f;
#pragma unroll 8
        for (int i = 0; i < 32; ++i) sacc += __builtin_bit_cast(float, (unsigned)(*(const LAS unsigned short*)(Kt + (32 * part + i) * TSTR + dk * 2)) << 16);
        red[part * 128 + dk] = sacc;
        __syncthreads();
        if (tid < 128) { const float nsum = (red[tid] + red[128 + tid]) + (red[256 + tid] + red[384 + tid]); for (int bb = 0; bb < nrep; ++bb) NST[(size_t)((bh + 4 * bb) * NCH + c) * 128 + tid] = nsum; }
    }
    lds_barrier();
}

__device__ __forceinline__ void m2_phase(const Params& P) {
    float* SC = (float*)(P.ws + WS_SC); float* MST = SC + 32 * NCH * 2; float* NST = (float*)(P.ws + WS_NST); bf16_t* CST = (bf16_t*)(P.ws + WS_CST);
    const int NT = gridDim.x * 512;
    for (int task = bidx() * 512 + tidx(); task < 65536 + 4096; task += NT) {
        if (task < 65536) {
            const int bh = task >> 11, e8 = task & 2047;
            bf16_t* ptr = CST + (size_t)bh * NCH * 16384 + (size_t)e8 * 8;
            float run[8];
#pragma unroll
            for (int e = 0; e < 8; ++e) run[e] = 0.f;
            float m = NEGF;
#pragma unroll 1
            for (int c0 = 0; c0 < NCH; c0 += 5) {
                u32x4 loc[5]; float bendv[5], mlocv[5];
#pragma unroll
                for (int j = 0; j < 5; ++j) { loc[j] = *(const u32x4*)(ptr + (size_t)(c0 + j) * 16384); bendv[j] = SC[(size_t)(bh * NCH + c0 + j) * 2]; mlocv[j] = SC[(size_t)(bh * NCH + c0 + j) * 2 + 1]; }
#pragma unroll
                for (int j = 0; j < 5; ++j) {
                    const int c = c0 + j;
                    const float bend = bendv[j], mloc = mlocv[j];
                    const float mn = fmaxf(bend + m, mloc), a = ex2((bend + m - mn) * LOG2E), bt = ex2((mloc - mn) * LOG2E);
                    u32x4 w; w.x = pk2(run[0], run[1]); w.y = pk2(run[2], run[3]); w.z = pk2(run[4], run[5]); w.w = pk2(run[6], run[7]);
                    *(u32x4*)(ptr + (size_t)c * 16384) = w;
                    run[0] = a * run[0] + bt * bflo(loc[j].x); run[1] = a * run[1] + bt * bfhi(loc[j].x);
                    run[2] = a * run[2] + bt * bflo(loc[j].y); run[3] = a * run[3] + bt * bfhi(loc[j].y);
                    run[4] = a * run[4] + bt * bflo(loc[j].z); run[5] = a * run[5] + bt * bfhi(loc[j].z);
                    run[6] = a * run[6] + bt * bflo(loc[j].w); run[7] = a * run[7] + bt * bfhi(loc[j].w);
                    if (e8 == 0) MST[bh * NCH + c] = m;
                    m = mn;
                }
            }
        } else {
            const int t2 = task - 65536, bh = t2 >> 7, dk = t2 & 127;
            float* ptr = NST + (size_t)bh * NCH * 128 + dk;
            float run = 0.f, m = NEGF;
#pragma unroll 1
            for (int c0 = 0; c0 < NCH; c0 += 13) {
                float locv[13], bendv[13], mlocv[13];
#pragma unroll
                for (int j = 0; j < 13; ++j) { locv[j] = ptr[(size_t)(c0 + j) * 128]; bendv[j] = SC[(size_t)(bh * NCH + c0 + j) * 2]; mlocv[j] = SC[(size_t)(bh * NCH + c0 + j) * 2 + 1]; }
#pragma unroll
                for (int j = 0; j < 13; ++j) {
                    const float mn = fmaxf(bendv[j] + m, mlocv[j]), a = ex2((bendv[j] + m - mn) * LOG2E), bt = ex2((mlocv[j] - mn) * LOG2E);
                    ptr[(size_t)(c0 + j) * 128] = run; run = a * run + bt * locv[j]; m = mn;
                }
            }
        }
    }
}

__device__ __forceinline__ void m3_unit(const Params& P, int layer, int bh, int c, LAS unsigned char* lds) {
    const int tid = tidx(), lane = tid & 63, wid = __builtin_amdgcn_readfirstlane(tid >> 6);
    const int b = bh >> 2, hh = bh & 3;
    const int nvalid = c == 0 ? NMETA : 128, p0 = c == 0 ? 0 : NMETA + 128 * (c - 1);
    const bf16_t* PB = (const bf16_t*)(P.ws + WS_BIG); const float* GT = (const float*)(P.ws + WS_GATES);
    const float* SC = (const float*)(P.ws + WS_SC); const float* MST = SC + 32 * NCH * 2; const float* NST = (const float*)(P.ws + WS_NST); const bf16_t* CST = (const bf16_t*)(P.ws + WS_CST);
    bf16_t* MA = (bf16_t*)(P.ws + WS_MA);
    const float* cw = P.in[8] + (size_t)layer * 4 * 1024; const float* cb = P.in[9] + (size_t)layer * 1024; const float* mng = P.in[11] + (size_t)layer * 512;
    LAS unsigned char* Qt = lds; LAS unsigned char* Kt = lds + 128 * RSTR; LAS unsigned char* Vt = lds + 2 * 128 * RSTR;
    LAS float* sg2 = (LAS float*)(lds + 2 * 128 * RSTR + 128 * TSTR); LAS float* sr2 = sg2 + 128; LAS float* sw = sg2 + 256; LAS float* semt = sg2 + 384; LAS float* sqn = sg2 + 512;
    LAS float* sst = sg2 + 640; LAS float* sst2 = sg2 + 896; LAS float* snp = sg2 + 1152;
    constexpr int CT_OFF = 116736;
    {
        const bf16_t* Cp = CST + (size_t)(bh * NCH + c) * 16384;
#pragma unroll
        for (int k = 0; k < 4; ++k) {
            const int S = (k * 8 + wid) * 64 + lane, row = S >> 4, cch = (S & 15) ^ (row & 15);
            __builtin_amdgcn_global_load_lds((const unsigned*)(Cp + (size_t)row * 128 + cch * 8), (LAS unsigned*)(lds + CT_OFF + (k * 8 + wid) * 1024), 16, 0, 0);
        }
    }
    const float npv = tid < 128 ? NST[(size_t)(bh * NCH + c) * 128 + tid] : 0.f;
    float li0 = NEGF, li1 = NEGF, lf0 = 0.f, lf1 = 0.f, mprev = 0.f;
    if (wid == 0) {
        const int i0 = 2 * lane, i1 = i0 + 1;
        const size_t rw0 = seqrow(b, p0 + (i0 < nvalid ? i0 : 0)), rw1 = seqrow(b, p0 + (i1 < nvalid ? i1 : 0));
        li0 = GT[rw0 * 8 + hh]; lf0 = GT[rw0 * 8 + 4 + hh]; li1 = GT[rw1 * 8 + hh]; lf1 = GT[rw1 * 8 + 4 + hh];
        if (i0 >= nvalid) { li0 = NEGF; lf0 = 0.f; } if (i1 >= nvalid) { li1 = NEGF; lf1 = 0.f; }
        mprev = MST[bh * NCH + c];
    }
    ConvW cqw, ckw; convw_load(cqw, cw, cb, hh * 128 + 8 * (tid & 15)); convw_load(ckw, cw, cb, 512 + hh * 128 + 8 * (tid & 15));
    if (wid == 0) {
        const int i0 = 2 * lane, i1 = i0 + 1;
        const float s = lf0 + lf1, incl = wscan_add(s, lane), excl = incl - s;
        const float b0 = excl + lf0, b1 = incl, g0 = li0 - b0, g1 = li1 - b1;
        const float inclm = wscan_max(fmaxf(g0, g1), lane);
        float exclm = __shfl_up(inclm, 1); if (lane == 0) exclm = NEGF;
        const float cm0 = fmaxf(exclm, g0), cm1 = inclm;
        const float M0 = fmaxf(mprev, cm0), M1 = fmaxf(mprev, cm1);
        sg2[i0] = g0 * LOG2E; sg2[i1] = g1 * LOG2E; sr2[i0] = -M0 * LOG2E; sr2[i1] = -M1 * LOG2E;
        sw[i0] = ex2((mprev - M0) * LOG2E); sw[i1] = ex2((mprev - M1) * LOG2E);
        semt[i0] = ex2(-(b0 + M0) * LOG2E); semt[i1] = ex2(-(b1 + M1) * LOG2E);
    }
#pragma unroll
    for (int it = 0; it < 4; ++it) {
        const int item = tid + 512 * it, i = item >> 4, ch = item & 15;
        u32x4 qw, kw, vw;
        {
            const int ic = i < nvalid ? i : nvalid - 1;
            f32x4 o0, o1;
            conv8w(PB, cqw, b, p0 + ic, hh * 128 + 8 * ch, o0, o1); qw = pack8(o0, o1);
            conv8w(PB, ckw, b, p0 + ic, 512 + hh * 128 + 8 * ch, o0, o1); kw = pack8(o0 * 0.08838834764831845f, o1 * 0.08838834764831845f);
            vw = *(const u32x4*)(PB + seqrow(b, p0 + ic) * NPB + 1024 + hh * 128 + 8 * ch);
            if (i >= nvalid) { qw = (u32x4){0u, 0u, 0u, 0u}; kw = qw; vw = qw; }
        }
        *(LAS u32x4*)(Qt + i * RSTR + ch * 16) = qw; *(LAS u32x4*)(Kt + i * RSTR + ch * 16) = kw; *(LAS u32x4*)(Vt + i * TSTR + ch * 16) = vw;
    }
    if (tid < 128) snp[tid] = npv;
    asm volatile("s_waitcnt vmcnt(0)" ::: "memory");
    __syncthreads();
    const int r = lane & 31, h = lane >> 5, g = lane >> 4, q = (lane & 15) >> 2, pp = lane & 3;
    const int qb = wid >> 1, dvh = wid & 1, t = 32 * qb + r;
    u32x2 mo_[2][4]; f32x4 gn_[2][4];
    {
        const size_t rowp = seqrow(b, p0 + (t < nvalid ? t : 0));
#pragma unroll
        for (int d = 0; d < 2; ++d)
#pragma unroll
            for (int r4 = 0; r4 < 4; ++r4) {
                const int col = hh * 128 + 32 * (2 * dvh + d) + 8 * r4 + 4 * h;
                mo_[d][r4] = *(const u32x2*)(PB + rowp * NPB + 1536 + col); gn_[d][r4] = *(const f32x4*)(mng + col);
            }
    }
    {
        const int i = tid >> 2, part = tid & 3;
        const LAS float* np = snp + 32 * part;
        float s = 0.f;
#pragma unroll
        for (int d8 = 0; d8 < 4; ++d8) {
            const u32x4 qv = *(const LAS u32x4*)(Qt + i * RSTR + (32 * part + 8 * d8) * 2);
            const f32x4 n0 = *(const LAS f32x4*)(np + 8 * d8), n1 = *(const LAS f32x4*)(np + 8 * d8 + 4);
            s += bflo(qv.x) * n0[0] + bfhi(qv.x) * n0[1] + bflo(qv.y) * n0[2] + bfhi(qv.y) * n0[3] + bflo(qv.z) * n1[0] + bfhi(qv.z) * n1[1] + bflo(qv.w) * n1[2] + bfhi(qv.w) * n1[3];
        }
        s += __shfl_xor(s, 1); s += __shfl_xor(s, 2);
        if (part == 0) sqn[i] = s;
    }
    bf16x8 qf[8];
#pragma unroll
    for (int ks = 0; ks < 8; ++ks) qf[ks] = *(const LAS bf16x8*)(Qt + t * RSTR + (16 * ks + 8 * h) * 2);
    f32x16 acc[2];
#pragma unroll
    for (int d = 0; d < 2; ++d)
#pragma unroll
        for (int e = 0; e < 16; ++e) acc[d][e] = 0.f;
    {
#pragma unroll
        for (int ks = 0; ks < 8; ++ks)
#pragma unroll
            for (int d = 0; d < 2; ++d) {
                const int dv = 32 * (2 * dvh + d) + r;
                const bf16x8 cf = *(const LAS bf16x8*)(lds + CT_OFF + (dv * 16 + ((2 * ks + h) ^ (dv & 15))) * 16);
                acc[d] = mfma32(cf, qf[ks], acc[d]);
            }
    }
    __syncthreads();
    const float wt = sw[t], r2 = sr2[t];
#pragma unroll
    for (int d = 0; d < 2; ++d) acc[d] = acc[d] * wt;
    float den = 0.f;
#pragma unroll 1
    for (int kb = 0; kb <= qb; ++kb) {
        f32x16 st;
#pragma unroll
        for (int e = 0; e < 16; ++e) st[e] = 0.f;
#pragma unroll
        for (int ks = 0; ks < 8; ++ks) { const bf16x8 kf = *(const LAS bf16x8*)(Kt + (32 * kb + r) * RSTR + (16 * ks + 8 * h) * 2); st = mfma32(kf, qf[ks], st); }
#pragma unroll
        for (int r4 = 0; r4 < 4; ++r4) {
            const int s0 = 32 * kb + 8 * r4 + 4 * h;
            const f32x4 gs = *(const LAS f32x4*)(sg2 + s0);
#pragma unroll
            for (int e = 0; e < 4; ++e) {
                float v = st[4 * r4 + e] * ex2(r2 + gs[e]);
                if (s0 + e > t) v = 0.f;
                den += v; st[4 * r4 + e] = v;
            }
        }
#pragma unroll
        for (int s2 = 0; s2 < 2; ++s2) {
            u32x4 pw; pw.x = pk2(st[8 * s2], st[8 * s2 + 1]); pw.y = pk2(st[8 * s2 + 2], st[8 * s2 + 3]); pw.z = pk2(st[8 * s2 + 4], st[8 * s2 + 5]); pw.w = pk2(st[8 * s2 + 6], st[8 * s2 + 7]);
            const bf16x8 pf = __builtin_bit_cast(bf16x8, pw);
#pragma unroll
            for (int d = 0; d < 2; ++d) {
                const LAS unsigned char* va = Vt + (32 * kb + 16 * s2 + 4 * h + q) * TSTR + (32 * (2 * dvh + d) + 16 * (g & 1) + 4 * pp) * 2;
                const bf16x8 vf = cat8(vtr(va), vtr(va + 8 * TSTR));
                acc[d] = mfma32(vf, pf, acc[d]);
            }
        }
    }
    den += __shfl_xor(den, 32);
    den += wt * sqn[t];
    const float inv = 1.f / fmaxf(fabsf(den), semt[t]);
    float s1 = 0.f;
#pragma unroll
    for (int d = 0; d < 2; ++d)
#pragma unroll
        for (int e = 0; e < 16; ++e) { acc[d][e] *= inv; s1 += acc[d][e]; }
    s1 += __shfl_xor(s1, 32);
    if (h == 0) sst[wid * 32 + r] = s1;
    __syncthreads();
    const float mean = (s1 + sst[(wid ^ 1) * 32 + r]) * (1.f / 128.f);
    float q2 = 0.f;
#pragma unroll
    for (int d = 0; d < 2; ++d)
#pragma unroll
        for (int e = 0; e < 16; ++e) { acc[d][e] -= mean; q2 += acc[d][e] * acc[d][e]; }
    q2 += __shfl_xor(q2, 32);
    if (h == 0) sst2[wid * 32 + r] = q2;
    __syncthreads();
    const float rstd = 1.f / sqrtf((q2 + sst2[(wid ^ 1) * 32 + r]) * (1.f / 128.f) + LN_EPS);
    if (t < nvalid) {
        const size_t row = seqrow(b, p0 + t);
#pragma unroll
        for (int d = 0; d < 2; ++d)
#pragma unroll
            for (int r4 = 0; r4 < 4; ++r4) {
                const int col = hh * 128 + 32 * (2 * dvh + d) + 8 * r4 + 4 * h;
                const u32x2 mo = mo_[d][r4];
                const f32x4 g4 = gn_[d][r4];
                const float o0 = acc[d][4 * r4] * rstd * g4[0] * sigm(bflo(mo.x)), o1 = acc[d][4 * r4 + 1] * rstd * g4[1] * sigm(bfhi(mo.x));
                const float o2 = acc[d][4 * r4 + 2] * rstd * g4[2] * sigm(bflo(mo.y)), o3 = acc[d][4 * r4 + 3] * rstd * g4[3] * sigm(bfhi(mo.y));
                u32x2 w; w.x = pk2(o0, o1); w.y = pk2(o2, o3);
                *(u32x2*)(MA + row * 512 + col) = w;
            }
    }
    lds_barrier();
}

constexpr int AT_KB = 64 * RSTR, AT_VB = 64 * TSTR, AT_BUF = AT_KB + AT_VB;
__device__ __forceinline__ void attn_unit(const Params& P, int layer, int b, int hd, int pq0, int nvalid, float lam, float lam_init, LAS unsigned char* lds) {
    const int tid = tidx(), lane = tid & 63, wid = __builtin_amdgcn_readfirstlane(tid >> 6);
    const int c = wid >> 2, wq = wid & 3, r = lane & 31, h = lane >> 5, g = lane >> 4, q = (lane & 15) >> 2, pp = lane & 3;
    const bf16_t* PB = (const bf16_t*)(P.ws + WS_BIG); bf16_t* AO = (bf16_t*)(P.ws + WS_MA) + (size_t)MPAD * 512;
    const float* ang = P.in[16] + (size_t)layer * 512;
    const int qi = 32 * wq + r, qp = pq0 + qi;
    bf16x8 qf[4];
    {
        const size_t qrow = seqrow(b, qp < LSEQ ? qp : LSEQ - 1);
#pragma unroll
        for (int ks = 0; ks < 4; ++ks) qf[ks] = *(const bf16x8*)(PB + qrow * NPB + 2048 + hd * 128 + c * 64 + 16 * ks + 8 * h);
    }
    const float slope2 = ex2(-2.f * (float)(hd + 1)) * LOG2E;
    const int ntiles = (pq0 + nvalid - 1) / 64 + 1;
    u32x4 pk[2], pv[2];
#define AT_LOAD(kt) do { _Pragma("unroll") for (int i_ = 0; i_ < 2; ++i_) { const int row_ = (tid + 512 * i_) >> 4, ch_ = tid & 15; int kp_ = 64 * (kt) + row_; kp_ = kp_ < LSEQ ? kp_ : LSEQ - 1; \
        const bf16_t* src_ = PB + seqrow(b, kp_) * NPB + hd * 128 + ch_ * 8; pk[i_] = *(const u32x4*)(src_ + 2560); pv[i_] = *(const u32x4*)(src_ + 3072); } } while (0)
#define AT_STORE(s) do { _Pragma("unroll") for (int i_ = 0; i_ < 2; ++i_) { const int row_ = (tid + 512 * i_) >> 4, ch_ = tid & 15; \
        *(LAS u32x4*)(lds + (s) * AT_BUF + row_ * RSTR + ch_ * 16) = pk[i_]; *(LAS u32x4*)(lds + (s) * AT_BUF + AT_KB + row_ * TSTR + ch_ * 16) = pv[i_]; } } while (0)
    AT_LOAD(ntiles - 1);
    float qkb;
    {
        float ss = 0.f;
#pragma unroll
        for (int ks = 0; ks < 4; ++ks)
#pragma unroll
            for (int j = 0; j < 8; ++j) { const float v = __builtin_bit_cast(float, (unsigned)(unsigned short)qf[ks][j] << 16); ss += v * v; }
        ss += __shfl_xor(ss, 32);
        const float* KM = (const float*)(P.ws + WS_KM) + layer * 72;
        const float k2 = fmaxf(KM[b * 8 + hd * 2 + c], KM[64 + hd * 2 + c]);
        qkb = sqrtf(ss) * sqrtf(k2) * 1.001f + 0.01f;
    }
    LAS unsigned* votes = (LAS unsigned*)(lds + 131072 + 2048);
    if (tid < 16) votes[tid] = 0u;
    AT_STORE((ntiles - 1) & 1);
    __syncthreads();
    float m_run = NEGF, l_run = 0.f;
    f32x16 o[4];
#pragma unroll
    for (int d = 0; d < 4; ++d)
#pragma unroll
        for (int e = 0; e < 16; ++e) o[d][e] = 0.f;
#pragma unroll 1
    for (int kt = ntiles - 1; kt >= 0; --kt) {
        const int s = kt & 1;
        if (kt > 0) AT_LOAD(kt - 1);
        const LAS unsigned char* Kb = lds + s * AT_BUF; const LAS unsigned char* Vb = Kb + AT_KB;
        if (64 * kt <= pq0 + 32 * wq + 31) {
        f32x16 st[2];
#pragma unroll
        for (int kb2 = 0; kb2 < 2; ++kb2) {
            const float tb = slope2 * (float)(64 * kt + 32 * kb2 - pq0 + 4 * h);
#pragma unroll
            for (int e = 0; e < 16; ++e) st[kb2][e] = tb + slope2 * (float)((e & 3) + 8 * (e >> 2));
#pragma unroll
            for (int ks = 0; ks < 4; ++ks) { const bf16x8 kf = *(const LAS bf16x8*)(Kb + (32 * kb2 + r) * RSTR + (c * 64 + 16 * ks + 8 * h) * 2); st[kb2] = mfma32(kf, qf[ks], st[kb2]); }
        }
        if (64 * kt + 63 > pq0 + 32 * wq) {
#pragma unroll
            for (int kb2 = 0; kb2 < 2; ++kb2)
#pragma unroll
                for (int e = 0; e < 16; ++e) { const int kp = 64 * kt + 32 * kb2 + (e & 3) + 8 * (e >> 2) + 4 * h; if (kp > qp) st[kb2][e] = NEGF; }
        }
        float mx = st[0][0];
#pragma unroll
        for (int e = 1; e < 16; ++e) mx = fmaxf(mx, st[0][e]);
#pragma unroll
        for (int e = 0; e < 16; ++e) mx = fmaxf(mx, st[1][e]);
        mx = fmaxf(mx, __shfl_xor(mx, 32));
        if (__any(mx > m_run + 8.f)) {
            const float m_new = fmaxf(m_run, mx), alpha = ex2(m_run - m_new);
            m_run = m_new; l_run *= alpha;
#pragma unroll
            for (int d = 0; d < 4; ++d) o[d] = o[d] * alpha;
        }
        const float m_new = m_run;
        float psum = 0.f;
#pragma unroll
        for (int kb2 = 0; kb2 < 2; ++kb2)
#pragma unroll
            for (int e = 0; e < 16; ++e) { const float p = ex2(st[kb2][e] - m_new); st[kb2][e] = p; psum += p; }
        l_run += psum;
#pragma unroll
        for (int kb2 = 0; kb2 < 2; ++kb2)
#pragma unroll
            for (int s2 = 0; s2 < 2; ++s2) {
                u32x4 pw; pw.x = pk2(st[kb2][8 * s2], st[kb2][8 * s2 + 1]); pw.y = pk2(st[kb2][8 * s2 + 2], st[kb2][8 * s2 + 3]); pw.z = pk2(st[kb2][8 * s2 + 4], st[kb2][8 * s2 + 5]); pw.w = pk2(st[kb2][8 * s2 + 6], st[kb2][8 * s2 + 7]);
                const bf16x8 pf = __builtin_bit_cast(bf16x8, pw);
#pragma unroll
                for (int d = 0; d < 4; ++d) {
                    const LAS unsigned char* va = Vb + (32 * kb2 + 16 * s2 + 4 * h + q) * TSTR + (32 * d + 16 * (g & 1) + 4 * pp) * 2;
                    const bf16x8 vf = cat8(vtr(va), vtr(va + 8 * TSTR));
                    o[d] = mfma32(vf, pf, o[d]);
                }
            }
        }
        if (kt > 0) {
            const float bnd = qkb + slope2 * (float)(64 * (kt - 1) + 63 - pq0);
            const bool dn = !__any(bnd >= m_run - 44.f);
            if (lane == 0) votes[s * 8 + wid] = dn ? 1u : 0u;
            AT_STORE(s ^ 1);
        }
        __syncthreads();
        if (kt > 0) {
            const u32x4 v0 = *(const LAS u32x4*)(votes + s * 8), v1 = *(const LAS u32x4*)(votes + s * 8 + 4);
            const unsigned all = (unsigned)__builtin_amdgcn_readfirstlane((int)((v0.x & v0.y) & (v0.z & v0.w) & (v1.x & v1.y) & (v1.z & v1.w)));
            if (all) break;
        }
    }
#undef AT_LOAD
#undef AT_STORE
    const float l_tot = l_run + __shfl_xor(l_run, 32), inv = 1.f / l_tot;
    LAS float* xch = (LAS float*)lds;
    if (c == 1) {
#pragma unroll
        for (int d = 0; d < 4; ++d)
#pragma unroll
            for (int e = 0; e < 16; ++e) xch[((wq * 4 + d) * 16 + e) * 64 + lane] = o[d][e] * inv;
    }
    __syncthreads();
    if (c == 0) {
        float ss = 0.f;
#pragma unroll
        for (int d = 0; d < 4; ++d)
#pragma unroll
            for (int e = 0; e < 16; ++e) { const float v = o[d][e] * inv - lam * xch[((wq * 4 + d) * 16 + e) * 64 + lane]; o[d][e] = v; ss += v * v; }
        ss += __shfl_xor(ss, 32);
        const float rms = (1.f / sqrtf(ss * (1.f / 128.f) + LN_EPS)) * (1.f - lam_init);
        f32x4 ga_[4][4];
#pragma unroll
        for (int d = 0; d < 4; ++d)
#pragma unroll
            for (int r4 = 0; r4 < 4; ++r4) ga_[d][r4] = *(const f32x4*)(ang + hd * 128 + 32 * d + 8 * r4 + 4 * h);
        if (qi < nvalid) {
            const size_t row = seqrow(b, qp);
#pragma unroll
            for (int d = 0; d < 4; ++d)
#pragma unroll
                for (int r4 = 0; r4 < 4; ++r4) {
                    const int col = hd * 128 + 32 * d + 8 * r4 + 4 * h;
                    const f32x4 g4 = ga_[d][r4];
                    u32x2 w; w.x = pk2(o[d][4 * r4] * rms * g4[0], o[d][4 * r4 + 1] * rms * g4[1]); w.y = pk2(o[d][4 * r4 + 2] * rms * g4[2], o[d][4 * r4 + 3] * rms * g4[3]);
                    *(u32x2*)(AO + row * 512 + col) = w;
                }
        }
    }
    lds_barrier();
}

#define XB_TMO      128
#define XB_XCNT(j)  (256  + 64 * (j))
#define XB_XSUB(j)  (1280 + 64 * (j))
#define XB_XGEN(j)  (2304 + 64 * (j))
#define XB_TOP      3328
#define XB_TOPGEN   3392
#define XCD_BAR_WORDS 3456
#define XB_SPIN_CAP (1u << 18)

__device__ __forceinline__ unsigned xb_ld(unsigned* p)              { return __hip_atomic_load(p, __ATOMIC_RELAXED, __HIP_MEMORY_SCOPE_AGENT); }
__device__ __forceinline__ unsigned xb_add(unsigned* p, unsigned v) { return __hip_atomic_fetch_add(p, v, __ATOMIC_RELAXED, __HIP_MEMORY_SCOPE_AGENT); }
__device__ __forceinline__ unsigned xb_xcc_id() { return (unsigned)__builtin_amdgcn_s_getreg((3 << 11) | 20) & 0xFu; }
#define XB_SPIN(cond, bar) do { unsigned _sp = 0; while (cond) { __builtin_amdgcn_s_sleep(1); \
    if ((++_sp & 255u) == 0u) { if (xb_ld(&(bar)[XB_TMO])) break; if (_sp > XB_SPIN_CAP) { atomicAdd(&(bar)[XB_TMO], 1u); break; } } } } while (0)

struct XcdBarrier {
    unsigned* bar; unsigned x;
    volatile LAS unsigned* st;
};

__device__ __forceinline__ XcdBarrier xcd_barrier_post(unsigned* bar, volatile LAS unsigned* st) {
    XcdBarrier b; b.bar = bar; b.x = xb_xcc_id(); b.st = st;
    if (threadIdx.x == 0) (void)xb_add(&bar[XB_XCNT(b.x)], 1u);
    return b;
}
__device__ __forceinline__ void xcd_barrier_complete(unsigned* bar, unsigned x, unsigned& nloc, unsigned& nx) {
    const unsigned G = gridDim.x * gridDim.y * gridDim.z;
    unsigned sum, cnt, mine, sp = 0u;
    for (;;) {
        sum = 0u; cnt = 0u; mine = 0u;
#pragma unroll
        for (unsigned j = 0; j < 16; ++j) { const unsigned c = xb_ld(&bar[XB_XCNT(j)]); sum += c; cnt += (c > 0u) ? 1u : 0u; mine = (j == x) ? c : mine; }
        if (sum == G) break;
        __builtin_amdgcn_s_sleep(1);
        if ((++sp & 255u) == 0u) { if (xb_ld(&bar[XB_TMO])) break; if (sp > XB_SPIN_CAP) { atomicAdd(&bar[XB_TMO], 1u); break; } }
    }
    nloc = mine > 0u ? mine : 1u; nx = cnt > 0u ? cnt : 1u;
}

__device__ __forceinline__ void xcd_barrier(const XcdBarrier& b) {
    asm volatile("s_waitcnt vmcnt(0)" ::: "memory");
    __syncthreads();
    if (threadIdx.x == 0) {
        unsigned* bar = b.bar;
        __builtin_amdgcn_s_waitcnt(0);
        unsigned nloc = b.st[0], nx = b.st[1];
        if (nloc == 0u) { xcd_barrier_complete(bar, b.x, nloc, nx); b.st[0] = nloc; b.st[1] = nx; }
        const unsigned old = xb_add(&bar[XB_XSUB(b.x)], 1u);
        const unsigned gen = old / nloc;
        if (old + 1u == (gen + 1u) * nloc) {
            __builtin_amdgcn_fence(__ATOMIC_RELEASE, "agent");
            asm volatile("s_waitcnt vmcnt(0)" ::: "memory");
            const unsigned og = xb_add(&bar[XB_TOP], 1u);
            const unsigned tg = og / nx;
            if (og + 1u == (tg + 1u) * nx) xb_add(&bar[XB_TOPGEN], 1u);
            else XB_SPIN(xb_ld(&bar[XB_TOPGEN]) == tg, bar);
            __builtin_amdgcn_fence(__ATOMIC_ACQUIRE, "agent");
            xb_add(&bar[XB_XGEN(b.x)], 1u);
            asm volatile("s_waitcnt vmcnt(0)" ::: "memory");
        } else {
            XB_SPIN(xb_ld(&bar[XB_XGEN(b.x)]) == gen, bar);
            __builtin_amdgcn_fence(__ATOMIC_ACQUIRE, "agent");
            asm volatile("s_waitcnt vmcnt(0)" ::: "memory");
        }
    }
    __syncthreads();
}

#ifndef PROBE_ATT
#define PROBE_ATT 1
#endif
#ifndef PROBE_M3
#define PROBE_M3 1
#endif
constexpr int LDS_BYTES = 155648;
constexpr int LDS_BST = LDS_BYTES - 64;
#ifndef PROG_LAYER
#define PROG_LAYER(L) 16*L+0, 16*L+1, 16*L+3, 16*L+4, 16*L+5, 16*L+6, 16*L+7, 16*L+8, 16*L+9, 16*L+11, 16*L+12
#endif
__device__ const unsigned char PROG[] = { PROG_LAYER(0), PROG_LAYER(1), 16 * 1 + 13 };
constexpr int NSTEP = 14;
__global__ void __launch_bounds__(512) hybrid_fwd(Params P) {
    extern __shared__ __attribute__((aligned(16))) unsigned char smem[];
    LAS unsigned char* lds = (LAS unsigned char*)smem;
    cg::grid_group grid = cg::this_grid();
    unsigned* barw = (unsigned*)(P.ws + WS_BAR);
    volatile LAS unsigned* bst = (volatile LAS unsigned*)(lds + LDS_BST);
    if (blockIdx.x == 0) for (int i = threadIdx.x; i < XCD_BAR_WORDS; i += 512) __hip_atomic_store(barw + i, 0u, __ATOMIC_RELAXED, __HIP_MEMORY_SCOPE_AGENT);
    if (blockIdx.x == 0 && threadIdx.x < 144) __hip_atomic_store((unsigned*)(P.ws + WS_KM) + threadIdx.x, 0u, __ATOMIC_RELAXED, __HIP_MEMORY_SCOPE_AGENT);
    if (threadIdx.x < 2) bst[threadIdx.x] = 0u;
    __syncthreads();

#ifndef PROBE_P0
#define PROBE_P0 1
#endif
#pragma unroll 1
    for (int rep0_ = 0; rep0_ < PROBE_P0; ++rep0_)
    {
        const int lane = tidx() & 63, wid = tidx() >> 6, gw = bidx() * 8 + wid, NGW = gridDim.x * 8;
        bf16_t* HB = (bf16_t*)(P.ws + WS_HB); float* HFM = (float*)(P.ws + WS_HFM);
        LAS float* scr = (LAS float*)(lds + wid * 16384);
        for (int it = gw; it < 2 * CW_ITEMS; it += NGW) conv_weight_item(P, it / CW_ITEMS, it % CW_ITEMS, scr, lane);
        const float* x = P.in[0]; const float* meta = P.in[1];
        {
            const size_t NT8 = (size_t)gridDim.x * 512, n8 = (size_t)MREAL * DM / 8;
#pragma unroll 1
            for (size_t i = (size_t)bidx() * 512 + tidx(); i < n8; i += 4 * NT8) {
                f32x4 v0[4], v1[4];
#pragma unroll
                for (int j = 0; j < 4; ++j) { const size_t ii = i + j * NT8 < n8 ? i + j * NT8 : i; v0[j] = *(const f32x4*)(x + ii * 8); v1[j] = *(const f32x4*)(x + ii * 8 + 4); }
                asm volatile("" : "+v"(v0[0]), "+v"(v0[1]), "+v"(v0[2]), "+v"(v0[3]), "+v"(v1[0]), "+v"(v1[1]), "+v"(v1[2]), "+v"(v1[3]));
#pragma unroll
                for (int j = 0; j < 4; ++j) if (i + j * NT8 < n8) *(u32x4*)(HB + (i + j * NT8) * 8) = pack8(v0[j], v1[j]);
            }
        }
        for (int row = gw; row < NMETA; row += NGW) {
#pragma unroll
            for (int j = 0; j < 4; ++j) {
                const f32x4 v = *(const f32x4*)(meta + (size_t)row * DM + 256 * j + 4 * lane);
                *(f32x4*)(HFM + (size_t)row * DM + 256 * j + 4 * lane) = v;
                u32x2 w; w.x = pk2(v[0], v[1]); w.y = pk2(v[2], v[3]);
                *(u32x2*)(HB + (size_t)(MROW0 + row) * DM + 256 * j + 4 * lane) = w;
            }
        }
    }
    grid.sync();
    (void)xcd_barrier_post(barw, bst);

#pragma unroll 1
    for (int ph = 0; ph < (int)sizeof(PROG); ++ph) {
        const int layer = PROG[ph] >> 4, step = PROG[ph] & 15;
        const int G = gridDim.x;
#define TIDV const int tid_ = tidx(), lane = tid_ & 63, wid = __builtin_amdgcn_readfirstlane(tid_ >> 6); (void)lane; (void)wid;
        bf16_t* HB = (bf16_t*)(P.ws + WS_HB); float* HFM = (float*)(P.ws + WS_HFM);
        bf16_t* BIG = (bf16_t*)(P.ws + WS_BIG); bf16_t* MA = (bf16_t*)(P.ws + WS_MA);
        const bf16_t* Wl = (const bf16_t*)(P.ws + WS_W) + (size_t)layer * OW_LAYER;
#define LNCTX float* ROWS = (float*)(P.ws + WS_ROWS); const float* CSl = (const float*)(P.ws + WS_CSBW) + (size_t)layer * 2 * OC_N; const float* BWl = CSl + OC_N; \
        const int tlast = 3 * layer + (step <= 1 ? -1 : step <= 9 ? 0 : step <= 12 ? 1 : 2);   \
        const float* rows_last = ROWS + (size_t)((tlast & 1) * MPAD) * 2; (void)CSl; (void)BWl; (void)rows_last;
        if (step == 0 || step == 3 || step == 11) {
            LNCTX
            float* z = ROWS + (size_t)(((tlast + 1) & 1) * MPAD) * 2;
            for (int i = bidx() * 512 + tidx(); i < MPAD * 2 / 4; i += G * 512) *(f32x4*)(z + 4 * i) = (f32x4){0.f, 0.f, 0.f, 0.f};
        }
        if (step == 0 || step == 11) {
            LNCTX
            const bf16_t* Wgu = Wl + (step ? OW_GU2 : OW_GU1); const int oc = step ? OC_GU2 : OC_GU1;
            const pg8::LnFix fx{rows_last, CSl + oc, BWl + oc, tlast >= 0 ? 1 : 0};
            pg8::Gemm gm{HB, Wgu, MREAL, 2 * FF, DM}; pg8::StaticOrder S; S.init(MREAL, 2 * FF, G, bidx());
            pg8::EpiSwiglu E{BIG, FF, fx};
            pg8::gemm_phase<pg8::EpiSwiglu, pg8::StaticOrder, true, true>(lds, gm, S, E);
            for (int ct = bidx(); ct < FF / 16; ct += G) {
                TIDV
                const int c0 = 16 * ct, R0 = 256 * (c0 >> 7) + (c0 & 127);
                const f32x4 ag = sg_tile_blk(HB + (size_t)MROW0 * DM, DM, Wgu, DM, R0, lane, wid, (LAS float*)lds), au = sg_tile_blk(HB + (size_t)MROW0 * DM, DM, Wgu, DM, R0 + 128, lane, wid, (LAS float*)lds);
                if (wid == 0) {
                    const int rb = R0 + (lane & 15);
                    float mu4[4] = {0.f, 0.f, 0.f, 0.f}, r4v[4] = {1.f, 1.f, 1.f, 1.f}, csg = 0.f, bwg = 0.f, csu = 0.f, bwu = 0.f;
                    if (fx.on) { csg = fx.cs[rb]; bwg = fx.bw[rb]; csu = fx.cs[rb + 128]; bwu = fx.bw[rb + 128];
#pragma unroll
                        for (int e = 0; e < 4; ++e) fx.stats((size_t)(MROW0 + 4 * (lane >> 4) + e), mu4[e], r4v[e]); }
#pragma unroll
                    for (int e = 0; e < 4; ++e) {
                        const size_t row = (size_t)(MROW0 + 4 * (lane >> 4) + e);
                        const float gv = (ag[e] - csg * mu4[e]) * r4v[e] + bwg, uv = (au[e] - csu * mu4[e]) * r4v[e] + bwu;
                        BIG[row * FF + c0 + (lane & 15)] = (bf16_t)f2bf(siluf(gv) * uv);
                    }
                }
            }
        } else if (step == 1 || step == 9 || step == 12) {
            LNCTX
            const bf16_t* A = step == 9 ? MA : BIG; const bf16_t* Bt = Wl + (step == 1 ? OW_D1 : step == 9 ? OW_OUT : OW_D2);
            const int K = step == 9 ? DM : FF; const float sc = step == 9 ? 1.f : 0.5f;
            pg8::Gemm gm{A, Bt, MREAL, DM, K}; pg8::StaticOrder S; S.init(MREAL, DM, G, bidx());
            const int raw = tlast < 0 ? 1 : 0;
            const int gi = step == 1 ? (layer == 0 ? 5 : 26) : step == 9 ? 5 : 21;
            const int gl = step == 1 ? (layer == 0 ? 0 : layer - 1) : layer;
            const float* gam = P.in[gi] + (size_t)gl * DM; const float* bet = P.in[gi + 1] + (size_t)gl * DM;
            float* rows_cur = ROWS + (size_t)(((tlast + 1) & 1) * MPAD) * 2;
            pg8::EpiResid E{P.in[0], (bf16_t*)(P.ws + WS_LO), HB, rows_last, rows_cur, gam, bet, sc, raw};
            pg8::gemm_phase<pg8::EpiResid, pg8::StaticOrder, true, true>(lds, gm, S, E);
            for (int ct = bidx(); ct < 64; ct += G) {
                TIDV
                const f32x4 a = sg_tile_blk(A + (size_t)MROW0 * K, K, Bt, K, 16 * ct, lane, wid, (LAS float*)lds);
                const int col = 16 * ct + (lane & 15);
                if (wid == 0) {
                    float hv[4], s1v[4] = {0.f, 0.f, 0.f, 0.f}, s2v[4] = {1.f, 1.f, 1.f, 1.f}, gcol = 1.f, bcol = 0.f;
#pragma unroll
                    for (int e = 0; e < 4; ++e) { const int mr = 4 * (lane >> 4) + e; hv[e] = HFM[(size_t)mr * DM + col]; if (!raw) { s1v[e] = rows_last[(size_t)(MROW0 + mr) * 2]; s2v[e] = rows_last[(size_t)(MROW0 + mr) * 2 + 1]; } }
                    if (!raw) { gcol = gam[col]; bcol = bet[col]; }
#pragma unroll
                    for (int e = 0; e < 4; ++e) {
                        const int mr = 4 * (lane >> 4) + e; float* p = HFM + (size_t)mr * DM + col;
                        float h = hv[e];
                        if (!raw) { const float mu = s1v[e] * (1.f / DM), r = __builtin_amdgcn_rsqf(s2v[e] * (1.f / DM) - mu * mu + LN_EPS);
                            h = (h - mu) * r * gcol + bcol; }
                        const float y = ALPHA * h + sc * a[e];
                        *p = y; HB[(size_t)(MROW0 + mr) * DM + col] = (bf16_t)f2bf(y);
                        float q1 = y, q2 = y * y;
                        q1 += __shfl_xor(q1, 1); q1 += __shfl_xor(q1, 2); q1 += __shfl_xor(q1, 4); q1 += __shfl_xor(q1, 8);
                        q2 += __shfl_xor(q2, 1); q2 += __shfl_xor(q2, 2); q2 += __shfl_xor(q2, 4); q2 += __shfl_xor(q2, 8);
                        if ((lane & 15) == 0) { atomicAdd(rows_cur + (size_t)(MROW0 + mr) * 2, q1); atomicAdd(rows_cur + (size_t)(MROW0 + mr) * 2 + 1, q2); }
                    }
                }
            }
        } else if (step == 13) {
            ln_phase(P, P.in[26] + (size_t)layer * DM, P.in[27] + (size_t)layer * DM, false, true, nullptr, nullptr, lds);
        } else if (step == 3 || step == 7) {
            LNCTX
            const int ng = step == 3 ? 1 : 2;
            float* GT = (float*)(P.ws + WS_GATES); const float* bif = P.in[10] + (size_t)layer * 8;
#pragma unroll 1
            for (int gi = 0; gi < ng; ++gi) {
                const bf16_t* A = step == 3 ? HB : MA + (size_t)gi * MPAD * 512;
                const bf16_t* Bt = Wl + (step == 3 ? OW_PB : gi ? OW_BA : OW_BM);
                const int N = step == 3 ? NPBW : DM, K = step == 3 ? DM : 512, ldc = step == 3 ? NPB : 2048, coff = gi * DM;
                const pg8::LnFix fx{rows_last, CSl + OC_PB, BWl + OC_PB, step == 3 ? 1 : 0};
                pg8::Gemm gm{A, Bt, MREAL, N, K}; pg8::StaticOrder S; S.init(MREAL, N, G, bidx());
                pg8::EpiPlain E{BIG, ldc, coff, step == 3 ? 8 : 0, step == 3 ? 10 : 0, QSCALE, fx, step == 3 ? GT : nullptr, bif};
                pg8::gemm_phase<pg8::EpiPlain, pg8::StaticOrder, true, true>(lds, gm, S, E);
                const int ntile = step == 3 ? NPB / 16 + 1 : N / 16;
                for (int ct = bidx(); ct < ntile; ct += G) {
                    TIDV
                    const f32x4 a = sg_tile_blk(A + (size_t)MROW0 * K, K, Bt, K, 16 * ct, lane, wid, (LAS float*)lds);
                    const float sc = (step == 3 && 16 * ct >= 2048 && 16 * ct < 2560) ? QSCALE : 1.f;
                    if (wid == 0) {
                        const int rb = 16 * ct + (lane & 15);
                        float mu4[4] = {0.f, 0.f, 0.f, 0.f}, r4v[4] = {1.f, 1.f, 1.f, 1.f}, cs1 = 0.f, bw1 = 0.f;
                        if (fx.on) { cs1 = fx.cs[rb]; bw1 = fx.bw[rb];
#pragma unroll
                            for (int e = 0; e < 4; ++e) fx.stats((size_t)(MROW0 + 4 * (lane >> 4) + e), mu4[e], r4v[e]); }
#pragma unroll
                        for (int e = 0; e < 4; ++e) {
                            const size_t row = (size_t)(MROW0 + 4 * (lane >> 4) + e);
                            const float v = (a[e] - cs1 * mu4[e]) * r4v[e] + bw1;
                            if (step == 3 && ct == NPB / 16) {
                                if ((lane & 15) < 8) { const float z = v + bif[lane & 15]; GT[row * 8 + (lane & 15)] = (lane & 15) < 4 ? z : fminf(z, 0.f) - __logf(1.f + __expf(-fabsf(z))); }
                            } else BIG[row * ldc + coff + rb] = (bf16_t)f2bf(v * sc);
                        }
                    }
                }
            }
        } else if (step == 4) {
            {
                float* KM = (float*)(P.ws + WS_KM) + layer * 72;
                TIDV
                const int gw = bidx() * 8 + wid, NGW = G * 8;
#pragma unroll 1
                for (int task = gw; task < 2049; task += NGW) {
                    const int real = task < 2048, slot = real ? task >> 8 : 8, nr = real ? 32 : NMETA;
                    const size_t r0 = real ? (size_t)(task >> 8) * SEQ + (size_t)(task & 255) * 32 : (size_t)MROW0;
                    float mxv = 0.f;
#pragma unroll 1
                    for (int i0 = 0; i0 < nr; i0 += 8) {
                        u32x4 vr[8];
#pragma unroll
                        for (int j = 0; j < 8; ++j) vr[j] = *(const u32x4*)(BIG + (r0 + i0 + j) * NPB + 2560 + lane * 8);
                        asm volatile("" : "+v"(vr[0]), "+v"(vr[1]), "+v"(vr[2]), "+v"(vr[3]), "+v"(vr[4]), "+v"(vr[5]), "+v"(vr[6]), "+v"(vr[7]));
#pragma unroll
                        for (int j = 0; j < 8; ++j) {
                            const u32x4 v = vr[j];
                            float ss = bflo(v.x) * bflo(v.x) + bfhi(v.x) * bfhi(v.x) + bflo(v.y) * bflo(v.y) + bfhi(v.y) * bfhi(v.y) + bflo(v.z) * bflo(v.z) + bfhi(v.z) * bfhi(v.z) + bflo(v.w) * bflo(v.w) + bfhi(v.w) * bfhi(v.w);
                            ss += __shfl_xor(ss, 1); ss += __shfl_xor(ss, 2); ss += __shfl_xor(ss, 4);
                            mxv = fmaxf(mxv, ss);
                        }
                    }
                    if ((lane & 7) == 0) atomicMax((unsigned*)KM + slot * 8 + (lane >> 3), __builtin_bit_cast(unsigned, mxv));
                }
            }
            for (int u = bidx(); u < 2048 + 4; u += G) { const int bh_ = u < 2048 ? u >> 6 : u - 2048, c_ = u < 2048 ? 1 + (u & 63) : 0; m1_unit(P, layer, bh_, c_, lds); }
        } else if (step == 5) {
            m2_phase(P);
        } else if (step == 6) {
            const float lam_init = layer == 0 ? 0.2f : 0.35550906759f;
            float lam;
            {
                TIDV
                const float* l1 = P.in[12] + layer * 64; const float* k1 = P.in[13] + layer * 64; const float* l2 = P.in[14] + layer * 64; const float* k2 = P.in[15] + layer * 64;
                const float s1 = wave_sum(l1[lane] * k1[lane]), s2 = wave_sum(l2[lane] * k2[lane]);
                lam = expf(s1) - expf(s2) + lam_init;
            }
#pragma unroll 1
            for (int rep_ = 0; rep_ < PROBE_ATT; ++rep_)
#pragma unroll 1
            for (int u = bidx(); u < 2048 + 4; u += G) {
                const int cbv = u & 255, i = u >> 8, jj = cbv & 31, j = (i & 4) ? 63 - jj : jj;
                const bool real = u < 2048; const int bh = real ? ((cbv >> 5) * 4 + (i & 3)) : (u - 2048);
                attn_unit(P, layer, bh >> 2, bh & 3, real ? NMETA + 128 * j : 0, real ? 128 : NMETA, lam, lam_init, lds);
            }
#pragma unroll 1
            for (int rep_ = 0; rep_ < PROBE_M3; ++rep_)
#pragma unroll 1
            for (int u = bidx(); u < 2048 + 4; u += G) { const int bh_ = u < 2048 ? u >> 6 : u - 2048, c_ = u < 2048 ? 1 + (u & 63) : 0; m3_unit(P, layer, bh_, c_, lds); }
        } else if (step == 8) {
            const bf16_t* Y = BIG; const float* bg = P.in[19] + (size_t)layer * 2048;
            pg8::Gemm gm{HB, Wl + OW_GM, MREAL, 2048, DM}; pg8::StaticOrder S; S.init(MREAL, 2048, G, bidx());
            LNCTX
            const pg8::LnFix fx{rows_last, CSl + OC_GM, BWl + OC_GM, 1};
            pg8::EpiGate E{MA, Y, bg, fx};
            pg8::gemm_phase<pg8::EpiGate, pg8::StaticOrder, true, true>(lds, gm, S, E);
            for (int ct = bidx(); ct < 64; ct += G) {
                TIDV
                const int c0 = 16 * ct, R0 = 256 * (c0 >> 7) + (c0 & 127);
                const f32x4 am = sg_tile_blk(HB + (size_t)MROW0 * DM, DM, Wl + OW_GM, DM, R0, lane, wid, (LAS float*)lds), aa = sg_tile_blk(HB + (size_t)MROW0 * DM, DM, Wl + OW_GM, DM, R0 + 128, lane, wid, (LAS float*)lds);
                const int col = c0 + (lane & 15), rb = R0 + (lane & 15);
                if (wid == 0) {
                    float mu4[4], r4v[4], ymv[4], yav[4];
                    const float csm = fx.cs[rb], bwm = fx.bw[rb], csa = fx.cs[rb + 128], bwa = fx.bw[rb + 128];
#pragma unroll
                    for (int e = 0; e < 4; ++e) { const size_t rowl = (size_t)(MROW0 + 4 * (lane >> 4) + e); fx.stats(rowl, mu4[e], r4v[e]); ymv[e] = bflo((unsigned)Y[rowl * 2048 + col]); yav[e] = bflo((unsigned)Y[rowl * 2048 + DM + col]); }
#pragma unroll
                    for (int e = 0; e < 4; ++e) {
                        const size_t row = (size_t)(MROW0 + 4 * (lane >> 4) + e);
                        const float gmv = (am[e] - csm * mu4[e]) * r4v[e] + bwm, gav = (aa[e] - csa * mu4[e]) * r4v[e] + bwa;
                        const float ym = ymv[e], ya = yav[e];
                        MA[row * DM + col] = (bf16_t)f2bf(sigm(gmv) * ym + sigm(gav) * ya);
                    }
                }
            }
        }
        {
            unsigned char* wsb = P.ws; asm volatile("" : "+s"(wsb));
            XcdBarrier xb; xb.bar = (unsigned*)(wsb + WS_BAR); xb.x = xb_xcc_id(); xb.st = (volatile LAS unsigned*)(lds + LDS_BST);
            xcd_barrier(xb);
#ifdef PROBE_SYNC
            for (int i_ = 0; i_ < PROBE_SYNC; ++i_) xcd_barrier(xb);
#endif
        }
    }
}

extern "C" void kernel_launch(void* const* d_in, const int* in_sizes, int n_in, void* d_out, int out_size, void* d_ws, size_t ws_size, hipStream_t stream) {
    static int grid = 0;
    if (grid == 0) {
        if (n_in != 28 || out_size != MREAL * DM || ws_size < WS_END) { fprintf(stderr, "kernel_launch: unexpected shapes (n_in %d out %d ws %zu)\n", n_in, out_size, ws_size); grid = -1; return; }
        int dev = 0, cus = 0, per_cu = 0;
        hipGetDevice(&dev); hipDeviceGetAttribute(&cus, hipDeviceAttributeMultiprocessorCount, dev);
        hipFuncSetAttribute((const void*)hybrid_fwd, hipFuncAttributeMaxDynamicSharedMemorySize, LDS_BYTES);
        hipOccupancyMaxActiveBlocksPerMultiprocessor(&per_cu, (const void*)hybrid_fwd, 512, LDS_BYTES);
        if (per_cu < 1) per_cu = 1;
        grid = cus * per_cu;
        (void)hipGetLastError();
    }
    if (grid < 0) return;
    Params p{};
    for (int i = 0; i < 28; ++i) p.in[i] = (const float*)d_in[i];
    p.out = (float*)d_out; p.ws = (unsigned char*)d_ws;
    void* args[] = {&p};
    hipError_t e = hipLaunchCooperativeKernel((const void*)hybrid_fwd, dim3(grid), dim3(512), args, LDS_BYTES, stream);
    if (e != hipSuccess) fprintf(stderr, "cooperative launch failed: %s (grid %d)\n", hipGetErrorString(e), grid);
}
```

```cpp
#include <hip/hip_runtime.h>
#include <hip/hip_cooperative_groups.h>
#include <cstdio>
#include <cstdint>
namespace cg = cooperative_groups;

__device__ __forceinline__ int tidx() { int t = threadIdx.x; asm volatile("" : "+v"(t)); return t; }
__device__ __forceinline__ int bidx() { int t = blockIdx.x; asm volatile("" : "+s"(t)); return t; }
namespace pg8 {
#define PG8_LAS __attribute__((address_space(3)))
typedef unsigned short bf16_t;
typedef short bf16x8 __attribute__((ext_vector_type(8)));
typedef float f32x4 __attribute__((ext_vector_type(4)));
typedef unsigned u32x4 __attribute__((ext_vector_type(4)));
constexpr int BM = 256, BK = 64, HALF = 128, HTB = HALF * BK * 2  , STAGE_BYTES = 8 * HTB, NXCD = 8, WGM = 8;

__host__ __device__ __forceinline__ int lds_byte(int r, int c) { const int st = (r >> 4) * 2 + (c >> 5), rr = r & 15, cc = c & 31, ob = rr * 64 + cc * 2; return st * 1024 + (ob ^ (((ob >> 9) & 1) << 5)); }
__host__ __device__ __forceinline__ void stage_rc(int b, int& R, int& C) { const int st = b / 1024, sb = b % 1024, swz = sb ^ (((sb >> 9) & 1) << 5); R = (st >> 1) * 16 + swz / 64; C = (st & 1) * 32 + (swz % 64) / 2; }
__host__ __device__ __forceinline__ int perm32(int rho) { const int n = rho >> 4, i = rho & 15; return 8 * (i >> 2) + 4 * n + (i & 3); }

struct Unit { int pm, pn; };
struct Gemm { const bf16_t* A; const bf16_t* Bt; int M, N, K; };

struct StaticOrder {
    int nM, nN, nwg, G, c;
    __host__ __device__ void init(int M, int N, int G_, int c_) { nM = M / BM; nN = N / BM; nwg = nM * nN; G = G_; c = c_; }
    __host__ __device__ bool next(int i, Unit& u) const {
        const long L = (long)i * G + c; if (L >= nwg) return false;
        int wgid = (int)L; { const int q = nwg / NXCD, r = nwg % NXCD, xcd = wgid % NXCD, off = wgid / NXCD; wgid = (xcd < r ? xcd * (q + 1) : r * (q + 1) + (xcd - r) * q) + off; }
        const int nig = WGM * nN, gid = wgid / nig, fm = gid * WGM, gsz = (nM - fm) < WGM ? (nM - fm) : WGM;
        u.pm = fm + ((wgid % nig) % gsz); u.pn = (wgid % nig) / gsz; return true;
    }
    __device__ __forceinline__ void a_ready(const Unit&) const {}
    __device__ __forceinline__ void done(const Unit&) const {}
};

__device__ __forceinline__ unsigned cvt_pk_bf16(float lo, float hi) { unsigned r; asm volatile("v_cvt_pk_bf16_f32 %0, %1, %2" : "=v"(r) : "v"(lo), "v"(hi)); return r; }
typedef float f32x2 __attribute__((ext_vector_type(2)));
__device__ __forceinline__ f32x2 gelu_pk(f32x2 v) {
    const f32x2 av = __builtin_elementwise_abs(v), d = av * 0.2316418882f + 1.0f;
    f32x2 t; t.x = __builtin_amdgcn_rcpf(d.x); t.y = __builtin_amdgcn_rcpf(d.y);
    f32x2 q = t * 0.5307027145f + (-0.7265760135f); q = q * t + 0.7107068705f; q = q * t + (-0.142248368f); q = q * t + 0.127414796f; q = q * t;
    const f32x2 s = (v * v) * (-0.72134752044f);
    f32x2 e; e.x = __builtin_amdgcn_exp2f(s.x); e.y = __builtin_amdgcn_exp2f(s.y);
    const f32x2 m = v * (q * e), r = v - m;
    f32x2 o; o.x = v.x < 0.f ? m.x : r.x; o.y = v.y < 0.f ? m.y : r.y; return o;
}

template <int ACT  > struct EpiBf16 {
    static constexpr bool PERM = true, AFTER_DRAIN = false; static_assert(ACT == 0 || ACT == 1, "EpiBf16: ACT is 0 (none) or 1 (gelu_pk)");
    bf16_t* O; int ldc; const float* bias; int split_cols; size_t split_stride; float scale0;
    __device__ __forceinline__ void operator()(const f32x4 (&acc)[2][2][4][2], const Unit& u, int wr, int wc, int fr, int fq) const {
        const int row0 = u.pm * BM + wr * 64 + fr; int colt = u.pn * BM; bf16_t* base = O;
        float sc = 1.f; if (split_cols) { const int t = colt / split_cols; base += (size_t)t * split_stride; colt -= t * split_cols; if (t == 0) sc = scale0; }
        const int col0 = colt + wc * 32 + 8 * fq, bcol0 = u.pn * BM + wc * 32 + 8 * fq;
        f32x4 bv[2][2];
#pragma unroll
        for (int bj = 0; bj < 2; ++bj)
#pragma unroll
            for (int n = 0; n < 2; ++n) bv[bj][n] = bias ? *(const f32x4*)(bias + bcol0 + bj * HALF + 4 * n) : (f32x4){0.f, 0.f, 0.f, 0.f};
#pragma unroll
        for (int ai = 0; ai < 2; ++ai)
#pragma unroll
            for (int m = 0; m < 4; ++m) { bf16_t* rowp = base + (size_t)(row0 + ai * HALF + m * 16) * ldc + col0;
#pragma unroll
                for (int bj = 0; bj < 2; ++bj) { f32x4 v0 = acc[ai][bj][m][0] + bv[bj][0], v1 = acc[ai][bj][m][1] + bv[bj][1];
                    if (ACT == 1) { f32x2 a = gelu_pk((f32x2){v0[0], v0[1]}), b = gelu_pk((f32x2){v0[2], v0[3]}), c = gelu_pk((f32x2){v1[0], v1[1]}), d = gelu_pk((f32x2){v1[2], v1[3]});
                        v0 = (f32x4){a.x, a.y, b.x, b.y}; v1 = (f32x4){c.x, c.y, d.x, d.y}; }
                    v0 = v0 * sc; v1 = v1 * sc; u32x4 w; w.x = cvt_pk_bf16(v0[0], v0[1]); w.y = cvt_pk_bf16(v0[2], v0[3]); w.z = cvt_pk_bf16(v1[0], v1[1]); w.w = cvt_pk_bf16(v1[2], v1[3]);
                    *(u32x4*)(rowp + bj * HALF) = w; } }
    }
};

struct PanelStats {
    unsigned* xbuf;
    unsigned* cnt;
    unsigned* tmo;
    int ntn; float eps;
    unsigned code;
    __device__ __forceinline__ bool run(const f32x4 (&v)[2][2][4][2], const Unit& u, int wr, int wc, int fr, int fq, PG8_LAS unsigned char* lds, int wid, int lane) const {
        typedef float f32x2v __attribute__((ext_vector_type(2)));
        PG8_LAS f32x2v* P = (PG8_LAS f32x2v*)lds;
        PG8_LAS f32x2v* S = (PG8_LAS f32x2v*)(lds + 8192);
        PG8_LAS unsigned* flag = (PG8_LAS unsigned*)(lds + 8192 + 2048);
#pragma unroll
        for (int ai = 0; ai < 2; ++ai)
#pragma unroll
            for (int m = 0; m < 4; ++m) {
                float s = 0.f;
#pragma unroll
                for (int bj = 0; bj < 2; ++bj)
#pragma unroll
                    for (int n = 0; n < 2; ++n) { const f32x4 x = v[ai][bj][m][n]; s += (x[0] + x[1]) + (x[2] + x[3]); }
                s += __shfl_xor(s, 16); s += __shfl_xor(s, 32);
                const float mw = s * (1.0f / 64.0f); float q = 0.f;
#pragma unroll
                for (int bj = 0; bj < 2; ++bj)
#pragma unroll
                    for (int n = 0; n < 2; ++n) { const f32x4 d = v[ai][bj][m][n] - mw; q += (d[0] * d[0] + d[1] * d[1]) + (d[2] * d[2] + d[3] * d[3]); }
                q += __shfl_xor(q, 16); q += __shfl_xor(q, 32);
                if (fq == 0) P[(ai * HALF + wr * 64 + m * 16 + fr) * 4 + wc] = (f32x2v){mw, q};
            }
        asm volatile("s_waitcnt lgkmcnt(0)" ::: "memory"); __builtin_amdgcn_s_barrier(); asm volatile("" ::: "memory");
#if defined(BROKEN_EXCHANGE_NO_WAIT)
#warning BROKEN CONTROL BUILD: the row-statistics exchange does not wait; results are wrong by design
        if (blockIdx.x >= 64) { const long long t0_ = clock64(); while (clock64() - t0_ < 60000) __builtin_amdgcn_s_sleep(8); }
#endif
        const int row = wid * 32 + (lane & 31);
        if (lane < 32) {
            const f32x2v a = P[row * 4 + 0], b = P[row * 4 + 1], c = P[row * 4 + 2], d = P[row * 4 + 3];
            const float mt = (a.x + b.x + c.x + d.x) * 0.25f;
            const float da = a.x - mt, db = b.x - mt, dc = c.x - mt, dd = d.x - mt;
            const float m2 = (a.y + b.y) + (c.y + d.y) + 64.0f * ((da * da + db * db) + (dc * dc + dd * dd));
            unsigned long long* slot = (unsigned long long*)xbuf + ((size_t)(u.pm * BM + row) * 4 + u.pn);
            __hip_atomic_store(slot, ((unsigned long long)__float_as_uint(m2) << 32) | __float_as_uint(mt), __ATOMIC_RELAXED, __HIP_MEMORY_SCOPE_AGENT);
        }
        asm volatile("s_waitcnt vmcnt(0)" ::: "memory");
        if (lane == 0) __hip_atomic_fetch_add(cnt + 64 * u.pm, 1u, __ATOMIC_RELAXED, __HIP_MEMORY_SCOPE_AGENT);
        if (wid == 0) {
            bool dead = false; const unsigned long long t0 = __builtin_amdgcn_s_memrealtime(); const unsigned want = 8u * (unsigned)ntn;
            for (;;) {
#if defined(BROKEN_EXCHANGE_NO_WAIT)
                break;
#endif
                if ((unsigned)__builtin_amdgcn_readfirstlane(__hip_atomic_load(cnt + 64 * u.pm, __ATOMIC_RELAXED, __HIP_MEMORY_SCOPE_AGENT)) >= want) break;
                if (__builtin_amdgcn_s_memrealtime() - t0 > 2000000ull) {
                    if (lane == 0) { unsigned expect = 0u; __hip_atomic_compare_exchange_strong(tmo + 1, &expect, code | (unsigned)(u.pm & 0xff), __ATOMIC_RELAXED, __ATOMIC_RELAXED, __HIP_MEMORY_SCOPE_AGENT);
                                     __hip_atomic_store(tmo, 1u, __ATOMIC_RELAXED, __HIP_MEMORY_SCOPE_AGENT); }
                    dead = true; break; }
                __builtin_amdgcn_s_sleep(2);
            }
            __builtin_amdgcn_fence(__ATOMIC_ACQUIRE, "agent");
            if (lane == 0) flag[0] = dead ? 1u : 0u;
        }
        asm volatile("s_waitcnt vmcnt(0) lgkmcnt(0)" ::: "memory"); __builtin_amdgcn_s_barrier(); asm volatile("" ::: "memory");
        const bool bad = flag[0] != 0u;
        if (lane < 32) {
            const unsigned long long* slot = (const unsigned long long*)xbuf + (size_t)(u.pm * BM + row) * 4; float mt[4], m2[4]; float ms = 0.f;
#pragma unroll
            for (int t = 0; t < 4; ++t) { if (t < ntn) { const unsigned long long w = __hip_atomic_load(slot + t, __ATOMIC_RELAXED, __HIP_MEMORY_SCOPE_AGENT); mt[t] = __uint_as_float((unsigned)w); m2[t] = __uint_as_float((unsigned)(w >> 32)); } else { mt[t] = 0.f; m2[t] = 0.f; } ms += mt[t]; }
            const float mean = ms / (float)ntn; float q = 0.f;
#pragma unroll
            for (int t = 0; t < 4; ++t) if (t < ntn) { const float dm = mt[t] - mean; q += m2[t] + 256.0f * dm * dm; }
            S[row] = (f32x2v){mean, 1.0f / sqrtf(q / (256.0f * (float)ntn) + eps)};
        }
        asm volatile("s_waitcnt lgkmcnt(0)" ::: "memory"); __builtin_amdgcn_s_barrier(); asm volatile("" ::: "memory");
        return bad;
    }
};
struct EpiLnRes {
    static constexpr bool PERM = false, AFTER_DRAIN = true;
    const float* base; float* out; int ldc; const float* bias; PanelStats st; unsigned poison;
    __device__ __forceinline__ void fused(f32x4 (&acc)[2][2][4][2], const Unit& u, int wr, int wc, int fr, int fq, PG8_LAS unsigned char* lds, int wid, int lane) const {
        typedef float f32x2v __attribute__((ext_vector_type(2)));
        const PG8_LAS f32x2v* S = (const PG8_LAS f32x2v*)(lds + 8192);
        const int col0 = u.pn * BM + wc * 32 + 4 * fq;
#pragma unroll
        for (int bj = 0; bj < 2; ++bj)
#pragma unroll
            for (int n = 0; n < 2; ++n) { const f32x4 bv = bias ? *(const f32x4*)(bias + col0 + bj * HALF + n * 16) : (f32x4){0.f, 0.f, 0.f, 0.f};
#pragma unroll
                for (int ai = 0; ai < 2; ++ai)
#pragma unroll
                    for (int m = 0; m < 4; ++m) acc[ai][bj][m][n] += bv; }
        f32x4 pre[4][2][2];
#pragma unroll
        for (int m = 0; m < 4; ++m) { const size_t off = (size_t)(u.pm * BM + wr * 64 + m * 16 + fr) * ldc + col0;
#pragma unroll
            for (int bj = 0; bj < 2; ++bj)
#pragma unroll
                for (int n = 0; n < 2; ++n) pre[m][bj][n] = *(const f32x4*)(base + off + bj * HALF + n * 16); }
        const bool bad = st.run(acc, u, wr, wc, fr, fq, lds, wid, lane) || poison != 0u;
        const float qnan = __builtin_nanf("");
#pragma unroll
        for (int ai = 0; ai < 2; ++ai)
#pragma unroll
            for (int m = 0; m < 4; ++m) { const int r = ai * HALF + wr * 64 + m * 16 + fr; const f32x2v sr = S[r]; const size_t off = (size_t)(u.pm * BM + r) * ldc + col0;
#pragma unroll
                for (int bj = 0; bj < 2; ++bj)
#pragma unroll
                    for (int n = 0; n < 2; ++n) { const f32x4 bs = ai == 0 ? pre[m][bj][n] : *(const f32x4*)(base + off + bj * HALF + n * 16); f32x4 o = bs + (acc[ai][bj][m][n] - sr.x) * sr.y;
                        if (bad) o = (f32x4){qnan, qnan, qnan, qnan}; *(f32x4*)(out + off + bj * HALF + n * 16) = o; }
                if (m & 1) asm volatile("" ::: "memory"); }
    }
};
struct EpiLnResLn {
    static constexpr bool PERM = false, AFTER_DRAIN = true;
    const float* base; float* out; bf16_t* xn; int ldc; const float* bias; PanelStats st1, st2; unsigned poison;
    __device__ __forceinline__ void fused(f32x4 (&acc)[2][2][4][2], const Unit& u, int wr, int wc, int fr, int fq, PG8_LAS unsigned char* lds, int wid, int lane) const {
        typedef float f32x2v __attribute__((ext_vector_type(2))); typedef unsigned u32x2v __attribute__((ext_vector_type(2)));
        const PG8_LAS f32x2v* S = (const PG8_LAS f32x2v*)(lds + 8192);
        const int col0 = u.pn * BM + wc * 32 + 4 * fq;
#pragma unroll
        for (int bj = 0; bj < 2; ++bj)
#pragma unroll
            for (int n = 0; n < 2; ++n) { const f32x4 bv = bias ? *(const f32x4*)(bias + col0 + bj * HALF + n * 16) : (f32x4){0.f, 0.f, 0.f, 0.f};
#pragma unroll
                for (int ai = 0; ai < 2; ++ai)
#pragma unroll
                    for (int m = 0; m < 4; ++m) acc[ai][bj][m][n] += bv; }
        bool bad = st1.run(acc, u, wr, wc, fr, fq, lds, wid, lane) || poison != 0u;
        const float qnan = __builtin_nanf("");
#pragma unroll
        for (int ai = 0; ai < 2; ++ai)
#pragma unroll
            for (int m = 0; m < 4; ++m) { const int r = ai * HALF + wr * 64 + m * 16 + fr; const f32x2v sr = S[r]; const size_t off = (size_t)(u.pm * BM + r) * ldc + col0;
#pragma unroll
                for (int bj = 0; bj < 2; ++bj)
#pragma unroll
                    for (int n = 0; n < 2; ++n) { const f32x4 bs = *(const f32x4*)(base + off + bj * HALF + n * 16); acc[ai][bj][m][n] = bs + (acc[ai][bj][m][n] - sr.x) * sr.y; }
                asm volatile("" : "+v"(acc[ai][0][m][0]), "+v"(acc[ai][0][m][1]), "+v"(acc[ai][1][m][0]), "+v"(acc[ai][1][m][1]));
                if (m & 1) asm volatile("" ::: "memory"); }
        const bool bad1 = bad;
        bad = st2.run(acc, u, wr, wc, fr, fq, lds, wid, lane) || bad;
#pragma unroll
        for (int ai = 0; ai < 2; ++ai)
#pragma unroll
            for (int m = 0; m < 4; ++m) { const int r = ai * HALF + wr * 64 + m * 16 + fr; const f32x2v sr = S[r]; const size_t off = (size_t)(u.pm * BM + r) * ldc + col0;
#pragma unroll
                for (int bj = 0; bj < 2; ++bj)
#pragma unroll
                    for (int n = 0; n < 2; ++n) { const f32x4 x1 = acc[ai][bj][m][n]; *(f32x4*)(out + off + bj * HALF + n * 16) = bad1 ? (f32x4){qnan, qnan, qnan, qnan} : x1;
                        const f32x4 o = (x1 - sr.x) * sr.y; u32x2v w; w.x = cvt_pk_bf16(o[0], o[1]); w.y = cvt_pk_bf16(o[2], o[3]);
                        if (bad) { w.x = 0x7fc07fc0u; w.y = 0x7fc07fc0u; } *(u32x2v*)(xn + off + bj * HALF + n * 16) = w; }
                asm volatile("" ::: "memory"); }
    }
};

template <class Epi, class Sched, bool ALIGN_EPI = false, bool SP2 = false>
__device__ __forceinline__ void gemm_phase(PG8_LAS unsigned char* lds, const Gemm g, const Sched& S, const Epi& E) {
    const int tid = tidx(), wid = __builtin_amdgcn_readfirstlane(tid >> 6), lane = tid & 63, wr = wid >> 2, wc = wid & 3, fr = lane & 15, fq = lane >> 4;
    const int K = g.K, nt = K / BK;
    unsigned voffA[2], voffB[2];
#pragma unroll
    for (int i = 0; i < 2; ++i) { int R, C; stage_rc(tid * 16 + i * 8192, R, C); const int Rb = Epi::PERM ? ((R & ~31) + perm32(R & 31)) : R;
        voffA[i] = (unsigned)(R * K + C) * 2u; voffB[i] = (unsigned)(Rb * K + C) * 2u; }
    const size_t kstep = (size_t)(BK * 2);
    const size_t hstep = (size_t)HALF * K * 2;
    const size_t tstep = 2 * hstep;
    const unsigned ldsw = (unsigned)wid * 1024u;
    const int aoff = lds_byte(wr * 64 + fr, fq * 8), boff = lds_byte(wc * 32 + fr, fq * 8);
#define PG8_SA(b, h) (((b) * 2 + (h)) * HTB)
#define PG8_SB(b, h) ((4 + (b) * 2 + (h)) * HTB)
#define PG8_STAGE(bufoff, gbase, voff) do { _Pragma("unroll") for (int _i = 0; _i < 2; ++_i) \
        __builtin_amdgcn_global_load_lds((const unsigned*)((const char*)(gbase) + (voff)[_i]), (PG8_LAS unsigned*)(lds + (bufoff) + ldsw + _i * 8192), 16, 0, 0); } while (0)
#define PG8_LDA(dst, b, h) do { _Pragma("unroll") for (int m = 0; m < 4; ++m) _Pragma("unroll") for (int k = 0; k < 2; ++k) dst[m][k] = *(const PG8_LAS bf16x8*)(lds + PG8_SA(b, h) + aoff + m * 2048 + k * 1024); } while (0)
#define PG8_LDB(dst, b, h) do { _Pragma("unroll") for (int n = 0; n < 2; ++n) _Pragma("unroll") for (int k = 0; k < 2; ++k) dst[n][k] = *(const PG8_LAS bf16x8*)(lds + PG8_SB(b, h) + boff + n * 2048 + k * 1024); } while (0)
#define PG8_MMA(ai, bj, At, Bt) do { __builtin_amdgcn_s_setprio(1); _Pragma("unroll") for (int m = 0; m < 4; ++m) _Pragma("unroll") for (int n = 0; n < 2; ++n) _Pragma("unroll") for (int k = 0; k < 2; ++k) \
        acc[ai][bj][m][n] = __builtin_amdgcn_mfma_f32_16x16x32_bf16(Bt[n][k], At[m][k], acc[ai][bj][m][n], 0, 0, 0); __builtin_amdgcn_s_setprio(0); } while (0)
#define PG8_WAIT_V(n) asm volatile("s_waitcnt vmcnt(" #n ")" ::: "memory")
#define PG8_WAIT_L(n) asm volatile("s_waitcnt lgkmcnt(" #n ")" ::: "memory")
#define PG8_BAR __builtin_amdgcn_s_barrier()
#define PG8_SCHED __builtin_amdgcn_sched_barrier(0)
    Unit cur, nxt; int ui = 0;
    if (!S.next(0, cur)) return;
    E.prefetch(cur, tid, lds + 135168);
    f32x4 acc[2][2][4][2];
#pragma unroll
    for (int a = 0; a < 2; ++a)
#pragma unroll
        for (int b = 0; b < 2; ++b)
#pragma unroll
            for (int m = 0; m < 4; ++m)
#pragma unroll
                for (int n = 0; n < 2; ++n) acc[a][b][m][n] = (f32x4){0.f, 0.f, 0.f, 0.f};
    bf16x8 At[4][2], B0[2][2], B1[2][2];
    const char* cA = (const char*)g.A + (size_t)cur.pm * tstep; const char* cB = (const char*)g.Bt + (size_t)cur.pn * tstep;
    S.a_ready(cur);
    if constexpr (SP2) {
        PG8_STAGE(PG8_SB(0, 0), cB, voffB); PG8_STAGE(PG8_SB(0, 1), cB + hstep, voffB); PG8_STAGE(PG8_SA(0, 0), cA, voffA); PG8_STAGE(PG8_SA(0, 1), cA + hstep, voffA);
        if (wr == 1) PG8_BAR;
        PG8_WAIT_V(2); PG8_BAR;
        PG8_STAGE(PG8_SB(1, 0), cB + kstep, voffB); PG8_STAGE(PG8_SA(1, 0), cA + kstep, voffA); PG8_STAGE(PG8_SB(1, 1), cB + hstep + kstep, voffB);
        PG8_WAIT_V(6); PG8_BAR;
    } else {
        PG8_STAGE(PG8_SB(0, 0), cB, voffB); PG8_STAGE(PG8_SA(0, 0), cA, voffA); PG8_STAGE(PG8_SB(0, 1), cB + hstep, voffB); PG8_STAGE(PG8_SA(0, 1), cA + hstep, voffA);
        if (wr == 1) PG8_BAR;
        PG8_WAIT_V(4); PG8_BAR;
        PG8_STAGE(PG8_SB(1, 0), cB + kstep, voffB); PG8_STAGE(PG8_SA(1, 0), cA + kstep, voffA); PG8_STAGE(PG8_SB(1, 1), cB + hstep + kstep, voffB);
        PG8_WAIT_V(6); PG8_BAR;
    }
    for (;;) {
        const bool has_next = S.next(ui + 1, nxt);
        const char* nA = has_next ? (const char*)g.A + (size_t)nxt.pm * tstep : cA; const char* nB = has_next ? (const char*)g.Bt + (size_t)nxt.pn * tstep : cB;
        for (int t = 0; t < nt; t += 2) {
            const bool last = (t == nt - 2);
            const char* a1 = cA + (size_t)(t + 1) * kstep;
            const char* a2 = last ? nA : cA + (size_t)(t + 2) * kstep; const char* b2 = last ? nB : cB + (size_t)(t + 2) * kstep;
            const char* a3 = a2 + kstep; const char* b3 = b2 + kstep;
            if (last && has_next) S.a_ready(nxt);
            if constexpr (SP2) {
            PG8_LDB(B0, 0, 0); PG8_LDB(B1, 0, 1); PG8_SCHED; PG8_LDA(At, 0, 0); PG8_STAGE(PG8_SA(1, 1), a1 + hstep, voffA);
            PG8_WAIT_V(8); PG8_WAIT_L(0); PG8_BAR; PG8_MMA(0, 0, At, B0); PG8_MMA(0, 1, At, B1); PG8_BAR; PG8_SCHED;
            PG8_LDA(At, 0, 1); PG8_STAGE(PG8_SB(0, 0), b2, voffB); PG8_STAGE(PG8_SB(0, 1), b2 + hstep, voffB); PG8_STAGE(PG8_SA(0, 0), a2, voffA);
            PG8_WAIT_V(8); PG8_WAIT_L(0); PG8_BAR; PG8_MMA(1, 0, At, B0); PG8_MMA(1, 1, At, B1); PG8_BAR; PG8_SCHED;
            PG8_LDB(B0, 1, 0); PG8_LDB(B1, 1, 1); PG8_SCHED; PG8_LDA(At, 1, 0); PG8_STAGE(PG8_SA(0, 1), a2 + hstep, voffA);
            PG8_WAIT_V(8); PG8_WAIT_L(0); PG8_BAR; PG8_MMA(0, 0, At, B0); PG8_MMA(0, 1, At, B1); PG8_BAR; PG8_SCHED;
            PG8_LDA(At, 1, 1); PG8_STAGE(PG8_SB(1, 0), b3, voffB); PG8_STAGE(PG8_SB(1, 1), b3 + hstep, voffB); PG8_STAGE(PG8_SA(1, 0), a3, voffA);
            PG8_WAIT_V(8); PG8_WAIT_L(0); PG8_BAR; PG8_MMA(1, 0, At, B0); PG8_MMA(1, 1, At, B1); PG8_BAR; PG8_SCHED;
            } else {
            PG8_LDB(B0, 0, 0); PG8_SCHED; PG8_LDA(At, 0, 0); PG8_STAGE(PG8_SA(1, 1), a1 + hstep, voffA);
            PG8_WAIT_L(8); PG8_BAR; PG8_WAIT_L(0); PG8_MMA(0, 0, At, B0); PG8_BAR; PG8_SCHED;
            PG8_LDB(B1, 0, 1); PG8_STAGE(PG8_SB(0, 0), b2, voffB);
            PG8_BAR; PG8_WAIT_L(0); PG8_MMA(0, 1, At, B1); PG8_BAR;
            PG8_LDA(At, 0, 1); PG8_STAGE(PG8_SA(0, 0), a2, voffA);
            PG8_BAR; PG8_WAIT_L(0); PG8_MMA(1, 0, At, B0); PG8_BAR; PG8_SCHED;
            PG8_STAGE(PG8_SB(0, 1), b2 + hstep, voffB);
            PG8_WAIT_V(6); PG8_BAR; PG8_MMA(1, 1, At, B1); PG8_BAR;
            PG8_LDB(B0, 1, 0); PG8_SCHED; PG8_LDA(At, 1, 0); PG8_STAGE(PG8_SA(0, 1), a2 + hstep, voffA);
            PG8_WAIT_L(8); PG8_BAR; PG8_WAIT_L(0); PG8_MMA(0, 0, At, B0); PG8_BAR; PG8_SCHED;
            PG8_LDB(B1, 1, 1); PG8_STAGE(PG8_SB(1, 0), b3, voffB);
            PG8_BAR; PG8_WAIT_L(0); PG8_MMA(0, 1, At, B1); PG8_BAR;
            PG8_LDA(At, 1, 1); PG8_STAGE(PG8_SA(1, 0), a3, voffA);
            PG8_BAR; PG8_WAIT_L(0); PG8_MMA(1, 0, At, B0); PG8_BAR; PG8_SCHED;
            PG8_STAGE(PG8_SB(1, 1), b3 + hstep, voffB);
            PG8_WAIT_V(6); PG8_BAR; PG8_MMA(1, 1, At, B1); PG8_BAR;
            }
        }
        if constexpr (ALIGN_EPI) { if (wr == 0) PG8_BAR; }
        if constexpr (!Epi::AFTER_DRAIN) { E(acc, cur, wr, wc, fr, fq, lds + 135168 + (ui & 1) * 4096); if (has_next) E.prefetch(nxt, tid, lds + 135168 + ((ui + 1) & 1) * 4096); S.done(cur); }
        if (!has_next) break;
#pragma unroll
        for (int a = 0; a < 2; ++a)
#pragma unroll
            for (int b = 0; b < 2; ++b)
#pragma unroll
                for (int m = 0; m < 4; ++m)
#pragma unroll
                    for (int n = 0; n < 2; ++n) acc[a][b][m][n] = (f32x4){0.f, 0.f, 0.f, 0.f};
        cur = nxt; cA = nA; cB = nB; ++ui;
        if constexpr (ALIGN_EPI) { if (wr == 1) PG8_BAR; }
    }
    PG8_WAIT_V(0);
    if constexpr (!ALIGN_EPI) { if (wr == 0) PG8_BAR; }
    PG8_BAR;
    if constexpr (Epi::AFTER_DRAIN) { E.fused(acc, cur, wr, wc, fr, fq, lds, wid, lane); S.done(cur); }
#undef PG8_SA
#undef PG8_SB
#undef PG8_STAGE
#undef PG8_LDA
#undef PG8_LDB
#undef PG8_MMA
#undef PG8_WAIT_V
#undef PG8_WAIT_L
#undef PG8_BAR
#undef PG8_SCHED
}
}

#define LAS __attribute__((address_space(3)))
typedef unsigned short bf16_t;
typedef short bf16x8 __attribute__((ext_vector_type(8)));
typedef short s16x4 __attribute__((ext_vector_type(4)));
typedef short v4i16_t __attribute__((ext_vector_type(4)));
typedef float f32x4 __attribute__((ext_vector_type(4)));
typedef float f32x16 __attribute__((ext_vector_type(16)));
typedef unsigned u32x4 __attribute__((ext_vector_type(4)));
typedef unsigned u32x2 __attribute__((ext_vector_type(2)));

constexpr int DM = 1024, NB = 8, SEQ = 8192, NMETA = 16, LSEQ = SEQ + NMETA, MREAL = NB * SEQ, MROW0 = MREAL, MPAD = MREAL + 256;
constexpr int FF = 2816, NPB = 3584, NPBW = 3840, DPROJ = 5640;
constexpr int NCH = 65;
constexpr float ALPHA = 1.41421356237f;
constexpr float LOG2E = 1.4426950408889634f;
constexpr float QSCALE = 0.125f * LOG2E;
constexpr float NEGF = -1e30f;
constexpr float LN_EPS = 1e-5f;

constexpr size_t OW_GU1 = 0, OW_D1 = 5767168, OW_PB = 8650752, OW_GM = 12582912, OW_BM = 14680064, OW_BA = 15204352, OW_OUT = 15728640, OW_GU2 = 16777216, OW_D2 = 22544384, OW_LAYER = 25427968;
constexpr int OC_GU1 = 0, OC_PB = 5632, OC_GM = 9472, OC_GU2 = 11520, OC_N = 17152;
constexpr size_t MiB = 1u << 20;
constexpr size_t WS_ROWS = 0;
constexpr size_t WS_CSBW = 4 * MiB;
constexpr size_t WS_HFM = 5 * MiB;
constexpr size_t WS_GATES = 6 * MiB;
constexpr size_t WS_BAR = 9 * MiB;
constexpr size_t WS_KM = WS_BAR + 16384;
constexpr size_t WS_SC = 10 * MiB;
constexpr size_t WS_NST = 11 * MiB;
constexpr size_t WS_STATS = 13 * MiB;
constexpr size_t WS_W = 16 * MiB;
constexpr size_t WS_HB = 113 * MiB;
constexpr size_t WS_LO = 242 * MiB;
constexpr size_t WS_CST = 371 * MiB;
constexpr size_t WS_MA = 436 * MiB;
constexpr size_t WS_BIG = 565 * MiB;
constexpr size_t WS_END = 1015 * MiB;

struct Params {
    const float* in[28];
    float* out; unsigned char* ws;
};

__device__ __forceinline__ unsigned f2bf(float f) { unsigned u = __builtin_bit_cast(unsigned, f); return (u + 0x7fffu + ((u >> 16) & 1u)) >> 16; }
typedef float f32x2_t __attribute__((ext_vector_type(2))); typedef __bf16 bf16x2_t __attribute__((ext_vector_type(2)));
__device__ __forceinline__ unsigned pk2(float lo, float hi) { f32x2_t v = {lo, hi}; bf16x2_t b = __builtin_convertvector(v, bf16x2_t); return __builtin_bit_cast(unsigned, b); }
__device__ __forceinline__ u32x4 pack8(f32x4 a, f32x4 b) { u32x4 w; w.x = pk2(a[0], a[1]); w.y = pk2(a[2], a[3]); w.z = pk2(b[0], b[1]); w.w = pk2(b[2], b[3]); return w; }
__device__ __forceinline__ float bflo(unsigned w) { return __builtin_bit_cast(float, w << 16); }
__device__ __forceinline__ float bfhi(unsigned w) { return __builtin_bit_cast(float, w & 0xffff0000u); }
__device__ __forceinline__ float ex2(float x) { return __builtin_amdgcn_exp2f(x); }
__device__ __forceinline__ float sigm(float x) { return __builtin_amdgcn_rcpf(1.f + ex2(-x * LOG2E)); }
__device__ __forceinline__ float siluf(float x) { return x * sigm(x); }
__device__ __forceinline__ float wave_sum(float v) {
#pragma unroll
    for (int o = 1; o < 64; o <<= 1) v += __shfl_xor(v, o);
    return v;
}
__device__ __forceinline__ float wave_max(float v) {
#pragma unroll
    for (int o = 1; o < 64; o <<= 1) v = fmaxf(v, __shfl_xor(v, o));
    return v;
}
__device__ __forceinline__ size_t seqrow(int b, int pos) { return pos < NMETA ? (size_t)(MROW0 + pos) : (size_t)b * SEQ + (size_t)(pos - NMETA); }
__device__ __forceinline__ f32x16 mfma32(bf16x8 a, bf16x8 b, f32x16 c) { return __builtin_amdgcn_mfma_f32_32x32x16_bf16(a, b, c, 0, 0, 0); }
__device__ __forceinline__ s16x4 vtr(const LAS unsigned char* p) { return __builtin_bit_cast(s16x4, __builtin_amdgcn_ds_read_tr16_b64_v4i16((LAS v4i16_t*)p)); }
__device__ __forceinline__ bf16x8 cat8(s16x4 lo, s16x4 hi) { return (bf16x8){lo[0], lo[1], lo[2], lo[3], hi[0], hi[1], hi[2], hi[3]}; }

namespace pg8 {
__device__ __forceinline__ void tab_prefetch(const float* rows, const float* v0, const float* v1, int pm, int cbase, int tid, PG8_LAS unsigned char* tab) {
    const int wid = __builtin_amdgcn_readfirstlane(tid >> 6), lane = tid & 63;
    if (rows) __builtin_amdgcn_global_load_lds((const unsigned*)(rows + (size_t)pm * 512 + tid), (PG8_LAS unsigned*)(tab + wid * 256), 4, 0, 0);
    const float* src = (wid < 4 ? v0 + (wid * 64 + lane) : v1 + ((wid - 4) * 64 + lane)) + cbase;
    __builtin_amdgcn_global_load_lds((const unsigned*)src, (PG8_LAS unsigned*)(tab + 2048 + wid * 256), 4, 0, 0);
}
__device__ __forceinline__ void tab_ready() { asm volatile("s_waitcnt vmcnt(14)" ::: "memory"); __builtin_amdgcn_s_barrier(); asm volatile("" ::: "memory"); }
__device__ __forceinline__ void tab_stats(const PG8_LAS unsigned char* tab, int rloc, float& mu, float& r) {
    const f32x2_t st = *(const PG8_LAS f32x2_t*)(tab + rloc * 8); mu = st.x * (1.f / DM); r = __builtin_amdgcn_rsqf(st.y * (1.f / DM) - mu * mu + LN_EPS);
}
struct LnFix {
    const float* rows; const float* cs; const float* bw; int on;
    __device__ __forceinline__ void stats(size_t row, float& mu, float& r) const {
        const f32x2_t st = *(const f32x2_t*)(rows + row * 2); mu = st.x * (1.f / DM); r = __builtin_amdgcn_rsqf(st.y * (1.f / DM) - mu * mu + LN_EPS);
    }
};
struct EpiSwiglu {
    static constexpr bool PERM = true, AFTER_DRAIN = false;
    bf16_t* O; int ldc; LnFix fx;
    __device__ __forceinline__ void prefetch(const Unit& u, int tid, PG8_LAS unsigned char* tab) const { if (fx.on) tab_prefetch(fx.rows, fx.cs, fx.bw, u.pm, u.pn * BM, tid, tab); }
    __device__ __forceinline__ void operator()(const f32x4 (&acc)[2][2][4][2], const Unit& u, int wr, int wc, int fr, int fq, const PG8_LAS unsigned char* tab) const {
        const int row0 = u.pm * BM + wr * 64 + fr, col0 = u.pn * 128 + wc * 32 + 8 * fq, cl = wc * 32 + 8 * fq;
        if (fx.on) tab_ready();
#pragma unroll
        for (int ai = 0; ai < 2; ++ai)
#pragma unroll
            for (int m = 0; m < 4; ++m) {
                const size_t row = (size_t)(row0 + ai * HALF + m * 16);
                float mu = 0.f, r = 1.f; if (fx.on) tab_stats(tab, wr * 64 + fr + ai * HALF + m * 16, mu, r);
                u32x4 w;
#pragma unroll
                for (int n = 0; n < 2; ++n) {
                    f32x4 csg = {0.f, 0.f, 0.f, 0.f}, bwg = csg, csu = csg, bwu = csg;
                    if (fx.on) { csg = *(const PG8_LAS f32x4*)(tab + 2048 + (cl + 4 * n) * 4); bwg = *(const PG8_LAS f32x4*)(tab + 3072 + (cl + 4 * n) * 4); csu = *(const PG8_LAS f32x4*)(tab + 2048 + (cl + HALF + 4 * n) * 4); bwu = *(const PG8_LAS f32x4*)(tab + 3072 + (cl + HALF + 4 * n) * 4); }
                    const f32x4 g = (acc[ai][0][m][n] - csg * mu) * r + bwg, up = (acc[ai][1][m][n] - csu * mu) * r + bwu;
                    const unsigned lo = pk2(siluf(g[0]) * up[0], siluf(g[1]) * up[1]), hi = pk2(siluf(g[2]) * up[2], siluf(g[3]) * up[3]);
                    if (n == 0) { w.x = lo; w.y = hi; } else { w.z = lo; w.w = hi; }
                }
                *(u32x4*)(O + row * ldc + col0) = w;
            }
    }
};
struct EpiPlain {
    static constexpr bool PERM = true, AFTER_DRAIN = false;
    bf16_t* O; int ldc; int coff; int slo, shi; float scale; LnFix fx; float* GT; const float* bif;
    __device__ __forceinline__ void prefetch(const Unit& u, int tid, PG8_LAS unsigned char* tab) const { if (fx.on) tab_prefetch(fx.rows, fx.cs, fx.bw, u.pm, u.pn * BM, tid, tab); }
    __device__ __forceinline__ void operator()(const f32x4 (&acc)[2][2][4][2], const Unit& u, int wr, int wc, int fr, int fq, const PG8_LAS unsigned char* tab) const {
        const int row0 = u.pm * BM + wr * 64 + fr, col0 = coff + u.pn * BM + wc * 32 + 8 * fq, cl = wc * 32 + 8 * fq;
        if (fx.on) tab_ready();
        if (GT && u.pn == 14) {
            if (wc == 0 && fq == 0) {
                const f32x4 cs0 = *(const PG8_LAS f32x4*)(tab + 2048 + cl * 4), cs1 = *(const PG8_LAS f32x4*)(tab + 2048 + (cl + 4) * 4);
                const f32x4 bw0 = *(const PG8_LAS f32x4*)(tab + 3072 + cl * 4) + *(const f32x4*)(bif), bw1 = *(const PG8_LAS f32x4*)(tab + 3072 + (cl + 4) * 4) + *(const f32x4*)(bif + 4);
#pragma unroll
                for (int ai = 0; ai < 2; ++ai)
#pragma unroll
                    for (int m = 0; m < 4; ++m) {
                        const size_t row = (size_t)(row0 + ai * HALF + m * 16);
                        float mu, r; tab_stats(tab, wr * 64 + fr + ai * HALF + m * 16, mu, r);
                        const f32x4 li = (acc[ai][0][m][0] - cs0 * mu) * r + bw0, z = (acc[ai][0][m][1] - cs1 * mu) * r + bw1;
                        f32x4 lf;
#pragma unroll
                        for (int e = 0; e < 4; ++e) lf[e] = fminf(z[e], 0.f) - __logf(1.f + __expf(-fabsf(z[e])));
                        *(f32x4*)(GT + row * 8) = li; *(f32x4*)(GT + row * 8 + 4) = lf;
                    }
            }
            return;
        }
        const float sc = (u.pn >= slo && u.pn < shi) ? scale : 1.f;
#pragma unroll
        for (int ai = 0; ai < 2; ++ai)
#pragma unroll
            for (int m = 0; m < 4; ++m) {
                const size_t row = (size_t)(row0 + ai * HALF + m * 16);
                float mu = 0.f, r = 1.f; if (fx.on) tab_stats(tab, wr * 64 + fr + ai * HALF + m * 16, mu, r);
#pragma unroll
                for (int bj = 0; bj < 2; ++bj) {
                    u32x4 w;
#pragma unroll
                    for (int n = 0; n < 2; ++n) {
                        f32x4 cs4 = {0.f, 0.f, 0.f, 0.f}, bw4 = cs4;
                        if (fx.on) { cs4 = *(const PG8_LAS f32x4*)(tab + 2048 + (cl + bj * HALF + 4 * n) * 4); bw4 = *(const PG8_LAS f32x4*)(tab + 3072 + (cl + bj * HALF + 4 * n) * 4); }
                        const f32x4 v = ((acc[ai][bj][m][n] - cs4 * mu) * r + bw4) * sc;
                        if (n == 0) { w.x = pk2(v[0], v[1]); w.y = pk2(v[2], v[3]); } else { w.z = pk2(v[0], v[1]); w.w = pk2(v[2], v[3]); }
                    }
                    *(u32x4*)(O + row * ldc + col0 + bj * HALF) = w;
                }
            }
    }
};
struct EpiResid {
    static constexpr bool PERM = true, AFTER_DRAIN = false;
    const float* src; bf16_t* LO; bf16_t* HB; const float* rows_prev; float* rows_cur; const float* gam; const float* bet; float s; int raw;
    __device__ __forceinline__ void prefetch(const Unit& u, int tid, PG8_LAS unsigned char* tab) const { if (!raw) tab_prefetch(rows_prev, gam, bet, u.pm, u.pn * BM, tid, tab); }
    __device__ __forceinline__ void operator()(const f32x4 (&acc)[2][2][4][2], const Unit& u, int wr, int wc, int fr, int fq, const PG8_LAS unsigned char* tab) const {
        const int row0 = u.pm * BM + wr * 64 + fr, col0 = u.pn * BM + wc * 32 + 8 * fq, cl = wc * 32 + 8 * fq;
        if (!raw) tab_ready();
#pragma unroll
        for (int ai = 0; ai < 2; ++ai)
#pragma unroll
            for (int m = 0; m < 4; ++m) {
                const size_t row = (size_t)(row0 + ai * HALF + m * 16);
                float mu = 0.f, rs = 1.f;
                if (!raw) tab_stats(tab, wr * 64 + fr + ai * HALF + m * 16, mu, rs);
                const float ar = ALPHA * rs, am = -ALPHA * rs * mu;
                float s1 = 0.f, s2 = 0.f;
#pragma unroll
                for (int bj = 0; bj < 2; ++bj) {
                    f32x4 g0 = {1.f, 1.f, 1.f, 1.f}, g1 = g0, b0 = {0.f, 0.f, 0.f, 0.f}, b1 = b0;
                    if (!raw) { g0 = *(const PG8_LAS f32x4*)(tab + 2048 + (cl + bj * HALF) * 4); g1 = *(const PG8_LAS f32x4*)(tab + 2048 + (cl + bj * HALF + 4) * 4); b0 = *(const PG8_LAS f32x4*)(tab + 3072 + (cl + bj * HALF) * 4); b1 = *(const PG8_LAS f32x4*)(tab + 3072 + (cl + bj * HALF + 4) * 4); }
                    f32x4 x0, x1;
                    if (raw) { x0 = *(const f32x4*)(src + row * DM + col0 + bj * HALF); x1 = *(const f32x4*)(src + row * DM + col0 + bj * HALF + 4); }
                    else { const u32x4 hi = *(const u32x4*)(HB + row * DM + col0 + bj * HALF), lo = *(const u32x4*)(LO + row * DM + col0 + bj * HALF);
                        x0 = (f32x4){bflo(hi.x) + bflo(lo.x), bfhi(hi.x) + bfhi(lo.x), bflo(hi.y) + bflo(lo.y), bfhi(hi.y) + bfhi(lo.y)};
                        x1 = (f32x4){bflo(hi.z) + bflo(lo.z), bfhi(hi.z) + bfhi(lo.z), bflo(hi.w) + bflo(lo.w), bfhi(hi.w) + bfhi(lo.w)}; }
                    const f32x4 o0 = (x0 * ar + am) * g0 + b0 * ALPHA + acc[ai][bj][m][0] * s, o1 = (x1 * ar + am) * g1 + b1 * ALPHA + acc[ai][bj][m][1] * s;
                    const u32x4 nh = pack8(o0, o1);
                    const f32x4 d0 = {o0[0] - bflo(nh.x), o0[1] - bfhi(nh.x), o0[2] - bflo(nh.y), o0[3] - bfhi(nh.y)}, d1 = {o1[0] - bflo(nh.z), o1[1] - bfhi(nh.z), o1[2] - bflo(nh.w), o1[3] - bfhi(nh.w)};
                    *(u32x4*)(HB + row * DM + col0 + bj * HALF) = nh; *(u32x4*)(LO + row * DM + col0 + bj * HALF) = pack8(d0, d1);
                    s1 += ((o0[0] + o0[1]) + (o0[2] + o0[3])) + ((o1[0] + o1[1]) + (o1[2] + o1[3]));
                    s2 += ((o0[0] * o0[0] + o0[1] * o0[1]) + (o0[2] * o0[2] + o0[3] * o0[3])) + ((o1[0] * o1[0] + o1[1] * o1[1]) + (o1[2] * o1[2] + o1[3] * o1[3]));
                }
                s1 += __shfl_xor(s1, 16); s1 += __shfl_xor(s1, 32); s2 += __shfl_xor(s2, 16); s2 += __shfl_xor(s2, 32);
                if (fq == 0) { float* rp = rows_cur + row * 2; atomicAdd(rp, s1); atomicAdd(rp + 1, s2); }
                asm volatile("" ::: "memory");
            }
    }
};
struct EpiGate {
    static constexpr bool PERM = true, AFTER_DRAIN = false;
    bf16_t* U; const bf16_t* Y; const float* bg; LnFix fx;
    __device__ __forceinline__ void prefetch(const Unit& u, int tid, PG8_LAS unsigned char* tab) const { tab_prefetch(fx.rows, fx.cs, fx.bw, u.pm, u.pn * BM, tid, tab); }
    __device__ __forceinline__ void operator()(const f32x4 (&acc)[2][2][4][2], const Unit& u, int wr, int wc, int fr, int fq, const PG8_LAS unsigned char* tab) const {
        const int row0 = u.pm * BM + wr * 64 + fr, col0 = u.pn * 128 + wc * 32 + 8 * fq, cl = wc * 32 + 8 * fq;
        tab_ready();
#pragma unroll
        for (int ai = 0; ai < 2; ++ai)
#pragma unroll
            for (int m = 0; m < 4; ++m) {
                const size_t row = (size_t)(row0 + ai * HALF + m * 16);
                float mu, r; tab_stats(tab, wr * 64 + fr + ai * HALF + m * 16, mu, r);
                const u32x4 ym = *(const u32x4*)(Y + row * 2048 + col0), ya = *(const u32x4*)(Y + row * 2048 + DM + col0);
                u32x4 w;
#pragma unroll
                for (int n = 0; n < 2; ++n) {
                    const f32x4 csm = *(const PG8_LAS f32x4*)(tab + 2048 + (cl + 4 * n) * 4), bm = *(const PG8_LAS f32x4*)(tab + 3072 + (cl + 4 * n) * 4);
                    const f32x4 csa = *(const PG8_LAS f32x4*)(tab + 2048 + (cl + HALF + 4 * n) * 4), ba = *(const PG8_LAS f32x4*)(tab + 3072 + (cl + HALF + 4 * n) * 4);
                    const f32x4 gm = (acc[ai][0][m][n] - csm * mu) * r + bm, ga = (acc[ai][1][m][n] - csa * mu) * r + ba;
                    const unsigned y0 = n ? ym.z : ym.x, y1 = n ? ym.w : ym.y, a0 = n ? ya.z : ya.x, a1 = n ? ya.w : ya.y;
                    const unsigned lo = pk2(sigm(gm[0]) * bflo(y0) + sigm(ga[0]) * bflo(a0), sigm(gm[1]) * bfhi(y0) + sigm(ga[1]) * bfhi(a0));
                    const unsigned hi = pk2(sigm(gm[2]) * bflo(y1) + sigm(ga[2]) * bflo(a1), sigm(gm[3]) * bfhi(y1) + sigm(ga[3]) * bfhi(a1));
                    if (n == 0) { w.x = lo; w.y = hi; } else { w.z = lo; w.w = hi; }
                }
                *(u32x4*)(U + row * DM + col0) = w;
            }
    }
};
}

__device__ __forceinline__ f32x4 sg_tile(const bf16_t* A, int lda, const bf16_t* Bt, int K, int n0, int lane) {
    const bf16_t* ap = A + (size_t)(lane & 15) * lda + 8 * (lane >> 4);
    const bf16_t* bp = Bt + (size_t)(n0 + (lane & 15)) * K + 8 * (lane >> 4);
    f32x4 acc = {0.f, 0.f, 0.f, 0.f};
#pragma unroll 8
    for (int k = 0; k < K; k += 32) {
        const bf16x8 a = *(const bf16x8*)(ap + k), b = *(const bf16x8*)(bp + k);
        acc = __builtin_amdgcn_mfma_f32_16x16x32_bf16(a, b, acc, 0, 0, 0);
    }
    return acc;
}

__device__ __forceinline__ f32x4 sg_tile_blk(const bf16_t* A, int lda, const bf16_t* Bt, int K, int n0, int lane, int wid, LAS float* red) {
    const int K8 = K >> 3;
    const bf16_t* ap = A + (size_t)(lane & 15) * lda + 8 * (lane >> 4) + wid * K8;
    const bf16_t* bp = Bt + (size_t)(n0 + (lane & 15)) * K + 8 * (lane >> 4) + wid * K8;
    f32x4 acc = {0.f, 0.f, 0.f, 0.f};
#pragma unroll 1
    for (int k = 0; k < K8; k += 128) {
        bf16x8 av[4], bv[4];
#pragma unroll
        for (int j = 0; j < 4; ++j) { const int kk = k + 32 * j < K8 ? k + 32 * j : k; av[j] = *(const bf16x8*)(ap + kk); bv[j] = *(const bf16x8*)(bp + kk); }
        asm volatile("" : "+v"(av[0]), "+v"(av[1]), "+v"(av[2]), "+v"(av[3]), "+v"(bv[0]), "+v"(bv[1]), "+v"(bv[2]), "+v"(bv[3]));
#pragma unroll
        for (int j = 0; j < 4; ++j) if (k + 32 * j < K8) acc = __builtin_amdgcn_mfma_f32_16x16x32_bf16(av[j], bv[j], acc, 0, 0, 0);
    }
    *(LAS f32x4*)(red + wid * 256 + lane * 4) = acc;
    __syncthreads();
    f32x4 sum = {0.f, 0.f, 0.f, 0.f};
    if (wid == 0) {
#pragma unroll
        for (int w = 0; w < 8; ++w) sum = sum + *(const LAS f32x4*)(red + w * 256 + lane * 4);
    }
    __syncthreads();
    return sum;
}

__device__ __forceinline__ void tr_rows(const float* Wsrc, int ldw, int K, bf16_t* dst, int kb0, int nkb, int nv4, const float* g, const float* bb, float* cs, float* bw, LAS float* scr, int lane, const float* addb = nullptr) {
    float csp[4] = {0.f, 0.f, 0.f, 0.f}, bwp[4] = {0.f, 0.f, 0.f, 0.f};
    const int c = lane & 7;
#pragma unroll 1
    for (int kb = kb0; kb < kb0 + nkb; ++kb) {
        const int k0 = 64 * kb;
        f32x4 vv[8];
        const bool okl = (lane & 7) < nv4; const int n4 = (lane & 7) * 4;
#pragma unroll
        for (int i = 0; i < 8; ++i) vv[i] = *(const f32x4*)(Wsrc + (size_t)(k0 + 8 * i + (lane >> 3)) * ldw + (okl ? n4 : 0));
        asm volatile("" : "+v"(vv[0]), "+v"(vv[1]), "+v"(vv[2]), "+v"(vv[3]), "+v"(vv[4]), "+v"(vv[5]), "+v"(vv[6]), "+v"(vv[7]));
#pragma unroll
        for (int i = 0; i < 8; ++i) { const int kk = 8 * i + (lane >> 3); f32x4 v = vv[i]; if (!okl) v = (f32x4){0.f, 0.f, 0.f, 0.f};
            scr[kk * 33 + n4] = v[0]; scr[kk * 33 + n4 + 1] = v[1]; scr[kk * 33 + n4 + 2] = v[2]; scr[kk * 33 + n4 + 3] = v[3]; }
        f32x4 g0 = {1.f, 1.f, 1.f, 1.f}, g1 = g0, b0 = {0.f, 0.f, 0.f, 0.f}, b1 = b0;
        if (g) { g0 = *(const f32x4*)(g + k0 + 8 * c); g1 = *(const f32x4*)(g + k0 + 8 * c + 4); b0 = *(const f32x4*)(bb + k0 + 8 * c); b1 = *(const f32x4*)(bb + k0 + 8 * c + 4); }
        asm volatile("s_waitcnt lgkmcnt(0)" ::: "memory");
#pragma unroll
        for (int j = 0; j < 4; ++j) {
            const int n = (lane >> 3) + 8 * j; const LAS float* sp = scr + (8 * c) * 33 + n;
            const float x0 = sp[0 * 33], x1 = sp[1 * 33], x2 = sp[2 * 33], x3 = sp[3 * 33], x4 = sp[4 * 33], x5 = sp[5 * 33], x6 = sp[6 * 33], x7 = sp[7 * 33];
            u32x4 o; o.x = pk2(x0 * g0[0], x1 * g0[1]); o.y = pk2(x2 * g0[2], x3 * g0[3]); o.z = pk2(x4 * g1[0], x5 * g1[1]); o.w = pk2(x6 * g1[2], x7 * g1[3]);
            *(u32x4*)(dst + (size_t)n * K + k0 + 8 * c) = o;
            csp[j] += ((bflo(o.x) + bfhi(o.x)) + (bflo(o.y) + bfhi(o.y))) + ((bflo(o.z) + bfhi(o.z)) + (bflo(o.w) + bfhi(o.w)));
            bwp[j] += ((x0 * b0[0] + x1 * b0[1]) + (x2 * b0[2] + x3 * b0[3])) + ((x4 * b1[0] + x5 * b1[1]) + (x6 * b1[2] + x7 * b1[3]));
        }
        asm volatile("s_waitcnt lgkmcnt(0)" ::: "memory");
    }
    if (g) {
#pragma unroll
        for (int j = 0; j < 4; ++j) {
            float a = csp[j], b = bwp[j];
            a += __shfl_xor(a, 1); a += __shfl_xor(a, 2); a += __shfl_xor(a, 4); b += __shfl_xor(b, 1); b += __shfl_xor(b, 2); b += __shfl_xor(b, 4);
            if (c == 0) { cs[(lane >> 3) + 8 * j] = a; bw[(lane >> 3) + 8 * j] = b + (addb ? addb[(lane >> 3) + 8 * j] : 0.f); }
        }
    }
}
constexpr int CW_ITEMS = 824;
__device__ __forceinline__ void conv_weight_item(const Params& P, int layer, int it, LAS float* scr, int lane) {
    bf16_t* W = (bf16_t*)(P.ws + WS_W) + (size_t)layer * OW_LAYER;
    float* CS = (float*)(P.ws + WS_CSBW) + (size_t)layer * 2 * OC_N; float* BW = CS + OC_N;
    const float* wg1 = P.in[2] + (size_t)layer * DM * FF; const float* wu1 = P.in[3] + (size_t)layer * DM * FF; const float* wd1 = P.in[4] + (size_t)layer * FF * DM;
    const float* win = P.in[7] + (size_t)layer * DM * DPROJ;
    const float* wbm = P.in[17] + (size_t)layer * 512 * DM; const float* wba = P.in[18] + (size_t)layer * 512 * DM; const float* wout = P.in[20] + (size_t)layer * DM * DM;
    const float* wg2 = P.in[23] + (size_t)layer * DM * FF; const float* wu2 = P.in[24] + (size_t)layer * DM * FF; const float* wd2 = P.in[25] + (size_t)layer * FF * DM;
    const float* ln1g = P.in[5] + (size_t)layer * DM; const float* ln1b = P.in[6] + (size_t)layer * DM;
    const float* ln2g = P.in[21] + (size_t)layer * DM; const float* ln2b = P.in[22] + (size_t)layer * DM;
    const float* ln3g = layer ? P.in[26] + (size_t)(layer - 1) * DM : nullptr; const float* ln3b = layer ? P.in[27] + (size_t)(layer - 1) * DM : nullptr;
    int r = it;
    if (r < 352) {
        const int second = r >= 176; if (second) r -= 176;
        const int R0 = 32 * r, pn = R0 >> 8, sgu = (R0 >> 7) & 1, i = R0 & 127;
        const float* src = (second ? (sgu ? wu2 : wg2) : (sgu ? wu1 : wg1)) + 128 * pn + i;
        const int oc = second ? OC_GU2 : OC_GU1;
        tr_rows(src, FF, DM, W + (second ? OW_GU2 : OW_GU1) + (size_t)R0 * DM, 0, 16, 8, second ? ln2g : ln3g, second ? ln2b : ln3b, CS + oc + R0, BW + oc + R0, scr, lane); return;
    }
    r -= 352;
    if (r < 192) {
        const int second = r >= 96; if (second) r -= 96;
        const int nb = r / 3, seg = r % 3, R0 = 32 * nb;
        tr_rows((second ? wd2 : wd1) + R0, DM, FF, W + (second ? OW_D2 : OW_D1) + (size_t)R0 * FF, 16 * seg, seg == 2 ? 12 : 16, 8, nullptr, nullptr, nullptr, nullptr, scr, lane); return;
    }
    r -= 192;
    if (r < 120) {
        const int R0 = 32 * r, csrc = R0 < 2048 ? R0 : (R0 < 3584 ? R0 + 8 : 2048);
        tr_rows(win + csrc, DPROJ, DM, W + OW_PB + (size_t)R0 * DM, 0, 16, R0 < 3584 ? 8 : (R0 == 3584 ? 2 : 0), ln1g, ln1b, CS + OC_PB + R0, BW + OC_PB + R0, scr, lane); return;
    }
    r -= 120;
    if (r < 64) {
        const int R0 = 32 * r, pn = R0 >> 8, sg = (R0 >> 7) & 1, i = R0 & 127, csrc = 3592 + 1024 * sg + 128 * pn + i;
        tr_rows(win + csrc, DPROJ, DM, W + OW_GM + (size_t)R0 * DM, 0, 16, 8, ln1g, ln1b, CS + OC_GM + R0, BW + OC_GM + R0, scr, lane, P.in[19] + (size_t)layer * 2048 + 1024 * sg + 128 * pn + i); return;
    }
    r -= 64;
    if (r < 64) {
        const int second = r >= 32; if (second) r -= 32;
        const int R0 = 32 * r;
        tr_rows((second ? wba : wbm) + R0, DM, 512, W + (second ? OW_BA : OW_BM) + (size_t)R0 * 512, 0, 8, 8, nullptr, nullptr, nullptr, nullptr, scr, lane); return;
    }
    r -= 64;
    { const int R0 = 32 * r; tr_rows(wout + R0, DM, DM, W + OW_OUT + (size_t)R0 * DM, 0, 16, 8, nullptr, nullptr, nullptr, nullptr, scr, lane); }
}

__device__ __forceinline__ void ln_row(const f32x4 (&vin)[4], int row, float* hf, const f32x4 (&gv)[4], const f32x4 (&bv)[4], bool gates, bool fin, const float* bif_l, LAS float* gwl, bf16_t* HB, float* ST, float* GT, int lane) {
    f32x4 v[4]; float s = 0.f;
#pragma unroll
    for (int j = 0; j < 4; ++j) { v[j] = vin[j]; s += (v[j][0] + v[j][1]) + (v[j][2] + v[j][3]); }
    const float mean = wave_sum(s) * (1.f / DM); float s2 = 0.f;
#pragma unroll
    for (int j = 0; j < 4; ++j) { v[j] = v[j] - mean; s2 += (v[j][0] * v[j][0] + v[j][1] * v[j][1]) + (v[j][2] * v[j][2] + v[j][3] * v[j][3]); }
    const float rstd = 1.f / sqrtf(wave_sum(s2) * (1.f / DM) + LN_EPS);
    if (lane == 0) { f32x2_t st = {mean, rstd}; *(f32x2_t*)(ST + (size_t)row * 2) = st; }
#pragma unroll
    for (int j = 0; j < 4; ++j) {
        v[j] = v[j] * rstd * gv[j] + bv[j];
        if (fin) *(f32x4*)(hf + 256 * j + 4 * lane) = v[j];
        if (!fin) { u32x2 w; w.x = pk2(v[j][0], v[j][1]); w.y = pk2(v[j][2], v[j][3]); *(u32x2*)(HB + (size_t)row * DM + 256 * j + 4 * lane) = w; }
    }
    if (gates) {
        float mine = 0.f;
#pragma unroll
        for (int g = 0; g < 8; ++g) {
            float d = 0.f;
#pragma unroll
            for (int j = 0; j < 4; ++j) { const f32x4 w4 = *(const LAS f32x4*)(gwl + g * 1024 + 256 * j + 4 * lane); d += (v[j][0] * w4[0] + v[j][1] * w4[1]) + (v[j][2] * w4[2] + v[j][3] * w4[3]); }
            d = wave_sum(d);
            if (lane == g) mine = d;
        }
        if (lane < 8) {
            const float z = mine + bif_l[lane];
            float o = z;
            if (lane >= 4) o = fminf(z, 0.f) - __logf(1.f + __expf(-fabsf(z)));
            GT[(size_t)row * 8 + lane] = o;
        }
    }
}
__device__ __forceinline__ void ln_phase(const Params& P, const float* gam, const float* bet, bool gates, bool fin, const float* win_l, const float* bif_l, LAS unsigned char* lds) {
    const int tid = tidx(), lane = tid & 63, wid = tid >> 6;
    float* hfm = (float*)(P.ws + WS_HFM); bf16_t* HB = (bf16_t*)(P.ws + WS_HB); float* GT = (float*)(P.ws + WS_GATES); float* ST = (float*)(P.ws + WS_STATS);
    LAS float* gwl = (LAS float*)lds;
    if (gates) {
        for (int idx = tid; idx < 8192; idx += 512) { const int k = idx >> 3, g = idx & 7; gwl[g * 1024 + k] = win_l[(size_t)k * DPROJ + 2048 + g]; }
        __syncthreads();
    }
    const int gw = bidx() * 8 + wid, NGW = gridDim.x * 8;
    f32x4 gv[4], bv[4];
#pragma unroll
    for (int j = 0; j < 4; ++j) { gv[j] = *(const f32x4*)(gam + 256 * j + 4 * lane); bv[j] = *(const f32x4*)(bet + 256 * j + 4 * lane); }
    constexpr int NR = MREAL;
    int row = 4 * gw;
    u32x2 ah[4][4], al[4][4];
#define LN_ROWP(r_) (P.out + (size_t)(r_) * DM)
    const bf16_t* LOp = (const bf16_t*)(P.ws + WS_LO);
#define LN_LOADRAW(h_, l_, r_, j_) do { h_ = *(const u32x2*)(HB + (size_t)(r_) * DM + 256 * (j_) + 4 * lane); l_ = *(const u32x2*)(LOp + (size_t)(r_) * DM + 256 * (j_) + 4 * lane); } while (0)
#define LN_COMB(dst_, hi_, lo_) dst_ = (f32x4){bflo(hi_.x) + bflo(lo_.x), bfhi(hi_.x) + bfhi(lo_.x), bflo(hi_.y) + bflo(lo_.y), bfhi(hi_.y) + bfhi(lo_.y)}
    if (row < NR) {
#pragma unroll
        for (int q4 = 0; q4 < 4; ++q4) {
#pragma unroll
            for (int j = 0; j < 4; ++j) LN_LOADRAW(ah[q4][j], al[q4][j], row + q4, j); }
    }
    while (row < NR) {
        f32x4 ca[4][4];
#pragma unroll
        for (int q4 = 0; q4 < 4; ++q4)
#pragma unroll
            for (int j = 0; j < 4; ++j) LN_COMB(ca[q4][j], ah[q4][j], al[q4][j]);
        const int nrow = row + 4 * NGW;
        if (nrow < NR) {
#pragma unroll
            for (int q4 = 0; q4 < 4; ++q4) {
#pragma unroll
                for (int j = 0; j < 4; ++j) LN_LOADRAW(ah[q4][j], al[q4][j], nrow + q4, j); }
        }
#pragma unroll
        for (int q4 = 0; q4 < 4; ++q4) ln_row(ca[q4], row + q4, LN_ROWP(row + q4), gv, bv, gates, fin, bif_l, gwl, HB, ST, GT, lane);
        row = nrow;
    }
#undef LN_ROWP
#undef LN_LOADRAW
#undef LN_COMB
}

__device__ __forceinline__ void conv8(const bf16_t* PB, const float* cw, const float* cb, int b, int pos, int chn, f32x4& o0, f32x4& o1) {
    o0 = *(const f32x4*)(cb + chn); o1 = *(const f32x4*)(cb + chn + 4);
#pragma unroll
    for (int j = 0; j < 4; ++j) {
        const int pp = pos - 3 + j;
        if (pp >= 0) {
            const u32x4 u = *(const u32x4*)(PB + seqrow(b, pp) * NPB + chn);
            const f32x4 w0 = *(const f32x4*)(cw + j * 1024 + chn), w1 = *(const f32x4*)(cw + j * 1024 + chn + 4);
            o0[0] += w0[0] * bflo(u.x); o0[1] += w0[1] * bfhi(u.x); o0[2] += w0[2] * bflo(u.y); o0[3] += w0[3] * bfhi(u.y);
            o1[0] += w1[0] * bflo(u.z); o1[1] += w1[1] * bfhi(u.z); o1[2] += w1[2] * bflo(u.w); o1[3] += w1[3] * bfhi(u.w);
        }
    }
#pragma unroll
    for (int e = 0; e < 4; ++e) { o0[e] = siluf(o0[e]); o1[e] = siluf(o1[e]); }
}
struct ConvW { f32x4 w[4][2]; f32x4 b[2]; };
__device__ __forceinline__ void convw_load(ConvW& cw8, const float* cw, const float* cb, int chn) {
    cw8.b[0] = *(const f32x4*)(cb + chn); cw8.b[1] = *(const f32x4*)(cb + chn + 4);
#pragma unroll
    for (int j = 0; j < 4; ++j) { cw8.w[j][0] = *(const f32x4*)(cw + j * 1024 + chn); cw8.w[j][1] = *(const f32x4*)(cw + j * 1024 + chn + 4); }
}
__device__ __forceinline__ void conv8w(const bf16_t* PB, const ConvW& cw8, int b, int pos, int chn, f32x4& o0, f32x4& o1) {
    o0 = cw8.b[0]; o1 = cw8.b[1];
    u32x4 u4[4];
#pragma unroll
    for (int j = 0; j < 4; ++j) {
        const int pp = pos - 3 + j;
        u4[j] = *(const u32x4*)(PB + seqrow(b, pp < 0 ? 0 : pp) * NPB + chn);
    }
#pragma unroll
    for (int j = 0; j < 4; ++j) {
        const bool ok = pos - 3 + j >= 0;
        const u32x4 u = {ok ? u4[j].x : 0u, ok ? u4[j].y : 0u, ok ? u4[j].z : 0u, ok ? u4[j].w : 0u};
        const f32x4 w0 = cw8.w[j][0], w1 = cw8.w[j][1];
        o0[0] += w0[0] * bflo(u.x); o0[1] += w0[1] * bfhi(u.x); o0[2] += w0[2] * bflo(u.y); o0[3] += w0[3] * bfhi(u.y);
        o1[0] += w1[0] * bflo(u.z); o1[1] += w1[1] * bfhi(u.z); o1[2] += w1[2] * bflo(u.w); o1[3] += w1[3] * bfhi(u.w);
    }
#pragma unroll
    for (int e = 0; e < 4; ++e) { o0[e] = siluf(o0[e]); o1[e] = siluf(o1[e]); }
}

__device__ __forceinline__ float wscan_add(float v, int lane) {
#pragma unroll
    for (int o = 1; o < 64; o <<= 1) { const float t = __shfl_up(v, o); if (lane >= o) v += t; }
    return v;
}
__device__ __forceinline__ float wscan_max(float v, int lane) {
#pragma unroll
    for (int o = 1; o < 64; o <<= 1) { const float t = __shfl_up(v, o); if (lane >= o) v = fmaxf(v, t); }
    return v;
}

__device__ __forceinline__ void lds_barrier() { asm volatile("s_waitcnt lgkmcnt(0)\n\ts_barrier" ::: "memory"); }

constexpr int TSTR = 320;
constexpr int RSTR = 272;
__device__ __forceinline__ void m1_unit(const Params& P, int layer, int bh, int c, LAS unsigned char* lds) {
    const int tid = tidx(), lane = tid & 63, wid = __builtin_amdgcn_readfirstlane(tid >> 6);
    const int b = bh >> 2, hh = bh & 3;
    const int nvalid = c == 0 ? NMETA : 128, p0 = c == 0 ? 0 : NMETA + 128 * (c - 1);
    const int nrep = c == 0 ? NB : 1;
    const bf16_t* PB = (const bf16_t*)(P.ws + WS_BIG); const float* GT = (const float*)(P.ws + WS_GATES);
    float* SC = (float*)(P.ws + WS_SC); float* NST = (float*)(P.ws + WS_NST); bf16_t* CST = (bf16_t*)(P.ws + WS_CST);
    const float* cw = P.in[8] + (size_t)layer * 4 * 1024; const float* cb = P.in[9] + (size_t)layer * 1024;
    LAS unsigned char* Kt = lds; LAS unsigned char* Vt = lds + 128 * TSTR; LAS float* sws = (LAS float*)(lds + 2 * 128 * TSTR);
    float li0 = NEGF, li1 = NEGF, lf0 = 0.f, lf1 = 0.f;
    if (wid == 0) {
        const int i0 = 2 * lane, i1 = i0 + 1;
        const size_t rw0 = seqrow(b, p0 + (i0 < nvalid ? i0 : 0)), rw1 = seqrow(b, p0 + (i1 < nvalid ? i1 : 0));
        li0 = GT[rw0 * 8 + hh]; lf0 = GT[rw0 * 8 + 4 + hh]; li1 = GT[rw1 * 8 + hh]; lf1 = GT[rw1 * 8 + 4 + hh];
        if (i0 >= nvalid) { li0 = NEGF; lf0 = 0.f; } if (i1 >= nvalid) { li1 = NEGF; lf1 = 0.f; }
    }
    ConvW ckw; convw_load(ckw, cw, cb, 512 + hh * 128 + 8 * (tid & 15));
    f32x4 kc0[4], kc1[4]; u32x4 vraw[4];
#pragma unroll
    for (int it = 0; it < 4; ++it) {
        const int item = tid + 512 * it, i = item >> 4, ch = item & 15;
        const int ic = i < nvalid ? i : nvalid - 1;
        conv8w(PB, ckw, b, p0 + ic, 512 + hh * 128 + 8 * ch, kc0[it], kc1[it]);
        vraw[it] = *(const u32x4*)(PB + seqrow(b, p0 + ic) * NPB + 1024 + hh * 128 + 8 * ch);
    }
    if (wid == 0) {
        const int i0 = 2 * lane, i1 = i0 + 1;
        const float s = lf0 + lf1, incl = wscan_add(s, lane), excl = incl - s;
        const float b0 = excl + lf0, b1 = incl, g0 = li0 - b0, g1 = li1 - b1;
        const float gmax = wave_max(fmaxf(g0, g1));
        sws[i0] = i0 < nvalid ? ex2((g0 - gmax) * LOG2E) : 0.f;
        sws[i1] = i1 < nvalid ? ex2((g1 - gmax) * LOG2E) : 0.f;
        const float bend = __shfl(incl, 63);
        if (lane == 0) { for (int bb = 0; bb < nrep; ++bb) { SC[(size_t)((bh + 4 * bb) * NCH + c) * 2] = bend; SC[(size_t)((bh + 4 * bb) * NCH + c) * 2 + 1] = bend + gmax; } }
    }
    __syncthreads();
#pragma unroll
    for (int it = 0; it < 4; ++it) {
        const int item = tid + 512 * it, i = item >> 4, ch = item & 15;
        const float sc = 0.08838834764831845f * sws[i];
        u32x4 kw = pack8(kc0[it] * sc, kc1[it] * sc), vw = vraw[it];
        if (i >= nvalid) { kw = (u32x4){0u, 0u, 0u, 0u}; vw = kw; }
        *(LAS u32x4*)(Kt + i * TSTR + ch * 16) = kw; *(LAS u32x4*)(Vt + i * TSTR + ch * 16) = vw;
    }
    __syncthreads();
    {
        const int h = lane >> 5, g = lane >> 4, q = (lane & 15) >> 2, pp = lane & 3;
        const int dkt = wid >> 1, dvt0 = (wid & 1) * 2;
        f32x16 acc[2];
#pragma unroll
        for (int t = 0; t < 2; ++t)
#pragma unroll
            for (int e = 0; e < 16; ++e) acc[t][e] = 0.f;
#pragma unroll
        for (int ks = 0; ks < 8; ++ks) {
            const int rowa = 16 * ks + 8 * h + q;
            const LAS unsigned char* ka = Kt + rowa * TSTR + (32 * dkt + 16 * (g & 1) + 4 * pp) * 2;
            const bf16x8 af = cat8(vtr(ka), vtr(ka + 4 * TSTR));
#pragma unroll
            for (int t = 0; t < 2; ++t) {
                const LAS unsigned char* va = Vt + rowa * TSTR + (32 * (dvt0 + t) + 16 * (g & 1) + 4 * pp) * 2;
                const bf16x8 bf = cat8(vtr(va), vtr(va + 4 * TSTR));
                acc[t] = mfma32(af, bf, acc[t]);
            }
        }
#pragma unroll
        for (int t = 0; t < 2; ++t) {
            const int dv = 32 * (dvt0 + t) + (lane & 31);
#pragma unroll
            for (int r4 = 0; r4 < 4; ++r4) {
                const int dk0 = 32 * dkt + 8 * r4 + 4 * h;
                u32x2 w; w.x = pk2(acc[t][4 * r4], acc[t][4 * r4 + 1]); w.y = pk2(acc[t][4 * r4 + 2], acc[t][4 * r4 + 3]);
                for (int bb = 0; bb < nrep; ++bb) *(u32x2*)(CST + (size_t)((bh + 4 * bb) * NCH + c) * 16384 + (size_t)dv * 128 + dk0) = w;
            }
        }
    }
    {
        LAS float* red = sws + 256;
        const int dk = tid & 127, part = tid >> 7;
        float sacc = 0.f;
#pragma unroll 8
        for (int i = 0; i < 32; ++i) sacc += __builtin_bit_cast(float, (unsigned)(*(const LAS unsigned short*)(Kt + (32 * part + i) * TSTR + dk * 2)) << 16);
        red[part * 128 + dk] = sacc;
        __syncthreads();
        if (tid < 128) { const float nsum = (red[tid] + red[128 + tid]) + (red[256 + tid] + red[384 + tid]); for (int bb = 0; bb < nrep; ++bb) NST[(size_t)((bh + 4 * bb) * NCH + c) * 128 + tid] = nsum; }
    }
    lds_barrier();
}

__device__ __forceinline__ void m2_phase(const Params& P) {
    float* SC = (float*)(P.ws + WS_SC); float* MST = SC + 32 * NCH * 2; float* NST = (float*)(P.ws + WS_NST); bf16_t* CST = (bf16_t*)(P.ws + WS_CST);
    const int NT = gridDim.x * 512;
    for (int task = bidx() * 512 + tidx(); task < 65536 + 4096; task += NT) {
        if (task < 65536) {
            const int bh = task >> 11, e8 = task & 2047;
            bf16_t* ptr = CST + (size_t)bh * NCH * 16384 + (size_t)e8 * 8;
            float run[8];
#pragma unroll
            for (int e = 0; e < 8; ++e) run[e] = 0.f;
            float m = NEGF;
#pragma unroll 1
            for (int c0 = 0; c0 < NCH; c0 += 5) {
                u32x4 loc[5]; float bendv[5], mlocv[5];
#pragma unroll
                for (int j = 0; j < 5; ++j) { loc[j] = *(const u32x4*)(ptr + (size_t)(c0 + j) * 16384); bendv[j] = SC[(size_t)(bh * NCH + c0 + j) * 2]; mlocv[j] = SC[(size_t)(bh * NCH + c0 + j) * 2 + 1]; }
#pragma unroll
                for (int j = 0; j < 5; ++j) {
                    const int c = c0 + j;
                    const float bend = bendv[j], mloc = mlocv[j];
                    const float mn = fmaxf(bend + m, mloc), a = ex2((bend + m - mn) * LOG2E), bt = ex2((mloc - mn) * LOG2E);
                    u32x4 w; w.x = pk2(run[0], run[1]); w.y = pk2(run[2], run[3]); w.z = pk2(run[4], run[5]); w.w = pk2(run[6], run[7]);
                    *(u32x4*)(ptr + (size_t)c * 16384) = w;
                    run[0] = a * run[0] + bt * bflo(loc[j].x); run[1] = a * run[1] + bt * bfhi(loc[j].x);
                    run[2] = a * run[2] + bt * bflo(loc[j].y); run[3] = a * run[3] + bt * bfhi(loc[j].y);
                    run[4] = a * run[4] + bt * bflo(loc[j].z); run[5] = a * run[5] + bt * bfhi(loc[j].z);
                    run[6] = a * run[6] + bt * bflo(loc[j].w); run[7] = a * run[7] + bt * bfhi(loc[j].w);
                    if (e8 == 0) MST[bh * NCH + c] = m;
                    m = mn;
                }
            }
        } else {
            const int t2 = task - 65536, bh = t2 >> 7, dk = t2 & 127;
            float* ptr = NST + (size_t)bh * NCH * 128 + dk;
            float run = 0.f, m = NEGF;
#pragma unroll 1
            for (int c0 = 0; c0 < NCH; c0 += 13) {
                float locv[13], bendv[13], mlocv[13];
#pragma unroll
                for (int j = 0; j < 13; ++j) { locv[j] = ptr[(size_t)(c0 + j) * 128]; bendv[j] = SC[(size_t)(bh * NCH + c0 + j) * 2]; mlocv[j] = SC[(size_t)(bh * NCH + c0 + j) * 2 + 1]; }
#pragma unroll
                for (int j = 0; j < 13; ++j) {
                    const float mn = fmaxf(bendv[j] + m, mlocv[j]), a = ex2((bendv[j] + m - mn) * LOG2E), bt = ex2((mlocv[j] - mn) * LOG2E);
                    ptr[(size_t)(c0 + j) * 128] = run; run = a * run + bt * locv[j]; m = mn;
                }
            }
        }
    }
}

__device__ __forceinline__ void m3_unit(const Params& P, int layer, int bh, int c, LAS unsigned char* lds) {
    const int tid = tidx(), lane = tid & 63, wid = __builtin_amdgcn_readfirstlane(tid >> 6);
    const int b = bh >> 2, hh = bh & 3;
    const int nvalid = c == 0 ? NMETA : 128, p0 = c == 0 ? 0 : NMETA + 128 * (c - 1);
    const bf16_t* PB = (const bf16_t*)(P.ws + WS_BIG); const float* GT = (const float*)(P.ws + WS_GATES);
    const float* SC = (const float*)(P.ws + WS_SC); const float* MST = SC + 32 * NCH * 2; const float* NST = (const float*)(P.ws + WS_NST); const bf16_t* CST = (const bf16_t*)(P.ws + WS_CST);
    bf16_t* MA = (bf16_t*)(P.ws + WS_MA);
    const float* cw = P.in[8] + (size_t)layer * 4 * 1024; const float* cb = P.in[9] + (size_t)layer * 1024; const float* mng = P.in[11] + (size_t)layer * 512;
    LAS unsigned char* Qt = lds; LAS unsigned char* Kt = lds + 128 * RSTR; LAS unsigned char* Vt = lds + 2 * 128 * RSTR;
    LAS float* sg2 = (LAS float*)(lds + 2 * 128 * RSTR + 128 * TSTR); LAS float* sr2 = sg2 + 128; LAS float* sw = sg2 + 256; LAS float* semt = sg2 + 384; LAS float* sqn = sg2 + 512;
    LAS float* sst = sg2 + 640; LAS float* sst2 = sg2 + 896; LAS float* snp = sg2 + 1152;
    constexpr int CT_OFF = 116736;
    {
        const bf16_t* Cp = CST + (size_t)(bh * NCH + c) * 16384;
#pragma unroll
        for (int k = 0; k < 4; ++k) {
            const int S = (k * 8 + wid) * 64 + lane, row = S >> 4, cch = (S & 15) ^ (row & 15);
            __builtin_amdgcn_global_load_lds((const unsigned*)(Cp + (size_t)row * 128 + cch * 8), (LAS unsigned*)(lds + CT_OFF + (k * 8 + wid) * 1024), 16, 0, 0);
        }
    }
    const float npv = tid < 128 ? NST[(size_t)(bh * NCH + c) * 128 + tid] : 0.f;
    float li0 = NEGF, li1 = NEGF, lf0 = 0.f, lf1 = 0.f, mprev = 0.f;
    if (wid == 0) {
        const int i0 = 2 * lane, i1 = i0 + 1;
        const size_t rw0 = seqrow(b, p0 + (i0 < nvalid ? i0 : 0)), rw1 = seqrow(b, p0 + (i1 < nvalid ? i1 : 0));
        li0 = GT[rw0 * 8 + hh]; lf0 = GT[rw0 * 8 + 4 + hh]; li1 = GT[rw1 * 8 + hh]; lf1 = GT[rw1 * 8 + 4 + hh];
        if (i0 >= nvalid) { li0 = NEGF; lf0 = 0.f; } if (i1 >= nvalid) { li1 = NEGF; lf1 = 0.f; }
        mprev = MST[bh * NCH + c];
    }
    ConvW cqw, ckw; convw_load(cqw, cw, cb, hh * 128 + 8 * (tid & 15)); convw_load(ckw, cw, cb, 512 + hh * 128 + 8 * (tid & 15));
    if (wid == 0) {
        const int i0 = 2 * lane, i1 = i0 + 1;
        const float s = lf0 + lf1, incl = wscan_add(s, lane), excl = incl - s;
        const float b0 = excl + lf0, b1 = incl, g0 = li0 - b0, g1 = li1 - b1;
        const float inclm = wscan_max(fmaxf(g0, g1), lane);
        float exclm = __shfl_up(inclm, 1); if (lane == 0) exclm = NEGF;
        const float cm0 = fmaxf(exclm, g0), cm1 = inclm;
        const float M0 = fmaxf(mprev, cm0), M1 = fmaxf(mprev, cm1);
        sg2[i0] = g0 * LOG2E; sg2[i1] = g1 * LOG2E; sr2[i0] = -M0 * LOG2E; sr2[i1] = -M1 * LOG2E;
        sw[i0] = ex2((mprev - M0) * LOG2E); sw[i1] = ex2((mprev - M1) * LOG2E);
        semt[i0] = ex2(-(b0 + M0) * LOG2E); semt[i1] = ex2(-(b1 + M1) * LOG2E);
    }
#pragma unroll
    for (int it = 0; it < 4; ++it) {
        const int item = tid + 512 * it, i = item >> 4, ch = item & 15;
        u32x4 qw, kw, vw;
        {
            const int ic = i < nvalid ? i : nvalid - 1;
            f32x4 o0, o1;
            conv8w(PB, cqw, b, p0 + ic, hh * 128 + 8 * ch, o0, o1); qw = pack8(o0, o1);
            conv8w(PB, ckw, b, p0 + ic, 512 + hh * 128 + 8 * ch, o0, o1); kw = pack8(o0 * 0.08838834764831845f, o1 * 0.08838834764831845f);
            vw = *(const u32x4*)(PB + seqrow(b, p0 + ic) * NPB + 1024 + hh * 128 + 8 * ch);
            if (i >= nvalid) { qw = (u32x4){0u, 0u, 0u, 0u}; kw = qw; vw = qw; }
        }
        *(LAS u32x4*)(Qt + i * RSTR + ch * 16) = qw; *(LAS u32x4*)(Kt + i * RSTR + ch * 16) = kw; *(LAS u32x4*)(Vt + i * TSTR + ch * 16) = vw;
    }
    if (tid < 128) snp[tid] = npv;
    asm volatile("s_waitcnt vmcnt(0)" ::: "memory");
    __syncthreads();
    const int r = lane & 31, h = lane >> 5, g = lane >> 4, q = (lane & 15) >> 2, pp = lane & 3;
    const int qb = wid >> 1, dvh = wid & 1, t = 32 * qb + r;
    u32x2 mo_[2][4]; f32x4 gn_[2][4];
    {
        const size_t rowp = seqrow(b, p0 + (t < nvalid ? t : 0));
#pragma unroll
        for (int d = 0; d < 2; ++d)
#pragma unroll
            for (int r4 = 0; r4 < 4; ++r4) {
                const int col = hh * 128 + 32 * (2 * dvh + d) + 8 * r4 + 4 * h;
                mo_[d][r4] = *(const u32x2*)(PB + rowp * NPB + 1536 + col); gn_[d][r4] = *(const f32x4*)(mng + col);
            }
    }
    {
        const int i = tid >> 2, part = tid & 3;
        const LAS float* np = snp + 32 * part;
        float s = 0.f;
#pragma unroll
        for (int d8 = 0; d8 < 4; ++d8) {
            const u32x4 qv = *(const LAS u32x4*)(Qt + i * RSTR + (32 * part + 8 * d8) * 2);
            const f32x4 n0 = *(const LAS f32x4*)(np + 8 * d8), n1 = *(const LAS f32x4*)(np + 8 * d8 + 4);
            s += bflo(qv.x) * n0[0] + bfhi(qv.x) * n0[1] + bflo(qv.y) * n0[2] + bfhi(qv.y) * n0[3] + bflo(qv.z) * n1[0] + bfhi(qv.z) * n1[1] + bflo(qv.w) * n1[2] + bfhi(qv.w) * n1[3];
        }
        s += __shfl_xor(s, 1); s += __shfl_xor(s, 2);
        if (part == 0) sqn[i] = s;
    }
    bf16x8 qf[8];
#pragma unroll
    for (int ks = 0; ks < 8; ++ks) qf[ks] = *(const LAS bf16x8*)(Qt + t * RSTR + (16 * ks + 8 * h) * 2);
    f32x16 acc[2];
#pragma unroll
    for (int d = 0; d < 2; ++d)
#pragma unroll
        for (int e = 0; e < 16; ++e) acc[d][e] = 0.f;
    {
#pragma unroll
        for (int ks = 0; ks < 8; ++ks)
#pragma unroll
            for (int d = 0; d < 2; ++d) {
                const int dv = 32 * (2 * dvh + d) + r;
                const bf16x8 cf = *(const LAS bf16x8*)(lds + CT_OFF + (dv * 16 + ((2 * ks + h) ^ (dv & 15))) * 16);
                acc[d] = mfma32(cf, qf[ks], acc[d]);
            }
    }
    __syncthreads();
    const float wt = sw[t], r2 = sr2[t];
#pragma unroll
    for (int d = 0; d < 2; ++d) acc[d] = acc[d] * wt;
    float den = 0.f;
#pragma unroll 1
    for (int kb = 0; kb <= qb; ++kb) {
        f32x16 st;
#pragma unroll
        for (int e = 0; e < 16; ++e) st[e] = 0.f;
#pragma unroll
        for (int ks = 0; ks < 8; ++ks) { const bf16x8 kf = *(const LAS bf16x8*)(Kt + (32 * kb + r) * RSTR + (16 * ks + 8 * h) * 2); st = mfma32(kf, qf[ks], st); }
#pragma unroll
        for (int r4 = 0; r4 < 4; ++r4) {
            const int s0 = 32 * kb + 8 * r4 + 4 * h;
            const f32x4 gs = *(const LAS f32x4*)(sg2 + s0);
#pragma unroll
            for (int e = 0; e < 4; ++e) {
                float v = st[4 * r4 + e] * ex2(r2 + gs[e]);
                if (s0 + e > t) v = 0.f;
                den += v; st[4 * r4 + e] = v;
            }
        }
#pragma unroll
        for (int s2 = 0; s2 < 2; ++s2) {
            u32x4 pw; pw.x = pk2(st[8 * s2], st[8 * s2 + 1]); pw.y = pk2(st[8 * s2 + 2], st[8 * s2 + 3]); pw.z = pk2(st[8 * s2 + 4], st[8 * s2 + 5]); pw.w = pk2(st[8 * s2 + 6], st[8 * s2 + 7]);
            const bf16x8 pf = __builtin_bit_cast(bf16x8, pw);
#pragma unroll
            for (int d = 0; d < 2; ++d) {
                const LAS unsigned char* va = Vt + (32 * kb + 16 * s2 + 4 * h + q) * TSTR + (32 * (2 * dvh + d) + 16 * (g & 1) + 4 * pp) * 2;
                const bf16x8 vf = cat8(vtr(va), vtr(va + 8 * TSTR));
                acc[d] = mfma32(vf, pf, acc[d]);
            }
        }
    }
    den += __shfl_xor(den, 32);
    den += wt * sqn[t];
    const float inv = 1.f / fmaxf(fabsf(den), semt[t]);
    float s1 = 0.f;
#pragma unroll
    for (int d = 0; d < 2; ++d)
#pragma unroll
        for (int e = 0; e < 16; ++e) { acc[d][e] *= inv; s1 += acc[d][e]; }
    s1 += __shfl_xor(s1, 32);
    if (h == 0) sst[wid * 32 + r] = s1;
    __syncthreads();
    const float mean = (s1 + sst[(wid ^ 1) * 32 + r]) * (1.f / 128.f);
    float q2 = 0.f;
#pragma unroll
    for (int d = 0; d < 2; ++d)
#pragma unroll
        for (int e = 0; e < 16; ++e) { acc[d][e] -= mean; q2 += acc[d][e] * acc[d][e]; }
    q2 += __shfl_xor(q2, 32);
    if (h == 0) sst2[wid * 32 + r] = q2;
    __syncthreads();
    const float rstd = 1.f / sqrtf((q2 + sst2[(wid ^ 1) * 32 + r]) * (1.f / 128.f) + LN_EPS);
    if (t < nvalid) {
        const size_t row = seqrow(b, p0 + t);
#pragma unroll
        for (int d = 0; d < 2; ++d)
#pragma unroll
            for (int r4 = 0; r4 < 4; ++r4) {
                const int col = hh * 128 + 32 * (2 * dvh + d) + 8 * r4 + 4 * h;
                const u32x2 mo = mo_[d][r4];
                const f32x4 g4 = gn_[d][r4];
                const float o0 = acc[d][4 * r4] * rstd * g4[0] * sigm(bflo(mo.x)), o1 = acc[d][4 * r4 + 1] * rstd * g4[1] * sigm(bfhi(mo.x));
                const float o2 = acc[d][4 * r4 + 2] * rstd * g4[2] * sigm(bflo(mo.y)), o3 = acc[d][4 * r4 + 3] * rstd * g4[3] * sigm(bfhi(mo.y));
                u32x2 w; w.x = pk2(o0, o1); w.y = pk2(o2, o3);
                *(u32x2*)(MA + row * 512 + col) = w;
            }
    }
    lds_barrier();
}

constexpr int AT_KB = 64 * RSTR, AT_VB = 64 * TSTR, AT_BUF = AT_KB + AT_VB;
__device__ __forceinline__ void attn_unit(const Params& P, int layer, int b, int hd, int pq0, int nvalid, float lam, float lam_init, LAS unsigned char* lds) {
    const int tid = tidx(), lane = tid & 63, wid = __builtin_amdgcn_readfirstlane(tid >> 6);
    const int c = wid >> 2, wq = wid & 3, r = lane & 31, h = lane >> 5, g = lane >> 4, q = (lane & 15) >> 2, pp = lane & 3;
    const bf16_t* PB = (const bf16_t*)(P.ws + WS_BIG); bf16_t* AO = (bf16_t*)(P.ws + WS_MA) + (size_t)MPAD * 512;
    const float* ang = P.in[16] + (size_t)layer * 512;
    const int qi = 32 * wq + r, qp = pq0 + qi;
    bf16x8 qf[4];
    {
        const size_t qrow = seqrow(b, qp < LSEQ ? qp : LSEQ - 1);
#pragma unroll
        for (int ks = 0; ks < 4; ++ks) qf[ks] = *(const bf16x8*)(PB + qrow * NPB + 2048 + hd * 128 + c * 64 + 16 * ks + 8 * h);
    }
    const float slope2 = ex2(-2.f * (float)(hd + 1)) * LOG2E;
    const int ntiles = (pq0 + nvalid - 1) / 64 + 1;
    u32x4 pk[2], pv[2];
#define AT_LOAD(kt) do { _Pragma("unroll") for (int i_ = 0; i_ < 2; ++i_) { const int row_ = (tid + 512 * i_) >> 4, ch_ = tid & 15; int kp_ = 64 * (kt) + row_; kp_ = kp_ < LSEQ ? kp_ : LSEQ - 1; \
        const bf16_t* src_ = PB + seqrow(b, kp_) * NPB + hd * 128 + ch_ * 8; pk[i_] = *(const u32x4*)(src_ + 2560); pv[i_] = *(const u32x4*)(src_ + 3072); } } while (0)
#define AT_STORE(s) do { _Pragma("unroll") for (int i_ = 0; i_ < 2; ++i_) { const int row_ = (tid + 512 * i_) >> 4, ch_ = tid & 15; \
        *(LAS u32x4*)(lds + (s) * AT_BUF + row_ * RSTR + ch_ * 16) = pk[i_]; *(LAS u32x4*)(lds + (s) * AT_BUF + AT_KB + row_ * TSTR + ch_ * 16) = pv[i_]; } } while (0)
    AT_LOAD(ntiles - 1);
    float qkb;
    {
        float ss = 0.f;
#pragma unroll
        for (int ks = 0; ks < 4; ++ks)
#pragma unroll
            for (int j = 0; j < 8; ++j) { const float v = __builtin_bit_cast(float, (unsigned)(unsigned short)qf[ks][j] << 16); ss += v * v; }
        ss += __shfl_xor(ss, 32);
        const float* KM = (const float*)(P.ws + WS_KM) + layer * 72;
        const float k2 = fmaxf(KM[b * 8 + hd * 2 + c], KM[64 + hd * 2 + c]);
        qkb = sqrtf(ss) * sqrtf(k2) * 1.001f + 0.01f;
    }
    LAS unsigned* votes = (LAS unsigned*)(lds + 131072 + 2048);
    if (tid < 16) votes[tid] = 0u;
    AT_STORE((ntiles - 1) & 1);
    __syncthreads();
    float m_run = NEGF, l_run = 0.f;
    f32x16 o[4];
#pragma unroll
    for (int d = 0; d < 4; ++d)
#pragma unroll
        for (int e = 0; e < 16; ++e) o[d][e] = 0.f;
#pragma unroll 1
    for (int kt = ntiles - 1; kt >= 0; --kt) {
        const int s = kt & 1;
        if (kt > 0) AT_LOAD(kt - 1);
        const LAS unsigned char* Kb = lds + s * AT_BUF; const LAS unsigned char* Vb = Kb + AT_KB;
        if (64 * kt <= pq0 + 32 * wq + 31) {
        f32x16 st[2];
#pragma unroll
        for (int kb2 = 0; kb2 < 2; ++kb2) {
            const float tb = slope2 * (float)(64 * kt + 32 * kb2 - pq0 + 4 * h);
#pragma unroll
            for (int e = 0; e < 16; ++e) st[kb2][e] = tb + slope2 * (float)((e & 3) + 8 * (e >> 2));
#pragma unroll
            for (int ks = 0; ks < 4; ++ks) { const bf16x8 kf = *(const LAS bf16x8*)(Kb + (32 * kb2 + r) * RSTR + (c * 64 + 16 * ks + 8 * h) * 2); st[kb2] = mfma32(kf, qf[ks], st[kb2]); }
        }
        if (64 * kt + 63 > pq0 + 32 * wq) {
#pragma unroll
            for (int kb2 = 0; kb2 < 2; ++kb2)
#pragma unroll
                for (int e = 0; e < 16; ++e) { const int kp = 64 * kt + 32 * kb2 + (e & 3) + 8 * (e >> 2) + 4 * h; if (kp > qp) st[kb2][e] = NEGF; }
        }
        float mx = st[0][0];
#pragma unroll
        for (int e = 1; e < 16; ++e) mx = fmaxf(mx, st[0][e]);
#pragma unroll
        for (int e = 0; e < 16; ++e) mx = fmaxf(mx, st[1][e]);
        mx = fmaxf(mx, __shfl_xor(mx, 32));
        if (__any(mx > m_run + 8.f)) {
            const float m_new = fmaxf(m_run, mx), alpha = ex2(m_run - m_new);
            m_run = m_new; l_run *= alpha;
#pragma unroll
            for (int d = 0; d < 4; ++d) o[d] = o[d] * alpha;
        }
        const float m_new = m_run;
        float psum = 0.f;
#pragma unroll
        for (int kb2 = 0; kb2 < 2; ++kb2)
#pragma unroll
            for (int e = 0; e < 16; ++e) { const float p = ex2(st[kb2][e] - m_new); st[kb2][e] = p; psum += p; }
        l_run += psum;
#pragma unroll
        for (int kb2 = 0; kb2 < 2; ++kb2)
#pragma unroll
            for (int s2 = 0; s2 < 2; ++s2) {
                u32x4 pw; pw.x = pk2(st[kb2][8 * s2], st[kb2][8 * s2 + 1]); pw.y = pk2(st[kb2][8 * s2 + 2], st[kb2][8 * s2 + 3]); pw.z = pk2(st[kb2][8 * s2 + 4], st[kb2][8 * s2 + 5]); pw.w = pk2(st[kb2][8 * s2 + 6], st[kb2][8 * s2 + 7]);
                const bf16x8 pf = __builtin_bit_cast(bf16x8, pw);
#pragma unroll
                for (int d = 0; d < 4; ++d) {
                    const LAS unsigned char* va = Vb + (32 * kb2 + 16 * s2 + 4 * h + q) * TSTR + (32 * d + 16 * (g & 1) + 4 * pp) * 2;
                    const bf16x8 vf = cat8(vtr(va), vtr(va + 8 * TSTR));
                    o[d] = mfma32(vf, pf, o[d]);
                }
            }
        }
        if (kt > 0) {
            const float bnd = qkb + slope2 * (float)(64 * (kt - 1) + 63 - pq0);
            const bool dn = !__any(bnd >= m_run - 44.f);
            if (lane == 0) votes[s * 8 + wid] = dn ? 1u : 0u;
            AT_STORE(s ^ 1);
        }
        __syncthreads();
        if (kt > 0) {
            const u32x4 v0 = *(const LAS u32x4*)(votes + s * 8), v1 = *(const LAS u32x4*)(votes + s * 8 + 4);
            const unsigned all = (unsigned)__builtin_amdgcn_readfirstlane((int)((v0.x & v0.y) & (v0.z & v0.w) & (v1.x & v1.y) & (v1.z & v1.w)));
            if (all) break;
        }
    }
#undef AT_LOAD
#undef AT_STORE
    const float l_tot = l_run + __shfl_xor(l_run, 32), inv = 1.f / l_tot;
    LAS float* xch = (LAS float*)lds;
    if (c == 1) {
#pragma unroll
        for (int d = 0; d < 4; ++d)
#pragma unroll
            for (int e = 0; e < 16; ++e) xch[((wq * 4 + d) * 16 + e) * 64 + lane] = o[d][e] * inv;
    }
    __syncthreads();
    if (c == 0) {
        float ss = 0.f;
#pragma unroll
        for (int d = 0; d < 4; ++d)
#pragma unroll
            for (int e = 0; e < 16; ++e) { const float v = o[d][e] * inv - lam * xch[((wq * 4 + d) * 16 + e) * 64 + lane]; o[d][e] = v; ss += v * v; }
        ss += __shfl_xor(ss, 32);
        const float rms = (1.f / sqrtf(ss * (1.f / 128.f) + LN_EPS)) * (1.f - lam_init);
        f32x4 ga_[4][4];
#pragma unroll
        for (int d = 0; d < 4; ++d)
#pragma unroll
            for (int r4 = 0; r4 < 4; ++r4) ga_[d][r4] = *(const f32x4*)(ang + hd * 128 + 32 * d + 8 * r4 + 4 * h);
        if (qi < nvalid) {
            const size_t row = seqrow(b, qp);
#pragma unroll
            for (int d = 0; d < 4; ++d)
#pragma unroll
                for (int r4 = 0; r4 < 4; ++r4) {
                    const int col = hd * 128 + 32 * d + 8 * r4 + 4 * h;
                    const f32x4 g4 = ga_[d][r4];
                    u32x2 w; w.x = pk2(o[d][4 * r4] * rms * g4[0], o[d][4 * r4 + 1] * rms * g4[1]); w.y = pk2(o[d][4 * r4 + 2] * rms * g4[2], o[d][4 * r4 + 3] * rms * g4[3]);
                    *(u32x2*)(AO + row * 512 + col) = w;
                }
        }
    }
    lds_barrier();
}

#define XB_TMO      128
#define XB_XCNT(j)  (256  + 64 * (j))
#define XB_XSUB(j)  (1280 + 64 * (j))
#define XB_XGEN(j)  (2304 + 64 * (j))
#define XB_TOP      3328
#define XB_TOPGEN   3392
#define XCD_BAR_WORDS 3456
#define XB_SPIN_CAP (1u << 18)

__device__ __forceinline__ unsigned xb_ld(unsigned* p)              { return __hip_atomic_load(p, __ATOMIC_RELAXED, __HIP_MEMORY_SCOPE_AGENT); }
__device__ __forceinline__ unsigned xb_add(unsigned* p, unsigned v) { return __hip_atomic_fetch_add(p, v, __ATOMIC_RELAXED, __HIP_MEMORY_SCOPE_AGENT); }
__device__ __forceinline__ unsigned xb_xcc_id() { return (unsigned)__builtin_amdgcn_s_getreg((3 << 11) | 20) & 0xFu; }
#define XB_SPIN(cond, bar) do { unsigned _sp = 0; while (cond) { __builtin_amdgcn_s_sleep(1); \
    if ((++_sp & 255u) == 0u) { if (xb_ld(&(bar)[XB_TMO])) break; if (_sp > XB_SPIN_CAP) { atomicAdd(&(bar)[XB_TMO], 1u); break; } } } } while (0)

struct XcdBarrier {
    unsigned* bar; unsigned x;
    volatile LAS unsigned* st;
};

__device__ __forceinline__ XcdBarrier xcd_barrier_post(unsigned* bar, volatile LAS unsigned* st) {
    XcdBarrier b; b.bar = bar; b.x = xb_xcc_id(); b.st = st;
    if (threadIdx.x == 0) (void)xb_add(&bar[XB_XCNT(b.x)], 1u);
    return b;
}
__device__ __forceinline__ void xcd_barrier_complete(unsigned* bar, unsigned x, unsigned& nloc, unsigned& nx) {
    const unsigned G = gridDim.x * gridDim.y * gridDim.z;
    unsigned sum, cnt, mine, sp = 0u;
    for (;;) {
        sum = 0u; cnt = 0u; mine = 0u;
#pragma unroll
        for (unsigned j = 0; j < 16; ++j) { const unsigned c = xb_ld(&bar[XB_XCNT(j)]); sum += c; cnt += (c > 0u) ? 1u : 0u; mine = (j == x) ? c : mine; }
        if (sum == G) break;
        __builtin_amdgcn_s_sleep(1);
        if ((++sp & 255u) == 0u) { if (xb_ld(&bar[XB_TMO])) break; if (sp > XB_SPIN_CAP) { atomicAdd(&bar[XB_TMO], 1u); break; } }
    }
    nloc = mine > 0u ? mine : 1u; nx = cnt > 0u ? cnt : 1u;
}

__device__ __forceinline__ void xcd_barrier(const XcdBarrier& b) {
    asm volatile("s_waitcnt vmcnt(0)" ::: "memory");
    __syncthreads();
    if (threadIdx.x == 0) {
        unsigned* bar = b.bar;
        __builtin_amdgcn_s_waitcnt(0);
        unsigned nloc = b.st[0], nx = b.st[1];
        if (nloc == 0u) { xcd_barrier_complete(bar, b.x, nloc, nx); b.st[0] = nloc; b.st[1] = nx; }
        const unsigned old = xb_add(&bar[XB_XSUB(b.x)], 1u);
        const unsigned gen = old / nloc;
        if (old + 1u == (gen + 1u) * nloc) {
            __builtin_amdgcn_fence(__ATOMIC_RELEASE, "agent");
            asm volatile("s_waitcnt vmcnt(0)" ::: "memory");
            const unsigned og = xb_add(&bar[XB_TOP], 1u);
            const unsigned tg = og / nx;
            if (og + 1u == (tg + 1u) * nx) xb_add(&bar[XB_TOPGEN], 1u);
            else XB_SPIN(xb_ld(&bar[XB_TOPGEN]) == tg, bar);
            __builtin_amdgcn_fence(__ATOMIC_ACQUIRE, "agent");
            xb_add(&bar[XB_XGEN(b.x)], 1u);
            asm volatile("s_waitcnt vmcnt(0)" ::: "memory");
        } else {
            XB_SPIN(xb_ld(&bar[XB_XGEN(b.x)]) == gen, bar);
            __builtin_amdgcn_fence(__ATOMIC_ACQUIRE, "agent");
            asm volatile("s_waitcnt vmcnt(0)" ::: "memory");
        }
    }
    __syncthreads();
}

#ifndef PROBE_ATT
#define PROBE_ATT 1
#endif
#ifndef PROBE_M3
#define PROBE_M3 1
#endif
constexpr int LDS_BYTES = 155648;
constexpr int LDS_BST = LDS_BYTES - 64;
#ifndef PROG_LAYER
#define PROG_LAYER(L) 16*L+0, 16*L+1, 16*L+3, 16*L+4, 16*L+5, 16*L+6, 16*L+7, 16*L+8, 16*L+9, 16*L+11, 16*L+12
#endif
__device__ const unsigned char PROG[] = { PROG_LAYER(0), PROG_LAYER(1), 16 * 1 + 13 };
constexpr int NSTEP = 14;
__global__ void __launch_bounds__(512) hybrid_fwd(Params P) {
    extern __shared__ __attribute__((aligned(16))) unsigned char smem[];
    LAS unsigned char* lds = (LAS unsigned char*)smem;
    cg::grid_group grid = cg::this_grid();
    unsigned* barw = (unsigned*)(P.ws + WS_BAR);
    volatile LAS unsigned* bst = (volatile LAS unsigned*)(lds + LDS_BST);
    if (blockIdx.x == 0) for (int i = threadIdx.x; i < XCD_BAR_WORDS; i += 512) __hip_atomic_store(barw + i, 0u, __ATOMIC_RELAXED, __HIP_MEMORY_SCOPE_AGENT);
    if (blockIdx.x == 0 && threadIdx.x < 144) __hip_atomic_store((unsigned*)(P.ws + WS_KM) + threadIdx.x, 0u, __ATOMIC_RELAXED, __HIP_MEMORY_SCOPE_AGENT);
    if (threadIdx.x < 2) bst[threadIdx.x] = 0u;
    __syncthreads();

#ifndef PROBE_P0
#define PROBE_P0 1
#endif
#pragma unroll 1
    for (int rep0_ = 0; rep0_ < PROBE_P0; ++rep0_)
    {
        const int lane = tidx() & 63, wid = tidx() >> 6, gw = bidx() * 8 + wid, NGW = gridDim.x * 8;
        bf16_t* HB = (bf16_t*)(P.ws + WS_HB); float* HFM = (float*)(P.ws + WS_HFM);
        LAS float* scr = (LAS float*)(lds + wid * 16384);
        for (int it = gw; it < 2 * CW_ITEMS; it += NGW) conv_weight_item(P, it / CW_ITEMS, it % CW_ITEMS, scr, lane);
        const float* x = P.in[0]; const float* meta = P.in[1];
        {
            const size_t NT8 = (size_t)gridDim.x * 512, n8 = (size_t)MREAL * DM / 8;
#pragma unroll 1
            for (size_t i = (size_t)bidx() * 512 + tidx(); i < n8; i += 4 * NT8) {
                f32x4 v0[4], v1[4];
#pragma unroll
                for (int j = 0; j < 4; ++j) { const size_t ii = i + j * NT8 < n8 ? i + j * NT8 : i; v0[j] = *(const f32x4*)(x + ii * 8); v1[j] = *(const f32x4*)(x + ii * 8 + 4); }
                asm volatile("" : "+v"(v0[0]), "+v"(v0[1]), "+v"(v0[2]), "+v"(v0[3]), "+v"(v1[0]), "+v"(v1[1]), "+v"(v1[2]), "+v"(v1[3]));
#pragma unroll
                for (int j = 0; j < 4; ++j) if (i + j * NT8 < n8) *(u32x4*)(HB + (i + j * NT8) * 8) = pack8(v0[j], v1[j]);
            }
        }
        for (int row = gw; row < NMETA; row += NGW) {
#pragma unroll
            for (int j = 0; j < 4; ++j) {
                const f32x4 v = *(const f32x4*)(meta + (size_t)row * DM + 256 * j + 4 * lane);
                *(f32x4*)(HFM + (size_t)row * DM + 256 * j + 4 * lane) = v;
                u32x2 w; w.x = pk2(v[0], v[1]); w.y = pk2(v[2], v[3]);
                *(u32x2*)(HB + (size_t)(MROW0 + row) * DM + 256 * j + 4 * lane) = w;
            }
        }
    }
    grid.sync();
    (void)xcd_barrier_post(barw, bst);

#pragma unroll 1
    for (int ph = 0; ph < (int)sizeof(PROG); ++ph) {
        const int layer = PROG[ph] >> 4, step = PROG[ph] & 15;
        const int G = gridDim.x;
#define TIDV const int tid_ = tidx(), lane = tid_ & 63, wid = __builtin_amdgcn_readfirstlane(tid_ >> 6); (void)lane; (void)wid;
        bf16_t* HB = (bf16_t*)(P.ws + WS_HB); float* HFM = (float*)(P.ws + WS_HFM);
        bf16_t* BIG = (bf16_t*)(P.ws + WS_BIG); bf16_t* MA = (bf16_t*)(P.ws + WS_MA);
        const bf16_t* Wl = (const bf16_t*)(P.ws + WS_W) + (size_t)layer * OW_LAYER;
#define LNCTX float* ROWS = (float*)(P.ws + WS_ROWS); const float* CSl = (const float*)(P.ws + WS_CSBW) + (size_t)layer * 2 * OC_N; const float* BWl = CSl + OC_N; \
        const int tlast = 3 * layer + (step <= 1 ? -1 : step <= 9 ? 0 : step <= 12 ? 1 : 2);   \
        const float* rows_last = ROWS + (size_t)((tlast & 1) * MPAD) * 2; (void)CSl; (void)BWl; (void)rows_last;
        if (step == 0 || step == 3 || step == 11) {
            LNCTX
            float* z = ROWS + (size_t)(((tlast + 1) & 1) * MPAD) * 2;
            for (int i = bidx() * 512 + tidx(); i < MPAD * 2 / 4; i += G * 512) *(f32x4*)(z + 4 * i) = (f32x4){0.f, 0.f, 0.f, 0.f};
        }
        if (step == 0 || step == 11) {
            LNCTX
            const bf16_t* Wgu = Wl + (step ? OW_GU2 : OW_GU1); const int oc = step ? OC_GU2 : OC_GU1;
            const pg8::LnFix fx{rows_last, CSl + oc, BWl + oc, tlast >= 0 ? 1 : 0};
            pg8::Gemm gm{HB, Wgu, MREAL, 2 * FF, DM}; pg8::StaticOrder S; S.init(MREAL, 2 * FF, G, bidx());
            pg8::EpiSwiglu E{BIG, FF, fx};
            pg8::gemm_phase<pg8::EpiSwiglu, pg8::StaticOrder, true, true>(lds, gm, S, E);
            for (int ct = bidx(); ct < FF / 16; ct += G) {
                TIDV
                const int c0 = 16 * ct, R0 = 256 * (c0 >> 7) + (c0 & 127);
                const f32x4 ag = sg_tile_blk(HB + (size_t)MROW0 * DM, DM, Wgu, DM, R0, lane, wid, (LAS float*)lds), au = sg_tile_blk(HB + (size_t)MROW0 * DM, DM, Wgu, DM, R0 + 128, lane, wid, (LAS float*)lds);
                if (wid == 0) {
                    const int rb = R0 + (lane & 15);
                    float mu4[4] = {0.f, 0.f, 0.f, 0.f}, r4v[4] = {1.f, 1.f, 1.f, 1.f}, csg = 0.f, bwg = 0.f, csu = 0.f, bwu = 0.f;
                    if (fx.on) { csg = fx.cs[rb]; bwg = fx.bw[rb]; csu = fx.cs[rb + 128]; bwu = fx.bw[rb + 128];
#pragma unroll
                        for (int e = 0; e < 4; ++e) fx.stats((size_t)(MROW0 + 4 * (lane >> 4) + e), mu4[e], r4v[e]); }
#pragma unroll
                    for (int e = 0; e < 4; ++e) {
                        const size_t row = (size_t)(MROW0 + 4 * (lane >> 4) + e);
                        const float gv = (ag[e] - csg * mu4[e]) * r4v[e] + bwg, uv = (au[e] - csu * mu4[e]) * r4v[e] + bwu;
                        BIG[row * FF + c0 + (lane & 15)] = (bf16_t)f2bf(siluf(gv) * uv);
                    }
                }
            }
        } else if (step == 1 || step == 9 || step == 12) {
            LNCTX
            const bf16_t* A = step == 9 ? MA : BIG; const bf16_t* Bt = Wl + (step == 1 ? OW_D1 : step == 9 ? OW_OUT : OW_D2);
            const int K = step == 9 ? DM : FF; const float sc = step == 9 ? 1.f : 0.5f;
            pg8::Gemm gm{A, Bt, MREAL, DM, K}; pg8::StaticOrder S; S.init(MREAL, DM, G, bidx());
            const int raw = tlast < 0 ? 1 : 0;
            const int gi = step == 1 ? (layer == 0 ? 5 : 26) : step == 9 ? 5 : 21;
            const int gl = step == 1 ? (layer == 0 ? 0 : layer - 1) : layer;
            const float* gam = P.in[gi] + (size_t)gl * DM; const float* bet = P.in[gi + 1] + (size_t)gl * DM;
            float* rows_cur = ROWS + (size_t)(((tlast + 1) & 1) * MPAD) * 2;
            pg8::EpiResid E{P.in[0], (bf16_t*)(P.ws + WS_LO), HB, rows_last, rows_cur, gam, bet, sc, raw};
            pg8::gemm_phase<pg8::EpiResid, pg8::StaticOrder, true, true>(lds, gm, S, E);
            for (int ct = bidx(); ct < 64; ct += G) {
                TIDV
                const f32x4 a = sg_tile_blk(A + (size_t)MROW0 * K, K, Bt, K, 16 * ct, lane, wid, (LAS float*)lds);
                const int col = 16 * ct + (lane & 15);
                if (wid == 0) {
                    float hv[4], s1v[4] = {0.f, 0.f, 0.f, 0.f}, s2v[4] = {1.f, 1.f, 1.f, 1.f}, gcol = 1.f, bcol = 0.f;
#pragma unroll
                    for (int e = 0; e < 4; ++e) { const int mr = 4 * (lane >> 4) + e; hv[e] = HFM[(size_t)mr * DM + col]; if (!raw) { s1v[e] = rows_last[(size_t)(MROW0 + mr) * 2]; s2v[e] = rows_last[(size_t)(MROW0 + mr) * 2 + 1]; } }
                    if (!raw) { gcol = gam[col]; bcol = bet[col]; }
#pragma unroll
                    for (int e = 0; e < 4; ++e) {
                        const int mr = 4 * (lane >> 4) + e; float* p = HFM + (size_t)mr * DM + col;
                        float h = hv[e];
                        if (!raw) { const float mu = s1v[e] * (1.f / DM), r = __builtin_amdgcn_rsqf(s2v[e] * (1.f / DM) - mu * mu + LN_EPS);
                            h = (h - mu) * r * gcol + bcol; }
                        const float y = ALPHA * h + sc * a[e];
                        *p = y; HB[(size_t)(MROW0 + mr) * DM + col] = (bf16_t)f2bf(y);
                        float q1 = y, q2 = y * y;
                        q1 += __shfl_xor(q1, 1); q1 += __shfl_xor(q1, 2); q1 += __shfl_xor(q1, 4); q1 += __shfl_xor(q1, 8);
                        q2 += __shfl_xor(q2, 1); q2 += __shfl_xor(q2, 2); q2 += __shfl_xor(q2, 4); q2 += __shfl_xor(q2, 8);
                        if ((lane & 15) == 0) { atomicAdd(rows_cur + (size_t)(MROW0 + mr) * 2, q1); atomicAdd(rows_cur + (size_t)(MROW0 + mr) * 2 + 1, q2); }
                    }
                }
            }
        } else if (step == 13) {
            ln_phase(P, P.in[26] + (size_t)layer * DM, P.in[27] + (size_t)layer * DM, false, true, nullptr, nullptr, lds);
        } else if (step == 3 || step == 7) {
            LNCTX
            const int ng = step == 3 ? 1 : 2;
            float* GT = (float*)(P.ws + WS_GATES); const float* bif = P.in[10] + (size_t)layer * 8;
#pragma unroll 1
            for (int gi = 0; gi < ng; ++gi) {
                const bf16_t* A = step == 3 ? HB : MA + (size_t)gi * MPAD * 512;
                const bf16_t* Bt = Wl + (step == 3 ? OW_PB : gi ? OW_BA : OW_BM);
                const int N = step == 3 ? NPBW : DM, K = step == 3 ? DM : 512, ldc = step == 3 ? NPB : 2048, coff = gi * DM;
                const pg8::LnFix fx{rows_last, CSl + OC_PB, BWl + OC_PB, step == 3 ? 1 : 0};
                pg8::Gemm gm{A, Bt, MREAL, N, K}; pg8::StaticOrder S; S.init(MREAL, N, G, bidx());
                pg8::EpiPlain E{BIG, ldc, coff, step == 3 ? 8 : 0, step == 3 ? 10 : 0, QSCALE, fx, step == 3 ? GT : nullptr, bif};
                pg8::gemm_phase<pg8::EpiPlain, pg8::StaticOrder, true, true>(lds, gm, S, E);
                const int ntile = step == 3 ? NPB / 16 + 1 : N / 16;
                for (int ct = bidx(); ct < ntile; ct += G) {
                    TIDV
                    const f32x4 a = sg_tile_blk(A + (size_t)MROW0 * K, K, Bt, K, 16 * ct, lane, wid, (LAS float*)lds);
                    const float sc = (step == 3 && 16 * ct >= 2048 && 16 * ct < 2560) ? QSCALE : 1.f;
                    if (wid == 0) {
                        const int rb = 16 * ct + (lane & 15);
                        float mu4[4] = {0.f, 0.f, 0.f, 0.f}, r4v[4] = {1.f, 1.f, 1.f, 1.f}, cs1 = 0.f, bw1 = 0.f;
                        if (fx.on) { cs1 = fx.cs[rb]; bw1 = fx.bw[rb];
#pragma unroll
                            for (int e = 0; e < 4; ++e) fx.stats((size_t)(MROW0 + 4 * (lane >> 4) + e), mu4[e], r4v[e]); }
#pragma unroll
                        for (int e = 0; e < 4; ++e) {
                            const size_t row = (size_t)(MROW0 + 4 * (lane >> 4) + e);
                            const float v = (a[e] - cs1 * mu4[e]) * r4v[e] + bw1;
                            if (step == 3 && ct == NPB / 16) {
                                if ((lane & 15) < 8) { const float z = v + bif[lane & 15]; GT[row * 8 + (lane & 15)] = (lane & 15) < 4 ? z : fminf(z, 0.f) - __logf(1.f + __expf(-fabsf(z))); }
                            } else BIG[row * ldc + coff + rb] = (bf16_t)f2bf(v * sc);
                        }
                    }
                }
            }
        } else if (step == 4) {
            {
                float* KM = (float*)(P.ws + WS_KM) + layer * 72;
                TIDV
                const int gw = bidx() * 8 + wid, NGW = G * 8;
#pragma unroll 1
                for (int task = gw; task < 2049; task += NGW) {
                    const int real = task < 2048, slot = real ? task >> 8 : 8, nr = real ? 32 : NMETA;
                    const size_t r0 = real ? (size_t)(task >> 8) * SEQ + (size_t)(task & 255) * 32 : (size_t)MROW0;
                    float mxv = 0.f;
#pragma unroll 1
                    for (int i0 = 0; i0 < nr; i0 += 8) {
                        u32x4 vr[8];
#pragma unroll
                        for (int j = 0; j < 8; ++j) vr[j] = *(const u32x4*)(BIG + (r0 + i0 + j) * NPB + 2560 + lane * 8);
                        asm volatile("" : "+v"(vr[0]), "+v"(vr[1]), "+v"(vr[2]), "+v"(vr[3]), "+v"(vr[4]), "+v"(vr[5]), "+v"(vr[6]), "+v"(vr[7]));
#pragma unroll
                        for (int j = 0; j < 8; ++j) {
                            const u32x4 v = vr[j];
                            float ss = bflo(v.x) * bflo(v.x) + bfhi(v.x) * bfhi(v.x) + bflo(v.y) * bflo(v.y) + bfhi(v.y) * bfhi(v.y) + bflo(v.z) * bflo(v.z) + bfhi(v.z) * bfhi(v.z) + bflo(v.w) * bflo(v.w) + bfhi(v.w) * bfhi(v.w);
                            ss += __shfl_xor(ss, 1); ss += __shfl_xor(ss, 2); ss += __shfl_xor(ss, 4);
                            mxv = fmaxf(mxv, ss);
                        }
                    }
                    if ((lane & 7) == 0) atomicMax((unsigned*)KM + slot * 8 + (lane >> 3), __builtin_bit_cast(unsigned, mxv));
                }
            }
            for (int u = bidx(); u < 2048 + 4; u += G) { const int bh_ = u < 2048 ? u >> 6 : u - 2048, c_ = u < 2048 ? 1 + (u & 63) : 0; m1_unit(P, layer, bh_, c_, lds); }
        } else if (step == 5) {
            m2_phase(P);
        } else if (step == 6) {
            const float lam_init = layer == 0 ? 0.2f : 0.35550906759f;
            float lam;
            {
                TIDV
                const float* l1 = P.in[12] + layer * 64; const float* k1 = P.in[13] + layer * 64; const float* l2 = P.in[14] + layer * 64; const float* k2 = P.in[15] + layer * 64;
                const float s1 = wave_sum(l1[lane] * k1[lane]), s2 = wave_sum(l2[lane] * k2[lane]);
                lam = expf(s1) - expf(s2) + lam_init;
            }
#pragma unroll 1
            for (int rep_ = 0; rep_ < PROBE_ATT; ++rep_)
#pragma unroll 1
            for (int u = bidx(); u < 2048 + 4; u += G) {
                const int cbv = u & 255, i = u >> 8, jj = cbv >> 3, j = (i & 4) ? 63 - jj : jj;
                const bool real = u < 2048; const int bh = real ? ((cbv & 7) * 4 + (i & 3)) : (u - 2048);
                attn_unit(P, layer, bh >> 2, bh & 3, real ? NMETA + 128 * j : 0, real ? 128 : NMETA, lam, lam_init, lds);
            }
#pragma unroll 1
            for (int rep_ = 0; rep_ < PROBE_M3; ++rep_)
#pragma unroll 1
            for (int u = bidx(); u < 2048 + 4; u += G) { const int bh_ = u < 2048 ? u >> 6 : u - 2048, c_ = u < 2048 ? 1 + (u & 63) : 0; m3_unit(P, layer, bh_, c_, lds); }
        } else if (step == 8) {
            const bf16_t* Y = BIG; const float* bg = P.in[19] + (size_t)layer * 2048;
            pg8::Gemm gm{HB, Wl + OW_GM, MREAL, 2048, DM}; pg8::StaticOrder S; S.init(MREAL, 2048, G, bidx());
            LNCTX
            const pg8::LnFix fx{rows_last, CSl + OC_GM, BWl + OC_GM, 1};
            pg8::EpiGate E{MA, Y, bg, fx};
            pg8::gemm_phase<pg8::EpiGate, pg8::StaticOrder, true, true>(lds, gm, S, E);
            for (int ct = bidx(); ct < 64; ct += G) {
                TIDV
                const int c0 = 16 * ct, R0 = 256 * (c0 >> 7) + (c0 & 127);
                const f32x4 am = sg_tile_blk(HB + (size_t)MROW0 * DM, DM, Wl + OW_GM, DM, R0, lane, wid, (LAS float*)lds), aa = sg_tile_blk(HB + (size_t)MROW0 * DM, DM, Wl + OW_GM, DM, R0 + 128, lane, wid, (LAS float*)lds);
                const int col = c0 + (lane & 15), rb = R0 + (lane & 15);
                if (wid == 0) {
                    float mu4[4], r4v[4], ymv[4], yav[4];
                    const float csm = fx.cs[rb], bwm = fx.bw[rb], csa = fx.cs[rb + 128], bwa = fx.bw[rb + 128];
#pragma unroll
                    for (int e = 0; e < 4; ++e) { const size_t rowl = (size_t)(MROW0 + 4 * (lane >> 4) + e); fx.stats(rowl, mu4[e], r4v[e]); ymv[e] = bflo((unsigned)Y[rowl * 2048 + col]); yav[e] = bflo((unsigned)Y[rowl * 2048 + DM + col]); }
#pragma unroll
                    for (int e = 0; e < 4; ++e) {
                        const size_t row = (size_t)(MROW0 + 4 * (lane >> 4) + e);
                        const float gmv = (am[e] - csm * mu4[e]) * r4v[e] + bwm, gav = (aa[e] - csa * mu4[e]) * r4v[e] + bwa;
                        const float ym = ymv[e], ya = yav[e];
                        MA[row * DM + col] = (bf16_t)f2bf(sigm(gmv) * ym + sigm(gav) * ya);
                    }
                }
            }
        }
        {
            unsigned char* wsb = P.ws; asm volatile("" : "+s"(wsb));
            XcdBarrier xb; xb.bar = (unsigned*)(wsb + WS_BAR); xb.x = xb_xcc_id(); xb.st = (volatile LAS unsigned*)(lds + LDS_BST);
            xcd_barrier(xb);
#ifdef PROBE_SYNC
            for (int i_ = 0; i_ < PROBE_SYNC; ++i_) xcd_barrier(xb);
#endif
        }
    }
}

extern "C" void kernel_launch(void* const* d_in, const int* in_sizes, int n_in, void* d_out, int out_size, void* d_ws, size_t ws_size, hipStream_t stream) {
    static int grid = 0;
    if (grid == 0) {
        if (n_in != 28 || out_size != MREAL * DM || ws_size < WS_END) { fprintf(stderr, "kernel_launch: unexpected shapes (n_in %d out %d ws %zu)\n", n_in, out_size, ws_size); grid = -1; return; }
        int dev = 0, cus = 0, per_cu = 0;
        hipGetDevice(&dev); hipDeviceGetAttribute(&cus, hipDeviceAttributeMultiprocessorCount, dev);
        hipFuncSetAttribute((const void*)hybrid_fwd, hipFuncAttributeMaxDynamicSharedMemorySize, LDS_BYTES);
        hipOccupancyMaxActiveBlocksPerMultiprocessor(&per_cu, (const void*)hybrid_fwd, 512, LDS_BYTES);
        if (per_cu < 1) per_cu = 1;
        grid = cus * per_cu;
        (void)hipGetLastError();
    }
    if (grid < 0) return;
    Params p{};
    for (int i = 0; i < 28; ++i) p.in[i] = (const float*)d_in[i];
    p.out = (float*)d_out; p.ws = (unsigned char*)d_ws;
    void* args[] = {&p};
    hipError_t e = hipLaunchCooperativeKernel((const void*)hybrid_fwd, dim3(grid), dim3(512), args, LDS_BYTES, stream);
    if (e != hipSuccess) fprintf(stderr, "cooperative launch failed: %s (grid %d)\n", hipGetErrorString(e), grid);
}
```

```cpp
#include <hip/hip_runtime.h>
#include <hip/hip_cooperative_groups.h>
#include <cstdio>
#include <cstdint>
namespace cg = cooperative_groups;

__device__ __forceinline__ int tidx() { int t = threadIdx.x; asm volatile("" : "+v"(t)); return t; }
__device__ __forceinline__ int bidx() { int t = blockIdx.x; asm volatile("" : "+s"(t)); return t; }
namespace pg8 {
#define PG8_LAS __attribute__((address_space(3)))
typedef unsigned short bf16_t;
typedef short bf16x8 __attribute__((ext_vector_type(8)));
typedef float f32x4 __attribute__((ext_vector_type(4)));
typedef unsigned u32x4 __attribute__((ext_vector_type(4)));
constexpr int BM = 256, BK = 64, HALF = 128, HTB = HALF * BK * 2  , STAGE_BYTES = 8 * HTB, NXCD = 8, WGM = 8;

__host__ __device__ __forceinline__ int lds_byte(int r, int c) { const int st = (r >> 4) * 2 + (c >> 5), rr = r & 15, cc = c & 31, ob = rr * 64 + cc * 2; return st * 1024 + (ob ^ (((ob >> 9) & 1) << 5)); }
__host__ __device__ __forceinline__ void stage_rc(int b, int& R, int& C) { const int st = b / 1024, sb = b % 1024, swz = sb ^ (((sb >> 9) & 1) << 5); R = (st >> 1) * 16 + swz / 64; C = (st & 1) * 32 + (swz % 64) / 2; }
__host__ __device__ __forceinline__ int perm32(int rho) { const int n = rho >> 4, i = rho & 15; return 8 * (i >> 2) + 4 * n + (i & 3); }

struct Unit { int pm, pn; };
struct Gemm { const bf16_t* A; const bf16_t* Bt; int M, N, K; };

struct StaticOrder {
    int nM, nN, nwg, G, c;
    __host__ __device__ void init(int M, int N, int G_, int c_) { nM = M / BM; nN = N / BM; nwg = nM * nN; G = G_; c = c_; }
    __host__ __device__ bool next(int i, Unit& u) const {
        const long L = (long)i * G + c; if (L >= nwg) return false;
        int wgid = (int)L; { const int q = nwg / NXCD, r = nwg % NXCD, xcd = wgid % NXCD, off = wgid / NXCD; wgid = (xcd < r ? xcd * (q + 1) : r * (q + 1) + (xcd - r) * q) + off; }
        const int nig = WGM * nN, gid = wgid / nig, fm = gid * WGM, gsz = (nM - fm) < WGM ? (nM - fm) : WGM;
        u.pm = fm + ((wgid % nig) % gsz); u.pn = (wgid % nig) / gsz; return true;
    }
    __device__ __forceinline__ void a_ready(const Unit&) const {}
    __device__ __forceinline__ void done(const Unit&) const {}
};

__device__ __forceinline__ unsigned cvt_pk_bf16(float lo, float hi) { unsigned r; asm volatile("v_cvt_pk_bf16_f32 %0, %1, %2" : "=v"(r) : "v"(lo), "v"(hi)); return r; }
typedef float f32x2 __attribute__((ext_vector_type(2)));
__device__ __forceinline__ f32x2 gelu_pk(f32x2 v) {
    const f32x2 av = __builtin_elementwise_abs(v), d = av * 0.2316418882f + 1.0f;
    f32x2 t; t.x = __builtin_amdgcn_rcpf(d.x); t.y = __builtin_amdgcn_rcpf(d.y);
    f32x2 q = t * 0.5307027145f + (-0.7265760135f); q = q * t + 0.7107068705f; q = q * t + (-0.142248368f); q = q * t + 0.127414796f; q = q * t;
    const f32x2 s = (v * v) * (-0.72134752044f);
    f32x2 e; e.x = __builtin_amdgcn_exp2f(s.x); e.y = __builtin_amdgcn_exp2f(s.y);
    const f32x2 m = v * (q * e), r = v - m;
    f32x2 o; o.x = v.x < 0.f ? m.x : r.x; o.y = v.y < 0.f ? m.y : r.y; return o;
}

template <int ACT  > struct EpiBf16 {
    static constexpr bool PERM = true, AFTER_DRAIN = false; static_assert(ACT == 0 || ACT == 1, "EpiBf16: ACT is 0 (none) or 1 (gelu_pk)");
    bf16_t* O; int ldc; const float* bias; int split_cols; size_t split_stride; float scale0;
    __device__ __forceinline__ void operator()(const f32x4 (&acc)[2][2][4][2], const Unit& u, int wr, int wc, int fr, int fq) const {
        const int row0 = u.pm * BM + wr * 64 + fr; int colt = u.pn * BM; bf16_t* base = O;
        float sc = 1.f; if (split_cols) { const int t = colt / split_cols; base += (size_t)t * split_stride; colt -= t * split_cols; if (t == 0) sc = scale0; }
        const int col0 = colt + wc * 32 + 8 * fq, bcol0 = u.pn * BM + wc * 32 + 8 * fq;
        f32x4 bv[2][2];
#pragma unroll
        for (int bj = 0; bj < 2; ++bj)
#pragma unroll
            for (int n = 0; n < 2; ++n) bv[bj][n] = bias ? *(const f32x4*)(bias + bcol0 + bj * HALF + 4 * n) : (f32x4){0.f, 0.f, 0.f, 0.f};
#pragma unroll
        for (int ai = 0; ai < 2; ++ai)
#pragma unroll
            for (int m = 0; m < 4; ++m) { bf16_t* rowp = base + (size_t)(row0 + ai * HALF + m * 16) * ldc + col0;
#pragma unroll
                for (int bj = 0; bj < 2; ++bj) { f32x4 v0 = acc[ai][bj][m][0] + bv[bj][0], v1 = acc[ai][bj][m][1] + bv[bj][1];
                    if (ACT == 1) { f32x2 a = gelu_pk((f32x2){v0[0], v0[1]}), b = gelu_pk((f32x2){v0[2], v0[3]}), c = gelu_pk((f32x2){v1[0], v1[1]}), d = gelu_pk((f32x2){v1[2], v1[3]});
                        v0 = (f32x4){a.x, a.y, b.x, b.y}; v1 = (f32x4){c.x, c.y, d.x, d.y}; }
                    v0 = v0 * sc; v1 = v1 * sc; u32x4 w; w.x = cvt_pk_bf16(v0[0], v0[1]); w.y = cvt_pk_bf16(v0[2], v0[3]); w.z = cvt_pk_bf16(v1[0], v1[1]); w.w = cvt_pk_bf16(v1[2], v1[3]);
                    *(u32x4*)(rowp + bj * HALF) = w; } }
    }
};

struct PanelStats {
    unsigned* xbuf;
    unsigned* cnt;
    unsigned* tmo;
    int ntn; float eps;
    unsigned code;
    __device__ __forceinline__ bool run(const f32x4 (&v)[2][2][4][2], const Unit& u, int wr, int wc, int fr, int fq, PG8_LAS unsigned char* lds, int wid, int lane) const {
        typedef float f32x2v __attribute__((ext_vector_type(2)));
        PG8_LAS f32x2v* P = (PG8_LAS f32x2v*)lds;
        PG8_LAS f32x2v* S = (PG8_LAS f32x2v*)(lds + 8192);
        PG8_LAS unsigned* flag = (PG8_LAS unsigned*)(lds + 8192 + 2048);
#pragma unroll
        for (int ai = 0; ai < 2; ++ai)
#pragma unroll
            for (int m = 0; m < 4; ++m) {
                float s = 0.f;
#pragma unroll
                for (int bj = 0; bj < 2; ++bj)
#pragma unroll
                    for (int n = 0; n < 2; ++n) { const f32x4 x = v[ai][bj][m][n]; s += (x[0] + x[1]) + (x[2] + x[3]); }
                s += __shfl_xor(s, 16); s += __shfl_xor(s, 32);
                const float mw = s * (1.0f / 64.0f); float q = 0.f;
#pragma unroll
                for (int bj = 0; bj < 2; ++bj)
#pragma unroll
                    for (int n = 0; n < 2; ++n) { const f32x4 d = v[ai][bj][m][n] - mw; q += (d[0] * d[0] + d[1] * d[1]) + (d[2] * d[2] + d[3] * d[3]); }
                q += __shfl_xor(q, 16); q += __shfl_xor(q, 32);
                if (fq == 0) P[(ai * HALF + wr * 64 + m * 16 + fr) * 4 + wc] = (f32x2v){mw, q};
            }
        asm volatile("s_waitcnt lgkmcnt(0)" ::: "memory"); __builtin_amdgcn_s_barrier(); asm volatile("" ::: "memory");
#if defined(BROKEN_EXCHANGE_NO_WAIT)
#warning BROKEN CONTROL BUILD: the row-statistics exchange does not wait; results are wrong by design
        if (blockIdx.x >= 64) { const long long t0_ = clock64(); while (clock64() - t0_ < 60000) __builtin_amdgcn_s_sleep(8); }
#endif
        const int row = wid * 32 + (lane & 31);
        if (lane < 32) {
            const f32x2v a = P[row * 4 + 0], b = P[row * 4 + 1], c = P[row * 4 + 2], d = P[row * 4 + 3];
            const float mt = (a.x + b.x + c.x + d.x) * 0.25f;
            const float da = a.x - mt, db = b.x - mt, dc = c.x - mt, dd = d.x - mt;
            const float m2 = (a.y + b.y) + (c.y + d.y) + 64.0f * ((da * da + db * db) + (dc * dc + dd * dd));
            unsigned long long* slot = (unsigned long long*)xbuf + ((size_t)(u.pm * BM + row) * 4 + u.pn);
            __hip_atomic_store(slot, ((unsigned long long)__float_as_uint(m2) << 32) | __float_as_uint(mt), __ATOMIC_RELAXED, __HIP_MEMORY_SCOPE_AGENT);
        }
        asm volatile("s_waitcnt vmcnt(0)" ::: "memory");
        if (lane == 0) __hip_atomic_fetch_add(cnt + 64 * u.pm, 1u, __ATOMIC_RELAXED, __HIP_MEMORY_SCOPE_AGENT);
        if (wid == 0) {
            bool dead = false; const unsigned long long t0 = __builtin_amdgcn_s_memrealtime(); const unsigned want = 8u * (unsigned)ntn;
            for (;;) {
#if defined(BROKEN_EXCHANGE_NO_WAIT)
                break;
#endif
                if ((unsigned)__builtin_amdgcn_readfirstlane(__hip_atomic_load(cnt + 64 * u.pm, __ATOMIC_RELAXED, __HIP_MEMORY_SCOPE_AGENT)) >= want) break;
                if (__builtin_amdgcn_s_memrealtime() - t0 > 2000000ull) {
                    if (lane == 0) { unsigned expect = 0u; __hip_atomic_compare_exchange_strong(tmo + 1, &expect, code | (unsigned)(u.pm & 0xff), __ATOMIC_RELAXED, __ATOMIC_RELAXED, __HIP_MEMORY_SCOPE_AGENT);
                                     __hip_atomic_store(tmo, 1u, __ATOMIC_RELAXED, __HIP_MEMORY_SCOPE_AGENT); }
                    dead = true; break; }
                __builtin_amdgcn_s_sleep(2);
            }
            __builtin_amdgcn_fence(__ATOMIC_ACQUIRE, "agent");
            if (lane == 0) flag[0] = dead ? 1u : 0u;
        }
        asm volatile("s_waitcnt vmcnt(0) lgkmcnt(0)" ::: "memory"); __builtin_amdgcn_s_barrier(); asm volatile("" ::: "memory");
        const bool bad = flag[0] != 0u;
        if (lane < 32) {
            const unsigned long long* slot = (const unsigned long long*)xbuf + (size_t)(u.pm * BM + row) * 4; float mt[4], m2[4]; float ms = 0.f;
#pragma unroll
            for (int t = 0; t < 4; ++t) { if (t < ntn) { const unsigned long long w = __hip_atomic_load(slot + t, __ATOMIC_RELAXED, __HIP_MEMORY_SCOPE_AGENT); mt[t] = __uint_as_float((unsigned)w); m2[t] = __uint_as_float((unsigned)(w >> 32)); } else { mt[t] = 0.f; m2[t] = 0.f; } ms += mt[t]; }
            const float mean = ms / (float)ntn; float q = 0.f;
#pragma unroll
            for (int t = 0; t < 4; ++t) if (t < ntn) { const float dm = mt[t] - mean; q += m2[t] + 256.0f * dm * dm; }
            S[row] = (f32x2v){mean, 1.0f / sqrtf(q / (256.0f * (float)ntn) + eps)};
        }
        asm volatile("s_waitcnt lgkmcnt(0)" ::: "memory"); __builtin_amdgcn_s_barrier(); asm volatile("" ::: "memory");
        return bad;
    }
};
struct EpiLnRes {
    static constexpr bool PERM = false, AFTER_DRAIN = true;
    const float* base; float* out; int ldc; const float* bias; PanelStats st; unsigned poison;
    __device__ __forceinline__ void fused(f32x4 (&acc)[2][2][4][2], const Unit& u, int wr, int wc, int fr, int fq, PG8_LAS unsigned char* lds, int wid, int lane) const {
        typedef float f32x2v __attribute__((ext_vector_type(2)));
        const PG8_LAS f32x2v* S = (const PG8_LAS f32x2v*)(lds + 8192);
        const int col0 = u.pn * BM + wc * 32 + 4 * fq;
#pragma unroll
        for (int bj = 0; bj < 2; ++bj)
#pragma unroll
            for (int n = 0; n < 2; ++n) { const f32x4 bv = bias ? *(const f32x4*)(bias + col0 + bj * HALF + n * 16) : (f32x4){0.f, 0.f, 0.f, 0.f};
#pragma unroll
                for (int ai = 0; ai < 2; ++ai)
#pragma unroll
                    for (int m = 0; m < 4; ++m) acc[ai][bj][m][n] += bv; }
        f32x4 pre[4][2][2];
#pragma unroll
        for (int m = 0; m < 4; ++m) { const size_t off = (size_t)(u.pm * BM + wr * 64 + m * 16 + fr) * ldc + col0;
#pragma unroll
            for (int bj = 0; bj < 2; ++bj)
#pragma unroll
                for (int n = 0; n < 2; ++n) pre[m][bj][n] = *(const f32x4*)(base + off + bj * HALF + n * 16); }
        const bool bad = st.run(acc, u, wr, wc, fr, fq, lds, wid, lane) || poison != 0u;
        const float qnan = __builtin_nanf("");
#pragma unroll
        for (int ai = 0; ai < 2; ++ai)
#pragma unroll
            for (int m = 0; m < 4; ++m) { const int r = ai * HALF + wr * 64 + m * 16 + fr; const f32x2v sr = S[r]; const size_t off = (size_t)(u.pm * BM + r) * ldc + col0;
#pragma unroll
                for (int bj = 0; bj < 2; ++bj)
#pragma unroll
                    for (int n = 0; n < 2; ++n) { const f32x4 bs = ai == 0 ? pre[m][bj][n] : *(const f32x4*)(base + off + bj * HALF + n * 16); f32x4 o = bs + (acc[ai][bj][m][n] - sr.x) * sr.y;
                        if (bad) o = (f32x4){qnan, qnan, qnan, qnan}; *(f32x4*)(out + off + bj * HALF + n * 16) = o; }
                if (m & 1) asm volatile("" ::: "memory"); }
    }
};
struct EpiLnResLn {
    static constexpr bool PERM = false, AFTER_DRAIN = true;
    const float* base; float* out; bf16_t* xn; int ldc; const float* bias; PanelStats st1, st2; unsigned poison;
    __device__ __forceinline__ void fused(f32x4 (&acc)[2][2][4][2], const Unit& u, int wr, int wc, int fr, int fq, PG8_LAS unsigned char* lds, int wid, int lane) const {
        typedef float f32x2v __attribute__((ext_vector_type(2))); typedef unsigned u32x2v __attribute__((ext_vector_type(2)));
        const PG8_LAS f32x2v* S = (const PG8_LAS f32x2v*)(lds + 8192);
        const int col0 = u.pn * BM + wc * 32 + 4 * fq;
#pragma unroll
        for (int bj = 0; bj < 2; ++bj)
#pragma unroll
            for (int n = 0; n < 2; ++n) { const f32x4 bv = bias ? *(const f32x4*)(bias + col0 + bj * HALF + n * 16) : (f32x4){0.f, 0.f, 0.f, 0.f};
#pragma unroll
                for (int ai = 0; ai < 2; ++ai)
#pragma unroll
                    for (int m = 0; m < 4; ++m) acc[ai][bj][m][n] += bv; }
        bool bad = st1.run(acc, u, wr, wc, fr, fq, lds, wid, lane) || poison != 0u;
        const float qnan = __builtin_nanf("");
#pragma unroll
        for (int ai = 0; ai < 2; ++ai)
#pragma unroll
            for (int m = 0; m < 4; ++m) { const int r = ai * HALF + wr * 64 + m * 16 + fr; const f32x2v sr = S[r]; const size_t off = (size_t)(u.pm * BM + r) * ldc + col0;
#pragma unroll
                for (int bj = 0; bj < 2; ++bj)
#pragma unroll
                    for (int n = 0; n < 2; ++n) { const f32x4 bs = *(const f32x4*)(base + off + bj * HALF + n * 16); acc[ai][bj][m][n] = bs + (acc[ai][bj][m][n] - sr.x) * sr.y; }
                asm volatile("" : "+v"(acc[ai][0][m][0]), "+v"(acc[ai][0][m][1]), "+v"(acc[ai][1][m][0]), "+v"(acc[ai][1][m][1]));
                if (m & 1) asm volatile("" ::: "memory"); }
        const bool bad1 = bad;
        bad = st2.run(acc, u, wr, wc, fr, fq, lds, wid, lane) || bad;
#pragma unroll
        for (int ai = 0; ai < 2; ++ai)
#pragma unroll
            for (int m = 0; m < 4; ++m) { const int r = ai * HALF + wr * 64 + m * 16 + fr; const f32x2v sr = S[r]; const size_t off = (size_t)(u.pm * BM + r) * ldc + col0;
#pragma unroll
                for (int bj = 0; bj < 2; ++bj)
#pragma unroll
                    for (int n = 0; n < 2; ++n) { const f32x4 x1 = acc[ai][bj][m][n]; *(f32x4*)(out + off + bj * HALF + n * 16) = bad1 ? (f32x4){qnan, qnan, qnan, qnan} : x1;
                        const f32x4 o = (x1 - sr.x) * sr.y; u32x2v w; w.x = cvt_pk_bf16(o[0], o[1]); w.y = cvt_pk_bf16(o[2], o[3]);
                        if (bad) { w.x = 0x7fc07fc0u; w.y = 0x7fc07fc0u; } *(u32x2v*)(xn + off + bj * HALF + n * 16) = w; }
                asm volatile("" ::: "memory"); }
    }
};

template <class Epi, class Sched, bool ALIGN_EPI = false, bool SP2 = false>
__device__ __forceinline__ void gemm_phase(PG8_LAS unsigned char* lds, const Gemm g, const Sched& S, const Epi& E) {
    const int tid = tidx(), wid = __builtin_amdgcn_readfirstlane(tid >> 6), lane = tid & 63, wr = wid >> 2, wc = wid & 3, fr = lane & 15, fq = lane >> 4;
    const int K = g.K, nt = K / BK;
    unsigned voffA[2], voffB[2];
#pragma unroll
    for (int i = 0; i < 2; ++i) { int R, C; stage_rc(tid * 16 + i * 8192, R, C); const int Rb = Epi::PERM ? ((R & ~31) + perm32(R & 31)) : R;
        voffA[i] = (unsigned)(R * K + C) * 2u; voffB[i] = (unsigned)(Rb * K + C) * 2u; }
    const size_t kstep = (size_t)(BK * 2);
    const size_t hstep = (size_t)HALF * K * 2;
    const size_t tstep = 2 * hstep;
    const unsigned ldsw = (unsigned)wid * 1024u;
    const int aoff = lds_byte(wr * 64 + fr, fq * 8), boff = lds_byte(wc * 32 + fr, fq * 8);
#define PG8_SA(b, h) (((b) * 2 + (h)) * HTB)
#define PG8_SB(b, h) ((4 + (b) * 2 + (h)) * HTB)
#define PG8_STAGE(bufoff, gbase, voff) do { _Pragma("unroll") for (int _i = 0; _i < 2; ++_i) \
        __builtin_amdgcn_global_load_lds((const unsigned*)((const char*)(gbase) + (voff)[_i]), (PG8_LAS unsigned*)(lds + (bufoff) + ldsw + _i * 8192), 16, 0, 0); } while (0)
#define PG8_LDA(dst, b, h) do { _Pragma("unroll") for (int m = 0; m < 4; ++m) _Pragma("unroll") for (int k = 0; k < 2; ++k) dst[m][k] = *(const PG8_LAS bf16x8*)(lds + PG8_SA(b, h) + aoff + m * 2048 + k * 1024); } while (0)
#define PG8_LDB(dst, b, h) do { _Pragma("unroll") for (int n = 0; n < 2; ++n) _Pragma("unroll") for (int k = 0; k < 2; ++k) dst[n][k] = *(const PG8_LAS bf16x8*)(lds + PG8_SB(b, h) + boff + n * 2048 + k * 1024); } while (0)
#define PG8_MMA(ai, bj, At, Bt) do { __builtin_amdgcn_s_setprio(1); _Pragma("unroll") for (int m = 0; m < 4; ++m) _Pragma("unroll") for (int n = 0; n < 2; ++n) _Pragma("unroll") for (int k = 0; k < 2; ++k) \
        acc[ai][bj][m][n] = __builtin_amdgcn_mfma_f32_16x16x32_bf16(Bt[n][k], At[m][k], acc[ai][bj][m][n], 0, 0, 0); __builtin_amdgcn_s_setprio(0); } while (0)
#define PG8_WAIT_V(n) asm volatile("s_waitcnt vmcnt(" #n ")" ::: "memory")
#define PG8_WAIT_L(n) asm volatile("s_waitcnt lgkmcnt(" #n ")" ::: "memory")
#define PG8_BAR __builtin_amdgcn_s_barrier()
#define PG8_SCHED __builtin_amdgcn_sched_barrier(0)
    Unit cur, nxt; int ui = 0;
    if (!S.next(0, cur)) return;
    E.prefetch(cur, tid, lds + 135168);
    f32x4 acc[2][2][4][2];
#pragma unroll
    for (int a = 0; a < 2; ++a)
#pragma unroll
        for (int b = 0; b < 2; ++b)
#pragma unroll
            for (int m = 0; m < 4; ++m)
#pragma unroll
                for (int n = 0; n < 2; ++n) acc[a][b][m][n] = (f32x4){0.f, 0.f, 0.f, 0.f};
    bf16x8 At[4][2], B0[2][2], B1[2][2];
    const char* cA = (const char*)g.A + (size_t)cur.pm * tstep; const char* cB = (const char*)g.Bt + (size_t)cur.pn * tstep;
    S.a_ready(cur);
    if constexpr (SP2) {
        PG8_STAGE(PG8_SB(0, 0), cB, voffB); PG8_STAGE(PG8_SB(0, 1), cB + hstep, voffB); PG8_STAGE(PG8_SA(0, 0), cA, voffA); PG8_STAGE(PG8_SA(0, 1), cA + hstep, voffA);
        if (wr == 1) PG8_BAR;
        PG8_WAIT_V(2); PG8_BAR;
        PG8_STAGE(PG8_SB(1, 0), cB + kstep, voffB); PG8_STAGE(PG8_SA(1, 0), cA + kstep, voffA); PG8_STAGE(PG8_SB(1, 1), cB + hstep + kstep, voffB);
        PG8_WAIT_V(6); PG8_BAR;
    } else {
        PG8_STAGE(PG8_SB(0, 0), cB, voffB); PG8_STAGE(PG8_SA(0, 0), cA, voffA); PG8_STAGE(PG8_SB(0, 1), cB + hstep, voffB); PG8_STAGE(PG8_SA(0, 1), cA + hstep, voffA);
        if (wr == 1) PG8_BAR;
        PG8_WAIT_V(4); PG8_BAR;
        PG8_STAGE(PG8_SB(1, 0), cB + kstep, voffB); PG8_STAGE(PG8_SA(1, 0), cA + kstep, voffA); PG8_STAGE(PG8_SB(1, 1), cB + hstep + kstep, voffB);
        PG8_WAIT_V(6); PG8_BAR;
    }
    for (;;) {
        const bool has_next = S.next(ui + 1, nxt);
        const char* nA = has_next ? (const char*)g.A + (size_t)nxt.pm * tstep : cA; const char* nB = has_next ? (const char*)g.Bt + (size_t)nxt.pn * tstep : cB;
        for (int t = 0; t < nt; t += 2) {
            const bool last = (t == nt - 2);
            const char* a1 = cA + (size_t)(t + 1) * kstep;
            const char* a2 = last ? nA : cA + (size_t)(t + 2) * kstep; const char* b2 = last ? nB : cB + (size_t)(t + 2) * kstep;
            const char* a3 = a2 + kstep; const char* b3 = b2 + kstep;
            if (last && has_next) S.a_ready(nxt);
            if constexpr (SP2) {
            PG8_LDB(B0, 0, 0); PG8_LDB(B1, 0, 1); PG8_SCHED; PG8_LDA(At, 0, 0); PG8_STAGE(PG8_SA(1, 1), a1 + hstep, voffA);
            PG8_WAIT_V(8); PG8_WAIT_L(0); PG8_BAR; PG8_MMA(0, 0, At, B0); PG8_MMA(0, 1, At, B1); PG8_BAR; PG8_SCHED;
            PG8_LDA(At, 0, 1); PG8_STAGE(PG8_SB(0, 0), b2, voffB); PG8_STAGE(PG8_SB(0, 1), b2 + hstep, voffB); PG8_STAGE(PG8_SA(0, 0), a2, voffA);
            PG8_WAIT_V(8); PG8_WAIT_L(0); PG8_BAR; PG8_MMA(1, 0, At, B0); PG8_MMA(1, 1, At, B1); PG8_BAR; PG8_SCHED;
            PG8_LDB(B0, 1, 0); PG8_LDB(B1, 1, 1); PG8_SCHED; PG8_LDA(At, 1, 0); PG8_STAGE(PG8_SA(0, 1), a2 + hstep, voffA);
            PG8_WAIT_V(8); PG8_WAIT_L(0); PG8_BAR; PG8_MMA(0, 0, At, B0); PG8_MMA(0, 1, At, B1); PG8_BAR; PG8_SCHED;
            PG8_LDA(At, 1, 1); PG8_STAGE(PG8_SB(1, 0), b3, voffB); PG8_STAGE(PG8_SB(1, 1), b3 + hstep, voffB); PG8_STAGE(PG8_SA(1, 0), a3, voffA);
            PG8_WAIT_V(8); PG8_WAIT_L(0); PG8_BAR; PG8_MMA(1, 0, At, B0); PG8_MMA(1, 1, At, B1); PG8_BAR; PG8_SCHED;
            } else {
            PG8_LDB(B0, 0, 0); PG8_SCHED; PG8_LDA(At, 0, 0); PG8_STAGE(PG8_SA(1, 1), a1 + hstep, voffA);
            PG8_WAIT_L(8); PG8_BAR; PG8_WAIT_L(0); PG8_MMA(0, 0, At, B0); PG8_BAR; PG8_SCHED;
            PG8_LDB(B1, 0, 1); PG8_STAGE(PG8_SB(0, 0), b2, voffB);
            PG8_BAR; PG8_WAIT_L(0); PG8_MMA(0, 1, At, B1); PG8_BAR;
            PG8_LDA(At, 0, 1); PG8_STAGE(PG8_SA(0, 0), a2, voffA);
            PG8_BAR; PG8_WAIT_L(0); PG8_MMA(1, 0, At, B0); PG8_BAR; PG8_SCHED;
            PG8_STAGE(PG8_SB(0, 1), b2 + hstep, voffB);
            PG8_WAIT_V(6); PG8_BAR; PG8_MMA(1, 1, At, B1); PG8_BAR;
            PG8_LDB(B0, 1, 0); PG8_SCHED; PG8_LDA(At, 1, 0); PG8_STAGE(PG8_SA(0, 1), a2 + hstep, voffA);
            PG8_WAIT_L(8); PG8_BAR; PG8_WAIT_L(0); PG8_MMA(0, 0, At, B0); PG8_BAR; PG8_SCHED;
            PG8_LDB(B1, 1, 1); PG8_STAGE(PG8_SB(1, 0), b3, voffB);
            PG8_BAR; PG8_WAIT_L(0); PG8_MMA(0, 1, At, B1); PG8_BAR;
            PG8_LDA(At, 1, 1); PG8_STAGE(PG8_SA(1, 0), a3, voffA);
            PG8_BAR; PG8_WAIT_L(0); PG8_MMA(1, 0, At, B0); PG8_BAR; PG8_SCHED;
            PG8_STAGE(PG8_SB(1, 1), b3 + hstep, voffB);
            PG8_WAIT_V(6); PG8_BAR; PG8_MMA(1, 1, At, B1); PG8_BAR;
            }
        }
        if constexpr (ALIGN_EPI) { if (wr == 0) PG8_BAR; }
        if constexpr (!Epi::AFTER_DRAIN) { E(acc, cur, wr, wc, fr, fq, lds + 135168 + (ui & 1) * 4096); if (has_next) E.prefetch(nxt, tid, lds + 135168 + ((ui + 1) & 1) * 4096); S.done(cur); }
        if (!has_next) break;
#pragma unroll
        for (int a = 0; a < 2; ++a)
#pragma unroll
            for (int b = 0; b < 2; ++b)
#pragma unroll
                for (int m = 0; m < 4; ++m)
#pragma unroll
                    for (int n = 0; n < 2; ++n) acc[a][b][m][n] = (f32x4){0.f, 0.f, 0.f, 0.f};
        cur = nxt; cA = nA; cB = nB; ++ui;
        if constexpr (ALIGN_EPI) { if (wr == 1) PG8_BAR; }
    }
    PG8_WAIT_V(0);
    if constexpr (!ALIGN_EPI) { if (wr == 0) PG8_BAR; }
    PG8_BAR;
    if constexpr (Epi::AFTER_DRAIN) { E.fused(acc, cur, wr, wc, fr, fq, lds, wid, lane); S.done(cur); }
#undef PG8_SA
#undef PG8_SB
#undef PG8_STAGE
#undef PG8_LDA
#undef PG8_LDB
#undef PG8_MMA
#undef PG8_WAIT_V
#undef PG8_WAIT_L
#undef PG8_BAR
#undef PG8_SCHED
}
}

#define LAS __attribute__((address_space(3)))
typedef unsigned short bf16_t;
typedef short bf16x8 __attribute__((ext_vector_type(8)));
typedef short s16x4 __attribute__((ext_vector_type(4)));
typedef short v4i16_t __attribute__((ext_vector_type(4)));
typedef float f32x4 __attribute__((ext_vector_type(4)));
typedef float f32x16 __attribute__((ext_vector_type(16)));
typedef unsigned u32x4 __attribute__((ext_vector_type(4)));
typedef unsigned u32x2 __attribute__((ext_vector_type(2)));

constexpr int DM = 1024, NB = 8, SEQ = 8192, NMETA = 16, LSEQ = SEQ + NMETA, MREAL = NB * SEQ, MROW0 = MREAL, MPAD = MREAL + 256;
constexpr int FF = 2816, NPB = 3584, NPBW = 3840, DPROJ = 5640;
constexpr int NCH = 65;
constexpr float ALPHA = 1.41421356237f;
constexpr float LOG2E = 1.4426950408889634f;
constexpr float QSCALE = 0.125f * LOG2E;
constexpr float NEGF = -1e30f;
constexpr float LN_EPS = 1e-5f;

constexpr size_t OW_GU1 = 0, OW_D1 = 5767168, OW_PB = 8650752, OW_GM = 12582912, OW_BM = 14680064, OW_BA = 15204352, OW_OUT = 15728640, OW_GU2 = 16777216, OW_D2 = 22544384, OW_LAYER = 25427968;
constexpr int OC_GU1 = 0, OC_PB = 5632, OC_GM = 9472, OC_GU2 = 11520, OC_N = 17152;
constexpr size_t MiB = 1u << 20;
constexpr size_t WS_ROWS = 0;
constexpr size_t WS_CSBW = 4 * MiB;
constexpr size_t WS_HFM = 5 * MiB;
constexpr size_t WS_GATES = 6 * MiB;
constexpr size_t WS_BAR = 9 * MiB;
constexpr size_t WS_KM = WS_BAR + 16384;
constexpr size_t WS_SC = 10 * MiB;
constexpr size_t WS_NST = 11 * MiB;
constexpr size_t WS_STATS = 13 * MiB;
constexpr size_t WS_W = 16 * MiB;
constexpr size_t WS_HB = 113 * MiB;
constexpr size_t WS_LO = 242 * MiB;
constexpr size_t WS_CST = 371 * MiB;
constexpr size_t WS_MA = 436 * MiB;
constexpr size_t WS_BIG = 565 * MiB;
constexpr size_t WS_END = 1015 * MiB;

struct Params {
    const float* in[28];
    float* out; unsigned char* ws;
};

__device__ __forceinline__ unsigned f2bf(float f) { unsigned u = __builtin_bit_cast(unsigned, f); return (u + 0x7fffu + ((u >> 16) & 1u)) >> 16; }
typedef float f32x2_t __attribute__((ext_vector_type(2))); typedef __bf16 bf16x2_t __attribute__((ext_vector_type(2)));
__device__ __forceinline__ unsigned pk2(float lo, float hi) { f32x2_t v = {lo, hi}; bf16x2_t b = __builtin_convertvector(v, bf16x2_t); return __builtin_bit_cast(unsigned, b); }
__device__ __forceinline__ u32x4 pack8(f32x4 a, f32x4 b) { u32x4 w; w.x = pk2(a[0], a[1]); w.y = pk2(a[2], a[3]); w.z = pk2(b[0], b[1]); w.w = pk2(b[2], b[3]); return w; }
__device__ __forceinline__ float bflo(unsigned w) { return __builtin_bit_cast(float, w << 16); }
__device__ __forceinline__ float bfhi(unsigned w) { return __builtin_bit_cast(float, w & 0xffff0000u); }
__device__ __forceinline__ float ex2(float x) { return __builtin_amdgcn_exp2f(x); }
__device__ __forceinline__ float sigm(float x) { return __builtin_amdgcn_rcpf(1.f + ex2(-x * LOG2E)); }
__device__ __forceinline__ float siluf(float x) { return x * sigm(x); }
__device__ __forceinline__ float wave_sum(float v) {
#pragma unroll
    for (int o = 1; o < 64; o <<= 1) v += __shfl_xor(v, o);
    return v;
}
__device__ __forceinline__ float wave_max(float v) {
#pragma unroll
    for (int o = 1; o < 64; o <<= 1) v = fmaxf(v, __shfl_xor(v, o));
    return v;
}
__device__ __forceinline__ size_t seqrow(int b, int pos) { return pos < NMETA ? (size_t)(MROW0 + pos) : (size_t)b * SEQ + (size_t)(pos - NMETA); }
__device__ __forceinline__ f32x16 mfma32(bf16x8 a, bf16x8 b, f32x16 c) { return __builtin_amdgcn_mfma_f32_32x32x16_bf16(a, b, c, 0, 0, 0); }
__device__ __forceinline__ s16x4 vtr(const LAS unsigned char* p) { return __builtin_bit_cast(s16x4, __builtin_amdgcn_ds_read_tr16_b64_v4i16((LAS v4i16_t*)p)); }
__device__ __forceinline__ bf16x8 cat8(s16x4 lo, s16x4 hi) { return (bf16x8){lo[0], lo[1], lo[2], lo[3], hi[0], hi[1], hi[2], hi[3]}; }

namespace pg8 {
__device__ __forceinline__ void tab_prefetch(const float* rows, const float* v0, const float* v1, int pm, int cbase, int tid, PG8_LAS unsigned char* tab) {
    const int wid = __builtin_amdgcn_readfirstlane(tid >> 6), lane = tid & 63;
    if (rows) __builtin_amdgcn_global_load_lds((const unsigned*)(rows + (size_t)pm * 512 + tid), (PG8_LAS unsigned*)(tab + wid * 256), 4, 0, 0);
    const float* src = (wid < 4 ? v0 + (wid * 64 + lane) : v1 + ((wid - 4) * 64 + lane)) + cbase;
    __builtin_amdgcn_global_load_lds((const unsigned*)src, (PG8_LAS unsigned*)(tab + 2048 + wid * 256), 4, 0, 0);
}
__device__ __forceinline__ void tab_ready() { asm volatile("s_waitcnt vmcnt(14)" ::: "memory"); __builtin_amdgcn_s_barrier(); asm volatile("" ::: "memory"); }
__device__ __forceinline__ void tab_stats(const PG8_LAS unsigned char* tab, int rloc, float& mu, float& r) {
    const f32x2_t st = *(const PG8_LAS f32x2_t*)(tab + rloc * 8); mu = st.x * (1.f / DM); r = __builtin_amdgcn_rsqf(st.y * (1.f / DM) - mu * mu + LN_EPS);
}
struct LnFix {
    const float* rows; const float* cs; const float* bw; int on;
    __device__ __forceinline__ void stats(size_t row, float& mu, float& r) const {
        const f32x2_t st = *(const f32x2_t*)(rows + row * 2); mu = st.x * (1.f / DM); r = __builtin_amdgcn_rsqf(st.y * (1.f / DM) - mu * mu + LN_EPS);
    }
};
struct EpiSwiglu {
    static constexpr bool PERM = true, AFTER_DRAIN = false;
    bf16_t* O; int ldc; LnFix fx;
    __device__ __forceinline__ void prefetch(const Unit& u, int tid, PG8_LAS unsigned char* tab) const { if (fx.on) tab_prefetch(fx.rows, fx.cs, fx.bw, u.pm, u.pn * BM, tid, tab); }
    __device__ __forceinline__ void operator()(const f32x4 (&acc)[2][2][4][2], const Unit& u, int wr, int wc, int fr, int fq, const PG8_LAS unsigned char* tab) const {
        const int row0 = u.pm * BM + wr * 64 + fr, col0 = u.pn * 128 + wc * 32 + 8 * fq, cl = wc * 32 + 8 * fq;
        if (fx.on) tab_ready();
#pragma unroll
        for (int ai = 0; ai < 2; ++ai)
#pragma unroll
            for (int m = 0; m < 4; ++m) {
                const size_t row = (size_t)(row0 + ai * HALF + m * 16);
                float mu = 0.f, r = 1.f; if (fx.on) tab_stats(tab, wr * 64 + fr + ai * HALF + m * 16, mu, r);
                u32x4 w;
#pragma unroll
                for (int n = 0; n < 2; ++n) {
                    f32x4 csg = {0.f, 0.f, 0.f, 0.f}, bwg = csg, csu = csg, bwu = csg;
                    if (fx.on) { csg = *(const PG8_LAS f32x4*)(tab + 2048 + (cl + 4 * n) * 4); bwg = *(const PG8_LAS f32x4*)(tab + 3072 + (cl + 4 * n) * 4); csu = *(const PG8_LAS f32x4*)(tab + 2048 + (cl + HALF + 4 * n) * 4); bwu = *(const PG8_LAS f32x4*)(tab + 3072 + (cl + HALF + 4 * n) * 4); }
                    const f32x4 g = (acc[ai][0][m][n] - csg * mu) * r + bwg, up = (acc[ai][1][m][n] - csu * mu) * r + bwu;
                    const unsigned lo = pk2(siluf(g[0]) * up[0], siluf(g[1]) * up[1]), hi = pk2(siluf(g[2]) * up[2], siluf(g[3]) * up[3]);
                    if (n == 0) { w.x = lo; w.y = hi; } else { w.z = lo; w.w = hi; }
                }
                *(u32x4*)(O + row * ldc + col0) = w;
            }
    }
};
struct EpiPlain {
    static constexpr bool PERM = true, AFTER_DRAIN = false;
    bf16_t* O; int ldc; int coff; int slo, shi; float scale; LnFix fx; float* GT; const float* bif;
    __device__ __forceinline__ void prefetch(const Unit& u, int tid, PG8_LAS unsigned char* tab) const { if (fx.on) tab_prefetch(fx.rows, fx.cs, fx.bw, u.pm, u.pn * BM, tid, tab); }
    __device__ __forceinline__ void operator()(const f32x4 (&acc)[2][2][4][2], const Unit& u, int wr, int wc, int fr, int fq, const PG8_LAS unsigned char* tab) const {
        const int row0 = u.pm * BM + wr * 64 + fr, col0 = coff + u.pn * BM + wc * 32 + 8 * fq, cl = wc * 32 + 8 * fq;
        if (fx.on) tab_ready();
        if (GT && u.pn == 14) {
            if (wc == 0 && fq == 0) {
                const f32x4 cs0 = *(const PG8_LAS f32x4*)(tab + 2048 + cl * 4), cs1 = *(const PG8_LAS f32x4*)(tab + 2048 + (cl + 4) * 4);
                const f32x4 bw0 = *(const PG8_LAS f32x4*)(tab + 3072 + cl * 4) + *(const f32x4*)(bif), bw1 = *(const PG8_LAS f32x4*)(tab + 3072 + (cl + 4) * 4) + *(const f32x4*)(bif + 4);
#pragma unroll
                for (int ai = 0; ai < 2; ++ai)
#pragma unroll
                    for (int m = 0; m < 4; ++m) {
                        const size_t row = (size_t)(row0 + ai * HALF + m * 16);
                        float mu, r; tab_stats(tab, wr * 64 + fr + ai * HALF + m * 16, mu, r);
                        const f32x4 li = (acc[ai][0][m][0] - cs0 * mu) * r + bw0, z = (acc[ai][0][m][1] - cs1 * mu) * r + bw1;
                        f32x4 lf;
#pragma unroll
                        for (int e = 0; e < 4; ++e) lf[e] = fminf(z[e], 0.f) - __logf(1.f + __expf(-fabsf(z[e])));
                        *(f32x4*)(GT + row * 8) = li; *(f32x4*)(GT + row * 8 + 4) = lf;
                    }
            }
            return;
        }
        const float sc = (u.pn >= slo && u.pn < shi) ? scale : 1.f;
#pragma unroll
        for (int ai = 0; ai < 2; ++ai)
#pragma unroll
            for (int m = 0; m < 4; ++m) {
                const size_t row = (size_t)(row0 + ai * HALF + m * 16);
                float mu = 0.f, r = 1.f; if (fx.on) tab_stats(tab, wr * 64 + fr + ai * HALF + m * 16, mu, r);
#pragma unroll
                for (int bj = 0; bj < 2; ++bj) {
                    u32x4 w;
#pragma unroll
                    for (int n = 0; n < 2; ++n) {
                        f32x4 cs4 = {0.f, 0.f, 0.f, 0.f}, bw4 = cs4;
                        if (fx.on) { cs4 = *(const PG8_LAS f32x4*)(tab + 2048 + (cl + bj * HALF + 4 * n) * 4); bw4 = *(const PG8_LAS f32x4*)(tab + 3072 + (cl + bj * HALF + 4 * n) * 4); }
                        const f32x4 v = ((acc[ai][bj][m][n] - cs4 * mu) * r + bw4) * sc;
                        if (n == 0) { w.x = pk2(v[0], v[1]); w.y = pk2(v[2], v[3]); } else { w.z = pk2(v[0], v[1]); w.w = pk2(v[2], v[3]); }
                    }
                    *(u32x4*)(O + row * ldc + col0 + bj * HALF) = w;
                }
            }
    }
};
struct EpiResid {
    static constexpr bool PERM = true, AFTER_DRAIN = false;
    const float* src; bf16_t* LO; bf16_t* HB; const float* rows_prev; float* rows_cur; const float* gam; const float* bet; float s; int raw;
    __device__ __forceinline__ void prefetch(const Unit& u, int tid, PG8_LAS unsigned char* tab) const { if (!raw) tab_prefetch(rows_prev, gam, bet, u.pm, u.pn * BM, tid, tab); }
    __device__ __forceinline__ void operator()(const f32x4 (&acc)[2][2][4][2], const Unit& u, int wr, int wc, int fr, int fq, const PG8_LAS unsigned char* tab) const {
        const int row0 = u.pm * BM + wr * 64 + fr, col0 = u.pn * BM + wc * 32 + 8 * fq, cl = wc * 32 + 8 * fq;
        if (!raw) tab_ready();
#pragma unroll
        for (int ai = 0; ai < 2; ++ai)
#pragma unroll
            for (int m = 0; m < 4; ++m) {
                const size_t row = (size_t)(row0 + ai * HALF + m * 16);
                float mu = 0.f, rs = 1.f;
                if (!raw) tab_stats(tab, wr * 64 + fr + ai * HALF + m * 16, mu, rs);
                const float ar = ALPHA * rs, am = -ALPHA * rs * mu;
                float s1 = 0.f, s2 = 0.f;
#pragma unroll
                for (int bj = 0; bj < 2; ++bj) {
                    f32x4 g0 = {1.f, 1.f, 1.f, 1.f}, g1 = g0, b0 = {0.f, 0.f, 0.f, 0.f}, b1 = b0;
                    if (!raw) { g0 = *(const PG8_LAS f32x4*)(tab + 2048 + (cl + bj * HALF) * 4); g1 = *(const PG8_LAS f32x4*)(tab + 2048 + (cl + bj * HALF + 4) * 4); b0 = *(const PG8_LAS f32x4*)(tab + 3072 + (cl + bj * HALF) * 4); b1 = *(const PG8_LAS f32x4*)(tab + 3072 + (cl + bj * HALF + 4) * 4); }
                    f32x4 x0, x1;
                    if (raw) { x0 = *(const f32x4*)(src + row * DM + col0 + bj * HALF); x1 = *(const f32x4*)(src + row * DM + col0 + bj * HALF + 4); }
                    else { const u32x4 hi = *(const u32x4*)(HB + row * DM + col0 + bj * HALF), lo = *(const u32x4*)(LO + row * DM + col0 + bj * HALF);
                        x0 = (f32x4){bflo(hi.x) + bflo(lo.x), bfhi(hi.x) + bfhi(lo.x), bflo(hi.y) + bflo(lo.y), bfhi(hi.y) + bfhi(lo.y)};
                        x1 = (f32x4){bflo(hi.z) + bflo(lo.z), bfhi(hi.z) + bfhi(lo.z), bflo(hi.w) + bflo(lo.w), bfhi(hi.w) + bfhi(lo.w)}; }
                    const f32x4 o0 = (x0 * ar + am) * g0 + b0 * ALPHA + acc[ai][bj][m][0] * s, o1 = (x1 * ar + am) * g1 + b1 * ALPHA + acc[ai][bj][m][1] * s;
                    const u32x4 nh = pack8(o0, o1);
                    const f32x4 d0 = {o0[0] - bflo(nh.x), o0[1] - bfhi(nh.x), o0[2] - bflo(nh.y), o0[3] - bfhi(nh.y)}, d1 = {o1[0] - bflo(nh.z), o1[1] - bfhi(nh.z), o1[2] - bflo(nh.w), o1[3] - bfhi(nh.w)};
                    *(u32x4*)(HB + row * DM + col0 + bj * HALF) = nh; *(u32x4*)(LO + row * DM + col0 + bj * HALF) = pack8(d0, d1);
                    s1 += ((o0[0] + o0[1]) + (o0[2] + o0[3])) + ((o1[0] + o1[1]) + (o1[2] + o1[3]));
                    s2 += ((o0[0] * o0[0] + o0[1] * o0[1]) + (o0[2] * o0[2] + o0[3] * o0[3])) + ((o1[0] * o1[0] + o1[1] * o1[1]) + (o1[2] * o1[2] + o1[3] * o1[3]));
                }
                s1 += __shfl_xor(s1, 16); s1 += __shfl_xor(s1, 32); s2 += __shfl_xor(s2, 16); s2 += __shfl_xor(s2, 32);
                if (fq == 0) { float* rp = rows_cur + row * 2; atomicAdd(rp, s1); atomicAdd(rp + 1, s2); }
                asm volatile("" ::: "memory");
            }
    }
};
struct EpiGate {
    static constexpr bool PERM = true, AFTER_DRAIN = false;
    bf16_t* U; const bf16_t* Y; const float* bg; LnFix fx;
    __device__ __forceinline__ void prefetch(const Unit& u, int tid, PG8_LAS unsigned char* tab) const { tab_prefetch(fx.rows, fx.cs, fx.bw, u.pm, u.pn * BM, tid, tab); }
    __device__ __forceinline__ void operator()(const f32x4 (&acc)[2][2][4][2], const Unit& u, int wr, int wc, int fr, int fq, const PG8_LAS unsigned char* tab) const {
        const int row0 = u.pm * BM + wr * 64 + fr, col0 = u.pn * 128 + wc * 32 + 8 * fq, cl = wc * 32 + 8 * fq;
        tab_ready();
#pragma unroll
        for (int ai = 0; ai < 2; ++ai)
#pragma unroll
            for (int m = 0; m < 4; ++m) {
                const size_t row = (size_t)(row0 + ai * HALF + m * 16);
                float mu, r; tab_stats(tab, wr * 64 + fr + ai * HALF + m * 16, mu, r);
                const u32x4 ym = *(const u32x4*)(Y + row * 2048 + col0), ya = *(const u32x4*)(Y + row * 2048 + DM + col0);
                u32x4 w;
#pragma unroll
                for (int n = 0; n < 2; ++n) {
                    const f32x4 csm = *(const PG8_LAS f32x4*)(tab + 2048 + (cl + 4 * n) * 4), bm = *(const PG8_LAS f32x4*)(tab + 3072 + (cl + 4 * n) * 4);
                    const f32x4 csa = *(const PG8_LAS f32x4*)(tab + 2048 + (cl + HALF + 4 * n) * 4), ba = *(const PG8_LAS f32x4*)(tab + 3072 + (cl + HALF + 4 * n) * 4);
                    const f32x4 gm = (acc[ai][0][m][n] - csm * mu) * r + bm, ga = (acc[ai][1][m][n] - csa * mu) * r + ba;
                    const unsigned y0 = n ? ym.z : ym.x, y1 = n ? ym.w : ym.y, a0 = n ? ya.z : ya.x, a1 = n ? ya.w : ya.y;
                    const unsigned lo = pk2(sigm(gm[0]) * bflo(y0) + sigm(ga[0]) * bflo(a0), sigm(gm[1]) * bfhi(y0) + sigm(ga[1]) * bfhi(a0));
                    const unsigned hi = pk2(sigm(gm[2]) * bflo(y1) + sigm(ga[2]) * bflo(a1), sigm(gm[3]) * bfhi(y1) + sigm(ga[3]) * bfhi(a1));
                    if (n == 0) { w.x = lo; w.y = hi; } else { w.z = lo; w.w = hi; }
                }
                *(u32x4*)(U + row * DM + col0) = w;
            }
    }
};
}

__device__ __forceinline__ f32x4 sg_tile(const bf16_t* A, int lda, const bf16_t* Bt, int K, int n0, int lane) {
    const bf16_t* ap = A + (size_t)(lane & 15) * lda + 8 * (lane >> 4);
    const bf16_t* bp = Bt + (size_t)(n0 + (lane & 15)) * K + 8 * (lane >> 4);
    f32x4 acc = {0.f, 0.f, 0.f, 0.f};
#pragma unroll 8
    for (int k = 0; k < K; k += 32) {
        const bf16x8 a = *(const bf16x8*)(ap + k), b = *(const bf16x8*)(bp + k);
        acc = __builtin_amdgcn_mfma_f32_16x16x32_bf16(a, b, acc, 0, 0, 0);
    }
    return acc;
}

__device__ __forceinline__ f32x4 sg_tile_blk(const bf16_t* A, int lda, const bf16_t* Bt, int K, int n0, int lane, int wid, LAS float* red) {
    const int K8 = K >> 3;
    const bf16_t* ap = A + (size_t)(lane & 15) * lda + 8 * (lane >> 4) + wid * K8;
    const bf16_t* bp = Bt + (size_t)(n0 + (lane & 15)) * K + 8 * (lane >> 4) + wid * K8;
    f32x4 acc = {0.f, 0.f, 0.f, 0.f};
#pragma unroll 1
    for (int k = 0; k < K8; k += 128) {
        bf16x8 av[4], bv[4];
#pragma unroll
        for (int j = 0; j < 4; ++j) { const int kk = k + 32 * j < K8 ? k + 32 * j : k; av[j] = *(const bf16x8*)(ap + kk); bv[j] = *(const bf16x8*)(bp + kk); }
        asm volatile("" : "+v"(av[0]), "+v"(av[1]), "+v"(av[2]), "+v"(av[3]), "+v"(bv[0]), "+v"(bv[1]), "+v"(bv[2]), "+v"(bv[3]));
#pragma unroll
        for (int j = 0; j < 4; ++j) if (k + 32 * j < K8) acc = __builtin_amdgcn_mfma_f32_16x16x32_bf16(av[j], bv[j], acc, 0, 0, 0);
    }
    *(LAS f32x4*)(red + wid * 256 + lane * 4) = acc;
    __syncthreads();
    f32x4 sum = {0.f, 0.f, 0.f, 0.f};
    if (wid == 0) {
#pragma unroll
        for (int w = 0; w < 8; ++w) sum = sum + *(const LAS f32x4*)(red + w * 256 + lane * 4);
    }
    __syncthreads();
    return sum;
}

__device__ __forceinline__ void tr_rows(const float* Wsrc, int ldw, int K, bf16_t* dst, int kb0, int nkb, int nv4, const float* g, const float* bb, float* cs, float* bw, LAS float* scr, int lane, const float* addb = nullptr) {
    float csp[4] = {0.f, 0.f, 0.f, 0.f}, bwp[4] = {0.f, 0.f, 0.f, 0.f};
    const int c = lane & 7;
#pragma unroll 1
    for (int kb = kb0; kb < kb0 + nkb; ++kb) {
        const int k0 = 64 * kb;
        f32x4 vv[8];
        const bool okl = (lane & 7) < nv4; const int n4 = (lane & 7) * 4;
#pragma unroll
        for (int i = 0; i < 8; ++i) vv[i] = *(const f32x4*)(Wsrc + (size_t)(k0 + 8 * i + (lane >> 3)) * ldw + (okl ? n4 : 0));
        asm volatile("" : "+v"(vv[0]), "+v"(vv[1]), "+v"(vv[2]), "+v"(vv[3]), "+v"(vv[4]), "+v"(vv[5]), "+v"(vv[6]), "+v"(vv[7]));
#pragma unroll
        for (int i = 0; i < 8; ++i) { const int kk = 8 * i + (lane >> 3); f32x4 v = vv[i]; if (!okl) v = (f32x4){0.f, 0.f, 0.f, 0.f};
            scr[kk * 33 + n4] = v[0]; scr[kk * 33 + n4 + 1] = v[1]; scr[kk * 33 + n4 + 2] = v[2]; scr[kk * 33 + n4 + 3] = v[3]; }
        f32x4 g0 = {1.f, 1.f, 1.f, 1.f}, g1 = g0, b0 = {0.f, 0.f, 0.f, 0.f}, b1 = b0;
        if (g) { g0 = *(const f32x4*)(g + k0 + 8 * c); g1 = *(const f32x4*)(g + k0 + 8 * c + 4); b0 = *(const f32x4*)(bb + k0 + 8 * c); b1 = *(const f32x4*)(bb + k0 + 8 * c + 4); }
        asm volatile("s_waitcnt lgkmcnt(0)" ::: "memory");
#pragma unroll
        for (int j = 0; j < 4; ++j) {
            const int n = (lane >> 3) + 8 * j; const LAS float* sp = scr + (8 * c) * 33 + n;
            const float x0 = sp[0 * 33], x1 = sp[1 * 33], x2 = sp[2 * 33], x3 = sp[3 * 33], x4 = sp[4 * 33], x5 = sp[5 * 33], x6 = sp[6 * 33], x7 = sp[7 * 33];
            u32x4 o; o.x = pk2(x0 * g0[0], x1 * g0[1]); o.y = pk2(x2 * g0[2], x3 * g0[3]); o.z = pk2(x4 * g1[0], x5 * g1[1]); o.w = pk2(x6 * g1[2], x7 * g1[3]);
            *(u32x4*)(dst + (size_t)n * K + k0 + 8 * c) = o;
            csp[j] += ((bflo(o.x) + bfhi(o.x)) + (bflo(o.y) + bfhi(o.y))) + ((bflo(o.z) + bfhi(o.z)) + (bflo(o.w) + bfhi(o.w)));
            bwp[j] += ((x0 * b0[0] + x1 * b0[1]) + (x2 * b0[2] + x3 * b0[3])) + ((x4 * b1[0] + x5 * b1[1]) + (x6 * b1[2] + x7 * b1[3]));
        }
        asm volatile("s_waitcnt lgkmcnt(0)" ::: "memory");
    }
    if (g) {
#pragma unroll
        for (int j = 0; j < 4; ++j) {
            float a = csp[j], b = bwp[j];
            a += __shfl_xor(a, 1); a += __shfl_xor(a, 2); a += __shfl_xor(a, 4); b += __shfl_xor(b, 1); b += __shfl_xor(b, 2); b += __shfl_xor(b, 4);
            if (c == 0) { cs[(lane >> 3) + 8 * j] = a; bw[(lane >> 3) + 8 * j] = b + (addb ? addb[(lane >> 3) + 8 * j] : 0.f); }
        }
    }
}
constexpr int CW_ITEMS = 824;
__device__ __forceinline__ void conv_weight_item(const Params& P, int layer, int it, LAS float* scr, int lane) {
    bf16_t* W = (bf16_t*)(P.ws + WS_W) + (size_t)layer * OW_LAYER;
    float* CS = (float*)(P.ws + WS_CSBW) + (size_t)layer * 2 * OC_N; float* BW = CS + OC_N;
    const float* wg1 = P.in[2] + (size_t)layer * DM * FF; const float* wu1 = P.in[3] + (size_t)layer * DM * FF; const float* wd1 = P.in[4] + (size_t)layer * FF * DM;
    const float* win = P.in[7] + (size_t)layer * DM * DPROJ;
    const float* wbm = P.in[17] + (size_t)layer * 512 * DM; const float* wba = P.in[18] + (size_t)layer * 512 * DM; const float* wout = P.in[20] + (size_t)layer * DM * DM;
    const float* wg2 = P.in[23] + (size_t)layer * DM * FF; const float* wu2 = P.in[24] + (size_t)layer * DM * FF; const float* wd2 = P.in[25] + (size_t)layer * FF * DM;
    const float* ln1g = P.in[5] + (size_t)layer * DM; const float* ln1b = P.in[6] + (size_t)layer * DM;
    const float* ln2g = P.in[21] + (size_t)layer * DM; const float* ln2b = P.in[22] + (size_t)layer * DM;
    const float* ln3g = layer ? P.in[26] + (size_t)(layer - 1) * DM : nullptr; const float* ln3b = layer ? P.in[27] + (size_t)(layer - 1) * DM : nullptr;
    int r = it;
    if (r < 352) {
        const int second = r >= 176; if (second) r -= 176;
        const int R0 = 32 * r, pn = R0 >> 8, sgu = (R0 >> 7) & 1, i = R0 & 127;
        const float* src = (second ? (sgu ? wu2 : wg2) : (sgu ? wu1 : wg1)) + 128 * pn + i;
        const int oc = second ? OC_GU2 : OC_GU1;
        tr_rows(src, FF, DM, W + (second ? OW_GU2 : OW_GU1) + (size_t)R0 * DM, 0, 16, 8, second ? ln2g : ln3g, second ? ln2b : ln3b, CS + oc + R0, BW + oc + R0, scr, lane); return;
    }
    r -= 352;
    if (r < 192) {
        const int second = r >= 96; if (second) r -= 96;
        const int nb = r / 3, seg = r % 3, R0 = 32 * nb;
        tr_rows((second ? wd2 : wd1) + R0, DM, FF, W + (second ? OW_D2 : OW_D1) + (size_t)R0 * FF, 16 * seg, seg == 2 ? 12 : 16, 8, nullptr, nullptr, nullptr, nullptr, scr, lane); return;
    }
    r -= 192;
    if (r < 120) {
        const int R0 = 32 * r, csrc = R0 < 2048 ? R0 : (R0 < 3584 ? R0 + 8 : 2048);
        tr_rows(win + csrc, DPROJ, DM, W + OW_PB + (size_t)R0 * DM, 0, 16, R0 < 3584 ? 8 : (R0 == 3584 ? 2 : 0), ln1g, ln1b, CS + OC_PB + R0, BW + OC_PB + R0, scr, lane); return;
    }
    r -= 120;
    if (r < 64) {
        const int R0 = 32 * r, pn = R0 >> 8, sg = (R0 >> 7) & 1, i = R0 & 127, csrc = 3592 + 1024 * sg + 128 * pn + i;
        tr_rows(win + csrc, DPROJ, DM, W + OW_GM + (size_t)R0 * DM, 0, 16, 8, ln1g, ln1b, CS + OC_GM + R0, BW + OC_GM + R0, scr, lane, P.in[19] + (size_t)layer * 2048 + 1024 * sg + 128 * pn + i); return;
    }
    r -= 64;
    if (r < 64) {
        const int second = r >= 32; if (second) r -= 32;
        const int R0 = 32 * r;
        tr_rows((second ? wba : wbm) + R0, DM, 512, W + (second ? OW_BA : OW_BM) + (size_t)R0 * 512, 0, 8, 8, nullptr, nullptr, nullptr, nullptr, scr, lane); return;
    }
    r -= 64;
    { const int R0 = 32 * r; tr_rows(wout + R0, DM, DM, W + OW_OUT + (size_t)R0 * DM, 0, 16, 8, nullptr, nullptr, nullptr, nullptr, scr, lane); }
}

__device__ __forceinline__ void ln_row(const f32x4 (&vin)[4], int row, float* hf, const f32x4 (&gv)[4], const f32x4 (&bv)[4], bool gates, bool fin, const float* bif_l, LAS float* gwl, bf16_t* HB, float* ST, float* GT, int lane) {
    f32x4 v[4]; float s = 0.f;
#pragma unroll
    for (int j = 0; j < 4; ++j) { v[j] = vin[j]; s += (v[j][0] + v[j][1]) + (v[j][2] + v[j][3]); }
    const float mean = wave_sum(s) * (1.f / DM); float s2 = 0.f;
#pragma unroll
    for (int j = 0; j < 4; ++j) { v[j] = v[j] - mean; s2 += (v[j][0] * v[j][0] + v[j][1] * v[j][1]) + (v[j][2] * v[j][2] + v[j][3] * v[j][3]); }
    const float rstd = 1.f / sqrtf(wave_sum(s2) * (1.f / DM) + LN_EPS);
    if (lane == 0) { f32x2_t st = {mean, rstd}; *(f32x2_t*)(ST + (size_t)row * 2) = st; }
#pragma unroll
    for (int j = 0; j < 4; ++j) {
        v[j] = v[j] * rstd * gv[j] + bv[j];
        if (fin) *(f32x4*)(hf + 256 * j + 4 * lane) = v[j];
        if (!fin) { u32x2 w; w.x = pk2(v[j][0], v[j][1]); w.y = pk2(v[j][2], v[j][3]); *(u32x2*)(HB + (size_t)row * DM + 256 * j + 4 * lane) = w; }
    }
    if (gates) {
        float mine = 0.f;
#pragma unroll
        for (int g = 0; g < 8; ++g) {
            float d = 0.f;
#pragma unroll
            for (int j = 0; j < 4; ++j) { const f32x4 w4 = *(const LAS f32x4*)(gwl + g * 1024 + 256 * j + 4 * lane); d += (v[j][0] * w4[0] + v[j][1] * w4[1]) + (v[j][2] * w4[2] + v[j][3] * w4[3]); }
            d = wave_sum(d);
            if (lane == g) mine = d;
        }
        if (lane < 8) {
            const float z = mine + bif_l[lane];
            float o = z;
            if (lane >= 4) o = fminf(z, 0.f) - __logf(1.f + __expf(-fabsf(z)));
            GT[(size_t)row * 8 + lane] = o;
        }
    }
}
__device__ __forceinline__ void ln_phase(const Params& P, const float* gam, const float* bet, bool gates, bool fin, const float* win_l, const float* bif_l, LAS unsigned char* lds) {
    const int tid = tidx(), lane = tid & 63, wid = tid >> 6;
    float* hfm = (float*)(P.ws + WS_HFM); bf16_t* HB = (bf16_t*)(P.ws + WS_HB); float* GT = (float*)(P.ws + WS_GATES); float* ST = (float*)(P.ws + WS_STATS);
    LAS float* gwl = (LAS float*)lds;
    if (gates) {
        for (int idx = tid; idx < 8192; idx += 512) { const int k = idx >> 3, g = idx & 7; gwl[g * 1024 + k] = win_l[(size_t)k * DPROJ + 2048 + g]; }
        __syncthreads();
    }
    const int gw = bidx() * 8 + wid, NGW = gridDim.x * 8;
    f32x4 gv[4], bv[4];
#pragma unroll
    for (int j = 0; j < 4; ++j) { gv[j] = *(const f32x4*)(gam + 256 * j + 4 * lane); bv[j] = *(const f32x4*)(bet + 256 * j + 4 * lane); }
    constexpr int NR = MREAL;
    int row = 4 * gw;
    u32x2 ah[4][4], al[4][4];
#define LN_ROWP(r_) (P.out + (size_t)(r_) * DM)
    const bf16_t* LOp = (const bf16_t*)(P.ws + WS_LO);
#define LN_LOADRAW(h_, l_, r_, j_) do { h_ = *(const u32x2*)(HB + (size_t)(r_) * DM + 256 * (j_) + 4 * lane); l_ = *(const u32x2*)(LOp + (size_t)(r_) * DM + 256 * (j_) + 4 * lane); } while (0)
#define LN_COMB(dst_, hi_, lo_) dst_ = (f32x4){bflo(hi_.x) + bflo(lo_.x), bfhi(hi_.x) + bfhi(lo_.x), bflo(hi_.y) + bflo(lo_.y), bfhi(hi_.y) + bfhi(lo_.y)}
    if (row < NR) {
#pragma unroll
        for (int q4 = 0; q4 < 4; ++q4) {
#pragma unroll
            for (int j = 0; j < 4; ++j) LN_LOADRAW(ah[q4][j], al[q4][j], row + q4, j); }
    }
    while (row < NR) {
        f32x4 ca[4][4];
#pragma unroll
        for (int q4 = 0; q4 < 4; ++q4)
#pragma unroll
            for (int j = 0; j < 4; ++j) LN_COMB(ca[q4][j], ah[q4][j], al[q4][j]);
        const int nrow = row + 4 * NGW;
        if (nrow < NR) {
#pragma unroll
            for (int q4 = 0; q4 < 4; ++q4) {
#pragma unroll
                for (int j = 0; j < 4; ++j) LN_LOADRAW(ah[q4][j], al[q4][j], nrow + q4, j); }
        }
#pragma unroll
        for (int q4 = 0; q4 < 4; ++q4) ln_row(ca[q4], row + q4, LN_ROWP(row + q4), gv, bv, gates, fin, bif_l, gwl, HB, ST, GT, lane);
        row = nrow;
    }
#undef LN_ROWP
#undef LN_LOADRAW
#undef LN_COMB
}

__device__ __forceinline__ void conv8(const bf16_t* PB, const float* cw, const float* cb, int b, int pos, int chn, f32x4& o0, f32x4& o1) {
    o0 = *(const f32x4*)(cb + chn); o1 = *(const f32x4*)(cb + chn + 4);
#pragma unroll
    for (int j = 0; j < 4; ++j) {
        const int pp = pos - 3 + j;
        if (pp >= 0) {
            const u32x4 u = *(const u32x4*)(PB + seqrow(b, pp) * NPB + chn);
            const f32x4 w0 = *(const f32x4*)(cw + j * 1024 + chn), w1 = *(const f32x4*)(cw + j * 1024 + chn + 4);
            o0[0] += w0[0] * bflo(u.x); o0[1] += w0[1] * bfhi(u.x); o0[2] += w0[2] * bflo(u.y); o0[3] += w0[3] * bfhi(u.y);
            o1[0] += w1[0] * bflo(u.z); o1[1] += w1[1] * bfhi(u.z); o1[2] += w1[2] * bflo(u.w); o1[3] += w1[3] * bfhi(u.w);
        }
    }
#pragma unroll
    for (int e = 0; e < 4; ++e) { o0[e] = siluf(o0[e]); o1[e] = siluf(o1[e]); }
}
struct ConvW { f32x4 w[4][2]; f32x4 b[2]; };
__device__ __forceinline__ void convw_load(ConvW& cw8, const float* cw, const float* cb, int chn) {
    cw8.b[0] = *(const f32x4*)(cb + chn); cw8.b[1] = *(const f32x4*)(cb + chn + 4);
#pragma unroll
    for (int j = 0; j < 4; ++j) { cw8.w[j][0] = *(const f32x4*)(cw + j * 1024 + chn); cw8.w[j][1] = *(const f32x4*)(cw + j * 1024 + chn + 4); }
}
__device__ __forceinline__ void conv8w(const bf16_t* PB, const ConvW& cw8, int b, int pos, int chn, f32x4& o0, f32x4& o1) {
    o0 = cw8.b[0]; o1 = cw8.b[1];
    u32x4 u4[4];
#pragma unroll
    for (int j = 0; j < 4; ++j) {
        const int pp = pos - 3 + j;
        u4[j] = *(const u32x4*)(PB + seqrow(b, pp < 0 ? 0 : pp) * NPB + chn);
    }
#pragma unroll
    for (int j = 0; j < 4; ++j) {
        const bool ok = pos - 3 + j >= 0;
        const u32x4 u = {ok ? u4[j].x : 0u, ok ? u4[j].y : 0u, ok ? u4[j].z : 0u, ok ? u4[j].w : 0u};
        const f32x4 w0 = cw8.w[j][0], w1 = cw8.w[j][1];
        o0[0] += w0[0] * bflo(u.x); o0[1] += w0[1] * bfhi(u.x); o0[2] += w0[2] * bflo(u.y); o0[3] += w0[3] * bfhi(u.y);
        o1[0] += w1[0] * bflo(u.z); o1[1] += w1[1] * bfhi(u.z); o1[2] += w1[2] * bflo(u.w); o1[3] += w1[3] * bfhi(u.w);
    }
#pragma unroll
    for (int e = 0; e < 4; ++e) { o0[e] = siluf(o0[e]); o1[e] = siluf(o1[e]); }
}

__device__ __forceinline__ float wscan_add(float v, int lane) {
#pragma unroll
    for (int o = 1; o < 64; o <<= 1) { const float t = __shfl_up(v, o); if (lane >= o) v += t; }
    return v;
}
__device__ __forceinline__ float wscan_max(float v, int lane) {
#pragma unroll
    for (int o = 1; o < 64; o <<= 1) { const float t = __shfl_up(v, o); if (lane >= o) v = fmaxf(v, t); }
    return v;
}

__device__ __forceinline__ void lds_barrier() { asm volatile("s_waitcnt lgkmcnt(0)\n\ts_barrier" ::: "memory"); }

constexpr int TSTR = 320;
constexpr int RSTR = 272;
__device__ __forceinline__ void m1_unit(const Params& P, int layer, int bh, int c, LAS unsigned char* lds) {
    const int tid = tidx(), lane = tid & 63, wid = __builtin_amdgcn_readfirstlane(tid >> 6);
    const int b = bh >> 2, hh = bh & 3;
    const int nvalid = c == 0 ? NMETA : 128, p0 = c == 0 ? 0 : NMETA + 128 * (c - 1);
    const int nrep = c == 0 ? NB : 1;
    const bf16_t* PB = (const bf16_t*)(P.ws + WS_BIG); const float* GT = (const float*)(P.ws + WS_GATES);
    float* SC = (float*)(P.ws + WS_SC); float* NST = (float*)(P.ws + WS_NST); bf16_t* CST = (bf16_t*)(P.ws + WS_CST);
    const float* cw = P.in[8] + (size_t)layer * 4 * 1024; const float* cb = P.in[9] + (size_t)layer * 1024;
    LAS unsigned char* Kt = lds; LAS unsigned char* Vt = lds + 128 * TSTR; LAS float* sws = (LAS float*)(lds + 2 * 128 * TSTR);
    float li0 = NEGF, li1 = NEGF, lf0 = 0.f, lf1 = 0.f;
    if (wid == 0) {
        const int i0 = 2 * lane, i1 = i0 + 1;
        const size_t rw0 = seqrow(b, p0 + (i0 < nvalid ? i0 : 0)), rw1 = seqrow(b, p0 + (i1 < nvalid ? i1 : 0));
        li0 = GT[rw0 * 8 + hh]; lf0 = GT[rw0 * 8 + 4 + hh]; li1 = GT[rw1 * 8 + hh]; lf1 = GT[rw1 * 8 + 4 + hh];
        if (i0 >= nvalid) { li0 = NEGF; lf0 = 0.f; } if (i1 >= nvalid) { li1 = NEGF; lf1 = 0.f; }
    }
    ConvW ckw; convw_load(ckw, cw, cb, 512 + hh * 128 + 8 * (tid & 15));
    f32x4 kc0[4], kc1[4]; u32x4 vraw[4];
#pragma unroll
    for (int it = 0; it < 4; ++it) {
        const int item = tid + 512 * it, i = item >> 4, ch = item & 15;
        const int ic = i < nvalid ? i : nvalid - 1;
        conv8w(PB, ckw, b, p0 + ic, 512 + hh * 128 + 8 * ch, kc0[it], kc1[it]);
        vraw[it] = *(const u32x4*)(PB + seqrow(b, p0 + ic) * NPB + 1024 + hh * 128 + 8 * ch);
    }
    if (wid == 0) {
        const int i0 = 2 * lane, i1 = i0 + 1;
        const float s = lf0 + lf1, incl = wscan_add(s, lane), excl = incl - s;
        const float b0 = excl + lf0, b1 = incl, g0 = li0 - b0, g1 = li1 - b1;
        const float gmax = wave_max(fmaxf(g0, g1));
        sws[i0] = i0 < nvalid ? ex2((g0 - gmax) * LOG2E) : 0.f;
        sws[i1] = i1 < nvalid ? ex2((g1 - gmax) * LOG2E) : 0.f;
        const float bend = __shfl(incl, 63);
        if (lane == 0) { for (int bb = 0; bb < nrep; ++bb) { SC[(size_t)((bh + 4 * bb) * NCH + c) * 2] = bend; SC[(size_t)((bh + 4 * bb) * NCH + c) * 2 + 1] = bend + gmax; } }
    }
    __syncthreads();
#pragma unroll
    for (int it = 0; it < 4; ++it) {
        const int item = tid + 512 * it, i = item >> 4, ch = item & 15;
        const float sc = 0.08838834764831845f * sws[i];
        u32x4 kw = pack8(kc0[it] * sc, kc1[it] * sc), vw = vraw[it];
        if (i >= nvalid) { kw = (u32x4){0u, 0u, 0u, 0u}; vw = kw; }
        *(LAS u32x4*)(Kt + i * TSTR + ch * 16) = kw; *(LAS u32x4*)(Vt + i * TSTR + ch * 16) = vw;
    }
    __syncthreads();
    {
        const int h = lane >> 5, g = lane >> 4, q = (lane & 15) >> 2, pp = lane & 3;
        const int dkt = wid >> 1, dvt0 = (wid & 1) * 2;
        f32x16 acc[2];
#pragma unroll
        for (int t = 0; t < 2; ++t)
#pragma unroll
            for (int e = 0; e < 16; ++e) acc[t][e] = 0.f;
#pragma unroll
        for (int ks = 0; ks < 8; ++ks) {
            const int rowa = 16 * ks + 8 * h + q;
            const LAS unsigned char* ka = Kt + rowa * TSTR + (32 * dkt + 16 * (g & 1) + 4 * pp) * 2;
            const bf16x8 af = cat8(vtr(ka), vtr(ka + 4 * TSTR));
#pragma unroll
            for (int t = 0; t < 2; ++t) {
                const LAS unsigned char* va = Vt + rowa * TSTR + (32 * (dvt0 + t) + 16 * (g & 1) + 4 * pp) * 2;
                const bf16x8 bf = cat8(vtr(va), vtr(va + 4 * TSTR));
                acc[t] = mfma32(af, bf, acc[t]);
            }
        }
#pragma unroll
        for (int t = 0; t < 2; ++t) {
            const int dv = 32 * (dvt0 + t) + (lane & 31);
#pragma unroll
            for (int r4 = 0; r4 < 4; ++r4) {
                const int dk0 = 32 * dkt + 8 * r4 + 4 * h;
                u32x2 w; w.x = pk2(acc[t][4 * r4], acc[t][4 * r4 + 1]); w.y = pk2(acc[t][4 * r4 + 2], acc[t][4 * r4 + 3]);
                for (int bb = 0; bb < nrep; ++bb) *(u32x2*)(CST + (size_t)((bh + 4 * bb) * NCH + c) * 16384 + (size_t)dv * 128 + dk0) = w;
            }
        }
    }
    {
        LAS float* red = sws + 256;
        const int dk = tid & 127, part = tid >> 7;
        float sacc = 0.f;
#pragma unroll 8
        for (int i = 0; i < 32; ++i) sacc += __builtin_bit_cast(float, (unsigned)(*(const LAS unsigned short*)(Kt + (32 * part + i) * TSTR + dk * 2)) << 16);
        red[part * 128 + dk] = sacc;
        __syncthreads();
        if (tid < 128) { const float nsum = (red[tid] + red[128 + tid]) + (red[256 + tid] + red[384 + tid]); for (int bb = 0; bb < nrep; ++bb) NST[(size_t)((bh + 4 * bb) * NCH + c) * 128 + tid] = nsum; }
    }
    lds_barrier();
}

__device__ __forceinline__ void m2_phase(const Params& P) {
    float* SC = (float*)(P.ws + WS_SC); float* MST = SC + 32 * NCH * 2; float* NST = (float*)(P.ws + WS_NST); bf16_t* CST = (bf16_t*)(P.ws + WS_CST);
    const int NT = gridDim.x * 512;
    for (int task = bidx() * 512 + tidx(); task < 65536 + 4096; task += NT) {
        if (task < 65536) {
            const int bh = task >> 11, e8 = task & 2047;
            bf16_t* ptr = CST + (size_t)bh * NCH * 16384 + (size_t)e8 * 8;
            float run[8];
#pragma unroll
            for (int e = 0; e < 8; ++e) run[e] = 0.f;
            float m = NEGF;
#pragma unroll 1
            for (int c0 = 0; c0 < NCH; c0 += 5) {
                u32x4 loc[5]; float bendv[5], mlocv[5];
#pragma unroll
                for (int j = 0; j < 5; ++j) { loc[j] = *(const u32x4*)(ptr + (size_t)(c0 + j) * 16384); bendv[j] = SC[(size_t)(bh * NCH + c0 + j) * 2]; mlocv[j] = SC[(size_t)(bh * NCH + c0 + j) * 2 + 1]; }
#pragma unroll
                for (int j = 0; j < 5; ++j) {
                    const int c = c0 + j;
                    const float bend = bendv[j], mloc = mlocv[j];
                    const float mn = fmaxf(bend + m, mloc), a = ex2((bend + m - mn) * LOG2E), bt = ex2((mloc - mn) * LOG2E);
                    u32x4 w; w.x = pk2(run[0], run[1]); w.y = pk2(run[2], run[3]); w.z = pk2(run[4], run[5]); w.w = pk2(run[6], run[7]);
                    *(u32x4*)(ptr + (size_t)c * 16384) = w;
                    run[0] = a * run[0] + bt * bflo(loc[j].x); run[1] = a * run[1] + bt * bfhi(loc[j].x);
                    run[2] = a * run[2] + bt * bflo(loc[j].y); run[3] = a * run[3] + bt * bfhi(loc[j].y);
                    run[4] = a * run[4] + bt * bflo(loc[j].z); run[5] = a * run[5] + bt * bfhi(loc[j].z);
                    run[6] = a * run[6] + bt * bflo(loc[j].w); run[7] = a * run[7] + bt * bfhi(loc[j].w);
                    if (e8 == 0) MST[bh * NCH + c] = m;
                    m = mn;
                }
            }
        } else {
            const int t2 = task - 65536, bh = t2 >> 7, dk = t2 & 127;
            float* ptr = NST + (size_t)bh * NCH * 128 + dk;
            float run = 0.f, m = NEGF;
#pragma unroll 1
            for (int c0 = 0; c0 < NCH; c0 += 13) {
                float locv[13], bendv[13], mlocv[13];
#pragma unroll
                for (int j = 0; j < 13; ++j) { locv[j] = ptr[(size_t)(c0 + j) * 128]; bendv[j] = SC[(size_t)(bh * NCH + c0 + j) * 2]; mlocv[j] = SC[(size_t)(bh * NCH + c0 + j) * 2 + 1]; }
#pragma unroll
                for (int j = 0; j < 13; ++j) {
                    const float mn = fmaxf(bendv[j] + m, mlocv[j]), a = ex2((bendv[j] + m - mn) * LOG2E), bt = ex2((mlocv[j] - mn) * LOG2E);
                    ptr[(size_t)(c0 + j) * 128] = run; run = a * run + bt * locv[j]; m = mn;
                }
            }
        }
    }
}

__device__ __forceinline__ void m3_unit(const Params& P, int layer, int bh, int c, LAS unsigned char* lds) {
    const int tid = tidx(), lane = tid & 63, wid = __builtin_amdgcn_readfirstlane(tid >> 6);
    const int b = bh >> 2, hh = bh & 3;
    const int nvalid = c == 0 ? NMETA : 128, p0 = c == 0 ? 0 : NMETA + 128 * (c - 1);
    const bf16_t* PB = (const bf16_t*)(P.ws + WS_BIG); const float* GT = (const float*)(P.ws + WS_GATES);
    const float* SC = (const float*)(P.ws + WS_SC); const float* MST = SC + 32 * NCH * 2; const float* NST = (const float*)(P.ws + WS_NST); const bf16_t* CST = (const bf16_t*)(P.ws + WS_CST);
    bf16_t* MA = (bf16_t*)(P.ws + WS_MA);
    const float* cw = P.in[8] + (size_t)layer * 4 * 1024; const float* cb = P.in[9] + (size_t)layer * 1024; const float* mng = P.in[11] + (size_t)layer * 512;
    LAS unsigned char* Qt = lds; LAS unsigned char* Kt = lds + 128 * RSTR; LAS unsigned char* Vt = lds + 2 * 128 * RSTR;
    LAS float* sg2 = (LAS float*)(lds + 2 * 128 * RSTR + 128 * TSTR); LAS float* sr2 = sg2 + 128; LAS float* sw = sg2 + 256; LAS float* semt = sg2 + 384; LAS float* sqn = sg2 + 512;
    LAS float* sst = sg2 + 640; LAS float* sst2 = sg2 + 896; LAS float* snp = sg2 + 1152;
    constexpr int CT_OFF = 116736;
    {
        const bf16_t* Cp = CST + (size_t)(bh * NCH + c) * 16384;
#pragma unroll
        for (int k = 0; k < 4; ++k) {
            const int S = (k * 8 + wid) * 64 + lane, row = S >> 4, cch = (S & 15) ^ (row & 15);
            __builtin_amdgcn_global_load_lds((const unsigned*)(Cp + (size_t)row * 128 + cch * 8), (LAS unsigned*)(lds + CT_OFF + (k * 8 + wid) * 1024), 16, 0, 0);
        }
    }
    const float npv = tid < 128 ? NST[(size_t)(bh * NCH + c) * 128 + tid] : 0.f;
    float li0 = NEGF, li1 = NEGF, lf0 = 0.f, lf1 = 0.f, mprev = 0.f;
    if (wid == 0) {
        const int i0 = 2 * lane, i1 = i0 + 1;
        const size_t rw0 = seqrow(b, p0 + (i0 < nvalid ? i0 : 0)), rw1 = seqrow(b, p0 + (i1 < nvalid ? i1 : 0));
        li0 = GT[rw0 * 8 + hh]; lf0 = GT[rw0 * 8 + 4 + hh]; li1 = GT[rw1 * 8 + hh]; lf1 = GT[rw1 * 8 + 4 + hh];
        if (i0 >= nvalid) { li0 = NEGF; lf0 = 0.f; } if (i1 >= nvalid) { li1 = NEGF; lf1 = 0.f; }
        mprev = MST[bh * NCH + c];
    }
    ConvW cqw, ckw; convw_load(cqw, cw, cb, hh * 128 + 8 * (tid & 15)); convw_load(ckw, cw, cb, 512 + hh * 128 + 8 * (tid & 15));
    if (wid == 0) {
        const int i0 = 2 * lane, i1 = i0 + 1;
        const float s = lf0 + lf1, incl = wscan_add(s, lane), excl = incl - s;
        const float b0 = excl + lf0, b1 = incl, g0 = li0 - b0, g1 = li1 - b1;
        const float inclm = wscan_max(fmaxf(g0, g1), lane);
        float exclm = __shfl_up(inclm, 1); if (lane == 0) exclm = NEGF;
        const float cm0 = fmaxf(exclm, g0), cm1 = inclm;
        const float M0 = fmaxf(mprev, cm0), M1 = fmaxf(mprev, cm1);
        sg2[i0] = g0 * LOG2E; sg2[i1] = g1 * LOG2E; sr2[i0] = -M0 * LOG2E; sr2[i1] = -M1 * LOG2E;
        sw[i0] = ex2((mprev - M0) * LOG2E); sw[i1] = ex2((mprev - M1) * LOG2E);
        semt[i0] = ex2(-(b0 + M0) * LOG2E); semt[i1] = ex2(-(b1 + M1) * LOG2E);
    }
#pragma unroll
    for (int it = 0; it < 4; ++it) {
        const int item = tid + 512 * it, i = item >> 4, ch = item & 15;
        u32x4 qw, kw, vw;
        {
            const int ic = i < nvalid ? i : nvalid - 1;
            f32x4 o0, o1;
            conv8w(PB, cqw, b, p0 + ic, hh * 128 + 8 * ch, o0, o1); qw = pack8(o0, o1);
            conv8w(PB, ckw, b, p0 + ic, 512 + hh * 128 + 8 * ch, o0, o1); kw = pack8(o0 * 0.08838834764831845f, o1 * 0.08838834764831845f);
            vw = *(const u32x4*)(PB + seqrow(b, p0 + ic) * NPB + 1024 + hh * 128 + 8 * ch);
            if (i >= nvalid) { qw = (u32x4){0u, 0u, 0u, 0u}; kw = qw; vw = qw; }
        }
        *(LAS u32x4*)(Qt + i * RSTR + ch * 16) = qw; *(LAS u32x4*)(Kt + i * RSTR + ch * 16) = kw; *(LAS u32x4*)(Vt + i * TSTR + ch * 16) = vw;
    }
    if (tid < 128) snp[tid] = npv;
    asm volatile("s_waitcnt vmcnt(0)" ::: "memory");
    __syncthreads();
    const int r = lane & 31, h = lane >> 5, g = lane >> 4, q = (lane & 15) >> 2, pp = lane & 3;
    const int qb = wid >> 1, dvh = wid & 1, t = 32 * qb + r;
    u32x2 mo_[2][4]; f32x4 gn_[2][4];
    {
        const size_t rowp = seqrow(b, p0 + (t < nvalid ? t : 0));
#pragma unroll
        for (int d = 0; d < 2; ++d)
#pragma unroll
            for (int r4 = 0; r4 < 4; ++r4) {
                const int col = hh * 128 + 32 * (2 * dvh + d) + 8 * r4 + 4 * h;
                mo_[d][r4] = *(const u32x2*)(PB + rowp * NPB + 1536 + col); gn_[d][r4] = *(const f32x4*)(mng + col);
            }
    }
    {
        const int i = tid >> 2, part = tid & 3;
        const LAS float* np = snp + 32 * part;
        float s = 0.f;
#pragma unroll
        for (int d8 = 0; d8 < 4; ++d8) {
            const u32x4 qv = *(const LAS u32x4*)(Qt + i * RSTR + (32 * part + 8 * d8) * 2);
            const f32x4 n0 = *(const LAS f32x4*)(np + 8 * d8), n1 = *(const LAS f32x4*)(np + 8 * d8 + 4);
            s += bflo(qv.x) * n0[0] + bfhi(qv.x) * n0[1] + bflo(qv.y) * n0[2] + bfhi(qv.y) * n0[3] + bflo(qv.z) * n1[0] + bfhi(qv.z) * n1[1] + bflo(qv.w) * n1[2] + bfhi(qv.w) * n1[3];
        }
        s += __shfl_xor(s, 1); s += __shfl_xor(s, 2);
        if (part == 0) sqn[i] = s;
    }
    bf16x8 qf[8];
#pragma unroll
    for (int ks = 0; ks < 8; ++ks) qf[ks] = *(const LAS bf16x8*)(Qt + t * RSTR + (16 * ks + 8 * h) * 2);
    f32x16 acc[2];
#pragma unroll
    for (int d = 0; d < 2; ++d)
#pragma unroll
        for (int e = 0; e < 16; ++e) acc[d][e] = 0.f;
    {
#pragma unroll
        for (int ks = 0; ks < 8; ++ks)
#pragma unroll
            for (int d = 0; d < 2; ++d) {
                const int dv = 32 * (2 * dvh + d) + r;
                const bf16x8 cf = *(const LAS bf16x8*)(lds + CT_OFF + (dv * 16 + ((2 * ks + h) ^ (dv & 15))) * 16);
                acc[d] = mfma32(cf, qf[ks], acc[d]);
            }
    }
    __syncthreads();
    const float wt = sw[t], r2 = sr2[t];
#pragma unroll
    for (int d = 0; d < 2; ++d) acc[d] = acc[d] * wt;
    float den = 0.f;
#pragma unroll 1
    for (int kb = 0; kb <= qb; ++kb) {
        f32x16 st;
#pragma unroll
        for (int e = 0; e < 16; ++e) st[e] = 0.f;
#pragma unroll
        for (int ks = 0; ks < 8; ++ks) { const bf16x8 kf = *(const LAS bf16x8*)(Kt + (32 * kb + r) * RSTR + (16 * ks + 8 * h) * 2); st = mfma32(kf, qf[ks], st); }
#pragma unroll
        for (int r4 = 0; r4 < 4; ++r4) {
            const int s0 = 32 * kb + 8 * r4 + 4 * h;
            const f32x4 gs = *(const LAS f32x4*)(sg2 + s0);
#pragma unroll
            for (int e = 0; e < 4; ++e) {
                float v = st[4 * r4 + e] * ex2(r2 + gs[e]);
                if (s0 + e > t) v = 0.f;
                den += v; st[4 * r4 + e] = v;
            }
        }
#pragma unroll
        for (int s2 = 0; s2 < 2; ++s2) {
            u32x4 pw; pw.x = pk2(st[8 * s2], st[8 * s2 + 1]); pw.y = pk2(st[8 * s2 + 2], st[8 * s2 + 3]); pw.z = pk2(st[8 * s2 + 4], st[8 * s2 + 5]); pw.w = pk2(st[8 * s2 + 6], st[8 * s2 + 7]);
            const bf16x8 pf = __builtin_bit_cast(bf16x8, pw);
#pragma unroll
            for (int d = 0; d < 2; ++d) {
                const LAS unsigned char* va = Vt + (32 * kb + 16 * s2 + 4 * h + q) * TSTR + (32 * (2 * dvh + d) + 16 * (g & 1) + 4 * pp) * 2;
                const bf16x8 vf = cat8(vtr(va), vtr(va + 8 * TSTR));
                acc[d] = mfma32(vf, pf, acc[d]);
            }
        }
    }
    den += __shfl_xor(den, 32);
    den += wt * sqn[t];
    const float inv = 1.f / fmaxf(fabsf(den), semt[t]);
    float s1 = 0.f;
#pragma unroll
    for (int d = 0; d < 2; ++d)
#pragma unroll
        for (int e = 0; e < 16; ++e) { acc[d][e] *= inv; s1 += acc[d][e]; }
    s1 += __shfl_xor(s1, 32);
    if (h == 0) sst[wid * 32 + r] = s1;
    __syncthreads();
    const float mean = (s1 + sst[(wid ^ 1) * 32 + r]) * (1.f / 128.f);
    float q2 = 0.f;
#pragma unroll
    for (int d = 0; d < 2; ++d)
#pragma unroll
        for (int e = 0; e < 16; ++e) { acc[d][e] -= mean; q2 += acc[d][e] * acc[d][e]; }
    q2 += __shfl_xor(q2, 32);
    if (h == 0) sst2[wid * 32 + r] = q2;
    __syncthreads();
    const float rstd = 1.f / sqrtf((q2 + sst2[(wid ^ 1) * 32 + r]) * (1.f / 128.f) + LN_EPS);
    if (t < nvalid) {
        const size_t row = seqrow(b, p0 + t);
#pragma unroll
        for (int d = 0; d < 2; ++d)
#pragma unroll
            for (int r4 = 0; r4 < 4; ++r4) {
                const int col = hh * 128 + 32 * (2 * dvh + d) + 8 * r4 + 4 * h;
                const u32x2 mo = mo_[d][r4];
                const f32x4 g4 = gn_[d][r4];
                const float o0 = acc[d][4 * r4] * rstd * g4[0] * sigm(bflo(mo.x)), o1 = acc[d][4 * r4 + 1] * rstd * g4[1] * sigm(bfhi(mo.x));
                const float o2 = acc[d][4 * r4 + 2] * rstd * g4[2] * sigm(bflo(mo.y)), o3 = acc[d][4 * r4 + 3] * rstd * g4[3] * sigm(bfhi(mo.y));
                u32x2 w; w.x = pk2(o0, o1); w.y = pk2(o2, o3);
                *(u32x2*)(MA + row * 512 + col) = w;
            }
    }
    lds_barrier();
}

constexpr int AT_KB = 64 * RSTR, AT_VB = 64 * TSTR, AT_BUF = AT_KB + AT_VB;
__device__ __forceinline__ void attn_unit(const Params& P, int layer, int b, int hd, int pq0, int nvalid, float lam, float lam_init, LAS unsigned char* lds) {
    const int tid = tidx(), lane = tid & 63, wid = __builtin_amdgcn_readfirstlane(tid >> 6);
    const int c = wid >> 2, wq = wid & 3, r = lane & 31, h = lane >> 5, g = lane >> 4, q = (lane & 15) >> 2, pp = lane & 3;
    const bf16_t* PB = (const bf16_t*)(P.ws + WS_BIG); bf16_t* AO = (bf16_t*)(P.ws + WS_MA) + (size_t)MPAD * 512;
    const float* ang = P.in[16] + (size_t)layer * 512;
    const int qi = 32 * wq + r, qp = pq0 + qi;
    bf16x8 qf[4];
    {
        const size_t qrow = seqrow(b, qp < LSEQ ? qp : LSEQ - 1);
#pragma unroll
        for (int ks = 0; ks < 4; ++ks) qf[ks] = *(const bf16x8*)(PB + qrow * NPB + 2048 + hd * 128 + c * 64 + 16 * ks + 8 * h);
    }
    const float slope2 = ex2(-2.f * (float)(hd + 1)) * LOG2E;
    const int ntiles = (pq0 + nvalid - 1) / 64 + 1;
    u32x4 pk[2], pv[2];
#define AT_LOAD(kt) do { _Pragma("unroll") for (int i_ = 0; i_ < 2; ++i_) { const int row_ = (tid + 512 * i_) >> 4, ch_ = tid & 15; int kp_ = 64 * (kt) + row_; kp_ = kp_ < LSEQ ? kp_ : LSEQ - 1; \
        const bf16_t* src_ = PB + seqrow(b, kp_) * NPB + hd * 128 + ch_ * 8; pk[i_] = *(const u32x4*)(src_ + 2560); pv[i_] = *(const u32x4*)(src_ + 3072); } } while (0)
#define AT_STORE(s) do { _Pragma("unroll") for (int i_ = 0; i_ < 2; ++i_) { const int row_ = (tid + 512 * i_) >> 4, ch_ = tid & 15; \
        *(LAS u32x4*)(lds + (s) * AT_BUF + row_ * RSTR + ch_ * 16) = pk[i_]; *(LAS u32x4*)(lds + (s) * AT_BUF + AT_KB + row_ * TSTR + ch_ * 16) = pv[i_]; } } while (0)
    AT_LOAD(ntiles - 1);
    float qkb;
    {
        float ss = 0.f;
#pragma unroll
        for (int ks = 0; ks < 4; ++ks)
#pragma unroll
            for (int j = 0; j < 8; ++j) { const float v = __builtin_bit_cast(float, (unsigned)(unsigned short)qf[ks][j] << 16); ss += v * v; }
        ss += __shfl_xor(ss, 32);
        const float* KM = (const float*)(P.ws + WS_KM) + layer * 72;
        const float k2 = fmaxf(KM[b * 8 + hd * 2 + c], KM[64 + hd * 2 + c]);
        qkb = sqrtf(ss) * sqrtf(k2) * 1.001f + 0.01f;
    }
    LAS unsigned* votes = (LAS unsigned*)(lds + 131072 + 2048);
    if (tid < 16) votes[tid] = 0u;
    AT_STORE((ntiles - 1) & 1);
    __syncthreads();
    float m_run = NEGF, l_run = 0.f;
    f32x16 o[4];
#pragma unroll
    for (int d = 0; d < 4; ++d)
#pragma unroll
        for (int e = 0; e < 16; ++e) o[d][e] = 0.f;
#pragma unroll 1
    for (int kt = ntiles - 1; kt >= 0; --kt) {
        const int s = kt & 1;
        if (kt > 0) AT_LOAD(kt - 1);
        const LAS unsigned char* Kb = lds + s * AT_BUF; const LAS unsigned char* Vb = Kb + AT_KB;
        if (64 * kt <= pq0 + 32 * wq + 31) {
        f32x16 st[2];
#pragma unroll
        for (int kb2 = 0; kb2 < 2; ++kb2) {
            const float tb = slope2 * (float)(64 * kt + 32 * kb2 - pq0 + 4 * h);
#pragma unroll
            for (int e = 0; e < 16; ++e) st[kb2][e] = tb + slope2 * (float)((e & 3) + 8 * (e >> 2));
#pragma unroll
            for (int ks = 0; ks < 4; ++ks) { const bf16x8 kf = *(const LAS bf16x8*)(Kb + (32 * kb2 + r) * RSTR + (c * 64 + 16 * ks + 8 * h) * 2); st[kb2] = mfma32(kf, qf[ks], st[kb2]); }
        }
        if (64 * kt + 63 > pq0 + 32 * wq) {
#pragma unroll
            for (int kb2 = 0; kb2 < 2; ++kb2)
#pragma unroll
                for (int e = 0; e < 16; ++e) { const int kp = 64 * kt + 32 * kb2 + (e & 3) + 8 * (e >> 2) + 4 * h; if (kp > qp) st[kb2][e] = NEGF; }
        }
        float mx = st[0][0];
#pragma unroll
        for (int e = 1; e < 16; ++e) mx = fmaxf(mx, st[0][e]);
#pragma unroll
        for (int e = 0; e < 16; ++e) mx = fmaxf(mx, st[1][e]);
        mx = fmaxf(mx, __shfl_xor(mx, 32));
        if (__any(mx > m_run + 8.f)) {
            const float m_new = fmaxf(m_run, mx), alpha = ex2(m_run - m_new);
            m_run = m_new; l_run *= alpha;
#pragma unroll
            for (int d = 0; d < 4; ++d) o[d] = o[d] * alpha;
        }
        const float m_new = m_run;
        float psum = 0.f;
#pragma unroll
        for (int kb2 = 0; kb2 < 2; ++kb2)
#pragma unroll
            for (int e = 0; e < 16; ++e) { const float p = ex2(st[kb2][e] - m_new); st[kb2][e] = p; psum += p; }
        l_run += psum;
#pragma unroll
        for (int kb2 = 0; kb2 < 2; ++kb2)
#pragma unroll
            for (int s2 = 0; s2 < 2; ++s2) {
                u32x4 pw; pw.x = pk2(st[kb2][8 * s2], st[kb2][8 * s2 + 1]); pw.y = pk2(st[kb2][8 * s2 + 2], st[kb2][8 * s2 + 3]); pw.z = pk2(st[kb2][8 * s2 + 4], st[kb2][8 * s2 + 5]); pw.w = pk2(st[kb2][8 * s2 + 6], st[kb2][8 * s2 + 7]);
                const bf16x8 pf = __builtin_bit_cast(bf16x8, pw);
#pragma unroll
                for (int d = 0; d < 4; ++d) {
                    const LAS unsigned char* va = Vb + (32 * kb2 + 16 * s2 + 4 * h + q) * TSTR + (32 * d + 16 * (g & 1) + 4 * pp) * 2;
                    const bf16x8 vf = cat8(vtr(va), vtr(va + 8 * TSTR));
                    o[d] = mfma32(vf, pf, o[d]);
                }
            }
        }
        if (kt > 0) {
            const float bnd = qkb + slope2 * (float)(64 * (kt - 1) + 63 - pq0);
            const bool dn = !__any(bnd >= m_run - 44.f);
            if (lane == 0) votes[s * 8 + wid] = dn ? 1u : 0u;
            AT_STORE(s ^ 1);
        }
        __syncthreads();
        if (kt > 0) {
            const u32x4 v0 = *(const LAS u32x4*)(votes + s * 8), v1 = *(const LAS u32x4*)(votes + s * 8 + 4);
            const unsigned all = (unsigned)__builtin_amdgcn_readfirstlane((int)((v0.x & v0.y) & (v0.z & v0.w) & (v1.x & v1.y) & (v1.z & v1.w)));
            if (all) break;
        }
    }
#undef AT_LOAD
#undef AT_STORE
    const float l_tot = l_run + __shfl_xor(l_run, 32), inv = 1.f / l_tot;
    LAS float* xch = (LAS float*)lds;
    if (c == 1) {
#pragma unroll
        for (int d = 0; d < 4; ++d)
#pragma unroll
            for (int e = 0; e < 16; ++e) xch[((wq * 4 + d) * 16 + e) * 64 + lane] = o[d][e] * inv;
    }
    __syncthreads();
    if (c == 0) {
        float ss = 0.f;
#pragma unroll
        for (int d = 0; d < 4; ++d)
#pragma unroll
            for (int e = 0; e < 16; ++e) { const float v = o[d][e] * inv - lam * xch[((wq * 4 + d) * 16 + e) * 64 + lane]; o[d][e] = v; ss += v * v; }
        ss += __shfl_xor(ss, 32);
        const float rms = (1.f / sqrtf(ss * (1.f / 128.f) + LN_EPS)) * (1.f - lam_init);
        f32x4 ga_[4][4];
#pragma unroll
        for (int d = 0; d < 4; ++d)
#pragma unroll
            for (int r4 = 0; r4 < 4; ++r4) ga_[d][r4] = *(const f32x4*)(ang + hd * 128 + 32 * d + 8 * r4 + 4 * h);
        if (qi < nvalid) {
            const size_t row = seqrow(b, qp);
#pragma unroll
            for (int d = 0; d < 4; ++d)
#pragma unroll
                for (int r4 = 0; r4 < 4; ++r4) {
                    const int col = hd * 128 + 32 * d + 8 * r4 + 4 * h;
                    const f32x4 g4 = ga_[d][r4];
                    u32x2 w; w.x = pk2(o[d][4 * r4] * rms * g4[0], o[d][4 * r4 + 1] * rms * g4[1]); w.y = pk2(o[d][4 * r4 + 2] * rms * g4[2], o[d][4 * r4 + 3] * rms * g4[3]);
                    *(u32x2*)(AO + row * 512 + col) = w;
                }
        }
    }
    lds_barrier();
}

#define XB_TMO      128
#define XB_XCNT(j)  (256  + 64 * (j))
#define XB_XSUB(j)  (1280 + 64 * (j))
#define XB_XGEN(j)  (2304 + 64 * (j))
#define XB_TOP      3328
#define XB_TOPGEN   3392
#define XCD_BAR_WORDS 3456
#define XB_SPIN_CAP (1u << 18)

__device__ __forceinline__ unsigned xb_ld(unsigned* p)              { return __hip_atomic_load(p, __ATOMIC_RELAXED, __HIP_MEMORY_SCOPE_AGENT); }
__device__ __forceinline__ unsigned xb_add(unsigned* p, unsigned v) { return __hip_atomic_fetch_add(p, v, __ATOMIC_RELAXED, __HIP_MEMORY_SCOPE_AGENT); }
__device__ __forceinline__ unsigned xb_xcc_id() { return (unsigned)__builtin_amdgcn_s_getreg((3 << 11) | 20) & 0xFu; }
#define XB_SPIN(cond, bar) do { unsigned _sp = 0; while (cond) { __builtin_amdgcn_s_sleep(1); \
    if ((++_sp & 255u) == 0u) { if (xb_ld(&(bar)[XB_TMO])) break; if (_sp > XB_SPIN_CAP) { atomicAdd(&(bar)[XB_TMO], 1u); break; } } } } while (0)

struct XcdBarrier {
    unsigned* bar; unsigned x;
    volatile LAS unsigned* st;
};

__device__ __forceinline__ XcdBarrier xcd_barrier_post(unsigned* bar, volatile LAS unsigned* st) {
    XcdBarrier b; b.bar = bar; b.x = xb_xcc_id(); b.st = st;
    if (threadIdx.x == 0) (void)xb_add(&bar[XB_XCNT(b.x)], 1u);
    return b;
}
__device__ __forceinline__ void xcd_barrier_complete(unsigned* bar, unsigned x, unsigned& nloc, unsigned& nx) {
    const unsigned G = gridDim.x * gridDim.y * gridDim.z;
    unsigned sum, cnt, mine, sp = 0u;
    for (;;) {
        sum = 0u; cnt = 0u; mine = 0u;
#pragma unroll
        for (unsigned j = 0; j < 16; ++j) { const unsigned c = xb_ld(&bar[XB_XCNT(j)]); sum += c; cnt += (c > 0u) ? 1u : 0u; mine = (j == x) ? c : mine; }
        if (sum == G) break;
        __builtin_amdgcn_s_sleep(1);
        if ((++sp & 255u) == 0u) { if (xb_ld(&bar[XB_TMO])) break; if (sp > XB_SPIN_CAP) { atomicAdd(&bar[XB_TMO], 1u); break; } }
    }
    nloc = mine > 0u ? mine : 1u; nx = cnt > 0u ? cnt : 1u;
}

__device__ __forceinline__ void xcd_barrier(const XcdBarrier& b) {
    asm volatile("s_waitcnt vmcnt(0)" ::: "memory");
    __syncthreads();
    if (threadIdx.x == 0) {
        unsigned* bar = b.bar;
        __builtin_amdgcn_s_waitcnt(0);
        unsigned nloc = b.st[0], nx = b.st[1];
        if (nloc == 0u) { xcd_barrier_complete(bar, b.x, nloc, nx); b.st[0] = nloc; b.st[1] = nx; }
        const unsigned old = xb_add(&bar[XB_XSUB(b.x)], 1u);
        const unsigned gen = old / nloc;
        if (old + 1u == (gen + 1u) * nloc) {
            __builtin_amdgcn_fence(__ATOMIC_RELEASE, "agent");
            asm volatile("s_waitcnt vmcnt(0)" ::: "memory");
            const unsigned og = xb_add(&bar[XB_TOP], 1u);
            const unsigned tg = og / nx;
            if (og + 1u == (tg + 1u) * nx) xb_add(&bar[XB_TOPGEN], 1u);
            else XB_SPIN(xb_ld(&bar[XB_TOPGEN]) == tg, bar);
            __builtin_amdgcn_fence(__ATOMIC_ACQUIRE, "agent");
            xb_add(&bar[XB_XGEN(b.x)], 1u);
            asm volatile("s_waitcnt vmcnt(0)" ::: "memory");
        } else {
            XB_SPIN(xb_ld(&bar[XB_XGEN(b.x)]) == gen, bar);
            __builtin_amdgcn_fence(__ATOMIC_ACQUIRE, "agent");
            asm volatile("s_waitcnt vmcnt(0)" ::: "memory");
        }
    }
    __syncthreads();
}

#ifndef PROBE_ATT
#define PROBE_ATT 1
#endif
#ifndef PROBE_M3
#define PROBE_M3 1
#endif
constexpr int LDS_BYTES = 155648;
constexpr int LDS_BST = LDS_BYTES - 64;
#ifndef PROG_LAYER
#define PROG_LAYER(L) 16*L+0, 16*L+1, 16*L+3, 16*L+4, 16*L+5, 16*L+6, 16*L+7, 16*L+8, 16*L+9, 16*L+11, 16*L+12
#endif
__device__ const unsigned char PROG[] = { PROG_LAYER(0), PROG_LAYER(1), 16 * 1 + 13 };
constexpr int NSTEP = 14;
__global__ void __launch_bounds__(512) hybrid_fwd(Params P) {
    extern __shared__ __attribute__((aligned(16))) unsigned char smem[];
    LAS unsigned char* lds = (LAS unsigned char*)smem;
    cg::grid_group grid = cg::this_grid();
    unsigned* barw = (unsigned*)(P.ws + WS_BAR);
    volatile LAS unsigned* bst = (volatile LAS unsigned*)(lds + LDS_BST);
    if (blockIdx.x == 0) for (int i = threadIdx.x; i < XCD_BAR_WORDS; i += 512) __hip_atomic_store(barw + i, 0u, __ATOMIC_RELAXED, __HIP_MEMORY_SCOPE_AGENT);
    if (blockIdx.x == 0 && threadIdx.x < 144) __hip_atomic_store((unsigned*)(P.ws + WS_KM) + threadIdx.x, 0u, __ATOMIC_RELAXED, __HIP_MEMORY_SCOPE_AGENT);
    if (threadIdx.x < 2) bst[threadIdx.x] = 0u;
    __syncthreads();

#ifndef PROBE_P0
#define PROBE_P0 1
#endif
#pragma unroll 1
    for (int rep0_ = 0; rep0_ < PROBE_P0; ++rep0_)
    {
        const int lane = tidx() & 63, wid = tidx() >> 6, gw = bidx() * 8 + wid, NGW = gridDim.x * 8;
        bf16_t* HB = (bf16_t*)(P.ws + WS_HB); float* HFM = (float*)(P.ws + WS_HFM);
        LAS float* scr = (LAS float*)(lds + wid * 16384);
        for (int it = gw; it < 2 * CW_ITEMS; it += NGW) conv_weight_item(P, it / CW_ITEMS, it % CW_ITEMS, scr, lane);
        const float* x = P.in[0]; const float* meta = P.in[1];
        {
            const size_t NT8 = (size_t)gridDim.x * 512, n8 = (size_t)MREAL * DM / 8;
#pragma unroll 1
            for (size_t i = (size_t)bidx() * 512 + tidx(); i < n8; i += 4 * NT8) {
                f32x4 v0[4], v1[4];
#pragma unroll
                for (int j = 0; j < 4; ++j) { const size_t ii = i + j * NT8 < n8 ? i + j * NT8 : i; v0[j] = *(const f32x4*)(x + ii * 8); v1[j] = *(const f32x4*)(x + ii * 8 + 4); }
                asm volatile("" : "+v"(v0[0]), "+v"(v0[1]), "+v"(v0[2]), "+v"(v0[3]), "+v"(v1[0]), "+v"(v1[1]), "+v"(v1[2]), "+v"(v1[3]));
#pragma unroll
                for (int j = 0; j < 4; ++j) if (i + j * NT8 < n8) *(u32x4*)(HB + (i + j * NT8) * 8) = pack8(v0[j], v1[j]);
            }
        }
        for (int row = gw; row < NMETA; row += NGW) {
#pragma unroll
            for (int j = 0; j < 4; ++j) {
                const f32x4 v = *(const f32x4*)(meta + (size_t)row * DM + 256 * j + 4 * lane);
                *(f32x4*)(HFM + (size_t)row * DM + 256 * j + 4 * lane) = v;
                u32x2 w; w.x = pk2(v[0], v[1]); w.y = pk2(v[2], v[3]);
                *(u32x2*)(HB + (size_t)(MROW0 + row) * DM + 256 * j + 4 * lane) = w;
            }
        }
    }
    grid.sync();
    (void)xcd_barrier_post(barw, bst);

#pragma unroll 1
    for (int ph = 0; ph < (int)sizeof(PROG); ++ph) {
        const int layer = PROG[ph] >> 4, step = PROG[ph] & 15;
        const int G = gridDim.x;
#define TIDV const int tid_ = tidx(), lane = tid_ & 63, wid = __builtin_amdgcn_readfirstlane(tid_ >> 6); (void)lane; (void)wid;
        bf16_t* HB = (bf16_t*)(P.ws + WS_HB); float* HFM = (float*)(P.ws + WS_HFM);
        bf16_t* BIG = (bf16_t*)(P.ws + WS_BIG); bf16_t* MA = (bf16_t*)(P.ws + WS_MA);
        const bf16_t* Wl = (const bf16_t*)(P.ws + WS_W) + (size_t)layer * OW_LAYER;
#define LNCTX float* ROWS = (float*)(P.ws + WS_ROWS); const float* CSl = (const float*)(P.ws + WS_CSBW) + (size_t)layer * 2 * OC_N; const float* BWl = CSl + OC_N; \
        const int tlast = 3 * layer + (step <= 1 ? -1 : step <= 9 ? 0 : step <= 12 ? 1 : 2);   \
        const float* rows_last = ROWS + (size_t)((tlast & 1) * MPAD) * 2; (void)CSl; (void)BWl; (void)rows_last;
        if (step == 0 || step == 3 || step == 11) {
            LNCTX
            float* z = ROWS + (size_t)(((tlast + 1) & 1) * MPAD) * 2;
            for (int i = bidx() * 512 + tidx(); i < MPAD * 2 / 4; i += G * 512) *(f32x4*)(z + 4 * i) = (f32x4){0.f, 0.f, 0.f, 0.f};
        }
        if (step == 0 || step == 11) {
            LNCTX
            const bf16_t* Wgu = Wl + (step ? OW_GU2 : OW_GU1); const int oc = step ? OC_GU2 : OC_GU1;
            const pg8::LnFix fx{rows_last, CSl + oc, BWl + oc, tlast >= 0 ? 1 : 0};
            pg8::Gemm gm{HB, Wgu, MREAL, 2 * FF, DM}; pg8::StaticOrder S; S.init(MREAL, 2 * FF, G, bidx());
            pg8::EpiSwiglu E{BIG, FF, fx};
            pg8::gemm_phase<pg8::EpiSwiglu, pg8::StaticOrder, true, true>(lds, gm, S, E);
            for (int ct = bidx(); ct < FF / 16; ct += G) {
                TIDV
                const int c0 = 16 * ct, R0 = 256 * (c0 >> 7) + (c0 & 127);
                const f32x4 ag = sg_tile_blk(HB + (size_t)MROW0 * DM, DM, Wgu, DM, R0, lane, wid, (LAS float*)lds), au = sg_tile_blk(HB + (size_t)MROW0 * DM, DM, Wgu, DM, R0 + 128, lane, wid, (LAS float*)lds);
                if (wid == 0) {
                    const int rb = R0 + (lane & 15);
                    float mu4[4] = {0.f, 0.f, 0.f, 0.f}, r4v[4] = {1.f, 1.f, 1.f, 1.f}, csg = 0.f, bwg = 0.f, csu = 0.f, bwu = 0.f;
                    if (fx.on) { csg = fx.cs[rb]; bwg = fx.bw[rb]; csu = fx.cs[rb + 128]; bwu = fx.bw[rb + 128];
#pragma unroll
                        for (int e = 0; e < 4; ++e) fx.stats((size_t)(MROW0 + 4 * (lane >> 4) + e), mu4[e], r4v[e]); }
#pragma unroll
                    for (int e = 0; e < 4; ++e) {
                        const size_t row = (size_t)(MROW0 + 4 * (lane >> 4) + e);
                        const float gv = (ag[e] - csg * mu4[e]) * r4v[e] + bwg, uv = (au[e] - csu * mu4[e]) * r4v[e] + bwu;
                        BIG[row * FF + c0 + (lane & 15)] = (bf16_t)f2bf(siluf(gv) * uv);
                    }
                }
            }
        } else if (step == 1 || step == 9 || step == 12) {
            LNCTX
            const bf16_t* A = step == 9 ? MA : BIG; const bf16_t* Bt = Wl + (step == 1 ? OW_D1 : step == 9 ? OW_OUT : OW_D2);
            const int K = step == 9 ? DM : FF; const float sc = step == 9 ? 1.f : 0.5f;
            pg8::Gemm gm{A, Bt, MREAL, DM, K}; pg8::StaticOrder S; S.init(MREAL, DM, G, bidx());
            const int raw = tlast < 0 ? 1 : 0;
            const int gi = step == 1 ? (layer == 0 ? 5 : 26) : step == 9 ? 5 : 21;
            const int gl = step == 1 ? (layer == 0 ? 0 : layer - 1) : layer;
            const float* gam = P.in[gi] + (size_t)gl * DM; const float* bet = P.in[gi + 1] + (size_t)gl * DM;
            float* rows_cur = ROWS + (size_t)(((tlast + 1) & 1) * MPAD) * 2;
            pg8::EpiResid E{P.in[0], (bf16_t*)(P.ws + WS_LO), HB, rows_last, rows_cur, gam, bet, sc, raw};
            pg8::gemm_phase<pg8::EpiResid, pg8::StaticOrder, true, true>(lds, gm, S, E);
            for (int ct = bidx(); ct < 64; ct += G) {
                TIDV
                const f32x4 a = sg_tile_blk(A + (size_t)MROW0 * K, K, Bt, K, 16 * ct, lane, wid, (LAS float*)lds);
                const int col = 16 * ct + (lane & 15);
                if (wid == 0) {
                    float hv[4], s1v[4] = {0.f, 0.f, 0.f, 0.f}, s2v[4] = {1.f, 1.f, 1.f, 1.f}, gcol = 1.f, bcol = 0.f;
#pragma unroll
                    for (int e = 0; e < 4; ++e) { const int mr = 4 * (lane >> 4) + e; hv[e] = HFM[(size_t)mr * DM + col]; if (!raw) { s1v[e] = rows_last[(size_t)(MROW0 + mr) * 2]; s2v[e] = rows_last[(size_t)(MROW0 + mr) * 2 + 1]; } }
                    if (!raw) { gcol = gam[col]; bcol = bet[col]; }
#pragma unroll
                    for (int e = 0; e < 4; ++e) {
                        const int mr = 4 * (lane >> 4) + e; float* p = HFM + (size_t)mr * DM + col;
                        float h = hv[e];
                        if (!raw) { const float mu = s1v[e] * (1.f / DM), r = __builtin_amdgcn_rsqf(s2v[e] * (1.f / DM) - mu * mu + LN_EPS);
                            h = (h - mu) * r * gcol + bcol; }
                        const float y = ALPHA * h + sc * a[e];
                        *p = y; HB[(size_t)(MROW0 + mr) * DM + col] = (bf16_t)f2bf(y);
                        float q1 = y, q2 = y * y;
                        q1 += __shfl_xor(q1, 1); q1 += __shfl_xor(q1, 2); q1 += __shfl_xor(q1, 4); q1 += __shfl_xor(q1, 8);
                        q2 += __shfl_xor(q2, 1); q2 += __shfl_xor(q2, 2); q2 += __shfl_xor(q2, 4); q2 += __shfl_xor(q2, 8);
                        if ((lane & 15) == 0) { atomicAdd(rows_cur + (size_t)(MROW0 + mr) * 2, q1); atomicAdd(rows_cur + (size_t)(MROW0 + mr) * 2 + 1, q2); }
                    }
                }
            }
        } else if (step == 13) {
            ln_phase(P, P.in[26] + (size_t)layer * DM, P.in[27] + (size_t)layer * DM, false, true, nullptr, nullptr, lds);
        } else if (step == 3 || step == 7) {
            LNCTX
            const int ng = step == 3 ? 1 : 2;
            float* GT = (float*)(P.ws + WS_GATES); const float* bif = P.in[10] + (size_t)layer * 8;
#pragma unroll 1
            for (int gi = 0; gi < ng; ++gi) {
                const bf16_t* A = step == 3 ? HB : MA + (size_t)gi * MPAD * 512;
                const bf16_t* Bt = Wl + (step == 3 ? OW_PB : gi ? OW_BA : OW_BM);
                const int N = step == 3 ? NPBW : DM, K = step == 3 ? DM : 512, ldc = step == 3 ? NPB : 2048, coff = gi * DM;
                const pg8::LnFix fx{rows_last, CSl + OC_PB, BWl + OC_PB, step == 3 ? 1 : 0};
                pg8::Gemm gm{A, Bt, MREAL, N, K}; pg8::StaticOrder S; S.init(MREAL, N, G, bidx());
                pg8::EpiPlain E{BIG, ldc, coff, step == 3 ? 8 : 0, step == 3 ? 10 : 0, QSCALE, fx, step == 3 ? GT : nullptr, bif};
                pg8::gemm_phase<pg8::EpiPlain, pg8::StaticOrder, true, true>(lds, gm, S, E);
                const int ntile = step == 3 ? NPB / 16 + 1 : N / 16;
                for (int ct = bidx(); ct < ntile; ct += G) {
                    TIDV
                    const f32x4 a = sg_tile_blk(A + (size_t)MROW0 * K, K, Bt, K, 16 * ct, lane, wid, (LAS float*)lds);
                    const float sc = (step == 3 && 16 * ct >= 2048 && 16 * ct < 2560) ? QSCALE : 1.f;
                    if (wid == 0) {
                        const int rb = 16 * ct + (lane & 15);
                        float mu4[4] = {0.f, 0.f, 0.f, 0.f}, r4v[4] = {1.f, 1.f, 1.f, 1.f}, cs1 = 0.f, bw1 = 0.f;
                        if (fx.on) { cs1 = fx.cs[rb]; bw1 = fx.bw[rb];
#pragma unroll
                            for (int e = 0; e < 4; ++e) fx.stats((size_t)(MROW0 + 4 * (lane >> 4) + e), mu4[e], r4v[e]); }
#pragma unroll
                        for (int e = 0; e < 4; ++e) {
                            const size_t row = (size_t)(MROW0 + 4 * (lane >> 4) + e);
                            const float v = (a[e] - cs1 * mu4[e]) * r4v[e] + bw1;
                            if (step == 3 && ct == NPB / 16) {
                                if ((lane & 15) < 8) { const float z = v + bif[lane & 15]; GT[row * 8 + (lane & 15)] = (lane & 15) < 4 ? z : fminf(z, 0.f) - __logf(1.f + __expf(-fabsf(z))); }
                            } else BIG[row * ldc + coff + rb] = (bf16_t)f2bf(v * sc);
                        }
                    }
                }
            }
        } else if (step == 4) {
            {
                float* KM = (float*)(P.ws + WS_KM) + layer * 72;
                TIDV
                const int gw = bidx() * 8 + wid, NGW = G * 8;
#pragma unroll 1
                for (int task = gw; task < 2049; task += NGW) {
                    const int real = task < 2048, slot = real ? task >> 8 : 8, nr = real ? 32 : NMETA;
                    const size_t r0 = real ? (size_t)(task >> 8) * SEQ + (size_t)(task & 255) * 32 : (size_t)MROW0;
                    float mxv = 0.f;
#pragma unroll 1
                    for (int i0 = 0; i0 < nr; i0 += 8) {
                        u32x4 vr[8];
#pragma unroll
                        for (int j = 0; j < 8; ++j) vr[j] = *(const u32x4*)(BIG + (r0 + i0 + j) * NPB + 2560 + lane * 8);
                        asm volatile("" : "+v"(vr[0]), "+v"(vr[1]), "+v"(vr[2]), "+v"(vr[3]), "+v"(vr[4]), "+v"(vr[5]), "+v"(vr[6]), "+v"(vr[7]));
#pragma unroll
                        for (int j = 0; j < 8; ++j) {
                            const u32x4 v = vr[j];
                            float ss = bflo(v.x) * bflo(v.x) + bfhi(v.x) * bfhi(v.x) + bflo(v.y) * bflo(v.y) + bfhi(v.y) * bfhi(v.y) + bflo(v.z) * bflo(v.z) + bfhi(v.z) * bfhi(v.z) + bflo(v.w) * bflo(v.w) + bfhi(v.w) * bfhi(v.w);
                            ss += __shfl_xor(ss, 1); ss += __shfl_xor(ss, 2); ss += __shfl_xor(ss, 4);
                            mxv = fmaxf(mxv, ss);
                        }
                    }
                    if ((lane & 7) == 0) atomicMax((unsigned*)KM + slot * 8 + (lane >> 3), __builtin_bit_cast(unsigned, mxv));
                }
            }
            for (int u = bidx(); u < 2048 + 4; u += G) { const int bh_ = u < 2048 ? u >> 6 : u - 2048, c_ = u < 2048 ? 1 + (u & 63) : 0; m1_unit(P, layer, bh_, c_, lds); }
        } else if (step == 5) {
            m2_phase(P);
        } else if (step == 6) {
            const float lam_init = layer == 0 ? 0.2f : 0.35550906759f;
            float lam;
            {
                TIDV
                const float* l1 = P.in[12] + layer * 64; const float* k1 = P.in[13] + layer * 64; const float* l2 = P.in[14] + layer * 64; const float* k2 = P.in[15] + layer * 64;
                const float s1 = wave_sum(l1[lane] * k1[lane]), s2 = wave_sum(l2[lane] * k2[lane]);
                lam = expf(s1) - expf(s2) + lam_init;
            }
#pragma unroll 1
            for (int rep_ = 0; rep_ < PROBE_ATT; ++rep_)
#pragma unroll 1
            for (int u = bidx(); u < 2048 + 4; u += G) {
                const int cbv = u & 255, i = u >> 8, jj = cbv >> 3, j = (i & 1) ? 63 - jj : jj;
                const bool real = u < 2048; const int bh = real ? ((cbv & 7) * 4 + ((i >> 1) & 3)) : (u - 2048);
                attn_unit(P, layer, bh >> 2, bh & 3, real ? NMETA + 128 * j : 0, real ? 128 : NMETA, lam, lam_init, lds);
            }
#pragma unroll 1
            for (int rep_ = 0; rep_ < PROBE_M3; ++rep_)
#pragma unroll 1
            for (int u = bidx(); u < 2048 + 4; u += G) { const int bh_ = u < 2048 ? u >> 6 : u - 2048, c_ = u < 2048 ? 1 + (u & 63) : 0; m3_unit(P, layer, bh_, c_, lds); }
        } else if (step == 8) {
            const bf16_t* Y = BIG; const float* bg = P.in[19] + (size_t)layer * 2048;
            pg8::Gemm gm{HB, Wl + OW_GM, MREAL, 2048, DM}; pg8::StaticOrder S; S.init(MREAL, 2048, G, bidx());
            LNCTX
            const pg8::LnFix fx{rows_last, CSl + OC_GM, BWl + OC_GM, 1};
            pg8::EpiGate E{MA, Y, bg, fx};
            pg8::gemm_phase<pg8::EpiGate, pg8::StaticOrder, true, true>(lds, gm, S, E);
            for (int ct = bidx(); ct < 64; ct += G) {
                TIDV
                const int c0 = 16 * ct, R0 = 256 * (c0 >> 7) + (c0 & 127);
                const f32x4 am = sg_tile_blk(HB + (size_t)MROW0 * DM, DM, Wl + OW_GM, DM, R0, lane, wid, (LAS float*)lds), aa = sg_tile_blk(HB + (size_t)MROW0 * DM, DM, Wl + OW_GM, DM, R0 + 128, lane, wid, (LAS float*)lds);
                const int col = c0 + (lane & 15), rb = R0 + (lane & 15);
                if (wid == 0) {
                    float mu4[4], r4v[4], ymv[4], yav[4];
                    const float csm = fx.cs[rb], bwm = fx.bw[rb], csa = fx.cs[rb + 128], bwa = fx.bw[rb + 128];
#pragma unroll
                    for (int e = 0; e < 4; ++e) { const size_t rowl = (size_t)(MROW0 + 4 * (lane >> 4) + e); fx.stats(rowl, mu4[e], r4v[e]); ymv[e] = bflo((unsigned)Y[rowl * 2048 + col]); yav[e] = bflo((unsigned)Y[rowl * 2048 + DM + col]); }
#pragma unroll
                    for (int e = 0; e < 4; ++e) {
                        const size_t row = (size_t)(MROW0 + 4 * (lane >> 4) + e);
                        const float gmv = (am[e] - csm * mu4[e]) * r4v[e] + bwm, gav = (aa[e] - csa * mu4[e]) * r4v[e] + bwa;
                        const float ym = ymv[e], ya = yav[e];
                        MA[row * DM + col] = (bf16_t)f2bf(sigm(gmv) * ym + sigm(gav) * ya);
                    }
                }
            }
        }
        {
            unsigned char* wsb = P.ws; asm volatile("" : "+s"(wsb));
            XcdBarrier xb; xb.bar = (unsigned*)(wsb + WS_BAR); xb.x = xb_xcc_id(); xb.st = (volatile LAS unsigned*)(lds + LDS_BST);
            xcd_barrier(xb);
#ifdef PROBE_SYNC
            for (int i_ = 0; i_ < PROBE_SYNC; ++i_) xcd_barrier(xb);
#endif
        }
    }
}

extern "C" void kernel_launch(void* const* d_in, const int* in_sizes, int n_in, void* d_out, int out_size, void* d_ws, size_t ws_size, hipStream_t stream) {
    static int grid = 0;
    if (grid == 0) {
        if (n_in != 28 || out_size != MREAL * DM || ws_size < WS_END) { fprintf(stderr, "kernel_launch: unexpected shapes (n_in %d out %d ws %zu)\n", n_in, out_size, ws_size); grid = -1; return; }
        int dev = 0, cus = 0, per_cu = 0;
        hipGetDevice(&dev); hipDeviceGetAttribute(&cus, hipDeviceAttributeMultiprocessorCount, dev);
        hipFuncSetAttribute((const void*)hybrid_fwd, hipFuncAttributeMaxDynamicSharedMemorySize, LDS_BYTES);
        hipOccupancyMaxActiveBlocksPerMultiprocessor(&per_cu, (const void*)hybrid_fwd, 512, LDS_BYTES);
        if (per_cu < 1) per_cu = 1;
        grid = cus * per_cu;
        (void)hipGetLastError();
    }
    if (grid < 0) return;
    Params p{};
    for (int i = 0; i < 28; ++i) p.in[i] = (const float*)d_in[i];
    p.out = (float*)d_out; p.ws = (unsigned char*)d_ws;
    void* args[] = {&p};
    hipError_t e = hipLaunchCooperativeKernel((const void*)hybrid_fwd, dim3(grid), dim3(512), args, LDS_BYTES, stream);
    if (e != hipSuccess) fprintf(stderr, "cooperative launch failed: %s (grid %d)\n", hipGetErrorString(e), grid);
}
```

```cpp
#include <hip/hip_runtime.h>
#include <hip/hip_cooperative_groups.h>
#include <cstdio>
#include <cstdint>
namespace cg = cooperative_groups;

__device__ __forceinline__ int tidx() { int t = threadIdx.x; asm volatile("" : "+v"(t)); return t; }
__device__ __forceinline__ int bidx() { int t = blockIdx.x; asm volatile("" : "+s"(t)); return t; }
namespace pg8 {
#define PG8_LAS __attribute__((address_space(3)))
typedef unsigned short bf16_t;
typedef short bf16x8 __attribute__((ext_vector_type(8)));
typedef float f32x4 __attribute__((ext_vector_type(4)));
typedef unsigned u32x4 __attribute__((ext_vector_type(4)));
constexpr int BM = 256, BK = 64, HALF = 128, HTB = HALF * BK * 2  , STAGE_BYTES = 8 * HTB, NXCD = 8, WGM = 8;

__host__ __device__ __forceinline__ int lds_byte(int r, int c) { const int st = (r >> 4) * 2 + (c >> 5), rr = r & 15, cc = c & 31, ob = rr * 64 + cc * 2; return st * 1024 + (ob ^ (((ob >> 9) & 1) << 5)); }
__host__ __device__ __forceinline__ void stage_rc(int b, int& R, int& C) { const int st = b / 1024, sb = b % 1024, swz = sb ^ (((sb >> 9) & 1) << 5); R = (st >> 1) * 16 + swz / 64; C = (st & 1) * 32 + (swz % 64) / 2; }
__host__ __device__ __forceinline__ int perm32(int rho) { const int n = rho >> 4, i = rho & 15; return 8 * (i >> 2) + 4 * n + (i & 3); }

struct Unit { int pm, pn; };
struct Gemm { const bf16_t* A; const bf16_t* Bt; int M, N, K; };

struct StaticOrder {
    int nM, nN, nwg, G, c;
    __host__ __device__ void init(int M, int N, int G_, int c_) { nM = M / BM; nN = N / BM; nwg = nM * nN; G = G_; c = c_; }
    __host__ __device__ bool next(int i, Unit& u) const {
        const long L = (long)i * G + c; if (L >= nwg) return false;
        int wgid = (int)L; { const int q = nwg / NXCD, r = nwg % NXCD, xcd = wgid % NXCD, off = wgid / NXCD; wgid = (xcd < r ? xcd * (q + 1) : r * (q + 1) + (xcd - r) * q) + off; }
        const int nig = WGM * nN, gid = wgid / nig, fm = gid * WGM, gsz = (nM - fm) < WGM ? (nM - fm) : WGM;
        u.pm = fm + ((wgid % nig) % gsz); u.pn = (wgid % nig) / gsz; return true;
    }
    __device__ __forceinline__ void a_ready(const Unit&) const {}
    __device__ __forceinline__ void done(const Unit&) const {}
};

__device__ __forceinline__ unsigned cvt_pk_bf16(float lo, float hi) { unsigned r; asm volatile("v_cvt_pk_bf16_f32 %0, %1, %2" : "=v"(r) : "v"(lo), "v"(hi)); return r; }
typedef float f32x2 __attribute__((ext_vector_type(2)));
__device__ __forceinline__ f32x2 gelu_pk(f32x2 v) {
    const f32x2 av = __builtin_elementwise_abs(v), d = av * 0.2316418882f + 1.0f;
    f32x2 t; t.x = __builtin_amdgcn_rcpf(d.x); t.y = __builtin_amdgcn_rcpf(d.y);
    f32x2 q = t * 0.5307027145f + (-0.7265760135f); q = q * t + 0.7107068705f; q = q * t + (-0.142248368f); q = q * t + 0.127414796f; q = q * t;
    const f32x2 s = (v * v) * (-0.72134752044f);
    f32x2 e; e.x = __builtin_amdgcn_exp2f(s.x); e.y = __builtin_amdgcn_exp2f(s.y);
    const f32x2 m = v * (q * e), r = v - m;
    f32x2 o; o.x = v.x < 0.f ? m.x : r.x; o.y = v.y < 0.f ? m.y : r.y; return o;
}

template <int ACT  > struct EpiBf16 {
    static constexpr bool PERM = true, AFTER_DRAIN = false; static_assert(ACT == 0 || ACT == 1, "EpiBf16: ACT is 0 (none) or 1 (gelu_pk)");
    bf16_t* O; int ldc; const float* bias; int split_cols; size_t split_stride; float scale0;
    __device__ __forceinline__ void operator()(const f32x4 (&acc)[2][2][4][2], const Unit& u, int wr, int wc, int fr, int fq) const {
        const int row0 = u.pm * BM + wr * 64 + fr; int colt = u.pn * BM; bf16_t* base = O;
        float sc = 1.f; if (split_cols) { const int t = colt / split_cols; base += (size_t)t * split_stride; colt -= t * split_cols; if (t == 0) sc = scale0; }
        const int col0 = colt + wc * 32 + 8 * fq, bcol0 = u.pn * BM + wc * 32 + 8 * fq;
        f32x4 bv[2][2];
#pragma unroll
        for (int bj = 0; bj < 2; ++bj)
#pragma unroll
            for (int n = 0; n < 2; ++n) bv[bj][n] = bias ? *(const f32x4*)(bias + bcol0 + bj * HALF + 4 * n) : (f32x4){0.f, 0.f, 0.f, 0.f};
#pragma unroll
        for (int ai = 0; ai < 2; ++ai)
#pragma unroll
            for (int m = 0; m < 4; ++m) { bf16_t* rowp = base + (size_t)(row0 + ai * HALF + m * 16) * ldc + col0;
#pragma unroll
                for (int bj = 0; bj < 2; ++bj) { f32x4 v0 = acc[ai][bj][m][0] + bv[bj][0], v1 = acc[ai][bj][m][1] + bv[bj][1];
                    if (ACT == 1) { f32x2 a = gelu_pk((f32x2){v0[0], v0[1]}), b = gelu_pk((f32x2){v0[2], v0[3]}), c = gelu_pk((f32x2){v1[0], v1[1]}), d = gelu_pk((f32x2){v1[2], v1[3]});
                        v0 = (f32x4){a.x, a.y, b.x, b.y}; v1 = (f32x4){c.x, c.y, d.x, d.y}; }
                    v0 = v0 * sc; v1 = v1 * sc; u32x4 w; w.x = cvt_pk_bf16(v0[0], v0[1]); w.y = cvt_pk_bf16(v0[2], v0[3]); w.z = cvt_pk_bf16(v1[0], v1[1]); w.w = cvt_pk_bf16(v1[2], v1[3]);
                    *(u32x4*)(rowp + bj * HALF) = w; } }
    }
};

struct PanelStats {
    unsigned* xbuf;
    unsigned* cnt;
    unsigned* tmo;
    int ntn; float eps;
    unsigned code;
    __device__ __forceinline__ bool run(const f32x4 (&v)[2][2][4][2], const Unit& u, int wr, int wc, int fr, int fq, PG8_LAS unsigned char* lds, int wid, int lane) const {
        typedef float f32x2v __attribute__((ext_vector_type(2)));
        PG8_LAS f32x2v* P = (PG8_LAS f32x2v*)lds;
        PG8_LAS f32x2v* S = (PG8_LAS f32x2v*)(lds + 8192);
        PG8_LAS unsigned* flag = (PG8_LAS unsigned*)(lds + 8192 + 2048);
#pragma unroll
        for (int ai = 0; ai < 2; ++ai)
#pragma unroll
            for (int m = 0; m < 4; ++m) {
                float s = 0.f;
#pragma unroll
                for (int bj = 0; bj < 2; ++bj)
#pragma unroll
                    for (int n = 0; n < 2; ++n) { const f32x4 x = v[ai][bj][m][n]; s += (x[0] + x[1]) + (x[2] + x[3]); }
                s += __shfl_xor(s, 16); s += __shfl_xor(s, 32);
                const float mw = s * (1.0f / 64.0f); float q = 0.f;
#pragma unroll
                for (int bj = 0; bj < 2; ++bj)
#pragma unroll
                    for (int n = 0; n < 2; ++n) { const f32x4 d = v[ai][bj][m][n] - mw; q += (d[0] * d[0] + d[1] * d[1]) + (d[2] * d[2] + d[3] * d[3]); }
                q += __shfl_xor(q, 16); q += __shfl_xor(q, 32);
                if (fq == 0) P[(ai * HALF + wr * 64 + m * 16 + fr) * 4 + wc] = (f32x2v){mw, q};
            }
        asm volatile("s_waitcnt lgkmcnt(0)" ::: "memory"); __builtin_amdgcn_s_barrier(); asm volatile("" ::: "memory");
#if defined(BROKEN_EXCHANGE_NO_WAIT)
#warning BROKEN CONTROL BUILD: the row-statistics exchange does not wait; results are wrong by design
        if (blockIdx.x >= 64) { const long long t0_ = clock64(); while (clock64() - t0_ < 60000) __builtin_amdgcn_s_sleep(8); }
#endif
        const int row = wid * 32 + (lane & 31);
        if (lane < 32) {
            const f32x2v a = P[row * 4 + 0], b = P[row * 4 + 1], c = P[row * 4 + 2], d = P[row * 4 + 3];
            const float mt = (a.x + b.x + c.x + d.x) * 0.25f;
            const float da = a.x - mt, db = b.x - mt, dc = c.x - mt, dd = d.x - mt;
            const float m2 = (a.y + b.y) + (c.y + d.y) + 64.0f * ((da * da + db * db) + (dc * dc + dd * dd));
            unsigned long long* slot = (unsigned long long*)xbuf + ((size_t)(u.pm * BM + row) * 4 + u.pn);
            __hip_atomic_store(slot, ((unsigned long long)__float_as_uint(m2) << 32) | __float_as_uint(mt), __ATOMIC_RELAXED, __HIP_MEMORY_SCOPE_AGENT);
        }
        asm volatile("s_waitcnt vmcnt(0)" ::: "memory");
        if (lane == 0) __hip_atomic_fetch_add(cnt + 64 * u.pm, 1u, __ATOMIC_RELAXED, __HIP_MEMORY_SCOPE_AGENT);
        if (wid == 0) {
            bool dead = false; const unsigned long long t0 = __builtin_amdgcn_s_memrealtime(); const unsigned want = 8u * (unsigned)ntn;
            for (;;) {
#if defined(BROKEN_EXCHANGE_NO_WAIT)
                break;
#endif
                if ((unsigned)__builtin_amdgcn_readfirstlane(__hip_atomic_load(cnt + 64 * u.pm, __ATOMIC_RELAXED, __HIP_MEMORY_SCOPE_AGENT)) >= want) break;
                if (__builtin_amdgcn_s_memrealtime() - t0 > 2000000ull) {
                    if (lane == 0) { unsigned expect = 0u; __hip_atomic_compare_exchange_strong(tmo + 1, &expect, code | (unsigned)(u.pm & 0xff), __ATOMIC_RELAXED, __ATOMIC_RELAXED, __HIP_MEMORY_SCOPE_AGENT);
                                     __hip_atomic_store(tmo, 1u, __ATOMIC_RELAXED, __HIP_MEMORY_SCOPE_AGENT); }
                    dead = true; break; }
                __builtin_amdgcn_s_sleep(2);
            }
            __builtin_amdgcn_fence(__ATOMIC_ACQUIRE, "agent");
            if (lane == 0) flag[0] = dead ? 1u : 0u;
        }
        asm volatile("s_waitcnt vmcnt(0) lgkmcnt(0)" ::: "memory"); __builtin_amdgcn_s_barrier(); asm volatile("" ::: "memory");
        const bool bad = flag[0] != 0u;
        if (lane < 32) {
            const unsigned long long* slot = (const unsigned long long*)xbuf + (size_t)(u.pm * BM + row) * 4; float mt[4], m2[4]; float ms = 0.f;
#pragma unroll
            for (int t = 0; t < 4; ++t) { if (t < ntn) { const unsigned long long w = __hip_atomic_load(slot + t, __ATOMIC_RELAXED, __HIP_MEMORY_SCOPE_AGENT); mt[t] = __uint_as_float((unsigned)w); m2[t] = __uint_as_float((unsigned)(w >> 32)); } else { mt[t] = 0.f; m2[t] = 0.f; } ms += mt[t]; }
            const float mean = ms / (float)ntn; float q = 0.f;
#pragma unroll
            for (int t = 0; t < 4; ++t) if (t < ntn) { const float dm = mt[t] - mean; q += m2[t] + 256.0f * dm * dm; }
            S[row] = (f32x2v){mean, 1.0f / sqrtf(q / (256.0f * (float)ntn) + eps)};
        }
        asm volatile("s_waitcnt lgkmcnt(0)" ::: "memory"); __builtin_amdgcn_s_barrier(); asm volatile("" ::: "memory");
        return bad;
    }
};
struct EpiLnRes {
    static constexpr bool PERM = false, AFTER_DRAIN = true;
    const float* base; float* out; int ldc; const float* bias; PanelStats st; unsigned poison;
    __device__ __forceinline__ void fused(f32x4 (&acc)[2][2][4][2], const Unit& u, int wr, int wc, int fr, int fq, PG8_LAS unsigned char* lds, int wid, int lane) const {
        typedef float f32x2v __attribute__((ext_vector_type(2)));
        const PG8_LAS f32x2v* S = (const PG8_LAS f32x2v*)(lds + 8192);
        const int col0 = u.pn * BM + wc * 32 + 4 * fq;
#pragma unroll
        for (int bj = 0; bj < 2; ++bj)
#pragma unroll
            for (int n = 0; n < 2; ++n) { const f32x4 bv = bias ? *(const f32x4*)(bias + col0 + bj * HALF + n * 16) : (f32x4){0.f, 0.f, 0.f, 0.f};
#pragma unroll
                for (int ai = 0; ai < 2; ++ai)
#pragma unroll
                    for (int m = 0; m < 4; ++m) acc[ai][bj][m][n] += bv; }
        f32x4 pre[4][2][2];
#pragma unroll
        for (int m = 0; m < 4; ++m) { const size_t off = (size_t)(u.pm * BM + wr * 64 + m * 16 + fr) * ldc + col0;
#pragma unroll
            for (int bj = 0; bj < 2; ++bj)
#pragma unroll
                for (int n = 0; n < 2; ++n) pre[m][bj][n] = *(const f32x4*)(base + off + bj * HALF + n * 16); }
        const bool bad = st.run(acc, u, wr, wc, fr, fq, lds, wid, lane) || poison != 0u;
        const float qnan = __builtin_nanf("");
#pragma unroll
        for (int ai = 0; ai < 2; ++ai)
#pragma unroll
            for (int m = 0; m < 4; ++m) { const int r = ai * HALF + wr * 64 + m * 16 + fr; const f32x2v sr = S[r]; const size_t off = (size_t)(u.pm * BM + r) * ldc + col0;
#pragma unroll
                for (int bj = 0; bj < 2; ++bj)
#pragma unroll
                    for (int n = 0; n < 2; ++n) { const f32x4 bs = ai == 0 ? pre[m][bj][n] : *(const f32x4*)(base + off + bj * HALF + n * 16); f32x4 o = bs + (acc[ai][bj][m][n] - sr.x) * sr.y;
                        if (bad) o = (f32x4){qnan, qnan, qnan, qnan}; *(f32x4*)(out + off + bj * HALF + n * 16) = o; }
                if (m & 1) asm volatile("" ::: "memory"); }
    }
};
struct EpiLnResLn {
    static constexpr bool PERM = false, AFTER_DRAIN = true;
    const float* base; float* out; bf16_t* xn; int ldc; const float* bias; PanelStats st1, st2; unsigned poison;
    __device__ __forceinline__ void fused(f32x4 (&acc)[2][2][4][2], const Unit& u, int wr, int wc, int fr, int fq, PG8_LAS unsigned char* lds, int wid, int lane) const {
        typedef float f32x2v __attribute__((ext_vector_type(2))); typedef unsigned u32x2v __attribute__((ext_vector_type(2)));
        const PG8_LAS f32x2v* S = (const PG8_LAS f32x2v*)(lds + 8192);
        const int col0 = u.pn * BM + wc * 32 + 4 * fq;
#pragma unroll
        for (int bj = 0; bj < 2; ++bj)
#pragma unroll
            for (int n = 0; n < 2; ++n) { const f32x4 bv = bias ? *(const f32x4*)(bias + col0 + bj * HALF + n * 16) : (f32x4){0.f, 0.f, 0.f, 0.f};
#pragma unroll
                for (int ai = 0; ai < 2; ++ai)
#pragma unroll
                    for (int m = 0; m < 4; ++m) acc[ai][bj][m][n] += bv; }
        bool bad = st1.run(acc, u, wr, wc, fr, fq, lds, wid, lane) || poison != 0u;
        const float qnan = __builtin_nanf("");
#pragma unroll
        for (int ai = 0; ai < 2; ++ai)
#pragma unroll
            for (int m = 0; m < 4; ++m) { const int r = ai * HALF + wr * 64 + m * 16 + fr; const f32x2v sr = S[r]; const size_t off = (size_t)(u.pm * BM + r) * ldc + col0;
#pragma unroll
                for (int bj = 0; bj < 2; ++bj)
#pragma unroll
                    for (int n = 0; n < 2; ++n) { const f32x4 bs = *(const f32x4*)(base + off + bj * HALF + n * 16); acc[ai][bj][m][n] = bs + (acc[ai][bj][m][n] - sr.x) * sr.y; }
                asm volatile("" : "+v"(acc[ai][0][m][0]), "+v"(acc[ai][0][m][1]), "+v"(acc[ai][1][m][0]), "+v"(acc[ai][1][m][1]));
                if (m & 1) asm volatile("" ::: "memory"); }
        const bool bad1 = bad;
        bad = st2.run(acc, u, wr, wc, fr, fq, lds, wid, lane) || bad;
#pragma unroll
        for (int ai = 0; ai < 2; ++ai)
#pragma unroll
            for (int m = 0; m < 4; ++m) { const int r = ai * HALF + wr * 64 + m * 16 + fr; const f32x2v sr = S[r]; const size_t off = (size_t)(u.pm * BM + r) * ldc + col0;
#pragma unroll
                for (int bj = 0; bj < 2; ++bj)
#pragma unroll
                    for (int n = 0; n < 2; ++n) { const f32x4 x1 = acc[ai][bj][m][n]; *(f32x4*)(out + off + bj * HALF + n * 16) = bad1 ? (f32x4){qnan, qnan, qnan, qnan} : x1;
                        const f32x4 o = (x1 - sr.x) * sr.y; u32x2v w; w.x = cvt_pk_bf16(o[0], o[1]); w.y = cvt_pk_bf16(o[2], o[3]);
                        if (bad) { w.x = 0x7fc07fc0u; w.y = 0x7fc07fc0u; } *(u32x2v*)(xn + off + bj * HALF + n * 16) = w; }
                asm volatile("" ::: "memory"); }
    }
};

template <class Epi, class Sched, bool ALIGN_EPI = false, bool SP2 = false>
__device__ __forceinline__ void gemm_phase(PG8_LAS unsigned char* lds, const Gemm g, const Sched& S, const Epi& E) {
    const int tid = tidx(), wid = __builtin_amdgcn_readfirstlane(tid >> 6), lane = tid & 63, wr = wid >> 2, wc = wid & 3, fr = lane & 15, fq = lane >> 4;
    const int K = g.K, nt = K / BK;
    unsigned voffA[2], voffB[2];
#pragma unroll
    for (int i = 0; i < 2; ++i) { int R, C; stage_rc(tid * 16 + i * 8192, R, C); const int Rb = Epi::PERM ? ((R & ~31) + perm32(R & 31)) : R;
        voffA[i] = (unsigned)(R * K + C) * 2u; voffB[i] = (unsigned)(Rb * K + C) * 2u; }
    const size_t kstep = (size_t)(BK * 2);
    const size_t hstep = (size_t)HALF * K * 2;
    const size_t tstep = 2 * hstep;
    const unsigned ldsw = (unsigned)wid * 1024u;
    const int aoff = lds_byte(wr * 64 + fr, fq * 8), boff = lds_byte(wc * 32 + fr, fq * 8);
#define PG8_SA(b, h) (((b) * 2 + (h)) * HTB)
#define PG8_SB(b, h) ((4 + (b) * 2 + (h)) * HTB)
#define PG8_STAGE(bufoff, gbase, voff) do { _Pragma("unroll") for (int _i = 0; _i < 2; ++_i) \
        __builtin_amdgcn_global_load_lds((const unsigned*)((const char*)(gbase) + (voff)[_i]), (PG8_LAS unsigned*)(lds + (bufoff) + ldsw + _i * 8192), 16, 0, 0); } while (0)
#define PG8_LDA(dst, b, h) do { _Pragma("unroll") for (int m = 0; m < 4; ++m) _Pragma("unroll") for (int k = 0; k < 2; ++k) dst[m][k] = *(const PG8_LAS bf16x8*)(lds + PG8_SA(b, h) + aoff + m * 2048 + k * 1024); } while (0)
#define PG8_LDB(dst, b, h) do { _Pragma("unroll") for (int n = 0; n < 2; ++n) _Pragma("unroll") for (int k = 0; k < 2; ++k) dst[n][k] = *(const PG8_LAS bf16x8*)(lds + PG8_SB(b, h) + boff + n * 2048 + k * 1024); } while (0)
#define PG8_MMA(ai, bj, At, Bt) do { __builtin_amdgcn_s_setprio(1); _Pragma("unroll") for (int m = 0; m < 4; ++m) _Pragma("unroll") for (int n = 0; n < 2; ++n) _Pragma("unroll") for (int k = 0; k < 2; ++k) \
        acc[ai][bj][m][n] = __builtin_amdgcn_mfma_f32_16x16x32_bf16(Bt[n][k], At[m][k], acc[ai][bj][m][n], 0, 0, 0); __builtin_amdgcn_s_setprio(0); } while (0)
#define PG8_WAIT_V(n) asm volatile("s_waitcnt vmcnt(" #n ")" ::: "memory")
#define PG8_WAIT_L(n) asm volatile("s_waitcnt lgkmcnt(" #n ")" ::: "memory")
#define PG8_BAR __builtin_amdgcn_s_barrier()
#define PG8_SCHED __builtin_amdgcn_sched_barrier(0)
    Unit cur, nxt; int ui = 0;
    if (!S.next(0, cur)) return;
    E.prefetch(cur, tid, lds + 135168);
    f32x4 acc[2][2][4][2];
#pragma unroll
    for (int a = 0; a < 2; ++a)
#pragma unroll
        for (int b = 0; b < 2; ++b)
#pragma unroll
            for (int m = 0; m < 4; ++m)
#pragma unroll
                for (int n = 0; n < 2; ++n) acc[a][b][m][n] = (f32x4){0.f, 0.f, 0.f, 0.f};
    bf16x8 At[4][2], B0[2][2], B1[2][2];
    const char* cA = (const char*)g.A + (size_t)cur.pm * tstep; const char* cB = (const char*)g.Bt + (size_t)cur.pn * tstep;
    S.a_ready(cur);
    if constexpr (SP2) {
        PG8_STAGE(PG8_SB(0, 0), cB, voffB); PG8_STAGE(PG8_SB(0, 1), cB + hstep, voffB); PG8_STAGE(PG8_SA(0, 0), cA, voffA); PG8_STAGE(PG8_SA(0, 1), cA + hstep, voffA);
        if (wr == 1) PG8_BAR;
        PG8_WAIT_V(2); PG8_BAR;
        PG8_STAGE(PG8_SB(1, 0), cB + kstep, voffB); PG8_STAGE(PG8_SA(1, 0), cA + kstep, voffA); PG8_STAGE(PG8_SB(1, 1), cB + hstep + kstep, voffB);
        PG8_WAIT_V(6); PG8_BAR;
    } else {
        PG8_STAGE(PG8_SB(0, 0), cB, voffB); PG8_STAGE(PG8_SA(0, 0), cA, voffA); PG8_STAGE(PG8_SB(0, 1), cB + hstep, voffB); PG8_STAGE(PG8_SA(0, 1), cA + hstep, voffA);
        if (wr == 1) PG8_BAR;
        PG8_WAIT_V(4); PG8_BAR;
        PG8_STAGE(PG8_SB(1, 0), cB + kstep, voffB); PG8_STAGE(PG8_SA(1, 0), cA + kstep, voffA); PG8_STAGE(PG8_SB(1, 1), cB + hstep + kstep, voffB);
        PG8_WAIT_V(6); PG8_BAR;
    }
    for (;;) {
        const bool has_next = S.next(ui + 1, nxt);
        const char* nA = has_next ? (const char*)g.A + (size_t)nxt.pm * tstep : cA; const char* nB = has_next ? (const char*)g.Bt + (size_t)nxt.pn * tstep : cB;
        for (int t = 0; t < nt; t += 2) {
            const bool last = (t == nt - 2);
            const char* a1 = cA + (size_t)(t + 1) * kstep;
            const char* a2 = last ? nA : cA + (size_t)(t + 2) * kstep; const char* b2 = last ? nB : cB + (size_t)(t + 2) * kstep;
            const char* a3 = a2 + kstep; const char* b3 = b2 + kstep;
            if (last && has_next) S.a_ready(nxt);
            if constexpr (SP2) {
            PG8_LDB(B0, 0, 0); PG8_LDB(B1, 0, 1); PG8_SCHED; PG8_LDA(At, 0, 0); PG8_STAGE(PG8_SA(1, 1), a1 + hstep, voffA);
            PG8_WAIT_V(8); PG8_WAIT_L(0); PG8_BAR; PG8_MMA(0, 0, At, B0); PG8_MMA(0, 1, At, B1); PG8_BAR; PG8_SCHED;
            PG8_LDA(At, 0, 1); PG8_STAGE(PG8_SB(0, 0), b2, voffB); PG8_STAGE(PG8_SB(0, 1), b2 + hstep, voffB); PG8_STAGE(PG8_SA(0, 0), a2, voffA);
            PG8_WAIT_V(8); PG8_WAIT_L(0); PG8_BAR; PG8_MMA(1, 0, At, B0); PG8_MMA(1, 1, At, B1); PG8_BAR; PG8_SCHED;
            PG8_LDB(B0, 1, 0); PG8_LDB(B1, 1, 1); PG8_SCHED; PG8_LDA(At, 1, 0); PG8_STAGE(PG8_SA(0, 1), a2 + hstep, voffA);
            PG8_WAIT_V(8); PG8_WAIT_L(0); PG8_BAR; PG8_MMA(0, 0, At, B0); PG8_MMA(0, 1, At, B1); PG8_BAR; PG8_SCHED;
            PG8_LDA(At, 1, 1); PG8_STAGE(PG8_SB(1, 0), b3, voffB); PG8_STAGE(PG8_SB(1, 1), b3 + hstep, voffB); PG8_STAGE(PG8_SA(1, 0), a3, voffA);
            PG8_WAIT_V(8); PG8_WAIT_L(0); PG8_BAR; PG8_MMA(1, 0, At, B0); PG8_MMA(1, 1, At, B1); PG8_BAR; PG8_SCHED;
            } else {
            PG8_LDB(B0, 0, 0); PG8_SCHED; PG8_LDA(At, 0, 0); PG8_STAGE(PG8_SA(1, 1), a1 + hstep, voffA);
            PG8_WAIT_L(8); PG8_BAR; PG8_WAIT_L(0); PG8_MMA(0, 0, At, B0); PG8_BAR; PG8_SCHED;
            PG8_LDB(B1, 0, 1); PG8_STAGE(PG8_SB(0, 0), b2, voffB);
            PG8_BAR; PG8_WAIT_L(0); PG8_MMA(0, 1, At, B1); PG8_BAR;
            PG8_LDA(At, 0, 1); PG8_STAGE(PG8_SA(0, 0), a2, voffA);
            PG8_BAR; PG8_WAIT_L(0); PG8_MMA(1, 0, At, B0); PG8_BAR; PG8_SCHED;
            PG8_STAGE(PG8_SB(0, 1), b2 + hstep, voffB);
            PG8_WAIT_V(6); PG8_BAR; PG8_MMA(1, 1, At, B1); PG8_BAR;
            PG8_LDB(B0, 1, 0); PG8_SCHED; PG8_LDA(At, 1, 0); PG8_STAGE(PG8_SA(0, 1), a2 + hstep, voffA);
            PG8_WAIT_L(8); PG8_BAR; PG8_WAIT_L(0); PG8_MMA(0, 0, At, B0); PG8_BAR; PG8_SCHED;
            PG8_LDB(B1, 1, 1); PG8_STAGE(PG8_SB(1, 0), b3, voffB);
            PG8_BAR; PG8_WAIT_L(0); PG8_MMA(0, 1, At, B1); PG8_BAR;
            PG8_LDA(At, 1, 1); PG8_STAGE(PG8_SA(1, 0), a3, voffA);
            PG8_BAR; PG8_WAIT_L(0); PG8_MMA(1, 0, At, B0); PG8_BAR; PG8_SCHED;
            PG8_STAGE(PG8_SB(1, 1), b3 + hstep, voffB);
            PG8_WAIT_V(6); PG8_BAR; PG8_MMA(1, 1, At, B1); PG8_BAR;
            }
        }
        if constexpr (ALIGN_EPI) { if (wr == 0) PG8_BAR; }
        if constexpr (!Epi::AFTER_DRAIN) { E(acc, cur, wr, wc, fr, fq, lds + 135168 + (ui & 1) * 4096); if (has_next) E.prefetch(nxt, tid, lds + 135168 + ((ui + 1) & 1) * 4096); S.done(cur); }
        if (!has_next) break;
#pragma unroll
        for (int a = 0; a < 2; ++a)
#pragma unroll
            for (int b = 0; b < 2; ++b)
#pragma unroll
                for (int m = 0; m < 4; ++m)
#pragma unroll
                    for (int n = 0; n < 2; ++n) acc[a][b][m][n] = (f32x4){0.f, 0.f, 0.f, 0.f};
        cur = nxt; cA = nA; cB = nB; ++ui;
        if constexpr (ALIGN_EPI) { if (wr == 1) PG8_BAR; }
    }
    PG8_WAIT_V(0);
    if constexpr (!ALIGN_EPI) { if (wr == 0) PG8_BAR; }
    PG8_BAR;
    if constexpr (Epi::AFTER_DRAIN) { E.fused(acc, cur, wr, wc, fr, fq, lds, wid, lane); S.done(cur); }
#undef PG8_SA
#undef PG8_SB
#undef PG8_STAGE
#undef PG8_LDA
#undef PG8_LDB
#undef PG8_MMA
#undef PG8_WAIT_V
#undef PG8_WAIT_L
#undef PG8_BAR
#undef PG8_SCHED
}
}

#define LAS __attribute__((address_space(3)))
typedef unsigned short bf16_t;
typedef short bf16x8 __attribute__((ext_vector_type(8)));
typedef short s16x4 __attribute__((ext_vector_type(4)));
typedef short v4i16_t __attribute__((ext_vector_type(4)));
typedef float f32x4 __attribute__((ext_vector_type(4)));
typedef float f32x16 __attribute__((ext_vector_type(16)));
typedef unsigned u32x4 __attribute__((ext_vector_type(4)));
typedef unsigned u32x2 __attribute__((ext_vector_type(2)));

constexpr int DM = 1024, NB = 8, SEQ = 8192, NMETA = 16, LSEQ = SEQ + NMETA, MREAL = NB * SEQ, MROW0 = MREAL, MPAD = MREAL + 256;
constexpr int FF = 2816, NPB = 3584, NPBW = 3840, DPROJ = 5640;
constexpr int NCH = 65;
constexpr float ALPHA = 1.41421356237f;
constexpr float LOG2E = 1.4426950408889634f;
constexpr float QSCALE = 0.125f * LOG2E;
constexpr float NEGF = -1e30f;
constexpr float LN_EPS = 1e-5f;

constexpr size_t OW_GU1 = 0, OW_D1 = 5767168, OW_PB = 8650752, OW_GM = 12582912, OW_BM = 14680064, OW_BA = 15204352, OW_OUT = 15728640, OW_GU2 = 16777216, OW_D2 = 22544384, OW_LAYER = 25427968;
constexpr int OC_GU1 = 0, OC_PB = 5632, OC_GM = 9472, OC_GU2 = 11520, OC_N = 17152;
constexpr size_t MiB = 1u << 20;
constexpr size_t WS_ROWS = 0;
constexpr size_t WS_CSBW = 4 * MiB;
constexpr size_t WS_HFM = 5 * MiB;
constexpr size_t WS_GATES = 6 * MiB;
constexpr size_t WS_BAR = 9 * MiB;
constexpr size_t WS_KM = WS_BAR + 16384;
constexpr size_t WS_SC = 10 * MiB;
constexpr size_t WS_NST = 11 * MiB;
constexpr size_t WS_STATS = 13 * MiB;
constexpr size_t WS_W = 16 * MiB;
constexpr size_t WS_HB = 113 * MiB;
constexpr size_t WS_LO = 242 * MiB;
constexpr size_t WS_CST = 371 * MiB;
constexpr size_t WS_MA = 436 * MiB;
constexpr size_t WS_BIG = 565 * MiB;
constexpr size_t WS_END = 1015 * MiB;

struct Params {
    const float* in[28];
    float* out; unsigned char* ws;
};

__device__ __forceinline__ unsigned f2bf(float f) { unsigned u = __builtin_bit_cast(unsigned, f); return (u + 0x7fffu + ((u >> 16) & 1u)) >> 16; }
typedef float f32x2_t __attribute__((ext_vector_type(2))); typedef __bf16 bf16x2_t __attribute__((ext_vector_type(2)));
__device__ __forceinline__ unsigned pk2(float lo, float hi) { f32x2_t v = {lo, hi}; bf16x2_t b = __builtin_convertvector(v, bf16x2_t); return __builtin_bit_cast(unsigned, b); }
__device__ __forceinline__ u32x4 pack8(f32x4 a, f32x4 b) { u32x4 w; w.x = pk2(a[0], a[1]); w.y = pk2(a[2], a[3]); w.z = pk2(b[0], b[1]); w.w = pk2(b[2], b[3]); return w; }
__device__ __forceinline__ float bflo(unsigned w) { return __builtin_bit_cast(float, w << 16); }
__device__ __forceinline__ float bfhi(unsigned w) { return __builtin_bit_cast(float, w & 0xffff0000u); }
__device__ __forceinline__ float ex2(float x) { return __builtin_amdgcn_exp2f(x); }
__device__ __forceinline__ float sigm(float x) { return __builtin_amdgcn_rcpf(1.f + ex2(-x * LOG2E)); }
__device__ __forceinline__ float siluf(float x) { return x * sigm(x); }
__device__ __forceinline__ float wave_sum(float v) {
#pragma unroll
    for (int o = 1; o < 64; o <<= 1) v += __shfl_xor(v, o);
    return v;
}
__device__ __forceinline__ float wave_max(float v) {
#pragma unroll
    for (int o = 1; o < 64; o <<= 1) v = fmaxf(v, __shfl_xor(v, o));
    return v;
}
__device__ __forceinline__ size_t seqrow(int b, int pos) { return pos < NMETA ? (size_t)(MROW0 + pos) : (size_t)b * SEQ + (size_t)(pos - NMETA); }
__device__ __forceinline__ f32x16 mfma32(bf16x8 a, bf16x8 b, f32x16 c) { return __builtin_amdgcn_mfma_f32_32x32x16_bf16(a, b, c, 0, 0, 0); }
__device__ __forceinline__ s16x4 vtr(const LAS unsigned char* p) { return __builtin_bit_cast(s16x4, __builtin_amdgcn_ds_read_tr16_b64_v4i16((LAS v4i16_t*)p)); }
__device__ __forceinline__ bf16x8 cat8(s16x4 lo, s16x4 hi) { return (bf16x8){lo[0], lo[1], lo[2], lo[3], hi[0], hi[1], hi[2], hi[3]}; }

namespace pg8 {
__device__ __forceinline__ void tab_prefetch(const float* rows, const float* v0, const float* v1, int pm, int cbase, int tid, PG8_LAS unsigned char* tab) {
    const int wid = __builtin_amdgcn_readfirstlane(tid >> 6), lane = tid & 63;
    if (rows) __builtin_amdgcn_global_load_lds((const unsigned*)(rows + (size_t)pm * 512 + tid), (PG8_LAS unsigned*)(tab + wid * 256), 4, 0, 0);
    const float* src = (wid < 4 ? v0 + (wid * 64 + lane) : v1 + ((wid - 4) * 64 + lane)) + cbase;
    __builtin_amdgcn_global_load_lds((const unsigned*)src, (PG8_LAS unsigned*)(tab + 2048 + wid * 256), 4, 0, 0);
}
__device__ __forceinline__ void tab_ready() { asm volatile("s_waitcnt vmcnt(14)" ::: "memory"); __builtin_amdgcn_s_barrier(); asm volatile("" ::: "memory"); }
__device__ __forceinline__ void tab_stats(const PG8_LAS unsigned char* tab, int rloc, float& mu, float& r) {
    const f32x2_t st = *(const PG8_LAS f32x2_t*)(tab + rloc * 8); mu = st.x * (1.f / DM); r = __builtin_amdgcn_rsqf(st.y * (1.f / DM) - mu * mu + LN_EPS);
}
struct LnFix {
    const float* rows; const float* cs; const float* bw; int on;
    __device__ __forceinline__ void stats(size_t row, float& mu, float& r) const {
        const f32x2_t st = *(const f32x2_t*)(rows + row * 2); mu = st.x * (1.f / DM); r = __builtin_amdgcn_rsqf(st.y * (1.f / DM) - mu * mu + LN_EPS);
    }
};
struct EpiSwiglu {
    static constexpr bool PERM = true, AFTER_DRAIN = false;
    bf16_t* O; int ldc; LnFix fx;
    __device__ __forceinline__ void prefetch(const Unit& u, int tid, PG8_LAS unsigned char* tab) const { if (fx.on) tab_prefetch(fx.rows, fx.cs, fx.bw, u.pm, u.pn * BM, tid, tab); }
    __device__ __forceinline__ void operator()(const f32x4 (&acc)[2][2][4][2], const Unit& u, int wr, int wc, int fr, int fq, const PG8_LAS unsigned char* tab) const {
        const int row0 = u.pm * BM + wr * 64 + fr, col0 = u.pn * 128 + wc * 32 + 8 * fq, cl = wc * 32 + 8 * fq;
        if (fx.on) tab_ready();
#pragma unroll
        for (int ai = 0; ai < 2; ++ai)
#pragma unroll
            for (int m = 0; m < 4; ++m) {
                const size_t row = (size_t)(row0 + ai * HALF + m * 16);
                float mu = 0.f, r = 1.f; if (fx.on) tab_stats(tab, wr * 64 + fr + ai * HALF + m * 16, mu, r);
                u32x4 w;
#pragma unroll
                for (int n = 0; n < 2; ++n) {
                    f32x4 csg = {0.f, 0.f, 0.f, 0.f}, bwg = csg, csu = csg, bwu = csg;
                    if (fx.on) { csg = *(const PG8_LAS f32x4*)(tab + 2048 + (cl + 4 * n) * 4); bwg = *(const PG8_LAS f32x4*)(tab + 3072 + (cl + 4 * n) * 4); csu = *(const PG8_LAS f32x4*)(tab + 2048 + (cl + HALF + 4 * n) * 4); bwu = *(const PG8_LAS f32x4*)(tab + 3072 + (cl + HALF + 4 * n) * 4); }
                    const f32x4 g = (acc[ai][0][m][n] - csg * mu) * r + bwg, up = (acc[ai][1][m][n] - csu * mu) * r + bwu;
                    const unsigned lo = pk2(siluf(g[0]) * up[0], siluf(g[1]) * up[1]), hi = pk2(siluf(g[2]) * up[2], siluf(g[3]) * up[3]);
                    if (n == 0) { w.x = lo; w.y = hi; } else { w.z = lo; w.w = hi; }
                }
                *(u32x4*)(O + row * ldc + col0) = w;
            }
    }
};
struct EpiPlain {
    static constexpr bool PERM = true, AFTER_DRAIN = false;
    bf16_t* O; int ldc; int coff; int slo, shi; float scale; LnFix fx; float* GT; const float* bif;
    __device__ __forceinline__ void prefetch(const Unit& u, int tid, PG8_LAS unsigned char* tab) const { if (fx.on) tab_prefetch(fx.rows, fx.cs, fx.bw, u.pm, u.pn * BM, tid, tab); }
    __device__ __forceinline__ void operator()(const f32x4 (&acc)[2][2][4][2], const Unit& u, int wr, int wc, int fr, int fq, const PG8_LAS unsigned char* tab) const {
        const int row0 = u.pm * BM + wr * 64 + fr, col0 = coff + u.pn * BM + wc * 32 + 8 * fq, cl = wc * 32 + 8 * fq;
        if (fx.on) tab_ready();
        if (GT && u.pn == 14) {
            if (wc == 0 && fq == 0) {
                const f32x4 cs0 = *(const PG8_LAS f32x4*)(tab + 2048 + cl * 4), cs1 = *(const PG8_LAS f32x4*)(tab + 2048 + (cl + 4) * 4);
                const f32x4 bw0 = *(const PG8_LAS f32x4*)(tab + 3072 + cl * 4) + *(const f32x4*)(bif), bw1 = *(const PG8_LAS f32x4*)(tab + 3072 + (cl + 4) * 4) + *(const f32x4*)(bif + 4);
#pragma unroll
                for (int ai = 0; ai < 2; ++ai)
#pragma unroll
                    for (int m = 0; m < 4; ++m) {
                        const size_t row = (size_t)(row0 + ai * HALF + m * 16);
                        float mu, r; tab_stats(tab, wr * 64 + fr + ai * HALF + m * 16, mu, r);
                        const f32x4 li = (acc[ai][0][m][0] - cs0 * mu) * r + bw0, z = (acc[ai][0][m][1] - cs1 * mu) * r + bw1;
                        f32x4 lf;
#pragma unroll
                        for (int e = 0; e < 4; ++e) lf[e] = fminf(z[e], 0.f) - __logf(1.f + __expf(-fabsf(z[e])));
                        *(f32x4*)(GT + row * 8) = li; *(f32x4*)(GT + row * 8 + 4) = lf;
                    }
            }
            return;
        }
        const float sc = (u.pn >= slo && u.pn < shi) ? scale : 1.f;
#pragma unroll
        for (int ai = 0; ai < 2; ++ai)
#pragma unroll
            for (int m = 0; m < 4; ++m) {
                const size_t row = (size_t)(row0 + ai * HALF + m * 16);
                float mu = 0.f, r = 1.f; if (fx.on) tab_stats(tab, wr * 64 + fr + ai * HALF + m * 16, mu, r);
#pragma unroll
                for (int bj = 0; bj < 2; ++bj) {
                    u32x4 w;
#pragma unroll
                    for (int n = 0; n < 2; ++n) {
                        f32x4 cs4 = {0.f, 0.f, 0.f, 0.f}, bw4 = cs4;
                        if (fx.on) { cs4 = *(const PG8_LAS f32x4*)(tab + 2048 + (cl + bj * HALF + 4 * n) * 4); bw4 = *(const PG8_LAS f32x4*)(tab + 3072 + (cl + bj * HALF + 4 * n) * 4); }
                        const f32x4 v = ((acc[ai][bj][m][n] - cs4 * mu) * r + bw4) * sc;
                        if (n == 0) { w.x = pk2(v[0], v[1]); w.y = pk2(v[2], v[3]); } else { w.z = pk2(v[0], v[1]); w.w = pk2(v[2], v[3]); }
                    }
                    *(u32x4*)(O + row * ldc + col0 + bj * HALF) = w;
                }
            }
    }
};
struct EpiResid {
    static constexpr bool PERM = true, AFTER_DRAIN = false;
    const float* src; bf16_t* LO; bf16_t* HB; const float* rows_prev; float* rows_cur; const float* gam; const float* bet; float s; int raw;
    __device__ __forceinline__ void prefetch(const Unit& u, int tid, PG8_LAS unsigned char* tab) const { if (!raw) tab_prefetch(rows_prev, gam, bet, u.pm, u.pn * BM, tid, tab); }
    __device__ __forceinline__ void operator()(const f32x4 (&acc)[2][2][4][2], const Unit& u, int wr, int wc, int fr, int fq, const PG8_LAS unsigned char* tab) const {
        const int row0 = u.pm * BM + wr * 64 + fr, col0 = u.pn * BM + wc * 32 + 8 * fq, cl = wc * 32 + 8 * fq;
        if (!raw) tab_ready();
#pragma unroll
        for (int ai = 0; ai < 2; ++ai)
#pragma unroll
            for (int m = 0; m < 4; ++m) {
                const size_t row = (size_t)(row0 + ai * HALF + m * 16);
                float mu = 0.f, rs = 1.f;
                if (!raw) tab_stats(tab, wr * 64 + fr + ai * HALF + m * 16, mu, rs);
                const float ar = ALPHA * rs, am = -ALPHA * rs * mu;
                float s1 = 0.f, s2 = 0.f;
#pragma unroll
                for (int bj = 0; bj < 2; ++bj) {
                    f32x4 g0 = {1.f, 1.f, 1.f, 1.f}, g1 = g0, b0 = {0.f, 0.f, 0.f, 0.f}, b1 = b0;
                    if (!raw) { g0 = *(const PG8_LAS f32x4*)(tab + 2048 + (cl + bj * HALF) * 4); g1 = *(const PG8_LAS f32x4*)(tab + 2048 + (cl + bj * HALF + 4) * 4); b0 = *(const PG8_LAS f32x4*)(tab + 3072 + (cl + bj * HALF) * 4); b1 = *(const PG8_LAS f32x4*)(tab + 3072 + (cl + bj * HALF + 4) * 4); }
                    f32x4 x0, x1;
                    if (raw) { x0 = *(const f32x4*)(src + row * DM + col0 + bj * HALF); x1 = *(const f32x4*)(src + row * DM + col0 + bj * HALF + 4); }
                    else { const u32x4 hi = *(const u32x4*)(HB + row * DM + col0 + bj * HALF), lo = *(const u32x4*)(LO + row * DM + col0 + bj * HALF);
                        x0 = (f32x4){bflo(hi.x) + bflo(lo.x), bfhi(hi.x) + bfhi(lo.x), bflo(hi.y) + bflo(lo.y), bfhi(hi.y) + bfhi(lo.y)};
                        x1 = (f32x4){bflo(hi.z) + bflo(lo.z), bfhi(hi.z) + bfhi(lo.z), bflo(hi.w) + bflo(lo.w), bfhi(hi.w) + bfhi(lo.w)}; }
                    const f32x4 o0 = (x0 * ar + am) * g0 + b0 * ALPHA + acc[ai][bj][m][0] * s, o1 = (x1 * ar + am) * g1 + b1 * ALPHA + acc[ai][bj][m][1] * s;
                    const u32x4 nh = pack8(o0, o1);
                    const f32x4 d0 = {o0[0] - bflo(nh.x), o0[1] - bfhi(nh.x), o0[2] - bflo(nh.y), o0[3] - bfhi(nh.y)}, d1 = {o1[0] - bflo(nh.z), o1[1] - bfhi(nh.z), o1[2] - bflo(nh.w), o1[3] - bfhi(nh.w)};
                    *(u32x4*)(HB + row * DM + col0 + bj * HALF) = nh; *(u32x4*)(LO + row * DM + col0 + bj * HALF) = pack8(d0, d1);
                    s1 += ((o0[0] + o0[1]) + (o0[2] + o0[3])) + ((o1[0] + o1[1]) + (o1[2] + o1[3]));
                    s2 += ((o0[0] * o0[0] + o0[1] * o0[1]) + (o0[2] * o0[2] + o0[3] * o0[3])) + ((o1[0] * o1[0] + o1[1] * o1[1]) + (o1[2] * o1[2] + o1[3] * o1[3]));
                }
                s1 += __shfl_xor(s1, 16); s1 += __shfl_xor(s1, 32); s2 += __shfl_xor(s2, 16); s2 += __shfl_xor(s2, 32);
                if (fq == 0) { float* rp = rows_cur + row * 2; atomicAdd(rp, s1); atomicAdd(rp + 1, s2); }
                asm volatile("" ::: "memory");
            }
    }
};
struct EpiGate {
    static constexpr bool PERM = true, AFTER_DRAIN = false;
    bf16_t* U; const bf16_t* Y; const float* bg; LnFix fx;
    __device__ __forceinline__ void prefetch(const Unit& u, int tid, PG8_LAS unsigned char* tab) const { tab_prefetch(fx.rows, fx.cs, fx.bw, u.pm, u.pn * BM, tid, tab); }
    __device__ __forceinline__ void operator()(const f32x4 (&acc)[2][2][4][2], const Unit& u, int wr, int wc, int fr, int fq, const PG8_LAS unsigned char* tab) const {
        const int row0 = u.pm * BM + wr * 64 + fr, col0 = u.pn * 128 + wc * 32 + 8 * fq, cl = wc * 32 + 8 * fq;
        tab_ready();
#pragma unroll
        for (int ai = 0; ai < 2; ++ai)
#pragma unroll
            for (int m = 0; m < 4; ++m) {
                const size_t row = (size_t)(row0 + ai * HALF + m * 16);
                float mu, r; tab_stats(tab, wr * 64 + fr + ai * HALF + m * 16, mu, r);
                const u32x4 ym = *(const u32x4*)(Y + row * 2048 + col0), ya = *(const u32x4*)(Y + row * 2048 + DM + col0);
                u32x4 w;
#pragma unroll
                for (int n = 0; n < 2; ++n) {
                    const f32x4 csm = *(const PG8_LAS f32x4*)(tab + 2048 + (cl + 4 * n) * 4), bm = *(const PG8_LAS f32x4*)(tab + 3072 + (cl + 4 * n) * 4);
                    const f32x4 csa = *(const PG8_LAS f32x4*)(tab + 2048 + (cl + HALF + 4 * n) * 4), ba = *(const PG8_LAS f32x4*)(tab + 3072 + (cl + HALF + 4 * n) * 4);
                    const f32x4 gm = (acc[ai][0][m][n] - csm * mu) * r + bm, ga = (acc[ai][1][m][n] - csa * mu) * r + ba;
                    const unsigned y0 = n ? ym.z : ym.x, y1 = n ? ym.w : ym.y, a0 = n ? ya.z : ya.x, a1 = n ? ya.w : ya.y;
                    const unsigned lo = pk2(sigm(gm[0]) * bflo(y0) + sigm(ga[0]) * bflo(a0), sigm(gm[1]) * bfhi(y0) + sigm(ga[1]) * bfhi(a0));
                    const unsigned hi = pk2(sigm(gm[2]) * bflo(y1) + sigm(ga[2]) * bflo(a1), sigm(gm[3]) * bfhi(y1) + sigm(ga[3]) * bfhi(a1));
                    if (n == 0) { w.x = lo; w.y = hi; } else { w.z = lo; w.w = hi; }
                }
                *(u32x4*)(U + row * DM + col0) = w;
            }
    }
};
}

__device__ __forceinline__ f32x4 sg_tile(const bf16_t* A, int lda, const bf16_t* Bt, int K, int n0, int lane) {
    const bf16_t* ap = A + (size_t)(lane & 15) * lda + 8 * (lane >> 4);
    const bf16_t* bp = Bt + (size_t)(n0 + (lane & 15)) * K + 8 * (lane >> 4);
    f32x4 acc = {0.f, 0.f, 0.f, 0.f};
#pragma unroll 8
    for (int k = 0; k < K; k += 32) {
        const bf16x8 a = *(const bf16x8*)(ap + k), b = *(const bf16x8*)(bp + k);
        acc = __builtin_amdgcn_mfma_f32_16x16x32_bf16(a, b, acc, 0, 0, 0);
    }
    return acc;
}

__device__ __forceinline__ f32x4 sg_tile_blk(const bf16_t* A, int lda, const bf16_t* Bt, int K, int n0, int lane, int wid, LAS float* red) {
    const int K8 = K >> 3;
    const bf16_t* ap = A + (size_t)(lane & 15) * lda + 8 * (lane >> 4) + wid * K8;
    const bf16_t* bp = Bt + (size_t)(n0 + (lane & 15)) * K + 8 * (lane >> 4) + wid * K8;
    f32x4 acc = {0.f, 0.f, 0.f, 0.f};
#pragma unroll 1
    for (int k = 0; k < K8; k += 128) {
        bf16x8 av[4], bv[4];
#pragma unroll
        for (int j = 0; j < 4; ++j) { const int kk = k + 32 * j < K8 ? k + 32 * j : k; av[j] = *(const bf16x8*)(ap + kk); bv[j] = *(const bf16x8*)(bp + kk); }
        asm volatile("" : "+v"(av[0]), "+v"(av[1]), "+v"(av[2]), "+v"(av[3]), "+v"(bv[0]), "+v"(bv[1]), "+v"(bv[2]), "+v"(bv[3]));
#pragma unroll
        for (int j = 0; j < 4; ++j) if (k + 32 * j < K8) acc = __builtin_amdgcn_mfma_f32_16x16x32_bf16(av[j], bv[j], acc, 0, 0, 0);
    }
    *(LAS f32x4*)(red + wid * 256 + lane * 4) = acc;
    __syncthreads();
    f32x4 sum = {0.f, 0.f, 0.f, 0.f};
    if (wid == 0) {
#pragma unroll
        for (int w = 0; w < 8; ++w) sum = sum + *(const LAS f32x4*)(red + w * 256 + lane * 4);
    }
    __syncthreads();
    return sum;
}

__device__ __forceinline__ void tr_rows(const float* Wsrc, int ldw, int K, bf16_t* dst, int kb0, int nkb, int nv4, const float* g, const float* bb, float* cs, float* bw, LAS float* scr, int lane, const float* addb = nullptr) {
    float csp[4] = {0.f, 0.f, 0.f, 0.f}, bwp[4] = {0.f, 0.f, 0.f, 0.f};
    const int c = lane & 7;
#pragma unroll 1
    for (int kb = kb0; kb < kb0 + nkb; ++kb) {
        const int k0 = 64 * kb;
        f32x4 vv[8];
        const bool okl = (lane & 7) < nv4; const int n4 = (lane & 7) * 4;
#pragma unroll
        for (int i = 0; i < 8; ++i) vv[i] = *(const f32x4*)(Wsrc + (size_t)(k0 + 8 * i + (lane >> 3)) * ldw + (okl ? n4 : 0));
        asm volatile("" : "+v"(vv[0]), "+v"(vv[1]), "+v"(vv[2]), "+v"(vv[3]), "+v"(vv[4]), "+v"(vv[5]), "+v"(vv[6]), "+v"(vv[7]));
#pragma unroll
        for (int i = 0; i < 8; ++i) { const int kk = 8 * i + (lane >> 3); f32x4 v = vv[i]; if (!okl) v = (f32x4){0.f, 0.f, 0.f, 0.f};
            scr[kk * 33 + n4] = v[0]; scr[kk * 33 + n4 + 1] = v[1]; scr[kk * 33 + n4 + 2] = v[2]; scr[kk * 33 + n4 + 3] = v[3]; }
        f32x4 g0 = {1.f, 1.f, 1.f, 1.f}, g1 = g0, b0 = {0.f, 0.f, 0.f, 0.f}, b1 = b0;
        if (g) { g0 = *(const f32x4*)(g + k0 + 8 * c); g1 = *(const f32x4*)(g + k0 + 8 * c + 4); b0 = *(const f32x4*)(bb + k0 + 8 * c); b1 = *(const f32x4*)(bb + k0 + 8 * c + 4); }
        asm volatile("s_waitcnt lgkmcnt(0)" ::: "memory");
#pragma unroll
        for (int j = 0; j < 4; ++j) {
            const int n = (lane >> 3) + 8 * j; const LAS float* sp = scr + (8 * c) * 33 + n;
            const float x0 = sp[0 * 33], x1 = sp[1 * 33], x2 = sp[2 * 33], x3 = sp[3 * 33], x4 = sp[4 * 33], x5 = sp[5 * 33], x6 = sp[6 * 33], x7 = sp[7 * 33];
            u32x4 o; o.x = pk2(x0 * g0[0], x1 * g0[1]); o.y = pk2(x2 * g0[2], x3 * g0[3]); o.z = pk2(x4 * g1[0], x5 * g1[1]); o.w = pk2(x6 * g1[2], x7 * g1[3]);
            *(u32x4*)(dst + (size_t)n * K + k0 + 8 * c) = o;
            csp[j] += ((bflo(o.x) + bfhi(o.x)) + (bflo(o.y) + bfhi(o.y))) + ((bflo(o.z) + bfhi(o.z)) + (bflo(o.w) + bfhi(o.w)));
            bwp[j] += ((x0 * b0[0] + x1 * b0[1]) + (x2 * b0[2] + x3 * b0[3])) + ((x4 * b1[0] + x5 * b1[1]) + (x6 * b1[2] + x7 * b1[3]));
        }
        asm volatile("s_waitcnt lgkmcnt(0)" ::: "memory");
    }
    if (g) {
#pragma unroll
        for (int j = 0; j < 4; ++j) {
            float a = csp[j], b = bwp[j];
            a += __shfl_xor(a, 1); a += __shfl_xor(a, 2); a += __shfl_xor(a, 4); b += __shfl_xor(b, 1); b += __shfl_xor(b, 2); b += __shfl_xor(b, 4);
            if (c == 0) { cs[(lane >> 3) + 8 * j] = a; bw[(lane >> 3) + 8 * j] = b + (addb ? addb[(lane >> 3) + 8 * j] : 0.f); }
        }
    }
}
constexpr int CW_ITEMS = 824;
__device__ __forceinline__ void conv_weight_item(const Params& P, int layer, int it, LAS float* scr, int lane) {
    bf16_t* W = (bf16_t*)(P.ws + WS_W) + (size_t)layer * OW_LAYER;
    float* CS = (float*)(P.ws + WS_CSBW) + (size_t)layer * 2 * OC_N; float* BW = CS + OC_N;
    const float* wg1 = P.in[2] + (size_t)layer * DM * FF; const float* wu1 = P.in[3] + (size_t)layer * DM * FF; const float* wd1 = P.in[4] + (size_t)layer * FF * DM;
    const float* win = P.in[7] + (size_t)layer * DM * DPROJ;
    const float* wbm = P.in[17] + (size_t)layer * 512 * DM; const float* wba = P.in[18] + (size_t)layer * 512 * DM; const float* wout = P.in[20] + (size_t)layer * DM * DM;
    const float* wg2 = P.in[23] + (size_t)layer * DM * FF; const float* wu2 = P.in[24] + (size_t)layer * DM * FF; const float* wd2 = P.in[25] + (size_t)layer * FF * DM;
    const float* ln1g = P.in[5] + (size_t)layer * DM; const float* ln1b = P.in[6] + (size_t)layer * DM;
    const float* ln2g = P.in[21] + (size_t)layer * DM; const float* ln2b = P.in[22] + (size_t)layer * DM;
    const float* ln3g = layer ? P.in[26] + (size_t)(layer - 1) * DM : nullptr; const float* ln3b = layer ? P.in[27] + (size_t)(layer - 1) * DM : nullptr;
    int r = it;
    if (r < 352) {
        const int second = r >= 176; if (second) r -= 176;
        const int R0 = 32 * r, pn = R0 >> 8, sgu = (R0 >> 7) & 1, i = R0 & 127;
        const float* src = (second ? (sgu ? wu2 : wg2) : (sgu ? wu1 : wg1)) + 128 * pn + i;
        const int oc = second ? OC_GU2 : OC_GU1;
        tr_rows(src, FF, DM, W + (second ? OW_GU2 : OW_GU1) + (size_t)R0 * DM, 0, 16, 8, second ? ln2g : ln3g, second ? ln2b : ln3b, CS + oc + R0, BW + oc + R0, scr, lane); return;
    }
    r -= 352;
    if (r < 192) {
        const int second = r >= 96; if (second) r -= 96;
        const int nb = r / 3, seg = r % 3, R0 = 32 * nb;
        tr_rows((second ? wd2 : wd1) + R0, DM, FF, W + (second ? OW_D2 : OW_D1) + (size_t)R0 * FF, 16 * seg, seg == 2 ? 12 : 16, 8, nullptr, nullptr, nullptr, nullptr, scr, lane); return;
    }
    r -= 192;
    if (r < 120) {
        const int R0 = 32 * r, csrc = R0 < 2048 ? R0 : (R0 < 3584 ? R0 + 8 : 2048);
        tr_rows(win + csrc, DPROJ, DM, W + OW_PB + (size_t)R0 * DM, 0, 16, R0 < 3584 ? 8 : (R0 == 3584 ? 2 : 0), ln1g, ln1b, CS + OC_PB + R0, BW + OC_PB + R0, scr, lane); return;
    }
    r -= 120;
    if (r < 64) {
        const int R0 = 32 * r, pn = R0 >> 8, sg = (R0 >> 7) & 1, i = R0 & 127, csrc = 3592 + 1024 * sg + 128 * pn + i;
        tr_rows(win + csrc, DPROJ, DM, W + OW_GM + (size_t)R0 * DM, 0, 16, 8, ln1g, ln1b, CS + OC_GM + R0, BW + OC_GM + R0, scr, lane, P.in[19] + (size_t)layer * 2048 + 1024 * sg + 128 * pn + i); return;
    }
    r -= 64;
    if (r < 64) {
        const int second = r >= 32; if (second) r -= 32;
        const int R0 = 32 * r;
        tr_rows((second ? wba : wbm) + R0, DM, 512, W + (second ? OW_BA : OW_BM) + (size_t)R0 * 512, 0, 8, 8, nullptr, nullptr, nullptr, nullptr, scr, lane); return;
    }
    r -= 64;
    { const int R0 = 32 * r; tr_rows(wout + R0, DM, DM, W + OW_OUT + (size_t)R0 * DM, 0, 16, 8, nullptr, nullptr, nullptr, nullptr, scr, lane); }
}

__device__ __forceinline__ void ln_row(const f32x4 (&vin)[4], int row, float* hf, const f32x4 (&gv)[4], const f32x4 (&bv)[4], bool gates, bool fin, const float* bif_l, LAS float* gwl, bf16_t* HB, float* ST, float* GT, int lane) {
    f32x4 v[4]; float s = 0.f;
#pragma unroll
    for (int j = 0; j < 4; ++j) { v[j] = vin[j]; s += (v[j][0] + v[j][1]) + (v[j][2] + v[j][3]); }
    const float mean = wave_sum(s) * (1.f / DM); float s2 = 0.f;
#pragma unroll
    for (int j = 0; j < 4; ++j) { v[j] = v[j] - mean; s2 += (v[j][0] * v[j][0] + v[j][1] * v[j][1]) + (v[j][2] * v[j][2] + v[j][3] * v[j][3]); }
    const float rstd = 1.f / sqrtf(wave_sum(s2) * (1.f / DM) + LN_EPS);
    if (lane == 0) { f32x2_t st = {mean, rstd}; *(f32x2_t*)(ST + (size_t)row * 2) = st; }
#pragma unroll
    for (int j = 0; j < 4; ++j) {
        v[j] = v[j] * rstd * gv[j] + bv[j];
        if (fin) *(f32x4*)(hf + 256 * j + 4 * lane) = v[j];
        if (!fin) { u32x2 w; w.x = pk2(v[j][0], v[j][1]); w.y = pk2(v[j][2], v[j][3]); *(u32x2*)(HB + (size_t)row * DM + 256 * j + 4 * lane) = w; }
    }
    if (gates) {
        float mine = 0.f;
#pragma unroll
        for (int g = 0; g < 8; ++g) {
            float d = 0.f;
#pragma unroll
            for (int j = 0; j < 4; ++j) { const f32x4 w4 = *(const LAS f32x4*)(gwl + g * 1024 + 256 * j + 4 * lane); d += (v[j][0] * w4[0] + v[j][1] * w4[1]) + (v[j][2] * w4[2] + v[j][3] * w4[3]); }
            d = wave_sum(d);
            if (lane == g) mine = d;
        }
        if (lane < 8) {
            const float z = mine + bif_l[lane];
            float o = z;
            if (lane >= 4) o = fminf(z, 0.f) - __logf(1.f + __expf(-fabsf(z)));
            GT[(size_t)row * 8 + lane] = o;
        }
    }
}
__device__ __forceinline__ void ln_phase(const Params& P, const float* gam, const float* bet, bool gates, bool fin, const float* win_l, const float* bif_l, LAS unsigned char* lds) {
    const int tid = tidx(), lane = tid & 63, wid = tid >> 6;
    float* hfm = (float*)(P.ws + WS_HFM); bf16_t* HB = (bf16_t*)(P.ws + WS_HB); float* GT = (float*)(P.ws + WS_GATES); float* ST = (float*)(P.ws + WS_STATS);
    LAS float* gwl = (LAS float*)lds;
    if (gates) {
        for (int idx = tid; idx < 8192; idx += 512) { const int k = idx >> 3, g = idx & 7; gwl[g * 1024 + k] = win_l[(size_t)k * DPROJ + 2048 + g]; }
        __syncthreads();
    }
    const int gw = bidx() * 8 + wid, NGW = gridDim.x * 8;
    f32x4 gv[4], bv[4];
#pragma unroll
    for (int j = 0; j < 4; ++j) { gv[j] = *(const f32x4*)(gam + 256 * j + 4 * lane); bv[j] = *(const f32x4*)(bet + 256 * j + 4 * lane); }
    constexpr int NR = MREAL;
    int row = 4 * gw;
    u32x2 ah[4][4], al[4][4];
#define LN_ROWP(r_) (P.out + (size_t)(r_) * DM)
    const bf16_t* LOp = (const bf16_t*)(P.ws + WS_LO);
#define LN_LOADRAW(h_, l_, r_, j_) do { h_ = *(const u32x2*)(HB + (size_t)(r_) * DM + 256 * (j_) + 4 * lane); l_ = *(const u32x2*)(LOp + (size_t)(r_) * DM + 256 * (j_) + 4 * lane); } while (0)
#define LN_COMB(dst_, hi_, lo_) dst_ = (f32x4){bflo(hi_.x) + bflo(lo_.x), bfhi(hi_.x) + bfhi(lo_.x), bflo(hi_.y) + bflo(lo_.y), bfhi(hi_.y) + bfhi(lo_.y)}
    if (row < NR) {
#pragma unroll
        for (int q4 = 0; q4 < 4; ++q4) {
#pragma unroll
            for (int j = 0; j < 4; ++j) LN_LOADRAW(ah[q4][j], al[q4][j], row + q4, j); }
    }
    while (row < NR) {
        f32x4 ca[4][4];
#pragma unroll
        for (int q4 = 0; q4 < 4; ++q4)
#pragma unroll
            for (int j = 0; j < 4; ++j) LN_COMB(ca[q4][j], ah[q4][j], al[q4][j]);
        const int nrow = row + 4 * NGW;
        if (nrow < NR) {
#pragma unroll
            for (int q4 = 0; q4 < 4; ++q4) {
#pragma unroll
                for (int j = 0; j < 4; ++j) LN_LOADRAW(ah[q4][j], al[q4][j], nrow + q4, j); }
        }
#pragma unroll
        for (int q4 = 0; q4 < 4; ++q4) ln_row(ca[q4], row + q4, LN_ROWP(row + q4), gv, bv, gates, fin, bif_l, gwl, HB, ST, GT, lane);
        row = nrow;
    }
#undef LN_ROWP
#undef LN_LOADRAW
#undef LN_COMB
}

__device__ __forceinline__ void conv8(const bf16_t* PB, const float* cw, const float* cb, int b, int pos, int chn, f32x4& o0, f32x4& o1) {
    o0 = *(const f32x4*)(cb + chn); o1 = *(const f32x4*)(cb + chn + 4);
#pragma unroll
    for (int j = 0; j < 4; ++j) {
        const int pp = pos - 3 + j;
        if (pp >= 0) {
            const u32x4 u = *(const u32x4*)(PB + seqrow(b, pp) * NPB + chn);
            const f32x4 w0 = *(const f32x4*)(cw + j * 1024 + chn), w1 = *(const f32x4*)(cw + j * 1024 + chn + 4);
            o0[0] += w0[0] * bflo(u.x); o0[1] += w0[1] * bfhi(u.x); o0[2] += w0[2] * bflo(u.y); o0[3] += w0[3] * bfhi(u.y);
            o1[0] += w1[0] * bflo(u.z); o1[1] += w1[1] * bfhi(u.z); o1[2] += w1[2] * bflo(u.w); o1[3] += w1[3] * bfhi(u.w);
        }
    }
#pragma unroll
    for (int e = 0; e < 4; ++e) { o0[e] = siluf(o0[e]); o1[e] = siluf(o1[e]); }
}
struct ConvW { f32x4 w[4][2]; f32x4 b[2]; };
__device__ __forceinline__ void convw_load(ConvW& cw8, const float* cw, const float* cb, int chn) {
    cw8.b[0] = *(const f32x4*)(cb + chn); cw8.b[1] = *(const f32x4*)(cb + chn + 4);
#pragma unroll
    for (int j = 0; j < 4; ++j) { cw8.w[j][0] = *(const f32x4*)(cw + j * 1024 + chn); cw8.w[j][1] = *(const f32x4*)(cw + j * 1024 + chn + 4); }
}
__device__ __forceinline__ void conv8w(const bf16_t* PB, const ConvW& cw8, int b, int pos, int chn, f32x4& o0, f32x4& o1) {
    o0 = cw8.b[0]; o1 = cw8.b[1];
    u32x4 u4[4];
#pragma unroll
    for (int j = 0; j < 4; ++j) {
        const int pp = pos - 3 + j;
        u4[j] = *(const u32x4*)(PB + seqrow(b, pp < 0 ? 0 : pp) * NPB + chn);
    }
#pragma unroll
    for (int j = 0; j < 4; ++j) {
        const bool ok = pos - 3 + j >= 0;
        const u32x4 u = {ok ? u4[j].x : 0u, ok ? u4[j].y : 0u, ok ? u4[j].z : 0u, ok ? u4[j].w : 0u};
        const f32x4 w0 = cw8.w[j][0], w1 = cw8.w[j][1];
        o0[0] += w0[0] * bflo(u.x); o0[1] += w0[1] * bfhi(u.x); o0[2] += w0[2] * bflo(u.y); o0[3] += w0[3] * bfhi(u.y);
        o1[0] += w1[0] * bflo(u.z); o1[1] += w1[1] * bfhi(u.z); o1[2] += w1[2] * bflo(u.w); o1[3] += w1[3] * bfhi(u.w);
    }
#pragma unroll
    for (int e = 0; e < 4; ++e) { o0[e] = siluf(o0[e]); o1[e] = siluf(o1[e]); }
}

__device__ __forceinline__ float wscan_add(float v, int lane) {
#pragma unroll
    for (int o = 1; o < 64; o <<= 1) { const float t = __shfl_up(v, o); if (lane >= o) v += t; }
    return v;
}
__device__ __forceinline__ float wscan_max(float v, int lane) {
#pragma unroll
    for (int o = 1; o < 64; o <<= 1) { const float t = __shfl_up(v, o); if (lane >= o) v = fmaxf(v, t); }
    return v;
}

__device__ __forceinline__ void lds_barrier() { asm volatile("s_waitcnt lgkmcnt(0)\n\ts_barrier" ::: "memory"); }

constexpr int TSTR = 320;
constexpr int RSTR = 272;
__device__ __forceinline__ void m1_unit(const Params& P, int layer, int bh, int c, LAS unsigned char* lds) {
    const int tid = tidx(), lane = tid & 63, wid = __builtin_amdgcn_readfirstlane(tid >> 6);
    const int b = bh >> 2, hh = bh & 3;
    const int nvalid = c == 0 ? NMETA : 128, p0 = c == 0 ? 0 : NMETA + 128 * (c - 1);
    const int nrep = c == 0 ? NB : 1;
    const bf16_t* PB = (const bf16_t*)(P.ws + WS_BIG); const float* GT = (const float*)(P.ws + WS_GATES);
    float* SC = (float*)(P.ws + WS_SC); float* NST = (float*)(P.ws + WS_NST); bf16_t* CST = (bf16_t*)(P.ws + WS_CST);
    const float* cw = P.in[8] + (size_t)layer * 4 * 1024; const float* cb = P.in[9] + (size_t)layer * 1024;
    LAS unsigned char* Kt = lds; LAS unsigned char* Vt = lds + 128 * TSTR; LAS float* sws = (LAS float*)(lds + 2 * 128 * TSTR);
    float li0 = NEGF, li1 = NEGF, lf0 = 0.f, lf1 = 0.f;
    if (wid == 0) {
        const int i0 = 2 * lane, i1 = i0 + 1;
        const size_t rw0 = seqrow(b, p0 + (i0 < nvalid ? i0 : 0)), rw1 = seqrow(b, p0 + (i1 < nvalid ? i1 : 0));
        li0 = GT[rw0 * 8 + hh]; lf0 = GT[rw0 * 8 + 4 + hh]; li1 = GT[rw1 * 8 + hh]; lf1 = GT[rw1 * 8 + 4 + hh];
        if (i0 >= nvalid) { li0 = NEGF; lf0 = 0.f; } if (i1 >= nvalid) { li1 = NEGF; lf1 = 0.f; }
    }
    ConvW ckw; convw_load(ckw, cw, cb, 512 + hh * 128 + 8 * (tid & 15));
    f32x4 kc0[4], kc1[4]; u32x4 vraw[4];
#pragma unroll
    for (int it = 0; it < 4; ++it) {
        const int item = tid + 512 * it, i = item >> 4, ch = item & 15;
        const int ic = i < nvalid ? i : nvalid - 1;
        conv8w(PB, ckw, b, p0 + ic, 512 + hh * 128 + 8 * ch, kc0[it], kc1[it]);
        vraw[it] = *(const u32x4*)(PB + seqrow(b, p0 + ic) * NPB + 1024 + hh * 128 + 8 * ch);
    }
    if (wid == 0) {
        const int i0 = 2 * lane, i1 = i0 + 1;
        const float s = lf0 + lf1, incl = wscan_add(s, lane), excl = incl - s;
        const float b0 = excl + lf0, b1 = incl, g0 = li0 - b0, g1 = li1 - b1;
        const float gmax = wave_max(fmaxf(g0, g1));
        sws[i0] = i0 < nvalid ? ex2((g0 - gmax) * LOG2E) : 0.f;
        sws[i1] = i1 < nvalid ? ex2((g1 - gmax) * LOG2E) : 0.f;
        const float bend = __shfl(incl, 63);
        if (lane == 0) { for (int bb = 0; bb < nrep; ++bb) { SC[(size_t)((bh + 4 * bb) * NCH + c) * 2] = bend; SC[(size_t)((bh + 4 * bb) * NCH + c) * 2 + 1] = bend + gmax; } }
    }
    __syncthreads();
#pragma unroll
    for (int it = 0; it < 4; ++it) {
        const int item = tid + 512 * it, i = item >> 4, ch = item & 15;
        const float sc = 0.08838834764831845f * sws[i];
        u32x4 kw = pack8(kc0[it] * sc, kc1[it] * sc), vw = vraw[it];
        if (i >= nvalid) { kw = (u32x4){0u, 0u, 0u, 0u}; vw = kw; }
        *(LAS u32x4*)(Kt + i * TSTR + ch * 16) = kw; *(LAS u32x4*)(Vt + i * TSTR + ch * 16) = vw;
    }
    __syncthreads();
    {
        const int h = lane >> 5, g = lane >> 4, q = (lane & 15) >> 2, pp = lane & 3;
        const int dkt = wid >> 1, dvt0 = (wid & 1) * 2;
        f32x16 acc[2];
#pragma unroll
        for (int t = 0; t < 2; ++t)
#pragma unroll
            for (int e = 0; e < 16; ++e) acc[t][e] = 0.f;
#pragma unroll
        for (int ks = 0; ks < 8; ++ks) {
            const int rowa = 16 * ks + 8 * h + q;
            const LAS unsigned char* ka = Kt + rowa * TSTR + (32 * dkt + 16 * (g & 1) + 4 * pp) * 2;
            const bf16x8 af = cat8(vtr(ka), vtr(ka + 4 * TSTR));
#pragma unroll
            for (int t = 0; t < 2; ++t) {
                const LAS unsigned char* va = Vt + rowa * TSTR + (32 * (dvt0 + t) + 16 * (g & 1) + 4 * pp) * 2;
                const bf16x8 bf = cat8(vtr(va), vtr(va + 4 * TSTR));
                acc[t] = mfma32(af, bf, acc[t]);
            }
        }
#pragma unroll
        for (int t = 0; t < 2; ++t) {
            const int dv = 32 * (dvt0 + t) + (lane & 31);
#pragma unroll
            for (int r4 = 0; r4 < 4; ++r4) {
                const int dk0 = 32 * dkt + 8 * r4 + 4 * h;
                u32x2 w; w.x = pk2(acc[t][4 * r4], acc[t][4 * r4 + 1]); w.y = pk2(acc[t][4 * r4 + 2], acc[t][4 * r4 + 3]);
                for (int bb = 0; bb < nrep; ++bb) *(u32x2*)(CST + (size_t)((bh + 4 * bb) * NCH + c) * 16384 + (size_t)dv * 128 + dk0) = w;
            }
        }
    }
    {
        LAS float* red = sws + 256;
        const int dk = tid & 127, part = tid >> 7;
        float sacc = 0.f;
#pragma unroll 8
        for (int i = 0; i < 32; ++i) sacc += __builtin_bit_cast(float, (unsigned)(*(const LAS unsigned short*)(Kt + (32 * part + i) * TSTR + dk * 2)) << 16);
        red[part * 128 + dk] = sacc;
        __syncthreads();
        if (tid < 128) { const float nsum = (red[tid] + red[128 + tid]) + (red[256 + tid] + red[384 + tid]); for (int bb = 0; bb < nrep; ++bb) NST[(size_t)((bh + 4 * bb) * NCH + c) * 128 + tid] = nsum; }
    }
    lds_barrier();
}

__device__ __forceinline__ void m2_phase(const Params& P) {
    float* SC = (float*)(P.ws + WS_SC); float* MST = SC + 32 * NCH * 2; float* NST = (float*)(P.ws + WS_NST); bf16_t* CST = (bf16_t*)(P.ws + WS_CST);
    const int NT = gridDim.x * 512;
    for (int task = bidx() * 512 + tidx(); task < 65536 + 4096; task += NT) {
        if (task < 65536) {
            const int bh = task >> 11, e8 = task & 2047;
            bf16_t* ptr = CST + (size_t)bh * NCH * 16384 + (size_t)e8 * 8;
            float run[8];
#pragma unroll
            for (int e = 0; e < 8; ++e) run[e] = 0.f;
            float m = NEGF;
#pragma unroll 1
            for (int c0 = 0; c0 < NCH; c0 += 5) {
                u32x4 loc[5]; float bendv[5], mlocv[5];
#pragma unroll
                for (int j = 0; j < 5; ++j) { loc[j] = *(const u32x4*)(ptr + (size_t)(c0 + j) * 16384); bendv[j] = SC[(size_t)(bh * NCH + c0 + j) * 2]; mlocv[j] = SC[(size_t)(bh * NCH + c0 + j) * 2 + 1]; }
#pragma unroll
                for (int j = 0; j < 5; ++j) {
                    const int c = c0 + j;
                    const float bend = bendv[j], mloc = mlocv[j];
                    const float mn = fmaxf(bend + m, mloc), a = ex2((bend + m - mn) * LOG2E), bt = ex2((mloc - mn) * LOG2E);
                    u32x4 w; w.x = pk2(run[0], run[1]); w.y = pk2(run[2], run[3]); w.z = pk2(run[4], run[5]); w.w = pk2(run[6], run[7]);
                    *(u32x4*)(ptr + (size_t)c * 16384) = w;
                    run[0] = a * run[0] + bt * bflo(loc[j].x); run[1] = a * run[1] + bt * bfhi(loc[j].x);
                    run[2] = a * run[2] + bt * bflo(loc[j].y); run[3] = a * run[3] + bt * bfhi(loc[j].y);
                    run[4] = a * run[4] + bt * bflo(loc[j].z); run[5] = a * run[5] + bt * bfhi(loc[j].z);
                    run[6] = a * run[6] + bt * bflo(loc[j].w); run[7] = a * run[7] + bt * bfhi(loc[j].w);
                    if (e8 == 0) MST[bh * NCH + c] = m;
                    m = mn;
                }
            }
        } else {
            const int t2 = task - 65536, bh = t2 >> 7, dk = t2 & 127;
            float* ptr = NST + (size_t)bh * NCH * 128 + dk;
            float run = 0.f, m = NEGF;
#pragma unroll 1
            for (int c0 = 0; c0 < NCH; c0 += 13) {
                float locv[13], bendv[13], mlocv[13];
#pragma unroll
                for (int j = 0; j < 13; ++j) { locv[j] = ptr[(size_t)(c0 + j) * 128]; bendv[j] = SC[(size_t)(bh * NCH + c0 + j) * 2]; mlocv[j] = SC[(size_t)(bh * NCH + c0 + j) * 2 + 1]; }
#pragma unroll
                for (int j = 0; j < 13; ++j) {
                    const float mn = fmaxf(bendv[j] + m, mlocv[j]), a = ex2((bendv[j] + m - mn) * LOG2E), bt = ex2((mlocv[j] - mn) * LOG2E);
                    ptr[(size_t)(c0 + j) * 128] = run; run = a * run + bt * locv[j]; m = mn;
                }
            }
        }
    }
}

__device__ __forceinline__ void m3_unit(const Params& P, int layer, int bh, int c, LAS unsigned char* lds) {
    const int tid = tidx(), lane = tid & 63, wid = __builtin_amdgcn_readfirstlane(tid >> 6);
    const int b = bh >> 2, hh = bh & 3;
    const int nvalid = c == 0 ? NMETA : 128, p0 = c == 0 ? 0 : NMETA + 128 * (c - 1);
    const bf16_t* PB = (const bf16_t*)(P.ws + WS_BIG); const float* GT = (const float*)(P.ws + WS_GATES);
    const float* SC = (const float*)(P.ws + WS_SC); const float* MST = SC + 32 * NCH * 2; const float* NST = (const float*)(P.ws + WS_NST); const bf16_t* CST = (const bf16_t*)(P.ws + WS_CST);
    bf16_t* MA = (bf16_t*)(P.ws + WS_MA);
    const float* cw = P.in[8] + (size_t)layer * 4 * 1024; const float* cb = P.in[9] + (size_t)layer * 1024; const float* mng = P.in[11] + (size_t)layer * 512;
    LAS unsigned char* Qt = lds; LAS unsigned char* Kt = lds + 128 * RSTR; LAS unsigned char* Vt = lds + 2 * 128 * RSTR;
    LAS float* sg2 = (LAS float*)(lds + 2 * 128 * RSTR + 128 * TSTR); LAS float* sr2 = sg2 + 128; LAS float* sw = sg2 + 256; LAS float* semt = sg2 + 384; LAS float* sqn = sg2 + 512;
    LAS float* sst = sg2 + 640; LAS float* sst2 = sg2 + 896; LAS float* snp = sg2 + 1152;
    constexpr int CT_OFF = 116736;
    {
        const bf16_t* Cp = CST + (size_t)(bh * NCH + c) * 16384;
#pragma unroll
        for (int k = 0; k < 4; ++k) {
            const int S = (k * 8 + wid) * 64 + lane, row = S >> 4, cch = (S & 15) ^ (row & 15);
            __builtin_amdgcn_global_load_lds((const unsigned*)(Cp + (size_t)row * 128 + cch * 8), (LAS unsigned*)(lds + CT_OFF + (k * 8 + wid) * 1024), 16, 0, 0);
        }
    }
    const float npv = tid < 128 ? NST[(size_t)(bh * NCH + c) * 128 + tid] : 0.f;
    float li0 = NEGF, li1 = NEGF, lf0 = 0.f, lf1 = 0.f, mprev = 0.f;
    if (wid == 0) {
        const int i0 = 2 * lane, i1 = i0 + 1;
        const size_t rw0 = seqrow(b, p0 + (i0 < nvalid ? i0 : 0)), rw1 = seqrow(b, p0 + (i1 < nvalid ? i1 : 0));
        li0 = GT[rw0 * 8 + hh]; lf0 = GT[rw0 * 8 + 4 + hh]; li1 = GT[rw1 * 8 + hh]; lf1 = GT[rw1 * 8 + 4 + hh];
        if (i0 >= nvalid) { li0 = NEGF; lf0 = 0.f; } if (i1 >= nvalid) { li1 = NEGF; lf1 = 0.f; }
        mprev = MST[bh * NCH + c];
    }
    ConvW cqw, ckw; convw_load(cqw, cw, cb, hh * 128 + 8 * (tid & 15)); convw_load(ckw, cw, cb, 512 + hh * 128 + 8 * (tid & 15));
    if (wid == 0) {
        const int i0 = 2 * lane, i1 = i0 + 1;
        const float s = lf0 + lf1, incl = wscan_add(s, lane), excl = incl - s;
        const float b0 = excl + lf0, b1 = incl, g0 = li0 - b0, g1 = li1 - b1;
        const float inclm = wscan_max(fmaxf(g0, g1), lane);
        float exclm = __shfl_up(inclm, 1); if (lane == 0) exclm = NEGF;
        const float cm0 = fmaxf(exclm, g0), cm1 = inclm;
        const float M0 = fmaxf(mprev, cm0), M1 = fmaxf(mprev, cm1);
        sg2[i0] = g0 * LOG2E; sg2[i1] = g1 * LOG2E; sr2[i0] = -M0 * LOG2E; sr2[i1] = -M1 * LOG2E;
        sw[i0] = ex2((mprev - M0) * LOG2E); sw[i1] = ex2((mprev - M1) * LOG2E);
        semt[i0] = ex2(-(b0 + M0) * LOG2E); semt[i1] = ex2(-(b1 + M1) * LOG2E);
    }
#pragma unroll
    for (int it = 0; it < 4; ++it) {
        const int item = tid + 512 * it, i = item >> 4, ch = item & 15;
        u32x4 qw, kw, vw;
        {
            const int ic = i < nvalid ? i : nvalid - 1;
            f32x4 o0, o1;
            conv8w(PB, cqw, b, p0 + ic, hh * 128 + 8 * ch, o0, o1); qw = pack8(o0, o1);
            conv8w(PB, ckw, b, p0 + ic, 512 + hh * 128 + 8 * ch, o0, o1); kw = pack8(o0 * 0.08838834764831845f, o1 * 0.08838834764831845f);
            vw = *(const u32x4*)(PB + seqrow(b, p0 + ic) * NPB + 1024 + hh * 128 + 8 * ch);
            if (i >= nvalid) { qw = (u32x4){0u, 0u, 0u, 0u}; kw = qw; vw = qw; }
        }
        *(LAS u32x4*)(Qt + i * RSTR + ch * 16) = qw; *(LAS u32x4*)(Kt + i * RSTR + ch * 16) = kw; *(LAS u32x4*)(Vt + i * TSTR + ch * 16) = vw;
    }
    if (tid < 128) snp[tid] = npv;
    asm volatile("s_waitcnt vmcnt(0)" ::: "memory");
    __syncthreads();
    const int r = lane & 31, h = lane >> 5, g = lane >> 4, q = (lane & 15) >> 2, pp = lane & 3;
    const int qb = wid >> 1, dvh = wid & 1, t = 32 * qb + r;
    u32x2 mo_[2][4]; f32x4 gn_[2][4];
    {
        const size_t rowp = seqrow(b, p0 + (t < nvalid ? t : 0));
#pragma unroll
        for (int d = 0; d < 2; ++d)
#pragma unroll
            for (int r4 = 0; r4 < 4; ++r4) {
                const int col = hh * 128 + 32 * (2 * dvh + d) + 8 * r4 + 4 * h;
                mo_[d][r4] = *(const u32x2*)(PB + rowp * NPB + 1536 + col); gn_[d][r4] = *(const f32x4*)(mng + col);
            }
    }
    {
        const int i = tid >> 2, part = tid & 3;
        const LAS float* np = snp + 32 * part;
        float s = 0.f;
#pragma unroll
        for (int d8 = 0; d8 < 4; ++d8) {
            const u32x4 qv = *(const LAS u32x4*)(Qt + i * RSTR + (32 * part + 8 * d8) * 2);
            const f32x4 n0 = *(const LAS f32x4*)(np + 8 * d8), n1 = *(const LAS f32x4*)(np + 8 * d8 + 4);
            s += bflo(qv.x) * n0[0] + bfhi(qv.x) * n0[1] + bflo(qv.y) * n0[2] + bfhi(qv.y) * n0[3] + bflo(qv.z) * n1[0] + bfhi(qv.z) * n1[1] + bflo(qv.w) * n1[2] + bfhi(qv.w) * n1[3];
        }
        s += __shfl_xor(s, 1); s += __shfl_xor(s, 2);
        if (part == 0) sqn[i] = s;
    }
    bf16x8 qf[8];
#pragma unroll
    for (int ks = 0; ks < 8; ++ks) qf[ks] = *(const LAS bf16x8*)(Qt + t * RSTR + (16 * ks + 8 * h) * 2);
    f32x16 acc[2];
#pragma unroll
    for (int d = 0; d < 2; ++d)
#pragma unroll
        for (int e = 0; e < 16; ++e) acc[d][e] = 0.f;
    {
#pragma unroll
        for (int ks = 0; ks < 8; ++ks)
#pragma unroll
            for (int d = 0; d < 2; ++d) {
                const int dv = 32 * (2 * dvh + d) + r;
                const bf16x8 cf = *(const LAS bf16x8*)(lds + CT_OFF + (dv * 16 + ((2 * ks + h) ^ (dv & 15))) * 16);
                acc[d] = mfma32(cf, qf[ks], acc[d]);
            }
    }
    __syncthreads();
    const float wt = sw[t], r2 = sr2[t];
#pragma unroll
    for (int d = 0; d < 2; ++d) acc[d] = acc[d] * wt;
    float den = 0.f;
#pragma unroll 1
    for (int kb = 0; kb <= qb; ++kb) {
        f32x16 st;
#pragma unroll
        for (int e = 0; e < 16; ++e) st[e] = 0.f;
#pragma unroll
        for (int ks = 0; ks < 8; ++ks) { const bf16x8 kf = *(const LAS bf16x8*)(Kt + (32 * kb + r) * RSTR + (16 * ks + 8 * h) * 2); st = mfma32(kf, qf[ks], st); }
#pragma unroll
        for (int r4 = 0; r4 < 4; ++r4) {
            const int s0 = 32 * kb + 8 * r4 + 4 * h;
            const f32x4 gs = *(const LAS f32x4*)(sg2 + s0);
#pragma unroll
            for (int e = 0; e < 4; ++e) {
                float v = st[4 * r4 + e] * ex2(r2 + gs[e]);
                if (s0 + e > t) v = 0.f;
                den += v; st[4 * r4 + e] = v;
            }
        }
#pragma unroll
        for (int s2 = 0; s2 < 2; ++s2) {
            u32x4 pw; pw.x = pk2(st[8 * s2], st[8 * s2 + 1]); pw.y = pk2(st[8 * s2 + 2], st[8 * s2 + 3]); pw.z = pk2(st[8 * s2 + 4], st[8 * s2 + 5]); pw.w = pk2(st[8 * s2 + 6], st[8 * s2 + 7]);
            const bf16x8 pf = __builtin_bit_cast(bf16x8, pw);
#pragma unroll
            for (int d = 0; d < 2; ++d) {
                const LAS unsigned char* va = Vt + (32 * kb + 16 * s2 + 4 * h + q) * TSTR + (32 * (2 * dvh + d) + 16 * (g & 1) + 4 * pp) * 2;
                const bf16x8 vf = cat8(vtr(va), vtr(va + 8 * TSTR));
                acc[d] = mfma32(vf, pf, acc[d]);
            }
        }
    }
    den += __shfl_xor(den, 32);
    den += wt * sqn[t];
    const float inv = 1.f / fmaxf(fabsf(den), semt[t]);
    float s1 = 0.f;
#pragma unroll
    for (int d = 0; d < 2; ++d)
#pragma unroll
        for (int e = 0; e < 16; ++e) { acc[d][e] *= inv; s1 += acc[d][e]; }
    s1 += __shfl_xor(s1, 32);
    if (h == 0) sst[wid * 32 + r] = s1;
    __syncthreads();
    const float mean = (s1 + sst[(wid ^ 1) * 32 + r]) * (1.f / 128.f);
    float q2 = 0.f;
#pragma unroll
    for (int d = 0; d < 2; ++d)
#pragma unroll
        for (int e = 0; e < 16; ++e) { acc[d][e] -= mean; q2 += acc[d][e] * acc[d][e]; }
    q2 += __shfl_xor(q2, 32);
    if (h == 0) sst2[wid * 32 + r] = q2;
    __syncthreads();
    const float rstd = 1.f / sqrtf((q2 + sst2[(wid ^ 1) * 32 + r]) * (1.f / 128.f) + LN_EPS);
    if (t < nvalid) {
        const size_t row = seqrow(b, p0 + t);
#pragma unroll
        for (int d = 0; d < 2; ++d)
#pragma unroll
            for (int r4 = 0; r4 < 4; ++r4) {
                const int col = hh * 128 + 32 * (2 * dvh + d) + 8 * r4 + 4 * h;
                const u32x2 mo = mo_[d][r4];
                const f32x4 g4 = gn_[d][r4];
                const float o0 = acc[d][4 * r4] * rstd * g4[0] * sigm(bflo(mo.x)), o1 = acc[d][4 * r4 + 1] * rstd * g4[1] * sigm(bfhi(mo.x));
                const float o2 = acc[d][4 * r4 + 2] * rstd * g4[2] * sigm(bflo(mo.y)), o3 = acc[d][4 * r4 + 3] * rstd * g4[3] * sigm(bfhi(mo.y));
                u32x2 w; w.x = pk2(o0, o1); w.y = pk2(o2, o3);
                *(u32x2*)(MA + row * 512 + col) = w;
            }
    }
    lds_barrier();
}

constexpr int AT_KB = 64 * RSTR, AT_VB = 64 * TSTR, AT_BUF = AT_KB + AT_VB;
__device__ __forceinline__ void attn_unit(const Params& P, int layer, int b, int hd, int pq0, int nvalid, float lam, float lam_init, LAS unsigned char* lds) {
    const int tid = tidx(), lane = tid & 63, wid = __builtin_amdgcn_readfirstlane(tid >> 6);
    const int c = wid >> 2, wq = wid & 3, r = lane & 31, h = lane >> 5, g = lane >> 4, q = (lane & 15) >> 2, pp = lane & 3;
    const bf16_t* PB = (const bf16_t*)(P.ws + WS_BIG); bf16_t* AO = (bf16_t*)(P.ws + WS_MA) + (size_t)MPAD * 512;
    const float* ang = P.in[16] + (size_t)layer * 512;
    const int qi = 32 * wq + r, qp = pq0 + qi;
    bf16x8 qf[4];
    {
        const size_t qrow = seqrow(b, qp < LSEQ ? qp : LSEQ - 1);
#pragma unroll
        for (int ks = 0; ks < 4; ++ks) qf[ks] = *(const bf16x8*)(PB + qrow * NPB + 2048 + hd * 128 + c * 64 + 16 * ks + 8 * h);
    }
    const float slope2 = ex2(-2.f * (float)(hd + 1)) * LOG2E;
    const int ntiles = (pq0 + nvalid - 1) / 64 + 1;
    u32x4 pk[2], pv[2];
#define AT_LOAD(kt) do { _Pragma("unroll") for (int i_ = 0; i_ < 2; ++i_) { const int row_ = (tid + 512 * i_) >> 4, ch_ = tid & 15; int kp_ = 64 * (kt) + row_; kp_ = kp_ < LSEQ ? kp_ : LSEQ - 1; \
        const bf16_t* src_ = PB + seqrow(b, kp_) * NPB + hd * 128 + ch_ * 8; pk[i_] = *(const u32x4*)(src_ + 2560); pv[i_] = *(const u32x4*)(src_ + 3072); } } while (0)
#define AT_STORE(s) do { _Pragma("unroll") for (int i_ = 0; i_ < 2; ++i_) { const int row_ = (tid + 512 * i_) >> 4, ch_ = tid & 15; \
        *(LAS u32x4*)(lds + (s) * AT_BUF + row_ * RSTR + ch_ * 16) = pk[i_]; *(LAS u32x4*)(lds + (s) * AT_BUF + AT_KB + row_ * TSTR + ch_ * 16) = pv[i_]; } } while (0)
    AT_LOAD(ntiles - 1);
    float qkb;
    {
        float ss = 0.f;
#pragma unroll
        for (int ks = 0; ks < 4; ++ks)
#pragma unroll
            for (int j = 0; j < 8; ++j) { const float v = __builtin_bit_cast(float, (unsigned)(unsigned short)qf[ks][j] << 16); ss += v * v; }
        ss += __shfl_xor(ss, 32);
        const float* KM = (const float*)(P.ws + WS_KM) + layer * 72;
        const float k2 = fmaxf(KM[b * 8 + hd * 2 + c], KM[64 + hd * 2 + c]);
        qkb = sqrtf(ss) * sqrtf(k2) * 1.001f + 0.01f;
    }
    LAS unsigned* votes = (LAS unsigned*)(lds + 131072 + 2048);
    if (tid < 16) votes[tid] = 0u;
    AT_STORE((ntiles - 1) & 1);
    __syncthreads();
    float m_run = NEGF, l_run = 0.f;
    f32x16 o[4];
#pragma unroll
    for (int d = 0; d < 4; ++d)
#pragma unroll
        for (int e = 0; e < 16; ++e) o[d][e] = 0.f;
#pragma unroll 1
    for (int kt = ntiles - 1; kt >= 0; --kt) {
        const int s = kt & 1;
        if (kt > 0) AT_LOAD(kt - 1);
        const LAS unsigned char* Kb = lds + s * AT_BUF; const LAS unsigned char* Vb = Kb + AT_KB;
        if (64 * kt <= pq0 + 32 * wq + 31) {
        f32x16 st[2];
#pragma unroll
        for (int kb2 = 0; kb2 < 2; ++kb2) {
            const float tb = slope2 * (float)(64 * kt + 32 * kb2 - pq0 + 4 * h);
#pragma unroll
            for (int e = 0; e < 16; ++e) st[kb2][e] = tb + slope2 * (float)((e & 3) + 8 * (e >> 2));
#pragma unroll
            for (int ks = 0; ks < 4; ++ks) { const bf16x8 kf = *(const LAS bf16x8*)(Kb + (32 * kb2 + r) * RSTR + (c * 64 + 16 * ks + 8 * h) * 2); st[kb2] = mfma32(kf, qf[ks], st[kb2]); }
        }
        if (64 * kt + 63 > pq0 + 32 * wq) {
#pragma unroll
            for (int kb2 = 0; kb2 < 2; ++kb2)
#pragma unroll
                for (int e = 0; e < 16; ++e) { const int kp = 64 * kt + 32 * kb2 + (e & 3) + 8 * (e >> 2) + 4 * h; if (kp > qp) st[kb2][e] = NEGF; }
        }
        float mx = st[0][0];
#pragma unroll
        for (int e = 1; e < 16; ++e) mx = fmaxf(mx, st[0][e]);
#pragma unroll
        for (int e = 0; e < 16; ++e) mx = fmaxf(mx, st[1][e]);
        mx = fmaxf(mx, __shfl_xor(mx, 32));
        if (__any(mx > m_run + 8.f)) {
            const float m_new = fmaxf(m_run, mx), alpha = ex2(m_run - m_new);
            m_run = m_new; l_run *= alpha;
#pragma unroll
            for (int d = 0; d < 4; ++d) o[d] = o[d] * alpha;
        }
        const float m_new = m_run;
        float psum = 0.f;
#pragma unroll
        for (int kb2 = 0; kb2 < 2; ++kb2)
#pragma unroll
            for (int e = 0; e < 16; ++e) { const float p = ex2(st[kb2][e] - m_new); st[kb2][e] = p; psum += p; }
        l_run += psum;
#pragma unroll
        for (int kb2 = 0; kb2 < 2; ++kb2)
#pragma unroll
            for (int s2 = 0; s2 < 2; ++s2) {
                u32x4 pw; pw.x = pk2(st[kb2][8 * s2], st[kb2][8 * s2 + 1]); pw.y = pk2(st[kb2][8 * s2 + 2], st[kb2][8 * s2 + 3]); pw.z = pk2(st[kb2][8 * s2 + 4], st[kb2][8 * s2 + 5]); pw.w = pk2(st[kb2][8 * s2 + 6], st[kb2][8 * s2 + 7]);
                const bf16x8 pf = __builtin_bit_cast(bf16x8, pw);
#pragma unroll
                for (int d = 0; d < 4; ++d) {
                    const LAS unsigned char* va = Vb + (32 * kb2 + 16 * s2 + 4 * h + q) * TSTR + (32 * d + 16 * (g & 1) + 4 * pp) * 2;
                    const bf16x8 vf = cat8(vtr(va), vtr(va + 8 * TSTR));
                    o[d] = mfma32(vf, pf, o[d]);
                }
            }
        }
        if (kt > 0) {
            const float bnd = qkb + slope2 * (float)(64 * (kt - 1) + 63 - pq0);
            const bool dn = !__any(bnd >= m_run - 40.f);
            if (lane == 0) votes[s * 8 + wid] = dn ? 1u : 0u;
            AT_STORE(s ^ 1);
        }
        __syncthreads();
        if (kt > 0) {
            const u32x4 v0 = *(const LAS u32x4*)(votes + s * 8), v1 = *(const LAS u32x4*)(votes + s * 8 + 4);
            const unsigned all = (unsigned)__builtin_amdgcn_readfirstlane((int)((v0.x & v0.y) & (v0.z & v0.w) & (v1.x & v1.y) & (v1.z & v1.w)));
            if (all) break;
        }
    }
#undef AT_LOAD
#undef AT_STORE
    const float l_tot = l_run + __shfl_xor(l_run, 32), inv = 1.f / l_tot;
    LAS float* xch = (LAS float*)lds;
    if (c == 1) {
#pragma unroll
        for (int d = 0; d < 4; ++d)
#pragma unroll
            for (int e = 0; e < 16; ++e) xch[((wq * 4 + d) * 16 + e) * 64 + lane] = o[d][e] * inv;
    }
    __syncthreads();
    if (c == 0) {
        float ss = 0.f;
#pragma unroll
        for (int d = 0; d < 4; ++d)
#pragma unroll
            for (int e = 0; e < 16; ++e) { const float v = o[d][e] * inv - lam * xch[((wq * 4 + d) * 16 + e) * 64 + lane]; o[d][e] = v; ss += v * v; }
        ss += __shfl_xor(ss, 32);
        const float rms = (1.f / sqrtf(ss * (1.f / 128.f) + LN_EPS)) * (1.f - lam_init);
        f32x4 ga_[4][4];
#pragma unroll
        for (int d = 0; d < 4; ++d)
#pragma unroll
            for (int r4 = 0; r4 < 4; ++r4) ga_[d][r4] = *(const f32x4*)(ang + hd * 128 + 32 * d + 8 * r4 + 4 * h);
        if (qi < nvalid) {
            const size_t row = seqrow(b, qp);
#pragma unroll
            for (int d = 0; d < 4; ++d)
#pragma unroll
                for (int r4 = 0; r4 < 4; ++r4) {
                    const int col = hd * 128 + 32 * d + 8 * r4 + 4 * h;
                    const f32x4 g4 = ga_[d][r4];
                    u32x2 w; w.x = pk2(o[d][4 * r4] * rms * g4[0], o[d][4 * r4 + 1] * rms * g4[1]); w.y = pk2(o[d][4 * r4 + 2] * rms * g4[2], o[d][4 * r4 + 3] * rms * g4[3]);
                    *(u32x2*)(AO + row * 512 + col) = w;
                }
        }
    }
    lds_barrier();
}

#define XB_TMO      128
#define XB_XCNT(j)  (256  + 64 * (j))
#define XB_XSUB(j)  (1280 + 64 * (j))
#define XB_XGEN(j)  (2304 + 64 * (j))
#define XB_TOP      3328
#define XB_TOPGEN   3392
#define XCD_BAR_WORDS 3456
#define XB_SPIN_CAP (1u << 18)

__device__ __forceinline__ unsigned xb_ld(unsigned* p)              { return __hip_atomic_load(p, __ATOMIC_RELAXED, __HIP_MEMORY_SCOPE_AGENT); }
__device__ __forceinline__ unsigned xb_add(unsigned* p, unsigned v) { return __hip_atomic_fetch_add(p, v, __ATOMIC_RELAXED, __HIP_MEMORY_SCOPE_AGENT); }
__device__ __forceinline__ unsigned xb_xcc_id() { return (unsigned)__builtin_amdgcn_s_getreg((3 << 11) | 20) & 0xFu; }
#define XB_SPIN(cond, bar) do { unsigned _sp = 0; while (cond) { __builtin_amdgcn_s_sleep(1); \
    if ((++_sp & 255u) == 0u) { if (xb_ld(&(bar)[XB_TMO])) break; if (_sp > XB_SPIN_CAP) { atomicAdd(&(bar)[XB_TMO], 1u); break; } } } } while (0)

struct XcdBarrier {
    unsigned* bar; unsigned x;
    volatile LAS unsigned* st;
};

__device__ __forceinline__ XcdBarrier xcd_barrier_post(unsigned* bar, volatile LAS unsigned* st) {
    XcdBarrier b; b.bar = bar; b.x = xb_xcc_id(); b.st = st;
    if (threadIdx.x == 0) (void)xb_add(&bar[XB_XCNT(b.x)], 1u);
    return b;
}
__device__ __forceinline__ void xcd_barrier_complete(unsigned* bar, unsigned x, unsigned& nloc, unsigned& nx) {
    const unsigned G = gridDim.x * gridDim.y * gridDim.z;
    unsigned sum, cnt, mine, sp = 0u;
    for (;;) {
        sum = 0u; cnt = 0u; mine = 0u;
#pragma unroll
        for (unsigned j = 0; j < 16; ++j) { const unsigned c = xb_ld(&bar[XB_XCNT(j)]); sum += c; cnt += (c > 0u) ? 1u : 0u; mine = (j == x) ? c : mine; }
        if (sum == G) break;
        __builtin_amdgcn_s_sleep(1);
        if ((++sp & 255u) == 0u) { if (xb_ld(&bar[XB_TMO])) break; if (sp > XB_SPIN_CAP) { atomicAdd(&bar[XB_TMO], 1u); break; } }
    }
    nloc = mine > 0u ? mine : 1u; nx = cnt > 0u ? cnt : 1u;
}

__device__ __forceinline__ void xcd_barrier(const XcdBarrier& b) {
    asm volatile("s_waitcnt vmcnt(0)" ::: "memory");
    __syncthreads();
    if (threadIdx.x == 0) {
        unsigned* bar = b.bar;
        __builtin_amdgcn_s_waitcnt(0);
        unsigned nloc = b.st[0], nx = b.st[1];
        if (nloc == 0u) { xcd_barrier_complete(bar, b.x, nloc, nx); b.st[0] = nloc; b.st[1] = nx; }
        const unsigned old = xb_add(&bar[XB_XSUB(b.x)], 1u);
        const unsigned gen = old / nloc;
        if (old + 1u == (gen + 1u) * nloc) {
            __builtin_amdgcn_fence(__ATOMIC_RELEASE, "agent");
            asm volatile("s_waitcnt vmcnt(0)" ::: "memory");
            const unsigned og = xb_add(&bar[XB_TOP], 1u);
            const unsigned tg = og / nx;
            if (og + 1u == (tg + 1u) * nx) xb_add(&bar[XB_TOPGEN], 1u);
            else XB_SPIN(xb_ld(&bar[XB_TOPGEN]) == tg, bar);
            __builtin_amdgcn_fence(__ATOMIC_ACQUIRE, "agent");
            xb_add(&bar[XB_XGEN(b.x)], 1u);
            asm volatile("s_waitcnt vmcnt(0)" ::: "memory");
        } else {
            XB_SPIN(xb_ld(&bar[XB_XGEN(b.x)]) == gen, bar);
            __builtin_amdgcn_fence(__ATOMIC_ACQUIRE, "agent");
            asm volatile("s_waitcnt vmcnt(0)" ::: "memory");
        }
    }
    __syncthreads();
}

#ifndef PROBE_ATT
#define PROBE_ATT 1
#endif
#ifndef PROBE_M3
#define PROBE_M3 1
#endif
constexpr int LDS_BYTES = 155648;
constexpr int LDS_BST = LDS_BYTES - 64;
#ifndef PROG_LAYER
#define PROG_LAYER(L) 16*L+0, 16*L+1, 16*L+3, 16*L+4, 16*L+5, 16*L+6, 16*L+7, 16*L+8, 16*L+9, 16*L+11, 16*L+12
#endif
__device__ const unsigned char PROG[] = { PROG_LAYER(0), PROG_LAYER(1), 16 * 1 + 13 };
constexpr int NSTEP = 14;
__global__ void __launch_bounds__(512) hybrid_fwd(Params P) {
    extern __shared__ __attribute__((aligned(16))) unsigned char smem[];
    LAS unsigned char* lds = (LAS unsigned char*)smem;
    cg::grid_group grid = cg::this_grid();
    unsigned* barw = (unsigned*)(P.ws + WS_BAR);
    volatile LAS unsigned* bst = (volatile LAS unsigned*)(lds + LDS_BST);
    if (blockIdx.x == 0) for (int i = threadIdx.x; i < XCD_BAR_WORDS; i += 512) __hip_atomic_store(barw + i, 0u, __ATOMIC_RELAXED, __HIP_MEMORY_SCOPE_AGENT);
    if (blockIdx.x == 0 && threadIdx.x < 144) __hip_atomic_store((unsigned*)(P.ws + WS_KM) + threadIdx.x, 0u, __ATOMIC_RELAXED, __HIP_MEMORY_SCOPE_AGENT);
    if (threadIdx.x < 2) bst[threadIdx.x] = 0u;
    __syncthreads();

#ifndef PROBE_P0
#define PROBE_P0 1
#endif
#pragma unroll 1
    for (int rep0_ = 0; rep0_ < PROBE_P0; ++rep0_)
    {
        const int lane = tidx() & 63, wid = tidx() >> 6, gw = bidx() * 8 + wid, NGW = gridDim.x * 8;
        bf16_t* HB = (bf16_t*)(P.ws + WS_HB); float* HFM = (float*)(P.ws + WS_HFM);
        LAS float* scr = (LAS float*)(lds + wid * 16384);
        for (int it = gw; it < 2 * CW_ITEMS; it += NGW) conv_weight_item(P, it / CW_ITEMS, it % CW_ITEMS, scr, lane);
        const float* x = P.in[0]; const float* meta = P.in[1];
        {
            const size_t NT8 = (size_t)gridDim.x * 512, n8 = (size_t)MREAL * DM / 8;
#pragma unroll 1
            for (size_t i = (size_t)bidx() * 512 + tidx(); i < n8; i += 4 * NT8) {
                f32x4 v0[4], v1[4];
#pragma unroll
                for (int j = 0; j < 4; ++j) { const size_t ii = i + j * NT8 < n8 ? i + j * NT8 : i; v0[j] = *(const f32x4*)(x + ii * 8); v1[j] = *(const f32x4*)(x + ii * 8 + 4); }
                asm volatile("" : "+v"(v0[0]), "+v"(v0[1]), "+v"(v0[2]), "+v"(v0[3]), "+v"(v1[0]), "+v"(v1[1]), "+v"(v1[2]), "+v"(v1[3]));
#pragma unroll
                for (int j = 0; j < 4; ++j) if (i + j * NT8 < n8) *(u32x4*)(HB + (i + j * NT8) * 8) = pack8(v0[j], v1[j]);
            }
        }
        for (int row = gw; row < NMETA; row += NGW) {
#pragma unroll
            for (int j = 0; j < 4; ++j) {
                const f32x4 v = *(const f32x4*)(meta + (size_t)row * DM + 256 * j + 4 * lane);
                *(f32x4*)(HFM + (size_t)row * DM + 256 * j + 4 * lane) = v;
                u32x2 w; w.x = pk2(v[0], v[1]); w.y = pk2(v[2], v[3]);
                *(u32x2*)(HB + (size_t)(MROW0 + row) * DM + 256 * j + 4 * lane) = w;
            }
        }
    }
    grid.sync();
    (void)xcd_barrier_post(barw, bst);

#pragma unroll 1
    for (int ph = 0; ph < (int)sizeof(PROG); ++ph) {
        const int layer = PROG[ph] >> 4, step = PROG[ph] & 15;
        const int G = gridDim.x;
#define TIDV const int tid_ = tidx(), lane = tid_ & 63, wid = __builtin_amdgcn_readfirstlane(tid_ >> 6); (void)lane; (void)wid;
        bf16_t* HB = (bf16_t*)(P.ws + WS_HB); float* HFM = (float*)(P.ws + WS_HFM);
        bf16_t* BIG = (bf16_t*)(P.ws + WS_BIG); bf16_t* MA = (bf16_t*)(P.ws + WS_MA);
        const bf16_t* Wl = (const bf16_t*)(P.ws + WS_W) + (size_t)layer * OW_LAYER;
#define LNCTX float* ROWS = (float*)(P.ws + WS_ROWS); const float* CSl = (const float*)(P.ws + WS_CSBW) + (size_t)layer * 2 * OC_N; const float* BWl = CSl + OC_N; \
        const int tlast = 3 * layer + (step <= 1 ? -1 : step <= 9 ? 0 : step <= 12 ? 1 : 2);   \
        const float* rows_last = ROWS + (size_t)((tlast & 1) * MPAD) * 2; (void)CSl; (void)BWl; (void)rows_last;
        if (step == 0 || step == 3 || step == 11) {
            LNCTX
            float* z = ROWS + (size_t)(((tlast + 1) & 1) * MPAD) * 2;
            for (int i = bidx() * 512 + tidx(); i < MPAD * 2 / 4; i += G * 512) *(f32x4*)(z + 4 * i) = (f32x4){0.f, 0.f, 0.f, 0.f};
        }
        if (step == 0 || step == 11) {
            LNCTX
            const bf16_t* Wgu = Wl + (step ? OW_GU2 : OW_GU1); const int oc = step ? OC_GU2 : OC_GU1;
            const pg8::LnFix fx{rows_last, CSl + oc, BWl + oc, tlast >= 0 ? 1 : 0};
            pg8::Gemm gm{HB, Wgu, MREAL, 2 * FF, DM}; pg8::StaticOrder S; S.init(MREAL, 2 * FF, G, bidx());
            pg8::EpiSwiglu E{BIG, FF, fx};
            pg8::gemm_phase<pg8::EpiSwiglu, pg8::StaticOrder, true, true>(lds, gm, S, E);
            for (int ct = bidx(); ct < FF / 16; ct += G) {
                TIDV
                const int c0 = 16 * ct, R0 = 256 * (c0 >> 7) + (c0 & 127);
                const f32x4 ag = sg_tile_blk(HB + (size_t)MROW0 * DM, DM, Wgu, DM, R0, lane, wid, (LAS float*)lds), au = sg_tile_blk(HB + (size_t)MROW0 * DM, DM, Wgu, DM, R0 + 128, lane, wid, (LAS float*)lds);
                if (wid == 0) {
                    const int rb = R0 + (lane & 15);
                    float mu4[4] = {0.f, 0.f, 0.f, 0.f}, r4v[4] = {1.f, 1.f, 1.f, 1.f}, csg = 0.f, bwg = 0.f, csu = 0.f, bwu = 0.f;
                    if (fx.on) { csg = fx.cs[rb]; bwg = fx.bw[rb]; csu = fx.cs[rb + 128]; bwu = fx.bw[rb + 128];
#pragma unroll
                        for (int e = 0; e < 4; ++e) fx.stats((size_t)(MROW0 + 4 * (lane >> 4) + e), mu4[e], r4v[e]); }
#pragma unroll
                    for (int e = 0; e < 4; ++e) {
                        const size_t row = (size_t)(MROW0 + 4 * (lane >> 4) + e);
                        const float gv = (ag[e] - csg * mu4[e]) * r4v[e] + bwg, uv = (au[e] - csu * mu4[e]) * r4v[e] + bwu;
                        BIG[row * FF + c0 + (lane & 15)] = (bf16_t)f2bf(siluf(gv) * uv);
                    }
                }
            }
        } else if (step == 1 || step == 9 || step == 12) {
            LNCTX
            const bf16_t* A = step == 9 ? MA : BIG; const bf16_t* Bt = Wl + (step == 1 ? OW_D1 : step == 9 ? OW_OUT : OW_D2);
            const int K = step == 9 ? DM : FF; const float sc = step == 9 ? 1.f : 0.5f;
            pg8::Gemm gm{A, Bt, MREAL, DM, K}; pg8::StaticOrder S; S.init(MREAL, DM, G, bidx());
            const int raw = tlast < 0 ? 1 : 0;
            const int gi = step == 1 ? (layer == 0 ? 5 : 26) : step == 9 ? 5 : 21;
            const int gl = step == 1 ? (layer == 0 ? 0 : layer - 1) : layer;
            const float* gam = P.in[gi] + (size_t)gl * DM; const float* bet = P.in[gi + 1] + (size_t)gl * DM;
            float* rows_cur = ROWS + (size_t)(((tlast + 1) & 1) * MPAD) * 2;
            pg8::EpiResid E{P.in[0], (bf16_t*)(P.ws + WS_LO), HB, rows_last, rows_cur, gam, bet, sc, raw};
            pg8::gemm_phase<pg8::EpiResid, pg8::StaticOrder, true, true>(lds, gm, S, E);
            for (int ct = bidx(); ct < 64; ct += G) {
                TIDV
                const f32x4 a = sg_tile_blk(A + (size_t)MROW0 * K, K, Bt, K, 16 * ct, lane, wid, (LAS float*)lds);
                const int col = 16 * ct + (lane & 15);
                if (wid == 0) {
                    float hv[4], s1v[4] = {0.f, 0.f, 0.f, 0.f}, s2v[4] = {1.f, 1.f, 1.f, 1.f}, gcol = 1.f, bcol = 0.f;
#pragma unroll
                    for (int e = 0; e < 4; ++e) { const int mr = 4 * (lane >> 4) + e; hv[e] = HFM[(size_t)mr * DM + col]; if (!raw) { s1v[e] = rows_last[(size_t)(MROW0 + mr) * 2]; s2v[e] = rows_last[(size_t)(MROW0 + mr) * 2 + 1]; } }
                    if (!raw) { gcol = gam[col]; bcol = bet[col]; }
#pragma unroll
                    for (int e = 0; e < 4; ++e) {
                        const int mr = 4 * (lane >> 4) + e; float* p = HFM + (size_t)mr * DM + col;
                        float h = hv[e];
                        if (!raw) { const float mu = s1v[e] * (1.f / DM), r = __builtin_amdgcn_rsqf(s2v[e] * (1.f / DM) - mu * mu + LN_EPS);
                            h = (h - mu) * r * gcol + bcol; }
                        const float y = ALPHA * h + sc * a[e];
                        *p = y; HB[(size_t)(MROW0 + mr) * DM + col] = (bf16_t)f2bf(y);
                        float q1 = y, q2 = y * y;
                        q1 += __shfl_xor(q1, 1); q1 += __shfl_xor(q1, 2); q1 += __shfl_xor(q1, 4); q1 += __shfl_xor(q1, 8);
                        q2 += __shfl_xor(q2, 1); q2 += __shfl_xor(q2, 2); q2 += __shfl_xor(q2, 4); q2 += __shfl_xor(q2, 8);
                        if ((lane & 15) == 0) { atomicAdd(rows_cur + (size_t)(MROW0 + mr) * 2, q1); atomicAdd(rows_cur + (size_t)(MROW0 + mr) * 2 + 1, q2); }
                    }
                }
            }
        } else if (step == 13) {
            ln_phase(P, P.in[26] + (size_t)layer * DM, P.in[27] + (size_t)layer * DM, false, true, nullptr, nullptr, lds);
        } else if (step == 3 || step == 7) {
            LNCTX
            const int ng = step == 3 ? 1 : 2;
            float* GT = (float*)(P.ws + WS_GATES); const float* bif = P.in[10] + (size_t)layer * 8;
#pragma unroll 1
            for (int gi = 0; gi < ng; ++gi) {
                const bf16_t* A = step == 3 ? HB : MA + (size_t)gi * MPAD * 512;
                const bf16_t* Bt = Wl + (step == 3 ? OW_PB : gi ? OW_BA : OW_BM);
                const int N = step == 3 ? NPBW : DM, K = step == 3 ? DM : 512, ldc = step == 3 ? NPB : 2048, coff = gi * DM;
                const pg8::LnFix fx{rows_last, CSl + OC_PB, BWl + OC_PB, step == 3 ? 1 : 0};
                pg8::Gemm gm{A, Bt, MREAL, N, K}; pg8::StaticOrder S; S.init(MREAL, N, G, bidx());
                pg8::EpiPlain E{BIG, ldc, coff, step == 3 ? 8 : 0, step == 3 ? 10 : 0, QSCALE, fx, step == 3 ? GT : nullptr, bif};
                pg8::gemm_phase<pg8::EpiPlain, pg8::StaticOrder, true, true>(lds, gm, S, E);
                const int ntile = step == 3 ? NPB / 16 + 1 : N / 16;
                for (int ct = bidx(); ct < ntile; ct += G) {
                    TIDV
                    const f32x4 a = sg_tile_blk(A + (size_t)MROW0 * K, K, Bt, K, 16 * ct, lane, wid, (LAS float*)lds);
                    const float sc = (step == 3 && 16 * ct >= 2048 && 16 * ct < 2560) ? QSCALE : 1.f;
                    if (wid == 0) {
                        const int rb = 16 * ct + (lane & 15);
                        float mu4[4] = {0.f, 0.f, 0.f, 0.f}, r4v[4] = {1.f, 1.f, 1.f, 1.f}, cs1 = 0.f, bw1 = 0.f;
                        if (fx.on) { cs1 = fx.cs[rb]; bw1 = fx.bw[rb];
#pragma unroll
                            for (int e = 0; e < 4; ++e) fx.stats((size_t)(MROW0 + 4 * (lane >> 4) + e), mu4[e], r4v[e]); }
#pragma unroll
                        for (int e = 0; e < 4; ++e) {
                            const size_t row = (size_t)(MROW0 + 4 * (lane >> 4) + e);
                            const float v = (a[e] - cs1 * mu4[e]) * r4v[e] + bw1;
                            if (step == 3 && ct == NPB / 16) {
                                if ((lane & 15) < 8) { const float z = v + bif[lane & 15]; GT[row * 8 + (lane & 15)] = (lane & 15) < 4 ? z : fminf(z, 0.f) - __logf(1.f + __expf(-fabsf(z))); }
                            } else BIG[row * ldc + coff + rb] = (bf16_t)f2bf(v * sc);
                        }
                    }
                }
            }
        } else if (step == 4) {
            {
                float* KM = (float*)(P.ws + WS_KM) + layer * 72;
                TIDV
                const int gw = bidx() * 8 + wid, NGW = G * 8;
#pragma unroll 1
                for (int task = gw; task < 2049; task += NGW) {
                    const int real = task < 2048, slot = real ? task >> 8 : 8, nr = real ? 32 : NMETA;
                    const size_t r0 = real ? (size_t)(task >> 8) * SEQ + (size_t)(task & 255) * 32 : (size_t)MROW0;
                    float mxv = 0.f;
#pragma unroll 1
                    for (int i0 = 0; i0 < nr; i0 += 8) {
                        u32x4 vr[8];
#pragma unroll
                        for (int j = 0; j < 8; ++j) vr[j] = *(const u32x4*)(BIG + (r0 + i0 + j) * NPB + 2560 + lane * 8);
                        asm volatile("" : "+v"(vr[0]), "+v"(vr[1]), "+v"(vr[2]), "+v"(vr[3]), "+v"(vr[4]), "+v"(vr[5]), "+v"(vr[6]), "+v"(vr[7]));
#pragma unroll
                        for (int j = 0; j < 8; ++j) {
                            const u32x4 v = vr[j];
                            float ss = bflo(v.x) * bflo(v.x) + bfhi(v.x) * bfhi(v.x) + bflo(v.y) * bflo(v.y) + bfhi(v.y) * bfhi(v.y) + bflo(v.z) * bflo(v.z) + bfhi(v.z) * bfhi(v.z) + bflo(v.w) * bflo(v.w) + bfhi(v.w) * bfhi(v.w);
                            ss += __shfl_xor(ss, 1); ss += __shfl_xor(ss, 2); ss += __shfl_xor(ss, 4);
                            mxv = fmaxf(mxv, ss);
                        }
                    }
                    if ((lane & 7) == 0) atomicMax((unsigned*)KM + slot * 8 + (lane >> 3), __builtin_bit_cast(unsigned, mxv));
                }
            }
            for (int u = bidx(); u < 2048 + 4; u += G) { const int bh_ = u < 2048 ? u >> 6 : u - 2048, c_ = u < 2048 ? 1 + (u & 63) : 0; m1_unit(P, layer, bh_, c_, lds); }
        } else if (step == 5) {
            m2_phase(P);
        } else if (step == 6) {
            const float lam_init = layer == 0 ? 0.2f : 0.35550906759f;
            float lam;
            {
                TIDV
                const float* l1 = P.in[12] + layer * 64; const float* k1 = P.in[13] + layer * 64; const float* l2 = P.in[14] + layer * 64; const float* k2 = P.in[15] + layer * 64;
                const float s1 = wave_sum(l1[lane] * k1[lane]), s2 = wave_sum(l2[lane] * k2[lane]);
                lam = expf(s1) - expf(s2) + lam_init;
            }
#pragma unroll 1
            for (int rep_ = 0; rep_ < PROBE_ATT; ++rep_)
#pragma unroll 1
            for (int u = bidx(); u < 2048 + 4; u += G) {
                const int cbv = u & 255, i = u >> 8, jj = cbv >> 3, j = (i & 1) ? 63 - jj : jj;
                const bool real = u < 2048; const int bh = real ? ((cbv & 7) * 4 + ((i >> 1) & 3)) : (u - 2048);
                attn_unit(P, layer, bh >> 2, bh & 3, real ? NMETA + 128 * j : 0, real ? 128 : NMETA, lam, lam_init, lds);
            }
#pragma unroll 1
            for (int rep_ = 0; rep_ < PROBE_M3; ++rep_)
#pragma unroll 1
            for (int u = bidx(); u < 2048 + 4; u += G) { const int bh_ = u < 2048 ? u >> 6 : u - 2048, c_ = u < 2048 ? 1 + (u & 63) : 0; m3_unit(P, layer, bh_, c_, lds); }
        } else if (step == 8) {
            const bf16_t* Y = BIG; const float* bg = P.in[19] + (size_t)layer * 2048;
            pg8::Gemm gm{HB, Wl + OW_GM, MREAL, 2048, DM}; pg8::StaticOrder S; S.init(MREAL, 2048, G, bidx());
            LNCTX
            const pg8::LnFix fx{rows_last, CSl + OC_GM, BWl + OC_GM, 1};
            pg8::EpiGate E{MA, Y, bg, fx};
            pg8::gemm_phase<pg8::EpiGate, pg8::StaticOrder, true, true>(lds, gm, S, E);
            for (int ct = bidx(); ct < 64; ct += G) {
                TIDV
                const int c0 = 16 * ct, R0 = 256 * (c0 >> 7) + (c0 & 127);
                const f32x4 am = sg_tile_blk(HB + (size_t)MROW0 * DM, DM, Wl + OW_GM, DM, R0, lane, wid, (LAS float*)lds), aa = sg_tile_blk(HB + (size_t)MROW0 * DM, DM, Wl + OW_GM, DM, R0 + 128, lane, wid, (LAS float*)lds);
                const int col = c0 + (lane & 15), rb = R0 + (lane & 15);
                if (wid == 0) {
                    float mu4[4], r4v[4], ymv[4], yav[4];
                    const float csm = fx.cs[rb], bwm = fx.bw[rb], csa = fx.cs[rb + 128], bwa = fx.bw[rb + 128];
#pragma unroll
                    for (int e = 0; e < 4; ++e) { const size_t rowl = (size_t)(MROW0 + 4 * (lane >> 4) + e); fx.stats(rowl, mu4[e], r4v[e]); ymv[e] = bflo((unsigned)Y[rowl * 2048 + col]); yav[e] = bflo((unsigned)Y[rowl * 2048 + DM + col]); }
#pragma unroll
                    for (int e = 0; e < 4; ++e) {
                        const size_t row = (size_t)(MROW0 + 4 * (lane >> 4) + e);
                        const float gmv = (am[e] - csm * mu4[e]) * r4v[e] + bwm, gav = (aa[e] - csa * mu4[e]) * r4v[e] + bwa;
                        const float ym = ymv[e], ya = yav[e];
                        MA[row * DM + col] = (bf16_t)f2bf(sigm(gmv) * ym + sigm(gav) * ya);
                    }
                }
            }
        }
        {
            unsigned char* wsb = P.ws; asm volatile("" : "+s"(wsb));
            XcdBarrier xb; xb.bar = (unsigned*)(wsb + WS_BAR); xb.x = xb_xcc_id(); xb.st = (volatile LAS unsigned*)(lds + LDS_BST);
            xcd_barrier(xb);
#ifdef PROBE_SYNC
            for (int i_ = 0; i_ < PROBE_SYNC; ++i_) xcd_barrier(xb);
#endif
        }
    }
}

extern "C" void kernel_launch(void* const* d_in, const int* in_sizes, int n_in, void* d_out, int out_size, void* d_ws, size_t ws_size, hipStream_t stream) {
    static int grid = 0;
    if (grid == 0) {
        if (n_in != 28 || out_size != MREAL * DM || ws_size < WS_END) { fprintf(stderr, "kernel_launch: unexpected shapes (n_in %d out %d ws %zu)\n", n_in, out_size, ws_size); grid = -1; return; }
        int dev = 0, cus = 0, per_cu = 0;
        hipGetDevice(&dev); hipDeviceGetAttribute(&cus, hipDeviceAttributeMultiprocessorCount, dev);
        hipFuncSetAttribute((const void*)hybrid_fwd, hipFuncAttributeMaxDynamicSharedMemorySize, LDS_BYTES);
        hipOccupancyMaxActiveBlocksPerMultiprocessor(&per_cu, (const void*)hybrid_fwd, 512, LDS_BYTES);
        if (per_cu < 1) per_cu = 1;
        grid = cus * per_cu;
        (void)hipGetLastError();
    }
    if (grid < 0) return;
    Params p{};
    for (int i = 0; i < 28; ++i) p.in[i] = (const float*)d_in[i];
    p.out = (float*)d_out; p.ws = (unsigned char*)d_ws;
    void* args[] = {&p};
    hipError_t e = hipLaunchCooperativeKernel((const void*)hybrid_fwd, dim3(grid), dim3(512), args, LDS_BYTES, stream);
    if (e != hipSuccess) fprintf(stderr, "cooperative launch failed: %s (grid %d)\n", hipGetErrorString(e), grid);
}
```

```cpp
#include <hip/hip_runtime.h>
#include <hip/hip_cooperative_groups.h>
#include <cstdio>
#include <cstdint>
namespace cg = cooperative_groups;

__device__ __forceinline__ int tidx() { int t = threadIdx.x; asm volatile("" : "+v"(t)); return t; }
__device__ __forceinline__ int bidx() { int t = blockIdx.x; asm volatile("" : "+s"(t)); return t; }
namespace pg8 {
#define PG8_LAS __attribute__((address_space(3)))
typedef unsigned short bf16_t;
typedef short bf16x8 __attribute__((ext_vector_type(8)));
typedef float f32x4 __attribute__((ext_vector_type(4)));
typedef unsigned u32x4 __attribute__((ext_vector_type(4)));
constexpr int BM = 256, BK = 64, HALF = 128, HTB = HALF * BK * 2  , STAGE_BYTES = 8 * HTB, NXCD = 8, WGM = 8;

__host__ __device__ __forceinline__ int lds_byte(int r, int c) { const int st = (r >> 4) * 2 + (c >> 5), rr = r & 15, cc = c & 31, ob = rr * 64 + cc * 2; return st * 1024 + (ob ^ (((ob >> 9) & 1) << 5)); }
__host__ __device__ __forceinline__ void stage_rc(int b, int& R, int& C) { const int st = b / 1024, sb = b % 1024, swz = sb ^ (((sb >> 9) & 1) << 5); R = (st >> 1) * 16 + swz / 64; C = (st & 1) * 32 + (swz % 64) / 2; }
__host__ __device__ __forceinline__ int perm32(int rho) { const int n = rho >> 4, i = rho & 15; return 8 * (i >> 2) + 4 * n + (i & 3); }

struct Unit { int pm, pn; };
struct Gemm { const bf16_t* A; const bf16_t* Bt; int M, N, K; };

struct StaticOrder {
    int nM, nN, nwg, G, c;
    __host__ __device__ void init(int M, int N, int G_, int c_) { nM = M / BM; nN = N / BM; nwg = nM * nN; G = G_; c = c_; }
    __host__ __device__ bool next(int i, Unit& u) const {
        const long L = (long)i * G + c; if (L >= nwg) return false;
        int wgid = (int)L; { const int q = nwg / NXCD, r = nwg % NXCD, xcd = wgid % NXCD, off = wgid / NXCD; wgid = (xcd < r ? xcd * (q + 1) : r * (q + 1) + (xcd - r) * q) + off; }
        const int nig = WGM * nN, gid = wgid / nig, fm = gid * WGM, gsz = (nM - fm) < WGM ? (nM - fm) : WGM;
        u.pm = fm + ((wgid % nig) % gsz); u.pn = (wgid % nig) / gsz; return true;
    }
    __device__ __forceinline__ void a_ready(const Unit&) const {}
    __device__ __forceinline__ void done(const Unit&) const {}
};

__device__ __forceinline__ unsigned cvt_pk_bf16(float lo, float hi) { unsigned r; asm volatile("v_cvt_pk_bf16_f32 %0, %1, %2" : "=v"(r) : "v"(lo), "v"(hi)); return r; }
typedef float f32x2 __attribute__((ext_vector_type(2)));
__device__ __forceinline__ f32x2 gelu_pk(f32x2 v) {
    const f32x2 av = __builtin_elementwise_abs(v), d = av * 0.2316418882f + 1.0f;
    f32x2 t; t.x = __builtin_amdgcn_rcpf(d.x); t.y = __builtin_amdgcn_rcpf(d.y);
    f32x2 q = t * 0.5307027145f + (-0.7265760135f); q = q * t + 0.7107068705f; q = q * t + (-0.142248368f); q = q * t + 0.127414796f; q = q * t;
    const f32x2 s = (v * v) * (-0.72134752044f);
    f32x2 e; e.x = __builtin_amdgcn_exp2f(s.x); e.y = __builtin_amdgcn_exp2f(s.y);
    const f32x2 m = v * (q * e), r = v - m;
    f32x2 o; o.x = v.x < 0.f ? m.x : r.x; o.y = v.y < 0.f ? m.y : r.y; return o;
}

template <int ACT  > struct EpiBf16 {
    static constexpr bool PERM = true, AFTER_DRAIN = false; static_assert(ACT == 0 || ACT == 1, "EpiBf16: ACT is 0 (none) or 1 (gelu_pk)");
    bf16_t* O; int ldc; const float* bias; int split_cols; size_t split_stride; float scale0;
    __device__ __forceinline__ void operator()(const f32x4 (&acc)[2][2][4][2], const Unit& u, int wr, int wc, int fr, int fq) const {
        const int row0 = u.pm * BM + wr * 64 + fr; int colt = u.pn * BM; bf16_t* base = O;
        float sc = 1.f; if (split_cols) { const int t = colt / split_cols; base += (size_t)t * split_stride; colt -= t * split_cols; if (t == 0) sc = scale0; }
        const int col0 = colt + wc * 32 + 8 * fq, bcol0 = u.pn * BM + wc * 32 + 8 * fq;
        f32x4 bv[2][2];
#pragma unroll
        for (int bj = 0; bj < 2; ++bj)
#pragma unroll
            for (int n = 0; n < 2; ++n) bv[bj][n] = bias ? *(const f32x4*)(bias + bcol0 + bj * HALF + 4 * n) : (f32x4){0.f, 0.f, 0.f, 0.f};
#pragma unroll
        for (int ai = 0; ai < 2; ++ai)
#pragma unroll
            for (int m = 0; m < 4; ++m) { bf16_t* rowp = base + (size_t)(row0 + ai * HALF + m * 16) * ldc + col0;
#pragma unroll
                for (int bj = 0; bj < 2; ++bj) { f32x4 v0 = acc[ai][bj][m][0] + bv[bj][0], v1 = acc[ai][bj][m][1] + bv[bj][1];
                    if (ACT == 1) { f32x2 a = gelu_pk((f32x2){v0[0], v0[1]}), b = gelu_pk((f32x2){v0[2], v0[3]}), c = gelu_pk((f32x2){v1[0], v1[1]}), d = gelu_pk((f32x2){v1[2], v1[3]});
                        v0 = (f32x4){a.x, a.y, b.x, b.y}; v1 = (f32x4){c.x, c.y, d.x, d.y}; }
                    v0 = v0 * sc; v1 = v1 * sc; u32x4 w; w.x = cvt_pk_bf16(v0[0], v0[1]); w.y = cvt_pk_bf16(v0[2], v0[3]); w.z = cvt_pk_bf16(v1[0], v1[1]); w.w = cvt_pk_bf16(v1[2], v1[3]);
                    *(u32x4*)(rowp + bj * HALF) = w; } }
    }
};

struct PanelStats {
    unsigned* xbuf;
    unsigned* cnt;
    unsigned* tmo;
    int ntn; float eps;
    unsigned code;
    __device__ __forceinline__ bool run(const f32x4 (&v)[2][2][4][2], const Unit& u, int wr, int wc, int fr, int fq, PG8_LAS unsigned char* lds, int wid, int lane) const {
        typedef float f32x2v __attribute__((ext_vector_type(2)));
        PG8_LAS f32x2v* P = (PG8_LAS f32x2v*)lds;
        PG8_LAS f32x2v* S = (PG8_LAS f32x2v*)(lds + 8192);
        PG8_LAS unsigned* flag = (PG8_LAS unsigned*)(lds + 8192 + 2048);
#pragma unroll
        for (int ai = 0; ai < 2; ++ai)
#pragma unroll
            for (int m = 0; m < 4; ++m) {
                float s = 0.f;
#pragma unroll
                for (int bj = 0; bj < 2; ++bj)
#pragma unroll
                    for (int n = 0; n < 2; ++n) { const f32x4 x = v[ai][bj][m][n]; s += (x[0] + x[1]) + (x[2] + x[3]); }
                s += __shfl_xor(s, 16); s += __shfl_xor(s, 32);
                const float mw = s * (1.0f / 64.0f); float q = 0.f;
#pragma unroll
                for (int bj = 0; bj < 2; ++bj)
#pragma unroll
                    for (int n = 0; n < 2; ++n) { const f32x4 d = v[ai][bj][m][n] - mw; q += (d[0] * d[0] + d[1] * d[1]) + (d[2] * d[2] + d[3] * d[3]); }
                q += __shfl_xor(q, 16); q += __shfl_xor(q, 32);
                if (fq == 0) P[(ai * HALF + wr * 64 + m * 16 + fr) * 4 + wc] = (f32x2v){mw, q};
            }
        asm volatile("s_waitcnt lgkmcnt(0)" ::: "memory"); __builtin_amdgcn_s_barrier(); asm volatile("" ::: "memory");
#if defined(BROKEN_EXCHANGE_NO_WAIT)
#warning BROKEN CONTROL BUILD: the row-statistics exchange does not wait; results are wrong by design
        if (blockIdx.x >= 64) { const long long t0_ = clock64(); while (clock64() - t0_ < 60000) __builtin_amdgcn_s_sleep(8); }
#endif
        const int row = wid * 32 + (lane & 31);
        if (lane < 32) {
            const f32x2v a = P[row * 4 + 0], b = P[row * 4 + 1], c = P[row * 4 + 2], d = P[row * 4 + 3];
            const float mt = (a.x + b.x + c.x + d.x) * 0.25f;
            const float da = a.x - mt, db = b.x - mt, dc = c.x - mt, dd = d.x - mt;
            const float m2 = (a.y + b.y) + (c.y + d.y) + 64.0f * ((da * da + db * db) + (dc * dc + dd * dd));
            unsigned long long* slot = (unsigned long long*)xbuf + ((size_t)(u.pm * BM + row) * 4 + u.pn);
            __hip_atomic_store(slot, ((unsigned long long)__float_as_uint(m2) << 32) | __float_as_uint(mt), __ATOMIC_RELAXED, __HIP_MEMORY_SCOPE_AGENT);
        }
        asm volatile("s_waitcnt vmcnt(0)" ::: "memory");
        if (lane == 0) __hip_atomic_fetch_add(cnt + 64 * u.pm, 1u, __ATOMIC_RELAXED, __HIP_MEMORY_SCOPE_AGENT);
        if (wid == 0) {
            bool dead = false; const unsigned long long t0 = __builtin_amdgcn_s_memrealtime(); const unsigned want = 8u * (unsigned)ntn;
            for (;;) {
#if defined(BROKEN_EXCHANGE_NO_WAIT)
                break;
#endif
                if ((unsigned)__builtin_amdgcn_readfirstlane(__hip_atomic_load(cnt + 64 * u.pm, __ATOMIC_RELAXED, __HIP_MEMORY_SCOPE_AGENT)) >= want) break;
                if (__builtin_amdgcn_s_memrealtime() - t0 > 2000000ull) {
                    if (lane == 0) { unsigned expect = 0u; __hip_atomic_compare_exchange_strong(tmo + 1, &expect, code | (unsigned)(u.pm & 0xff), __ATOMIC_RELAXED, __ATOMIC_RELAXED, __HIP_MEMORY_SCOPE_AGENT);
                                     __hip_atomic_store(tmo, 1u, __ATOMIC_RELAXED, __HIP_MEMORY_SCOPE_AGENT); }
                    dead = true; break; }
                __builtin_amdgcn_s_sleep(2);
            }
            __builtin_amdgcn_fence(__ATOMIC_ACQUIRE, "agent");
            if (lane == 0) flag[0] = dead ? 1u : 0u;
        }
        asm volatile("s_waitcnt vmcnt(0) lgkmcnt(0)" ::: "memory"); __builtin_amdgcn_s_barrier(); asm volatile("" ::: "memory");
        const bool bad = flag[0] != 0u;
        if (lane < 32) {
            const unsigned long long* slot = (const unsigned long long*)xbuf + (size_t)(u.pm * BM + row) * 4; float mt[4], m2[4]; float ms = 0.f;
#pragma unroll
            for (int t = 0; t < 4; ++t) { if (t < ntn) { const unsigned long long w = __hip_atomic_load(slot + t, __ATOMIC_RELAXED, __HIP_MEMORY_SCOPE_AGENT); mt[t] = __uint_as_float((unsigned)w); m2[t] = __uint_as_float((unsigned)(w >> 32)); } else { mt[t] = 0.f; m2[t] = 0.f; } ms += mt[t]; }
            const float mean = ms / (float)ntn; float q = 0.f;
#pragma unroll
            for (int t = 0; t < 4; ++t) if (t < ntn) { const float dm = mt[t] - mean; q += m2[t] + 256.0f * dm * dm; }
            S[row] = (f32x2v){mean, 1.0f / sqrtf(q / (256.0f * (float)ntn) + eps)};
        }
        asm volatile("s_waitcnt lgkmcnt(0)" ::: "memory"); __builtin_amdgcn_s_barrier(); asm volatile("" ::: "memory");
        return bad;
    }
};
struct EpiLnRes {
    static constexpr bool PERM = false, AFTER_DRAIN = true;
    const float* base; float* out; int ldc; const float* bias; PanelStats st; unsigned poison;
    __device__ __forceinline__ void fused(f32x4 (&acc)[2][2][4][2], const Unit& u, int wr, int wc, int fr, int fq, PG8_LAS unsigned char* lds, int wid, int lane) const {
        typedef float f32x2v __attribute__((ext_vector_type(2)));
        const PG8_LAS f32x2v* S = (const PG8_LAS f32x2v*)(lds + 8192);
        const int col0 = u.pn * BM + wc * 32 + 4 * fq;
#pragma unroll
        for (int bj = 0; bj < 2; ++bj)
#pragma unroll
            for (int n = 0; n < 2; ++n) { const f32x4 bv = bias ? *(const f32x4*)(bias + col0 + bj * HALF + n * 16) : (f32x4){0.f, 0.f, 0.f, 0.f};
#pragma unroll
                for (int ai = 0; ai < 2; ++ai)
#pragma unroll
                    for (int m = 0; m < 4; ++m) acc[ai][bj][m][n] += bv; }
        f32x4 pre[4][2][2];
#pragma unroll
        for (int m = 0; m < 4; ++m) { const size_t off = (size_t)(u.pm * BM + wr * 64 + m * 16 + fr) * ldc + col0;
#pragma unroll
            for (int bj = 0; bj < 2; ++bj)
#pragma unroll
                for (int n = 0; n < 2; ++n) pre[m][bj][n] = *(const f32x4*)(base + off + bj * HALF + n * 16); }
        const bool bad = st.run(acc, u, wr, wc, fr, fq, lds, wid, lane) || poison != 0u;
        const float qnan = __builtin_nanf("");
#pragma unroll
        for (int ai = 0; ai < 2; ++ai)
#pragma unroll
            for (int m = 0; m < 4; ++m) { const int r = ai * HALF + wr * 64 + m * 16 + fr; const f32x2v sr = S[r]; const size_t off = (size_t)(u.pm * BM + r) * ldc + col0;
#pragma unroll
                for (int bj = 0; bj < 2; ++bj)
#pragma unroll
                    for (int n = 0; n < 2; ++n) { const f32x4 bs = ai == 0 ? pre[m][bj][n] : *(const f32x4*)(base + off + bj * HALF + n * 16); f32x4 o = bs + (acc[ai][bj][m][n] - sr.x) * sr.y;
                        if (bad) o = (f32x4){qnan, qnan, qnan, qnan}; *(f32x4*)(out + off + bj * HALF + n * 16) = o; }
                if (m & 1) asm volatile("" ::: "memory"); }
    }
};
struct EpiLnResLn {
    static constexpr bool PERM = false, AFTER_DRAIN = true;
    const float* base; float* out; bf16_t* xn; int ldc; const float* bias; PanelStats st1, st2; unsigned poison;
    __device__ __forceinline__ void fused(f32x4 (&acc)[2][2][4][2], const Unit& u, int wr, int wc, int fr, int fq, PG8_LAS unsigned char* lds, int wid, int lane) const {
        typedef float f32x2v __attribute__((ext_vector_type(2))); typedef unsigned u32x2v __attribute__((ext_vector_type(2)));
        const PG8_LAS f32x2v* S = (const PG8_LAS f32x2v*)(lds + 8192);
        const int col0 = u.pn * BM + wc * 32 + 4 * fq;
#pragma unroll
        for (int bj = 0; bj < 2; ++bj)
#pragma unroll
            for (int n = 0; n < 2; ++n) { const f32x4 bv = bias ? *(const f32x4*)(bias + col0 + bj * HALF + n * 16) : (f32x4){0.f, 0.f, 0.f, 0.f};
#pragma unroll
                for (int ai = 0; ai < 2; ++ai)
#pragma unroll
                    for (int m = 0; m < 4; ++m) acc[ai][bj][m][n] += bv; }
        bool bad = st1.run(acc, u, wr, wc, fr, fq, lds, wid, lane) || poison != 0u;
        const float qnan = __builtin_nanf("");
#pragma unroll
        for (int ai = 0; ai < 2; ++ai)
#pragma unroll
            for (int m = 0; m < 4; ++m) { const int r = ai * HALF + wr * 64 + m * 16 + fr; const f32x2v sr = S[r]; const size_t off = (size_t)(u.pm * BM + r) * ldc + col0;
#pragma unroll
                for (int bj = 0; bj < 2; ++bj)
#pragma unroll
                    for (int n = 0; n < 2; ++n) { const f32x4 bs = *(const f32x4*)(base + off + bj * HALF + n * 16); acc[ai][bj][m][n] = bs + (acc[ai][bj][m][n] - sr.x) * sr.y; }
                asm volatile("" : "+v"(acc[ai][0][m][0]), "+v"(acc[ai][0][m][1]), "+v"(acc[ai][1][m][0]), "+v"(acc[ai][1][m][1]));
                if (m & 1) asm volatile("" ::: "memory"); }
        const bool bad1 = bad;
        bad = st2.run(acc, u, wr, wc, fr, fq, lds, wid, lane) || bad;
#pragma unroll
        for (int ai = 0; ai < 2; ++ai)
#pragma unroll
            for (int m = 0; m < 4; ++m) { const int r = ai * HALF + wr * 64 + m * 16 + fr; const f32x2v sr = S[r]; const size_t off = (size_t)(u.pm * BM + r) * ldc + col0;
#pragma unroll
                for (int bj = 0; bj < 2; ++bj)
#pragma unroll
                    for (int n = 0; n < 2; ++n) { const f32x4 x1 = acc[ai][bj][m][n]; *(f32x4*)(out + off + bj * HALF + n * 16) = bad1 ? (f32x4){qnan, qnan, qnan, qnan} : x1;
                        const f32x4 o = (x1 - sr.x) * sr.y; u32x2v w; w.x = cvt_pk_bf16(o[0], o[1]); w.y = cvt_pk_bf16(o[2], o[3]);
                        if (bad) { w.x = 0x7fc07fc0u; w.y = 0x7fc07fc0u; } *(u32x2v*)(xn + off + bj * HALF + n * 16) = w; }
                asm volatile("" ::: "memory"); }
    }
};

template <class Epi, class Sched, bool ALIGN_EPI = false, bool SP2 = false>
__device__ __forceinline__ void gemm_phase(PG8_LAS unsigned char* lds, const Gemm g, const Sched& S, const Epi& E) {
    const int tid = tidx(), wid = __builtin_amdgcn_readfirstlane(tid >> 6), lane = tid & 63, wr = wid >> 2, wc = wid & 3, fr = lane & 15, fq = lane >> 4;
    const int K = g.K, nt = K / BK;
    unsigned voffA[2], voffB[2];
#pragma unroll
    for (int i = 0; i < 2; ++i) { int R, C; stage_rc(tid * 16 + i * 8192, R, C); const int Rb = Epi::PERM ? ((R & ~31) + perm32(R & 31)) : R;
        voffA[i] = (unsigned)(R * K + C) * 2u; voffB[i] = (unsigned)(Rb * K + C) * 2u; }
    const size_t kstep = (size_t)(BK * 2);
    const size_t hstep = (size_t)HALF * K * 2;
    const size_t tstep = 2 * hstep;
    const unsigned ldsw = (unsigned)wid * 1024u;
    const int aoff = lds_byte(wr * 64 + fr, fq * 8), boff = lds_byte(wc * 32 + fr, fq * 8);
#define PG8_SA(b, h) (((b) * 2 + (h)) * HTB)
#define PG8_SB(b, h) ((4 + (b) * 2 + (h)) * HTB)
#define PG8_STAGE(bufoff, gbase, voff) do { _Pragma("unroll") for (int _i = 0; _i < 2; ++_i) \
        __builtin_amdgcn_global_load_lds((const unsigned*)((const char*)(gbase) + (voff)[_i]), (PG8_LAS unsigned*)(lds + (bufoff) + ldsw + _i * 8192), 16, 0, 0); } while (0)
#define PG8_LDA(dst, b, h) do { _Pragma("unroll") for (int m = 0; m < 4; ++m) _Pragma("unroll") for (int k = 0; k < 2; ++k) dst[m][k] = *(const PG8_LAS bf16x8*)(lds + PG8_SA(b, h) + aoff + m * 2048 + k * 1024); } while (0)
#define PG8_LDB(dst, b, h) do { _Pragma("unroll") for (int n = 0; n < 2; ++n) _Pragma("unroll") for (int k = 0; k < 2; ++k) dst[n][k] = *(const PG8_LAS bf16x8*)(lds + PG8_SB(b, h) + boff + n * 2048 + k * 1024); } while (0)
#define PG8_MMA(ai, bj, At, Bt) do { __builtin_amdgcn_s_setprio(1); _Pragma("unroll") for (int m = 0; m < 4; ++m) _Pragma("unroll") for (int n = 0; n < 2; ++n) _Pragma("unroll") for (int k = 0; k < 2; ++k) \
        acc[ai][bj][m][n] = __builtin_amdgcn_mfma_f32_16x16x32_bf16(Bt[n][k], At[m][k], acc[ai][bj][m][n], 0, 0, 0); __builtin_amdgcn_s_setprio(0); } while (0)
#define PG8_WAIT_V(n) asm volatile("s_waitcnt vmcnt(" #n ")" ::: "memory")
#define PG8_WAIT_L(n) asm volatile("s_waitcnt lgkmcnt(" #n ")" ::: "memory")
#define PG8_BAR __builtin_amdgcn_s_barrier()
#define PG8_SCHED __builtin_amdgcn_sched_barrier(0)
    Unit cur, nxt; int ui = 0;
    if (!S.next(0, cur)) return;
    E.prefetch(cur, tid, lds + 135168);
    f32x4 acc[2][2][4][2];
#pragma unroll
    for (int a = 0; a < 2; ++a)
#pragma unroll
        for (int b = 0; b < 2; ++b)
#pragma unroll
            for (int m = 0; m < 4; ++m)
#pragma unroll
                for (int n = 0; n < 2; ++n) acc[a][b][m][n] = (f32x4){0.f, 0.f, 0.f, 0.f};
    bf16x8 At[4][2], B0[2][2], B1[2][2];
    const char* cA = (const char*)g.A + (size_t)cur.pm * tstep; const char* cB = (const char*)g.Bt + (size_t)cur.pn * tstep;
    S.a_ready(cur);
    if constexpr (SP2) {
        PG8_STAGE(PG8_SB(0, 0), cB, voffB); PG8_STAGE(PG8_SB(0, 1), cB + hstep, voffB); PG8_STAGE(PG8_SA(0, 0), cA, voffA); PG8_STAGE(PG8_SA(0, 1), cA + hstep, voffA);
        if (wr == 1) PG8_BAR;
        PG8_WAIT_V(2); PG8_BAR;
        PG8_STAGE(PG8_SB(1, 0), cB + kstep, voffB); PG8_STAGE(PG8_SA(1, 0), cA + kstep, voffA); PG8_STAGE(PG8_SB(1, 1), cB + hstep + kstep, voffB);
        PG8_WAIT_V(6); PG8_BAR;
    } else {
        PG8_STAGE(PG8_SB(0, 0), cB, voffB); PG8_STAGE(PG8_SA(0, 0), cA, voffA); PG8_STAGE(PG8_SB(0, 1), cB + hstep, voffB); PG8_STAGE(PG8_SA(0, 1), cA + hstep, voffA);
        if (wr == 1) PG8_BAR;
        PG8_WAIT_V(4); PG8_BAR;
        PG8_STAGE(PG8_SB(1, 0), cB + kstep, voffB); PG8_STAGE(PG8_SA(1, 0), cA + kstep, voffA); PG8_STAGE(PG8_SB(1, 1), cB + hstep + kstep, voffB);
        PG8_WAIT_V(6); PG8_BAR;
    }
    for (;;) {
        const bool has_next = S.next(ui + 1, nxt);
        const char* nA = has_next ? (const char*)g.A + (size_t)nxt.pm * tstep : cA; const char* nB = has_next ? (const char*)g.Bt + (size_t)nxt.pn * tstep : cB;
        for (int t = 0; t < nt; t += 2) {
            const bool last = (t == nt - 2);
            const char* a1 = cA + (size_t)(t + 1) * kstep;
            const char* a2 = last ? nA : cA + (size_t)(t + 2) * kstep; const char* b2 = last ? nB : cB + (size_t)(t + 2) * kstep;
            const char* a3 = a2 + kstep; const char* b3 = b2 + kstep;
            if (last && has_next) S.a_ready(nxt);
            if constexpr (SP2) {
            PG8_LDB(B0, 0, 0); PG8_LDB(B1, 0, 1); PG8_SCHED; PG8_LDA(At, 0, 0); PG8_STAGE(PG8_SA(1, 1), a1 + hstep, voffA);
            PG8_WAIT_V(8); PG8_WAIT_L(0); PG8_BAR; PG8_MMA(0, 0, At, B0); PG8_MMA(0, 1, At, B1); PG8_BAR; PG8_SCHED;
            PG8_LDA(At, 0, 1); PG8_STAGE(PG8_SB(0, 0), b2, voffB); PG8_STAGE(PG8_SB(0, 1), b2 + hstep, voffB); PG8_STAGE(PG8_SA(0, 0), a2, voffA);
            PG8_WAIT_V(8); PG8_WAIT_L(0); PG8_BAR; PG8_MMA(1, 0, At, B0); PG8_MMA(1, 1, At, B1); PG8_BAR; PG8_SCHED;
            PG8_LDB(B0, 1, 0); PG8_LDB(B1, 1, 1); PG8_SCHED; PG8_LDA(At, 1, 0); PG8_STAGE(PG8_SA(0, 1), a2 + hstep, voffA);
            PG8_WAIT_V(8); PG8_WAIT_L(0); PG8_BAR; PG8_MMA(0, 0, At, B0); PG8_MMA(0, 1, At, B1); PG8_BAR; PG8_SCHED;
            PG8_LDA(At, 1, 1); PG8_STAGE(PG8_SB(1, 0), b3, voffB); PG8_STAGE(PG8_SB(1, 1), b3 + hstep, voffB); PG8_STAGE(PG8_SA(1, 0), a3, voffA);
            PG8_WAIT_V(8); PG8_WAIT_L(0); PG8_BAR; PG8_MMA(1, 0, At, B0); PG8_MMA(1, 1, At, B1); PG8_BAR; PG8_SCHED;
            } else {
            PG8_LDB(B0, 0, 0); PG8_SCHED; PG8_LDA(At, 0, 0); PG8_STAGE(PG8_SA(1, 1), a1 + hstep, voffA);
            PG8_WAIT_L(8); PG8_BAR; PG8_WAIT_L(0); PG8_MMA(0, 0, At, B0); PG8_BAR; PG8_SCHED;
            PG8_LDB(B1, 0, 1); PG8_STAGE(PG8_SB(0, 0), b2, voffB);
            PG8_BAR; PG8_WAIT_L(0); PG8_MMA(0, 1, At, B1); PG8_BAR;
            PG8_LDA(At, 0, 1); PG8_STAGE(PG8_SA(0, 0), a2, voffA);
            PG8_BAR; PG8_WAIT_L(0); PG8_MMA(1, 0, At, B0); PG8_BAR; PG8_SCHED;
            PG8_STAGE(PG8_SB(0, 1), b2 + hstep, voffB);
            PG8_WAIT_V(6); PG8_BAR; PG8_MMA(1, 1, At, B1); PG8_BAR;
            PG8_LDB(B0, 1, 0); PG8_SCHED; PG8_LDA(At, 1, 0); PG8_STAGE(PG8_SA(0, 1), a2 + hstep, voffA);
            PG8_WAIT_L(8); PG8_BAR; PG8_WAIT_L(0); PG8_MMA(0, 0, At, B0); PG8_BAR; PG8_SCHED;
            PG8_LDB(B1, 1, 1); PG8_STAGE(PG8_SB(1, 0), b3, voffB);
            PG8_BAR; PG8_WAIT_L(0); PG8_MMA(0, 1, At, B1); PG8_BAR;
            PG8_LDA(At, 1, 1); PG8_STAGE(PG8_SA(1, 0), a3, voffA);
            PG8_BAR; PG8_WAIT_L(0); PG8_MMA(1, 0, At, B0); PG8_BAR; PG8_SCHED;
            PG8_STAGE(PG8_SB(1, 1), b3 + hstep, voffB);
            PG8_WAIT_V(6); PG8_BAR; PG8_MMA(1, 1, At, B1); PG8_BAR;
            }
        }
        if constexpr (ALIGN_EPI) { if (wr == 0) PG8_BAR; }
        if constexpr (!Epi::AFTER_DRAIN) { E(acc, cur, wr, wc, fr, fq, lds + 135168 + (ui & 1) * 4096); if (has_next) E.prefetch(nxt, tid, lds + 135168 + ((ui + 1) & 1) * 4096); S.done(cur); }
        if (!has_next) break;
#pragma unroll
        for (int a = 0; a < 2; ++a)
#pragma unroll
            for (int b = 0; b < 2; ++b)
#pragma unroll
                for (int m = 0; m < 4; ++m)
#pragma unroll
                    for (int n = 0; n < 2; ++n) acc[a][b][m][n] = (f32x4){0.f, 0.f, 0.f, 0.f};
        cur = nxt; cA = nA; cB = nB; ++ui;
        if constexpr (ALIGN_EPI) { if (wr == 1) PG8_BAR; }
    }
    PG8_WAIT_V(0);
    if constexpr (!ALIGN_EPI) { if (wr == 0) PG8_BAR; }
    PG8_BAR;
    if constexpr (Epi::AFTER_DRAIN) { E.fused(acc, cur, wr, wc, fr, fq, lds, wid, lane); S.done(cur); }
#undef PG8_SA
#undef PG8_SB
#undef PG8_STAGE
#undef PG8_LDA
#undef PG8_LDB
#undef PG8_MMA
#undef PG8_WAIT_V
#undef PG8_WAIT_L
#undef PG8_BAR
#undef PG8_SCHED
}
}

#define LAS __attribute__((address_space(3)))
typedef unsigned short bf16_t;
typedef short bf16x8 __attribute__((ext_vector_type(8)));
typedef short s16x4 __attribute__((ext_vector_type(4)));
typedef short v4i16_t __attribute__((ext_vector_type(4)));
typedef float f32x4 __attribute__((ext_vector_type(4)));
typedef float f32x16 __attribute__((ext_vector_type(16)));
typedef unsigned u32x4 __attribute__((ext_vector_type(4)));
typedef unsigned u32x2 __attribute__((ext_vector_type(2)));

constexpr int DM = 1024, NB = 8, SEQ = 8192, NMETA = 16, LSEQ = SEQ + NMETA, MREAL = NB * SEQ, MROW0 = MREAL, MPAD = MREAL + 256;
constexpr int FF = 2816, NPB = 3584, NPBW = 3840, DPROJ = 5640;
constexpr int NCH = 65;
constexpr float ALPHA = 1.41421356237f;
constexpr float LOG2E = 1.4426950408889634f;
constexpr float QSCALE = 0.125f * LOG2E;
constexpr float NEGF = -1e30f;
constexpr float LN_EPS = 1e-5f;

constexpr size_t OW_GU1 = 0, OW_D1 = 5767168, OW_PB = 8650752, OW_GM = 12582912, OW_BM = 14680064, OW_BA = 15204352, OW_OUT = 15728640, OW_GU2 = 16777216, OW_D2 = 22544384, OW_LAYER = 25427968;
constexpr int OC_GU1 = 0, OC_PB = 5632, OC_GM = 9472, OC_GU2 = 11520, OC_N = 17152;
constexpr size_t MiB = 1u << 20;
constexpr size_t WS_ROWS = 0;
constexpr size_t WS_CSBW = 4 * MiB;
constexpr size_t WS_HFM = 5 * MiB;
constexpr size_t WS_GATES = 6 * MiB;
constexpr size_t WS_BAR = 9 * MiB;
constexpr size_t WS_KM = WS_BAR + 16384;
constexpr size_t WS_SC = 10 * MiB;
constexpr size_t WS_NST = 11 * MiB;
constexpr size_t WS_STATS = 13 * MiB;
constexpr size_t WS_W = 16 * MiB;
constexpr size_t WS_HB = 113 * MiB;
constexpr size_t WS_LO = 242 * MiB;
constexpr size_t WS_CST = 371 * MiB;
constexpr size_t WS_MA = 436 * MiB;
constexpr size_t WS_BIG = 565 * MiB;
constexpr size_t WS_END = 1015 * MiB;

struct Params {
    const float* in[28];
    float* out; unsigned char* ws;
};

__device__ __forceinline__ unsigned f2bf(float f) { unsigned u = __builtin_bit_cast(unsigned, f); return (u + 0x7fffu + ((u >> 16) & 1u)) >> 16; }
typedef float f32x2_t __attribute__((ext_vector_type(2))); typedef __bf16 bf16x2_t __attribute__((ext_vector_type(2)));
__device__ __forceinline__ unsigned pk2(float lo, float hi) { f32x2_t v = {lo, hi}; bf16x2_t b = __builtin_convertvector(v, bf16x2_t); return __builtin_bit_cast(unsigned, b); }
__device__ __forceinline__ u32x4 pack8(f32x4 a, f32x4 b) { u32x4 w; w.x = pk2(a[0], a[1]); w.y = pk2(a[2], a[3]); w.z = pk2(b[0], b[1]); w.w = pk2(b[2], b[3]); return w; }
__device__ __forceinline__ float bflo(unsigned w) { return __builtin_bit_cast(float, w << 16); }
__device__ __forceinline__ float bfhi(unsigned w) { return __builtin_bit_cast(float, w & 0xffff0000u); }
__device__ __forceinline__ float ex2(float x) { return __builtin_amdgcn_exp2f(x); }
__device__ __forceinline__ float sigm(float x) { return __builtin_amdgcn_rcpf(1.f + ex2(-x * LOG2E)); }
__device__ __forceinline__ float siluf(float x) { return x * sigm(x); }
__device__ __forceinline__ float wave_sum(float v) {
#pragma unroll
    for (int o = 1; o < 64; o <<= 1) v += __shfl_xor(v, o);
    return v;
}
__device__ __forceinline__ float wave_max(float v) {
#pragma unroll
    for (int o = 1; o < 64; o <<= 1) v = fmaxf(v, __shfl_xor(v, o));
    return v;
}
__device__ __forceinline__ size_t seqrow(int b, int pos) { return pos < NMETA ? (size_t)(MROW0 + pos) : (size_t)b * SEQ + (size_t)(pos - NMETA); }
__device__ __forceinline__ f32x16 mfma32(bf16x8 a, bf16x8 b, f32x16 c) { return __builtin_amdgcn_mfma_f32_32x32x16_bf16(a, b, c, 0, 0, 0); }
__device__ __forceinline__ s16x4 vtr(const LAS unsigned char* p) { return __builtin_bit_cast(s16x4, __builtin_amdgcn_ds_read_tr16_b64_v4i16((LAS v4i16_t*)p)); }
__device__ __forceinline__ bf16x8 cat8(s16x4 lo, s16x4 hi) { return (bf16x8){lo[0], lo[1], lo[2], lo[3], hi[0], hi[1], hi[2], hi[3]}; }

namespace pg8 {
__device__ __forceinline__ void tab_prefetch(const float* rows, const float* v0, const float* v1, int pm, int cbase, int tid, PG8_LAS unsigned char* tab) {
    const int wid = __builtin_amdgcn_readfirstlane(tid >> 6), lane = tid & 63;
    if (rows) __builtin_amdgcn_global_load_lds((const unsigned*)(rows + (size_t)pm * 512 + tid), (PG8_LAS unsigned*)(tab + wid * 256), 4, 0, 0);
    const float* src = (wid < 4 ? v0 + (wid * 64 + lane) : v1 + ((wid - 4) * 64 + lane)) + cbase;
    __builtin_amdgcn_global_load_lds((const unsigned*)src, (PG8_LAS unsigned*)(tab + 2048 + wid * 256), 4, 0, 0);
}
__device__ __forceinline__ void tab_ready() { asm volatile("s_waitcnt vmcnt(14)" ::: "memory"); __builtin_amdgcn_s_barrier(); asm volatile("" ::: "memory"); }
__device__ __forceinline__ void tab_stats(const PG8_LAS unsigned char* tab, int rloc, float& mu, float& r) {
    const f32x2_t st = *(const PG8_LAS f32x2_t*)(tab + rloc * 8); mu = st.x * (1.f / DM); r = __builtin_amdgcn_rsqf(st.y * (1.f / DM) - mu * mu + LN_EPS);
}
struct LnFix {
    const float* rows; const float* cs; const float* bw; int on;
    __device__ __forceinline__ void stats(size_t row, float& mu, float& r) const {
        const f32x2_t st = *(const f32x2_t*)(rows + row * 2); mu = st.x * (1.f / DM); r = __builtin_amdgcn_rsqf(st.y * (1.f / DM) - mu * mu + LN_EPS);
    }
};
struct EpiSwiglu {
    static constexpr bool PERM = true, AFTER_DRAIN = false;
    bf16_t* O; int ldc; LnFix fx;
    __device__ __forceinline__ void prefetch(const Unit& u, int tid, PG8_LAS unsigned char* tab) const { if (fx.on) tab_prefetch(fx.rows, fx.cs, fx.bw, u.pm, u.pn * BM, tid, tab); }
    __device__ __forceinline__ void operator()(const f32x4 (&acc)[2][2][4][2], const Unit& u, int wr, int wc, int fr, int fq, const PG8_LAS unsigned char* tab) const {
        const int row0 = u.pm * BM + wr * 64 + fr, col0 = u.pn * 128 + wc * 32 + 8 * fq, cl = wc * 32 + 8 * fq;
        if (fx.on) tab_ready();
#pragma unroll
        for (int ai = 0; ai < 2; ++ai)
#pragma unroll
            for (int m = 0; m < 4; ++m) {
                const size_t row = (size_t)(row0 + ai * HALF + m * 16);
                float mu = 0.f, r = 1.f; if (fx.on) tab_stats(tab, wr * 64 + fr + ai * HALF + m * 16, mu, r);
                u32x4 w;
#pragma unroll
                for (int n = 0; n < 2; ++n) {
                    f32x4 csg = {0.f, 0.f, 0.f, 0.f}, bwg = csg, csu = csg, bwu = csg;
                    if (fx.on) { csg = *(const PG8_LAS f32x4*)(tab + 2048 + (cl + 4 * n) * 4); bwg = *(const PG8_LAS f32x4*)(tab + 3072 + (cl + 4 * n) * 4); csu = *(const PG8_LAS f32x4*)(tab + 2048 + (cl + HALF + 4 * n) * 4); bwu = *(const PG8_LAS f32x4*)(tab + 3072 + (cl + HALF + 4 * n) * 4); }
                    const f32x4 g = (acc[ai][0][m][n] - csg * mu) * r + bwg, up = (acc[ai][1][m][n] - csu * mu) * r + bwu;
                    const unsigned lo = pk2(siluf(g[0]) * up[0], siluf(g[1]) * up[1]), hi = pk2(siluf(g[2]) * up[2], siluf(g[3]) * up[3]);
                    if (n == 0) { w.x = lo; w.y = hi; } else { w.z = lo; w.w = hi; }
                }
                *(u32x4*)(O + row * ldc + col0) = w;
            }
    }
};
struct EpiPlain {
    static constexpr bool PERM = true, AFTER_DRAIN = false;
    bf16_t* O; int ldc; int coff; int slo, shi; float scale; LnFix fx; float* GT; const float* bif;
    __device__ __forceinline__ void prefetch(const Unit& u, int tid, PG8_LAS unsigned char* tab) const { if (fx.on) tab_prefetch(fx.rows, fx.cs, fx.bw, u.pm, u.pn * BM, tid, tab); }
    __device__ __forceinline__ void operator()(const f32x4 (&acc)[2][2][4][2], const Unit& u, int wr, int wc, int fr, int fq, const PG8_LAS unsigned char* tab) const {
        const int row0 = u.pm * BM + wr * 64 + fr, col0 = coff + u.pn * BM + wc * 32 + 8 * fq, cl = wc * 32 + 8 * fq;
        if (fx.on) tab_ready();
        if (GT && u.pn == 14) {
            if (wc == 0 && fq == 0) {
                const f32x4 cs0 = *(const PG8_LAS f32x4*)(tab + 2048 + cl * 4), cs1 = *(const PG8_LAS f32x4*)(tab + 2048 + (cl + 4) * 4);
                const f32x4 bw0 = *(const PG8_LAS f32x4*)(tab + 3072 + cl * 4) + *(const f32x4*)(bif), bw1 = *(const PG8_LAS f32x4*)(tab + 3072 + (cl + 4) * 4) + *(const f32x4*)(bif + 4);
#pragma unroll
                for (int ai = 0; ai < 2; ++ai)
#pragma unroll
                    for (int m = 0; m < 4; ++m) {
                        const size_t row = (size_t)(row0 + ai * HALF + m * 16);
                        float mu, r; tab_stats(tab, wr * 64 + fr + ai * HALF + m * 16, mu, r);
                        const f32x4 li = (acc[ai][0][m][0] - cs0 * mu) * r + bw0, z = (acc[ai][0][m][1] - cs1 * mu) * r + bw1;
                        f32x4 lf;
#pragma unroll
                        for (int e = 0; e < 4; ++e) lf[e] = fminf(z[e], 0.f) - __logf(1.f + __expf(-fabsf(z[e])));
                        *(f32x4*)(GT + row * 8) = li; *(f32x4*)(GT + row * 8 + 4) = lf;
                    }
            }
            return;
        }
        const float sc = (u.pn >= slo && u.pn < shi) ? scale : 1.f;
#pragma unroll
        for (int ai = 0; ai < 2; ++ai)
#pragma unroll
            for (int m = 0; m < 4; ++m) {
                const size_t row = (size_t)(row0 + ai * HALF + m * 16);
                float mu = 0.f, r = 1.f; if (fx.on) tab_stats(tab, wr * 64 + fr + ai * HALF + m * 16, mu, r);
#pragma unroll
                for (int bj = 0; bj < 2; ++bj) {
                    u32x4 w;
#pragma unroll
                    for (int n = 0; n < 2; ++n) {
                        f32x4 cs4 = {0.f, 0.f, 0.f, 0.f}, bw4 = cs4;
                        if (fx.on) { cs4 = *(const PG8_LAS f32x4*)(tab + 2048 + (cl + bj * HALF + 4 * n) * 4); bw4 = *(const PG8_LAS f32x4*)(tab + 3072 + (cl + bj * HALF + 4 * n) * 4); }
                        const f32x4 v = ((acc[ai][bj][m][n] - cs4 * mu) * r + bw4) * sc;
                        if (n == 0) { w.x = pk2(v[0], v[1]); w.y = pk2(v[2], v[3]); } else { w.z = pk2(v[0], v[1]); w.w = pk2(v[2], v[3]); }
                    }
                    *(u32x4*)(O + row * ldc + col0 + bj * HALF) = w;
                }
            }
    }
};
struct EpiResid {
    static constexpr bool PERM = true, AFTER_DRAIN = false;
    const float* src; bf16_t* LO; bf16_t* HB; const float* rows_prev; float* rows_cur; const float* gam; const float* bet; float s; int raw;
    __device__ __forceinline__ void prefetch(const Unit& u, int tid, PG8_LAS unsigned char* tab) const { if (!raw) tab_prefetch(rows_prev, gam, bet, u.pm, u.pn * BM, tid, tab); }
    __device__ __forceinline__ void operator()(const f32x4 (&acc)[2][2][4][2], const Unit& u, int wr, int wc, int fr, int fq, const PG8_LAS unsigned char* tab) const {
        const int row0 = u.pm * BM + wr * 64 + fr, col0 = u.pn * BM + wc * 32 + 8 * fq, cl = wc * 32 + 8 * fq;
        if (!raw) tab_ready();
#pragma unroll
        for (int ai = 0; ai < 2; ++ai)
#pragma unroll
            for (int m = 0; m < 4; ++m) {
                const size_t row = (size_t)(row0 + ai * HALF + m * 16);
                float mu = 0.f, rs = 1.f;
                if (!raw) tab_stats(tab, wr * 64 + fr + ai * HALF + m * 16, mu, rs);
                const float ar = ALPHA * rs, am = -ALPHA * rs * mu;
                float s1 = 0.f, s2 = 0.f;
#pragma unroll
                for (int bj = 0; bj < 2; ++bj) {
                    f32x4 g0 = {1.f, 1.f, 1.f, 1.f}, g1 = g0, b0 = {0.f, 0.f, 0.f, 0.f}, b1 = b0;
                    if (!raw) { g0 = *(const PG8_LAS f32x4*)(tab + 2048 + (cl + bj * HALF) * 4); g1 = *(const PG8_LAS f32x4*)(tab + 2048 + (cl + bj * HALF + 4) * 4); b0 = *(const PG8_LAS f32x4*)(tab + 3072 + (cl + bj * HALF) * 4); b1 = *(const PG8_LAS f32x4*)(tab + 3072 + (cl + bj * HALF + 4) * 4); }
                    f32x4 x0, x1;
                    if (raw) { x0 = *(const f32x4*)(src + row * DM + col0 + bj * HALF); x1 = *(const f32x4*)(src + row * DM + col0 + bj * HALF + 4); }
                    else { const u32x4 hi = *(const u32x4*)(HB + row * DM + col0 + bj * HALF), lo = *(const u32x4*)(LO + row * DM + col0 + bj * HALF);
                        x0 = (f32x4){bflo(hi.x) + bflo(lo.x), bfhi(hi.x) + bfhi(lo.x), bflo(hi.y) + bflo(lo.y), bfhi(hi.y) + bfhi(lo.y)};
                        x1 = (f32x4){bflo(hi.z) + bflo(lo.z), bfhi(hi.z) + bfhi(lo.z), bflo(hi.w) + bflo(lo.w), bfhi(hi.w) + bfhi(lo.w)}; }
                    const f32x4 o0 = (x0 * ar + am) * g0 + b0 * ALPHA + acc[ai][bj][m][0] * s, o1 = (x1 * ar + am) * g1 + b1 * ALPHA + acc[ai][bj][m][1] * s;
                    const u32x4 nh = pack8(o0, o1);
                    const f32x4 d0 = {o0[0] - bflo(nh.x), o0[1] - bfhi(nh.x), o0[2] - bflo(nh.y), o0[3] - bfhi(nh.y)}, d1 = {o1[0] - bflo(nh.z), o1[1] - bfhi(nh.z), o1[2] - bflo(nh.w), o1[3] - bfhi(nh.w)};
                    *(u32x4*)(HB + row * DM + col0 + bj * HALF) = nh; *(u32x4*)(LO + row * DM + col0 + bj * HALF) = pack8(d0, d1);
                    s1 += ((o0[0] + o0[1]) + (o0[2] + o0[3])) + ((o1[0] + o1[1]) + (o1[2] + o1[3]));
                    s2 += ((o0[0] * o0[0] + o0[1] * o0[1]) + (o0[2] * o0[2] + o0[3] * o0[3])) + ((o1[0] * o1[0] + o1[1] * o1[1]) + (o1[2] * o1[2] + o1[3] * o1[3]));
                }
                s1 += __shfl_xor(s1, 16); s1 += __shfl_xor(s1, 32); s2 += __shfl_xor(s2, 16); s2 += __shfl_xor(s2, 32);
                if (fq == 0) { float* rp = rows_cur + row * 2; atomicAdd(rp, s1); atomicAdd(rp + 1, s2); }
                asm volatile("" ::: "memory");
            }
    }
};
struct EpiGate {
    static constexpr bool PERM = true, AFTER_DRAIN = false;
    bf16_t* U; const bf16_t* Y; const float* bg; LnFix fx;
    __device__ __forceinline__ void prefetch(const Unit& u, int tid, PG8_LAS unsigned char* tab) const { tab_prefetch(fx.rows, fx.cs, fx.bw, u.pm, u.pn * BM, tid, tab); }
    __device__ __forceinline__ void operator()(const f32x4 (&acc)[2][2][4][2], const Unit& u, int wr, int wc, int fr, int fq, const PG8_LAS unsigned char* tab) const {
        const int row0 = u.pm * BM + wr * 64 + fr, col0 = u.pn * 128 + wc * 32 + 8 * fq, cl = wc * 32 + 8 * fq;
        tab_ready();
#pragma unroll
        for (int ai = 0; ai < 2; ++ai)
#pragma unroll
            for (int m = 0; m < 4; ++m) {
                const size_t row = (size_t)(row0 + ai * HALF + m * 16);
                float mu, r; tab_stats(tab, wr * 64 + fr + ai * HALF + m * 16, mu, r);
                const u32x4 ym = *(const u32x4*)(Y + row * 2048 + col0), ya = *(const u32x4*)(Y + row * 2048 + DM + col0);
                u32x4 w;
#pragma unroll
                for (int n = 0; n < 2; ++n) {
                    const f32x4 csm = *(const PG8_LAS f32x4*)(tab + 2048 + (cl + 4 * n) * 4), bm = *(const PG8_LAS f32x4*)(tab + 3072 + (cl + 4 * n) * 4);
                    const f32x4 csa = *(const PG8_LAS f32x4*)(tab + 2048 + (cl + HALF + 4 * n) * 4), ba = *(const PG8_LAS f32x4*)(tab + 3072 + (cl + HALF + 4 * n) * 4);
                    const f32x4 gm = (acc[ai][0][m][n] - csm * mu) * r + bm, ga = (acc[ai][1][m][n] - csa * mu) * r + ba;
                    const unsigned y0 = n ? ym.z : ym.x, y1 = n ? ym.w : ym.y, a0 = n ? ya.z : ya.x, a1 = n ? ya.w : ya.y;
                    const unsigned lo = pk2(sigm(gm[0]) * bflo(y0) + sigm(ga[0]) * bflo(a0), sigm(gm[1]) * bfhi(y0) + sigm(ga[1]) * bfhi(a0));
                    const unsigned hi = pk2(sigm(gm[2]) * bflo(y1) + sigm(ga[2]) * bflo(a1), sigm(gm[3]) * bfhi(y1) + sigm(ga[3]) * bfhi(a1));
                    if (n == 0) { w.x = lo; w.y = hi; } else { w.z = lo; w.w = hi; }
                }
                *(u32x4*)(U + row * DM + col0) = w;
            }
    }
};
}

__device__ __forceinline__ f32x4 sg_tile(const bf16_t* A, int lda, const bf16_t* Bt, int K, int n0, int lane) {
    const bf16_t* ap = A + (size_t)(lane & 15) * lda + 8 * (lane >> 4);
    const bf16_t* bp = Bt + (size_t)(n0 + (lane & 15)) * K + 8 * (lane >> 4);
    f32x4 acc = {0.f, 0.f, 0.f, 0.f};
#pragma unroll 8
    for (int k = 0; k < K; k += 32) {
        const bf16x8 a = *(const bf16x8*)(ap + k), b = *(const bf16x8*)(bp + k);
        acc = __builtin_amdgcn_mfma_f32_16x16x32_bf16(a, b, acc, 0, 0, 0);
    }
    return acc;
}

__device__ __forceinline__ f32x4 sg_tile_blk(const bf16_t* A, int lda, const bf16_t* Bt, int K, int n0, int lane, int wid, LAS float* red) {
    const int K8 = K >> 3;
    const bf16_t* ap = A + (size_t)(lane & 15) * lda + 8 * (lane >> 4) + wid * K8;
    const bf16_t* bp = Bt + (size_t)(n0 + (lane & 15)) * K + 8 * (lane >> 4) + wid * K8;
    f32x4 acc = {0.f, 0.f, 0.f, 0.f};
#pragma unroll 1
    for (int k = 0; k < K8; k += 128) {
        bf16x8 av[4], bv[4];
#pragma unroll
        for (int j = 0; j < 4; ++j) { const int kk = k + 32 * j < K8 ? k + 32 * j : k; av[j] = *(const bf16x8*)(ap + kk); bv[j] = *(const bf16x8*)(bp + kk); }
        asm volatile("" : "+v"(av[0]), "+v"(av[1]), "+v"(av[2]), "+v"(av[3]), "+v"(bv[0]), "+v"(bv[1]), "+v"(bv[2]), "+v"(bv[3]));
#pragma unroll
        for (int j = 0; j < 4; ++j) if (k + 32 * j < K8) acc = __builtin_amdgcn_mfma_f32_16x16x32_bf16(av[j], bv[j], acc, 0, 0, 0);
    }
    *(LAS f32x4*)(red + wid * 256 + lane * 4) = acc;
    __syncthreads();
    f32x4 sum = {0.f, 0.f, 0.f, 0.f};
    if (wid == 0) {
#pragma unroll
        for (int w = 0; w < 8; ++w) sum = sum + *(const LAS f32x4*)(red + w * 256 + lane * 4);
    }
    __syncthreads();
    return sum;
}

__device__ __forceinline__ void tr_rows(const float* Wsrc, int ldw, int K, bf16_t* dst, int kb0, int nkb, int nv4, const float* g, const float* bb, float* cs, float* bw, LAS float* scr, int lane, const float* addb = nullptr) {
    float csp[4] = {0.f, 0.f, 0.f, 0.f}, bwp[4] = {0.f, 0.f, 0.f, 0.f};
    const int c = lane & 7;
#pragma unroll 1
    for (int kb = kb0; kb < kb0 + nkb; ++kb) {
        const int k0 = 64 * kb;
        f32x4 vv[8];
        const bool okl = (lane & 7) < nv4; const int n4 = (lane & 7) * 4;
#pragma unroll
        for (int i = 0; i < 8; ++i) vv[i] = *(const f32x4*)(Wsrc + (size_t)(k0 + 8 * i + (lane >> 3)) * ldw + (okl ? n4 : 0));
        asm volatile("" : "+v"(vv[0]), "+v"(vv[1]), "+v"(vv[2]), "+v"(vv[3]), "+v"(vv[4]), "+v"(vv[5]), "+v"(vv[6]), "+v"(vv[7]));
#pragma unroll
        for (int i = 0; i < 8; ++i) { const int kk = 8 * i + (lane >> 3); f32x4 v = vv[i]; if (!okl) v = (f32x4){0.f, 0.f, 0.f, 0.f};
            scr[kk * 33 + n4] = v[0]; scr[kk * 33 + n4 + 1] = v[1]; scr[kk * 33 + n4 + 2] = v[2]; scr[kk * 33 + n4 + 3] = v[3]; }
        f32x4 g0 = {1.f, 1.f, 1.f, 1.f}, g1 = g0, b0 = {0.f, 0.f, 0.f, 0.f}, b1 = b0;
        if (g) { g0 = *(const f32x4*)(g + k0 + 8 * c); g1 = *(const f32x4*)(g + k0 + 8 * c + 4); b0 = *(const f32x4*)(bb + k0 + 8 * c); b1 = *(const f32x4*)(bb + k0 + 8 * c + 4); }
        asm volatile("s_waitcnt lgkmcnt(0)" ::: "memory");
#pragma unroll
        for (int j = 0; j < 4; ++j) {
            const int n = (lane >> 3) + 8 * j; const LAS float* sp = scr + (8 * c) * 33 + n;
            const float x0 = sp[0 * 33], x1 = sp[1 * 33], x2 = sp[2 * 33], x3 = sp[3 * 33], x4 = sp[4 * 33], x5 = sp[5 * 33], x6 = sp[6 * 33], x7 = sp[7 * 33];
            u32x4 o; o.x = pk2(x0 * g0[0], x1 * g0[1]); o.y = pk2(x2 * g0[2], x3 * g0[3]); o.z = pk2(x4 * g1[0], x5 * g1[1]); o.w = pk2(x6 * g1[2], x7 * g1[3]);
            *(u32x4*)(dst + (size_t)n * K + k0 + 8 * c) = o;
            csp[j] += ((bflo(o.x) + bfhi(o.x)) + (bflo(o.y) + bfhi(o.y))) + ((bflo(o.z) + bfhi(o.z)) + (bflo(o.w) + bfhi(o.w)));
            bwp[j] += ((x0 * b0[0] + x1 * b0[1]) + (x2 * b0[2] + x3 * b0[3])) + ((x4 * b1[0] + x5 * b1[1]) + (x6 * b1[2] + x7 * b1[3]));
        }
        asm volatile("s_waitcnt lgkmcnt(0)" ::: "memory");
    }
    if (g) {
#pragma unroll
        for (int j = 0; j < 4; ++j) {
            float a = csp[j], b = bwp[j];
            a += __shfl_xor(a, 1); a += __shfl_xor(a, 2); a += __shfl_xor(a, 4); b += __shfl_xor(b, 1); b += __shfl_xor(b, 2); b += __shfl_xor(b, 4);
            if (c == 0) { cs[(lane >> 3) + 8 * j] = a; bw[(lane >> 3) + 8 * j] = b + (addb ? addb[(lane >> 3) + 8 * j] : 0.f); }
        }
    }
}
constexpr int CW_ITEMS = 824;
__device__ __forceinline__ void conv_weight_item(const Params& P, int layer, int it, LAS float* scr, int lane) {
    bf16_t* W = (bf16_t*)(P.ws + WS_W) + (size_t)layer * OW_LAYER;
    float* CS = (float*)(P.ws + WS_CSBW) + (size_t)layer * 2 * OC_N; float* BW = CS + OC_N;
    const float* wg1 = P.in[2] + (size_t)layer * DM * FF; const float* wu1 = P.in[3] + (size_t)layer * DM * FF; const float* wd1 = P.in[4] + (size_t)layer * FF * DM;
    const float* win = P.in[7] + (size_t)layer * DM * DPROJ;
    const float* wbm = P.in[17] + (size_t)layer * 512 * DM; const float* wba = P.in[18] + (size_t)layer * 512 * DM; const float* wout = P.in[20] + (size_t)layer * DM * DM;
    const float* wg2 = P.in[23] + (size_t)layer * DM * FF; const float* wu2 = P.in[24] + (size_t)layer * DM * FF; const float* wd2 = P.in[25] + (size_t)layer * FF * DM;
    const float* ln1g = P.in[5] + (size_t)layer * DM; const float* ln1b = P.in[6] + (size_t)layer * DM;
    const float* ln2g = P.in[21] + (size_t)layer * DM; const float* ln2b = P.in[22] + (size_t)layer * DM;
    const float* ln3g = layer ? P.in[26] + (size_t)(layer - 1) * DM : nullptr; const float* ln3b = layer ? P.in[27] + (size_t)(layer - 1) * DM : nullptr;
    int r = it;
    if (r < 352) {
        const int second = r >= 176; if (second) r -= 176;
        const int R0 = 32 * r, pn = R0 >> 8, sgu = (R0 >> 7) & 1, i = R0 & 127;
        const float* src = (second ? (sgu ? wu2 : wg2) : (sgu ? wu1 : wg1)) + 128 * pn + i;
        const int oc = second ? OC_GU2 : OC_GU1;
        tr_rows(src, FF, DM, W + (second ? OW_GU2 : OW_GU1) + (size_t)R0 * DM, 0, 16, 8, second ? ln2g : ln3g, second ? ln2b : ln3b, CS + oc + R0, BW + oc + R0, scr, lane); return;
    }
    r -= 352;
    if (r < 192) {
        const int second = r >= 96; if (second) r -= 96;
        const int nb = r / 3, seg = r % 3, R0 = 32 * nb;
        tr_rows((second ? wd2 : wd1) + R0, DM, FF, W + (second ? OW_D2 : OW_D1) + (size_t)R0 * FF, 16 * seg, seg == 2 ? 12 : 16, 8, nullptr, nullptr, nullptr, nullptr, scr, lane); return;
    }
    r -= 192;
    if (r < 120) {
        const int R0 = 32 * r, csrc = R0 < 2048 ? R0 : (R0 < 3584 ? R0 + 8 : 2048);
        tr_rows(win + csrc, DPROJ, DM, W + OW_PB + (size_t)R0 * DM, 0, 16, R0 < 3584 ? 8 : (R0 == 3584 ? 2 : 0), ln1g, ln1b, CS + OC_PB + R0, BW + OC_PB + R0, scr, lane); return;
    }
    r -= 120;
    if (r < 64) {
        const int R0 = 32 * r, pn = R0 >> 8, sg = (R0 >> 7) & 1, i = R0 & 127, csrc = 3592 + 1024 * sg + 128 * pn + i;
        tr_rows(win + csrc, DPROJ, DM, W + OW_GM + (size_t)R0 * DM, 0, 16, 8, ln1g, ln1b, CS + OC_GM + R0, BW + OC_GM + R0, scr, lane, P.in[19] + (size_t)layer * 2048 + 1024 * sg + 128 * pn + i); return;
    }
    r -= 64;
    if (r < 64) {
        const int second = r >= 32; if (second) r -= 32;
        const int R0 = 32 * r;
        tr_rows((second ? wba : wbm) + R0, DM, 512, W + (second ? OW_BA : OW_BM) + (size_t)R0 * 512, 0, 8, 8, nullptr, nullptr, nullptr, nullptr, scr, lane); return;
    }
    r -= 64;
    { const int R0 = 32 * r; tr_rows(wout + R0, DM, DM, W + OW_OUT + (size_t)R0 * DM, 0, 16, 8, nullptr, nullptr, nullptr, nullptr, scr, lane); }
}

__device__ __forceinline__ void ln_row(const f32x4 (&vin)[4], int row, float* hf, const f32x4 (&gv)[4], const f32x4 (&bv)[4], bool gates, bool fin, const float* bif_l, LAS float* gwl, bf16_t* HB, float* ST, float* GT, int lane) {
    f32x4 v[4]; float s = 0.f;
#pragma unroll
    for (int j = 0; j < 4; ++j) { v[j] = vin[j]; s += (v[j][0] + v[j][1]) + (v[j][2] + v[j][3]); }
    const float mean = wave_sum(s) * (1.f / DM); float s2 = 0.f;
#pragma unroll
    for (int j = 0; j < 4; ++j) { v[j] = v[j] - mean; s2 += (v[j][0] * v[j][0] + v[j][1] * v[j][1]) + (v[j][2] * v[j][2] + v[j][3] * v[j][3]); }
    const float rstd = 1.f / sqrtf(wave_sum(s2) * (1.f / DM) + LN_EPS);
    if (lane == 0) { f32x2_t st = {mean, rstd}; *(f32x2_t*)(ST + (size_t)row * 2) = st; }
#pragma unroll
    for (int j = 0; j < 4; ++j) {
        v[j] = v[j] * rstd * gv[j] + bv[j];
        if (fin) *(f32x4*)(hf + 256 * j + 4 * lane) = v[j];
        if (!fin) { u32x2 w; w.x = pk2(v[j][0], v[j][1]); w.y = pk2(v[j][2], v[j][3]); *(u32x2*)(HB + (size_t)row * DM + 256 * j + 4 * lane) = w; }
    }
    if (gates) {
        float mine = 0.f;
#pragma unroll
        for (int g = 0; g < 8; ++g) {
            float d = 0.f;
#pragma unroll
            for (int j = 0; j < 4; ++j) { const f32x4 w4 = *(const LAS f32x4*)(gwl + g * 1024 + 256 * j + 4 * lane); d += (v[j][0] * w4[0] + v[j][1] * w4[1]) + (v[j][2] * w4[2] + v[j][3] * w4[3]); }
            d = wave_sum(d);
            if (lane == g) mine = d;
        }
        if (lane < 8) {
            const float z = mine + bif_l[lane];
            float o = z;
            if (lane >= 4) o = fminf(z, 0.f) - __logf(1.f + __expf(-fabsf(z)));
            GT[(size_t)row * 8 + lane] = o;
        }
    }
}
__device__ __forceinline__ void ln_phase(const Params& P, const float* gam, const float* bet, bool gates, bool fin, const float* win_l, const float* bif_l, LAS unsigned char* lds) {
    const int tid = tidx(), lane = tid & 63, wid = tid >> 6;
    float* hfm = (float*)(P.ws + WS_HFM); bf16_t* HB = (bf16_t*)(P.ws + WS_HB); float* GT = (float*)(P.ws + WS_GATES); float* ST = (float*)(P.ws + WS_STATS);
    LAS float* gwl = (LAS float*)lds;
    if (gates) {
        for (int idx = tid; idx < 8192; idx += 512) { const int k = idx >> 3, g = idx & 7; gwl[g * 1024 + k] = win_l[(size_t)k * DPROJ + 2048 + g]; }
        __syncthreads();
    }
    const int gw = bidx() * 8 + wid, NGW = gridDim.x * 8;
    f32x4 gv[4], bv[4];
#pragma unroll
    for (int j = 0; j < 4; ++j) { gv[j] = *(const f32x4*)(gam + 256 * j + 4 * lane); bv[j] = *(const f32x4*)(bet + 256 * j + 4 * lane); }
    constexpr int NR = MREAL;
    int row = 4 * gw;
    u32x2 ah[4][4], al[4][4];
#define LN_ROWP(r_) (P.out + (size_t)(r_) * DM)
    const bf16_t* LOp = (const bf16_t*)(P.ws + WS_LO);
#define LN_LOADRAW(h_, l_, r_, j_) do { h_ = *(const u32x2*)(HB + (size_t)(r_) * DM + 256 * (j_) + 4 * lane); l_ = *(const u32x2*)(LOp + (size_t)(r_) * DM + 256 * (j_) + 4 * lane); } while (0)
#define LN_COMB(dst_, hi_, lo_) dst_ = (f32x4){bflo(hi_.x) + bflo(lo_.x), bfhi(hi_.x) + bfhi(lo_.x), bflo(hi_.y) + bflo(lo_.y), bfhi(hi_.y) + bfhi(lo_.y)}
    if (row < NR) {
#pragma unroll
        for (int q4 = 0; q4 < 4; ++q4) {
#pragma unroll
            for (int j = 0; j < 4; ++j) LN_LOADRAW(ah[q4][j], al[q4][j], row + q4, j); }
    }
    while (row < NR) {
        f32x4 ca[4][4];
#pragma unroll
        for (int q4 = 0; q4 < 4; ++q4)
#pragma unroll
            for (int j = 0; j < 4; ++j) LN_COMB(ca[q4][j], ah[q4][j], al[q4][j]);
        const int nrow = row + 4 * NGW;
        if (nrow < NR) {
#pragma unroll
            for (int q4 = 0; q4 < 4; ++q4) {
#pragma unroll
                for (int j = 0; j < 4; ++j) LN_LOADRAW(ah[q4][j], al[q4][j], nrow + q4, j); }
        }
#pragma unroll
        for (int q4 = 0; q4 < 4; ++q4) ln_row(ca[q4], row + q4, LN_ROWP(row + q4), gv, bv, gates, fin, bif_l, gwl, HB, ST, GT, lane);
        row = nrow;
    }
#undef LN_ROWP
#undef LN_LOADRAW
#undef LN_COMB
}

__device__ __forceinline__ void conv8(const bf16_t* PB, const float* cw, const float* cb, int b, int pos, int chn, f32x4& o0, f32x4& o1) {
    o0 = *(const f32x4*)(cb + chn); o1 = *(const f32x4*)(cb + chn + 4);
#pragma unroll
    for (int j = 0; j < 4; ++j) {
        const int pp = pos - 3 + j;
        if (pp >= 0) {
            const u32x4 u = *(const u32x4*)(PB + seqrow(b, pp) * NPB + chn);
            const f32x4 w0 = *(const f32x4*)(cw + j * 1024 + chn), w1 = *(const f32x4*)(cw + j * 1024 + chn + 4);
            o0[0] += w0[0] * bflo(u.x); o0[1] += w0[1] * bfhi(u.x); o0[2] += w0[2] * bflo(u.y); o0[3] += w0[3] * bfhi(u.y);
            o1[0] += w1[0] * bflo(u.z); o1[1] += w1[1] * bfhi(u.z); o1[2] += w1[2] * bflo(u.w); o1[3] += w1[3] * bfhi(u.w);
        }
    }
#pragma unroll
    for (int e = 0; e < 4; ++e) { o0[e] = siluf(o0[e]); o1[e] = siluf(o1[e]); }
}
struct ConvW { f32x4 w[4][2]; f32x4 b[2]; };
__device__ __forceinline__ void convw_load(ConvW& cw8, const float* cw, const float* cb, int chn) {
    cw8.b[0] = *(const f32x4*)(cb + chn); cw8.b[1] = *(const f32x4*)(cb + chn + 4);
#pragma unroll
    for (int j = 0; j < 4; ++j) { cw8.w[j][0] = *(const f32x4*)(cw + j * 1024 + chn); cw8.w[j][1] = *(const f32x4*)(cw + j * 1024 + chn + 4); }
}
__device__ __forceinline__ void conv8w(const bf16_t* PB, const ConvW& cw8, int b, int pos, int chn, f32x4& o0, f32x4& o1) {
    o0 = cw8.b[0]; o1 = cw8.b[1];
    u32x4 u4[4];
#pragma unroll
    for (int j = 0; j < 4; ++j) {
        const int pp = pos - 3 + j;
        u4[j] = *(const u32x4*)(PB + seqrow(b, pp < 0 ? 0 : pp) * NPB + chn);
    }
#pragma unroll
    for (int j = 0; j < 4; ++j) {
        const bool ok = pos - 3 + j >= 0;
        const u32x4 u = {ok ? u4[j].x : 0u, ok ? u4[j].y : 0u, ok ? u4[j].z : 0u, ok ? u4[j].w : 0u};
        const f32x4 w0 = cw8.w[j][0], w1 = cw8.w[j][1];
        o0[0] += w0[0] * bflo(u.x); o0[1] += w0[1] * bfhi(u.x); o0[2] += w0[2] * bflo(u.y); o0[3] += w0[3] * bfhi(u.y);
        o1[0] += w1[0] * bflo(u.z); o1[1] += w1[1] * bfhi(u.z); o1[2] += w1[2] * bflo(u.w); o1[3] += w1[3] * bfhi(u.w);
    }
#pragma unroll
    for (int e = 0; e < 4; ++e) { o0[e] = siluf(o0[e]); o1[e] = siluf(o1[e]); }
}

__device__ __forceinline__ float wscan_add(float v, int lane) {
#pragma unroll
    for (int o = 1; o < 64; o <<= 1) { const float t = __shfl_up(v, o); if (lane >= o) v += t; }
    return v;
}
__device__ __forceinline__ float wscan_max(float v, int lane) {
#pragma unroll
    for (int o = 1; o < 64; o <<= 1) { const float t = __shfl_up(v, o); if (lane >= o) v = fmaxf(v, t); }
    return v;
}

__device__ __forceinline__ void lds_barrier() { asm volatile("s_waitcnt lgkmcnt(0)\n\ts_barrier" ::: "memory"); }

constexpr int TSTR = 320;
constexpr int RSTR = 272;
__device__ __forceinline__ void m1_unit(const Params& P, int layer, int bh, int c, LAS unsigned char* lds) {
    const int tid = tidx(), lane = tid & 63, wid = __builtin_amdgcn_readfirstlane(tid >> 6);
    const int b = bh >> 2, hh = bh & 3;
    const int nvalid = c == 0 ? NMETA : 128, p0 = c == 0 ? 0 : NMETA + 128 * (c - 1);
    const int nrep = c == 0 ? NB : 1;
    const bf16_t* PB = (const bf16_t*)(P.ws + WS_BIG); const float* GT = (const float*)(P.ws + WS_GATES);
    float* SC = (float*)(P.ws + WS_SC); float* NST = (float*)(P.ws + WS_NST); bf16_t* CST = (bf16_t*)(P.ws + WS_CST);
    const float* cw = P.in[8] + (size_t)layer * 4 * 1024; const float* cb = P.in[9] + (size_t)layer * 1024;
    LAS unsigned char* Kt = lds; LAS unsigned char* Vt = lds + 128 * TSTR; LAS float* sws = (LAS float*)(lds + 2 * 128 * TSTR);
    float li0 = NEGF, li1 = NEGF, lf0 = 0.f, lf1 = 0.f;
    if (wid == 0) {
        const int i0 = 2 * lane, i1 = i0 + 1;
        const size_t rw0 = seqrow(b, p0 + (i0 < nvalid ? i0 : 0)), rw1 = seqrow(b, p0 + (i1 < nvalid ? i1 : 0));
        li0 = GT[rw0 * 8 + hh]; lf0 = GT[rw0 * 8 + 4 + hh]; li1 = GT[rw1 * 8 + hh]; lf1 = GT[rw1 * 8 + 4 + hh];
        if (i0 >= nvalid) { li0 = NEGF; lf0 = 0.f; } if (i1 >= nvalid) { li1 = NEGF; lf1 = 0.f; }
    }
    ConvW ckw; convw_load(ckw, cw, cb, 512 + hh * 128 + 8 * (tid & 15));
    f32x4 kc0[4], kc1[4]; u32x4 vraw[4];
#pragma unroll
    for (int it = 0; it < 4; ++it) {
        const int item = tid + 512 * it, i = item >> 4, ch = item & 15;
        const int ic = i < nvalid ? i : nvalid - 1;
        conv8w(PB, ckw, b, p0 + ic, 512 + hh * 128 + 8 * ch, kc0[it], kc1[it]);
        vraw[it] = *(const u32x4*)(PB + seqrow(b, p0 + ic) * NPB + 1024 + hh * 128 + 8 * ch);
    }
    if (wid == 0) {
        const int i0 = 2 * lane, i1 = i0 + 1;
        const float s = lf0 + lf1, incl = wscan_add(s, lane), excl = incl - s;
        const float b0 = excl + lf0, b1 = incl, g0 = li0 - b0, g1 = li1 - b1;
        const float gmax = wave_max(fmaxf(g0, g1));
        sws[i0] = i0 < nvalid ? ex2((g0 - gmax) * LOG2E) : 0.f;
        sws[i1] = i1 < nvalid ? ex2((g1 - gmax) * LOG2E) : 0.f;
        const float bend = __shfl(incl, 63);
        if (lane == 0) { for (int bb = 0; bb < nrep; ++bb) { SC[(size_t)((bh + 4 * bb) * NCH + c) * 2] = bend; SC[(size_t)((bh + 4 * bb) * NCH + c) * 2 + 1] = bend + gmax; } }
    }
    __syncthreads();
#pragma unroll
    for (int it = 0; it < 4; ++it) {
        const int item = tid + 512 * it, i = item >> 4, ch = item & 15;
        const float sc = 0.08838834764831845f * sws[i];
        u32x4 kw = pack8(kc0[it] * sc, kc1[it] * sc), vw = vraw[it];
        if (i >= nvalid) { kw = (u32x4){0u, 0u, 0u, 0u}; vw = kw; }
        *(LAS u32x4*)(Kt + i * TSTR + ch * 16) = kw; *(LAS u32x4*)(Vt + i * TSTR + ch * 16) = vw;
    }
    __syncthreads();
    {
        const int h = lane >> 5, g = lane >> 4, q = (lane & 15) >> 2, pp = lane & 3;
        const int dkt = wid >> 1, dvt0 = (wid & 1) * 2;
        f32x16 acc[2];
#pragma unroll
        for (int t = 0; t < 2; ++t)
#pragma unroll
            for (int e = 0; e < 16; ++e) acc[t][e] = 0.f;
#pragma unroll
        for (int ks = 0; ks < 8; ++ks) {
            const int rowa = 16 * ks + 8 * h + q;
            const LAS unsigned char* ka = Kt + rowa * TSTR + (32 * dkt + 16 * (g & 1) + 4 * pp) * 2;
            const bf16x8 af = cat8(vtr(ka), vtr(ka + 4 * TSTR));
#pragma unroll
            for (int t = 0; t < 2; ++t) {
                const LAS unsigned char* va = Vt + rowa * TSTR + (32 * (dvt0 + t) + 16 * (g & 1) + 4 * pp) * 2;
                const bf16x8 bf = cat8(vtr(va), vtr(va + 4 * TSTR));
                acc[t] = mfma32(af, bf, acc[t]);
            }
        }
#pragma unroll
        for (int t = 0; t < 2; ++t) {
            const int dv = 32 * (dvt0 + t) + (lane & 31);
#pragma unroll
            for (int r4 = 0; r4 < 4; ++r4) {
                const int dk0 = 32 * dkt + 8 * r4 + 4 * h;
                u32x2 w; w.x = pk2(acc[t][4 * r4], acc[t][4 * r4 + 1]); w.y = pk2(acc[t][4 * r4 + 2], acc[t][4 * r4 + 3]);
                for (int bb = 0; bb < nrep; ++bb) *(u32x2*)(CST + (size_t)((bh + 4 * bb) * NCH + c) * 16384 + (size_t)dv * 128 + dk0) = w;
            }
        }
    }
    {
        LAS float* red = sws + 256;
        const int dk = tid & 127, part = tid >> 7;
        float sacc = 0.f;
#pragma unroll 8
        for (int i = 0; i < 32; ++i) sacc += __builtin_bit_cast(float, (unsigned)(*(const LAS unsigned short*)(Kt + (32 * part + i) * TSTR + dk * 2)) << 16);
        red[part * 128 + dk] = sacc;
        __syncthreads();
        if (tid < 128) { const float nsum = (red[tid] + red[128 + tid]) + (red[256 + tid] + red[384 + tid]); for (int bb = 0; bb < nrep; ++bb) NST[(size_t)((bh + 4 * bb) * NCH + c) * 128 + tid] = nsum; }
    }
    lds_barrier();
}

__device__ __forceinline__ void m2_phase(const Params& P) {
    float* SC = (float*)(P.ws + WS_SC); float* MST = SC + 32 * NCH * 2; float* NST = (float*)(P.ws + WS_NST); bf16_t* CST = (bf16_t*)(P.ws + WS_CST);
    const int NT = gridDim.x * 512;
    for (int task = bidx() * 512 + tidx(); task < 65536 + 4096; task += NT) {
        if (task < 65536) {
            const int bh = task >> 11, e8 = task & 2047;
            bf16_t* ptr = CST + (size_t)bh * NCH * 16384 + (size_t)e8 * 8;
            float run[8];
#pragma unroll
            for (int e = 0; e < 8; ++e) run[e] = 0.f;
            float m = NEGF;
#pragma unroll 1
            for (int c0 = 0; c0 < NCH; c0 += 5) {
                u32x4 loc[5]; float bendv[5], mlocv[5];
#pragma unroll
                for (int j = 0; j < 5; ++j) { loc[j] = *(const u32x4*)(ptr + (size_t)(c0 + j) * 16384); bendv[j] = SC[(size_t)(bh * NCH + c0 + j) * 2]; mlocv[j] = SC[(size_t)(bh * NCH + c0 + j) * 2 + 1]; }
#pragma unroll
                for (int j = 0; j < 5; ++j) {
                    const int c = c0 + j;
                    const float bend = bendv[j], mloc = mlocv[j];
                    const float mn = fmaxf(bend + m, mloc), a = ex2((bend + m - mn) * LOG2E), bt = ex2((mloc - mn) * LOG2E);
                    u32x4 w; w.x = pk2(run[0], run[1]); w.y = pk2(run[2], run[3]); w.z = pk2(run[4], run[5]); w.w = pk2(run[6], run[7]);
                    *(u32x4*)(ptr + (size_t)c * 16384) = w;
                    run[0] = a * run[0] + bt * bflo(loc[j].x); run[1] = a * run[1] + bt * bfhi(loc[j].x);
                    run[2] = a * run[2] + bt * bflo(loc[j].y); run[3] = a * run[3] + bt * bfhi(loc[j].y);
                    run[4] = a * run[4] + bt * bflo(loc[j].z); run[5] = a * run[5] + bt * bfhi(loc[j].z);
                    run[6] = a * run[6] + bt * bflo(loc[j].w); run[7] = a * run[7] + bt * bfhi(loc[j].w);
                    if (e8 == 0) MST[bh * NCH + c] = m;
                    m = mn;
                }
            }
        } else {
            const int t2 = task - 65536, bh = t2 >> 7, dk = t2 & 127;
            float* ptr = NST + (size_t)bh * NCH * 128 + dk;
            float run = 0.f, m = NEGF;
#pragma unroll 1
            for (int c0 = 0; c0 < NCH; c0 += 13) {
                float locv[13], bendv[13], mlocv[13];
#pragma unroll
                for (int j = 0; j < 13; ++j) { locv[j] = ptr[(size_t)(c0 + j) * 128]; bendv[j] = SC[(size_t)(bh * NCH + c0 + j) * 2]; mlocv[j] = SC[(size_t)(bh * NCH + c0 + j) * 2 + 1]; }
#pragma unroll
                for (int j = 0; j < 13; ++j) {
                    const float mn = fmaxf(bendv[j] + m, mlocv[j]), a = ex2((bendv[j] + m - mn) * LOG2E), bt = ex2((mlocv[j] - mn) * LOG2E);
                    ptr[(size_t)(c0 + j) * 128] = run; run = a * run + bt * locv[j]; m = mn;
                }
            }
        }
    }
}

__device__ __forceinline__ void m3_unit(const Params& P, int layer, int bh, int c, LAS unsigned char* lds) {
    const int tid = tidx(), lane = tid & 63, wid = __builtin_amdgcn_readfirstlane(tid >> 6);
    const int b = bh >> 2, hh = bh & 3;
    const int nvalid = c == 0 ? NMETA : 128, p0 = c == 0 ? 0 : NMETA + 128 * (c - 1);
    const bf16_t* PB = (const bf16_t*)(P.ws + WS_BIG); const float* GT = (const float*)(P.ws + WS_GATES);
    const float* SC = (const float*)(P.ws + WS_SC); const float* MST = SC + 32 * NCH * 2; const float* NST = (const float*)(P.ws + WS_NST); const bf16_t* CST = (const bf16_t*)(P.ws + WS_CST);
    bf16_t* MA = (bf16_t*)(P.ws + WS_MA);
    const float* cw = P.in[8] + (size_t)layer * 4 * 1024; const float* cb = P.in[9] + (size_t)layer * 1024; const float* mng = P.in[11] + (size_t)layer * 512;
    LAS unsigned char* Qt = lds; LAS unsigned char* Kt = lds + 128 * RSTR; LAS unsigned char* Vt = lds + 2 * 128 * RSTR;
    LAS float* sg2 = (LAS float*)(lds + 2 * 128 * RSTR + 128 * TSTR); LAS float* sr2 = sg2 + 128; LAS float* sw = sg2 + 256; LAS float* semt = sg2 + 384; LAS float* sqn = sg2 + 512;
    LAS float* sst = sg2 + 640; LAS float* sst2 = sg2 + 896; LAS float* snp = sg2 + 1152;
    constexpr int CT_OFF = 116736;
    {
        const bf16_t* Cp = CST + (size_t)(bh * NCH + c) * 16384;
#pragma unroll
        for (int k = 0; k < 4; ++k) {
            const int S = (k * 8 + wid) * 64 + lane, row = S >> 4, cch = (S & 15) ^ (row & 15);
            __builtin_amdgcn_global_load_lds((const unsigned*)(Cp + (size_t)row * 128 + cch * 8), (LAS unsigned*)(lds + CT_OFF + (k * 8 + wid) * 1024), 16, 0, 0);
        }
    }
    const float npv = tid < 128 ? NST[(size_t)(bh * NCH + c) * 128 + tid] : 0.f;
    float li0 = NEGF, li1 = NEGF, lf0 = 0.f, lf1 = 0.f, mprev = 0.f;
    if (wid == 0) {
        const int i0 = 2 * lane, i1 = i0 + 1;
        const size_t rw0 = seqrow(b, p0 + (i0 < nvalid ? i0 : 0)), rw1 = seqrow(b, p0 + (i1 < nvalid ? i1 : 0));
        li0 = GT[rw0 * 8 + hh]; lf0 = GT[rw0 * 8 + 4 + hh]; li1 = GT[rw1 * 8 + hh]; lf1 = GT[rw1 * 8 + 4 + hh];
        if (i0 >= nvalid) { li0 = NEGF; lf0 = 0.f; } if (i1 >= nvalid) { li1 = NEGF; lf1 = 0.f; }
        mprev = MST[bh * NCH + c];
    }
    ConvW cqw, ckw; convw_load(cqw, cw, cb, hh * 128 + 8 * (tid & 15)); convw_load(ckw, cw, cb, 512 + hh * 128 + 8 * (tid & 15));
    if (wid == 0) {
        const int i0 = 2 * lane, i1 = i0 + 1;
        const float s = lf0 + lf1, incl = wscan_add(s, lane), excl = incl - s;
        const float b0 = excl + lf0, b1 = incl, g0 = li0 - b0, g1 = li1 - b1;
        const float inclm = wscan_max(fmaxf(g0, g1), lane);
        float exclm = __shfl_up(inclm, 1); if (lane == 0) exclm = NEGF;
        const float cm0 = fmaxf(exclm, g0), cm1 = inclm;
        const float M0 = fmaxf(mprev, cm0), M1 = fmaxf(mprev, cm1);
        sg2[i0] = g0 * LOG2E; sg2[i1] = g1 * LOG2E; sr2[i0] = -M0 * LOG2E; sr2[i1] = -M1 * LOG2E;
        sw[i0] = ex2((mprev - M0) * LOG2E); sw[i1] = ex2((mprev - M1) * LOG2E);
        semt[i0] = ex2(-(b0 + M0) * LOG2E); semt[i1] = ex2(-(b1 + M1) * LOG2E);
    }
#pragma unroll
    for (int it = 0; it < 4; ++it) {
        const int item = tid + 512 * it, i = item >> 4, ch = item & 15;
        u32x4 qw, kw, vw;
        {
            const int ic = i < nvalid ? i : nvalid - 1;
            f32x4 o0, o1;
            conv8w(PB, cqw, b, p0 + ic, hh * 128 + 8 * ch, o0, o1); qw = pack8(o0, o1);
            conv8w(PB, ckw, b, p0 + ic, 512 + hh * 128 + 8 * ch, o0, o1); kw = pack8(o0 * 0.08838834764831845f, o1 * 0.08838834764831845f);
            vw = *(const u32x4*)(PB + seqrow(b, p0 + ic) * NPB + 1024 + hh * 128 + 8 * ch);
            if (i >= nvalid) { qw = (u32x4){0u, 0u, 0u, 0u}; kw = qw; vw = qw; }
        }
        *(LAS u32x4*)(Qt + i * RSTR + ch * 16) = qw; *(LAS u32x4*)(Kt + i * RSTR + ch * 16) = kw; *(LAS u32x4*)(Vt + i * TSTR + ch * 16) = vw;
    }
    if (tid < 128) snp[tid] = npv;
    asm volatile("s_waitcnt vmcnt(0)" ::: "memory");
    __syncthreads();
    const int r = lane & 31, h = lane >> 5, g = lane >> 4, q = (lane & 15) >> 2, pp = lane & 3;
    const int qb = wid >> 1, dvh = wid & 1, t = 32 * qb + r;
    u32x2 mo_[2][4]; f32x4 gn_[2][4];
    {
        const size_t rowp = seqrow(b, p0 + (t < nvalid ? t : 0));
#pragma unroll
        for (int d = 0; d < 2; ++d)
#pragma unroll
            for (int r4 = 0; r4 < 4; ++r4) {
                const int col = hh * 128 + 32 * (2 * dvh + d) + 8 * r4 + 4 * h;
                mo_[d][r4] = *(const u32x2*)(PB + rowp * NPB + 1536 + col); gn_[d][r4] = *(const f32x4*)(mng + col);
            }
    }
    {
        const int i = tid >> 2, part = tid & 3;
        const LAS float* np = snp + 32 * part;
        float s = 0.f;
#pragma unroll
        for (int d8 = 0; d8 < 4; ++d8) {
            const u32x4 qv = *(const LAS u32x4*)(Qt + i * RSTR + (32 * part + 8 * d8) * 2);
            const f32x4 n0 = *(const LAS f32x4*)(np + 8 * d8), n1 = *(const LAS f32x4*)(np + 8 * d8 + 4);
            s += bflo(qv.x) * n0[0] + bfhi(qv.x) * n0[1] + bflo(qv.y) * n0[2] + bfhi(qv.y) * n0[3] + bflo(qv.z) * n1[0] + bfhi(qv.z) * n1[1] + bflo(qv.w) * n1[2] + bfhi(qv.w) * n1[3];
        }
        s += __shfl_xor(s, 1); s += __shfl_xor(s, 2);
        if (part == 0) sqn[i] = s;
    }
    bf16x8 qf[8];
#pragma unroll
    for (int ks = 0; ks < 8; ++ks) qf[ks] = *(const LAS bf16x8*)(Qt + t * RSTR + (16 * ks + 8 * h) * 2);
    f32x16 acc[2];
#pragma unroll
    for (int d = 0; d < 2; ++d)
#pragma unroll
        for (int e = 0; e < 16; ++e) acc[d][e] = 0.f;
    {
#pragma unroll
        for (int ks = 0; ks < 8; ++ks)
#pragma unroll
            for (int d = 0; d < 2; ++d) {
                const int dv = 32 * (2 * dvh + d) + r;
                const bf16x8 cf = *(const LAS bf16x8*)(lds + CT_OFF + (dv * 16 + ((2 * ks + h) ^ (dv & 15))) * 16);
                acc[d] = mfma32(cf, qf[ks], acc[d]);
            }
    }
    __syncthreads();
    const float wt = sw[t], r2 = sr2[t];
#pragma unroll
    for (int d = 0; d < 2; ++d) acc[d] = acc[d] * wt;
    float den = 0.f;
#pragma unroll 1
    for (int kb = 0; kb <= qb; ++kb) {
        f32x16 st;
#pragma unroll
        for (int e = 0; e < 16; ++e) st[e] = 0.f;
#pragma unroll
        for (int ks = 0; ks < 8; ++ks) { const bf16x8 kf = *(const LAS bf16x8*)(Kt + (32 * kb + r) * RSTR + (16 * ks + 8 * h) * 2); st = mfma32(kf, qf[ks], st); }
#pragma unroll
        for (int r4 = 0; r4 < 4; ++r4) {
            const int s0 = 32 * kb + 8 * r4 + 4 * h;
            const f32x4 gs = *(const LAS f32x4*)(sg2 + s0);
#pragma unroll
            for (int e = 0; e < 4; ++e) {
                float v = st[4 * r4 + e] * ex2(r2 + gs[e]);
                if (s0 + e > t) v = 0.f;
                den += v; st[4 * r4 + e] = v;
            }
        }
#pragma unroll
        for (int s2 = 0; s2 < 2; ++s2) {
            u32x4 pw; pw.x = pk2(st[8 * s2], st[8 * s2 + 1]); pw.y = pk2(st[8 * s2 + 2], st[8 * s2 + 3]); pw.z = pk2(st[8 * s2 + 4], st[8 * s2 + 5]); pw.w = pk2(st[8 * s2 + 6], st[8 * s2 + 7]);
            const bf16x8 pf = __builtin_bit_cast(bf16x8, pw);
#pragma unroll
            for (int d = 0; d < 2; ++d) {
                const LAS unsigned char* va = Vt + (32 * kb + 16 * s2 + 4 * h + q) * TSTR + (32 * (2 * dvh + d) + 16 * (g & 1) + 4 * pp) * 2;
                const bf16x8 vf = cat8(vtr(va), vtr(va + 8 * TSTR));
                acc[d] = mfma32(vf, pf, acc[d]);
            }
        }
    }
    den += __shfl_xor(den, 32);
    den += wt * sqn[t];
    const float inv = 1.f / fmaxf(fabsf(den), semt[t]);
    float s1 = 0.f;
#pragma unroll
    for (int d = 0; d < 2; ++d)
#pragma unroll
        for (int e = 0; e < 16; ++e) { acc[d][e] *= inv; s1 += acc[d][e]; }
    s1 += __shfl_xor(s1, 32);
    if (h == 0) sst[wid * 32 + r] = s1;
    __syncthreads();
    const float mean = (s1 + sst[(wid ^ 1) * 32 + r]) * (1.f / 128.f);
    float q2 = 0.f;
#pragma unroll
    for (int d = 0; d < 2; ++d)
#pragma unroll
        for (int e = 0; e < 16; ++e) { acc[d][e] -= mean; q2 += acc[d][e] * acc[d][e]; }
    q2 += __shfl_xor(q2, 32);
    if (h == 0) sst2[wid * 32 + r] = q2;
    __syncthreads();
    const float rstd = 1.f / sqrtf((q2 + sst2[(wid ^ 1) * 32 + r]) * (1.f / 128.f) + LN_EPS);
    if (t < nvalid) {
        const size_t row = seqrow(b, p0 + t);
#pragma unroll
        for (int d = 0; d < 2; ++d)
#pragma unroll
            for (int r4 = 0; r4 < 4; ++r4) {
                const int col = hh * 128 + 32 * (2 * dvh + d) + 8 * r4 + 4 * h;
                const u32x2 mo = mo_[d][r4];
                const f32x4 g4 = gn_[d][r4];
                const float o0 = acc[d][4 * r4] * rstd * g4[0] * sigm(bflo(mo.x)), o1 = acc[d][4 * r4 + 1] * rstd * g4[1] * sigm(bfhi(mo.x));
                const float o2 = acc[d][4 * r4 + 2] * rstd * g4[2] * sigm(bflo(mo.y)), o3 = acc[d][4 * r4 + 3] * rstd * g4[3] * sigm(bfhi(mo.y));
                u32x2 w; w.x = pk2(o0, o1); w.y = pk2(o2, o3);
                *(u32x2*)(MA + row * 512 + col) = w;
            }
    }
    lds_barrier();
}

constexpr int AT_KB = 64 * RSTR, AT_VB = 64 * TSTR, AT_BUF = AT_KB + AT_VB;
__device__ __forceinline__ void attn_unit(const Params& P, int layer, int b, int hd, int pq0, int nvalid, float lam, float lam_init, LAS unsigned char* lds) {
    const int tid = tidx(), lane = tid & 63, wid = __builtin_amdgcn_readfirstlane(tid >> 6);
    const int c = wid >> 2, wq = wid & 3, r = lane & 31, h = lane >> 5, g = lane >> 4, q = (lane & 15) >> 2, pp = lane & 3;
    const bf16_t* PB = (const bf16_t*)(P.ws + WS_BIG); bf16_t* AO = (bf16_t*)(P.ws + WS_MA) + (size_t)MPAD * 512;
    const float* ang = P.in[16] + (size_t)layer * 512;
    const int qi = 32 * wq + r, qp = pq0 + qi;
    bf16x8 qf[4];
    {
        const size_t qrow = seqrow(b, qp < LSEQ ? qp : LSEQ - 1);
#pragma unroll
        for (int ks = 0; ks < 4; ++ks) qf[ks] = *(const bf16x8*)(PB + qrow * NPB + 2048 + hd * 128 + c * 64 + 16 * ks + 8 * h);
    }
    const float slope2 = ex2(-2.f * (float)(hd + 1)) * LOG2E;
    const int ntiles = (pq0 + nvalid - 1) / 64 + 1;
    u32x4 pk[2], pv[2];
#define AT_LOAD(kt) do { _Pragma("unroll") for (int i_ = 0; i_ < 2; ++i_) { const int row_ = (tid + 512 * i_) >> 4, ch_ = tid & 15; int kp_ = 64 * (kt) + row_; kp_ = kp_ < LSEQ ? kp_ : LSEQ - 1; \
        const bf16_t* src_ = PB + seqrow(b, kp_) * NPB + hd * 128 + ch_ * 8; pk[i_] = *(const u32x4*)(src_ + 2560); pv[i_] = *(const u32x4*)(src_ + 3072); } } while (0)
#define AT_STORE(s) do { _Pragma("unroll") for (int i_ = 0; i_ < 2; ++i_) { const int row_ = (tid + 512 * i_) >> 4, ch_ = tid & 15; \
        *(LAS u32x4*)(lds + (s) * AT_BUF + row_ * RSTR + ch_ * 16) = pk[i_]; *(LAS u32x4*)(lds + (s) * AT_BUF + AT_KB + row_ * TSTR + ch_ * 16) = pv[i_]; } } while (0)
    AT_LOAD(ntiles - 1);
    float qkb;
    {
        float ss = 0.f;
#pragma unroll
        for (int ks = 0; ks < 4; ++ks)
#pragma unroll
            for (int j = 0; j < 8; ++j) { const float v = __builtin_bit_cast(float, (unsigned)(unsigned short)qf[ks][j] << 16); ss += v * v; }
        ss += __shfl_xor(ss, 32);
        const float* KM = (const float*)(P.ws + WS_KM) + layer * 72;
        const float k2 = fmaxf(KM[b * 8 + hd * 2 + c], KM[64 + hd * 2 + c]);
        qkb = sqrtf(ss) * sqrtf(k2) * 1.001f + 0.01f;
    }
    LAS unsigned* votes = (LAS unsigned*)(lds + 131072 + 2048);
    if (tid < 16) votes[tid] = 0u;
    AT_STORE((ntiles - 1) & 1);
    __syncthreads();
    float m_run = NEGF, l_run = 0.f;
    f32x16 o[4];
#pragma unroll
    for (int d = 0; d < 4; ++d)
#pragma unroll
        for (int e = 0; e < 16; ++e) o[d][e] = 0.f;
#pragma unroll 1
    for (int kt = ntiles - 1; kt >= 0; --kt) {
        const int s = kt & 1;
        if (kt > 0) AT_LOAD(kt - 1);
        const LAS unsigned char* Kb = lds + s * AT_BUF; const LAS unsigned char* Vb = Kb + AT_KB;
        if (64 * kt <= pq0 + 32 * wq + 31) {
        f32x16 st[2];
#pragma unroll
        for (int kb2 = 0; kb2 < 2; ++kb2) {
            const float tb = slope2 * (float)(64 * kt + 32 * kb2 - pq0 + 4 * h);
#pragma unroll
            for (int e = 0; e < 16; ++e) st[kb2][e] = tb + slope2 * (float)((e & 3) + 8 * (e >> 2));
#pragma unroll
            for (int ks = 0; ks < 4; ++ks) { const bf16x8 kf = *(const LAS bf16x8*)(Kb + (32 * kb2 + r) * RSTR + (c * 64 + 16 * ks + 8 * h) * 2); st[kb2] = mfma32(kf, qf[ks], st[kb2]); }
        }
        if (64 * kt + 63 > pq0 + 32 * wq) {
#pragma unroll
            for (int kb2 = 0; kb2 < 2; ++kb2)
#pragma unroll
                for (int e = 0; e < 16; ++e) { const int kp = 64 * kt + 32 * kb2 + (e & 3) + 8 * (e >> 2) + 4 * h; if (kp > qp) st[kb2][e] = NEGF; }
        }
        float mx = st[0][0];
#pragma unroll
        for (int e = 1; e < 16; ++e) mx = fmaxf(mx, st[0][e]);
#pragma unroll
        for (int e = 0; e < 16; ++e) mx = fmaxf(mx, st[1][e]);
        mx = fmaxf(mx, __shfl_xor(mx, 32));
        if (__any(mx > m_run + 12.f)) {
            const float m_new = fmaxf(m_run, mx), alpha = ex2(m_run - m_new);
            m_run = m_new; l_run *= alpha;
#pragma unroll
            for (int d = 0; d < 4; ++d) o[d] = o[d] * alpha;
        }
        const float m_new = m_run;
        float psum = 0.f;
#pragma unroll
        for (int kb2 = 0; kb2 < 2; ++kb2)
#pragma unroll
            for (int e = 0; e < 16; ++e) { const float p = ex2(st[kb2][e] - m_new); st[kb2][e] = p; psum += p; }
        l_run += psum;
#pragma unroll
        for (int kb2 = 0; kb2 < 2; ++kb2)
#pragma unroll
            for (int s2 = 0; s2 < 2; ++s2) {
                u32x4 pw; pw.x = pk2(st[kb2][8 * s2], st[kb2][8 * s2 + 1]); pw.y = pk2(st[kb2][8 * s2 + 2], st[kb2][8 * s2 + 3]); pw.z = pk2(st[kb2][8 * s2 + 4], st[kb2][8 * s2 + 5]); pw.w = pk2(st[kb2][8 * s2 + 6], st[kb2][8 * s2 + 7]);
                const bf16x8 pf = __builtin_bit_cast(bf16x8, pw);
#pragma unroll
                for (int d = 0; d < 4; ++d) {
                    const LAS unsigned char* va = Vb + (32 * kb2 + 16 * s2 + 4 * h + q) * TSTR + (32 * d + 16 * (g & 1) + 4 * pp) * 2;
                    const bf16x8 vf = cat8(vtr(va), vtr(va + 8 * TSTR));
                    o[d] = mfma32(vf, pf, o[d]);
                }
            }
        }
        if (kt > 0) {
            const float bnd = qkb + slope2 * (float)(64 * (kt - 1) + 63 - pq0);
            const bool dn = !__any(bnd >= m_run - 40.f);
            if (lane == 0) votes[s * 8 + wid] = dn ? 1u : 0u;
            AT_STORE(s ^ 1);
        }
        __syncthreads();
        if (kt > 0) {
            const u32x4 v0 = *(const LAS u32x4*)(votes + s * 8), v1 = *(const LAS u32x4*)(votes + s * 8 + 4);
            const unsigned all = (unsigned)__builtin_amdgcn_readfirstlane((int)((v0.x & v0.y) & (v0.z & v0.w) & (v1.x & v1.y) & (v1.z & v1.w)));
            if (all) break;
        }
    }
#undef AT_LOAD
#undef AT_STORE
    const float l_tot = l_run + __shfl_xor(l_run, 32), inv = 1.f / l_tot;
    LAS float* xch = (LAS float*)lds;
    if (c == 1) {
#pragma unroll
        for (int d = 0; d < 4; ++d)
#pragma unroll
            for (int e = 0; e < 16; ++e) xch[((wq * 4 + d) * 16 + e) * 64 + lane] = o[d][e] * inv;
    }
    __syncthreads();
    if (c == 0) {
        float ss = 0.f;
#pragma unroll
        for (int d = 0; d < 4; ++d)
#pragma unroll
            for (int e = 0; e < 16; ++e) { const float v = o[d][e] * inv - lam * xch[((wq * 4 + d) * 16 + e) * 64 + lane]; o[d][e] = v; ss += v * v; }
        ss += __shfl_xor(ss, 32);
        const float rms = (1.f / sqrtf(ss * (1.f / 128.f) + LN_EPS)) * (1.f - lam_init);
        f32x4 ga_[4][4];
#pragma unroll
        for (int d = 0; d < 4; ++d)
#pragma unroll
            for (int r4 = 0; r4 < 4; ++r4) ga_[d][r4] = *(const f32x4*)(ang + hd * 128 + 32 * d + 8 * r4 + 4 * h);
        if (qi < nvalid) {
            const size_t row = seqrow(b, qp);
#pragma unroll
            for (int d = 0; d < 4; ++d)
#pragma unroll
                for (int r4 = 0; r4 < 4; ++r4) {
                    const int col = hd * 128 + 32 * d + 8 * r4 + 4 * h;
                    const f32x4 g4 = ga_[d][r4];
                    u32x2 w; w.x = pk2(o[d][4 * r4] * rms * g4[0], o[d][4 * r4 + 1] * rms * g4[1]); w.y = pk2(o[d][4 * r4 + 2] * rms * g4[2], o[d][4 * r4 + 3] * rms * g4[3]);
                    *(u32x2*)(AO + row * 512 + col) = w;
                }
        }
    }
    lds_barrier();
}

#define XB_TMO      128
#define XB_XCNT(j)  (256  + 64 * (j))
#define XB_XSUB(j)  (1280 + 64 * (j))
#define XB_XGEN(j)  (2304 + 64 * (j))
#define XB_TOP      3328
#define XB_TOPGEN   3392
#define XCD_BAR_WORDS 3456
#define XB_SPIN_CAP (1u << 18)

__device__ __forceinline__ unsigned xb_ld(unsigned* p)              { return __hip_atomic_load(p, __ATOMIC_RELAXED, __HIP_MEMORY_SCOPE_AGENT); }
__device__ __forceinline__ unsigned xb_add(unsigned* p, unsigned v) { return __hip_atomic_fetch_add(p, v, __ATOMIC_RELAXED, __HIP_MEMORY_SCOPE_AGENT); }
__device__ __forceinline__ unsigned xb_xcc_id() { return (unsigned)__builtin_amdgcn_s_getreg((3 << 11) | 20) & 0xFu; }
#define XB_SPIN(cond, bar) do { unsigned _sp = 0; while (cond) { __builtin_amdgcn_s_sleep(1); \
    if ((++_sp & 255u) == 0u) { if (xb_ld(&(bar)[XB_TMO])) break; if (_sp > XB_SPIN_CAP) { atomicAdd(&(bar)[XB_TMO], 1u); break; } } } } while (0)

struct XcdBarrier {
    unsigned* bar; unsigned x;
    volatile LAS unsigned* st;
};

__device__ __forceinline__ XcdBarrier xcd_barrier_post(unsigned* bar, volatile LAS unsigned* st) {
    XcdBarrier b; b.bar = bar; b.x = xb_xcc_id(); b.st = st;
    if (threadIdx.x == 0) (void)xb_add(&bar[XB_XCNT(b.x)], 1u);
    return b;
}
__device__ __forceinline__ void xcd_barrier_complete(unsigned* bar, unsigned x, unsigned& nloc, unsigned& nx) {
    const unsigned G = gridDim.x * gridDim.y * gridDim.z;
    unsigned sum, cnt, mine, sp = 0u;
    for (;;) {
        sum = 0u; cnt = 0u; mine = 0u;
#pragma unroll
        for (unsigned j = 0; j < 16; ++j) { const unsigned c = xb_ld(&bar[XB_XCNT(j)]); sum += c; cnt += (c > 0u) ? 1u : 0u; mine = (j == x) ? c : mine; }
        if (sum == G) break;
        __builtin_amdgcn_s_sleep(1);
        if ((++sp & 255u) == 0u) { if (xb_ld(&bar[XB_TMO])) break; if (sp > XB_SPIN_CAP) { atomicAdd(&bar[XB_TMO], 1u); break; } }
    }
    nloc = mine > 0u ? mine : 1u; nx = cnt > 0u ? cnt : 1u;
}

__device__ __forceinline__ void xcd_barrier(const XcdBarrier& b) {
    asm volatile("s_waitcnt vmcnt(0)" ::: "memory");
    __syncthreads();
    if (threadIdx.x == 0) {
        unsigned* bar = b.bar;
        __builtin_amdgcn_s_waitcnt(0);
        unsigned nloc = b.st[0], nx = b.st[1];
        if (nloc == 0u) { xcd_barrier_complete(bar, b.x, nloc, nx); b.st[0] = nloc; b.st[1] = nx; }
        const unsigned old = xb_add(&bar[XB_XSUB(b.x)], 1u);
        const unsigned gen = old / nloc;
        if (old + 1u == (gen + 1u) * nloc) {
            __builtin_amdgcn_fence(__ATOMIC_RELEASE, "agent");
            asm volatile("s_waitcnt vmcnt(0)" ::: "memory");
            const unsigned og = xb_add(&bar[XB_TOP], 1u);
            const unsigned tg = og / nx;
            if (og + 1u == (tg + 1u) * nx) xb_add(&bar[XB_TOPGEN], 1u);
            else XB_SPIN(xb_ld(&bar[XB_TOPGEN]) == tg, bar);
            __builtin_amdgcn_fence(__ATOMIC_ACQUIRE, "agent");
            xb_add(&bar[XB_XGEN(b.x)], 1u);
            asm volatile("s_waitcnt vmcnt(0)" ::: "memory");
        } else {
            XB_SPIN(xb_ld(&bar[XB_XGEN(b.x)]) == gen, bar);
            __builtin_amdgcn_fence(__ATOMIC_ACQUIRE, "agent");
            asm volatile("s_waitcnt vmcnt(0)" ::: "memory");
        }
    }
    __syncthreads();
}

#ifndef PROBE_ATT
#define PROBE_ATT 1
#endif
#ifndef PROBE_M3
#define PROBE_M3 1
#endif
constexpr int LDS_BYTES = 155648;
constexpr int LDS_BST = LDS_BYTES - 64;
#ifndef PROG_LAYER
#define PROG_LAYER(L) 16*L+0, 16*L+1, 16*L+3, 16*L+4, 16*L+5, 16*L+6, 16*L+7, 16*L+8, 16*L+9, 16*L+11, 16*L+12
#endif
__device__ const unsigned char PROG[] = { PROG_LAYER(0), PROG_LAYER(1), 16 * 1 + 13 };
constexpr int NSTEP = 14;
__global__ void __launch_bounds__(512) hybrid_fwd(Params P) {
    extern __shared__ __attribute__((aligned(16))) unsigned char smem[];
    LAS unsigned char* lds = (LAS unsigned char*)smem;
    cg::grid_group grid = cg::this_grid();
    unsigned* barw = (unsigned*)(P.ws + WS_BAR);
    volatile LAS unsigned* bst = (volatile LAS unsigned*)(lds + LDS_BST);
    if (blockIdx.x == 0) for (int i = threadIdx.x; i < XCD_BAR_WORDS; i += 512) __hip_atomic_store(barw + i, 0u, __ATOMIC_RELAXED, __HIP_MEMORY_SCOPE_AGENT);
    if (blockIdx.x == 0 && threadIdx.x < 144) __hip_atomic_store((unsigned*)(P.ws + WS_KM) + threadIdx.x, 0u, __ATOMIC_RELAXED, __HIP_MEMORY_SCOPE_AGENT);
    if (threadIdx.x < 2) bst[threadIdx.x] = 0u;
    __syncthreads();

#ifndef PROBE_P0
#define PROBE_P0 1
#endif
#pragma unroll 1
    for (int rep0_ = 0; rep0_ < PROBE_P0; ++rep0_)
    {
        const int lane = tidx() & 63, wid = tidx() >> 6, gw = bidx() * 8 + wid, NGW = gridDim.x * 8;
        bf16_t* HB = (bf16_t*)(P.ws + WS_HB); float* HFM = (float*)(P.ws + WS_HFM);
        LAS float* scr = (LAS float*)(lds + wid * 16384);
        for (int it = gw; it < 2 * CW_ITEMS; it += NGW) conv_weight_item(P, it / CW_ITEMS, it % CW_ITEMS, scr, lane);
        const float* x = P.in[0]; const float* meta = P.in[1];
        {
            const size_t NT8 = (size_t)gridDim.x * 512, n8 = (size_t)MREAL * DM / 8;
#pragma unroll 1
            for (size_t i = (size_t)bidx() * 512 + tidx(); i < n8; i += 4 * NT8) {
                f32x4 v0[4], v1[4];
#pragma unroll
                for (int j = 0; j < 4; ++j) { const size_t ii = i + j * NT8 < n8 ? i + j * NT8 : i; v0[j] = *(const f32x4*)(x + ii * 8); v1[j] = *(const f32x4*)(x + ii * 8 + 4); }
                asm volatile("" : "+v"(v0[0]), "+v"(v0[1]), "+v"(v0[2]), "+v"(v0[3]), "+v"(v1[0]), "+v"(v1[1]), "+v"(v1[2]), "+v"(v1[3]));
#pragma unroll
                for (int j = 0; j < 4; ++j) if (i + j * NT8 < n8) *(u32x4*)(HB + (i + j * NT8) * 8) = pack8(v0[j], v1[j]);
            }
        }
        for (int row = gw; row < NMETA; row += NGW) {
#pragma unroll
            for (int j = 0; j < 4; ++j) {
                const f32x4 v = *(const f32x4*)(meta + (size_t)row * DM + 256 * j + 4 * lane);
                *(f32x4*)(HFM + (size_t)row * DM + 256 * j + 4 * lane) = v;
                u32x2 w; w.x = pk2(v[0], v[1]); w.y = pk2(v[2], v[3]);
                *(u32x2*)(HB + (size_t)(MROW0 + row) * DM + 256 * j + 4 * lane) = w;
            }
        }
    }
    grid.sync();
    (void)xcd_barrier_post(barw, bst);

#pragma unroll 1
    for (int ph = 0; ph < (int)sizeof(PROG); ++ph) {
        const int layer = PROG[ph] >> 4, step = PROG[ph] & 15;
        const int G = gridDim.x;
#define TIDV const int tid_ = tidx(), lane = tid_ & 63, wid = __builtin_amdgcn_readfirstlane(tid_ >> 6); (void)lane; (void)wid;
        bf16_t* HB = (bf16_t*)(P.ws + WS_HB); float* HFM = (float*)(P.ws + WS_HFM);
        bf16_t* BIG = (bf16_t*)(P.ws + WS_BIG); bf16_t* MA = (bf16_t*)(P.ws + WS_MA);
        const bf16_t* Wl = (const bf16_t*)(P.ws + WS_W) + (size_t)layer * OW_LAYER;
#define LNCTX float* ROWS = (float*)(P.ws + WS_ROWS); const float* CSl = (const float*)(P.ws + WS_CSBW) + (size_t)layer * 2 * OC_N; const float* BWl = CSl + OC_N; \
        const int tlast = 3 * layer + (step <= 1 ? -1 : step <= 9 ? 0 : step <= 12 ? 1 : 2);   \
        const float* rows_last = ROWS + (size_t)((tlast & 1) * MPAD) * 2; (void)CSl; (void)BWl; (void)rows_last;
        if (step == 0 || step == 3 || step == 11) {
            LNCTX
            float* z = ROWS + (size_t)(((tlast + 1) & 1) * MPAD) * 2;
            for (int i = bidx() * 512 + tidx(); i < MPAD * 2 / 4; i += G * 512) *(f32x4*)(z + 4 * i) = (f32x4){0.f, 0.f, 0.f, 0.f};
        }
        if (step == 0 || step == 11) {
            LNCTX
            const bf16_t* Wgu = Wl + (step ? OW_GU2 : OW_GU1); const int oc = step ? OC_GU2 : OC_GU1;
            const pg8::LnFix fx{rows_last, CSl + oc, BWl + oc, tlast >= 0 ? 1 : 0};
            pg8::Gemm gm{HB, Wgu, MREAL, 2 * FF, DM}; pg8::StaticOrder S; S.init(MREAL, 2 * FF, G, bidx());
            pg8::EpiSwiglu E{BIG, FF, fx};
            pg8::gemm_phase<pg8::EpiSwiglu, pg8::StaticOrder, true, true>(lds, gm, S, E);
            for (int ct = bidx(); ct < FF / 16; ct += G) {
                TIDV
                const int c0 = 16 * ct, R0 = 256 * (c0 >> 7) + (c0 & 127);
                const f32x4 ag = sg_tile_blk(HB + (size_t)MROW0 * DM, DM, Wgu, DM, R0, lane, wid, (LAS float*)lds), au = sg_tile_blk(HB + (size_t)MROW0 * DM, DM, Wgu, DM, R0 + 128, lane, wid, (LAS float*)lds);
                if (wid == 0) {
                    const int rb = R0 + (lane & 15);
                    float mu4[4] = {0.f, 0.f, 0.f, 0.f}, r4v[4] = {1.f, 1.f, 1.f, 1.f}, csg = 0.f, bwg = 0.f, csu = 0.f, bwu = 0.f;
                    if (fx.on) { csg = fx.cs[rb]; bwg = fx.bw[rb]; csu = fx.cs[rb + 128]; bwu = fx.bw[rb + 128];
#pragma unroll
                        for (int e = 0; e < 4; ++e) fx.stats((size_t)(MROW0 + 4 * (lane >> 4) + e), mu4[e], r4v[e]); }
#pragma unroll
                    for (int e = 0; e < 4; ++e) {
                        const size_t row = (size_t)(MROW0 + 4 * (lane >> 4) + e);
                        const float gv = (ag[e] - csg * mu4[e]) * r4v[e] + bwg, uv = (au[e] - csu * mu4[e]) * r4v[e] + bwu;
                        BIG[row * FF + c0 + (lane & 15)] = (bf16_t)f2bf(siluf(gv) * uv);
                    }
                }
            }
        } else if (step == 1 || step == 9 || step == 12) {
            LNCTX
            const bf16_t* A = step == 9 ? MA : BIG; const bf16_t* Bt = Wl + (step == 1 ? OW_D1 : step == 9 ? OW_OUT : OW_D2);
            const int K = step == 9 ? DM : FF; const float sc = step == 9 ? 1.f : 0.5f;
            pg8::Gemm gm{A, Bt, MREAL, DM, K}; pg8::StaticOrder S; S.init(MREAL, DM, G, bidx());
            const int raw = tlast < 0 ? 1 : 0;
            const int gi = step == 1 ? (layer == 0 ? 5 : 26) : step == 9 ? 5 : 21;
            const int gl = step == 1 ? (layer == 0 ? 0 : layer - 1) : layer;
            const float* gam = P.in[gi] + (size_t)gl * DM; const float* bet = P.in[gi + 1] + (size_t)gl * DM;
            float* rows_cur = ROWS + (size_t)(((tlast + 1) & 1) * MPAD) * 2;
            pg8::EpiResid E{P.in[0], (bf16_t*)(P.ws + WS_LO), HB, rows_last, rows_cur, gam, bet, sc, raw};
            pg8::gemm_phase<pg8::EpiResid, pg8::StaticOrder, true, true>(lds, gm, S, E);
            for (int ct = bidx(); ct < 64; ct += G) {
                TIDV
                const f32x4 a = sg_tile_blk(A + (size_t)MROW0 * K, K, Bt, K, 16 * ct, lane, wid, (LAS float*)lds);
                const int col = 16 * ct + (lane & 15);
                if (wid == 0) {
                    float hv[4], s1v[4] = {0.f, 0.f, 0.f, 0.f}, s2v[4] = {1.f, 1.f, 1.f, 1.f}, gcol = 1.f, bcol = 0.f;
#pragma unroll
                    for (int e = 0; e < 4; ++e) { const int mr = 4 * (lane >> 4) + e; hv[e] = HFM[(size_t)mr * DM + col]; if (!raw) { s1v[e] = rows_last[(size_t)(MROW0 + mr) * 2]; s2v[e] = rows_last[(size_t)(MROW0 + mr) * 2 + 1]; } }
                    if (!raw) { gcol = gam[col]; bcol = bet[col]; }
#pragma unroll
                    for (int e = 0; e < 4; ++e) {
                        const int mr = 4 * (lane >> 4) + e; float* p = HFM + (size_t)mr * DM + col;
                        float h = hv[e];
                        if (!raw) { const float mu = s1v[e] * (1.f / DM), r = __builtin_amdgcn_rsqf(s2v[e] * (1.f / DM) - mu * mu + LN_EPS);
                            h = (h - mu) * r * gcol + bcol; }
                        const float y = ALPHA * h + sc * a[e];
                        *p = y; HB[(size_t)(MROW0 + mr) * DM + col] = (bf16_t)f2bf(y);
                        float q1 = y, q2 = y * y;
                        q1 += __shfl_xor(q1, 1); q1 += __shfl_xor(q1, 2); q1 += __shfl_xor(q1, 4); q1 += __shfl_xor(q1, 8);
                        q2 += __shfl_xor(q2, 1); q2 += __shfl_xor(q2, 2); q2 += __shfl_xor(q2, 4); q2 += __shfl_xor(q2, 8);
                        if ((lane & 15) == 0) { atomicAdd(rows_cur + (size_t)(MROW0 + mr) * 2, q1); atomicAdd(rows_cur + (size_t)(MROW0 + mr) * 2 + 1, q2); }
                    }
                }
            }
        } else if (step == 13) {
            ln_phase(P, P.in[26] + (size_t)layer * DM, P.in[27] + (size_t)layer * DM, false, true, nullptr, nullptr, lds);
        } else if (step == 3 || step == 7) {
            LNCTX
            const int ng = step == 3 ? 1 : 2;
            float* GT = (float*)(P.ws + WS_GATES); const float* bif = P.in[10] + (size_t)layer * 8;
#pragma unroll 1
            for (int gi = 0; gi < ng; ++gi) {
                const bf16_t* A = step == 3 ? HB : MA + (size_t)gi * MPAD * 512;
                const bf16_t* Bt = Wl + (step == 3 ? OW_PB : gi ? OW_BA : OW_BM);
                const int N = step == 3 ? NPBW : DM, K = step == 3 ? DM : 512, ldc = step == 3 ? NPB : 2048, coff = gi * DM;
                const pg8::LnFix fx{rows_last, CSl + OC_PB, BWl + OC_PB, step == 3 ? 1 : 0};
                pg8::Gemm gm{A, Bt, MREAL, N, K}; pg8::StaticOrder S; S.init(MREAL, N, G, bidx());
                pg8::EpiPlain E{BIG, ldc, coff, step == 3 ? 8 : 0, step == 3 ? 10 : 0, QSCALE, fx, step == 3 ? GT : nullptr, bif};
                pg8::gemm_phase<pg8::EpiPlain, pg8::StaticOrder, true, true>(lds, gm, S, E);
                const int ntile = step == 3 ? NPB / 16 + 1 : N / 16;
                for (int ct = bidx(); ct < ntile; ct += G) {
                    TIDV
                    const f32x4 a = sg_tile_blk(A + (size_t)MROW0 * K, K, Bt, K, 16 * ct, lane, wid, (LAS float*)lds);
                    const float sc = (step == 3 && 16 * ct >= 2048 && 16 * ct < 2560) ? QSCALE : 1.f;
                    if (wid == 0) {
                        const int rb = 16 * ct + (lane & 15);
                        float mu4[4] = {0.f, 0.f, 0.f, 0.f}, r4v[4] = {1.f, 1.f, 1.f, 1.f}, cs1 = 0.f, bw1 = 0.f;
                        if (fx.on) { cs1 = fx.cs[rb]; bw1 = fx.bw[rb];
#pragma unroll
                            for (int e = 0; e < 4; ++e) fx.stats((size_t)(MROW0 + 4 * (lane >> 4) + e), mu4[e], r4v[e]); }
#pragma unroll
                        for (int e = 0; e < 4; ++e) {
                            const size_t row = (size_t)(MROW0 + 4 * (lane >> 4) + e);
                            const float v = (a[e] - cs1 * mu4[e]) * r4v[e] + bw1;
                            if (step == 3 && ct == NPB / 16) {
                                if ((lane & 15) < 8) { const float z = v + bif[lane & 15]; GT[row * 8 + (lane & 15)] = (lane & 15) < 4 ? z : fminf(z, 0.f) - __logf(1.f + __expf(-fabsf(z))); }
                            } else BIG[row * ldc + coff + rb] = (bf16_t)f2bf(v * sc);
                        }
                    }
                }
            }
        } else if (step == 4) {
            {
                float* KM = (float*)(P.ws + WS_KM) + layer * 72;
                TIDV
                const int gw = bidx() * 8 + wid, NGW = G * 8;
#pragma unroll 1
                for (int task = gw; task < 2049; task += NGW) {
                    const int real = task < 2048, slot = real ? task >> 8 : 8, nr = real ? 32 : NMETA;
                    const size_t r0 = real ? (size_t)(task >> 8) * SEQ + (size_t)(task & 255) * 32 : (size_t)MROW0;
                    float mxv = 0.f;
#pragma unroll 1
                    for (int i0 = 0; i0 < nr; i0 += 8) {
                        u32x4 vr[8];
#pragma unroll
                        for (int j = 0; j < 8; ++j) vr[j] = *(const u32x4*)(BIG + (r0 + i0 + j) * NPB + 2560 + lane * 8);
                        asm volatile("" : "+v"(vr[0]), "+v"(vr[1]), "+v"(vr[2]), "+v"(vr[3]), "+v"(vr[4]), "+v"(vr[5]), "+v"(vr[6]), "+v"(vr[7]));
#pragma unroll
                        for (int j = 0; j < 8; ++j) {
                            const u32x4 v = vr[j];
                            float ss = bflo(v.x) * bflo(v.x) + bfhi(v.x) * bfhi(v.x) + bflo(v.y) * bflo(v.y) + bfhi(v.y) * bfhi(v.y) + bflo(v.z) * bflo(v.z) + bfhi(v.z) * bfhi(v.z) + bflo(v.w) * bflo(v.w) + bfhi(v.w) * bfhi(v.w);
                            ss += __shfl_xor(ss, 1); ss += __shfl_xor(ss, 2); ss += __shfl_xor(ss, 4);
                            mxv = fmaxf(mxv, ss);
                        }
                    }
                    if ((lane & 7) == 0) atomicMax((unsigned*)KM + slot * 8 + (lane >> 3), __builtin_bit_cast(unsigned, mxv));
                }
            }
            for (int u = bidx(); u < 2048 + 4; u += G) { const int bh_ = u < 2048 ? u >> 6 : u - 2048, c_ = u < 2048 ? 1 + (u & 63) : 0; m1_unit(P, layer, bh_, c_, lds); }
        } else if (step == 5) {
            m2_phase(P);
        } else if (step == 6) {
            const float lam_init = layer == 0 ? 0.2f : 0.35550906759f;
            float lam;
            {
                TIDV
                const float* l1 = P.in[12] + layer * 64; const float* k1 = P.in[13] + layer * 64; const float* l2 = P.in[14] + layer * 64; const float* k2 = P.in[15] + layer * 64;
                const float s1 = wave_sum(l1[lane] * k1[lane]), s2 = wave_sum(l2[lane] * k2[lane]);
                lam = expf(s1) - expf(s2) + lam_init;
            }
#pragma unroll 1
            for (int rep_ = 0; rep_ < PROBE_ATT; ++rep_)
#pragma unroll 1
            for (int u = bidx(); u < 2048 + 4; u += G) {
                const int cbv = u & 255, i = u >> 8, jj = cbv >> 3, j = (i & 1) ? 63 - jj : jj;
                const bool real = u < 2048; const int bh = real ? ((cbv & 7) * 4 + ((i >> 1) & 3)) : (u - 2048);
                attn_unit(P, layer, bh >> 2, bh & 3, real ? NMETA + 128 * j : 0, real ? 128 : NMETA, lam, lam_init, lds);
            }
#pragma unroll 1
            for (int rep_ = 0; rep_ < PROBE_M3; ++rep_)
#pragma unroll 1
            for (int u = bidx(); u < 2048 + 4; u += G) { const int bh_ = u < 2048 ? u >> 6 : u - 2048, c_ = u < 2048 ? 1 + (u & 63) : 0; m3_unit(P, layer, bh_, c_, lds); }
        } else if (step == 8) {
            const bf16_t* Y = BIG; const float* bg = P.in[19] + (size_t)layer * 2048;
            pg8::Gemm gm{HB, Wl + OW_GM, MREAL, 2048, DM}; pg8::StaticOrder S; S.init(MREAL, 2048, G, bidx());
            LNCTX
            const pg8::LnFix fx{rows_last, CSl + OC_GM, BWl + OC_GM, 1};
            pg8::EpiGate E{MA, Y, bg, fx};
            pg8::gemm_phase<pg8::EpiGate, pg8::StaticOrder, true, true>(lds, gm, S, E);
            for (int ct = bidx(); ct < 64; ct += G) {
                TIDV
                const int c0 = 16 * ct, R0 = 256 * (c0 >> 7) + (c0 & 127);
                const f32x4 am = sg_tile_blk(HB + (size_t)MROW0 * DM, DM, Wl + OW_GM, DM, R0, lane, wid, (LAS float*)lds), aa = sg_tile_blk(HB + (size_t)MROW0 * DM, DM, Wl + OW_GM, DM, R0 + 128, lane, wid, (LAS float*)lds);
                const int col = c0 + (lane & 15), rb = R0 + (lane & 15);
                if (wid == 0) {
                    float mu4[4], r4v[4], ymv[4], yav[4];
                    const float csm = fx.cs[rb], bwm = fx.bw[rb], csa = fx.cs[rb + 128], bwa = fx.bw[rb + 128];
#pragma unroll
                    for (int e = 0; e < 4; ++e) { const size_t rowl = (size_t)(MROW0 + 4 * (lane >> 4) + e); fx.stats(rowl, mu4[e], r4v[e]); ymv[e] = bflo((unsigned)Y[rowl * 2048 + col]); yav[e] = bflo((unsigned)Y[rowl * 2048 + DM + col]); }
#pragma unroll
                    for (int e = 0; e < 4; ++e) {
                        const size_t row = (size_t)(MROW0 + 4 * (lane >> 4) + e);
                        const float gmv = (am[e] - csm * mu4[e]) * r4v[e] + bwm, gav = (aa[e] - csa * mu4[e]) * r4v[e] + bwa;
                        const float ym = ymv[e], ya = yav[e];
                        MA[row * DM + col] = (bf16_t)f2bf(sigm(gmv) * ym + sigm(gav) * ya);
                    }
                }
            }
        }
        {
            unsigned char* wsb = P.ws; asm volatile("" : "+s"(wsb));
            XcdBarrier xb; xb.bar = (unsigned*)(wsb + WS_BAR); xb.x = xb_xcc_id(); xb.st = (volatile LAS unsigned*)(lds + LDS_BST);
            xcd_barrier(xb);
#ifdef PROBE_SYNC
            for (int i_ = 0; i_ < PROBE_SYNC; ++i_) xcd_barrier(xb);
#endif
        }
    }
}

extern "C" void kernel_launch(void* const* d_in, const int* in_sizes, int n_in, void* d_out, int out_size, void* d_ws, size_t ws_size, hipStream_t stream) {
    static int grid = 0;
    if (grid == 0) {
        if (n_in != 28 || out_size != MREAL * DM || ws_size < WS_END) { fprintf(stderr, "kernel_launch: unexpected shapes (n_in %d out %d ws %zu)\n", n_in, out_size, ws_size); grid = -1; return; }
        int dev = 0, cus = 0, per_cu = 0;
        hipGetDevice(&dev); hipDeviceGetAttribute(&cus, hipDeviceAttributeMultiprocessorCount, dev);
        hipFuncSetAttribute((const void*)hybrid_fwd, hipFuncAttributeMaxDynamicSharedMemorySize, LDS_BYTES);
        hipOccupancyMaxActiveBlocksPerMultiprocessor(&per_cu, (const void*)hybrid_fwd, 512, LDS_BYTES);
        if (per_cu < 1) per_cu = 1;
        grid = cus * per_cu;
        (void)hipGetLastError();
    }
    if (grid < 0) return;
    Params p{};
    for (int i = 0; i < 28; ++i) p.in[i] = (const float*)d_in[i];
    p.out = (float*)d_out; p.ws = (unsigned char*)d_ws;
    void* args[] = {&p};
    hipError_t e = hipLaunchCooperativeKernel((const void*)hybrid_fwd, dim3(grid), dim3(512), args, LDS_BYTES, stream);
    if (e != hipSuccess) fprintf(stderr, "cooperative launch failed: %s (grid %d)\n", hipGetErrorString(e), grid);
}
```
